# Optimizing an MI355X kernel written in HIP

```python
import jax, jax.numpy as jnp
from jax import lax
import numpy as np

D_MODEL = 1024
BATCH = 8
SEQ = 2048
DEPTH = 2
DEC_BATCH = 128
DEC_SEQ = 4
PAST_LEN = 16384
PAGE_SIZE = 128

MIX_WIDTH = D_MODEL
N_MIXERS = 4
GROUP_WIDTH = MIX_WIDTH // N_MIXERS
N_SUB = 4
SUB_DIM = GROUP_WIDTH // N_SUB
POOL_WINDOWS = (2, 4, 8, 16)
POOL_BUF = max(POOL_WINDOWS) - 1
CONV_WIDTH = 31
SHORT_WIDTH = 3
CHUNK = 128
D_FF = 4 * D_MODEL
EPS = 1e-6
IN_WIDTH = GROUP_WIDTH * (1 + 2 + 2 + 3)

kernel_name = "hybrid_parallel_pool_conv_sgu_shortconv_step"


def rms_norm(x, g):
    xf = x.astype(jnp.float32)
    y = xf * lax.rsqrt(jnp.mean(xf * xf, axis=-1, keepdims=True) + EPS)
    return (y * g.astype(jnp.float32)).astype(x.dtype)


def layer_norm(x, g, b):
    xf = x.astype(jnp.float32)
    mu = jnp.mean(xf, axis=-1, keepdims=True)
    xc = xf - mu
    var = jnp.mean(xc * xc, axis=-1, keepdims=True)
    y = xc * lax.rsqrt(var + EPS) * g.astype(jnp.float32) + b.astype(jnp.float32)
    return y.astype(x.dtype)


def causal_depthwise_conv(x, buf, w):
    ext = jnp.concatenate([buf.astype(x.dtype), x], axis=1)
    k = w.shape[0]
    y = lax.conv_general_dilated(ext, w.astype(ext.dtype)[:, None, :], window_strides=(1,),
                                 padding="VALID", dimension_numbers=("NWC", "WIO", "NWC"),
                                 feature_group_count=x.shape[-1])
    return y, ext[:, ext.shape[1] - (k - 1):]


def pool_mixer(a, buf, pos0, w_pool, scale):
    bn, t, _ = a.shape
    p = POOL_BUF
    ext = jnp.concatenate([buf.astype(jnp.float32), a.astype(jnp.float32)], axis=1)
    cs = jnp.concatenate([jnp.zeros((bn, 1, GROUP_WIDTH), jnp.float32),
                          jnp.cumsum(ext, axis=1)], axis=1)
    pos = pos0 + jnp.arange(t)
    cur = ext[:, p:]
    outs = []
    for gi, w in enumerate(POOL_WINDOWS):
        sl = slice(gi * SUB_DIM, (gi + 1) * SUB_DIM)
        win_sum = cs[:, p + 1:p + 1 + t, sl] - cs[:, p + 1 - w:p + 1 - w + t, sl]
        cnt = jnp.minimum(w, pos + 1).astype(jnp.float32)[None, :, None]
        outs.append(win_sum / cnt - cur[..., sl])
    d = jnp.stack(outs, axis=2)
    y = jnp.einsum("btgc,gcd->btgd", d, w_pool.astype(jnp.float32)).reshape(bn, t, GROUP_WIDTH)
    y = y * scale.astype(jnp.float32)
    return y.astype(a.dtype), ext[:, ext.shape[1] - p:].astype(a.dtype)


def conformer_conv(z, buf, conv_w, conv_b, ln_g, ln_b):
    p, gate = jnp.split(z, 2, axis=-1)
    g = p * jax.nn.sigmoid(gate)
    c, new_buf = causal_depthwise_conv(g, buf, conv_w)
    c = c + conv_b
    bn, t, _ = c.shape
    c = layer_norm(c.reshape(bn, t, N_SUB, SUB_DIM), ln_g.reshape(N_SUB, SUB_DIM),
                   ln_b.reshape(N_SUB, SUB_DIM))
    return jax.nn.silu(c).reshape(bn, t, GROUP_WIDTH), new_buf


def chunk_spatial_gating(z, ln_g, ln_b, w_s, b_s):
    bn, t, _ = z.shape
    u, v = jnp.split(z, 2, axis=-1)
    v = layer_norm(v.reshape(bn, t, N_SUB, SUB_DIM), ln_g.reshape(N_SUB, SUB_DIM),
                   ln_b.reshape(N_SUB, SUB_DIM))
    n_chunks = -(-t // CHUNK)
    pad = n_chunks * CHUNK - t
    vp = jnp.pad(v, ((0, 0), (0, pad), (0, 0), (0, 0))).reshape(bn, n_chunks, CHUNK, N_SUB, SUB_DIM)
    mask = jnp.tril(jnp.ones((CHUNK, CHUNK), dtype=bool))
    w_causal = jnp.where(mask[None], w_s, jnp.zeros((), w_s.dtype))
    s = jnp.einsum("hts,bnshd->bnthd", w_causal, vp) + jnp.transpose(b_s)[None, None, :, :, None]
    s = s.reshape(bn, n_chunks * CHUNK, N_SUB, SUB_DIM)[:, :t].reshape(bn, t, GROUP_WIDTH)
    return u * s, v.reshape(bn, t, GROUP_WIDTH)


def short_gated_conv(z, buf, w):
    bg, cg, h = jnp.split(z, 3, axis=-1)
    c, new_buf = causal_depthwise_conv(cg * h, buf, w)
    return bg * c, new_buf


def decoder_layer(x, pos0, pool_buf, conv_buf, short_buf, g_mix_pre, g_mix_post, g_ffn_pre,
                  g_ffn_post, w_in, w_out, w_pool, pool_scale, conv_w, conv_b, conv_ln_g,
                  conv_ln_b, sgu_ln_g, sgu_ln_b, sgu_w, sgu_b, short_w, w_up, w_down):
    gw = GROUP_WIDTH
    h = rms_norm(x, g_mix_pre)
    z = h @ w_in
    y_a, nb_pool = pool_mixer(z[..., :gw], pool_buf, pos0, w_pool, pool_scale)
    y_b, nb_conv = conformer_conv(z[..., gw:3 * gw], conv_buf, conv_w, conv_b, conv_ln_g, conv_ln_b)
    y_c, v_rows = chunk_spatial_gating(z[..., 3 * gw:5 * gw], sgu_ln_g, sgu_ln_b, sgu_w, sgu_b)
    y_d, nb_short = short_gated_conv(z[..., 5 * gw:], short_buf, short_w)
    o = jnp.concatenate([y_a, y_b, y_c, y_d], axis=-1) @ w_out
    x = x + rms_norm(o, g_mix_post)
    f = rms_norm(x, g_ffn_pre)
    f = jnp.square(jax.nn.relu(f @ w_up)) @ w_down
    x = x + rms_norm(f, g_ffn_post)
    return x, nb_pool, nb_conv, nb_short, v_rows


def setup_inputs(seed: int = 0) -> dict:
    key = jax.random.key(seed)
    ks = jax.random.split(key, 24)

    def nrm(k, shape, scale):
        return jax.random.normal(k, shape, jnp.float32) * scale

    return {
        "x_prompt": nrm(ks[0], (BATCH, SEQ, D_MODEL), 1.0),
        "x_sample": nrm(ks[1], (DEC_BATCH, DEC_SEQ, D_MODEL), 1.0),
        "state_pool": nrm(ks[2], (DEPTH, DEC_BATCH, POOL_BUF, GROUP_WIDTH), 1.0),
        "state_conv": nrm(ks[3], (DEPTH, DEC_BATCH, CONV_WIDTH - 1, GROUP_WIDTH), 0.5),
        "state_short": nrm(ks[4], (DEPTH, DEC_BATCH, SHORT_WIDTH - 1, GROUP_WIDTH), 1.0),
        "norm_mix_pre": 1.0 + nrm(ks[5], (DEPTH, D_MODEL), 0.1),
        "norm_mix_post": 1.0 + nrm(ks[6], (DEPTH, D_MODEL), 0.1),
        "norm_ffn_pre": 1.0 + nrm(ks[7], (DEPTH, D_MODEL), 0.1),
        "norm_ffn_post": 1.0 + nrm(ks[8], (DEPTH, D_MODEL), 0.1),
        "w_in": nrm(ks[9], (DEPTH, D_MODEL, IN_WIDTH), D_MODEL ** -0.5),
        "w_out": nrm(ks[10], (DEPTH, MIX_WIDTH, D_MODEL), MIX_WIDTH ** -0.5),
        "w_pool": nrm(ks[11], (DEPTH, N_SUB, SUB_DIM, SUB_DIM), SUB_DIM ** -0.5),
        "pool_scale": 1.0 + nrm(ks[12], (DEPTH, GROUP_WIDTH), 0.1),
        "conv_w": nrm(ks[13], (DEPTH, CONV_WIDTH, GROUP_WIDTH), CONV_WIDTH ** -0.5),
        "conv_b": nrm(ks[14], (DEPTH, GROUP_WIDTH), 0.01),
        "conv_ln_g": 1.0 + nrm(ks[15], (DEPTH, GROUP_WIDTH), 0.1),
        "conv_ln_b": nrm(ks[16], (DEPTH, GROUP_WIDTH), 0.01),
        "sgu_ln_g": 1.0 + nrm(ks[17], (DEPTH, GROUP_WIDTH), 0.1),
        "sgu_ln_b": nrm(ks[18], (DEPTH, GROUP_WIDTH), 0.01),
        "sgu_w": nrm(ks[19], (DEPTH, N_SUB, CHUNK, CHUNK), CHUNK ** -0.5),
        "sgu_b": 1.0 + nrm(ks[20], (DEPTH, N_SUB, CHUNK), 0.1),
        "short_w": nrm(ks[21], (DEPTH, SHORT_WIDTH, GROUP_WIDTH), SHORT_WIDTH ** -0.5),
        "w_ffn_up": nrm(ks[22], (DEPTH, D_MODEL, D_FF), D_MODEL ** -0.5),
        "w_ffn_down": nrm(ks[23], (DEPTH, D_FF, D_MODEL), D_FF ** -0.5),
    }


def reference(x_prompt, x_sample, state_pool, state_conv, state_short, norm_mix_pre,
              norm_mix_post, norm_ffn_pre, norm_ffn_post, w_in, w_out, w_pool, pool_scale,
              conv_w, conv_b, conv_ln_g, conv_ln_b, sgu_ln_g, sgu_ln_b, sgu_w, sgu_b, short_w,
              w_ffn_up, w_ffn_down):
    bp = x_prompt.shape[0]
    yp = x_prompt
    ys = x_sample
    pool_p, pool_s, conv_p, conv_s, short_p, short_s, v_s = [], [], [], [], [], [], []
    for l in range(DEPTH):
        params = (norm_mix_pre[l], norm_mix_post[l], norm_ffn_pre[l], norm_ffn_post[l], w_in[l],
                  w_out[l], w_pool[l], pool_scale[l], conv_w[l], conv_b[l], conv_ln_g[l],
                  conv_ln_b[l], sgu_ln_g[l], sgu_ln_b[l], sgu_w[l], sgu_b[l], short_w[l],
                  w_ffn_up[l], w_ffn_down[l])
        yp, pa, pb, pd, _ = decoder_layer(
            yp, 0,
            jnp.zeros((bp, POOL_BUF, GROUP_WIDTH), yp.dtype),
            jnp.zeros((bp, CONV_WIDTH - 1, GROUP_WIDTH), yp.dtype),
            jnp.zeros((bp, SHORT_WIDTH - 1, GROUP_WIDTH), yp.dtype),
            *params)
        ys, sa, sb, sd, sv = decoder_layer(ys, PAST_LEN, state_pool[l], state_conv[l],
                                           state_short[l], *params)
        pool_p.append(pa); pool_s.append(sa)
        conv_p.append(pb); conv_s.append(sb)
        short_p.append(pd); short_s.append(sd)
        v_s.append(sv)
    return (yp, ys, jnp.stack(pool_p), jnp.stack(pool_s), jnp.stack(conv_p), jnp.stack(conv_s),
            jnp.stack(short_p), jnp.stack(short_s), jnp.stack(v_s))
```

```cpp
#include <hip/hip_runtime.h>
#include <hip/hip_cooperative_groups.h>
#include <cstdio>
#include <cstdint>
namespace pg8 {
#define PG8_LAS __attribute__((address_space(3)))
typedef unsigned short bf16_t;
typedef short bf16x8 __attribute__((ext_vector_type(8)));
typedef float f32x4 __attribute__((ext_vector_type(4)));
typedef unsigned u32x4 __attribute__((ext_vector_type(4)));
constexpr int BM = 256, BK = 64, HALF = 128, HTB = HALF * BK * 2  , STAGE_BYTES = 8 * HTB, NXCD = 8, WGM = 8;

__host__ __device__ __forceinline__ int lds_byte(int r, int c) { const int st = (r >> 4) * 2 + (c >> 5), rr = r & 15, cc = c & 31, ob = rr * 64 + cc * 2; return st * 1024 + (ob ^ (((ob >> 9) & 1) << 5)); }
__host__ __device__ __forceinline__ void stage_rc(int b, int& R, int& C) { const int st = b / 1024, sb = b % 1024, swz = sb ^ (((sb >> 9) & 1) << 5); R = (st >> 1) * 16 + swz / 64; C = (st & 1) * 32 + (swz % 64) / 2; }
__host__ __device__ __forceinline__ int perm32(int rho) { const int n = rho >> 4, i = rho & 15; return 8 * (i >> 2) + 4 * n + (i & 3); }

struct Unit { int pm, pn; };
struct Gemm { const bf16_t* A; const bf16_t* Bt; int M, N, K; };

struct StaticOrder {
    int nM, nN, nwg, G, c;
    __host__ __device__ void init(int M, int N, int G_, int c_) { nM = M / BM; nN = N / BM; nwg = nM * nN; G = G_; c = c_; }
    __host__ __device__ bool next(int i, Unit& u) const {
        const long L = (long)i * G + c; if (L >= nwg) return false;
        int wgid = (int)L; { const int q = nwg / NXCD, r = nwg % NXCD, xcd = wgid % NXCD, off = wgid / NXCD; wgid = (xcd < r ? xcd * (q + 1) : r * (q + 1) + (xcd - r) * q) + off; }
        const int nig = WGM * nN, gid = wgid / nig, fm = gid * WGM, gsz = (nM - fm) < WGM ? (nM - fm) : WGM;
        u.pm = fm + ((wgid % nig) % gsz); u.pn = (wgid % nig) / gsz; return true;
    }
    __device__ __forceinline__ void a_ready(const Unit&) const {}
    __device__ __forceinline__ void done(const Unit&) const {}
};

__device__ __forceinline__ unsigned cvt_pk_bf16(float lo, float hi) { unsigned r; asm volatile("v_cvt_pk_bf16_f32 %0, %1, %2" : "=v"(r) : "v"(lo), "v"(hi)); return r; }
__device__ __forceinline__ float relu_sq(float x) { float r; asm volatile("v_max_f32 %0, 0, %1" : "=v"(r) : "v"(x)); return r * r; }
template <int ACT  > struct EpiBf16 {
    static constexpr bool PERM = true, AFTER_DRAIN = false;
    bf16_t* O; int ldc;
    __device__ __forceinline__ void operator()(const f32x4 (&acc)[2][2][4][2], const Unit& u, int wr, int wc, int fr, int fq) const {
        const int row0 = u.pm * BM + wr * 64 + fr; const int col0 = u.pn * BM + wc * 32 + 8 * fq;
#pragma unroll
        for (int ai = 0; ai < 2; ++ai)
#pragma unroll
            for (int m = 0; m < 4; ++m) { bf16_t* rowp = O + (size_t)(row0 + ai * HALF + m * 16) * ldc + col0;
#pragma unroll
                for (int bj = 0; bj < 2; ++bj) { f32x4 v0 = acc[ai][bj][m][0], v1 = acc[ai][bj][m][1];
                    if (ACT == 1) {
#pragma unroll
                        for (int e = 0; e < 4; ++e) { v0[e] = relu_sq(v0[e]); v1[e] = relu_sq(v1[e]); } }
                    u32x4 w; w.x = cvt_pk_bf16(v0[0], v0[1]); w.y = cvt_pk_bf16(v0[2], v0[3]); w.z = cvt_pk_bf16(v1[0], v1[1]); w.w = cvt_pk_bf16(v1[2], v1[3]);
                    *(u32x4*)(rowp + bj * HALF) = w; } }
    }
};

template <class Epi, class Sched, bool ALIGN_EPI = false, bool SP2 = false>
__device__ __forceinline__ void gemm_phase(PG8_LAS unsigned char* lds, const Gemm g, const Sched& S, const Epi& E, const int tid) {
    const int wid = __builtin_amdgcn_readfirstlane(tid >> 6), lane = tid & 63, wr = wid >> 2, wc = wid & 3, fr = lane & 15, fq = lane >> 4;
    const int K = g.K, nt = K / BK;
    unsigned voffA[2], voffB[2];
#pragma unroll
    for (int i = 0; i < 2; ++i) { int R, C; stage_rc(tid * 16 + i * 8192, R, C); const int Rb = Epi::PERM ? ((R & ~31) + perm32(R & 31)) : R;
        voffA[i] = (unsigned)(R * K + C) * 2u; voffB[i] = (unsigned)(Rb * K + C) * 2u; }
    const size_t kstep = (size_t)(BK * 2);
    const size_t hstep = (size_t)HALF * K * 2;
    const size_t tstep = 2 * hstep;
    const unsigned ldsw = (unsigned)wid * 1024u;
    const int aoff = lds_byte(wr * 64 + fr, fq * 8), boff = lds_byte(wc * 32 + fr, fq * 8);
#define PG8_SA(b, h) (((b) * 2 + (h)) * HTB)
#define PG8_SB(b, h) ((4 + (b) * 2 + (h)) * HTB)
#define PG8_STAGE(bufoff, gbase, voff) do { _Pragma("unroll") for (int _i = 0; _i < 2; ++_i) \
        __builtin_amdgcn_global_load_lds((const unsigned*)((const char*)(gbase) + (voff)[_i]), (PG8_LAS unsigned*)(lds + (bufoff) + ldsw + _i * 8192), 16, 0, 0); } while (0)
#define PG8_LDA(dst, b, h) do { _Pragma("unroll") for (int m = 0; m < 4; ++m) _Pragma("unroll") for (int k = 0; k < 2; ++k) dst[m][k] = *(const PG8_LAS bf16x8*)(lds + PG8_SA(b, h) + aoff + m * 2048 + k * 1024); } while (0)
#define PG8_LDB(dst, b, h) do { _Pragma("unroll") for (int n = 0; n < 2; ++n) _Pragma("unroll") for (int k = 0; k < 2; ++k) dst[n][k] = *(const PG8_LAS bf16x8*)(lds + PG8_SB(b, h) + boff + n * 2048 + k * 1024); } while (0)
#define PG8_MMA(ai, bj, At, Bt) do { __builtin_amdgcn_s_setprio(1); _Pragma("unroll") for (int m = 0; m < 4; ++m) _Pragma("unroll") for (int n = 0; n < 2; ++n) _Pragma("unroll") for (int k = 0; k < 2; ++k) \
        acc[ai][bj][m][n] = __builtin_amdgcn_mfma_f32_16x16x32_bf16(Bt[n][k], At[m][k], acc[ai][bj][m][n], 0, 0, 0); __builtin_amdgcn_s_setprio(0); } while (0)
#define PG8_WAIT_V(n) asm volatile("s_waitcnt vmcnt(" #n ")" ::: "memory")
#define PG8_WAIT_L(n) asm volatile("s_waitcnt lgkmcnt(" #n ")" ::: "memory")
#define PG8_BAR __builtin_amdgcn_s_barrier()
#define PG8_SCHED __builtin_amdgcn_sched_barrier(0)
    Unit cur, nxt; int ui = 0;
    if (!S.next(0, cur)) return;
    f32x4 acc[2][2][4][2];
#pragma unroll
    for (int a = 0; a < 2; ++a)
#pragma unroll
        for (int b = 0; b < 2; ++b)
#pragma unroll
            for (int m = 0; m < 4; ++m)
#pragma unroll
                for (int n = 0; n < 2; ++n) acc[a][b][m][n] = (f32x4){0.f, 0.f, 0.f, 0.f};
    bf16x8 At[4][2], B0[2][2], B1[2][2];
    const char* cA = (const char*)g.A + (size_t)cur.pm * tstep; const char* cB = (const char*)g.Bt + (size_t)cur.pn * tstep;
    S.a_ready(cur);
    if constexpr (SP2) {
        PG8_STAGE(PG8_SB(0, 0), cB, voffB); PG8_STAGE(PG8_SB(0, 1), cB + hstep, voffB); PG8_STAGE(PG8_SA(0, 0), cA, voffA); PG8_STAGE(PG8_SA(0, 1), cA + hstep, voffA);
        if (wr == 1) PG8_BAR;
        PG8_WAIT_V(2); PG8_BAR;
        PG8_STAGE(PG8_SB(1, 0), cB + kstep, voffB); PG8_STAGE(PG8_SA(1, 0), cA + kstep, voffA); PG8_STAGE(PG8_SB(1, 1), cB + hstep + kstep, voffB);
        PG8_WAIT_V(6); PG8_BAR;
    } else {
        PG8_STAGE(PG8_SB(0, 0), cB, voffB); PG8_STAGE(PG8_SA(0, 0), cA, voffA); PG8_STAGE(PG8_SB(0, 1), cB + hstep, voffB); PG8_STAGE(PG8_SA(0, 1), cA + hstep, voffA);
        if (wr == 1) PG8_BAR;
        PG8_WAIT_V(4); PG8_BAR;
        PG8_STAGE(PG8_SB(1, 0), cB + kstep, voffB); PG8_STAGE(PG8_SA(1, 0), cA + kstep, voffA); PG8_STAGE(PG8_SB(1, 1), cB + hstep + kstep, voffB);
        PG8_WAIT_V(6); PG8_BAR;
    }
    for (;;) {
        const bool has_next = S.next(ui + 1, nxt);
        const char* nA = has_next ? (const char*)g.A + (size_t)nxt.pm * tstep : cA; const char* nB = has_next ? (const char*)g.Bt + (size_t)nxt.pn * tstep : cB;
        for (int t = 0; t < nt; t += 2) {
            const bool last = (t == nt - 2);
            const char* a1 = cA + (size_t)(t + 1) * kstep;
            const char* a2 = last ? nA : cA + (size_t)(t + 2) * kstep; const char* b2 = last ? nB : cB + (size_t)(t + 2) * kstep;
            const char* a3 = a2 + kstep; const char* b3 = b2 + kstep;
            if (last && has_next) S.a_ready(nxt);
            if constexpr (SP2) {
            PG8_LDB(B0, 0, 0); PG8_LDB(B1, 0, 1); PG8_SCHED; PG8_LDA(At, 0, 0); PG8_STAGE(PG8_SA(1, 1), a1 + hstep, voffA);
            PG8_WAIT_V(8); PG8_WAIT_L(0); PG8_BAR; PG8_MMA(0, 0, At, B0); PG8_MMA(0, 1, At, B1); PG8_BAR; PG8_SCHED;
            PG8_LDA(At, 0, 1); PG8_STAGE(PG8_SB(0, 0), b2, voffB); PG8_STAGE(PG8_SB(0, 1), b2 + hstep, voffB); PG8_STAGE(PG8_SA(0, 0), a2, voffA);
            PG8_WAIT_V(8); PG8_WAIT_L(0); PG8_BAR; PG8_MMA(1, 0, At, B0); PG8_MMA(1, 1, At, B1); PG8_BAR; PG8_SCHED;
            PG8_LDB(B0, 1, 0); PG8_LDB(B1, 1, 1); PG8_SCHED; PG8_LDA(At, 1, 0); PG8_STAGE(PG8_SA(0, 1), a2 + hstep, voffA);
            PG8_WAIT_V(8); PG8_WAIT_L(0); PG8_BAR; PG8_MMA(0, 0, At, B0); PG8_MMA(0, 1, At, B1); PG8_BAR; PG8_SCHED;
            PG8_LDA(At, 1, 1); PG8_STAGE(PG8_SB(1, 0), b3, voffB); PG8_STAGE(PG8_SB(1, 1), b3 + hstep, voffB); PG8_STAGE(PG8_SA(1, 0), a3, voffA);
            PG8_WAIT_V(8); PG8_WAIT_L(0); PG8_BAR; PG8_MMA(1, 0, At, B0); PG8_MMA(1, 1, At, B1); PG8_BAR; PG8_SCHED;
            } else {
            PG8_LDB(B0, 0, 0); PG8_SCHED; PG8_LDA(At, 0, 0); PG8_STAGE(PG8_SA(1, 1), a1 + hstep, voffA);
            PG8_WAIT_L(8); PG8_BAR; PG8_WAIT_L(0); PG8_MMA(0, 0, At, B0); PG8_BAR; PG8_SCHED;
            PG8_LDB(B1, 0, 1); PG8_STAGE(PG8_SB(0, 0), b2, voffB);
            PG8_BAR; PG8_WAIT_L(0); PG8_MMA(0, 1, At, B1); PG8_BAR;
            PG8_LDA(At, 0, 1); PG8_STAGE(PG8_SA(0, 0), a2, voffA);
            PG8_BAR; PG8_WAIT_L(0); PG8_MMA(1, 0, At, B0); PG8_BAR; PG8_SCHED;
            PG8_STAGE(PG8_SB(0, 1), b2 + hstep, voffB);
            PG8_WAIT_V(6); PG8_BAR; PG8_MMA(1, 1, At, B1); PG8_BAR;
            PG8_LDB(B0, 1, 0); PG8_SCHED; PG8_LDA(At, 1, 0); PG8_STAGE(PG8_SA(0, 1), a2 + hstep, voffA);
            PG8_WAIT_L(8); PG8_BAR; PG8_WAIT_L(0); PG8_MMA(0, 0, At, B0); PG8_BAR; PG8_SCHED;
            PG8_LDB(B1, 1, 1); PG8_STAGE(PG8_SB(1, 0), b3, voffB);
            PG8_BAR; PG8_WAIT_L(0); PG8_MMA(0, 1, At, B1); PG8_BAR;
            PG8_LDA(At, 1, 1); PG8_STAGE(PG8_SA(1, 0), a3, voffA);
            PG8_BAR; PG8_WAIT_L(0); PG8_MMA(1, 0, At, B0); PG8_BAR; PG8_SCHED;
            PG8_STAGE(PG8_SB(1, 1), b3 + hstep, voffB);
            PG8_WAIT_V(6); PG8_BAR; PG8_MMA(1, 1, At, B1); PG8_BAR;
            }
        }
        if constexpr (ALIGN_EPI) { if (wr == 0) PG8_BAR; }
        if constexpr (!Epi::AFTER_DRAIN) { E(acc, cur, wr, wc, fr, fq); S.done(cur); }
        if (!has_next) break;
#pragma unroll
        for (int a = 0; a < 2; ++a)
#pragma unroll
            for (int b = 0; b < 2; ++b)
#pragma unroll
                for (int m = 0; m < 4; ++m)
#pragma unroll
                    for (int n = 0; n < 2; ++n) acc[a][b][m][n] = (f32x4){0.f, 0.f, 0.f, 0.f};
        cur = nxt; cA = nA; cB = nB; ++ui;
        if constexpr (ALIGN_EPI) { if (wr == 1) PG8_BAR; }
    }
    PG8_WAIT_V(0);
    if constexpr (!ALIGN_EPI) { if (wr == 0) PG8_BAR; }
    PG8_BAR;
    if constexpr (Epi::AFTER_DRAIN) { E.fused(acc, cur, wr, wc, fr, fq, lds, wid, lane); S.done(cur); }
#undef PG8_SA
#undef PG8_SB
#undef PG8_STAGE
#undef PG8_LDA
#undef PG8_LDB
#undef PG8_MMA
#undef PG8_WAIT_V
#undef PG8_WAIT_L
#undef PG8_BAR
#undef PG8_SCHED
}
}

namespace cg = cooperative_groups;
#define LAS __attribute__((address_space(3)))
typedef unsigned short bf16;
typedef unsigned v4u __attribute__((ext_vector_type(4)));
typedef unsigned v2u __attribute__((ext_vector_type(2)));
typedef float f32x4 __attribute__((ext_vector_type(4)));
typedef short bf16x8 __attribute__((ext_vector_type(8)));

constexpr int NWAVES = 8;
constexpr int DM = 1024, FF = 4096, INW = 2048, GW = 256;
constexpr int MP = 16384, MS = 512, MT = MP + MS;
constexpr int SEQ = 2048, NBP = 8, NSB = 128, ST = 4, DEPTH = 2;
constexpr float EPS = 1e-6f;
constexpr size_t MiB = 1u << 20;
constexpr size_t WS_SGUW = 1 * MiB;
constexpr size_t WS_W = 2 * MiB, W_LAYER = 22 * MiB, W_IN = 0, W_OUT = 4 * MiB, W_UP = 6 * MiB, W_DN = 14 * MiB;
constexpr size_t WS_XN = 46 * MiB, WS_O = 79 * MiB, WS_H = 112 * MiB, WS_Z = 112 * MiB, WS_CAT = 178 * MiB, WS_END = 244 * MiB;
constexpr int LDS_BYTES = 147456;
constexpr int WAVE_SCR = 17408;
constexpr size_t OUT_Y = 0;
constexpr size_t OUT_POOL_P = (size_t)MT * DM;
constexpr size_t OUT_POOL_S = OUT_POOL_P + (size_t)DEPTH * NBP * 15 * GW;
constexpr size_t OUT_CONV_P = OUT_POOL_S + (size_t)DEPTH * NSB * 15 * GW;
constexpr size_t OUT_CONV_S = OUT_CONV_P + (size_t)DEPTH * NBP * 30 * GW;
constexpr size_t OUT_SHORT_P = OUT_CONV_S + (size_t)DEPTH * NSB * 30 * GW;
constexpr size_t OUT_SHORT_S = OUT_SHORT_P + (size_t)DEPTH * NBP * 2 * GW;
constexpr size_t OUT_V_S = OUT_SHORT_S + (size_t)DEPTH * NSB * 2 * GW;
constexpr size_t OUT_END = OUT_V_S + (size_t)DEPTH * NSB * ST * GW;

__device__ __forceinline__ float bf2f(bf16 b) { return __uint_as_float(((unsigned)b) << 16); }
__device__ __forceinline__ unsigned f2bf(float f) { unsigned u = __float_as_uint(f); return (u + 0x7fffu + ((u >> 16) & 1u)) >> 16; }
__device__ __forceinline__ unsigned pk2(float lo, float hi) { return f2bf(lo) | (f2bf(hi) << 16); }
__device__ __forceinline__ float wave_sum(float v) {
#pragma unroll
    for (int o = 1; o < 64; o <<= 1) v += __shfl_xor(v, o);
    return v;
}
__device__ __forceinline__ float sigm(float x) { return 1.f / (1.f + __expf(-x)); }
#define LDS_WAIT() asm volatile("s_waitcnt lgkmcnt(0)" ::: "memory")

__device__ __forceinline__ void transpose_item(const float* __restrict__ W, int K, int N, bf16* __restrict__ WT, const float* __restrict__ gk, LAS float* scr, int item, int lane) {
    const int nblk = N / 32, kb = item / nblk, nb = item % nblk, k0 = 64 * kb, n0 = 32 * nb;
#pragma unroll 8
    for (int i = 0; i < 32; ++i) { const int kk = 2 * i + (lane >> 5); float v = W[(size_t)(k0 + kk) * N + n0 + (lane & 31)]; if (gk) v *= gk[k0 + kk]; scr[kk * 33 + (lane & 31)] = v; }
    LDS_WAIT();
    const int c = lane & 7;
#pragma unroll
    for (int j = 0; j < 4; ++j) { const int n = (lane >> 3) + 8 * j; const LAS float* s = scr + (8 * c) * 33 + n;
        v4u o; o.x = pk2(s[0 * 33], s[1 * 33]); o.y = pk2(s[2 * 33], s[3 * 33]); o.z = pk2(s[4 * 33], s[5 * 33]); o.w = pk2(s[6 * 33], s[7 * 33]);
        *(v4u*)(WT + (size_t)(n0 + n) * K + k0 + 8 * c) = o; }
    LDS_WAIT();
}
__device__ __forceinline__ void fold_item(const float* __restrict__ W, bf16* __restrict__ WT, const float* __restrict__ wp, const float* __restrict__ ps, LAS float* scr, int item, int lane) {
    const int K = DM, N = DM; const int nblk = N / 32, g = item / nblk, nb = item % nblk, k0 = 64 * g, n0 = 32 * nb;
    LAS float* scr2 = scr + 64 * 33;
#pragma unroll 8
    for (int i = 0; i < 32; ++i) { const int kk = 2 * i + (lane >> 5); scr[kk * 33 + (lane & 31)] = W[(size_t)(k0 + kk) * N + n0 + (lane & 31)] * ps[k0 + kk]; }
    LDS_WAIT();
    const int n = lane & 31;
    for (int i = 0; i < 32; ++i) { const int kk = 2 * i + (lane >> 5); const float* wr = wp + (size_t)(g * 64 + kk) * 64; float a = 0.f;
#pragma unroll 16
        for (int d = 0; d < 64; ++d) a += wr[d] * scr[d * 33 + n];
        scr2[kk * 33 + n] = a; }
    LDS_WAIT();
    const int c = lane & 7;
#pragma unroll
    for (int j = 0; j < 4; ++j) { const int nn = (lane >> 3) + 8 * j; const LAS float* s = scr2 + (8 * c) * 33 + nn;
        v4u o; o.x = pk2(s[0 * 33], s[1 * 33]); o.y = pk2(s[2 * 33], s[3 * 33]); o.z = pk2(s[4 * 33], s[5 * 33]); o.w = pk2(s[6 * 33], s[7 * 33]);
        *(v4u*)(WT + (size_t)(n0 + nn) * K + k0 + 8 * c) = o; }
    LDS_WAIT();
}
__device__ __forceinline__ void rms_row_to_bf16(const float* __restrict__ xrow, bf16* __restrict__ orow, int lane) {
    const f32x4* xr = (const f32x4*)xrow + lane;
    f32x4 v[4]; float s = 0.f;
#pragma unroll
    for (int j = 0; j < 4; ++j) { v[j] = xr[64 * j]; s += (v[j].x * v[j].x + v[j].y * v[j].y) + (v[j].z * v[j].z + v[j].w * v[j].w); }
    const float rstd = rsqrtf(wave_sum(s) * (1.f / DM) + EPS);
    v2u* o8 = (v2u*)orow + lane;
#pragma unroll
    for (int j = 0; j < 4; ++j) { v2u o; o.x = pk2(v[j].x * rstd, v[j].y * rstd); o.y = pk2(v[j].z * rstd, v[j].w * rstd); o8[64 * j] = o; }
}
__device__ __forceinline__ void ew_row(const float* __restrict__ xrow, const bf16* __restrict__ orow, const float* __restrict__ g, float* __restrict__ Xrow, bf16* __restrict__ xnrow, bool write_xn, int lane) {
    const f32x4* xr = (const f32x4*)xrow + lane; const v2u* orr = (const v2u*)orow + lane; const f32x4* gr = (const f32x4*)g + lane;
    f32x4 x[4], o[4]; float so = 0.f;
#pragma unroll
    for (int j = 0; j < 4; ++j) { x[j] = xr[64 * j]; const v2u w = orr[64 * j];
        o[j].x = __uint_as_float(w.x << 16); o[j].y = __uint_as_float(w.x & 0xffff0000u); o[j].z = __uint_as_float(w.y << 16); o[j].w = __uint_as_float(w.y & 0xffff0000u);
        so += (o[j].x * o[j].x + o[j].y * o[j].y) + (o[j].z * o[j].z + o[j].w * o[j].w); }
    const float rs = rsqrtf(wave_sum(so) * (1.f / DM) + EPS); float s1 = 0.f;
    f32x4* Xr = (f32x4*)Xrow + lane;
#pragma unroll
    for (int j = 0; j < 4; ++j) { const f32x4 gg = gr[64 * j]; x[j] = x[j] + o[j] * rs * gg; s1 += (x[j].x * x[j].x + x[j].y * x[j].y) + (x[j].z * x[j].z + x[j].w * x[j].w); Xr[64 * j] = x[j]; }
    if (write_xn) { const float r1 = rsqrtf(wave_sum(s1) * (1.f / DM) + EPS); v2u* o8 = (v2u*)xnrow + lane;
#pragma unroll
        for (int j = 0; j < 4; ++j) { v2u w; w.x = pk2(x[j].x * r1, x[j].y * r1); w.y = pk2(x[j].z * r1, x[j].w * r1); o8[64 * j] = w; } }
}

template <bool SAMPLE>
__device__ __forceinline__ void pool_unit(const bf16* __restrict__ Z, bf16* __restrict__ CAT, const float* __restrict__ state, float* __restrict__ newp,
                                          int seq, int t0, int nrows, int g, int lane) {
    const int c = g * 64 + lane, w = 2 << g;
    const size_t rowbase = SAMPLE ? (size_t)MP + (size_t)seq * ST : (size_t)seq * SEQ;
    const bf16* zc = Z + rowbase * INW + c;
    const float* st = state + (size_t)seq * 15 * GW + c;
#define POOL_A(e) ((e) >= 0 ? bf2f(zc[(size_t)(e) * INW]) : (SAMPLE ? st[(15 + (e)) * GW] : 0.f))
    float S = 0.f;
    for (int j = 1; j < w; ++j) S += POOL_A(t0 - j);
#pragma unroll 4
    for (int t = t0; t < t0 + nrows; ++t) {
        const float a = POOL_A(t); S += a;
        const float cnt = SAMPLE ? (float)w : (float)(t + 1 < w ? t + 1 : w);
        CAT[(rowbase + t) * DM + c] = (bf16)f2bf(S / cnt - a);
        const int e = t - w + 1; S -= POOL_A(e);
    }
    const int T = SAMPLE ? ST : SEQ;
    if (t0 + nrows == T) {
        for (int j = 0; j < 15; ++j) { const int e = T - 15 + j; newp[((size_t)seq * 15 + j) * GW + c] = POOL_A(e); }
    }
#undef POOL_A
}
template <bool SAMPLE>
__device__ __forceinline__ void short_unit(const bf16* __restrict__ Z, bf16* __restrict__ CAT, const float* __restrict__ state, float* __restrict__ news,
                                           const float* __restrict__ sw, int seq, int t0, int nrows, int h, int lane) {
    const int c = h * 64 + lane;
    const size_t rowbase = SAMPLE ? (size_t)MP + (size_t)seq * ST : (size_t)seq * SEQ;
    const bf16* zc = Z + rowbase * INW + c;
    const float* st = state + (size_t)seq * 2 * GW + c;
    const float w0 = sw[c], w1 = sw[GW + c], w2 = sw[2 * GW + c];
#define SH_E(e) ((e) >= 0 ? bf2f(zc[(size_t)(e) * INW + 1536]) * bf2f(zc[(size_t)(e) * INW + 1792]) : (SAMPLE ? st[(2 + (e)) * GW] : 0.f))
    float e2 = SH_E(t0 - 2), e1 = SH_E(t0 - 1);
#pragma unroll 4
    for (int t = t0; t < t0 + nrows; ++t) {
        const float e0 = SH_E(t); const float bg = bf2f(zc[(size_t)t * INW + 1280]);
        CAT[(rowbase + t) * DM + 768 + c] = (bf16)f2bf(bg * (w0 * e2 + w1 * e1 + w2 * e0));
        e2 = e1; e1 = e0;
    }
    const int T = SAMPLE ? ST : SEQ;
    if (t0 + nrows == T) { news[((size_t)seq * 2 + 0) * GW + c] = e2; news[((size_t)seq * 2 + 1) * GW + c] = e1; }
#undef SH_E
}
template <bool SAMPLE>
__device__ __forceinline__ void conv_unit(const bf16* __restrict__ Z, bf16* __restrict__ CAT, const float* __restrict__ state, float* __restrict__ newc,
                                          const float* __restrict__ cw, const float* __restrict__ cb, const float* __restrict__ lg, const float* __restrict__ lb,
                                          int seq, int t0, int nrows, int h, LAS float* gL, int lane) {
    const int c = h * 64 + lane;
    const size_t rowbase = SAMPLE ? (size_t)MP + (size_t)seq * ST : (size_t)seq * SEQ;
    const bf16* zc = Z + rowbase * INW + c;
    bf16* oc = CAT + rowbase * DM + 256 + c;
    const int T = SAMPLE ? ST : SEQ;
    const bool last = (t0 + nrows == T);
    const int nin = nrows + 30;
#pragma unroll 4
    for (int r = 0; r < nin; ++r) { const int s = t0 - 30 + r; float gs = 0.f;
        if (s >= 0) { const unsigned off = (unsigned)s * INW; const float p = bf2f(zc[off + 256]), gt = bf2f(zc[off + 512]); gs = p * sigm(gt); }
        else if (SAMPLE) gs = state[((size_t)seq * 30 + 30 + s) * GW + c];
        if (last && s >= T - 30) newc[((size_t)seq * 30 + (s - (T - 30))) * GW + c] = gs;
        gL[r * 64 + lane] = gs; }
    LDS_WAIT();
    float wk[31];
#pragma unroll
    for (int k = 0; k < 31; ++k) wk[k] = cw[k * GW + c];
    const float bias = cb[c], gg = lg[c], bb = lb[c];
#pragma unroll 1
    for (int tq = 0; tq < nrows; tq += 4) {
        float acc[4] = {bias, bias, bias, bias};
#pragma unroll
        for (int r = 0; r < 34; ++r) { const float gv = gL[(tq + r) * 64 + lane];
#pragma unroll
            for (int q = 0; q < 4; ++q) { const int k = r - q; if (k >= 0 && k <= 30) acc[q] += wk[k] * gv; } }
#pragma unroll
        for (int q = 0; q < 4; ++q) { const float cv = acc[q];
            const float mean = wave_sum(cv) * (1.f / 64.f); const float d = cv - mean;
            const float var = wave_sum(d * d) * (1.f / 64.f);
            const float y = d * rsqrtf(var + EPS) * gg + bb;
            oc[(unsigned)(t0 + tq + q) * DM] = (bf16)f2bf(y * sigm(y)); }
    }
    LDS_WAIT();
}
__device__ __forceinline__ void sgu_unit(const bf16* __restrict__ Z, bf16* __restrict__ CAT, const bf16* __restrict__ Wb, const float* __restrict__ lg, const float* __restrict__ lb,
                                         const float* __restrict__ sb, int chunk, int h, LAS bf16* vT, int lane) {
    const size_t r0 = (size_t)chunk * 128;
    const int c = h * 64 + lane;
    const float gg = lg[c], bb = lb[c];
#pragma unroll 1
    for (int s = 0; s < 128; s += 4) {
        float v[4];
#pragma unroll
        for (int i = 0; i < 4; ++i) v[i] = bf2f(Z[(r0 + s + i) * INW + 1024 + c]);
#pragma unroll
        for (int i = 0; i < 4; ++i) { const float mean = wave_sum(v[i]) * (1.f / 64.f); const float d = v[i] - mean; const float var = wave_sum(d * d) * (1.f / 64.f); v[i] = d * rsqrtf(var + EPS) * gg + bb; }
        v2u w; w.x = pk2(v[0], v[1]); w.y = pk2(v[2], v[3]);
        *(LAS v2u*)(vT + lane * 136 + s) = w;
    }
    LDS_WAIT();
    const int fr = lane & 15, fq = lane >> 4;
#pragma unroll 1
    for (int mt = 0; mt < 8; ++mt) {
        f32x4 acc[4];
#pragma unroll
        for (int nt = 0; nt < 4; ++nt) acc[nt] = (f32x4){0.f, 0.f, 0.f, 0.f};
        const int nks = (mt * 16 + 15) / 32 + 1;
#pragma unroll 1
        for (int ks = 0; ks < nks; ++ks) {
            const bf16x8 a = *(const bf16x8*)(Wb + ((size_t)(h * 128 + mt * 16 + fr) * 128 + ks * 32 + fq * 8));
#pragma unroll
            for (int nt = 0; nt < 4; ++nt) { const bf16x8 b = *(const LAS bf16x8*)(vT + (nt * 16 + fr) * 136 + ks * 32 + fq * 8);
                acc[nt] = __builtin_amdgcn_mfma_f32_16x16x32_bf16(a, b, acc[nt], 0, 0, 0); }
        }
#pragma unroll
        for (int nt = 0; nt < 4; ++nt)
#pragma unroll
            for (int i = 0; i < 4; ++i) { const int t = mt * 16 + fq * 4 + i, cc = h * 64 + nt * 16 + fr;
                const float sv = acc[nt][i] + sb[h * 128 + t]; const float u = bf2f(Z[(r0 + t) * INW + 768 + cc]);
                CAT[(r0 + t) * DM + 512 + cc] = (bf16)f2bf(u * sv); }
    }
    LDS_WAIT();
}
__device__ __forceinline__ void sgu_sample_unit(const bf16* __restrict__ Z, bf16* __restrict__ CAT, const float* __restrict__ Wf, const float* __restrict__ lg, const float* __restrict__ lb,
                                                const float* __restrict__ sb, float* __restrict__ vout, int seq, int h, int lane) {
    const int c = h * 64 + lane; const size_t rowbase = (size_t)MP + (size_t)seq * ST;
    const float gg = lg[c], bb = lb[c];
    float vn[ST];
#pragma unroll
    for (int t = 0; t < ST; ++t) { const float v = bf2f(Z[(rowbase + t) * INW + 1024 + c]); const float mean = wave_sum(v) * (1.f / 64.f); const float d = v - mean; const float var = wave_sum(d * d) * (1.f / 64.f);
        vn[t] = d * rsqrtf(var + EPS) * gg + bb; vout[((size_t)seq * ST + t) * GW + c] = vn[t]; }
#pragma unroll
    for (int t = 0; t < ST; ++t) { float sv = sb[h * 128 + t];
#pragma unroll
        for (int s = 0; s <= t; ++s) sv += Wf[((size_t)h * 128 + t) * 128 + s] * vn[s];
        const float u = bf2f(Z[(rowbase + t) * INW + 768 + c]);
        CAT[(rowbase + t) * DM + 512 + c] = (bf16)f2bf(u * sv); }
}

constexpr int NPH = 15;
struct Args { const float* in[24]; float* out; unsigned char* ws; int ph_lo, ph_hi; };
__global__ void __launch_bounds__(NWAVES * 64, 2) hybrid_fwd(Args args) {
    extern __shared__ __attribute__((aligned(16))) unsigned char lds_raw[];
    LAS unsigned char* lds = (LAS unsigned char*)lds_raw;
    for (int ph = args.ph_lo; ph < args.ph_hi; ++ph) {
        int tid = threadIdx.x; asm volatile("" : "+v"(tid));
        const int lane = tid & 63, wave = __builtin_amdgcn_readfirstlane(tid >> 6);
        const int G = gridDim.x; const int bx = blockIdx.x;
        unsigned char* ws = args.ws;
        if (ph == 0) {
            const int vcu = (G % 8 == 0) ? (bx % 8) * (G / 8) + bx / 8 : bx; const int gw = vcu * NWAVES + wave, NGW = G * NWAVES;
            LAS float* scr = (LAS float*)(lds + wave * WAVE_SCR);
            bf16* XN = (bf16*)(ws + WS_XN); bf16* SGW = (bf16*)(ws + WS_SGUW);
            constexpr int I_IN = (DM / 64) * (INW / 32), I_OUT = (DM / 64) * (DM / 32), I_UP = (DM / 64) * (FF / 32), I_DN = (FF / 64) * (DM / 32);
            constexpr int I_LAYER = I_IN + I_OUT + I_UP + I_DN;
            for (int it = gw; it < DEPTH * I_LAYER; it += NGW) {
                const int l = it / I_LAYER; int r = it % I_LAYER;
                unsigned char* wl = ws + WS_W + (size_t)l * W_LAYER;
                if (r < I_OUT) {
                    const float* W = args.in[10] + (size_t)l * DM * DM;
                    if (r < 4 * (DM / 32)) fold_item(W, (bf16*)(wl + W_OUT), args.in[11] + (size_t)l * 4 * 64 * 64, args.in[12] + (size_t)l * GW, scr, r, lane);
                    else transpose_item(W, DM, DM, (bf16*)(wl + W_OUT), nullptr, scr, r, lane);
                    continue; }
                r -= I_OUT;
                if (r < I_IN) { transpose_item(args.in[9] + (size_t)l * DM * INW, DM, INW, (bf16*)(wl + W_IN), args.in[5] + (size_t)l * DM, scr, r, lane); continue; }
                r -= I_IN;
                if (r < I_UP) { transpose_item(args.in[22] + (size_t)l * DM * FF, DM, FF, (bf16*)(wl + W_UP), args.in[7] + (size_t)l * DM, scr, r, lane); continue; }
                r -= I_UP;
                transpose_item(args.in[23] + (size_t)l * FF * DM, FF, DM, (bf16*)(wl + W_DN), nullptr, scr, r, lane);
            }
            for (int m = gw; m < MT; m += NGW) rms_row_to_bf16(m < MP ? args.in[0] + (size_t)m * DM : args.in[1] + (size_t)(m - MP) * DM, XN + (size_t)m * DM, lane);
            for (int e = bx * (NWAVES * 64) + tid; e < DEPTH * 4 * 128 * 128; e += G * NWAVES * 64) { const int t = (e >> 7) & 127, s = e & 127; SGW[e] = (bf16)(s <= t ? f2bf(args.in[19][e]) : 0u); }
        } else {
            const int l = (ph - 1) / 7, k = (ph - 1) - 7 * l;
            unsigned char* wl = ws + WS_W + (size_t)l * W_LAYER;
            if (k == 0 || k == 2 || k == 5) {
                const bf16* A = (const bf16*)(ws + (k == 0 ? WS_XN : k == 2 ? WS_CAT : WS_H));
                const bf16* Bt = (const bf16*)(wl + (k == 0 ? W_IN : k == 2 ? W_OUT : W_DN));
                bf16* O = (bf16*)(ws + (k == 0 ? WS_Z : WS_O));
                const int N = k == 0 ? INW : DM, K = k == 5 ? FF : DM;
                pg8::Gemm g{A, Bt, MT, N, K}; pg8::StaticOrder S; S.init(MT, N, G, bx);
                pg8::EpiBf16<0> E{O, N};
                pg8::gemm_phase<pg8::EpiBf16<0>, pg8::StaticOrder, true, true>(lds, g, S, E, tid);
            } else if (k == 4) {
                pg8::Gemm g{(const bf16*)(ws + WS_XN), (const bf16*)(wl + W_UP), MT, FF, DM}; pg8::StaticOrder S; S.init(MT, FF, G, bx);
                pg8::EpiBf16<1> E{(bf16*)(ws + WS_H), FF};
                pg8::gemm_phase<pg8::EpiBf16<1>, pg8::StaticOrder, true, true>(lds, g, S, E, tid);
            } else if (k == 1) {
                const int vcu = (G % 8 == 0) ? (bx % 8) * (G / 8) + bx / 8 : bx; const int gw = vcu * NWAVES + wave, NGW = G * NWAVES;
                LAS float* scr = (LAS float*)(lds + wave * WAVE_SCR);
                const bf16* ZB = (const bf16*)(ws + WS_Z); bf16* CAT = (bf16*)(ws + WS_CAT); const bf16* SGW = (const bf16*)(ws + WS_SGUW) + (size_t)l * 4 * 128 * 128;
                float* out = args.out;
                constexpr int NU_SGU = 512, NU_CONV = 2048, NU_SEG = 1024, NU_SMP = 2048, NU = NU_SGU + NU_CONV + 2 * NU_SEG + NU_SMP;
#pragma unroll 1
                for (int u = gw; u < NU; u += NGW) {
                    int lane = tid & 63; asm volatile("" : "+v"(lane));
                    if (u < NU_SGU) { sgu_unit(ZB, CAT, SGW, args.in[17] + (size_t)l * GW, args.in[18] + (size_t)l * GW, args.in[20] + (size_t)l * 4 * 128, u >> 2, u & 3, (LAS bf16*)scr, lane); continue; }
                    int r = u - NU_SGU;
                    if (r < NU_CONV) { const int seg = r >> 2, h = r & 3, seq = seg >> 6, t0 = (seg & 63) * 32;
                        conv_unit<false>(ZB, CAT, nullptr, out + OUT_CONV_P + (size_t)l * NBP * 30 * GW, args.in[13] + (size_t)l * 31 * GW, args.in[14] + (size_t)l * GW, args.in[15] + (size_t)l * GW, args.in[16] + (size_t)l * GW, seq, t0, 32, h, scr, lane);
                        continue; }
                    r -= NU_CONV;
                    if (r < 2 * NU_SEG) { const int ty = r / NU_SEG, q = r % NU_SEG, seg = q >> 2, h = q & 3, seq = seg >> 5, t0 = (seg & 31) * 64;
                        if (ty == 0) pool_unit<false>(ZB, CAT, nullptr, out + OUT_POOL_P + (size_t)l * NBP * 15 * GW, seq, t0, 64, h, lane);
                        else short_unit<false>(ZB, CAT, nullptr, out + OUT_SHORT_P + (size_t)l * NBP * 2 * GW, args.in[21] + (size_t)l * 3 * GW, seq, t0, 64, h, lane);
                        continue; }
                    r -= 2 * NU_SEG;
                    { const int ty = r >> 9, q = r & 511, seq = q >> 2, h = q & 3;
                        if (ty == 0) conv_unit<true>(ZB, CAT, args.in[3] + (size_t)l * NSB * 30 * GW, out + OUT_CONV_S + (size_t)l * NSB * 30 * GW, args.in[13] + (size_t)l * 31 * GW, args.in[14] + (size_t)l * GW, args.in[15] + (size_t)l * GW, args.in[16] + (size_t)l * GW, seq, 0, ST, h, scr, lane);
                        else if (ty == 1) pool_unit<true>(ZB, CAT, args.in[2] + (size_t)l * NSB * 15 * GW, out + OUT_POOL_S + (size_t)l * NSB * 15 * GW, seq, 0, ST, h, lane);
                        else if (ty == 2) short_unit<true>(ZB, CAT, args.in[4] + (size_t)l * NSB * 2 * GW, out + OUT_SHORT_S + (size_t)l * NSB * 2 * GW, args.in[21] + (size_t)l * 3 * GW, seq, 0, ST, h, lane);
                        else sgu_sample_unit(ZB, CAT, args.in[19] + (size_t)l * 4 * 128 * 128, args.in[17] + (size_t)l * GW, args.in[18] + (size_t)l * GW, args.in[20] + (size_t)l * 4 * 128, out + OUT_V_S + (size_t)l * NSB * ST * GW, seq, h, lane); }
                }
            } else {
                const int vcu = (G % 8 == 0) ? (bx % 8) * (G / 8) + bx / 8 : bx; const int gw = vcu * NWAVES + wave, NGW = G * NWAVES;
                const float* g = args.in[k == 3 ? 6 : 8] + (size_t)l * DM;
                float* X = args.out; const bf16* OB = (const bf16*)(ws + WS_O); bf16* XN = (bf16*)(ws + WS_XN);
                const bool from_input = (l == 0 && k == 3), write_xn = !(l == DEPTH - 1 && k == 6);
                for (int m = gw; m < MT; m += NGW) {
                    const float* xr = from_input ? (m < MP ? args.in[0] + (size_t)m * DM : args.in[1] + (size_t)(m - MP) * DM) : X + (size_t)m * DM;
                    ew_row(xr, OB + (size_t)m * DM, g, X + (size_t)m * DM, XN + (size_t)m * DM, write_xn, lane); }
            }
        }
        if (ph + 1 < args.ph_hi) cg::this_grid().sync();
    }
}

#ifndef MK_N_LAUNCHES
#define MK_N_LAUNCHES 1
#endif
extern "C" void kernel_launch(void* const* d_in, const int* in_sizes, int n_in, void* d_out, int out_size, void* d_ws, size_t ws_size, hipStream_t stream) {
    static int grid = 0;
    if (grid == 0) {
        if (n_in != 24 || (size_t)out_size != OUT_END || ws_size < WS_END) { fprintf(stderr, "kernel_launch: unexpected shapes (n_in %d out %d ws %zu)\n", n_in, out_size, ws_size); grid = -1; return; }
        int dev = 0, cus = 0, per_cu = 0;
        if (hipGetDevice(&dev) != hipSuccess || hipDeviceGetAttribute(&cus, hipDeviceAttributeMultiprocessorCount, dev) != hipSuccess) { grid = -1; return; }
        if (hipFuncSetAttribute((const void*)hybrid_fwd, hipFuncAttributeMaxDynamicSharedMemorySize, LDS_BYTES) != hipSuccess) { fprintf(stderr, "kernel_launch: hipFuncSetAttribute failed\n"); grid = -1; return; }
        if (hipOccupancyMaxActiveBlocksPerMultiprocessor(&per_cu, (const void*)hybrid_fwd, NWAVES * 64, LDS_BYTES) != hipSuccess || per_cu < 1) per_cu = 1;
        (void)hipGetLastError();
        grid = cus * per_cu;
    }
    if (grid < 0) return;
    Args a{};
    for (int i = 0; i < 24; ++i) a.in[i] = (const float*)d_in[i];
    a.out = (float*)d_out; a.ws = (unsigned char*)d_ws;
#if MK_N_LAUNCHES == 1
    a.ph_lo = 0; a.ph_hi = NPH;
    void* kargs[] = {&a};
    hipError_t e = hipLaunchCooperativeKernel((const void*)hybrid_fwd, dim3(grid), dim3(NWAVES * 64), kargs, LDS_BYTES, stream);
    if (e != hipSuccess) fprintf(stderr, "cooperative launch failed: %s (grid %d)\n", hipGetErrorString(e), grid);
#else
    for (int p = 0; p < NPH; ++p) { a.ph_lo = p; a.ph_hi = p + 1; hipLaunchKernelGGL(hybrid_fwd, dim3(grid), dim3(NWAVES * 64), LDS_BYTES, stream, a); }
#endif
}
```

```cpp
#include <hip/hip_runtime.h>
#include <hip/hip_cooperative_groups.h>
#include <cstdio>
#include <cstdint>
namespace pg8 {
#define PG8_LAS __attribute__((address_space(3)))
typedef unsigned short bf16_t;
typedef short bf16x8 __attribute__((ext_vector_type(8)));
typedef float f32x4 __attribute__((ext_vector_type(4)));
typedef unsigned u32x4 __attribute__((ext_vector_type(4)));
constexpr int BM = 256, BK = 64, HALF = 128, HTB = HALF * BK * 2  , STAGE_BYTES = 8 * HTB, NXCD = 8, WGM = 8;

__host__ __device__ __forceinline__ int lds_byte(int r, int c) { const int st = (r >> 4) * 2 + (c >> 5), rr = r & 15, cc = c & 31, ob = rr * 64 + cc * 2; return st * 1024 + (ob ^ (((ob >> 9) & 1) << 5)); }
__host__ __device__ __forceinline__ void stage_rc(int b, int& R, int& C) { const int st = b / 1024, sb = b % 1024, swz = sb ^ (((sb >> 9) & 1) << 5); R = (st >> 1) * 16 + swz / 64; C = (st & 1) * 32 + (swz % 64) / 2; }
__host__ __device__ __forceinline__ int perm32(int rho) { const int n = rho >> 4, i = rho & 15; return 8 * (i >> 2) + 4 * n + (i & 3); }

struct Unit { int pm, pn; };
struct Gemm { const bf16_t* A; const bf16_t* Bt; int M, N, K; };

struct StaticOrder {
    int nM, nN, nwg, G, c;
    __host__ __device__ void init(int M, int N, int G_, int c_) { nM = M / BM; nN = N / BM; nwg = nM * nN; G = G_; c = c_; }
    __host__ __device__ bool next(int i, Unit& u) const {
        const long L = (long)i * G + c; if (L >= nwg) return false;
        int wgid = (int)L; { const int q = nwg / NXCD, r = nwg % NXCD, xcd = wgid % NXCD, off = wgid / NXCD; wgid = (xcd < r ? xcd * (q + 1) : r * (q + 1) + (xcd - r) * q) + off; }
        const int nig = WGM * nN, gid = wgid / nig, fm = gid * WGM, gsz = (nM - fm) < WGM ? (nM - fm) : WGM;
        u.pm = fm + ((wgid % nig) % gsz); u.pn = (wgid % nig) / gsz; return true;
    }
    __device__ __forceinline__ void a_ready(const Unit&) const {}
    __device__ __forceinline__ void done(const Unit&) const {}
};

__device__ __forceinline__ unsigned cvt_pk_bf16(float lo, float hi) { unsigned r; asm volatile("v_cvt_pk_bf16_f32 %0, %1, %2" : "=v"(r) : "v"(lo), "v"(hi)); return r; }
__device__ __forceinline__ float relu_sq(float x) { float r; asm volatile("v_max_f32 %0, 0, %1" : "=v"(r) : "v"(x)); return r * r; }
template <int ACT  > struct EpiBf16 {
    static constexpr bool PERM = true, AFTER_DRAIN = false;
    bf16_t* O; int ldc;
    __device__ __forceinline__ void operator()(const f32x4 (&acc)[2][2][4][2], const Unit& u, int wr, int wc, int fr, int fq) const {
        const int row0 = u.pm * BM + wr * 64 + fr; const int col0 = u.pn * BM + wc * 32 + 8 * fq;
#pragma unroll
        for (int ai = 0; ai < 2; ++ai)
#pragma unroll
            for (int m = 0; m < 4; ++m) { bf16_t* rowp = O + (size_t)(row0 + ai * HALF + m * 16) * ldc + col0;
#pragma unroll
                for (int bj = 0; bj < 2; ++bj) { f32x4 v0 = acc[ai][bj][m][0], v1 = acc[ai][bj][m][1];
                    if (ACT == 1) {
#pragma unroll
                        for (int e = 0; e < 4; ++e) { v0[e] = relu_sq(v0[e]); v1[e] = relu_sq(v1[e]); } }
                    u32x4 w; w.x = cvt_pk_bf16(v0[0], v0[1]); w.y = cvt_pk_bf16(v0[2], v0[3]); w.z = cvt_pk_bf16(v1[0], v1[1]); w.w = cvt_pk_bf16(v1[2], v1[3]);
                    *(u32x4*)(rowp + bj * HALF) = w; } }
    }
};

template <class Epi, class Sched, bool ALIGN_EPI = false, bool SP2 = false>
__device__ __forceinline__ void gemm_phase(PG8_LAS unsigned char* lds, const Gemm g, const Sched& S, const Epi& E, const int tid) {
    const int wid = __builtin_amdgcn_readfirstlane(tid >> 6), lane = tid & 63, wr = wid >> 2, wc = wid & 3, fr = lane & 15, fq = lane >> 4;
    const int K = g.K, nt = K / BK;
    unsigned voffA[2], voffB[2];
#pragma unroll
    for (int i = 0; i < 2; ++i) { int R, C; stage_rc(tid * 16 + i * 8192, R, C); const int Rb = Epi::PERM ? ((R & ~31) + perm32(R & 31)) : R;
        voffA[i] = (unsigned)(R * K + C) * 2u; voffB[i] = (unsigned)(Rb * K + C) * 2u; }
    const size_t kstep = (size_t)(BK * 2);
    const size_t hstep = (size_t)HALF * K * 2;
    const size_t tstep = 2 * hstep;
    const unsigned ldsw = (unsigned)wid * 1024u;
    const int aoff = lds_byte(wr * 64 + fr, fq * 8), boff = lds_byte(wc * 32 + fr, fq * 8);
#define PG8_SA(b, h) (((b) * 2 + (h)) * HTB)
#define PG8_SB(b, h) ((4 + (b) * 2 + (h)) * HTB)
#define PG8_STAGE(bufoff, gbase, voff) do { _Pragma("unroll") for (int _i = 0; _i < 2; ++_i) \
        __builtin_amdgcn_global_load_lds((const unsigned*)((const char*)(gbase) + (voff)[_i]), (PG8_LAS unsigned*)(lds + (bufoff) + ldsw + _i * 8192), 16, 0, 0); } while (0)
#define PG8_LDA(dst, b, h) do { _Pragma("unroll") for (int m = 0; m < 4; ++m) _Pragma("unroll") for (int k = 0; k < 2; ++k) dst[m][k] = *(const PG8_LAS bf16x8*)(lds + PG8_SA(b, h) + aoff + m * 2048 + k * 1024); } while (0)
#define PG8_LDB(dst, b, h) do { _Pragma("unroll") for (int n = 0; n < 2; ++n) _Pragma("unroll") for (int k = 0; k < 2; ++k) dst[n][k] = *(const PG8_LAS bf16x8*)(lds + PG8_SB(b, h) + boff + n * 2048 + k * 1024); } while (0)
#define PG8_MMA(ai, bj, At, Bt) do { __builtin_amdgcn_s_setprio(1); _Pragma("unroll") for (int m = 0; m < 4; ++m) _Pragma("unroll") for (int n = 0; n < 2; ++n) _Pragma("unroll") for (int k = 0; k < 2; ++k) \
        acc[ai][bj][m][n] = __builtin_amdgcn_mfma_f32_16x16x32_bf16(Bt[n][k], At[m][k], acc[ai][bj][m][n], 0, 0, 0); __builtin_amdgcn_s_setprio(0); } while (0)
#define PG8_WAIT_V(n) asm volatile("s_waitcnt vmcnt(" #n ")" ::: "memory")
#define PG8_WAIT_L(n) asm volatile("s_waitcnt lgkmcnt(" #n ")" ::: "memory")
#define PG8_BAR __builtin_amdgcn_s_barrier()
#define PG8_SCHED __builtin_amdgcn_sched_barrier(0)
    Unit cur, nxt; int ui = 0;
    if (!S.next(0, cur)) return;
    f32x4 acc[2][2][4][2];
#pragma unroll
    for (int a = 0; a < 2; ++a)
#pragma unroll
        for (int b = 0; b < 2; ++b)
#pragma unroll
            for (int m = 0; m < 4; ++m)
#pragma unroll
                for (int n = 0; n < 2; ++n) acc[a][b][m][n] = (f32x4){0.f, 0.f, 0.f, 0.f};
    bf16x8 At[4][2], B0[2][2], B1[2][2];
    const char* cA = (const char*)g.A + (size_t)cur.pm * tstep; const char* cB = (const char*)g.Bt + (size_t)cur.pn * tstep;
    S.a_ready(cur);
    if constexpr (SP2) {
        PG8_STAGE(PG8_SB(0, 0), cB, voffB); PG8_STAGE(PG8_SB(0, 1), cB + hstep, voffB); PG8_STAGE(PG8_SA(0, 0), cA, voffA); PG8_STAGE(PG8_SA(0, 1), cA + hstep, voffA);
        if (wr == 1) PG8_BAR;
        PG8_WAIT_V(2); PG8_BAR;
        PG8_STAGE(PG8_SB(1, 0), cB + kstep, voffB); PG8_STAGE(PG8_SA(1, 0), cA + kstep, voffA); PG8_STAGE(PG8_SB(1, 1), cB + hstep + kstep, voffB);
        PG8_WAIT_V(6); PG8_BAR;
    } else {
        PG8_STAGE(PG8_SB(0, 0), cB, voffB); PG8_STAGE(PG8_SA(0, 0), cA, voffA); PG8_STAGE(PG8_SB(0, 1), cB + hstep, voffB); PG8_STAGE(PG8_SA(0, 1), cA + hstep, voffA);
        if (wr == 1) PG8_BAR;
        PG8_WAIT_V(4); PG8_BAR;
        PG8_STAGE(PG8_SB(1, 0), cB + kstep, voffB); PG8_STAGE(PG8_SA(1, 0), cA + kstep, voffA); PG8_STAGE(PG8_SB(1, 1), cB + hstep + kstep, voffB);
        PG8_WAIT_V(6); PG8_BAR;
    }
    for (;;) {
        const bool has_next = S.next(ui + 1, nxt);
        const char* nA = has_next ? (const char*)g.A + (size_t)nxt.pm * tstep : cA; const char* nB = has_next ? (const char*)g.Bt + (size_t)nxt.pn * tstep : cB;
        for (int t = 0; t < nt; t += 2) {
            const bool last = (t == nt - 2);
            const char* a1 = cA + (size_t)(t + 1) * kstep;
            const char* a2 = last ? nA : cA + (size_t)(t + 2) * kstep; const char* b2 = last ? nB : cB + (size_t)(t + 2) * kstep;
            const char* a3 = a2 + kstep; const char* b3 = b2 + kstep;
            if (last && has_next) S.a_ready(nxt);
            if constexpr (SP2) {
            PG8_LDB(B0, 0, 0); PG8_LDB(B1, 0, 1); PG8_SCHED; PG8_LDA(At, 0, 0); PG8_STAGE(PG8_SA(1, 1), a1 + hstep, voffA);
            PG8_WAIT_V(8); PG8_WAIT_L(0); PG8_BAR; PG8_MMA(0, 0, At, B0); PG8_MMA(0, 1, At, B1); PG8_BAR; PG8_SCHED;
            PG8_LDA(At, 0, 1); PG8_STAGE(PG8_SB(0, 0), b2, voffB); PG8_STAGE(PG8_SB(0, 1), b2 + hstep, voffB); PG8_STAGE(PG8_SA(0, 0), a2, voffA);
            PG8_WAIT_V(8); PG8_WAIT_L(0); PG8_BAR; PG8_MMA(1, 0, At, B0); PG8_MMA(1, 1, At, B1); PG8_BAR; PG8_SCHED;
            PG8_LDB(B0, 1, 0); PG8_LDB(B1, 1, 1); PG8_SCHED; PG8_LDA(At, 1, 0); PG8_STAGE(PG8_SA(0, 1), a2 + hstep, voffA);
            PG8_WAIT_V(8); PG8_WAIT_L(0); PG8_BAR; PG8_MMA(0, 0, At, B0); PG8_MMA(0, 1, At, B1); PG8_BAR; PG8_SCHED;
            PG8_LDA(At, 1, 1); PG8_STAGE(PG8_SB(1, 0), b3, voffB); PG8_STAGE(PG8_SB(1, 1), b3 + hstep, voffB); PG8_STAGE(PG8_SA(1, 0), a3, voffA);
            PG8_WAIT_V(8); PG8_WAIT_L(0); PG8_BAR; PG8_MMA(1, 0, At, B0); PG8_MMA(1, 1, At, B1); PG8_BAR; PG8_SCHED;
            } else {
            PG8_LDB(B0, 0, 0); PG8_SCHED; PG8_LDA(At, 0, 0); PG8_STAGE(PG8_SA(1, 1), a1 + hstep, voffA);
            PG8_WAIT_L(8); PG8_BAR; PG8_WAIT_L(0); PG8_MMA(0, 0, At, B0); PG8_BAR; PG8_SCHED;
            PG8_LDB(B1, 0, 1); PG8_STAGE(PG8_SB(0, 0), b2, voffB);
            PG8_BAR; PG8_WAIT_L(0); PG8_MMA(0, 1, At, B1); PG8_BAR;
            PG8_LDA(At, 0, 1); PG8_STAGE(PG8_SA(0, 0), a2, voffA);
            PG8_BAR; PG8_WAIT_L(0); PG8_MMA(1, 0, At, B0); PG8_BAR; PG8_SCHED;
            PG8_STAGE(PG8_SB(0, 1), b2 + hstep, voffB);
            PG8_WAIT_V(6); PG8_BAR; PG8_MMA(1, 1, At, B1); PG8_BAR;
            PG8_LDB(B0, 1, 0); PG8_SCHED; PG8_LDA(At, 1, 0); PG8_STAGE(PG8_SA(0, 1), a2 + hstep, voffA);
            PG8_WAIT_L(8); PG8_BAR; PG8_WAIT_L(0); PG8_MMA(0, 0, At, B0); PG8_BAR; PG8_SCHED;
            PG8_LDB(B1, 1, 1); PG8_STAGE(PG8_SB(1, 0), b3, voffB);
            PG8_BAR; PG8_WAIT_L(0); PG8_MMA(0, 1, At, B1); PG8_BAR;
            PG8_LDA(At, 1, 1); PG8_STAGE(PG8_SA(1, 0), a3, voffA);
            PG8_BAR; PG8_WAIT_L(0); PG8_MMA(1, 0, At, B0); PG8_BAR; PG8_SCHED;
            PG8_STAGE(PG8_SB(1, 1), b3 + hstep, voffB);
            PG8_WAIT_V(6); PG8_BAR; PG8_MMA(1, 1, At, B1); PG8_BAR;
            }
        }
        if constexpr (ALIGN_EPI) { if (wr == 0) PG8_BAR; }
        if constexpr (!Epi::AFTER_DRAIN) { E(acc, cur, wr, wc, fr, fq); S.done(cur); }
        if (!has_next) break;
#pragma unroll
        for (int a = 0; a < 2; ++a)
#pragma unroll
            for (int b = 0; b < 2; ++b)
#pragma unroll
                for (int m = 0; m < 4; ++m)
#pragma unroll
                    for (int n = 0; n < 2; ++n) acc[a][b][m][n] = (f32x4){0.f, 0.f, 0.f, 0.f};
        cur = nxt; cA = nA; cB = nB; ++ui;
        if constexpr (ALIGN_EPI) { if (wr == 1) PG8_BAR; }
    }
    PG8_WAIT_V(0);
    if constexpr (!ALIGN_EPI) { if (wr == 0) PG8_BAR; }
    PG8_BAR;
    if constexpr (Epi::AFTER_DRAIN) { E.fused(acc, cur, wr, wc, fr, fq, lds, wid, lane); S.done(cur); }
#undef PG8_SA
#undef PG8_SB
#undef PG8_STAGE
#undef PG8_LDA
#undef PG8_LDB
#undef PG8_MMA
#undef PG8_WAIT_V
#undef PG8_WAIT_L
#undef PG8_BAR
#undef PG8_SCHED
}
}

namespace cg = cooperative_groups;
#define LAS __attribute__((address_space(3)))
typedef unsigned short bf16;
typedef unsigned v4u __attribute__((ext_vector_type(4)));
typedef unsigned v2u __attribute__((ext_vector_type(2)));
typedef float f32x4 __attribute__((ext_vector_type(4)));
typedef short bf16x8 __attribute__((ext_vector_type(8)));

constexpr int NWAVES = 8;
constexpr int DM = 1024, FF = 4096, INW = 2048, GW = 256;
constexpr int MP = 16384, MS = 512, MT = MP + MS;
constexpr int SEQ = 2048, NBP = 8, NSB = 128, ST = 4, DEPTH = 2;
constexpr float EPS = 1e-6f;
constexpr size_t MiB = 1u << 20;
constexpr size_t WS_SGUW = 1 * MiB;
constexpr size_t WS_W = 2 * MiB, W_LAYER = 22 * MiB, W_IN = 0, W_OUT = 4 * MiB, W_UP = 6 * MiB, W_DN = 14 * MiB;
constexpr size_t WS_XN = 46 * MiB, WS_O = 79 * MiB, WS_H = 112 * MiB, WS_Z = 112 * MiB, WS_CAT = 178 * MiB, WS_END = 244 * MiB;
constexpr int LDS_BYTES = 147456;
constexpr int MISC_OFF = LDS_BYTES - 256;
constexpr size_t WS_CTL = 0, CTL_ZERO_BYTES = 64 * 1024;
constexpr int WAVE_SCR = 17408;
constexpr size_t OUT_Y = 0;
constexpr size_t OUT_POOL_P = (size_t)MT * DM;
constexpr size_t OUT_POOL_S = OUT_POOL_P + (size_t)DEPTH * NBP * 15 * GW;
constexpr size_t OUT_CONV_P = OUT_POOL_S + (size_t)DEPTH * NSB * 15 * GW;
constexpr size_t OUT_CONV_S = OUT_CONV_P + (size_t)DEPTH * NBP * 30 * GW;
constexpr size_t OUT_SHORT_P = OUT_CONV_S + (size_t)DEPTH * NSB * 30 * GW;
constexpr size_t OUT_SHORT_S = OUT_SHORT_P + (size_t)DEPTH * NBP * 2 * GW;
constexpr size_t OUT_V_S = OUT_SHORT_S + (size_t)DEPTH * NSB * 2 * GW;
constexpr size_t OUT_END = OUT_V_S + (size_t)DEPTH * NSB * ST * GW;

__device__ __forceinline__ float bf2f(bf16 b) { return __uint_as_float(((unsigned)b) << 16); }
__device__ __forceinline__ unsigned f2bf(float f) { unsigned u = __float_as_uint(f); return (u + 0x7fffu + ((u >> 16) & 1u)) >> 16; }
__device__ __forceinline__ unsigned pk2(float lo, float hi) { return f2bf(lo) | (f2bf(hi) << 16); }
__device__ __forceinline__ float wave_sum(float v) {
#pragma unroll
    for (int o = 1; o < 64; o <<= 1) v += __shfl_xor(v, o);
    return v;
}
__device__ __forceinline__ float sigm(float x) { return 1.f / (1.f + __expf(-x)); }
#define LDS_WAIT() asm volatile("s_waitcnt lgkmcnt(0)" ::: "memory")

__device__ __forceinline__ void transpose_item(const float* __restrict__ W, int K, int N, bf16* __restrict__ WT, const float* __restrict__ gk, LAS float* scr, int item, int lane) {
    const int nblk = N / 32, kb = item / nblk, nb = item % nblk, k0 = 64 * kb, n0 = 32 * nb;
#pragma unroll 8
    for (int i = 0; i < 32; ++i) { const int kk = 2 * i + (lane >> 5); float v = W[(size_t)(k0 + kk) * N + n0 + (lane & 31)]; if (gk) v *= gk[k0 + kk]; scr[kk * 33 + (lane & 31)] = v; }
    LDS_WAIT();
    const int c = lane & 7;
#pragma unroll
    for (int j = 0; j < 4; ++j) { const int n = (lane >> 3) + 8 * j; const LAS float* s = scr + (8 * c) * 33 + n;
        v4u o; o.x = pk2(s[0 * 33], s[1 * 33]); o.y = pk2(s[2 * 33], s[3 * 33]); o.z = pk2(s[4 * 33], s[5 * 33]); o.w = pk2(s[6 * 33], s[7 * 33]);
        *(v4u*)(WT + (size_t)(n0 + n) * K + k0 + 8 * c) = o; }
    LDS_WAIT();
}
__device__ __forceinline__ void fold_item(const float* __restrict__ W, bf16* __restrict__ WT, const float* __restrict__ wp, const float* __restrict__ ps, LAS float* scr, int item, int lane) {
    const int K = DM, N = DM; const int nblk = N / 32, g = item / nblk, nb = item % nblk, k0 = 64 * g, n0 = 32 * nb;
    LAS float* scr2 = scr + 64 * 33;
#pragma unroll 8
    for (int i = 0; i < 32; ++i) { const int kk = 2 * i + (lane >> 5); scr[kk * 33 + (lane & 31)] = W[(size_t)(k0 + kk) * N + n0 + (lane & 31)] * ps[k0 + kk]; }
    LDS_WAIT();
    const int n = lane & 31;
    for (int i = 0; i < 32; ++i) { const int kk = 2 * i + (lane >> 5); const float* wr = wp + (size_t)(g * 64 + kk) * 64; float a = 0.f;
#pragma unroll 16
        for (int d = 0; d < 64; ++d) a += wr[d] * scr[d * 33 + n];
        scr2[kk * 33 + n] = a; }
    LDS_WAIT();
    const int c = lane & 7;
#pragma unroll
    for (int j = 0; j < 4; ++j) { const int nn = (lane >> 3) + 8 * j; const LAS float* s = scr2 + (8 * c) * 33 + nn;
        v4u o; o.x = pk2(s[0 * 33], s[1 * 33]); o.y = pk2(s[2 * 33], s[3 * 33]); o.z = pk2(s[4 * 33], s[5 * 33]); o.w = pk2(s[6 * 33], s[7 * 33]);
        *(v4u*)(WT + (size_t)(n0 + nn) * K + k0 + 8 * c) = o; }
    LDS_WAIT();
}
__device__ __forceinline__ void rms_row_to_bf16(const float* __restrict__ xrow, bf16* __restrict__ orow, int lane) {
    const f32x4* xr = (const f32x4*)xrow + lane;
    f32x4 v[4]; float s = 0.f;
#pragma unroll
    for (int j = 0; j < 4; ++j) { v[j] = xr[64 * j]; s += (v[j].x * v[j].x + v[j].y * v[j].y) + (v[j].z * v[j].z + v[j].w * v[j].w); }
    const float rstd = rsqrtf(wave_sum(s) * (1.f / DM) + EPS);
    v2u* o8 = (v2u*)orow + lane;
#pragma unroll
    for (int j = 0; j < 4; ++j) { v2u o; o.x = pk2(v[j].x * rstd, v[j].y * rstd); o.y = pk2(v[j].z * rstd, v[j].w * rstd); o8[64 * j] = o; }
}
__device__ __forceinline__ void ew_row(const float* __restrict__ xrow, const bf16* __restrict__ orow, const float* __restrict__ g, float* __restrict__ Xrow, bf16* __restrict__ xnrow, bool write_xn, int lane) {
    const f32x4* xr = (const f32x4*)xrow + lane; const v2u* orr = (const v2u*)orow + lane; const f32x4* gr = (const f32x4*)g + lane;
    f32x4 x[4], o[4]; float so = 0.f;
#pragma unroll
    for (int j = 0; j < 4; ++j) { x[j] = xr[64 * j]; const v2u w = orr[64 * j];
        o[j].x = __uint_as_float(w.x << 16); o[j].y = __uint_as_float(w.x & 0xffff0000u); o[j].z = __uint_as_float(w.y << 16); o[j].w = __uint_as_float(w.y & 0xffff0000u);
        so += (o[j].x * o[j].x + o[j].y * o[j].y) + (o[j].z * o[j].z + o[j].w * o[j].w); }
    const float rs = rsqrtf(wave_sum(so) * (1.f / DM) + EPS); float s1 = 0.f;
    f32x4* Xr = (f32x4*)Xrow + lane;
#pragma unroll
    for (int j = 0; j < 4; ++j) { const f32x4 gg = gr[64 * j]; x[j] = x[j] + o[j] * rs * gg; s1 += (x[j].x * x[j].x + x[j].y * x[j].y) + (x[j].z * x[j].z + x[j].w * x[j].w); Xr[64 * j] = x[j]; }
    if (write_xn) { const float r1 = rsqrtf(wave_sum(s1) * (1.f / DM) + EPS); v2u* o8 = (v2u*)xnrow + lane;
#pragma unroll
        for (int j = 0; j < 4; ++j) { v2u w; w.x = pk2(x[j].x * r1, x[j].y * r1); w.y = pk2(x[j].z * r1, x[j].w * r1); o8[64 * j] = w; } }
}

template <bool SAMPLE>
__device__ __forceinline__ void pool_unit(const bf16* __restrict__ Z, bf16* __restrict__ CAT, const float* __restrict__ state, float* __restrict__ newp,
                                          int seq, int t0, int nrows, int g, int lane) {
    const int c = g * 64 + lane, w = 2 << g;
    const size_t rowbase = SAMPLE ? (size_t)MP + (size_t)seq * ST : (size_t)seq * SEQ;
    const bf16* zc = Z + rowbase * INW + c;
    const float* st = state + (size_t)seq * 15 * GW + c;
#define POOL_A(e) ((e) >= 0 ? bf2f(zc[(size_t)(e) * INW]) : (SAMPLE ? st[(15 + (e)) * GW] : 0.f))
    float S = 0.f;
    for (int j = 1; j < w; ++j) S += POOL_A(t0 - j);
#pragma unroll 4
    for (int t = t0; t < t0 + nrows; ++t) {
        const float a = POOL_A(t); S += a;
        const float cnt = SAMPLE ? (float)w : (float)(t + 1 < w ? t + 1 : w);
        CAT[(rowbase + t) * DM + c] = (bf16)f2bf(S / cnt - a);
        const int e = t - w + 1; S -= POOL_A(e);
    }
    const int T = SAMPLE ? ST : SEQ;
    if (t0 + nrows == T) {
        for (int j = 0; j < 15; ++j) { const int e = T - 15 + j; newp[((size_t)seq * 15 + j) * GW + c] = POOL_A(e); }
    }
#undef POOL_A
}
template <bool SAMPLE>
__device__ __forceinline__ void short_unit(const bf16* __restrict__ Z, bf16* __restrict__ CAT, const float* __restrict__ state, float* __restrict__ news,
                                           const float* __restrict__ sw, int seq, int t0, int nrows, int h, int lane) {
    const int c = h * 64 + lane;
    const size_t rowbase = SAMPLE ? (size_t)MP + (size_t)seq * ST : (size_t)seq * SEQ;
    const bf16* zc = Z + rowbase * INW + c;
    const float* st = state + (size_t)seq * 2 * GW + c;
    const float w0 = sw[c], w1 = sw[GW + c], w2 = sw[2 * GW + c];
#define SH_E(e) ((e) >= 0 ? bf2f(zc[(size_t)(e) * INW + 1536]) * bf2f(zc[(size_t)(e) * INW + 1792]) : (SAMPLE ? st[(2 + (e)) * GW] : 0.f))
    float e2 = SH_E(t0 - 2), e1 = SH_E(t0 - 1);
#pragma unroll 4
    for (int t = t0; t < t0 + nrows; ++t) {
        const float e0 = SH_E(t); const float bg = bf2f(zc[(size_t)t * INW + 1280]);
        CAT[(rowbase + t) * DM + 768 + c] = (bf16)f2bf(bg * (w0 * e2 + w1 * e1 + w2 * e0));
        e2 = e1; e1 = e0;
    }
    const int T = SAMPLE ? ST : SEQ;
    if (t0 + nrows == T) { news[((size_t)seq * 2 + 0) * GW + c] = e2; news[((size_t)seq * 2 + 1) * GW + c] = e1; }
#undef SH_E
}
template <bool SAMPLE>
__device__ __forceinline__ void conv_unit(const bf16* __restrict__ Z, bf16* __restrict__ CAT, const float* __restrict__ state, float* __restrict__ newc,
                                          const float* __restrict__ cw, const float* __restrict__ cb, const float* __restrict__ lg, const float* __restrict__ lb,
                                          int seq, int t0, int nrows, int h, LAS float* gL, int lane) {
    const int c = h * 64 + lane;
    const size_t rowbase = SAMPLE ? (size_t)MP + (size_t)seq * ST : (size_t)seq * SEQ;
    const bf16* zc = Z + rowbase * INW + c;
    bf16* oc = CAT + rowbase * DM + 256 + c;
    const int T = SAMPLE ? ST : SEQ;
    const bool last = (t0 + nrows == T);
    const int nin = nrows + 30;
#pragma unroll 4
    for (int r = 0; r < nin; ++r) { const int s = t0 - 30 + r; float gs = 0.f;
        if (s >= 0) { const unsigned off = (unsigned)s * INW; const float p = bf2f(zc[off + 256]), gt = bf2f(zc[off + 512]); gs = p * sigm(gt); }
        else if (SAMPLE) gs = state[((size_t)seq * 30 + 30 + s) * GW + c];
        if (last && s >= T - 30) newc[((size_t)seq * 30 + (s - (T - 30))) * GW + c] = gs;
        gL[r * 64 + lane] = gs; }
    LDS_WAIT();
    float wk[31];
#pragma unroll
    for (int k = 0; k < 31; ++k) wk[k] = cw[k * GW + c];
    const float bias = cb[c], gg = lg[c], bb = lb[c];
#pragma unroll 1
    for (int tq = 0; tq < nrows; tq += 4) {
        float acc[4] = {bias, bias, bias, bias};
#pragma unroll
        for (int r = 0; r < 34; ++r) { const float gv = gL[(tq + r) * 64 + lane];
#pragma unroll
            for (int q = 0; q < 4; ++q) { const int k = r - q; if (k >= 0 && k <= 30) acc[q] += wk[k] * gv; } }
#pragma unroll
        for (int q = 0; q < 4; ++q) { const float cv = acc[q];
            const float mean = wave_sum(cv) * (1.f / 64.f); const float d = cv - mean;
            const float var = wave_sum(d * d) * (1.f / 64.f);
            const float y = d * rsqrtf(var + EPS) * gg + bb;
            oc[(unsigned)(t0 + tq + q) * DM] = (bf16)f2bf(y * sigm(y)); }
    }
    LDS_WAIT();
}
__device__ __forceinline__ void sgu_unit(const bf16* __restrict__ Z, bf16* __restrict__ CAT, const bf16* __restrict__ Wb, const float* __restrict__ lg, const float* __restrict__ lb,
                                         const float* __restrict__ sb, int chunk, int h, LAS bf16* vT, int lane) {
    const size_t r0 = (size_t)chunk * 128;
    const int c = h * 64 + lane;
    const float gg = lg[c], bb = lb[c];
#pragma unroll 1
    for (int s = 0; s < 128; s += 4) {
        float v[4];
#pragma unroll
        for (int i = 0; i < 4; ++i) v[i] = bf2f(Z[(r0 + s + i) * INW + 1024 + c]);
#pragma unroll
        for (int i = 0; i < 4; ++i) { const float mean = wave_sum(v[i]) * (1.f / 64.f); const float d = v[i] - mean; const float var = wave_sum(d * d) * (1.f / 64.f); v[i] = d * rsqrtf(var + EPS) * gg + bb; }
        v2u w; w.x = pk2(v[0], v[1]); w.y = pk2(v[2], v[3]);
        *(LAS v2u*)(vT + lane * 136 + s) = w;
    }
    LDS_WAIT();
    const int fr = lane & 15, fq = lane >> 4;
#pragma unroll 1
    for (int mt = 0; mt < 8; ++mt) {
        f32x4 acc[4];
#pragma unroll
        for (int nt = 0; nt < 4; ++nt) acc[nt] = (f32x4){0.f, 0.f, 0.f, 0.f};
        const int nks = (mt * 16 + 15) / 32 + 1;
#pragma unroll 1
        for (int ks = 0; ks < nks; ++ks) {
            const bf16x8 a = *(const bf16x8*)(Wb + ((size_t)(h * 128 + mt * 16 + fr) * 128 + ks * 32 + fq * 8));
#pragma unroll
            for (int nt = 0; nt < 4; ++nt) { const bf16x8 b = *(const LAS bf16x8*)(vT + (nt * 16 + fr) * 136 + ks * 32 + fq * 8);
                acc[nt] = __builtin_amdgcn_mfma_f32_16x16x32_bf16(a, b, acc[nt], 0, 0, 0); }
        }
#pragma unroll
        for (int nt = 0; nt < 4; ++nt)
#pragma unroll
            for (int i = 0; i < 4; ++i) { const int t = mt * 16 + fq * 4 + i, cc = h * 64 + nt * 16 + fr;
                const float sv = acc[nt][i] + sb[h * 128 + t]; const float u = bf2f(Z[(r0 + t) * INW + 768 + cc]);
                CAT[(r0 + t) * DM + 512 + cc] = (bf16)f2bf(u * sv); }
    }
    LDS_WAIT();
}
__device__ __forceinline__ void sgu_sample_unit(const bf16* __restrict__ Z, bf16* __restrict__ CAT, const float* __restrict__ Wf, const float* __restrict__ lg, const float* __restrict__ lb,
                                                const float* __restrict__ sb, float* __restrict__ vout, int seq, int h, int lane) {
    const int c = h * 64 + lane; const size_t rowbase = (size_t)MP + (size_t)seq * ST;
    const float gg = lg[c], bb = lb[c];
    float vn[ST];
#pragma unroll
    for (int t = 0; t < ST; ++t) { const float v = bf2f(Z[(rowbase + t) * INW + 1024 + c]); const float mean = wave_sum(v) * (1.f / 64.f); const float d = v - mean; const float var = wave_sum(d * d) * (1.f / 64.f);
        vn[t] = d * rsqrtf(var + EPS) * gg + bb; vout[((size_t)seq * ST + t) * GW + c] = vn[t]; }
#pragma unroll
    for (int t = 0; t < ST; ++t) { float sv = sb[h * 128 + t];
#pragma unroll
        for (int s = 0; s <= t; ++s) sv += Wf[((size_t)h * 128 + t) * 128 + s] * vn[s];
        const float u = bf2f(Z[(rowbase + t) * INW + 768 + c]);
        CAT[(rowbase + t) * DM + 512 + c] = (bf16)f2bf(u * sv); }
}

#define XB_TMO      128
#define XB_XCNT(j)  (256  + 64 * (j))
#define XB_XSUB(j)  (1280 + 64 * (j))
#define XB_XGEN(j)  (2304 + 64 * (j))
#define XB_TOP      3328
#define XB_TOPGEN   3392
#define XCD_BAR_WORDS 3456
#define XB_SPIN_CAP (1u << 18)

__device__ __forceinline__ unsigned xb_ld(unsigned* p)              { return __hip_atomic_load(p, __ATOMIC_RELAXED, __HIP_MEMORY_SCOPE_AGENT); }
__device__ __forceinline__ unsigned xb_add(unsigned* p, unsigned v) { return __hip_atomic_fetch_add(p, v, __ATOMIC_RELAXED, __HIP_MEMORY_SCOPE_AGENT); }
__device__ __forceinline__ unsigned xb_xcc_id() { return (unsigned)__builtin_amdgcn_s_getreg((3 << 11) | 20) & 0xFu; }
#define XB_SPIN(cond, bar) do { unsigned _sp = 0; while (cond) { __builtin_amdgcn_s_sleep(1); \
    if ((++_sp & 255u) == 0u) { if (xb_ld(&(bar)[XB_TMO])) break; if (_sp > XB_SPIN_CAP) { atomicAdd(&(bar)[XB_TMO], 1u); break; } } } } while (0)

struct XcdBarrier {
    unsigned* bar; unsigned x;
    volatile LAS unsigned* st;
};

__device__ __forceinline__ XcdBarrier xcd_barrier_post(unsigned* bar, volatile LAS unsigned* st) {
    XcdBarrier b; b.bar = bar; b.x = xb_xcc_id(); b.st = st;
    if (threadIdx.x == 0) (void)xb_add(&bar[XB_XCNT(b.x)], 1u);
    return b;
}
__device__ __forceinline__ void xcd_barrier_complete(unsigned* bar, unsigned x, unsigned& nloc, unsigned& nx) {
    const unsigned G = gridDim.x * gridDim.y * gridDim.z;
    unsigned sum, cnt, mine, sp = 0u;
    for (;;) {
        sum = 0u; cnt = 0u; mine = 0u;
#pragma unroll
        for (unsigned j = 0; j < 16; ++j) { const unsigned c = xb_ld(&bar[XB_XCNT(j)]); sum += c; cnt += (c > 0u) ? 1u : 0u; mine = (j == x) ? c : mine; }
        if (sum == G) break;
        __builtin_amdgcn_s_sleep(1);
        if ((++sp & 255u) == 0u) { if (xb_ld(&bar[XB_TMO])) break; if (sp > XB_SPIN_CAP) { atomicAdd(&bar[XB_TMO], 1u); break; } }
    }
    nloc = mine > 0u ? mine : 1u; nx = cnt > 0u ? cnt : 1u;
}

__device__ __forceinline__ void xcd_barrier(const XcdBarrier& b) {
    asm volatile("s_waitcnt vmcnt(0)" ::: "memory");
    __syncthreads();
    if (threadIdx.x == 0) {
        unsigned* bar = b.bar;
        __builtin_amdgcn_s_waitcnt(0);
        unsigned nloc = b.st[0], nx = b.st[1];
        if (nloc == 0u) { xcd_barrier_complete(bar, b.x, nloc, nx); b.st[0] = nloc; b.st[1] = nx; }
        const unsigned old = xb_add(&bar[XB_XSUB(b.x)], 1u);
        const unsigned gen = old / nloc;
        if (old + 1u == (gen + 1u) * nloc) {
            __builtin_amdgcn_fence(__ATOMIC_RELEASE, "agent");
            asm volatile("s_waitcnt vmcnt(0)" ::: "memory");
            const unsigned og = xb_add(&bar[XB_TOP], 1u);
            const unsigned tg = og / nx;
            if (og + 1u == (tg + 1u) * nx) xb_add(&bar[XB_TOPGEN], 1u);
            else XB_SPIN(xb_ld(&bar[XB_TOPGEN]) == tg, bar);
            __builtin_amdgcn_fence(__ATOMIC_ACQUIRE, "agent");
            xb_add(&bar[XB_XGEN(b.x)], 1u);
            asm volatile("s_waitcnt vmcnt(0)" ::: "memory");
        } else {
            XB_SPIN(xb_ld(&bar[XB_XGEN(b.x)]) == gen, bar);
            __builtin_amdgcn_fence(__ATOMIC_ACQUIRE, "agent");
            asm volatile("s_waitcnt vmcnt(0)" ::: "memory");
        }
    }
    __syncthreads();
}

template <int NT, int ACT>
__device__ __forceinline__ void small_gemm_tile(LAS unsigned char* lds, const bf16* __restrict__ A, const bf16* __restrict__ Bt, bf16* __restrict__ O, int ldc, int K, int m0, int n0, int tid) {
    constexpr int NC = 16 * NT;
    const int wave = __builtin_amdgcn_readfirstlane(tid >> 6), lane = tid & 63, fr = lane & 15, fq = lane >> 4;
    const int kw = K >> 3;
    const bf16* ap = A + (size_t)(m0 + fr) * K + wave * kw + fq * 8;
    const bf16* bp = Bt + (size_t)(n0 + fr) * K + wave * kw + fq * 8;
    f32x4 acc[4][NT];
#pragma unroll
    for (int m = 0; m < 4; ++m)
#pragma unroll
        for (int n = 0; n < NT; ++n) acc[m][n] = (f32x4){0.f, 0.f, 0.f, 0.f};
#pragma unroll 4
    for (int ks = 0; ks < kw; ks += 32) {
        bf16x8 a[4], b[NT];
#pragma unroll
        for (int m = 0; m < 4; ++m) a[m] = *(const bf16x8*)(ap + (size_t)m * 16 * K + ks);
#pragma unroll
        for (int n = 0; n < NT; ++n) b[n] = *(const bf16x8*)(bp + (size_t)n * 16 * K + ks);
#pragma unroll
        for (int m = 0; m < 4; ++m)
#pragma unroll
            for (int n = 0; n < NT; ++n) acc[m][n] = __builtin_amdgcn_mfma_f32_16x16x32_bf16(a[m], b[n], acc[m][n], 0, 0, 0);
    }
    LAS float* P = (LAS float*)lds + wave * (64 * NC);
#pragma unroll
    for (int m = 0; m < 4; ++m)
#pragma unroll
        for (int n = 0; n < NT; ++n)
#pragma unroll
            for (int i = 0; i < 4; ++i) P[(m * 16 + fq * 4 + i) * NC + n * 16 + fr] = acc[m][n][i];
    __syncthreads();
    constexpr int EPT = 64 * NC / 512;
    const int e0 = tid * EPT, row = e0 / NC, col = e0 % NC;
    float r[EPT];
#pragma unroll
    for (int j = 0; j < EPT; ++j) r[j] = 0.f;
#pragma unroll
    for (int w = 0; w < 8; ++w) { const LAS f32x4* q = (const LAS f32x4*)((LAS float*)lds + w * (64 * NC) + e0);
#pragma unroll
        for (int j = 0; j < EPT / 4; ++j) { const f32x4 v = q[j]; r[4 * j] += v[0]; r[4 * j + 1] += v[1]; r[4 * j + 2] += v[2]; r[4 * j + 3] += v[3]; } }
    if (ACT == 1) {
#pragma unroll
        for (int j = 0; j < EPT; ++j) { const float t = fmaxf(r[j], 0.f); r[j] = t * t; } }
    bf16* op = O + (size_t)(m0 + row) * ldc + n0 + col;
    if (EPT == 8) { v4u w; w.x = pk2(r[0], r[1]); w.y = pk2(r[2], r[3]); w.z = pk2(r[4 % EPT], r[5 % EPT]); w.w = pk2(r[6 % EPT], r[7 % EPT]); *(v4u*)op = w; }
    else { v2u w; w.x = pk2(r[0], r[1]); w.y = pk2(r[2], r[3]); *(v2u*)op = w; }
    __syncthreads();
}

constexpr int NPH = 15;
#ifndef REP_PRO
#define REP_PRO 1
#endif
#ifndef REP_GEMM
#define REP_GEMM 1
#endif
#ifndef REP_MIX
#define REP_MIX 1
#endif
#ifndef REP_SYNC
#define REP_SYNC 1
#endif
struct Args { const float* in[24]; float* out; unsigned char* ws; int ph_lo, ph_hi; };
__global__ void __launch_bounds__(NWAVES * 64, 2) hybrid_fwd(Args args) {
    extern __shared__ __attribute__((aligned(16))) unsigned char lds_raw[];
    LAS unsigned char* lds = (LAS unsigned char*)lds_raw;
    volatile LAS unsigned* MISC = (volatile LAS unsigned*)(lds + MISC_OFF);
    if (threadIdx.x < 64) MISC[threadIdx.x] = 0u;
    __syncthreads();
    const XcdBarrier bar = xcd_barrier_post((unsigned*)(args.ws + WS_CTL), MISC + 8);
    int rep = 0;
    for (int ph = args.ph_lo; ph < args.ph_hi;) {
        int tid = threadIdx.x; asm volatile("" : "+v"(tid));
        const int lane = tid & 63, wave = __builtin_amdgcn_readfirstlane(tid >> 6);
        const int G = gridDim.x; const int bx = blockIdx.x;
        unsigned char* ws = args.ws;
        const int kk_ = (ph - 1) % 7; const int nrep = ph == 0 ? REP_PRO : (kk_ == 1 ? REP_MIX : (kk_ == 3 || kk_ == 6) ? 1 : REP_GEMM);
        if (ph == 0) {
            const int vcu = (G % 8 == 0) ? (bx % 8) * (G / 8) + bx / 8 : bx; const int gw = vcu * NWAVES + wave, NGW = G * NWAVES;
            LAS float* scr = (LAS float*)(lds + wave * WAVE_SCR);
            bf16* XN = (bf16*)(ws + WS_XN); bf16* SGW = (bf16*)(ws + WS_SGUW);
            constexpr int I_IN = (DM / 64) * (INW / 32), I_OUT = (DM / 64) * (DM / 32), I_UP = (DM / 64) * (FF / 32), I_DN = (FF / 64) * (DM / 32);
            constexpr int I_LAYER = I_IN + I_OUT + I_UP + I_DN;
            for (int it = gw; it < DEPTH * I_LAYER; it += NGW) {
                const int l = it / I_LAYER; int r = it % I_LAYER;
                unsigned char* wl = ws + WS_W + (size_t)l * W_LAYER;
                if (r < I_OUT) {
                    const float* W = args.in[10] + (size_t)l * DM * DM;
                    if (r < 4 * (DM / 32)) fold_item(W, (bf16*)(wl + W_OUT), args.in[11] + (size_t)l * 4 * 64 * 64, args.in[12] + (size_t)l * GW, scr, r, lane);
                    else transpose_item(W, DM, DM, (bf16*)(wl + W_OUT), nullptr, scr, r, lane);
                    continue; }
                r -= I_OUT;
                if (r < I_IN) { transpose_item(args.in[9] + (size_t)l * DM * INW, DM, INW, (bf16*)(wl + W_IN), args.in[5] + (size_t)l * DM, scr, r, lane); continue; }
                r -= I_IN;
                if (r < I_UP) { transpose_item(args.in[22] + (size_t)l * DM * FF, DM, FF, (bf16*)(wl + W_UP), args.in[7] + (size_t)l * DM, scr, r, lane); continue; }
                r -= I_UP;
                transpose_item(args.in[23] + (size_t)l * FF * DM, FF, DM, (bf16*)(wl + W_DN), nullptr, scr, r, lane);
            }
            for (int m = gw; m < MT; m += NGW) rms_row_to_bf16(m < MP ? args.in[0] + (size_t)m * DM : args.in[1] + (size_t)(m - MP) * DM, XN + (size_t)m * DM, lane);
            for (int e = bx * (NWAVES * 64) + tid; e < DEPTH * 4 * 128 * 128; e += G * NWAVES * 64) { const int t = (e >> 7) & 127, s = e & 127; SGW[e] = (bf16)(s <= t ? f2bf(args.in[19][e]) : 0u); }
        } else {
            const int l = (ph - 1) / 7, k = (ph - 1) - 7 * l;
            unsigned char* wl = ws + WS_W + (size_t)l * W_LAYER;
            if (k == 0 || k == 2 || k == 5) {
                const bf16* A = (const bf16*)(ws + (k == 0 ? WS_XN : k == 2 ? WS_CAT : WS_H));
                const bf16* Bt = (const bf16*)(wl + (k == 0 ? W_IN : k == 2 ? W_OUT : W_DN));
                bf16* O = (bf16*)(ws + (k == 0 ? WS_Z : WS_O));
                const int N = k == 0 ? INW : DM, K = k == 5 ? FF : DM;
                pg8::Gemm g{A, Bt, MP, N, K}; pg8::StaticOrder S; S.init(MP, N, G, bx);
                pg8::EpiBf16<0> E{O, N};
                pg8::gemm_phase<pg8::EpiBf16<0>, pg8::StaticOrder, true, true>(lds, g, S, E, tid);
                if (k == 0) { for (int j = bx; j < (MS / 64) * (INW / 64); j += G) small_gemm_tile<4, 0>(lds, A, Bt, O, N, K, MP + (j & 7) * 64, (j >> 3) * 64, tid); }
                else { for (int j = bx; j < (MS / 64) * (DM / 32); j += G) small_gemm_tile<2, 0>(lds, A, Bt, O, N, K, MP + (j & 7) * 64, (j >> 3) * 32, tid); }
            } else if (k == 4) {
                pg8::Gemm g{(const bf16*)(ws + WS_XN), (const bf16*)(wl + W_UP), MP, FF, DM}; pg8::StaticOrder S; S.init(MP, FF, G, bx);
                pg8::EpiBf16<1> E{(bf16*)(ws + WS_H), FF};
                pg8::gemm_phase<pg8::EpiBf16<1>, pg8::StaticOrder, true, true>(lds, g, S, E, tid);
                for (int j = bx; j < (MS / 64) * (FF / 64); j += G) small_gemm_tile<4, 1>(lds, (const bf16*)(ws + WS_XN), (const bf16*)(wl + W_UP), (bf16*)(ws + WS_H), FF, DM, MP + (j & 7) * 64, (j >> 3) * 64, tid);
            } else if (k == 1) {
                const int vcu = (G % 8 == 0) ? (bx % 8) * (G / 8) + bx / 8 : bx; const int gw = vcu * NWAVES + wave, NGW = G * NWAVES;
                LAS float* scr = (LAS float*)(lds + wave * WAVE_SCR);
                const bf16* ZB = (const bf16*)(ws + WS_Z); bf16* CAT = (bf16*)(ws + WS_CAT); const bf16* SGW = (const bf16*)(ws + WS_SGUW) + (size_t)l * 4 * 128 * 128;
                float* out = args.out;
                constexpr int NU_SGU = 512, NU_CONV = 2048, NU_SEG = 1024, NU_SMP = 2048, NU = NU_SGU + NU_CONV + 2 * NU_SEG + NU_SMP;
#pragma unroll 1
                for (int u = gw; u < NU; u += NGW) {
                    int lane = tid & 63; asm volatile("" : "+v"(lane));
                    if (u < NU_SGU) { sgu_unit(ZB, CAT, SGW, args.in[17] + (size_t)l * GW, args.in[18] + (size_t)l * GW, args.in[20] + (size_t)l * 4 * 128, u >> 2, u & 3, (LAS bf16*)scr, lane); continue; }
                    int r = u - NU_SGU;
                    if (r < NU_CONV) { const int seg = r >> 2, h = r & 3, seq = seg >> 6, t0 = (seg & 63) * 32;
                        conv_unit<false>(ZB, CAT, nullptr, out + OUT_CONV_P + (size_t)l * NBP * 30 * GW, args.in[13] + (size_t)l * 31 * GW, args.in[14] + (size_t)l * GW, args.in[15] + (size_t)l * GW, args.in[16] + (size_t)l * GW, seq, t0, 32, h, scr, lane);
                        continue; }
                    r -= NU_CONV;
                    if (r < 2 * NU_SEG) { const int ty = r / NU_SEG, q = r % NU_SEG, seg = q >> 2, h = q & 3, seq = seg >> 5, t0 = (seg & 31) * 64;
                        if (ty == 0) pool_unit<false>(ZB, CAT, nullptr, out + OUT_POOL_P + (size_t)l * NBP * 15 * GW, seq, t0, 64, h, lane);
                        else short_unit<false>(ZB, CAT, nullptr, out + OUT_SHORT_P + (size_t)l * NBP * 2 * GW, args.in[21] + (size_t)l * 3 * GW, seq, t0, 64, h, lane);
                        continue; }
                    r -= 2 * NU_SEG;
                    { const int ty = r >> 9, q = r & 511, seq = q >> 2, h = q & 3;
                        if (ty == 0) conv_unit<true>(ZB, CAT, args.in[3] + (size_t)l * NSB * 30 * GW, out + OUT_CONV_S + (size_t)l * NSB * 30 * GW, args.in[13] + (size_t)l * 31 * GW, args.in[14] + (size_t)l * GW, args.in[15] + (size_t)l * GW, args.in[16] + (size_t)l * GW, seq, 0, ST, h, scr, lane);
                        else if (ty == 1) pool_unit<true>(ZB, CAT, args.in[2] + (size_t)l * NSB * 15 * GW, out + OUT_POOL_S + (size_t)l * NSB * 15 * GW, seq, 0, ST, h, lane);
                        else if (ty == 2) short_unit<true>(ZB, CAT, args.in[4] + (size_t)l * NSB * 2 * GW, out + OUT_SHORT_S + (size_t)l * NSB * 2 * GW, args.in[21] + (size_t)l * 3 * GW, seq, 0, ST, h, lane);
                        else sgu_sample_unit(ZB, CAT, args.in[19] + (size_t)l * 4 * 128 * 128, args.in[17] + (size_t)l * GW, args.in[18] + (size_t)l * GW, args.in[20] + (size_t)l * 4 * 128, out + OUT_V_S + (size_t)l * NSB * ST * GW, seq, h, lane); }
                }
            } else {
                const int vcu = (G % 8 == 0) ? (bx % 8) * (G / 8) + bx / 8 : bx; const int gw = vcu * NWAVES + wave, NGW = G * NWAVES;
                const float* g = args.in[k == 3 ? 6 : 8] + (size_t)l * DM;
                float* X = args.out; const bf16* OB = (const bf16*)(ws + WS_O); bf16* XN = (bf16*)(ws + WS_XN);
                const bool from_input = (l == 0 && k == 3), write_xn = !(l == DEPTH - 1 && k == 6);
                for (int m = gw; m < MT; m += NGW) {
                    const float* xr = from_input ? (m < MP ? args.in[0] + (size_t)m * DM : args.in[1] + (size_t)(m - MP) * DM) : X + (size_t)m * DM;
                    ew_row(xr, OB + (size_t)m * DM, g, X + (size_t)m * DM, XN + (size_t)m * DM, write_xn, lane); }
            }
        }
        if (++rep < nrep) { __syncthreads(); continue; }
        rep = 0; ++ph;
        if (ph < args.ph_hi) for (int rs = 0; rs < REP_SYNC; ++rs) { if (args.ph_lo < 0) cg::this_grid().sync(); else xcd_barrier(bar); }
    }
}

#ifndef MK_N_LAUNCHES
#define MK_N_LAUNCHES 1
#endif
extern "C" void kernel_launch(void* const* d_in, const int* in_sizes, int n_in, void* d_out, int out_size, void* d_ws, size_t ws_size, hipStream_t stream) {
    static int grid = 0;
    if (grid == 0) {
        if (n_in != 24 || (size_t)out_size != OUT_END || ws_size < WS_END) { fprintf(stderr, "kernel_launch: unexpected shapes (n_in %d out %d ws %zu)\n", n_in, out_size, ws_size); grid = -1; return; }
        int dev = 0, cus = 0, per_cu = 0;
        if (hipGetDevice(&dev) != hipSuccess || hipDeviceGetAttribute(&cus, hipDeviceAttributeMultiprocessorCount, dev) != hipSuccess) { grid = -1; return; }
        if (hipFuncSetAttribute((const void*)hybrid_fwd, hipFuncAttributeMaxDynamicSharedMemorySize, LDS_BYTES) != hipSuccess) { fprintf(stderr, "kernel_launch: hipFuncSetAttribute failed\n"); grid = -1; return; }
        if (hipOccupancyMaxActiveBlocksPerMultiprocessor(&per_cu, (const void*)hybrid_fwd, NWAVES * 64, LDS_BYTES) != hipSuccess || per_cu < 1) per_cu = 1;
        (void)hipGetLastError();
        grid = cus * per_cu;
    }
    if (grid < 0) return;
    if (hipMemsetAsync((char*)d_ws + WS_CTL, 0, CTL_ZERO_BYTES, stream) != hipSuccess) { fprintf(stderr, "kernel_launch: hipMemsetAsync failed\n"); return; }
    Args a{};
    for (int i = 0; i < 24; ++i) a.in[i] = (const float*)d_in[i];
    a.out = (float*)d_out; a.ws = (unsigned char*)d_ws;
#if MK_N_LAUNCHES == 1
    a.ph_lo = 0; a.ph_hi = NPH;
    void* kargs[] = {&a};
    hipError_t e = hipLaunchCooperativeKernel((const void*)hybrid_fwd, dim3(grid), dim3(NWAVES * 64), kargs, LDS_BYTES, stream);
    if (e != hipSuccess) fprintf(stderr, "cooperative launch failed: %s (grid %d)\n", hipGetErrorString(e), grid);
#else
    for (int p = 0; p < NPH; ++p) { a.ph_lo = p; a.ph_hi = p + 1; hipLaunchKernelGGL(hybrid_fwd, dim3(grid), dim3(NWAVES * 64), LDS_BYTES, stream, a); }
#endif
}
```

```cpp
#include <hip/hip_runtime.h>
#include <hip/hip_cooperative_groups.h>
#include <cstdio>
#include <cstdint>
namespace pg8 {
#define PG8_LAS __attribute__((address_space(3)))
typedef unsigned short bf16_t;
typedef short bf16x8 __attribute__((ext_vector_type(8)));
typedef float f32x4 __attribute__((ext_vector_type(4)));
typedef unsigned u32x4 __attribute__((ext_vector_type(4)));
constexpr int BM = 256, BK = 64, HALF = 128, HTB = HALF * BK * 2  , STAGE_BYTES = 8 * HTB, NXCD = 8, WGM = 8;

__host__ __device__ __forceinline__ int lds_byte(int r, int c) { const int st = (r >> 4) * 2 + (c >> 5), rr = r & 15, cc = c & 31, ob = rr * 64 + cc * 2; return st * 1024 + (ob ^ (((ob >> 9) & 1) << 5)); }
__host__ __device__ __forceinline__ void stage_rc(int b, int& R, int& C) { const int st = b / 1024, sb = b % 1024, swz = sb ^ (((sb >> 9) & 1) << 5); R = (st >> 1) * 16 + swz / 64; C = (st & 1) * 32 + (swz % 64) / 2; }
__host__ __device__ __forceinline__ int perm32(int rho) { const int n = rho >> 4, i = rho & 15; return 8 * (i >> 2) + 4 * n + (i & 3); }

struct Unit { int pm, pn; };
struct Gemm { const bf16_t* A; const bf16_t* Bt; int M, N, K; };

struct StaticOrder {
    int nM, nN, nwg, G, c;
    __host__ __device__ void init(int M, int N, int G_, int c_) { nM = M / BM; nN = N / BM; nwg = nM * nN; G = G_; c = c_; }
    __host__ __device__ bool next(int i, Unit& u) const {
        const long L = (long)i * G + c; if (L >= nwg) return false;
        int wgid = (int)L; { const int q = nwg / NXCD, r = nwg % NXCD, xcd = wgid % NXCD, off = wgid / NXCD; wgid = (xcd < r ? xcd * (q + 1) : r * (q + 1) + (xcd - r) * q) + off; }
        const int nig = WGM * nN, gid = wgid / nig, fm = gid * WGM, gsz = (nM - fm) < WGM ? (nM - fm) : WGM;
        u.pm = fm + ((wgid % nig) % gsz); u.pn = (wgid % nig) / gsz; return true;
    }
    __device__ __forceinline__ void a_ready(const Unit&) const {}
    __device__ __forceinline__ void done(const Unit&) const {}
};

__device__ __forceinline__ unsigned cvt_pk_bf16(float lo, float hi) { unsigned r; asm volatile("v_cvt_pk_bf16_f32 %0, %1, %2" : "=v"(r) : "v"(lo), "v"(hi)); return r; }
__device__ __forceinline__ float relu_sq(float x) { float r; asm volatile("v_max_f32 %0, 0, %1" : "=v"(r) : "v"(x)); return r * r; }
template <int ACT  > struct EpiBf16 {
    static constexpr bool PERM = true, AFTER_DRAIN = false;
    bf16_t* O; int ldc;
    __device__ __forceinline__ void operator()(const f32x4 (&acc)[2][2][4][2], const Unit& u, int wr, int wc, int fr, int fq) const {
        const int row0 = u.pm * BM + wr * 64 + fr; const int col0 = u.pn * BM + wc * 32 + 8 * fq;
#pragma unroll
        for (int ai = 0; ai < 2; ++ai)
#pragma unroll
            for (int m = 0; m < 4; ++m) { bf16_t* rowp = O + (size_t)(row0 + ai * HALF + m * 16) * ldc + col0;
#pragma unroll
                for (int bj = 0; bj < 2; ++bj) { f32x4 v0 = acc[ai][bj][m][0], v1 = acc[ai][bj][m][1];
                    if (ACT == 1) {
#pragma unroll
                        for (int e = 0; e < 4; ++e) { v0[e] = relu_sq(v0[e]); v1[e] = relu_sq(v1[e]); } }
                    u32x4 w; w.x = cvt_pk_bf16(v0[0], v0[1]); w.y = cvt_pk_bf16(v0[2], v0[3]); w.z = cvt_pk_bf16(v1[0], v1[1]); w.w = cvt_pk_bf16(v1[2], v1[3]);
                    *(u32x4*)(rowp + bj * HALF) = w; } }
    }
};

template <class Epi, class Sched, bool ALIGN_EPI = false, bool SP2 = false>
__device__ __forceinline__ void gemm_phase(PG8_LAS unsigned char* lds, const Gemm g, const Sched& S, const Epi& E, const int tid) {
    const int wid = __builtin_amdgcn_readfirstlane(tid >> 6), lane = tid & 63, wr = wid >> 2, wc = wid & 3, fr = lane & 15, fq = lane >> 4;
    const int K = g.K, nt = K / BK;
    unsigned voffA[2], voffB[2];
#pragma unroll
    for (int i = 0; i < 2; ++i) { int R, C; stage_rc(tid * 16 + i * 8192, R, C); const int Rb = Epi::PERM ? ((R & ~31) + perm32(R & 31)) : R;
        voffA[i] = (unsigned)(R * K + C) * 2u; voffB[i] = (unsigned)(Rb * K + C) * 2u; }
    const size_t kstep = (size_t)(BK * 2);
    const size_t hstep = (size_t)HALF * K * 2;
    const size_t tstep = 2 * hstep;
    const unsigned ldsw = (unsigned)wid * 1024u;
    const int aoff = lds_byte(wr * 64 + fr, fq * 8), boff = lds_byte(wc * 32 + fr, fq * 8);
#define PG8_SA(b, h) (((b) * 2 + (h)) * HTB)
#define PG8_SB(b, h) ((4 + (b) * 2 + (h)) * HTB)
#define PG8_STAGE(bufoff, gbase, voff) do { _Pragma("unroll") for (int _i = 0; _i < 2; ++_i) \
        __builtin_amdgcn_global_load_lds((const unsigned*)((const char*)(gbase) + (voff)[_i]), (PG8_LAS unsigned*)(lds + (bufoff) + ldsw + _i * 8192), 16, 0, 0); } while (0)
#define PG8_LDA(dst, b, h) do { _Pragma("unroll") for (int m = 0; m < 4; ++m) _Pragma("unroll") for (int k = 0; k < 2; ++k) dst[m][k] = *(const PG8_LAS bf16x8*)(lds + PG8_SA(b, h) + aoff + m * 2048 + k * 1024); } while (0)
#define PG8_LDB(dst, b, h) do { _Pragma("unroll") for (int n = 0; n < 2; ++n) _Pragma("unroll") for (int k = 0; k < 2; ++k) dst[n][k] = *(const PG8_LAS bf16x8*)(lds + PG8_SB(b, h) + boff + n * 2048 + k * 1024); } while (0)
#define PG8_MMA(ai, bj, At, Bt) do { __builtin_amdgcn_s_setprio(1); _Pragma("unroll") for (int m = 0; m < 4; ++m) _Pragma("unroll") for (int n = 0; n < 2; ++n) _Pragma("unroll") for (int k = 0; k < 2; ++k) \
        acc[ai][bj][m][n] = __builtin_amdgcn_mfma_f32_16x16x32_bf16(Bt[n][k], At[m][k], acc[ai][bj][m][n], 0, 0, 0); __builtin_amdgcn_s_setprio(0); } while (0)
#define PG8_WAIT_V(n) asm volatile("s_waitcnt vmcnt(" #n ")" ::: "memory")
#define PG8_WAIT_L(n) asm volatile("s_waitcnt lgkmcnt(" #n ")" ::: "memory")
#define PG8_BAR __builtin_amdgcn_s_barrier()
#define PG8_SCHED __builtin_amdgcn_sched_barrier(0)
    Unit cur, nxt; int ui = 0;
    if (!S.next(0, cur)) return;
    f32x4 acc[2][2][4][2];
#pragma unroll
    for (int a = 0; a < 2; ++a)
#pragma unroll
        for (int b = 0; b < 2; ++b)
#pragma unroll
            for (int m = 0; m < 4; ++m)
#pragma unroll
                for (int n = 0; n < 2; ++n) acc[a][b][m][n] = (f32x4){0.f, 0.f, 0.f, 0.f};
    bf16x8 At[4][2], B0[2][2], B1[2][2];
    const char* cA = (const char*)g.A + (size_t)cur.pm * tstep; const char* cB = (const char*)g.Bt + (size_t)cur.pn * tstep;
    S.a_ready(cur);
    if constexpr (SP2) {
        PG8_STAGE(PG8_SB(0, 0), cB, voffB); PG8_STAGE(PG8_SB(0, 1), cB + hstep, voffB); PG8_STAGE(PG8_SA(0, 0), cA, voffA); PG8_STAGE(PG8_SA(0, 1), cA + hstep, voffA);
        if (wr == 1) PG8_BAR;
        PG8_WAIT_V(2); PG8_BAR;
        PG8_STAGE(PG8_SB(1, 0), cB + kstep, voffB); PG8_STAGE(PG8_SA(1, 0), cA + kstep, voffA); PG8_STAGE(PG8_SB(1, 1), cB + hstep + kstep, voffB);
        PG8_WAIT_V(6); PG8_BAR;
    } else {
        PG8_STAGE(PG8_SB(0, 0), cB, voffB); PG8_STAGE(PG8_SA(0, 0), cA, voffA); PG8_STAGE(PG8_SB(0, 1), cB + hstep, voffB); PG8_STAGE(PG8_SA(0, 1), cA + hstep, voffA);
        if (wr == 1) PG8_BAR;
        PG8_WAIT_V(4); PG8_BAR;
        PG8_STAGE(PG8_SB(1, 0), cB + kstep, voffB); PG8_STAGE(PG8_SA(1, 0), cA + kstep, voffA); PG8_STAGE(PG8_SB(1, 1), cB + hstep + kstep, voffB);
        PG8_WAIT_V(6); PG8_BAR;
    }
    for (;;) {
        const bool has_next = S.next(ui + 1, nxt);
        const char* nA = has_next ? (const char*)g.A + (size_t)nxt.pm * tstep : cA; const char* nB = has_next ? (const char*)g.Bt + (size_t)nxt.pn * tstep : cB;
        for (int t = 0; t < nt; t += 2) {
            const bool last = (t == nt - 2);
            const char* a1 = cA + (size_t)(t + 1) * kstep;
            const char* a2 = last ? nA : cA + (size_t)(t + 2) * kstep; const char* b2 = last ? nB : cB + (size_t)(t + 2) * kstep;
            const char* a3 = a2 + kstep; const char* b3 = b2 + kstep;
            if (last && has_next) S.a_ready(nxt);
            if constexpr (SP2) {
            PG8_LDB(B0, 0, 0); PG8_LDB(B1, 0, 1); PG8_SCHED; PG8_LDA(At, 0, 0); PG8_STAGE(PG8_SA(1, 1), a1 + hstep, voffA);
            PG8_WAIT_V(8); PG8_WAIT_L(0); PG8_BAR; PG8_MMA(0, 0, At, B0); PG8_MMA(0, 1, At, B1); PG8_BAR; PG8_SCHED;
            PG8_LDA(At, 0, 1); PG8_STAGE(PG8_SB(0, 0), b2, voffB); PG8_STAGE(PG8_SB(0, 1), b2 + hstep, voffB); PG8_STAGE(PG8_SA(0, 0), a2, voffA);
            PG8_WAIT_V(8); PG8_WAIT_L(0); PG8_BAR; PG8_MMA(1, 0, At, B0); PG8_MMA(1, 1, At, B1); PG8_BAR; PG8_SCHED;
            PG8_LDB(B0, 1, 0); PG8_LDB(B1, 1, 1); PG8_SCHED; PG8_LDA(At, 1, 0); PG8_STAGE(PG8_SA(0, 1), a2 + hstep, voffA);
            PG8_WAIT_V(8); PG8_WAIT_L(0); PG8_BAR; PG8_MMA(0, 0, At, B0); PG8_MMA(0, 1, At, B1); PG8_BAR; PG8_SCHED;
            PG8_LDA(At, 1, 1); PG8_STAGE(PG8_SB(1, 0), b3, voffB); PG8_STAGE(PG8_SB(1, 1), b3 + hstep, voffB); PG8_STAGE(PG8_SA(1, 0), a3, voffA);
            PG8_WAIT_V(8); PG8_WAIT_L(0); PG8_BAR; PG8_MMA(1, 0, At, B0); PG8_MMA(1, 1, At, B1); PG8_BAR; PG8_SCHED;
            } else {
            PG8_LDB(B0, 0, 0); PG8_SCHED; PG8_LDA(At, 0, 0); PG8_STAGE(PG8_SA(1, 1), a1 + hstep, voffA);
            PG8_WAIT_L(8); PG8_BAR; PG8_WAIT_L(0); PG8_MMA(0, 0, At, B0); PG8_BAR; PG8_SCHED;
            PG8_LDB(B1, 0, 1); PG8_STAGE(PG8_SB(0, 0), b2, voffB);
            PG8_BAR; PG8_WAIT_L(0); PG8_MMA(0, 1, At, B1); PG8_BAR;
            PG8_LDA(At, 0, 1); PG8_STAGE(PG8_SA(0, 0), a2, voffA);
            PG8_BAR; PG8_WAIT_L(0); PG8_MMA(1, 0, At, B0); PG8_BAR; PG8_SCHED;
            PG8_STAGE(PG8_SB(0, 1), b2 + hstep, voffB);
            PG8_WAIT_V(6); PG8_BAR; PG8_MMA(1, 1, At, B1); PG8_BAR;
            PG8_LDB(B0, 1, 0); PG8_SCHED; PG8_LDA(At, 1, 0); PG8_STAGE(PG8_SA(0, 1), a2 + hstep, voffA);
            PG8_WAIT_L(8); PG8_BAR; PG8_WAIT_L(0); PG8_MMA(0, 0, At, B0); PG8_BAR; PG8_SCHED;
            PG8_LDB(B1, 1, 1); PG8_STAGE(PG8_SB(1, 0), b3, voffB);
            PG8_BAR; PG8_WAIT_L(0); PG8_MMA(0, 1, At, B1); PG8_BAR;
            PG8_LDA(At, 1, 1); PG8_STAGE(PG8_SA(1, 0), a3, voffA);
            PG8_BAR; PG8_WAIT_L(0); PG8_MMA(1, 0, At, B0); PG8_BAR; PG8_SCHED;
            PG8_STAGE(PG8_SB(1, 1), b3 + hstep, voffB);
            PG8_WAIT_V(6); PG8_BAR; PG8_MMA(1, 1, At, B1); PG8_BAR;
            }
        }
        if constexpr (ALIGN_EPI) { if (wr == 0) PG8_BAR; }
        if constexpr (!Epi::AFTER_DRAIN) { E(acc, cur, wr, wc, fr, fq); S.done(cur); }
        if (!has_next) break;
#pragma unroll
        for (int a = 0; a < 2; ++a)
#pragma unroll
            for (int b = 0; b < 2; ++b)
#pragma unroll
                for (int m = 0; m < 4; ++m)
#pragma unroll
                    for (int n = 0; n < 2; ++n) acc[a][b][m][n] = (f32x4){0.f, 0.f, 0.f, 0.f};
        cur = nxt; cA = nA; cB = nB; ++ui;
        if constexpr (ALIGN_EPI) { if (wr == 1) PG8_BAR; }
    }
    PG8_WAIT_V(0);
    if constexpr (!ALIGN_EPI) { if (wr == 0) PG8_BAR; }
    PG8_BAR;
    if constexpr (Epi::AFTER_DRAIN) { E.fused(acc, cur, wr, wc, fr, fq, lds, wid, lane); S.done(cur); }
#undef PG8_SA
#undef PG8_SB
#undef PG8_STAGE
#undef PG8_LDA
#undef PG8_LDB
#undef PG8_MMA
#undef PG8_WAIT_V
#undef PG8_WAIT_L
#undef PG8_BAR
#undef PG8_SCHED
}
}

namespace cg = cooperative_groups;
#define LAS __attribute__((address_space(3)))
typedef unsigned short bf16;
typedef unsigned v4u __attribute__((ext_vector_type(4)));
typedef unsigned v2u __attribute__((ext_vector_type(2)));
typedef float f32x4 __attribute__((ext_vector_type(4)));
typedef short bf16x8 __attribute__((ext_vector_type(8)));

constexpr int NWAVES = 8;
constexpr int DM = 1024, FF = 4096, INW = 2048, GW = 256;
constexpr int MP = 16384, MS = 512, MT = MP + MS;
constexpr int SEQ = 2048, NBP = 8, NSB = 128, ST = 4, DEPTH = 2;
constexpr float EPS = 1e-6f;
constexpr size_t MiB = 1u << 20;
constexpr size_t WS_SGUW = 1 * MiB;
constexpr size_t WS_W = 2 * MiB, W_LAYER = 22 * MiB, W_IN = 0, W_OUT = 4 * MiB, W_UP = 6 * MiB, W_DN = 14 * MiB;
constexpr size_t WS_XN = 46 * MiB, WS_O = 79 * MiB, WS_H = 112 * MiB, WS_Z = 112 * MiB, WS_CAT = 178 * MiB, WS_END = 244 * MiB;
constexpr int LDS_BYTES = 147456;
constexpr int MISC_OFF = LDS_BYTES - 256;
constexpr size_t WS_CTL = 0, CTL_ZERO_BYTES = 64 * 1024;
constexpr int WAVE_SCR = 17408;
constexpr size_t OUT_Y = 0;
constexpr size_t OUT_POOL_P = (size_t)MT * DM;
constexpr size_t OUT_POOL_S = OUT_POOL_P + (size_t)DEPTH * NBP * 15 * GW;
constexpr size_t OUT_CONV_P = OUT_POOL_S + (size_t)DEPTH * NSB * 15 * GW;
constexpr size_t OUT_CONV_S = OUT_CONV_P + (size_t)DEPTH * NBP * 30 * GW;
constexpr size_t OUT_SHORT_P = OUT_CONV_S + (size_t)DEPTH * NSB * 30 * GW;
constexpr size_t OUT_SHORT_S = OUT_SHORT_P + (size_t)DEPTH * NBP * 2 * GW;
constexpr size_t OUT_V_S = OUT_SHORT_S + (size_t)DEPTH * NSB * 2 * GW;
constexpr size_t OUT_END = OUT_V_S + (size_t)DEPTH * NSB * ST * GW;

__device__ __forceinline__ float bf2f(bf16 b) { return __uint_as_float(((unsigned)b) << 16); }
__device__ __forceinline__ unsigned f2bf(float f) { unsigned u = __float_as_uint(f); return (u + 0x7fffu + ((u >> 16) & 1u)) >> 16; }
__device__ __forceinline__ unsigned pk2(float lo, float hi) { return f2bf(lo) | (f2bf(hi) << 16); }
template <int CTRL, int ROWMASK> __device__ __forceinline__ float dpp_get(float v) { return __int_as_float(__builtin_amdgcn_update_dpp(0, __float_as_int(v), CTRL, ROWMASK, 0xF, false)); }
__device__ __forceinline__ float sum8(float v) { v += dpp_get<0xB1, 0xF>(v); v += dpp_get<0x4E, 0xF>(v); v += dpp_get<0x141, 0xF>(v); return v; }
__device__ __forceinline__ float wave_sum(float v) {
    v = sum8(v); v += dpp_get<0x140, 0xF>(v); v += dpp_get<0x142, 0xA>(v); v += dpp_get<0x143, 0xC>(v);
    return __int_as_float(__builtin_amdgcn_readlane(__float_as_int(v), 63));
}
__device__ __forceinline__ void unpack8(const v4u w, float (&f)[8]) {
    f[0] = __uint_as_float(w.x << 16); f[1] = __uint_as_float(w.x & 0xffff0000u); f[2] = __uint_as_float(w.y << 16); f[3] = __uint_as_float(w.y & 0xffff0000u);
    f[4] = __uint_as_float(w.z << 16); f[5] = __uint_as_float(w.z & 0xffff0000u); f[6] = __uint_as_float(w.w << 16); f[7] = __uint_as_float(w.w & 0xffff0000u); }
__device__ __forceinline__ v4u pack8(const float (&f)[8]) { v4u w; w.x = pg8::cvt_pk_bf16(f[0], f[1]); w.y = pg8::cvt_pk_bf16(f[2], f[3]); w.z = pg8::cvt_pk_bf16(f[4], f[5]); w.w = pg8::cvt_pk_bf16(f[6], f[7]); return w; }
__device__ __forceinline__ v4u ld16(const bf16* p) { return *(const v4u*)p; }
__device__ __forceinline__ float sigm(float x) { return 1.f / (1.f + __expf(-x)); }
#define LDS_WAIT() asm volatile("s_waitcnt lgkmcnt(0)" ::: "memory")

__device__ __forceinline__ void transpose_item(const float* __restrict__ W, int K, int N, bf16* __restrict__ WT, const float* __restrict__ gk, LAS float* scr, int item, int lane) {
    const int nblk = N / 32, kb = item / nblk, nb = item % nblk, k0 = 64 * kb, n0 = 32 * nb;
#pragma unroll 8
    for (int i = 0; i < 32; ++i) { const int kk = 2 * i + (lane >> 5); float v = W[(size_t)(k0 + kk) * N + n0 + (lane & 31)]; if (gk) v *= gk[k0 + kk]; scr[kk * 33 + (lane & 31)] = v; }
    LDS_WAIT();
    const int c = lane & 7;
#pragma unroll
    for (int j = 0; j < 4; ++j) { const int n = (lane >> 3) + 8 * j; const LAS float* s = scr + (8 * c) * 33 + n;
        v4u o; o.x = pk2(s[0 * 33], s[1 * 33]); o.y = pk2(s[2 * 33], s[3 * 33]); o.z = pk2(s[4 * 33], s[5 * 33]); o.w = pk2(s[6 * 33], s[7 * 33]);
        *(v4u*)(WT + (size_t)(n0 + n) * K + k0 + 8 * c) = o; }
    LDS_WAIT();
}
__device__ __forceinline__ void fold_item(const float* __restrict__ W, bf16* __restrict__ WT, const float* __restrict__ wp, const float* __restrict__ ps, LAS float* scr, int item, int lane) {
    const int K = DM, N = DM; const int nblk = N / 32, g = item / nblk, nb = item % nblk, k0 = 64 * g, n0 = 32 * nb;
    LAS float* scr2 = scr + 64 * 33;
#pragma unroll 8
    for (int i = 0; i < 32; ++i) { const int kk = 2 * i + (lane >> 5); scr[kk * 33 + (lane & 31)] = W[(size_t)(k0 + kk) * N + n0 + (lane & 31)] * ps[k0 + kk]; }
    LDS_WAIT();
    const int n = lane & 31;
    for (int i = 0; i < 32; ++i) { const int kk = 2 * i + (lane >> 5); const float* wr = wp + (size_t)(g * 64 + kk) * 64; float a = 0.f;
#pragma unroll 16
        for (int d = 0; d < 64; ++d) a += wr[d] * scr[d * 33 + n];
        scr2[kk * 33 + n] = a; }
    LDS_WAIT();
    const int c = lane & 7;
#pragma unroll
    for (int j = 0; j < 4; ++j) { const int nn = (lane >> 3) + 8 * j; const LAS float* s = scr2 + (8 * c) * 33 + nn;
        v4u o; o.x = pk2(s[0 * 33], s[1 * 33]); o.y = pk2(s[2 * 33], s[3 * 33]); o.z = pk2(s[4 * 33], s[5 * 33]); o.w = pk2(s[6 * 33], s[7 * 33]);
        *(v4u*)(WT + (size_t)(n0 + nn) * K + k0 + 8 * c) = o; }
    LDS_WAIT();
}
__device__ __forceinline__ void rms_row_to_bf16(const float* __restrict__ xrow, bf16* __restrict__ orow, int lane) {
    const f32x4* xr = (const f32x4*)xrow + lane;
    f32x4 v[4]; float s = 0.f;
#pragma unroll
    for (int j = 0; j < 4; ++j) { v[j] = xr[64 * j]; s += (v[j].x * v[j].x + v[j].y * v[j].y) + (v[j].z * v[j].z + v[j].w * v[j].w); }
    const float rstd = rsqrtf(wave_sum(s) * (1.f / DM) + EPS);
    v2u* o8 = (v2u*)orow + lane;
#pragma unroll
    for (int j = 0; j < 4; ++j) { v2u o; o.x = pk2(v[j].x * rstd, v[j].y * rstd); o.y = pk2(v[j].z * rstd, v[j].w * rstd); o8[64 * j] = o; }
}
__device__ __forceinline__ void ew_row(const float* __restrict__ xrow, const bf16* __restrict__ orow, const float* __restrict__ g, float* __restrict__ Xrow, bf16* __restrict__ xnrow, bool write_xn, int lane) {
    const f32x4* xr = (const f32x4*)xrow + lane; const v2u* orr = (const v2u*)orow + lane; const f32x4* gr = (const f32x4*)g + lane;
    f32x4 x[4], o[4]; float so = 0.f;
#pragma unroll
    for (int j = 0; j < 4; ++j) { x[j] = xr[64 * j]; const v2u w = orr[64 * j];
        o[j].x = __uint_as_float(w.x << 16); o[j].y = __uint_as_float(w.x & 0xffff0000u); o[j].z = __uint_as_float(w.y << 16); o[j].w = __uint_as_float(w.y & 0xffff0000u);
        so += (o[j].x * o[j].x + o[j].y * o[j].y) + (o[j].z * o[j].z + o[j].w * o[j].w); }
    const float rs = rsqrtf(wave_sum(so) * (1.f / DM) + EPS); float s1 = 0.f;
    f32x4* Xr = (f32x4*)Xrow + lane;
#pragma unroll
    for (int j = 0; j < 4; ++j) { const f32x4 gg = gr[64 * j]; x[j] = x[j] + o[j] * rs * gg; s1 += (x[j].x * x[j].x + x[j].y * x[j].y) + (x[j].z * x[j].z + x[j].w * x[j].w); Xr[64 * j] = x[j]; }
    if (write_xn) { const float r1 = rsqrtf(wave_sum(s1) * (1.f / DM) + EPS); v2u* o8 = (v2u*)xnrow + lane;
#pragma unroll
        for (int j = 0; j < 4; ++j) { v2u w; w.x = pk2(x[j].x * r1, x[j].y * r1); w.y = pk2(x[j].z * r1, x[j].w * r1); o8[64 * j] = w; } }
}

template <bool SAMPLE>
__device__ __forceinline__ void pool_unit(const bf16* __restrict__ Z, bf16* __restrict__ CAT, const float* __restrict__ state, float* __restrict__ newp,
                                          int seq, int t0, int nrows, int g, int lane) {
    const int c = g * 64 + lane, w = 2 << g;
    const size_t rowbase = SAMPLE ? (size_t)MP + (size_t)seq * ST : (size_t)seq * SEQ;
    const bf16* zc = Z + rowbase * INW + c;
    const float* st = state + (size_t)seq * 15 * GW + c;
#define POOL_A(e) ((e) >= 0 ? bf2f(zc[(size_t)(e) * INW]) : (SAMPLE ? st[(15 + (e)) * GW] : 0.f))
    float S = 0.f;
    for (int j = 1; j < w; ++j) S += POOL_A(t0 - j);
#pragma unroll 4
    for (int t = t0; t < t0 + nrows; ++t) {
        const float a = POOL_A(t); S += a;
        const float cnt = SAMPLE ? (float)w : (float)(t + 1 < w ? t + 1 : w);
        CAT[(rowbase + t) * DM + c] = (bf16)f2bf(S / cnt - a);
        const int e = t - w + 1; S -= POOL_A(e);
    }
    const int T = SAMPLE ? ST : SEQ;
    if (t0 + nrows == T) {
        for (int j = 0; j < 15; ++j) { const int e = T - 15 + j; newp[((size_t)seq * 15 + j) * GW + c] = POOL_A(e); }
    }
#undef POOL_A
}
template <bool SAMPLE>
__device__ __forceinline__ void short_unit(const bf16* __restrict__ Z, bf16* __restrict__ CAT, const float* __restrict__ state, float* __restrict__ news,
                                           const float* __restrict__ sw, int seq, int t0, int nrows, int h, int lane) {
    const int c = h * 64 + lane;
    const size_t rowbase = SAMPLE ? (size_t)MP + (size_t)seq * ST : (size_t)seq * SEQ;
    const bf16* zc = Z + rowbase * INW + c;
    const float* st = state + (size_t)seq * 2 * GW + c;
    const float w0 = sw[c], w1 = sw[GW + c], w2 = sw[2 * GW + c];
#define SH_E(e) ((e) >= 0 ? bf2f(zc[(size_t)(e) * INW + 1536]) * bf2f(zc[(size_t)(e) * INW + 1792]) : (SAMPLE ? st[(2 + (e)) * GW] : 0.f))
    float e2 = SH_E(t0 - 2), e1 = SH_E(t0 - 1);
#pragma unroll 4
    for (int t = t0; t < t0 + nrows; ++t) {
        const float e0 = SH_E(t); const float bg = bf2f(zc[(size_t)t * INW + 1280]);
        CAT[(rowbase + t) * DM + 768 + c] = (bf16)f2bf(bg * (w0 * e2 + w1 * e1 + w2 * e0));
        e2 = e1; e1 = e0;
    }
    const int T = SAMPLE ? ST : SEQ;
    if (t0 + nrows == T) { news[((size_t)seq * 2 + 0) * GW + c] = e2; news[((size_t)seq * 2 + 1) * GW + c] = e1; }
#undef SH_E
}
template <bool SAMPLE>
__device__ __forceinline__ void conv_unit(const bf16* __restrict__ Z, bf16* __restrict__ CAT, const float* __restrict__ state, float* __restrict__ newc,
                                          const float* __restrict__ cw, const float* __restrict__ cb, const float* __restrict__ lg, const float* __restrict__ lb,
                                          int seq, int t0, int nrows, int h, LAS float* gL, int lane) {
    const int c = h * 64 + lane;
    const size_t rowbase = SAMPLE ? (size_t)MP + (size_t)seq * ST : (size_t)seq * SEQ;
    const bf16* zc = Z + rowbase * INW + c;
    bf16* oc = CAT + rowbase * DM + 256 + c;
    const int T = SAMPLE ? ST : SEQ;
    const bool last = (t0 + nrows == T);
    const int nin = nrows + 30;
#pragma unroll 4
    for (int r = 0; r < nin; ++r) { const int s = t0 - 30 + r; float gs = 0.f;
        if (s >= 0) { const unsigned off = (unsigned)s * INW; const float p = bf2f(zc[off + 256]), gt = bf2f(zc[off + 512]); gs = p * sigm(gt); }
        else if (SAMPLE) gs = state[((size_t)seq * 30 + 30 + s) * GW + c];
        if (last && s >= T - 30) newc[((size_t)seq * 30 + (s - (T - 30))) * GW + c] = gs;
        gL[r * 64 + lane] = gs; }
    LDS_WAIT();
    float wk[31];
#pragma unroll
    for (int k = 0; k < 31; ++k) wk[k] = cw[k * GW + c];
    const float bias = cb[c], gg = lg[c], bb = lb[c];
#pragma unroll 1
    for (int tq = 0; tq < nrows; tq += 4) {
        float acc[4] = {bias, bias, bias, bias};
#pragma unroll
        for (int r = 0; r < 34; ++r) { const float gv = gL[(tq + r) * 64 + lane];
#pragma unroll
            for (int q = 0; q < 4; ++q) { const int k = r - q; if (k >= 0 && k <= 30) acc[q] += wk[k] * gv; } }
#pragma unroll
        for (int q = 0; q < 4; ++q) { const float cv = acc[q];
            const float mean = wave_sum(cv) * (1.f / 64.f); const float d = cv - mean;
            const float var = wave_sum(d * d) * (1.f / 64.f);
            const float y = d * rsqrtf(var + EPS) * gg + bb;
            oc[(unsigned)(t0 + tq + q) * DM] = (bf16)f2bf(y * sigm(y)); }
    }
    LDS_WAIT();
}
template <int W>
__device__ __forceinline__ void pool_unit_p(const bf16* __restrict__ Z, bf16* __restrict__ CAT, float* __restrict__ newp, int seq, int t0, int g, int lane) {
    const int rr = lane >> 3, cg = lane & 7, c0 = g * 64 + cg * 8, tb = t0 + rr * 8;
    const size_t rowbase = (size_t)seq * SEQ;
    const bf16* zb = Z + (rowbase + tb) * INW + c0;
    v4u raw[W + 7];
#pragma unroll
    for (int j = 0; j < W + 7; ++j) { const int dj = j - (W - 1); raw[j] = (tb + dj >= 0) ? ld16(zb + (long)dj * INW) : (v4u){0u, 0u, 0u, 0u}; }
    float S[8];
#pragma unroll
    for (int i = 0; i < 8; ++i) S[i] = 0.f;
#pragma unroll
    for (int j = 0; j < W - 1; ++j) { float f[8]; unpack8(raw[j], f);
#pragma unroll
        for (int i = 0; i < 8; ++i) S[i] += f[i]; }
    bf16* ob = CAT + (rowbase + tb) * DM + c0;
    const bool lastseg = (t0 + 64 == SEQ);
#pragma unroll
    for (int j = 0; j < 8; ++j) { float a[8], o[8], od[8]; unpack8(raw[j + W - 1], a); unpack8(raw[j], od);
        const int t = tb + j; const float inv = 1.f / (float)(t + 1 < W ? t + 1 : W);
#pragma unroll
        for (int i = 0; i < 8; ++i) { S[i] += a[i]; o[i] = S[i] * inv - a[i]; S[i] -= od[i]; }
        *(v4u*)(ob + j * DM) = pack8(o);
        if (lastseg && t >= SEQ - 15) { float* np = newp + ((size_t)seq * 15 + (t - (SEQ - 15))) * GW + c0; *(f32x4*)np = (f32x4){a[0], a[1], a[2], a[3]}; *(f32x4*)(np + 4) = (f32x4){a[4], a[5], a[6], a[7]}; }
    }
}
__device__ __forceinline__ void short_unit_p(const bf16* __restrict__ Z, bf16* __restrict__ CAT, float* __restrict__ news, const float* __restrict__ sw, int seq, int t0, int h, int lane) {
    const int rr = lane >> 3, cg = lane & 7, c0 = h * 64 + cg * 8, tb = t0 + rr * 8;
    const size_t rowbase = (size_t)seq * SEQ;
    const bf16* zb = Z + (rowbase + tb) * INW + c0;
    v4u Bv[8], Cv[10], Hv[10];
#pragma unroll
    for (int j = 0; j < 10; ++j) { const int dj = j - 2; const bool ok = (tb + dj >= 0);
        Cv[j] = ok ? ld16(zb + (long)dj * INW + 1536) : (v4u){0u, 0u, 0u, 0u}; Hv[j] = ok ? ld16(zb + (long)dj * INW + 1792) : (v4u){0u, 0u, 0u, 0u};
        if (j >= 2) Bv[j - 2] = ld16(zb + (long)dj * INW + 1280); }
    float w0[8], w1[8], w2[8];
#pragma unroll
    for (int i = 0; i < 8; ++i) { w0[i] = sw[c0 + i]; w1[i] = sw[GW + c0 + i]; w2[i] = sw[2 * GW + c0 + i]; }
    float e2[8], e1[8];
    { float c[8], hh[8]; unpack8(Cv[0], c); unpack8(Hv[0], hh);
#pragma unroll
      for (int i = 0; i < 8; ++i) e2[i] = c[i] * hh[i];
      unpack8(Cv[1], c); unpack8(Hv[1], hh);
#pragma unroll
      for (int i = 0; i < 8; ++i) e1[i] = c[i] * hh[i]; }
    bf16* ob = CAT + (rowbase + tb) * DM + 768 + c0;
#pragma unroll
    for (int j = 0; j < 8; ++j) { float c[8], hh[8], b[8], o[8]; unpack8(Cv[j + 2], c); unpack8(Hv[j + 2], hh); unpack8(Bv[j], b);
#pragma unroll
        for (int i = 0; i < 8; ++i) { const float e0 = c[i] * hh[i]; o[i] = b[i] * (w0[i] * e2[i] + w1[i] * e1[i] + w2[i] * e0); e2[i] = e1[i]; e1[i] = e0; }
        *(v4u*)(ob + j * DM) = pack8(o); }
    if (t0 + 64 == SEQ && rr == 7) { float* np = news + (size_t)seq * 2 * GW + c0;
        *(f32x4*)np = (f32x4){e2[0], e2[1], e2[2], e2[3]}; *(f32x4*)(np + 4) = (f32x4){e2[4], e2[5], e2[6], e2[7]};
        *(f32x4*)(np + GW) = (f32x4){e1[0], e1[1], e1[2], e1[3]}; *(f32x4*)(np + GW + 4) = (f32x4){e1[4], e1[5], e1[6], e1[7]}; }
}
__device__ __forceinline__ void conv_unit_p(const bf16* __restrict__ Z, bf16* __restrict__ CAT, float* __restrict__ newc,
                                            const float* __restrict__ cw, const float* __restrict__ cb, const float* __restrict__ lg, const float* __restrict__ lb,
                                            int seq, int t0, int h, LAS float* gL, int lane) {
    const int rr = lane >> 3, cg = lane & 7, c0 = h * 64 + cg * 8;
    const size_t rowbase = (size_t)seq * SEQ;
    const bool last = (t0 + 32 == SEQ);
    { v4u pv[8], gv[8];
#pragma unroll
      for (int j = 0; j < 8; ++j) { const int r = 8 * j + rr, sx = t0 - 30 + r; const bool ok = (sx >= 0 && r < 62);
          const bf16* zp = Z + (rowbase + (ok ? sx : 0)) * INW + c0;
          pv[j] = ok ? ld16(zp + 256) : (v4u){0u, 0u, 0u, 0u}; gv[j] = ok ? ld16(zp + 512) : (v4u){0u, 0u, 0u, 0u}; }
#pragma unroll
      for (int j = 0; j < 8; ++j) { const int r = 8 * j + rr, sx = t0 - 30 + r; float p[8], gt[8]; unpack8(pv[j], p); unpack8(gv[j], gt);
#pragma unroll
          for (int i = 0; i < 8; ++i) p[i] = p[i] * sigm(gt[i]);
          if (r < 62) { *(LAS f32x4*)(gL + r * 64 + cg * 8) = (f32x4){p[0], p[1], p[2], p[3]}; *(LAS f32x4*)(gL + r * 64 + cg * 8 + 4) = (f32x4){p[4], p[5], p[6], p[7]}; }
          if (last && sx >= SEQ - 30 && r < 62) { float* np = newc + ((size_t)seq * 30 + (sx - (SEQ - 30))) * GW + c0; *(f32x4*)np = (f32x4){p[0], p[1], p[2], p[3]}; *(f32x4*)(np + 4) = (f32x4){p[4], p[5], p[6], p[7]}; } }
    }
    LDS_WAIT();
    const int c = h * 64 + lane;
    float wk[31];
#pragma unroll
    for (int k = 0; k < 31; ++k) wk[k] = cw[k * GW + c];
    const float bias = cb[c], gg = lg[c], bb = lb[c];
#pragma unroll 1
    for (int tq = 0; tq < 32; tq += 4) {
        float acc[4] = {bias, bias, bias, bias};
#pragma unroll
        for (int r = 0; r < 34; ++r) { const float gvv = gL[(tq + r) * 64 + lane];
#pragma unroll
            for (int q = 0; q < 4; ++q) { const int k = r - q; if (k >= 0 && k <= 30) acc[q] += wk[k] * gvv; } }
        float y[4];
#pragma unroll
        for (int q = 0; q < 4; ++q) { const float cv = acc[q];
            const float mean = wave_sum(cv) * (1.f / 64.f); const float d = cv - mean;
            const float var = wave_sum(d * d) * (1.f / 64.f);
            const float yy = d * rsqrtf(var + EPS) * gg + bb; y[q] = yy * sigm(yy); }
        LDS_WAIT();
#pragma unroll
        for (int q = 0; q < 4; ++q) gL[(tq + q) * 64 + lane] = y[q];
    }
    LDS_WAIT();
    bf16* ob = CAT + (rowbase + t0) * DM + 256 + c0;
#pragma unroll
    for (int j = 0; j < 4; ++j) { const int r = 8 * j + rr; const f32x4 a = *(const LAS f32x4*)(gL + r * 64 + cg * 8), b = *(const LAS f32x4*)(gL + r * 64 + cg * 8 + 4);
        const float o[8] = {a[0], a[1], a[2], a[3], b[0], b[1], b[2], b[3]}; *(v4u*)(ob + r * DM) = pack8(o); }
    LDS_WAIT();
}
__device__ __forceinline__ int sgu_swz(int c, int chunk) { return (chunk ^ ((c & 15) ^ (c >> 4))) << 3; }
__device__ __forceinline__ void sgu_unit(const bf16* __restrict__ Z, bf16* __restrict__ CAT, const bf16* __restrict__ Wb, const float* __restrict__ lg, const float* __restrict__ lb,
                                         const float* __restrict__ sb, int chunk, int h, LAS bf16* vT, int lane) {
    const size_t r0 = (size_t)chunk * 128;
    { const int rr = lane >> 3, cg = lane & 7, c0 = h * 64 + cg * 8;
      float gg[8], bb[8];
#pragma unroll
      for (int i = 0; i < 8; ++i) { gg[i] = lg[c0 + i]; bb[i] = lb[c0 + i]; }
#pragma unroll 1
      for (int jh = 0; jh < 16; jh += 8) {
          v4u raw[8];
#pragma unroll
          for (int j = 0; j < 8; ++j) raw[j] = ld16(Z + (r0 + 8 * (jh + j) + rr) * INW + 1024 + c0);
#pragma unroll
          for (int j = 0; j < 8; ++j) { float x[8]; unpack8(raw[j], x);
              float sm = ((x[0] + x[1]) + (x[2] + x[3])) + ((x[4] + x[5]) + (x[6] + x[7])); const float mean = sum8(sm) * (1.f / 64.f);
              float q = 0.f;
#pragma unroll
              for (int i = 0; i < 8; ++i) { x[i] -= mean; q += x[i] * x[i]; }
              const float rstd = rsqrtf(sum8(q) * (1.f / 64.f) + EPS);
#pragma unroll
              for (int i = 0; i < 8; ++i) { const int cl = cg * 8 + i; vT[cl * 128 + sgu_swz(cl, jh + j) + rr] = (bf16)f2bf(x[i] * rstd * gg[i] + bb[i]); } }
      }
    }
    LDS_WAIT();
    const int fr = lane & 15, fq = lane >> 4;
#pragma unroll 1
    for (int mt = 0; mt < 8; ++mt) {
        f32x4 acc[4];
#pragma unroll
        for (int nt = 0; nt < 4; ++nt) acc[nt] = (f32x4){0.f, 0.f, 0.f, 0.f};
        const int nks = (mt * 16 + 15) / 32 + 1;
        const int t = mt * 16 + fr;
        v2u uv[4];
#pragma unroll
        for (int nt = 0; nt < 4; ++nt) uv[nt] = *(const v2u*)(Z + (r0 + t) * INW + 768 + h * 64 + nt * 16 + 4 * fq);
        const float bt = sb[h * 128 + t];
#pragma unroll 1
        for (int ks = 0; ks < nks; ++ks) {
            const bf16x8 wf = *(const bf16x8*)(Wb + ((size_t)(h * 128 + t) * 128 + ks * 32 + fq * 8));
#pragma unroll
            for (int nt = 0; nt < 4; ++nt) { const int cl = nt * 16 + fr; const bf16x8 vf = *(const LAS bf16x8*)(vT + cl * 128 + sgu_swz(cl, ks * 4 + fq));
                acc[nt] = __builtin_amdgcn_mfma_f32_16x16x32_bf16(vf, wf, acc[nt], 0, 0, 0); }
        }
#pragma unroll
        for (int nt = 0; nt < 4; ++nt) { const float u0 = __uint_as_float(uv[nt].x << 16), u1 = __uint_as_float(uv[nt].x & 0xffff0000u), u2 = __uint_as_float(uv[nt].y << 16), u3 = __uint_as_float(uv[nt].y & 0xffff0000u);
            v2u w; w.x = pg8::cvt_pk_bf16(u0 * (acc[nt][0] + bt), u1 * (acc[nt][1] + bt)); w.y = pg8::cvt_pk_bf16(u2 * (acc[nt][2] + bt), u3 * (acc[nt][3] + bt));
            *(v2u*)(CAT + (r0 + t) * DM + 512 + h * 64 + nt * 16 + 4 * fq) = w; }
    }
    LDS_WAIT();
}
__device__ __forceinline__ void sgu_sample_unit(const bf16* __restrict__ Z, bf16* __restrict__ CAT, const float* __restrict__ Wf, const float* __restrict__ lg, const float* __restrict__ lb,
                                                const float* __restrict__ sb, float* __restrict__ vout, int seq, int h, int lane) {
    const int c = h * 64 + lane; const size_t rowbase = (size_t)MP + (size_t)seq * ST;
    const float gg = lg[c], bb = lb[c];
    float vn[ST];
#pragma unroll
    for (int t = 0; t < ST; ++t) { const float v = bf2f(Z[(rowbase + t) * INW + 1024 + c]); const float mean = wave_sum(v) * (1.f / 64.f); const float d = v - mean; const float var = wave_sum(d * d) * (1.f / 64.f);
        vn[t] = d * rsqrtf(var + EPS) * gg + bb; vout[((size_t)seq * ST + t) * GW + c] = vn[t]; }
#pragma unroll
    for (int t = 0; t < ST; ++t) { float sv = sb[h * 128 + t];
#pragma unroll
        for (int s = 0; s <= t; ++s) sv += Wf[((size_t)h * 128 + t) * 128 + s] * vn[s];
        const float u = bf2f(Z[(rowbase + t) * INW + 768 + c]);
        CAT[(rowbase + t) * DM + 512 + c] = (bf16)f2bf(u * sv); }
}

#define XB_TMO      128
#define XB_XCNT(j)  (256  + 64 * (j))
#define XB_XSUB(j)  (1280 + 64 * (j))
#define XB_XGEN(j)  (2304 + 64 * (j))
#define XB_TOP      3328
#define XB_TOPGEN   3392
#define XCD_BAR_WORDS 3456
#define XB_SPIN_CAP (1u << 18)

__device__ __forceinline__ unsigned xb_ld(unsigned* p)              { return __hip_atomic_load(p, __ATOMIC_RELAXED, __HIP_MEMORY_SCOPE_AGENT); }
__device__ __forceinline__ unsigned xb_add(unsigned* p, unsigned v) { return __hip_atomic_fetch_add(p, v, __ATOMIC_RELAXED, __HIP_MEMORY_SCOPE_AGENT); }
__device__ __forceinline__ unsigned xb_xcc_id() { return (unsigned)__builtin_amdgcn_s_getreg((3 << 11) | 20) & 0xFu; }
#define XB_SPIN(cond, bar) do { unsigned _sp = 0; while (cond) { __builtin_amdgcn_s_sleep(1); \
    if ((++_sp & 255u) == 0u) { if (xb_ld(&(bar)[XB_TMO])) break; if (_sp > XB_SPIN_CAP) { atomicAdd(&(bar)[XB_TMO], 1u); break; } } } } while (0)

struct XcdBarrier {
    unsigned* bar; unsigned x;
    volatile LAS unsigned* st;
};

__device__ __forceinline__ XcdBarrier xcd_barrier_post(unsigned* bar, volatile LAS unsigned* st) {
    XcdBarrier b; b.bar = bar; b.x = xb_xcc_id(); b.st = st;
    if (threadIdx.x == 0) (void)xb_add(&bar[XB_XCNT(b.x)], 1u);
    return b;
}
__device__ __forceinline__ void xcd_barrier_complete(unsigned* bar, unsigned x, unsigned& nloc, unsigned& nx) {
    const unsigned G = gridDim.x * gridDim.y * gridDim.z;
    unsigned sum, cnt, mine, sp = 0u;
    for (;;) {
        sum = 0u; cnt = 0u; mine = 0u;
#pragma unroll
        for (unsigned j = 0; j < 16; ++j) { const unsigned c = xb_ld(&bar[XB_XCNT(j)]); sum += c; cnt += (c > 0u) ? 1u : 0u; mine = (j == x) ? c : mine; }
        if (sum == G) break;
        __builtin_amdgcn_s_sleep(1);
        if ((++sp & 255u) == 0u) { if (xb_ld(&bar[XB_TMO])) break; if (sp > XB_SPIN_CAP) { atomicAdd(&bar[XB_TMO], 1u); break; } }
    }
    nloc = mine > 0u ? mine : 1u; nx = cnt > 0u ? cnt : 1u;
}

__device__ __forceinline__ void xcd_barrier(const XcdBarrier& b) {
    asm volatile("s_waitcnt vmcnt(0)" ::: "memory");
    __syncthreads();
    if (threadIdx.x == 0) {
        unsigned* bar = b.bar;
        __builtin_amdgcn_s_waitcnt(0);
        unsigned nloc = b.st[0], nx = b.st[1];
        if (nloc == 0u) { xcd_barrier_complete(bar, b.x, nloc, nx); b.st[0] = nloc; b.st[1] = nx; }
        const unsigned old = xb_add(&bar[XB_XSUB(b.x)], 1u);
        const unsigned gen = old / nloc;
        if (old + 1u == (gen + 1u) * nloc) {
            __builtin_amdgcn_fence(__ATOMIC_RELEASE, "agent");
            asm volatile("s_waitcnt vmcnt(0)" ::: "memory");
            const unsigned og = xb_add(&bar[XB_TOP], 1u);
            const unsigned tg = og / nx;
            if (og + 1u == (tg + 1u) * nx) xb_add(&bar[XB_TOPGEN], 1u);
            else XB_SPIN(xb_ld(&bar[XB_TOPGEN]) == tg, bar);
            __builtin_amdgcn_fence(__ATOMIC_ACQUIRE, "agent");
            xb_add(&bar[XB_XGEN(b.x)], 1u);
            asm volatile("s_waitcnt vmcnt(0)" ::: "memory");
        } else {
            XB_SPIN(xb_ld(&bar[XB_XGEN(b.x)]) == gen, bar);
            __builtin_amdgcn_fence(__ATOMIC_ACQUIRE, "agent");
            asm volatile("s_waitcnt vmcnt(0)" ::: "memory");
        }
    }
    __syncthreads();
}

template <int NT, int ACT>
__device__ __forceinline__ void small_gemm_tile(LAS unsigned char* lds, const bf16* __restrict__ A, const bf16* __restrict__ Bt, bf16* __restrict__ O, int ldc, int K, int m0, int n0, int tid) {
    constexpr int NC = 16 * NT;
    const int wave = __builtin_amdgcn_readfirstlane(tid >> 6), lane = tid & 63, fr = lane & 15, fq = lane >> 4;
    const int kw = K >> 3;
    const bf16* ap = A + (size_t)(m0 + fr) * K + wave * kw + fq * 8;
    const bf16* bp = Bt + (size_t)(n0 + fr) * K + wave * kw + fq * 8;
    f32x4 acc[4][NT];
#pragma unroll
    for (int m = 0; m < 4; ++m)
#pragma unroll
        for (int n = 0; n < NT; ++n) acc[m][n] = (f32x4){0.f, 0.f, 0.f, 0.f};
#pragma unroll 4
    for (int ks = 0; ks < kw; ks += 32) {
        bf16x8 a[4], b[NT];
#pragma unroll
        for (int m = 0; m < 4; ++m) a[m] = *(const bf16x8*)(ap + (size_t)m * 16 * K + ks);
#pragma unroll
        for (int n = 0; n < NT; ++n) b[n] = *(const bf16x8*)(bp + (size_t)n * 16 * K + ks);
#pragma unroll
        for (int m = 0; m < 4; ++m)
#pragma unroll
            for (int n = 0; n < NT; ++n) acc[m][n] = __builtin_amdgcn_mfma_f32_16x16x32_bf16(a[m], b[n], acc[m][n], 0, 0, 0);
    }
    LAS float* P = (LAS float*)lds + wave * (64 * NC);
#pragma unroll
    for (int m = 0; m < 4; ++m)
#pragma unroll
        for (int n = 0; n < NT; ++n)
#pragma unroll
            for (int i = 0; i < 4; ++i) P[(m * 16 + fq * 4 + i) * NC + n * 16 + fr] = acc[m][n][i];
    __syncthreads();
    constexpr int EPT = 64 * NC / 512;
    const int e0 = tid * EPT, row = e0 / NC, col = e0 % NC;
    float r[EPT];
#pragma unroll
    for (int j = 0; j < EPT; ++j) r[j] = 0.f;
#pragma unroll
    for (int w = 0; w < 8; ++w) { const LAS f32x4* q = (const LAS f32x4*)((LAS float*)lds + w * (64 * NC) + e0);
#pragma unroll
        for (int j = 0; j < EPT / 4; ++j) { const f32x4 v = q[j]; r[4 * j] += v[0]; r[4 * j + 1] += v[1]; r[4 * j + 2] += v[2]; r[4 * j + 3] += v[3]; } }
    if (ACT == 1) {
#pragma unroll
        for (int j = 0; j < EPT; ++j) { const float t = fmaxf(r[j], 0.f); r[j] = t * t; } }
    bf16* op = O + (size_t)(m0 + row) * ldc + n0 + col;
    if (EPT == 8) { v4u w; w.x = pk2(r[0], r[1]); w.y = pk2(r[2], r[3]); w.z = pk2(r[4 % EPT], r[5 % EPT]); w.w = pk2(r[6 % EPT], r[7 % EPT]); *(v4u*)op = w; }
    else { v2u w; w.x = pk2(r[0], r[1]); w.y = pk2(r[2], r[3]); *(v2u*)op = w; }
    __syncthreads();
}

constexpr int NPH = 15;
#ifndef REP_PRO
#define REP_PRO 1
#endif
#ifndef REP_GEMM
#define REP_GEMM 1
#endif
#ifndef REP_MIX
#define REP_MIX 1
#endif
#ifndef REP_SYNC
#define REP_SYNC 1
#endif
struct Args { const float* in[24]; float* out; unsigned char* ws; int ph_lo, ph_hi; };
__global__ void __launch_bounds__(NWAVES * 64, 2) hybrid_fwd(Args args) {
    extern __shared__ __attribute__((aligned(16))) unsigned char lds_raw[];
    LAS unsigned char* lds = (LAS unsigned char*)lds_raw;
    volatile LAS unsigned* MISC = (volatile LAS unsigned*)(lds + MISC_OFF);
    if (threadIdx.x < 64) MISC[threadIdx.x] = 0u;
    __syncthreads();
    const XcdBarrier bar = xcd_barrier_post((unsigned*)(args.ws + WS_CTL), MISC + 8);
    int rep = 0;
    for (int ph = args.ph_lo; ph < args.ph_hi;) {
        int tid = threadIdx.x; asm volatile("" : "+v"(tid));
        const int lane = tid & 63, wave = __builtin_amdgcn_readfirstlane(tid >> 6);
        const int G = gridDim.x; const int bx = blockIdx.x;
        unsigned char* ws = args.ws;
        const int kk_ = (ph - 1) % 7; const int nrep = ph == 0 ? REP_PRO : (kk_ == 1 ? REP_MIX : (kk_ == 3 || kk_ == 6) ? 1 : REP_GEMM);
        if (ph == 0) {
            const int vcu = (G % 8 == 0) ? (bx % 8) * (G / 8) + bx / 8 : bx; const int gw = vcu * NWAVES + wave, NGW = G * NWAVES;
            LAS float* scr = (LAS float*)(lds + wave * WAVE_SCR);
            bf16* XN = (bf16*)(ws + WS_XN); bf16* SGW = (bf16*)(ws + WS_SGUW);
            constexpr int I_IN = (DM / 64) * (INW / 32), I_OUT = (DM / 64) * (DM / 32), I_UP = (DM / 64) * (FF / 32), I_DN = (FF / 64) * (DM / 32);
            constexpr int I_LAYER = I_IN + I_OUT + I_UP + I_DN;
            for (int it = gw; it < DEPTH * I_LAYER; it += NGW) {
                const int l = it / I_LAYER; int r = it % I_LAYER;
                unsigned char* wl = ws + WS_W + (size_t)l * W_LAYER;
                if (r < I_OUT) {
                    const float* W = args.in[10] + (size_t)l * DM * DM;
                    if (r < 4 * (DM / 32)) fold_item(W, (bf16*)(wl + W_OUT), args.in[11] + (size_t)l * 4 * 64 * 64, args.in[12] + (size_t)l * GW, scr, r, lane);
                    else transpose_item(W, DM, DM, (bf16*)(wl + W_OUT), nullptr, scr, r, lane);
                    continue; }
                r -= I_OUT;
                if (r < I_IN) { transpose_item(args.in[9] + (size_t)l * DM * INW, DM, INW, (bf16*)(wl + W_IN), args.in[5] + (size_t)l * DM, scr, r, lane); continue; }
                r -= I_IN;
                if (r < I_UP) { transpose_item(args.in[22] + (size_t)l * DM * FF, DM, FF, (bf16*)(wl + W_UP), args.in[7] + (size_t)l * DM, scr, r, lane); continue; }
                r -= I_UP;
                transpose_item(args.in[23] + (size_t)l * FF * DM, FF, DM, (bf16*)(wl + W_DN), nullptr, scr, r, lane);
            }
            for (int m = gw; m < MT; m += NGW) rms_row_to_bf16(m < MP ? args.in[0] + (size_t)m * DM : args.in[1] + (size_t)(m - MP) * DM, XN + (size_t)m * DM, lane);
            for (int e = bx * (NWAVES * 64) + tid; e < DEPTH * 4 * 128 * 128; e += G * NWAVES * 64) { const int t = (e >> 7) & 127, s = e & 127; SGW[e] = (bf16)(s <= t ? f2bf(args.in[19][e]) : 0u); }
        } else {
            const int l = (ph - 1) / 7, k = (ph - 1) - 7 * l;
            unsigned char* wl = ws + WS_W + (size_t)l * W_LAYER;
            if (k == 0 || k == 2 || k == 5) {
                const bf16* A = (const bf16*)(ws + (k == 0 ? WS_XN : k == 2 ? WS_CAT : WS_H));
                const bf16* Bt = (const bf16*)(wl + (k == 0 ? W_IN : k == 2 ? W_OUT : W_DN));
                bf16* O = (bf16*)(ws + (k == 0 ? WS_Z : WS_O));
                const int N = k == 0 ? INW : DM, K = k == 5 ? FF : DM;
                pg8::Gemm g{A, Bt, MP, N, K}; pg8::StaticOrder S; S.init(MP, N, G, bx);
                pg8::EpiBf16<0> E{O, N};
                pg8::gemm_phase<pg8::EpiBf16<0>, pg8::StaticOrder, true, true>(lds, g, S, E, tid);
                if (k == 0) { for (int j = bx; j < (MS / 64) * (INW / 64); j += G) small_gemm_tile<4, 0>(lds, A, Bt, O, N, K, MP + (j & 7) * 64, (j >> 3) * 64, tid); }
                else { for (int j = bx; j < (MS / 64) * (DM / 32); j += G) small_gemm_tile<2, 0>(lds, A, Bt, O, N, K, MP + (j & 7) * 64, (j >> 3) * 32, tid); }
            } else if (k == 4) {
                pg8::Gemm g{(const bf16*)(ws + WS_XN), (const bf16*)(wl + W_UP), MP, FF, DM}; pg8::StaticOrder S; S.init(MP, FF, G, bx);
                pg8::EpiBf16<1> E{(bf16*)(ws + WS_H), FF};
                pg8::gemm_phase<pg8::EpiBf16<1>, pg8::StaticOrder, true, true>(lds, g, S, E, tid);
                for (int j = bx; j < (MS / 64) * (FF / 64); j += G) small_gemm_tile<4, 1>(lds, (const bf16*)(ws + WS_XN), (const bf16*)(wl + W_UP), (bf16*)(ws + WS_H), FF, DM, MP + (j & 7) * 64, (j >> 3) * 64, tid);
            } else if (k == 1) {
                const int vcu = (G % 8 == 0) ? (bx % 8) * (G / 8) + bx / 8 : bx; const int gw = vcu * NWAVES + wave, NGW = G * NWAVES;
                LAS float* scr = (LAS float*)(lds + wave * WAVE_SCR);
                const bf16* ZB = (const bf16*)(ws + WS_Z); bf16* CAT = (bf16*)(ws + WS_CAT); const bf16* SGW = (const bf16*)(ws + WS_SGUW) + (size_t)l * 4 * 128 * 128;
                float* out = args.out;
                constexpr int NU_SGU = 512, NU_CONV = 2048, NU_SEG = 1024, NU_SMP = 2048, NU = NU_SGU + NU_CONV + 2 * NU_SEG + NU_SMP;
#pragma unroll 1
                for (int ui = 0; ui * NGW < NU; ++ui) {
                    const int u = ui * NGW + ((ui & 1) ? NGW - 1 - gw : gw);
                    if (u >= NU) continue;
                    int lane = tid & 63; asm volatile("" : "+v"(lane));
                    if (u < NU_SGU) { sgu_unit(ZB, CAT, SGW, args.in[17] + (size_t)l * GW, args.in[18] + (size_t)l * GW, args.in[20] + (size_t)l * 4 * 128, u >> 2, u & 3, (LAS bf16*)scr, lane); continue; }
                    int r = u - NU_SGU;
                    if (r < NU_CONV) { const int seg = r >> 2, h = r & 3, seq = seg >> 6, t0 = (seg & 63) * 32;
                        conv_unit_p(ZB, CAT, out + OUT_CONV_P + (size_t)l * NBP * 30 * GW, args.in[13] + (size_t)l * 31 * GW, args.in[14] + (size_t)l * GW, args.in[15] + (size_t)l * GW, args.in[16] + (size_t)l * GW, seq, t0, h, scr, lane);
                        continue; }
                    r -= NU_CONV;
                    if (r < 2 * NU_SEG) { const int ty = r / NU_SEG, q = r % NU_SEG, seg = q >> 2, h = q & 3, seq = seg >> 5, t0 = (seg & 31) * 64;
                        if (ty == 0) { float* np = out + OUT_POOL_P + (size_t)l * NBP * 15 * GW;
                            if (h == 0) pool_unit_p<2>(ZB, CAT, np, seq, t0, h, lane); else if (h == 1) pool_unit_p<4>(ZB, CAT, np, seq, t0, h, lane);
                            else if (h == 2) pool_unit_p<8>(ZB, CAT, np, seq, t0, h, lane); else pool_unit_p<16>(ZB, CAT, np, seq, t0, h, lane); }
                        else short_unit_p(ZB, CAT, out + OUT_SHORT_P + (size_t)l * NBP * 2 * GW, args.in[21] + (size_t)l * 3 * GW, seq, t0, h, lane);
                        continue; }
                    r -= 2 * NU_SEG;
                    { const int ty = r >> 9, q = r & 511, seq = q >> 2, h = q & 3;
                        if (ty == 0) conv_unit<true>(ZB, CAT, args.in[3] + (size_t)l * NSB * 30 * GW, out + OUT_CONV_S + (size_t)l * NSB * 30 * GW, args.in[13] + (size_t)l * 31 * GW, args.in[14] + (size_t)l * GW, args.in[15] + (size_t)l * GW, args.in[16] + (size_t)l * GW, seq, 0, ST, h, scr, lane);
                        else if (ty == 1) pool_unit<true>(ZB, CAT, args.in[2] + (size_t)l * NSB * 15 * GW, out + OUT_POOL_S + (size_t)l * NSB * 15 * GW, seq, 0, ST, h, lane);
                        else if (ty == 2) short_unit<true>(ZB, CAT, args.in[4] + (size_t)l * NSB * 2 * GW, out + OUT_SHORT_S + (size_t)l * NSB * 2 * GW, args.in[21] + (size_t)l * 3 * GW, seq, 0, ST, h, lane);
                        else sgu_sample_unit(ZB, CAT, args.in[19] + (size_t)l * 4 * 128 * 128, args.in[17] + (size_t)l * GW, args.in[18] + (size_t)l * GW, args.in[20] + (size_t)l * 4 * 128, out + OUT_V_S + (size_t)l * NSB * ST * GW, seq, h, lane); }
                }
            } else {
                const int vcu = (G % 8 == 0) ? (bx % 8) * (G / 8) + bx / 8 : bx; const int gw = vcu * NWAVES + wave, NGW = G * NWAVES;
                const float* g = args.in[k == 3 ? 6 : 8] + (size_t)l * DM;
                float* X = args.out; const bf16* OB = (const bf16*)(ws + WS_O); bf16* XN = (bf16*)(ws + WS_XN);
                const bool from_input = (l == 0 && k == 3), write_xn = !(l == DEPTH - 1 && k == 6);
                for (int m = gw; m < MT; m += NGW) {
                    const float* xr = from_input ? (m < MP ? args.in[0] + (size_t)m * DM : args.in[1] + (size_t)(m - MP) * DM) : X + (size_t)m * DM;
                    ew_row(xr, OB + (size_t)m * DM, g, X + (size_t)m * DM, XN + (size_t)m * DM, write_xn, lane); }
            }
        }
        if (++rep < nrep) { __syncthreads(); continue; }
        rep = 0; ++ph;
        if (ph < args.ph_hi) for (int rs = 0; rs < REP_SYNC; ++rs) { if (args.ph_lo < 0) cg::this_grid().sync(); else xcd_barrier(bar); }
    }
}

#ifndef MK_N_LAUNCHES
#define MK_N_LAUNCHES 1
#endif
extern "C" void kernel_launch(void* const* d_in, const int* in_sizes, int n_in, void* d_out, int out_size, void* d_ws, size_t ws_size, hipStream_t stream) {
    static int grid = 0;
    if (grid == 0) {
        if (n_in != 24 || (size_t)out_size != OUT_END || ws_size < WS_END) { fprintf(stderr, "kernel_launch: unexpected shapes (n_in %d out %d ws %zu)\n", n_in, out_size, ws_size); grid = -1; return; }
        int dev = 0, cus = 0, per_cu = 0;
        if (hipGetDevice(&dev) != hipSuccess || hipDeviceGetAttribute(&cus, hipDeviceAttributeMultiprocessorCount, dev) != hipSuccess) { grid = -1; return; }
        if (hipFuncSetAttribute((const void*)hybrid_fwd, hipFuncAttributeMaxDynamicSharedMemorySize, LDS_BYTES) != hipSuccess) { fprintf(stderr, "kernel_launch: hipFuncSetAttribute failed\n"); grid = -1; return; }
        if (hipOccupancyMaxActiveBlocksPerMultiprocessor(&per_cu, (const void*)hybrid_fwd, NWAVES * 64, LDS_BYTES) != hipSuccess || per_cu < 1) per_cu = 1;
        (void)hipGetLastError();
        grid = cus * per_cu;
    }
    if (grid < 0) return;
    if (hipMemsetAsync((char*)d_ws + WS_CTL, 0, CTL_ZERO_BYTES, stream) != hipSuccess) { fprintf(stderr, "kernel_launch: hipMemsetAsync failed\n"); return; }
    Args a{};
    for (int i = 0; i < 24; ++i) a.in[i] = (const float*)d_in[i];
    a.out = (float*)d_out; a.ws = (unsigned char*)d_ws;
#if MK_N_LAUNCHES == 1
    a.ph_lo = 0; a.ph_hi = NPH;
    void* kargs[] = {&a};
    hipError_t e = hipLaunchCooperativeKernel((const void*)hybrid_fwd, dim3(grid), dim3(NWAVES * 64), kargs, LDS_BYTES, stream);
    if (e != hipSuccess) fprintf(stderr, "cooperative launch failed: %s (grid %d)\n", hipGetErrorString(e), grid);
#else
    for (int p = 0; p < NPH; ++p) { a.ph_lo = p; a.ph_hi = p + 1; hipLaunchKernelGGL(hybrid_fwd, dim3(grid), dim3(NWAVES * 64), LDS_BYTES, stream, a); }
#endif
}
```

```cpp
#include <hip/hip_runtime.h>
#include <hip/hip_cooperative_groups.h>
#include <cstdio>
#include <cstdint>
namespace pg8 {
#define PG8_LAS __attribute__((address_space(3)))
typedef unsigned short bf16_t;
typedef short bf16x8 __attribute__((ext_vector_type(8)));
typedef float f32x4 __attribute__((ext_vector_type(4)));
typedef unsigned u32x4 __attribute__((ext_vector_type(4)));
constexpr int BM = 256, BK = 64, HALF = 128, HTB = HALF * BK * 2  , STAGE_BYTES = 8 * HTB, NXCD = 8, WGM = 8;

__host__ __device__ __forceinline__ int lds_byte(int r, int c) { const int st = (r >> 4) * 2 + (c >> 5), rr = r & 15, cc = c & 31, ob = rr * 64 + cc * 2; return st * 1024 + (ob ^ (((ob >> 9) & 1) << 5)); }
__host__ __device__ __forceinline__ void stage_rc(int b, int& R, int& C) { const int st = b / 1024, sb = b % 1024, swz = sb ^ (((sb >> 9) & 1) << 5); R = (st >> 1) * 16 + swz / 64; C = (st & 1) * 32 + (swz % 64) / 2; }
__host__ __device__ __forceinline__ int perm32(int rho) { const int n = rho >> 4, i = rho & 15; return 8 * (i >> 2) + 4 * n + (i & 3); }

struct Unit { int pm, pn; };
struct Gemm { const bf16_t* A; const bf16_t* Bt; int M, N, K; };

struct StaticOrder {
    int nM, nN, nwg, G, c;
    __host__ __device__ void init(int M, int N, int G_, int c_) { nM = M / BM; nN = N / BM; nwg = nM * nN; G = G_; c = c_; }
    __host__ __device__ bool next(int i, Unit& u) const {
        const long L = (long)i * G + c; if (L >= nwg) return false;
        int wgid = (int)L; { const int q = nwg / NXCD, r = nwg % NXCD, xcd = wgid % NXCD, off = wgid / NXCD; wgid = (xcd < r ? xcd * (q + 1) : r * (q + 1) + (xcd - r) * q) + off; }
        const int nig = WGM * nN, gid = wgid / nig, fm = gid * WGM, gsz = (nM - fm) < WGM ? (nM - fm) : WGM;
        u.pm = fm + ((wgid % nig) % gsz); u.pn = (wgid % nig) / gsz; return true;
    }
    __device__ __forceinline__ void a_ready(const Unit&) const {}
    __device__ __forceinline__ void done(const Unit&) const {}
};

__device__ __forceinline__ unsigned cvt_pk_bf16(float lo, float hi) { unsigned r; asm volatile("v_cvt_pk_bf16_f32 %0, %1, %2" : "=v"(r) : "v"(lo), "v"(hi)); return r; }
__device__ __forceinline__ float relu_sq(float x) { float r; asm volatile("v_max_f32 %0, 0, %1" : "=v"(r) : "v"(x)); return r * r; }
template <int ACT  > struct EpiBf16 {
    static constexpr bool PERM = true, AFTER_DRAIN = false;
    bf16_t* O; int ldc;
    __device__ __forceinline__ void operator()(const f32x4 (&acc)[2][2][4][2], const Unit& u, int wr, int wc, int fr, int fq) const {
        const int row0 = u.pm * BM + wr * 64 + fr; const int col0 = u.pn * BM + wc * 32 + 8 * fq;
#pragma unroll
        for (int ai = 0; ai < 2; ++ai)
#pragma unroll
            for (int m = 0; m < 4; ++m) { bf16_t* rowp = O + (size_t)(row0 + ai * HALF + m * 16) * ldc + col0;
#pragma unroll
                for (int bj = 0; bj < 2; ++bj) { f32x4 v0 = acc[ai][bj][m][0], v1 = acc[ai][bj][m][1];
                    if (ACT == 1) {
#pragma unroll
                        for (int e = 0; e < 4; ++e) { v0[e] = relu_sq(v0[e]); v1[e] = relu_sq(v1[e]); } }
                    u32x4 w; w.x = cvt_pk_bf16(v0[0], v0[1]); w.y = cvt_pk_bf16(v0[2], v0[3]); w.z = cvt_pk_bf16(v1[0], v1[1]); w.w = cvt_pk_bf16(v1[2], v1[3]);
                    *(u32x4*)(rowp + bj * HALF) = w; } }
    }
};

template <class Epi, class Sched, bool ALIGN_EPI = false, bool SP2 = false>
__device__ __forceinline__ void gemm_phase(PG8_LAS unsigned char* lds, const Gemm g, const Sched& S, const Epi& E, const int tid) {
    const int wid = __builtin_amdgcn_readfirstlane(tid >> 6), lane = tid & 63, wr = wid >> 2, wc = wid & 3, fr = lane & 15, fq = lane >> 4;
    const int K = g.K, nt = K / BK;
    unsigned voffA[2], voffB[2];
#pragma unroll
    for (int i = 0; i < 2; ++i) { int R, C; stage_rc(tid * 16 + i * 8192, R, C); const int Rb = Epi::PERM ? ((R & ~31) + perm32(R & 31)) : R;
        voffA[i] = (unsigned)(R * K + C) * 2u; voffB[i] = (unsigned)(Rb * K + C) * 2u; }
    const size_t kstep = (size_t)(BK * 2);
    const size_t hstep = (size_t)HALF * K * 2;
    const size_t tstep = 2 * hstep;
    const unsigned ldsw = (unsigned)wid * 1024u;
    const int aoff = lds_byte(wr * 64 + fr, fq * 8), boff = lds_byte(wc * 32 + fr, fq * 8);
#define PG8_SA(b, h) (((b) * 2 + (h)) * HTB)
#define PG8_SB(b, h) ((4 + (b) * 2 + (h)) * HTB)
#define PG8_STAGE(bufoff, gbase, voff) do { _Pragma("unroll") for (int _i = 0; _i < 2; ++_i) \
        __builtin_amdgcn_global_load_lds((const unsigned*)((const char*)(gbase) + (voff)[_i]), (PG8_LAS unsigned*)(lds + (bufoff) + ldsw + _i * 8192), 16, 0, 0); } while (0)
#define PG8_LDA(dst, b, h) do { _Pragma("unroll") for (int m = 0; m < 4; ++m) _Pragma("unroll") for (int k = 0; k < 2; ++k) dst[m][k] = *(const PG8_LAS bf16x8*)(lds + PG8_SA(b, h) + aoff + m * 2048 + k * 1024); } while (0)
#define PG8_LDB(dst, b, h) do { _Pragma("unroll") for (int n = 0; n < 2; ++n) _Pragma("unroll") for (int k = 0; k < 2; ++k) dst[n][k] = *(const PG8_LAS bf16x8*)(lds + PG8_SB(b, h) + boff + n * 2048 + k * 1024); } while (0)
#define PG8_MMA(ai, bj, At, Bt) do { __builtin_amdgcn_s_setprio(1); _Pragma("unroll") for (int m = 0; m < 4; ++m) _Pragma("unroll") for (int n = 0; n < 2; ++n) _Pragma("unroll") for (int k = 0; k < 2; ++k) \
        acc[ai][bj][m][n] = __builtin_amdgcn_mfma_f32_16x16x32_bf16(Bt[n][k], At[m][k], acc[ai][bj][m][n], 0, 0, 0); __builtin_amdgcn_s_setprio(0); } while (0)
#define PG8_WAIT_V(n) asm volatile("s_waitcnt vmcnt(" #n ")" ::: "memory")
#define PG8_WAIT_L(n) asm volatile("s_waitcnt lgkmcnt(" #n ")" ::: "memory")
#define PG8_BAR __builtin_amdgcn_s_barrier()
#define PG8_SCHED __builtin_amdgcn_sched_barrier(0)
    Unit cur, nxt; int ui = 0;
    if (!S.next(0, cur)) return;
    f32x4 acc[2][2][4][2];
#pragma unroll
    for (int a = 0; a < 2; ++a)
#pragma unroll
        for (int b = 0; b < 2; ++b)
#pragma unroll
            for (int m = 0; m < 4; ++m)
#pragma unroll
                for (int n = 0; n < 2; ++n) acc[a][b][m][n] = (f32x4){0.f, 0.f, 0.f, 0.f};
    bf16x8 At[4][2], B0[2][2], B1[2][2];
    const char* cA = (const char*)g.A + (size_t)cur.pm * tstep; const char* cB = (const char*)g.Bt + (size_t)cur.pn * tstep;
    S.a_ready(cur);
    if constexpr (SP2) {
        PG8_STAGE(PG8_SB(0, 0), cB, voffB); PG8_STAGE(PG8_SB(0, 1), cB + hstep, voffB); PG8_STAGE(PG8_SA(0, 0), cA, voffA); PG8_STAGE(PG8_SA(0, 1), cA + hstep, voffA);
        if (wr == 1) PG8_BAR;
        PG8_WAIT_V(2); PG8_BAR;
        PG8_STAGE(PG8_SB(1, 0), cB + kstep, voffB); PG8_STAGE(PG8_SA(1, 0), cA + kstep, voffA); PG8_STAGE(PG8_SB(1, 1), cB + hstep + kstep, voffB);
        PG8_WAIT_V(6); PG8_BAR;
    } else {
        PG8_STAGE(PG8_SB(0, 0), cB, voffB); PG8_STAGE(PG8_SA(0, 0), cA, voffA); PG8_STAGE(PG8_SB(0, 1), cB + hstep, voffB); PG8_STAGE(PG8_SA(0, 1), cA + hstep, voffA);
        if (wr == 1) PG8_BAR;
        PG8_WAIT_V(4); PG8_BAR;
        PG8_STAGE(PG8_SB(1, 0), cB + kstep, voffB); PG8_STAGE(PG8_SA(1, 0), cA + kstep, voffA); PG8_STAGE(PG8_SB(1, 1), cB + hstep + kstep, voffB);
        PG8_WAIT_V(6); PG8_BAR;
    }
    for (;;) {
        const bool has_next = S.next(ui + 1, nxt);
        const char* nA = has_next ? (const char*)g.A + (size_t)nxt.pm * tstep : cA; const char* nB = has_next ? (const char*)g.Bt + (size_t)nxt.pn * tstep : cB;
        for (int t = 0; t < nt; t += 2) {
            const bool last = (t == nt - 2);
            const char* a1 = cA + (size_t)(t + 1) * kstep;
            const char* a2 = last ? nA : cA + (size_t)(t + 2) * kstep; const char* b2 = last ? nB : cB + (size_t)(t + 2) * kstep;
            const char* a3 = a2 + kstep; const char* b3 = b2 + kstep;
            if (last && has_next) S.a_ready(nxt);
            if constexpr (SP2) {
            PG8_LDB(B0, 0, 0); PG8_LDB(B1, 0, 1); PG8_SCHED; PG8_LDA(At, 0, 0); PG8_STAGE(PG8_SA(1, 1), a1 + hstep, voffA);
            PG8_WAIT_V(8); PG8_WAIT_L(0); PG8_BAR; PG8_MMA(0, 0, At, B0); PG8_MMA(0, 1, At, B1); PG8_BAR; PG8_SCHED;
            PG8_LDA(At, 0, 1); PG8_STAGE(PG8_SB(0, 0), b2, voffB); PG8_STAGE(PG8_SB(0, 1), b2 + hstep, voffB); PG8_STAGE(PG8_SA(0, 0), a2, voffA);
            PG8_WAIT_V(8); PG8_WAIT_L(0); PG8_BAR; PG8_MMA(1, 0, At, B0); PG8_MMA(1, 1, At, B1); PG8_BAR; PG8_SCHED;
            PG8_LDB(B0, 1, 0); PG8_LDB(B1, 1, 1); PG8_SCHED; PG8_LDA(At, 1, 0); PG8_STAGE(PG8_SA(0, 1), a2 + hstep, voffA);
            PG8_WAIT_V(8); PG8_WAIT_L(0); PG8_BAR; PG8_MMA(0, 0, At, B0); PG8_MMA(0, 1, At, B1); PG8_BAR; PG8_SCHED;
            PG8_LDA(At, 1, 1); PG8_STAGE(PG8_SB(1, 0), b3, voffB); PG8_STAGE(PG8_SB(1, 1), b3 + hstep, voffB); PG8_STAGE(PG8_SA(1, 0), a3, voffA);
            PG8_WAIT_V(8); PG8_WAIT_L(0); PG8_BAR; PG8_MMA(1, 0, At, B0); PG8_MMA(1, 1, At, B1); PG8_BAR; PG8_SCHED;
            } else {
            PG8_LDB(B0, 0, 0); PG8_SCHED; PG8_LDA(At, 0, 0); PG8_STAGE(PG8_SA(1, 1), a1 + hstep, voffA);
            PG8_WAIT_L(8); PG8_BAR; PG8_WAIT_L(0); PG8_MMA(0, 0, At, B0); PG8_BAR; PG8_SCHED;
            PG8_LDB(B1, 0, 1); PG8_STAGE(PG8_SB(0, 0), b2, voffB);
            PG8_BAR; PG8_WAIT_L(0); PG8_MMA(0, 1, At, B1); PG8_BAR;
            PG8_LDA(At, 0, 1); PG8_STAGE(PG8_SA(0, 0), a2, voffA);
            PG8_BAR; PG8_WAIT_L(0); PG8_MMA(1, 0, At, B0); PG8_BAR; PG8_SCHED;
            PG8_STAGE(PG8_SB(0, 1), b2 + hstep, voffB);
            PG8_WAIT_V(6); PG8_BAR; PG8_MMA(1, 1, At, B1); PG8_BAR;
            PG8_LDB(B0, 1, 0); PG8_SCHED; PG8_LDA(At, 1, 0); PG8_STAGE(PG8_SA(0, 1), a2 + hstep, voffA);
            PG8_WAIT_L(8); PG8_BAR; PG8_WAIT_L(0); PG8_MMA(0, 0, At, B0); PG8_BAR; PG8_SCHED;
            PG8_LDB(B1, 1, 1); PG8_STAGE(PG8_SB(1, 0), b3, voffB);
            PG8_BAR; PG8_WAIT_L(0); PG8_MMA(0, 1, At, B1); PG8_BAR;
            PG8_LDA(At, 1, 1); PG8_STAGE(PG8_SA(1, 0), a3, voffA);
            PG8_BAR; PG8_WAIT_L(0); PG8_MMA(1, 0, At, B0); PG8_BAR; PG8_SCHED;
            PG8_STAGE(PG8_SB(1, 1), b3 + hstep, voffB);
            PG8_WAIT_V(6); PG8_BAR; PG8_MMA(1, 1, At, B1); PG8_BAR;
            }
        }
        if constexpr (ALIGN_EPI) { if (wr == 0) PG8_BAR; }
        if constexpr (!Epi::AFTER_DRAIN) { E(acc, cur, wr, wc, fr, fq); S.done(cur); }
        if (!has_next) break;
#pragma unroll
        for (int a = 0; a < 2; ++a)
#pragma unroll
            for (int b = 0; b < 2; ++b)
#pragma unroll
                for (int m = 0; m < 4; ++m)
#pragma unroll
                    for (int n = 0; n < 2; ++n) acc[a][b][m][n] = (f32x4){0.f, 0.f, 0.f, 0.f};
        cur = nxt; cA = nA; cB = nB; ++ui;
        if constexpr (ALIGN_EPI) { if (wr == 1) PG8_BAR; }
    }
    PG8_WAIT_V(0);
    if constexpr (!ALIGN_EPI) { if (wr == 0) PG8_BAR; }
    PG8_BAR;
    if constexpr (Epi::AFTER_DRAIN) { E.fused(acc, cur, wr, wc, fr, fq, lds, wid, lane); S.done(cur); }
#undef PG8_SA
#undef PG8_SB
#undef PG8_STAGE
#undef PG8_LDA
#undef PG8_LDB
#undef PG8_MMA
#undef PG8_WAIT_V
#undef PG8_WAIT_L
#undef PG8_BAR
#undef PG8_SCHED
}
}

namespace cg = cooperative_groups;
#define LAS __attribute__((address_space(3)))
typedef unsigned short bf16;
typedef unsigned v4u __attribute__((ext_vector_type(4)));
typedef unsigned v2u __attribute__((ext_vector_type(2)));
typedef float f32x4 __attribute__((ext_vector_type(4)));
typedef short bf16x8 __attribute__((ext_vector_type(8)));

constexpr int NWAVES = 8;
constexpr int DM = 1024, FF = 4096, INW = 2048, GW = 256;
constexpr int MP = 16384, MS = 512, MT = MP + MS;
constexpr int SEQ = 2048, NBP = 8, NSB = 128, ST = 4, DEPTH = 2;
constexpr float EPS = 1e-6f;
constexpr size_t MiB = 1u << 20;
constexpr size_t WS_SGUW = 1 * MiB;
constexpr size_t WS_W = 2 * MiB, W_LAYER = 22 * MiB, W_IN = 0, W_OUT = 4 * MiB, W_UP = 6 * MiB, W_DN = 14 * MiB;
constexpr size_t WS_XN = 46 * MiB, WS_O = 79 * MiB, WS_H = 112 * MiB, WS_Z = 112 * MiB, WS_CAT = 178 * MiB, WS_END = 244 * MiB;
constexpr int LDS_BYTES = 147456;
constexpr int MISC_OFF = LDS_BYTES - 256;
constexpr size_t WS_CTL = 0, CTL_ZERO_BYTES = 64 * 1024;
constexpr int WAVE_SCR = 17408;
constexpr size_t OUT_Y = 0;
constexpr size_t OUT_POOL_P = (size_t)MT * DM;
constexpr size_t OUT_POOL_S = OUT_POOL_P + (size_t)DEPTH * NBP * 15 * GW;
constexpr size_t OUT_CONV_P = OUT_POOL_S + (size_t)DEPTH * NSB * 15 * GW;
constexpr size_t OUT_CONV_S = OUT_CONV_P + (size_t)DEPTH * NBP * 30 * GW;
constexpr size_t OUT_SHORT_P = OUT_CONV_S + (size_t)DEPTH * NSB * 30 * GW;
constexpr size_t OUT_SHORT_S = OUT_SHORT_P + (size_t)DEPTH * NBP * 2 * GW;
constexpr size_t OUT_V_S = OUT_SHORT_S + (size_t)DEPTH * NSB * 2 * GW;
constexpr size_t OUT_END = OUT_V_S + (size_t)DEPTH * NSB * ST * GW;

__device__ __forceinline__ float bf2f(bf16 b) { return __uint_as_float(((unsigned)b) << 16); }
__device__ __forceinline__ unsigned f2bf(float f) { unsigned u = __float_as_uint(f); return (u + 0x7fffu + ((u >> 16) & 1u)) >> 16; }
__device__ __forceinline__ unsigned pk2(float lo, float hi) { return f2bf(lo) | (f2bf(hi) << 16); }
template <int CTRL, int ROWMASK> __device__ __forceinline__ float dpp_get(float v) { return __int_as_float(__builtin_amdgcn_update_dpp(0, __float_as_int(v), CTRL, ROWMASK, 0xF, false)); }
__device__ __forceinline__ float sum8(float v) { v += dpp_get<0xB1, 0xF>(v); v += dpp_get<0x4E, 0xF>(v); v += dpp_get<0x141, 0xF>(v); return v; }
__device__ __forceinline__ float wave_sum(float v) {
    v = sum8(v); v += dpp_get<0x140, 0xF>(v); v += dpp_get<0x142, 0xA>(v); v += dpp_get<0x143, 0xC>(v);
    return __int_as_float(__builtin_amdgcn_readlane(__float_as_int(v), 63));
}
__device__ __forceinline__ void unpack8(const v4u w, float (&f)[8]) {
    f[0] = __uint_as_float(w.x << 16); f[1] = __uint_as_float(w.x & 0xffff0000u); f[2] = __uint_as_float(w.y << 16); f[3] = __uint_as_float(w.y & 0xffff0000u);
    f[4] = __uint_as_float(w.z << 16); f[5] = __uint_as_float(w.z & 0xffff0000u); f[6] = __uint_as_float(w.w << 16); f[7] = __uint_as_float(w.w & 0xffff0000u); }
__device__ __forceinline__ v4u pack8(const float (&f)[8]) { v4u w; w.x = pg8::cvt_pk_bf16(f[0], f[1]); w.y = pg8::cvt_pk_bf16(f[2], f[3]); w.z = pg8::cvt_pk_bf16(f[4], f[5]); w.w = pg8::cvt_pk_bf16(f[6], f[7]); return w; }
__device__ __forceinline__ v4u ld16(const bf16* p) { return *(const v4u*)p; }
__device__ __forceinline__ float sigm(float x) { return 1.f / (1.f + __expf(-x)); }
#define LDS_WAIT() asm volatile("s_waitcnt lgkmcnt(0)" ::: "memory")

__device__ __forceinline__ void transpose_item(const float* __restrict__ W, int K, int N, bf16* __restrict__ WT, const float* __restrict__ gk, LAS float* scr, int item, int lane) {
    const int nblk = N / 32, kb = item / nblk, nb = item % nblk, k0 = 64 * kb, n0 = 32 * nb;
#pragma unroll 8
    for (int i = 0; i < 32; ++i) { const int kk = 2 * i + (lane >> 5); float v = W[(size_t)(k0 + kk) * N + n0 + (lane & 31)]; if (gk) v *= gk[k0 + kk]; scr[kk * 33 + (lane & 31)] = v; }
    LDS_WAIT();
    const int c = lane & 7;
#pragma unroll
    for (int j = 0; j < 4; ++j) { const int n = (lane >> 3) + 8 * j; const LAS float* s = scr + (8 * c) * 33 + n;
        v4u o; o.x = pk2(s[0 * 33], s[1 * 33]); o.y = pk2(s[2 * 33], s[3 * 33]); o.z = pk2(s[4 * 33], s[5 * 33]); o.w = pk2(s[6 * 33], s[7 * 33]);
        *(v4u*)(WT + (size_t)(n0 + n) * K + k0 + 8 * c) = o; }
    LDS_WAIT();
}
struct TrDesc { const float* W; bf16* WT; const float* gk; int K, N, k0, n0; };
__device__ __forceinline__ void tr_load(float (&v)[32], const TrDesc& d, int lane) {
    const float* p = d.W + (size_t)(d.k0 + (lane >> 5)) * d.N + d.n0 + (lane & 31);
#pragma unroll
    for (int i = 0; i < 32; ++i) v[i] = p[(size_t)(2 * i) * d.N];
}
__device__ __forceinline__ void tr_store(const float (&v)[32], const TrDesc& d, LAS float* scr, int lane) {
#pragma unroll
    for (int i = 0; i < 32; ++i) { const int kk = 2 * i + (lane >> 5); float x = v[i]; if (d.gk) x *= d.gk[d.k0 + kk]; scr[kk * 33 + (lane & 31)] = x; }
    LDS_WAIT();
    const int c = lane & 7;
#pragma unroll
    for (int j = 0; j < 4; ++j) { const int n = (lane >> 3) + 8 * j; const LAS float* s = scr + (8 * c) * 33 + n;
        v4u o; o.x = pg8::cvt_pk_bf16(s[0 * 33], s[1 * 33]); o.y = pg8::cvt_pk_bf16(s[2 * 33], s[3 * 33]); o.z = pg8::cvt_pk_bf16(s[4 * 33], s[5 * 33]); o.w = pg8::cvt_pk_bf16(s[6 * 33], s[7 * 33]);
        *(v4u*)(d.WT + (size_t)(d.n0 + n) * d.K + d.k0 + 8 * c) = o; }
    LDS_WAIT();
}
__device__ __forceinline__ void fold_item(const float* __restrict__ W, bf16* __restrict__ WT, const float* __restrict__ wp, const float* __restrict__ ps, LAS float* scr, int item, int lane) {
    const int K = DM, N = DM; const int nblk = N / 32, g = item / nblk, nb = item % nblk, k0 = 64 * g, n0 = 32 * nb;
    LAS float* scr2 = scr + 64 * 33;
#pragma unroll 8
    for (int i = 0; i < 32; ++i) { const int kk = 2 * i + (lane >> 5); scr[kk * 33 + (lane & 31)] = W[(size_t)(k0 + kk) * N + n0 + (lane & 31)] * ps[k0 + kk]; }
    LDS_WAIT();
    const int n = lane & 31;
    for (int i = 0; i < 32; ++i) { const int kk = 2 * i + (lane >> 5); const float* wr = wp + (size_t)(g * 64 + kk) * 64; float a = 0.f;
#pragma unroll 16
        for (int d = 0; d < 64; ++d) a += wr[d] * scr[d * 33 + n];
        scr2[kk * 33 + n] = a; }
    LDS_WAIT();
    const int c = lane & 7;
#pragma unroll
    for (int j = 0; j < 4; ++j) { const int nn = (lane >> 3) + 8 * j; const LAS float* s = scr2 + (8 * c) * 33 + nn;
        v4u o; o.x = pk2(s[0 * 33], s[1 * 33]); o.y = pk2(s[2 * 33], s[3 * 33]); o.z = pk2(s[4 * 33], s[5 * 33]); o.w = pk2(s[6 * 33], s[7 * 33]);
        *(v4u*)(WT + (size_t)(n0 + nn) * K + k0 + 8 * c) = o; }
    LDS_WAIT();
}
__device__ __forceinline__ void rms_row_to_bf16(const float* __restrict__ xrow, bf16* __restrict__ orow, int lane) {
    const f32x4* xr = (const f32x4*)xrow + lane;
    f32x4 v[4]; float s = 0.f;
#pragma unroll
    for (int j = 0; j < 4; ++j) { v[j] = xr[64 * j]; s += (v[j].x * v[j].x + v[j].y * v[j].y) + (v[j].z * v[j].z + v[j].w * v[j].w); }
    const float rstd = rsqrtf(wave_sum(s) * (1.f / DM) + EPS);
    v2u* o8 = (v2u*)orow + lane;
#pragma unroll
    for (int j = 0; j < 4; ++j) { v2u o; o.x = pk2(v[j].x * rstd, v[j].y * rstd); o.y = pk2(v[j].z * rstd, v[j].w * rstd); o8[64 * j] = o; }
}
struct EwRow { f32x4 x[4]; v2u o[4]; };
__device__ __forceinline__ void ew_load(EwRow& r, const float* __restrict__ xrow, const bf16* __restrict__ orow, int lane) {
    const f32x4* xr = (const f32x4*)xrow + lane; const v2u* orr = (const v2u*)orow + lane;
#pragma unroll
    for (int j = 0; j < 4; ++j) { r.x[j] = xr[64 * j]; r.o[j] = orr[64 * j]; }
}
__device__ __forceinline__ void ew_finish(EwRow& r, const f32x4 (&gg)[4], float* __restrict__ Xrow, bf16* __restrict__ xnrow, bool write_xn, int lane) {
    f32x4 o[4]; float so = 0.f;
#pragma unroll
    for (int j = 0; j < 4; ++j) { const v2u w = r.o[j];
        o[j].x = __uint_as_float(w.x << 16); o[j].y = __uint_as_float(w.x & 0xffff0000u); o[j].z = __uint_as_float(w.y << 16); o[j].w = __uint_as_float(w.y & 0xffff0000u);
        so += (o[j].x * o[j].x + o[j].y * o[j].y) + (o[j].z * o[j].z + o[j].w * o[j].w); }
    const float rs = rsqrtf(wave_sum(so) * (1.f / DM) + EPS); float s1 = 0.f;
    f32x4* Xr = (f32x4*)Xrow + lane;
#pragma unroll
    for (int j = 0; j < 4; ++j) { f32x4 x = r.x[j] + o[j] * rs * gg[j]; r.x[j] = x; s1 += (x.x * x.x + x.y * x.y) + (x.z * x.z + x.w * x.w); Xr[64 * j] = x; }
    if (write_xn) { const float r1 = rsqrtf(wave_sum(s1) * (1.f / DM) + EPS); v2u* o8 = (v2u*)xnrow + lane;
#pragma unroll
        for (int j = 0; j < 4; ++j) { v2u w; w.x = pg8::cvt_pk_bf16(r.x[j].x * r1, r.x[j].y * r1); w.y = pg8::cvt_pk_bf16(r.x[j].z * r1, r.x[j].w * r1); o8[64 * j] = w; } }
}

template <bool SAMPLE>
__device__ __forceinline__ void pool_unit(const bf16* __restrict__ Z, bf16* __restrict__ CAT, const float* __restrict__ state, float* __restrict__ newp,
                                          int seq, int t0, int nrows, int g, int lane) {
    const int c = g * 64 + lane, w = 2 << g;
    const size_t rowbase = SAMPLE ? (size_t)MP + (size_t)seq * ST : (size_t)seq * SEQ;
    const bf16* zc = Z + rowbase * INW + c;
    const float* st = state + (size_t)seq * 15 * GW + c;
#define POOL_A(e) ((e) >= 0 ? bf2f(zc[(size_t)(e) * INW]) : (SAMPLE ? st[(15 + (e)) * GW] : 0.f))
    float S = 0.f;
    for (int j = 1; j < w; ++j) S += POOL_A(t0 - j);
#pragma unroll 4
    for (int t = t0; t < t0 + nrows; ++t) {
        const float a = POOL_A(t); S += a;
        const float cnt = SAMPLE ? (float)w : (float)(t + 1 < w ? t + 1 : w);
        CAT[(rowbase + t) * DM + c] = (bf16)f2bf(S / cnt - a);
        const int e = t - w + 1; S -= POOL_A(e);
    }
    const int T = SAMPLE ? ST : SEQ;
    if (t0 + nrows == T) {
        for (int j = 0; j < 15; ++j) { const int e = T - 15 + j; newp[((size_t)seq * 15 + j) * GW + c] = POOL_A(e); }
    }
#undef POOL_A
}
template <bool SAMPLE>
__device__ __forceinline__ void short_unit(const bf16* __restrict__ Z, bf16* __restrict__ CAT, const float* __restrict__ state, float* __restrict__ news,
                                           const float* __restrict__ sw, int seq, int t0, int nrows, int h, int lane) {
    const int c = h * 64 + lane;
    const size_t rowbase = SAMPLE ? (size_t)MP + (size_t)seq * ST : (size_t)seq * SEQ;
    const bf16* zc = Z + rowbase * INW + c;
    const float* st = state + (size_t)seq * 2 * GW + c;
    const float w0 = sw[c], w1 = sw[GW + c], w2 = sw[2 * GW + c];
#define SH_E(e) ((e) >= 0 ? bf2f(zc[(size_t)(e) * INW + 1536]) * bf2f(zc[(size_t)(e) * INW + 1792]) : (SAMPLE ? st[(2 + (e)) * GW] : 0.f))
    float e2 = SH_E(t0 - 2), e1 = SH_E(t0 - 1);
#pragma unroll 4
    for (int t = t0; t < t0 + nrows; ++t) {
        const float e0 = SH_E(t); const float bg = bf2f(zc[(size_t)t * INW + 1280]);
        CAT[(rowbase + t) * DM + 768 + c] = (bf16)f2bf(bg * (w0 * e2 + w1 * e1 + w2 * e0));
        e2 = e1; e1 = e0;
    }
    const int T = SAMPLE ? ST : SEQ;
    if (t0 + nrows == T) { news[((size_t)seq * 2 + 0) * GW + c] = e2; news[((size_t)seq * 2 + 1) * GW + c] = e1; }
#undef SH_E
}
template <bool SAMPLE>
__device__ __forceinline__ void conv_unit(const bf16* __restrict__ Z, bf16* __restrict__ CAT, const float* __restrict__ state, float* __restrict__ newc,
                                          const float* __restrict__ cw, const float* __restrict__ cb, const float* __restrict__ lg, const float* __restrict__ lb,
                                          int seq, int t0, int nrows, int h, LAS float* gL, int lane) {
    const int c = h * 64 + lane;
    const size_t rowbase = SAMPLE ? (size_t)MP + (size_t)seq * ST : (size_t)seq * SEQ;
    const bf16* zc = Z + rowbase * INW + c;
    bf16* oc = CAT + rowbase * DM + 256 + c;
    const int T = SAMPLE ? ST : SEQ;
    const bool last = (t0 + nrows == T);
    const int nin = nrows + 30;
#pragma unroll 4
    for (int r = 0; r < nin; ++r) { const int s = t0 - 30 + r; float gs = 0.f;
        if (s >= 0) { const unsigned off = (unsigned)s * INW; const float p = bf2f(zc[off + 256]), gt = bf2f(zc[off + 512]); gs = p * sigm(gt); }
        else if (SAMPLE) gs = state[((size_t)seq * 30 + 30 + s) * GW + c];
        if (last && s >= T - 30) newc[((size_t)seq * 30 + (s - (T - 30))) * GW + c] = gs;
        gL[r * 64 + lane] = gs; }
    LDS_WAIT();
    float wk[31];
#pragma unroll
    for (int k = 0; k < 31; ++k) wk[k] = cw[k * GW + c];
    const float bias = cb[c], gg = lg[c], bb = lb[c];
#pragma unroll 1
    for (int tq = 0; tq < nrows; tq += 4) {
        float acc[4] = {bias, bias, bias, bias};
#pragma unroll
        for (int r = 0; r < 34; ++r) { const float gv = gL[(tq + r) * 64 + lane];
#pragma unroll
            for (int q = 0; q < 4; ++q) { const int k = r - q; if (k >= 0 && k <= 30) acc[q] += wk[k] * gv; } }
#pragma unroll
        for (int q = 0; q < 4; ++q) { const float cv = acc[q];
            const float mean = wave_sum(cv) * (1.f / 64.f); const float d = cv - mean;
            const float var = wave_sum(d * d) * (1.f / 64.f);
            const float y = d * rsqrtf(var + EPS) * gg + bb;
            oc[(unsigned)(t0 + tq + q) * DM] = (bf16)f2bf(y * sigm(y)); }
    }
    LDS_WAIT();
}
template <int W>
__device__ __forceinline__ void pool_unit_p(const bf16* __restrict__ Z, bf16* __restrict__ CAT, float* __restrict__ newp, int seq, int t0, int g, int lane) {
    const int rr = lane >> 3, cg = lane & 7, c0 = g * 64 + cg * 8, tb = t0 + rr * 8;
    const size_t rowbase = (size_t)seq * SEQ;
    const bf16* zb = Z + (rowbase + tb) * INW + c0;
    v4u raw[W + 7];
#pragma unroll
    for (int j = 0; j < W + 7; ++j) { const int dj = j - (W - 1); raw[j] = (tb + dj >= 0) ? ld16(zb + (long)dj * INW) : (v4u){0u, 0u, 0u, 0u}; }
    float S[8];
#pragma unroll
    for (int i = 0; i < 8; ++i) S[i] = 0.f;
#pragma unroll
    for (int j = 0; j < W - 1; ++j) { float f[8]; unpack8(raw[j], f);
#pragma unroll
        for (int i = 0; i < 8; ++i) S[i] += f[i]; }
    bf16* ob = CAT + (rowbase + tb) * DM + c0;
    const bool lastseg = (t0 + 64 == SEQ);
#pragma unroll
    for (int j = 0; j < 8; ++j) { float a[8], o[8], od[8]; unpack8(raw[j + W - 1], a); unpack8(raw[j], od);
        const int t = tb + j; const float inv = 1.f / (float)(t + 1 < W ? t + 1 : W);
#pragma unroll
        for (int i = 0; i < 8; ++i) { S[i] += a[i]; o[i] = S[i] * inv - a[i]; S[i] -= od[i]; }
        *(v4u*)(ob + j * DM) = pack8(o);
        if (lastseg && t >= SEQ - 15) { float* np = newp + ((size_t)seq * 15 + (t - (SEQ - 15))) * GW + c0; *(f32x4*)np = (f32x4){a[0], a[1], a[2], a[3]}; *(f32x4*)(np + 4) = (f32x4){a[4], a[5], a[6], a[7]}; }
    }
}
__device__ __forceinline__ void short_unit_p(const bf16* __restrict__ Z, bf16* __restrict__ CAT, float* __restrict__ news, const float* __restrict__ sw, int seq, int t0, int h, int lane) {
    const int rr = lane >> 3, cg = lane & 7, c0 = h * 64 + cg * 8, tb = t0 + rr * 8;
    const size_t rowbase = (size_t)seq * SEQ;
    const bf16* zb = Z + (rowbase + tb) * INW + c0;
    v4u Bv[8], Cv[10], Hv[10];
#pragma unroll
    for (int j = 0; j < 10; ++j) { const int dj = j - 2; const bool ok = (tb + dj >= 0);
        Cv[j] = ok ? ld16(zb + (long)dj * INW + 1536) : (v4u){0u, 0u, 0u, 0u}; Hv[j] = ok ? ld16(zb + (long)dj * INW + 1792) : (v4u){0u, 0u, 0u, 0u};
        if (j >= 2) Bv[j - 2] = ld16(zb + (long)dj * INW + 1280); }
    float w0[8], w1[8], w2[8];
#pragma unroll
    for (int i = 0; i < 8; ++i) { w0[i] = sw[c0 + i]; w1[i] = sw[GW + c0 + i]; w2[i] = sw[2 * GW + c0 + i]; }
    float e2[8], e1[8];
    { float c[8], hh[8]; unpack8(Cv[0], c); unpack8(Hv[0], hh);
#pragma unroll
      for (int i = 0; i < 8; ++i) e2[i] = c[i] * hh[i];
      unpack8(Cv[1], c); unpack8(Hv[1], hh);
#pragma unroll
      for (int i = 0; i < 8; ++i) e1[i] = c[i] * hh[i]; }
    bf16* ob = CAT + (rowbase + tb) * DM + 768 + c0;
#pragma unroll
    for (int j = 0; j < 8; ++j) { float c[8], hh[8], b[8], o[8]; unpack8(Cv[j + 2], c); unpack8(Hv[j + 2], hh); unpack8(Bv[j], b);
#pragma unroll
        for (int i = 0; i < 8; ++i) { const float e0 = c[i] * hh[i]; o[i] = b[i] * (w0[i] * e2[i] + w1[i] * e1[i] + w2[i] * e0); e2[i] = e1[i]; e1[i] = e0; }
        *(v4u*)(ob + j * DM) = pack8(o); }
    if (t0 + 64 == SEQ && rr == 7) { float* np = news + (size_t)seq * 2 * GW + c0;
        *(f32x4*)np = (f32x4){e2[0], e2[1], e2[2], e2[3]}; *(f32x4*)(np + 4) = (f32x4){e2[4], e2[5], e2[6], e2[7]};
        *(f32x4*)(np + GW) = (f32x4){e1[0], e1[1], e1[2], e1[3]}; *(f32x4*)(np + GW + 4) = (f32x4){e1[4], e1[5], e1[6], e1[7]}; }
}
__device__ __forceinline__ void conv_unit_p(const bf16* __restrict__ Z, bf16* __restrict__ CAT, float* __restrict__ newc,
                                            const float* __restrict__ cw, const float* __restrict__ cb, const float* __restrict__ lg, const float* __restrict__ lb,
                                            int seq, int t0, int h, LAS float* gL, int lane) {
    const int rr = lane >> 3, cg = lane & 7, c0 = h * 64 + cg * 8;
    const size_t rowbase = (size_t)seq * SEQ;
    const bool last = (t0 + 32 == SEQ);
    { v4u pv[8], gv[8];
#pragma unroll
      for (int j = 0; j < 8; ++j) { const int r = 8 * j + rr, sx = t0 - 30 + r; const bool ok = (sx >= 0 && r < 62);
          const bf16* zp = Z + (rowbase + (ok ? sx : 0)) * INW + c0;
          pv[j] = ok ? ld16(zp + 256) : (v4u){0u, 0u, 0u, 0u}; gv[j] = ok ? ld16(zp + 512) : (v4u){0u, 0u, 0u, 0u}; }
#pragma unroll
      for (int j = 0; j < 8; ++j) { const int r = 8 * j + rr, sx = t0 - 30 + r; float p[8], gt[8]; unpack8(pv[j], p); unpack8(gv[j], gt);
#pragma unroll
          for (int i = 0; i < 8; ++i) p[i] = p[i] * sigm(gt[i]);
          if (r < 62) { *(LAS f32x4*)(gL + r * 64 + cg * 8) = (f32x4){p[0], p[1], p[2], p[3]}; *(LAS f32x4*)(gL + r * 64 + cg * 8 + 4) = (f32x4){p[4], p[5], p[6], p[7]}; }
          if (last && sx >= SEQ - 30 && r < 62) { float* np = newc + ((size_t)seq * 30 + (sx - (SEQ - 30))) * GW + c0; *(f32x4*)np = (f32x4){p[0], p[1], p[2], p[3]}; *(f32x4*)(np + 4) = (f32x4){p[4], p[5], p[6], p[7]}; } }
    }
    LDS_WAIT();
    const int c = h * 64 + lane;
    float wk[31];
#pragma unroll
    for (int k = 0; k < 31; ++k) wk[k] = cw[k * GW + c];
    const float bias = cb[c], gg = lg[c], bb = lb[c];
#pragma unroll 1
    for (int tq = 0; tq < 32; tq += 4) {
        float acc[4] = {bias, bias, bias, bias};
#pragma unroll
        for (int r = 0; r < 34; ++r) { const float gvv = gL[(tq + r) * 64 + lane];
#pragma unroll
            for (int q = 0; q < 4; ++q) { const int k = r - q; if (k >= 0 && k <= 30) acc[q] += wk[k] * gvv; } }
        float y[4];
#pragma unroll
        for (int q = 0; q < 4; ++q) { const float cv = acc[q];
            const float mean = wave_sum(cv) * (1.f / 64.f); const float d = cv - mean;
            const float var = wave_sum(d * d) * (1.f / 64.f);
            const float yy = d * rsqrtf(var + EPS) * gg + bb; y[q] = yy * sigm(yy); }
        LDS_WAIT();
#pragma unroll
        for (int q = 0; q < 4; ++q) gL[(tq + q) * 64 + lane] = y[q];
    }
    LDS_WAIT();
    bf16* ob = CAT + (rowbase + t0) * DM + 256 + c0;
#pragma unroll
    for (int j = 0; j < 4; ++j) { const int r = 8 * j + rr; const f32x4 a = *(const LAS f32x4*)(gL + r * 64 + cg * 8), b = *(const LAS f32x4*)(gL + r * 64 + cg * 8 + 4);
        const float o[8] = {a[0], a[1], a[2], a[3], b[0], b[1], b[2], b[3]}; *(v4u*)(ob + r * DM) = pack8(o); }
    LDS_WAIT();
}
__device__ __forceinline__ int sgu_swz(int c, int chunk) { return (chunk ^ ((c & 15) ^ (c >> 4))) << 3; }
__device__ __forceinline__ void sgu_unit(const bf16* __restrict__ Z, bf16* __restrict__ CAT, const bf16* __restrict__ Wb, const float* __restrict__ lg, const float* __restrict__ lb,
                                         const float* __restrict__ sb, int chunk, int h, LAS bf16* vT, int lane) {
    const size_t r0 = (size_t)chunk * 128;
    { const int rr = lane >> 3, cg = lane & 7, c0 = h * 64 + cg * 8;
      float gg[8], bb[8];
#pragma unroll
      for (int i = 0; i < 8; ++i) { gg[i] = lg[c0 + i]; bb[i] = lb[c0 + i]; }
#pragma unroll 1
      for (int jh = 0; jh < 16; jh += 8) {
          v4u raw[8];
#pragma unroll
          for (int j = 0; j < 8; ++j) raw[j] = ld16(Z + (r0 + 8 * (jh + j) + rr) * INW + 1024 + c0);
#pragma unroll
          for (int j = 0; j < 8; ++j) { float x[8]; unpack8(raw[j], x);
              float sm = ((x[0] + x[1]) + (x[2] + x[3])) + ((x[4] + x[5]) + (x[6] + x[7])); const float mean = sum8(sm) * (1.f / 64.f);
              float q = 0.f;
#pragma unroll
              for (int i = 0; i < 8; ++i) { x[i] -= mean; q += x[i] * x[i]; }
              const float rstd = rsqrtf(sum8(q) * (1.f / 64.f) + EPS);
#pragma unroll
              for (int i = 0; i < 8; ++i) { const int cl = cg * 8 + i; vT[cl * 128 + sgu_swz(cl, jh + j) + rr] = (bf16)f2bf(x[i] * rstd * gg[i] + bb[i]); } }
      }
    }
    LDS_WAIT();
    const int fr = lane & 15, fq = lane >> 4;
#pragma unroll 1
    for (int mt = 0; mt < 8; ++mt) {
        f32x4 acc[4];
#pragma unroll
        for (int nt = 0; nt < 4; ++nt) acc[nt] = (f32x4){0.f, 0.f, 0.f, 0.f};
        const int nks = (mt * 16 + 15) / 32 + 1;
        const int t = mt * 16 + fr;
        v2u uv[4];
#pragma unroll
        for (int nt = 0; nt < 4; ++nt) uv[nt] = *(const v2u*)(Z + (r0 + t) * INW + 768 + h * 64 + nt * 16 + 4 * fq);
        const float bt = sb[h * 128 + t];
#pragma unroll 1
        for (int ks = 0; ks < nks; ++ks) {
            const bf16x8 wf = *(const bf16x8*)(Wb + ((size_t)(h * 128 + t) * 128 + ks * 32 + fq * 8));
#pragma unroll
            for (int nt = 0; nt < 4; ++nt) { const int cl = nt * 16 + fr; const bf16x8 vf = *(const LAS bf16x8*)(vT + cl * 128 + sgu_swz(cl, ks * 4 + fq));
                acc[nt] = __builtin_amdgcn_mfma_f32_16x16x32_bf16(vf, wf, acc[nt], 0, 0, 0); }
        }
#pragma unroll
        for (int nt = 0; nt < 4; ++nt) { const float u0 = __uint_as_float(uv[nt].x << 16), u1 = __uint_as_float(uv[nt].x & 0xffff0000u), u2 = __uint_as_float(uv[nt].y << 16), u3 = __uint_as_float(uv[nt].y & 0xffff0000u);
            v2u w; w.x = pg8::cvt_pk_bf16(u0 * (acc[nt][0] + bt), u1 * (acc[nt][1] + bt)); w.y = pg8::cvt_pk_bf16(u2 * (acc[nt][2] + bt), u3 * (acc[nt][3] + bt));
            *(v2u*)(CAT + (r0 + t) * DM + 512 + h * 64 + nt * 16 + 4 * fq) = w; }
    }
    LDS_WAIT();
}
__device__ __forceinline__ void sgu_sample_unit(const bf16* __restrict__ Z, bf16* __restrict__ CAT, const float* __restrict__ Wf, const float* __restrict__ lg, const float* __restrict__ lb,
                                                const float* __restrict__ sb, float* __restrict__ vout, int seq, int h, int lane) {
    const int c = h * 64 + lane; const size_t rowbase = (size_t)MP + (size_t)seq * ST;
    const float gg = lg[c], bb = lb[c];
    float vn[ST];
#pragma unroll
    for (int t = 0; t < ST; ++t) { const float v = bf2f(Z[(rowbase + t) * INW + 1024 + c]); const float mean = wave_sum(v) * (1.f / 64.f); const float d = v - mean; const float var = wave_sum(d * d) * (1.f / 64.f);
        vn[t] = d * rsqrtf(var + EPS) * gg + bb; vout[((size_t)seq * ST + t) * GW + c] = vn[t]; }
#pragma unroll
    for (int t = 0; t < ST; ++t) { float sv = sb[h * 128 + t];
#pragma unroll
        for (int s = 0; s <= t; ++s) sv += Wf[((size_t)h * 128 + t) * 128 + s] * vn[s];
        const float u = bf2f(Z[(rowbase + t) * INW + 768 + c]);
        CAT[(rowbase + t) * DM + 512 + c] = (bf16)f2bf(u * sv); }
}

#define XB_TMO      128
#define XB_XCNT(j)  (256  + 64 * (j))
#define XB_XSUB(j)  (1280 + 64 * (j))
#define XB_XGEN(j)  (2304 + 64 * (j))
#define XB_TOP      3328
#define XB_TOPGEN   3392
#define XCD_BAR_WORDS 3456
#define XB_SPIN_CAP (1u << 18)

__device__ __forceinline__ unsigned xb_ld(unsigned* p)              { return __hip_atomic_load(p, __ATOMIC_RELAXED, __HIP_MEMORY_SCOPE_AGENT); }
__device__ __forceinline__ unsigned xb_add(unsigned* p, unsigned v) { return __hip_atomic_fetch_add(p, v, __ATOMIC_RELAXED, __HIP_MEMORY_SCOPE_AGENT); }
__device__ __forceinline__ unsigned xb_xcc_id() { return (unsigned)__builtin_amdgcn_s_getreg((3 << 11) | 20) & 0xFu; }
#define XB_SPIN(cond, bar) do { unsigned _sp = 0; while (cond) { __builtin_amdgcn_s_sleep(1); \
    if ((++_sp & 255u) == 0u) { if (xb_ld(&(bar)[XB_TMO])) break; if (_sp > XB_SPIN_CAP) { atomicAdd(&(bar)[XB_TMO], 1u); break; } } } } while (0)

struct XcdBarrier {
    unsigned* bar; unsigned x;
    volatile LAS unsigned* st;
};

__device__ __forceinline__ XcdBarrier xcd_barrier_post(unsigned* bar, volatile LAS unsigned* st) {
    XcdBarrier b; b.bar = bar; b.x = xb_xcc_id(); b.st = st;
    if (threadIdx.x == 0) (void)xb_add(&bar[XB_XCNT(b.x)], 1u);
    return b;
}
__device__ __forceinline__ void xcd_barrier_complete(unsigned* bar, unsigned x, unsigned& nloc, unsigned& nx) {
    const unsigned G = gridDim.x * gridDim.y * gridDim.z;
    unsigned sum, cnt, mine, sp = 0u;
    for (;;) {
        sum = 0u; cnt = 0u; mine = 0u;
#pragma unroll
        for (unsigned j = 0; j < 16; ++j) { const unsigned c = xb_ld(&bar[XB_XCNT(j)]); sum += c; cnt += (c > 0u) ? 1u : 0u; mine = (j == x) ? c : mine; }
        if (sum == G) break;
        __builtin_amdgcn_s_sleep(1);
        if ((++sp & 255u) == 0u) { if (xb_ld(&bar[XB_TMO])) break; if (sp > XB_SPIN_CAP) { atomicAdd(&bar[XB_TMO], 1u); break; } }
    }
    nloc = mine > 0u ? mine : 1u; nx = cnt > 0u ? cnt : 1u;
}

__device__ __forceinline__ void xcd_barrier(const XcdBarrier& b) {
    asm volatile("s_waitcnt vmcnt(0)" ::: "memory");
    __syncthreads();
    if (threadIdx.x == 0) {
        unsigned* bar = b.bar;
        __builtin_amdgcn_s_waitcnt(0);
        unsigned nloc = b.st[0], nx = b.st[1];
        if (nloc == 0u) { xcd_barrier_complete(bar, b.x, nloc, nx); b.st[0] = nloc; b.st[1] = nx; }
        const unsigned old = xb_add(&bar[XB_XSUB(b.x)], 1u);
        const unsigned gen = old / nloc;
        if (old + 1u == (gen + 1u) * nloc) {
            __builtin_amdgcn_fence(__ATOMIC_RELEASE, "agent");
            asm volatile("s_waitcnt vmcnt(0)" ::: "memory");
            const unsigned og = xb_add(&bar[XB_TOP], 1u);
            const unsigned tg = og / nx;
            if (og + 1u == (tg + 1u) * nx) xb_add(&bar[XB_TOPGEN], 1u);
            else XB_SPIN(xb_ld(&bar[XB_TOPGEN]) == tg, bar);
            __builtin_amdgcn_fence(__ATOMIC_ACQUIRE, "agent");
            xb_add(&bar[XB_XGEN(b.x)], 1u);
            asm volatile("s_waitcnt vmcnt(0)" ::: "memory");
        } else {
            XB_SPIN(xb_ld(&bar[XB_XGEN(b.x)]) == gen, bar);
            __builtin_amdgcn_fence(__ATOMIC_ACQUIRE, "agent");
            asm volatile("s_waitcnt vmcnt(0)" ::: "memory");
        }
    }
    __syncthreads();
}

template <int NT, int ACT>
__device__ __forceinline__ void small_gemm_tile(LAS unsigned char* lds, const bf16* __restrict__ A, const bf16* __restrict__ Bt, bf16* __restrict__ O, int ldc, int K, int m0, int n0, int tid) {
    constexpr int NC = 16 * NT;
    const int wave = __builtin_amdgcn_readfirstlane(tid >> 6), lane = tid & 63, fr = lane & 15, fq = lane >> 4;
    const int kw = K >> 3;
    const bf16* ap = A + (size_t)(m0 + fr) * K + wave * kw + fq * 8;
    const bf16* bp = Bt + (size_t)(n0 + fr) * K + wave * kw + fq * 8;
    f32x4 acc[4][NT];
#pragma unroll
    for (int m = 0; m < 4; ++m)
#pragma unroll
        for (int n = 0; n < NT; ++n) acc[m][n] = (f32x4){0.f, 0.f, 0.f, 0.f};
#pragma unroll 4
    for (int ks = 0; ks < kw; ks += 32) {
        bf16x8 a[4], b[NT];
#pragma unroll
        for (int m = 0; m < 4; ++m) a[m] = *(const bf16x8*)(ap + (size_t)m * 16 * K + ks);
#pragma unroll
        for (int n = 0; n < NT; ++n) b[n] = *(const bf16x8*)(bp + (size_t)n * 16 * K + ks);
#pragma unroll
        for (int m = 0; m < 4; ++m)
#pragma unroll
            for (int n = 0; n < NT; ++n) acc[m][n] = __builtin_amdgcn_mfma_f32_16x16x32_bf16(a[m], b[n], acc[m][n], 0, 0, 0);
    }
    LAS float* P = (LAS float*)lds + wave * (64 * NC);
#pragma unroll
    for (int m = 0; m < 4; ++m)
#pragma unroll
        for (int n = 0; n < NT; ++n)
#pragma unroll
            for (int i = 0; i < 4; ++i) P[(m * 16 + fq * 4 + i) * NC + n * 16 + fr] = acc[m][n][i];
    __syncthreads();
    constexpr int EPT = 64 * NC / 512;
    const int e0 = tid * EPT, row = e0 / NC, col = e0 % NC;
    float r[EPT];
#pragma unroll
    for (int j = 0; j < EPT; ++j) r[j] = 0.f;
#pragma unroll
    for (int w = 0; w < 8; ++w) { const LAS f32x4* q = (const LAS f32x4*)((LAS float*)lds + w * (64 * NC) + e0);
#pragma unroll
        for (int j = 0; j < EPT / 4; ++j) { const f32x4 v = q[j]; r[4 * j] += v[0]; r[4 * j + 1] += v[1]; r[4 * j + 2] += v[2]; r[4 * j + 3] += v[3]; } }
    if (ACT == 1) {
#pragma unroll
        for (int j = 0; j < EPT; ++j) { const float t = fmaxf(r[j], 0.f); r[j] = t * t; } }
    bf16* op = O + (size_t)(m0 + row) * ldc + n0 + col;
    if (EPT == 8) { v4u w; w.x = pk2(r[0], r[1]); w.y = pk2(r[2], r[3]); w.z = pk2(r[4 % EPT], r[5 % EPT]); w.w = pk2(r[6 % EPT], r[7 % EPT]); *(v4u*)op = w; }
    else { v2u w; w.x = pk2(r[0], r[1]); w.y = pk2(r[2], r[3]); *(v2u*)op = w; }
    __syncthreads();
}

constexpr int NPH = 15;
#ifndef REP_PRO
#define REP_PRO 1
#endif
#ifndef REP_GEMM
#define REP_GEMM 1
#endif
#ifndef REP_MIX
#define REP_MIX 1
#endif
#ifndef REP_SYNC
#define REP_SYNC 1
#endif
struct Args { const float* in[24]; float* out; unsigned char* ws; int ph_lo, ph_hi; };
__global__ void __launch_bounds__(NWAVES * 64, 2) hybrid_fwd(Args args) {
    extern __shared__ __attribute__((aligned(16))) unsigned char lds_raw[];
    LAS unsigned char* lds = (LAS unsigned char*)lds_raw;
    volatile LAS unsigned* MISC = (volatile LAS unsigned*)(lds + MISC_OFF);
    if (threadIdx.x < 64) MISC[threadIdx.x] = 0u;
    __syncthreads();
    (void)xcd_barrier_post((unsigned*)(args.ws + WS_CTL), MISC + 8);
    for (int ph = args.ph_lo; ph < args.ph_hi;) {
        int tid = threadIdx.x; asm volatile("" : "+v"(tid));
        const int lane = tid & 63, wave = __builtin_amdgcn_readfirstlane(tid >> 6);
        const int G = gridDim.x; const int bx = blockIdx.x;
        unsigned char* ws = args.ws;
        if (ph == 0) {
            const int vcu = (G % 8 == 0) ? (bx % 8) * (G / 8) + bx / 8 : bx; const int gw = vcu * NWAVES + wave, NGW = G * NWAVES;
            LAS float* scr = (LAS float*)(lds + wave * WAVE_SCR);
            bf16* XN = (bf16*)(ws + WS_XN); bf16* SGW = (bf16*)(ws + WS_SGUW);
            constexpr int I_FOLD = 4 * (DM / 32), I_OUT = (DM / 64) * (DM / 32) - I_FOLD, I_IN = (DM / 64) * (INW / 32), I_UP = (DM / 64) * (FF / 32), I_DN = (FF / 64) * (DM / 32);
            constexpr int I_LAYER = I_OUT + I_IN + I_UP + I_DN, I_ALL = DEPTH * I_LAYER;
            for (int it = gw; it < DEPTH * I_FOLD; it += NGW) { const int l = it / I_FOLD, r = it % I_FOLD;
                fold_item(args.in[10] + (size_t)l * DM * DM, (bf16*)(ws + WS_W + (size_t)l * W_LAYER + W_OUT), args.in[11] + (size_t)l * 4 * 64 * 64, args.in[12] + (size_t)l * GW, scr, r, lane); }
#define TR_DECODE(it_, d_) do { const int l_ = (it_) / I_LAYER; int r_ = (it_) % I_LAYER; unsigned char* wl_ = ws + WS_W + (size_t)l_ * W_LAYER; int nblk_; \
                if (r_ < I_OUT) { r_ += I_FOLD; d_.W = args.in[10] + (size_t)l_ * DM * DM; d_.WT = (bf16*)(wl_ + W_OUT); d_.gk = nullptr; d_.K = DM; d_.N = DM; } \
                else if ((r_ -= I_OUT) < I_IN) { d_.W = args.in[9] + (size_t)l_ * DM * INW; d_.WT = (bf16*)(wl_ + W_IN); d_.gk = args.in[5] + (size_t)l_ * DM; d_.K = DM; d_.N = INW; } \
                else if ((r_ -= I_IN) < I_UP) { d_.W = args.in[22] + (size_t)l_ * DM * FF; d_.WT = (bf16*)(wl_ + W_UP); d_.gk = args.in[7] + (size_t)l_ * DM; d_.K = DM; d_.N = FF; } \
                else { r_ -= I_UP; d_.W = args.in[23] + (size_t)l_ * FF * DM; d_.WT = (bf16*)(wl_ + W_DN); d_.gk = nullptr; d_.K = FF; d_.N = DM; } \
                nblk_ = d_.N / 32; d_.k0 = 64 * (r_ / nblk_); d_.n0 = 32 * (r_ % nblk_); } while (0)
            { int it = NGW - 1 - gw;
              if (it < I_ALL) {
                TrDesc dc; TR_DECODE(it, dc);
                float va[32], vb[32];
                tr_load(va, dc, lane);
#pragma unroll 1
                for (;;) {
                    const int itn = it + NGW; const bool more = itn < I_ALL;
                    TrDesc dn; { const int q = more ? itn : it; TR_DECODE(q, dn); }
                    tr_load(vb, dn, lane);
                    tr_store(va, dc, scr, lane);
                    if (!more) break;
#pragma unroll
                    for (int i = 0; i < 32; ++i) va[i] = vb[i];
                    dc = dn; it = itn;
                }
              }
            }
#undef TR_DECODE
            for (int m = gw; m < MT; m += NGW) rms_row_to_bf16(m < MP ? args.in[0] + (size_t)m * DM : args.in[1] + (size_t)(m - MP) * DM, XN + (size_t)m * DM, lane);
            for (int e = bx * (NWAVES * 64) + tid; e < DEPTH * 4 * 128 * 128; e += G * NWAVES * 64) { const int t = (e >> 7) & 127, s = e & 127; SGW[e] = (bf16)(s <= t ? f2bf(args.in[19][e]) : 0u); }
        } else {
            const int l = (ph - 1) / 7, k = (ph - 1) - 7 * l;
            unsigned char* wl = ws + WS_W + (size_t)l * W_LAYER;
            if (k == 0 || k == 2 || k == 5) {
                const bf16* A = (const bf16*)(ws + (k == 0 ? WS_XN : k == 2 ? WS_CAT : WS_H));
                const bf16* Bt = (const bf16*)(wl + (k == 0 ? W_IN : k == 2 ? W_OUT : W_DN));
                bf16* O = (bf16*)(ws + (k == 0 ? WS_Z : WS_O));
                const int N = k == 0 ? INW : DM, K = k == 5 ? FF : DM;
                pg8::Gemm g{A, Bt, MP, N, K}; pg8::StaticOrder S; S.init(MP, N, G, bx);
                pg8::EpiBf16<0> E{O, N};
                pg8::gemm_phase<pg8::EpiBf16<0>, pg8::StaticOrder, true, true>(lds, g, S, E, tid);
                if (k == 0) { for (int j = bx; j < (MS / 64) * (INW / 64); j += G) small_gemm_tile<4, 0>(lds, A, Bt, O, N, K, MP + (j & 7) * 64, (j >> 3) * 64, tid); }
                else { for (int j = bx; j < (MS / 64) * (DM / 32); j += G) small_gemm_tile<2, 0>(lds, A, Bt, O, N, K, MP + (j & 7) * 64, (j >> 3) * 32, tid); }
            } else if (k == 4) {
                pg8::Gemm g{(const bf16*)(ws + WS_XN), (const bf16*)(wl + W_UP), MP, FF, DM}; pg8::StaticOrder S; S.init(MP, FF, G, bx);
                pg8::EpiBf16<1> E{(bf16*)(ws + WS_H), FF};
                pg8::gemm_phase<pg8::EpiBf16<1>, pg8::StaticOrder, true, true>(lds, g, S, E, tid);
                for (int j = bx; j < (MS / 64) * (FF / 64); j += G) small_gemm_tile<4, 1>(lds, (const bf16*)(ws + WS_XN), (const bf16*)(wl + W_UP), (bf16*)(ws + WS_H), FF, DM, MP + (j & 7) * 64, (j >> 3) * 64, tid);
            } else if (k == 1) {
                const int vcu = (G % 8 == 0) ? (bx % 8) * (G / 8) + bx / 8 : bx; const int gw = vcu * NWAVES + wave, NGW = G * NWAVES;
                LAS float* scr = (LAS float*)(lds + wave * WAVE_SCR);
                const bf16* ZB = (const bf16*)(ws + WS_Z); bf16* CAT = (bf16*)(ws + WS_CAT); const bf16* SGW = (const bf16*)(ws + WS_SGUW) + (size_t)l * 4 * 128 * 128;
                float* out = args.out;
                constexpr int NU_SGU = 512, NU_CONV = 2048, NU_SEG = 1024, NU_SMP = 2048, NU = NU_SGU + NU_CONV + 2 * NU_SEG + NU_SMP;
#pragma unroll 1
                for (int ui = 0; ui * NGW < NU; ++ui) {
                    const int u = ui * NGW + ((ui & 1) ? NGW - 1 - gw : gw);
                    if (u >= NU) continue;
                    int lane = tid & 63; asm volatile("" : "+v"(lane));
                    if (u < NU_SGU) { sgu_unit(ZB, CAT, SGW, args.in[17] + (size_t)l * GW, args.in[18] + (size_t)l * GW, args.in[20] + (size_t)l * 4 * 128, u >> 2, u & 3, (LAS bf16*)scr, lane); continue; }
                    int r = u - NU_SGU;
                    if (r < NU_CONV) { const int seg = r >> 2, h = r & 3, seq = seg >> 6, t0 = (seg & 63) * 32;
                        conv_unit_p(ZB, CAT, out + OUT_CONV_P + (size_t)l * NBP * 30 * GW, args.in[13] + (size_t)l * 31 * GW, args.in[14] + (size_t)l * GW, args.in[15] + (size_t)l * GW, args.in[16] + (size_t)l * GW, seq, t0, h, scr, lane);
                        continue; }
                    r -= NU_CONV;
                    if (r < 2 * NU_SEG) { const int ty = r / NU_SEG, q = r % NU_SEG, seg = q >> 2, h = q & 3, seq = seg >> 5, t0 = (seg & 31) * 64;
                        if (ty == 0) { float* np = out + OUT_POOL_P + (size_t)l * NBP * 15 * GW;
                            if (h == 0) pool_unit_p<2>(ZB, CAT, np, seq, t0, h, lane); else if (h == 1) pool_unit_p<4>(ZB, CAT, np, seq, t0, h, lane);
                            else if (h == 2) pool_unit_p<8>(ZB, CAT, np, seq, t0, h, lane); else pool_unit_p<16>(ZB, CAT, np, seq, t0, h, lane); }
                        else short_unit_p(ZB, CAT, out + OUT_SHORT_P + (size_t)l * NBP * 2 * GW, args.in[21] + (size_t)l * 3 * GW, seq, t0, h, lane);
                        continue; }
                    r -= 2 * NU_SEG;
                    { const int ty = r >> 9, q = r & 511, seq = q >> 2, h = q & 3;
                        if (ty == 0) conv_unit<true>(ZB, CAT, args.in[3] + (size_t)l * NSB * 30 * GW, out + OUT_CONV_S + (size_t)l * NSB * 30 * GW, args.in[13] + (size_t)l * 31 * GW, args.in[14] + (size_t)l * GW, args.in[15] + (size_t)l * GW, args.in[16] + (size_t)l * GW, seq, 0, ST, h, scr, lane);
                        else if (ty == 1) pool_unit<true>(ZB, CAT, args.in[2] + (size_t)l * NSB * 15 * GW, out + OUT_POOL_S + (size_t)l * NSB * 15 * GW, seq, 0, ST, h, lane);
                        else if (ty == 2) short_unit<true>(ZB, CAT, args.in[4] + (size_t)l * NSB * 2 * GW, out + OUT_SHORT_S + (size_t)l * NSB * 2 * GW, args.in[21] + (size_t)l * 3 * GW, seq, 0, ST, h, lane);
                        else sgu_sample_unit(ZB, CAT, args.in[19] + (size_t)l * 4 * 128 * 128, args.in[17] + (size_t)l * GW, args.in[18] + (size_t)l * GW, args.in[20] + (size_t)l * 4 * 128, out + OUT_V_S + (size_t)l * NSB * ST * GW, seq, h, lane); }
                }
            } else {
                const int vcu = (G % 8 == 0) ? (bx % 8) * (G / 8) + bx / 8 : bx; const int gw = vcu * NWAVES + wave, NGW = G * NWAVES;
                const float* g = args.in[k == 3 ? 6 : 8] + (size_t)l * DM;
                float* X = args.out; const bf16* OB = (const bf16*)(ws + WS_O); bf16* XN = (bf16*)(ws + WS_XN);
                const bool from_input = (l == 0 && k == 3), write_xn = !(l == DEPTH - 1 && k == 6);
                f32x4 gg[4];
#pragma unroll
                for (int j = 0; j < 4; ++j) gg[j] = ((const f32x4*)g + lane)[64 * j];
#define EW_XSRC(m) (from_input ? ((m) < MP ? args.in[0] + (size_t)(m) * DM : args.in[1] + (size_t)((m) - MP) * DM) : X + (size_t)(m) * DM)
#pragma unroll 1
                for (int m = gw; m < MT; m += 2 * NGW) {
                    const int m2 = m + NGW; const bool two = m2 < MT;
                    EwRow ra, rb;
                    ew_load(ra, EW_XSRC(m), OB + (size_t)m * DM, lane);
                    { const int mc = two ? m2 : m; ew_load(rb, EW_XSRC(mc), OB + (size_t)mc * DM, lane); }
                    ew_finish(ra, gg, X + (size_t)m * DM, XN + (size_t)m * DM, write_xn, lane);
                    if (two) ew_finish(rb, gg, X + (size_t)m2 * DM, XN + (size_t)m2 * DM, write_xn, lane);
                }
#undef EW_XSRC
            }
        }
        ++ph;
        if (ph < args.ph_hi) {
            if (args.ph_lo < 0) cg::this_grid().sync();
            else { XcdBarrier b; b.bar = (unsigned*)(args.ws + WS_CTL); b.x = xb_xcc_id(); b.st = (volatile LAS unsigned*)(lds + MISC_OFF) + 8; xcd_barrier(b); }
        }
    }
}

#ifndef MK_N_LAUNCHES
#define MK_N_LAUNCHES 1
#endif
extern "C" void kernel_launch(void* const* d_in, const int* in_sizes, int n_in, void* d_out, int out_size, void* d_ws, size_t ws_size, hipStream_t stream) {
    static int grid = 0;
    if (grid == 0) {
        if (n_in != 24 || (size_t)out_size != OUT_END || ws_size < WS_END) { fprintf(stderr, "kernel_launch: unexpected shapes (n_in %d out %d ws %zu)\n", n_in, out_size, ws_size); grid = -1; return; }
        int dev = 0, cus = 0, per_cu = 0;
        if (hipGetDevice(&dev) != hipSuccess || hipDeviceGetAttribute(&cus, hipDeviceAttributeMultiprocessorCount, dev) != hipSuccess) { grid = -1; return; }
        if (hipFuncSetAttribute((const void*)hybrid_fwd, hipFuncAttributeMaxDynamicSharedMemorySize, LDS_BYTES) != hipSuccess) { fprintf(stderr, "kernel_launch: hipFuncSetAttribute failed\n"); grid = -1; return; }
        if (hipOccupancyMaxActiveBlocksPerMultiprocessor(&per_cu, (const void*)hybrid_fwd, NWAVES * 64, LDS_BYTES) != hipSuccess || per_cu < 1) per_cu = 1;
        (void)hipGetLastError();
        grid = cus * per_cu;
    }
    if (grid < 0) return;
    if (hipMemsetAsync((char*)d_ws + WS_CTL, 0, CTL_ZERO_BYTES, stream) != hipSuccess) { fprintf(stderr, "kernel_launch: hipMemsetAsync failed\n"); return; }
    Args a{};
    for (int i = 0; i < 24; ++i) a.in[i] = (const float*)d_in[i];
    a.out = (float*)d_out; a.ws = (unsigned char*)d_ws;
#if MK_N_LAUNCHES == 1
    a.ph_lo = 0; a.ph_hi = NPH;
    void* kargs[] = {&a};
    hipError_t e = hipLaunchCooperativeKernel((const void*)hybrid_fwd, dim3(grid), dim3(NWAVES * 64), kargs, LDS_BYTES, stream);
    if (e != hipSuccess) fprintf(stderr, "cooperative launch failed: %s (grid %d)\n", hipGetErrorString(e), grid);
#else
    for (int p = 0; p < NPH; ++p) { a.ph_lo = p; a.ph_hi = p + 1; hipLaunchKernelGGL(hybrid_fwd, dim3(grid), dim3(NWAVES * 64), LDS_BYTES, stream, a); }
#endif
}
```

```cpp
#include <hip/hip_runtime.h>
#include <hip/hip_cooperative_groups.h>
#include <cstdio>
#include <cstdint>
namespace pg8 {
#define PG8_LAS __attribute__((address_space(3)))
typedef unsigned short bf16_t;
typedef short bf16x8 __attribute__((ext_vector_type(8)));
typedef float f32x4 __attribute__((ext_vector_type(4)));
typedef unsigned u32x4 __attribute__((ext_vector_type(4)));
constexpr int BM = 256, BK = 64, HALF = 128, HTB = HALF * BK * 2  , STAGE_BYTES = 8 * HTB, NXCD = 8, WGM = 8;

__host__ __device__ __forceinline__ int lds_byte(int r, int c) { const int st = (r >> 4) * 2 + (c >> 5), rr = r & 15, cc = c & 31, ob = rr * 64 + cc * 2; return st * 1024 + (ob ^ (((ob >> 9) & 1) << 5)); }
__host__ __device__ __forceinline__ void stage_rc(int b, int& R, int& C) { const int st = b / 1024, sb = b % 1024, swz = sb ^ (((sb >> 9) & 1) << 5); R = (st >> 1) * 16 + swz / 64; C = (st & 1) * 32 + (swz % 64) / 2; }
__host__ __device__ __forceinline__ int perm32(int rho) { const int n = rho >> 4, i = rho & 15; return 8 * (i >> 2) + 4 * n + (i & 3); }

struct Unit { int pm, pn; };
struct Gemm { const bf16_t* A; const bf16_t* Bt; int M, N, K; };

struct StaticOrder {
    int nM, nN, nwg, G, c;
    __host__ __device__ void init(int M, int N, int G_, int c_) { nM = M / BM; nN = N / BM; nwg = nM * nN; G = G_; c = c_; }
    __host__ __device__ bool next(int i, Unit& u) const {
        const long L = (long)i * G + c; if (L >= nwg) return false;
        int wgid = (int)L; { const int q = nwg / NXCD, r = nwg % NXCD, xcd = wgid % NXCD, off = wgid / NXCD; wgid = (xcd < r ? xcd * (q + 1) : r * (q + 1) + (xcd - r) * q) + off; }
        const int nig = WGM * nN, gid = wgid / nig, fm = gid * WGM, gsz = (nM - fm) < WGM ? (nM - fm) : WGM;
        u.pm = fm + ((wgid % nig) % gsz); u.pn = (wgid % nig) / gsz; return true;
    }
    __device__ __forceinline__ void a_ready(const Unit&) const {}
    __device__ __forceinline__ void done(const Unit&) const {}
};

__device__ __forceinline__ unsigned cvt_pk_bf16(float lo, float hi) { unsigned r; asm volatile("v_cvt_pk_bf16_f32 %0, %1, %2" : "=v"(r) : "v"(lo), "v"(hi)); return r; }
__device__ __forceinline__ float relu_sq(float x) { float r; asm volatile("v_max_f32 %0, 0, %1" : "=v"(r) : "v"(x)); return r * r; }
template <int ACT  > struct EpiBf16 {
    static constexpr bool PERM = true, AFTER_DRAIN = false;
    bf16_t* O; int ldc;
    __device__ __forceinline__ void operator()(const f32x4 (&acc)[2][2][4][2], const Unit& u, int wr, int wc, int fr, int fq) const {
        const int row0 = u.pm * BM + wr * 64 + fr; const int col0 = u.pn * BM + wc * 32 + 8 * fq;
#pragma unroll
        for (int ai = 0; ai < 2; ++ai)
#pragma unroll
            for (int m = 0; m < 4; ++m) { bf16_t* rowp = O + (size_t)(row0 + ai * HALF + m * 16) * ldc + col0;
#pragma unroll
                for (int bj = 0; bj < 2; ++bj) { f32x4 v0 = acc[ai][bj][m][0], v1 = acc[ai][bj][m][1];
                    if (ACT == 1) {
#pragma unroll
                        for (int e = 0; e < 4; ++e) { v0[e] = relu_sq(v0[e]); v1[e] = relu_sq(v1[e]); } }
                    u32x4 w; w.x = cvt_pk_bf16(v0[0], v0[1]); w.y = cvt_pk_bf16(v0[2], v0[3]); w.z = cvt_pk_bf16(v1[0], v1[1]); w.w = cvt_pk_bf16(v1[2], v1[3]);
                    *(u32x4*)(rowp + bj * HALF) = w; } }
    }
};

template <class Epi, class Sched, bool ALIGN_EPI = false, bool SP2 = false>
__device__ __forceinline__ void gemm_phase(PG8_LAS unsigned char* lds, const Gemm g, const Sched& S, const Epi& E, const int tid) {
    const int wid = __builtin_amdgcn_readfirstlane(tid >> 6), lane = tid & 63, wr = wid >> 2, wc = wid & 3, fr = lane & 15, fq = lane >> 4;
    const int K = g.K, nt = K / BK;
    unsigned voffA[2], voffB[2];
#pragma unroll
    for (int i = 0; i < 2; ++i) { int R, C; stage_rc(tid * 16 + i * 8192, R, C); const int Rb = Epi::PERM ? ((R & ~31) + perm32(R & 31)) : R;
        voffA[i] = (unsigned)(R * K + C) * 2u; voffB[i] = (unsigned)(Rb * K + C) * 2u; }
    const size_t kstep = (size_t)(BK * 2);
    const size_t hstep = (size_t)HALF * K * 2;
    const size_t tstep = 2 * hstep;
    const unsigned ldsw = (unsigned)wid * 1024u;
    const int aoff = lds_byte(wr * 64 + fr, fq * 8), boff = lds_byte(wc * 32 + fr, fq * 8);
#define PG8_SA(b, h) (((b) * 2 + (h)) * HTB)
#define PG8_SB(b, h) ((4 + (b) * 2 + (h)) * HTB)
#define PG8_STAGE(bufoff, gbase, voff) do { _Pragma("unroll") for (int _i = 0; _i < 2; ++_i) \
        __builtin_amdgcn_global_load_lds((const unsigned*)((const char*)(gbase) + (voff)[_i]), (PG8_LAS unsigned*)(lds + (bufoff) + ldsw + _i * 8192), 16, 0, 0); } while (0)
#define PG8_LDA(dst, b, h) do { _Pragma("unroll") for (int m = 0; m < 4; ++m) _Pragma("unroll") for (int k = 0; k < 2; ++k) dst[m][k] = *(const PG8_LAS bf16x8*)(lds + PG8_SA(b, h) + aoff + m * 2048 + k * 1024); } while (0)
#define PG8_LDB(dst, b, h) do { _Pragma("unroll") for (int n = 0; n < 2; ++n) _Pragma("unroll") for (int k = 0; k < 2; ++k) dst[n][k] = *(const PG8_LAS bf16x8*)(lds + PG8_SB(b, h) + boff + n * 2048 + k * 1024); } while (0)
#define PG8_MMA(ai, bj, At, Bt) do { __builtin_amdgcn_s_setprio(1); _Pragma("unroll") for (int m = 0; m < 4; ++m) _Pragma("unroll") for (int n = 0; n < 2; ++n) _Pragma("unroll") for (int k = 0; k < 2; ++k) \
        acc[ai][bj][m][n] = __builtin_amdgcn_mfma_f32_16x16x32_bf16(Bt[n][k], At[m][k], acc[ai][bj][m][n], 0, 0, 0); __builtin_amdgcn_s_setprio(0); } while (0)
#define PG8_WAIT_V(n) asm volatile("s_waitcnt vmcnt(" #n ")" ::: "memory")
#define PG8_WAIT_L(n) asm volatile("s_waitcnt lgkmcnt(" #n ")" ::: "memory")
#define PG8_BAR __builtin_amdgcn_s_barrier()
#define PG8_SCHED __builtin_amdgcn_sched_barrier(0)
    Unit cur, nxt; int ui = 0;
    if (!S.next(0, cur)) return;
    f32x4 acc[2][2][4][2];
#pragma unroll
    for (int a = 0; a < 2; ++a)
#pragma unroll
        for (int b = 0; b < 2; ++b)
#pragma unroll
            for (int m = 0; m < 4; ++m)
#pragma unroll
                for (int n = 0; n < 2; ++n) acc[a][b][m][n] = (f32x4){0.f, 0.f, 0.f, 0.f};
    bf16x8 At[4][2], B0[2][2], B1[2][2];
    const char* cA = (const char*)g.A + (size_t)cur.pm * tstep; const char* cB = (const char*)g.Bt + (size_t)cur.pn * tstep;
    S.a_ready(cur);
    if constexpr (SP2) {
        PG8_STAGE(PG8_SB(0, 0), cB, voffB); PG8_STAGE(PG8_SB(0, 1), cB + hstep, voffB); PG8_STAGE(PG8_SA(0, 0), cA, voffA); PG8_STAGE(PG8_SA(0, 1), cA + hstep, voffA);
        if (wr == 1) PG8_BAR;
        PG8_WAIT_V(2); PG8_BAR;
        PG8_STAGE(PG8_SB(1, 0), cB + kstep, voffB); PG8_STAGE(PG8_SA(1, 0), cA + kstep, voffA); PG8_STAGE(PG8_SB(1, 1), cB + hstep + kstep, voffB);
        PG8_WAIT_V(6); PG8_BAR;
    } else {
        PG8_STAGE(PG8_SB(0, 0), cB, voffB); PG8_STAGE(PG8_SA(0, 0), cA, voffA); PG8_STAGE(PG8_SB(0, 1), cB + hstep, voffB); PG8_STAGE(PG8_SA(0, 1), cA + hstep, voffA);
        if (wr == 1) PG8_BAR;
        PG8_WAIT_V(4); PG8_BAR;
        PG8_STAGE(PG8_SB(1, 0), cB + kstep, voffB); PG8_STAGE(PG8_SA(1, 0), cA + kstep, voffA); PG8_STAGE(PG8_SB(1, 1), cB + hstep + kstep, voffB);
        PG8_WAIT_V(6); PG8_BAR;
    }
    for (;;) {
        const bool has_next = S.next(ui + 1, nxt);
        const char* nA = has_next ? (const char*)g.A + (size_t)nxt.pm * tstep : cA; const char* nB = has_next ? (const char*)g.Bt + (size_t)nxt.pn * tstep : cB;
        for (int t = 0; t < nt; t += 2) {
            const bool last = (t == nt - 2);
            const char* a1 = cA + (size_t)(t + 1) * kstep;
            const char* a2 = last ? nA : cA + (size_t)(t + 2) * kstep; const char* b2 = last ? nB : cB + (size_t)(t + 2) * kstep;
            const char* a3 = a2 + kstep; const char* b3 = b2 + kstep;
            if (last && has_next) S.a_ready(nxt);
            if constexpr (SP2) {
            PG8_LDB(B0, 0, 0); PG8_LDB(B1, 0, 1); PG8_SCHED; PG8_LDA(At, 0, 0); PG8_STAGE(PG8_SA(1, 1), a1 + hstep, voffA);
            PG8_WAIT_V(8); PG8_WAIT_L(0); PG8_BAR; PG8_MMA(0, 0, At, B0); PG8_MMA(0, 1, At, B1); PG8_BAR; PG8_SCHED;
            PG8_LDA(At, 0, 1); PG8_STAGE(PG8_SB(0, 0), b2, voffB); PG8_STAGE(PG8_SB(0, 1), b2 + hstep, voffB); PG8_STAGE(PG8_SA(0, 0), a2, voffA);
            PG8_WAIT_V(8); PG8_WAIT_L(0); PG8_BAR; PG8_MMA(1, 0, At, B0); PG8_MMA(1, 1, At, B1); PG8_BAR; PG8_SCHED;
            PG8_LDB(B0, 1, 0); PG8_LDB(B1, 1, 1); PG8_SCHED; PG8_LDA(At, 1, 0); PG8_STAGE(PG8_SA(0, 1), a2 + hstep, voffA);
            PG8_WAIT_V(8); PG8_WAIT_L(0); PG8_BAR; PG8_MMA(0, 0, At, B0); PG8_MMA(0, 1, At, B1); PG8_BAR; PG8_SCHED;
            PG8_LDA(At, 1, 1); PG8_STAGE(PG8_SB(1, 0), b3, voffB); PG8_STAGE(PG8_SB(1, 1), b3 + hstep, voffB); PG8_STAGE(PG8_SA(1, 0), a3, voffA);
            PG8_WAIT_V(8); PG8_WAIT_L(0); PG8_BAR; PG8_MMA(1, 0, At, B0); PG8_MMA(1, 1, At, B1); PG8_BAR; PG8_SCHED;
            } else {
            PG8_LDB(B0, 0, 0); PG8_SCHED; PG8_LDA(At, 0, 0); PG8_STAGE(PG8_SA(1, 1), a1 + hstep, voffA);
            PG8_WAIT_L(8); PG8_BAR; PG8_WAIT_L(0); PG8_MMA(0, 0, At, B0); PG8_BAR; PG8_SCHED;
            PG8_LDB(B1, 0, 1); PG8_STAGE(PG8_SB(0, 0), b2, voffB);
            PG8_BAR; PG8_WAIT_L(0); PG8_MMA(0, 1, At, B1); PG8_BAR;
            PG8_LDA(At, 0, 1); PG8_STAGE(PG8_SA(0, 0), a2, voffA);
            PG8_BAR; PG8_WAIT_L(0); PG8_MMA(1, 0, At, B0); PG8_BAR; PG8_SCHED;
            PG8_STAGE(PG8_SB(0, 1), b2 + hstep, voffB);
            PG8_WAIT_V(6); PG8_BAR; PG8_MMA(1, 1, At, B1); PG8_BAR;
            PG8_LDB(B0, 1, 0); PG8_SCHED; PG8_LDA(At, 1, 0); PG8_STAGE(PG8_SA(0, 1), a2 + hstep, voffA);
            PG8_WAIT_L(8); PG8_BAR; PG8_WAIT_L(0); PG8_MMA(0, 0, At, B0); PG8_BAR; PG8_SCHED;
            PG8_LDB(B1, 1, 1); PG8_STAGE(PG8_SB(1, 0), b3, voffB);
            PG8_BAR; PG8_WAIT_L(0); PG8_MMA(0, 1, At, B1); PG8_BAR;
            PG8_LDA(At, 1, 1); PG8_STAGE(PG8_SA(1, 0), a3, voffA);
            PG8_BAR; PG8_WAIT_L(0); PG8_MMA(1, 0, At, B0); PG8_BAR; PG8_SCHED;
            PG8_STAGE(PG8_SB(1, 1), b3 + hstep, voffB);
            PG8_WAIT_V(6); PG8_BAR; PG8_MMA(1, 1, At, B1); PG8_BAR;
            }
        }
        if constexpr (ALIGN_EPI) { if (wr == 0) PG8_BAR; }
        if constexpr (!Epi::AFTER_DRAIN) { E(acc, cur, wr, wc, fr, fq); S.done(cur); }
        if (!has_next) break;
#pragma unroll
        for (int a = 0; a < 2; ++a)
#pragma unroll
            for (int b = 0; b < 2; ++b)
#pragma unroll
                for (int m = 0; m < 4; ++m)
#pragma unroll
                    for (int n = 0; n < 2; ++n) acc[a][b][m][n] = (f32x4){0.f, 0.f, 0.f, 0.f};
        cur = nxt; cA = nA; cB = nB; ++ui;
        if constexpr (ALIGN_EPI) { if (wr == 1) PG8_BAR; }
    }
    PG8_WAIT_V(0);
    if constexpr (!ALIGN_EPI) { if (wr == 0) PG8_BAR; }
    PG8_BAR;
    if constexpr (Epi::AFTER_DRAIN) { E.fused(acc, cur, wr, wc, fr, fq, lds, wid, lane); S.done(cur); }
#undef PG8_SA
#undef PG8_SB
#undef PG8_STAGE
#undef PG8_LDA
#undef PG8_LDB
#undef PG8_MMA
#undef PG8_WAIT_V
#undef PG8_WAIT_L
#undef PG8_BAR
#undef PG8_SCHED
}
}

namespace cg = cooperative_groups;
#define LAS __attribute__((address_space(3)))
typedef unsigned short bf16;
typedef unsigned v4u __attribute__((ext_vector_type(4)));
typedef unsigned v2u __attribute__((ext_vector_type(2)));
typedef float f32x4 __attribute__((ext_vector_type(4)));
typedef short bf16x8 __attribute__((ext_vector_type(8)));

constexpr int NWAVES = 8;
constexpr int DM = 1024, FF = 4096, INW = 2048, GW = 256;
constexpr int MP = 16384, MS = 512, MT = MP + MS;
constexpr int SEQ = 2048, NBP = 8, NSB = 128, ST = 4, DEPTH = 2;
constexpr float EPS = 1e-6f;
constexpr size_t MiB = 1u << 20;
constexpr size_t WS_SGUW = 1 * MiB;
constexpr size_t WS_W = 2 * MiB, W_LAYER = 22 * MiB, W_IN = 0, W_OUT = 4 * MiB, W_UP = 6 * MiB, W_DN = 14 * MiB;
constexpr size_t WS_XN = 46 * MiB, WS_O = 79 * MiB, WS_H = 112 * MiB, WS_Z = 112 * MiB, WS_CAT = 178 * MiB, WS_X = 244 * MiB  , WS_END = 246 * MiB;
constexpr int CW_SEAM = 4096, SEAM_BANK = 4096;
constexpr int LDS_BYTES = 147456;
constexpr int MISC_OFF = LDS_BYTES - 256;
constexpr size_t WS_CTL = 0, CTL_ZERO_BYTES = 128 * 1024;
constexpr int WAVE_SCR = 17408;
constexpr size_t OUT_Y = 0;
constexpr size_t OUT_POOL_P = (size_t)MT * DM;
constexpr size_t OUT_POOL_S = OUT_POOL_P + (size_t)DEPTH * NBP * 15 * GW;
constexpr size_t OUT_CONV_P = OUT_POOL_S + (size_t)DEPTH * NSB * 15 * GW;
constexpr size_t OUT_CONV_S = OUT_CONV_P + (size_t)DEPTH * NBP * 30 * GW;
constexpr size_t OUT_SHORT_P = OUT_CONV_S + (size_t)DEPTH * NSB * 30 * GW;
constexpr size_t OUT_SHORT_S = OUT_SHORT_P + (size_t)DEPTH * NBP * 2 * GW;
constexpr size_t OUT_V_S = OUT_SHORT_S + (size_t)DEPTH * NSB * 2 * GW;
constexpr size_t OUT_END = OUT_V_S + (size_t)DEPTH * NSB * ST * GW;

__device__ __forceinline__ float bf2f(bf16 b) { return __uint_as_float(((unsigned)b) << 16); }
__device__ __forceinline__ unsigned f2bf(float f) { unsigned u = __float_as_uint(f); return (u + 0x7fffu + ((u >> 16) & 1u)) >> 16; }
__device__ __forceinline__ unsigned pk2(float lo, float hi) { return f2bf(lo) | (f2bf(hi) << 16); }
template <int CTRL, int ROWMASK> __device__ __forceinline__ float dpp_get(float v) { return __int_as_float(__builtin_amdgcn_update_dpp(0, __float_as_int(v), CTRL, ROWMASK, 0xF, false)); }
__device__ __forceinline__ float sum8(float v) { v += dpp_get<0xB1, 0xF>(v); v += dpp_get<0x4E, 0xF>(v); v += dpp_get<0x141, 0xF>(v); return v; }
__device__ __forceinline__ float wave_sum(float v) {
    v = sum8(v); v += dpp_get<0x140, 0xF>(v); v += dpp_get<0x142, 0xA>(v); v += dpp_get<0x143, 0xC>(v);
    return __int_as_float(__builtin_amdgcn_readlane(__float_as_int(v), 63));
}
__device__ __forceinline__ void unpack8(const v4u w, float (&f)[8]) {
    f[0] = __uint_as_float(w.x << 16); f[1] = __uint_as_float(w.x & 0xffff0000u); f[2] = __uint_as_float(w.y << 16); f[3] = __uint_as_float(w.y & 0xffff0000u);
    f[4] = __uint_as_float(w.z << 16); f[5] = __uint_as_float(w.z & 0xffff0000u); f[6] = __uint_as_float(w.w << 16); f[7] = __uint_as_float(w.w & 0xffff0000u); }
__device__ __forceinline__ v4u pack8(const float (&f)[8]) { v4u w; w.x = pg8::cvt_pk_bf16(f[0], f[1]); w.y = pg8::cvt_pk_bf16(f[2], f[3]); w.z = pg8::cvt_pk_bf16(f[4], f[5]); w.w = pg8::cvt_pk_bf16(f[6], f[7]); return w; }
__device__ __forceinline__ v4u ld16(const bf16* p) { return *(const v4u*)p; }
__device__ __forceinline__ float sigm(float x) { return 1.f / (1.f + __expf(-x)); }
#define LDS_WAIT() asm volatile("s_waitcnt lgkmcnt(0)" ::: "memory")

__device__ __forceinline__ void transpose_item(const float* __restrict__ W, int K, int N, bf16* __restrict__ WT, const float* __restrict__ gk, LAS float* scr, int item, int lane) {
    const int nblk = N / 32, kb = item / nblk, nb = item % nblk, k0 = 64 * kb, n0 = 32 * nb;
#pragma unroll 8
    for (int i = 0; i < 32; ++i) { const int kk = 2 * i + (lane >> 5); float v = W[(size_t)(k0 + kk) * N + n0 + (lane & 31)]; if (gk) v *= gk[k0 + kk]; scr[kk * 33 + (lane & 31)] = v; }
    LDS_WAIT();
    const int c = lane & 7;
#pragma unroll
    for (int j = 0; j < 4; ++j) { const int n = (lane >> 3) + 8 * j; const LAS float* s = scr + (8 * c) * 33 + n;
        v4u o; o.x = pk2(s[0 * 33], s[1 * 33]); o.y = pk2(s[2 * 33], s[3 * 33]); o.z = pk2(s[4 * 33], s[5 * 33]); o.w = pk2(s[6 * 33], s[7 * 33]);
        *(v4u*)(WT + (size_t)(n0 + n) * K + k0 + 8 * c) = o; }
    LDS_WAIT();
}
struct TrDesc { const float* W; bf16* WT; const float* gk; int K, N, k0, n0; };
__device__ __forceinline__ void tr_load(float (&v)[32], const TrDesc& d, int lane) {
    const float* p = d.W + (size_t)(d.k0 + (lane >> 5)) * d.N + d.n0 + (lane & 31);
#pragma unroll
    for (int i = 0; i < 32; ++i) v[i] = p[(size_t)(2 * i) * d.N];
}
__device__ __forceinline__ void tr_store(const float (&v)[32], const TrDesc& d, LAS float* scr, int lane) {
#pragma unroll
    for (int i = 0; i < 32; ++i) { const int kk = 2 * i + (lane >> 5); float x = v[i]; if (d.gk) x *= d.gk[d.k0 + kk]; scr[kk * 33 + (lane & 31)] = x; }
    LDS_WAIT();
    const int c = lane & 7;
#pragma unroll
    for (int j = 0; j < 4; ++j) { const int n = (lane >> 3) + 8 * j; const LAS float* s = scr + (8 * c) * 33 + n;
        v4u o; o.x = pg8::cvt_pk_bf16(s[0 * 33], s[1 * 33]); o.y = pg8::cvt_pk_bf16(s[2 * 33], s[3 * 33]); o.z = pg8::cvt_pk_bf16(s[4 * 33], s[5 * 33]); o.w = pg8::cvt_pk_bf16(s[6 * 33], s[7 * 33]);
        *(v4u*)(d.WT + (size_t)(d.n0 + n) * d.K + d.k0 + 8 * c) = o; }
    LDS_WAIT();
}
__device__ __forceinline__ void fold_item(const float* __restrict__ W, bf16* __restrict__ WT, const float* __restrict__ wp, const float* __restrict__ ps, LAS float* scr, int item, int lane) {
    const int K = DM, N = DM; const int nblk = N / 32, g = item / nblk, nb = item % nblk, k0 = 64 * g, n0 = 32 * nb;
    LAS float* scr2 = scr + 64 * 33;
#pragma unroll 8
    for (int i = 0; i < 32; ++i) { const int kk = 2 * i + (lane >> 5); scr[kk * 33 + (lane & 31)] = W[(size_t)(k0 + kk) * N + n0 + (lane & 31)] * ps[k0 + kk]; }
    LDS_WAIT();
    const int n = lane & 31;
    for (int i = 0; i < 32; ++i) { const int kk = 2 * i + (lane >> 5); const float* wr = wp + (size_t)(g * 64 + kk) * 64; float a = 0.f;
#pragma unroll 16
        for (int d = 0; d < 64; ++d) a += wr[d] * scr[d * 33 + n];
        scr2[kk * 33 + n] = a; }
    LDS_WAIT();
    const int c = lane & 7;
#pragma unroll
    for (int j = 0; j < 4; ++j) { const int nn = (lane >> 3) + 8 * j; const LAS float* s = scr2 + (8 * c) * 33 + nn;
        v4u o; o.x = pk2(s[0 * 33], s[1 * 33]); o.y = pk2(s[2 * 33], s[3 * 33]); o.z = pk2(s[4 * 33], s[5 * 33]); o.w = pk2(s[6 * 33], s[7 * 33]);
        *(v4u*)(WT + (size_t)(n0 + nn) * K + k0 + 8 * c) = o; }
    LDS_WAIT();
}
__device__ __forceinline__ void rms_row_to_bf16(const float* __restrict__ xrow, bf16* __restrict__ orow, int lane) {
    const f32x4* xr = (const f32x4*)xrow + lane;
    f32x4 v[4]; float s = 0.f;
#pragma unroll
    for (int j = 0; j < 4; ++j) { v[j] = xr[64 * j]; s += (v[j].x * v[j].x + v[j].y * v[j].y) + (v[j].z * v[j].z + v[j].w * v[j].w); }
    const float rstd = rsqrtf(wave_sum(s) * (1.f / DM) + EPS);
    v2u* o8 = (v2u*)orow + lane;
#pragma unroll
    for (int j = 0; j < 4; ++j) { v2u o; o.x = pk2(v[j].x * rstd, v[j].y * rstd); o.y = pk2(v[j].z * rstd, v[j].w * rstd); o8[64 * j] = o; }
}
struct EwRow { f32x4 x[4]; v2u o[4]; };
__device__ __forceinline__ void ew_load(EwRow& r, const float* __restrict__ xrow, const bf16* __restrict__ orow, int lane) {
    const f32x4* xr = (const f32x4*)xrow + lane; const v2u* orr = (const v2u*)orow + lane;
#pragma unroll
    for (int j = 0; j < 4; ++j) { r.x[j] = xr[64 * j]; r.o[j] = orr[64 * j]; }
}
__device__ __forceinline__ void ew_finish(EwRow& r, const f32x4 (&gg)[4], float* __restrict__ Xrow, bf16* __restrict__ xnrow, bool write_xn, int lane) {
    f32x4 o[4]; float so = 0.f;
#pragma unroll
    for (int j = 0; j < 4; ++j) { const v2u w = r.o[j];
        o[j].x = __uint_as_float(w.x << 16); o[j].y = __uint_as_float(w.x & 0xffff0000u); o[j].z = __uint_as_float(w.y << 16); o[j].w = __uint_as_float(w.y & 0xffff0000u);
        so += (o[j].x * o[j].x + o[j].y * o[j].y) + (o[j].z * o[j].z + o[j].w * o[j].w); }
    const float rs = rsqrtf(wave_sum(so) * (1.f / DM) + EPS); float s1 = 0.f;
    f32x4* Xr = (f32x4*)Xrow + lane;
#pragma unroll
    for (int j = 0; j < 4; ++j) { f32x4 x = r.x[j] + o[j] * rs * gg[j]; r.x[j] = x; s1 += (x.x * x.x + x.y * x.y) + (x.z * x.z + x.w * x.w); Xr[64 * j] = x; }
    if (write_xn) { const float r1 = rsqrtf(wave_sum(s1) * (1.f / DM) + EPS); v2u* o8 = (v2u*)xnrow + lane;
#pragma unroll
        for (int j = 0; j < 4; ++j) { v2u w; w.x = pg8::cvt_pk_bf16(r.x[j].x * r1, r.x[j].y * r1); w.y = pg8::cvt_pk_bf16(r.x[j].z * r1, r.x[j].w * r1); o8[64 * j] = w; } }
}

template <bool SAMPLE>
__device__ __forceinline__ void pool_unit(const bf16* __restrict__ Z, bf16* __restrict__ CAT, const float* __restrict__ state, float* __restrict__ newp,
                                          int seq, int t0, int nrows, int g, int lane) {
    const int c = g * 64 + lane, w = 2 << g;
    const size_t rowbase = SAMPLE ? (size_t)MP + (size_t)seq * ST : (size_t)seq * SEQ;
    const bf16* zc = Z + rowbase * INW + c;
    const float* st = state + (size_t)seq * 15 * GW + c;
#define POOL_A(e) ((e) >= 0 ? bf2f(zc[(size_t)(e) * INW]) : (SAMPLE ? st[(15 + (e)) * GW] : 0.f))
    float S = 0.f;
    for (int j = 1; j < w; ++j) S += POOL_A(t0 - j);
#pragma unroll 4
    for (int t = t0; t < t0 + nrows; ++t) {
        const float a = POOL_A(t); S += a;
        const float cnt = SAMPLE ? (float)w : (float)(t + 1 < w ? t + 1 : w);
        CAT[(rowbase + t) * DM + c] = (bf16)f2bf(S / cnt - a);
        const int e = t - w + 1; S -= POOL_A(e);
    }
    const int T = SAMPLE ? ST : SEQ;
    if (t0 + nrows == T) {
        for (int j = 0; j < 15; ++j) { const int e = T - 15 + j; newp[((size_t)seq * 15 + j) * GW + c] = POOL_A(e); }
    }
#undef POOL_A
}
template <bool SAMPLE>
__device__ __forceinline__ void short_unit(const bf16* __restrict__ Z, bf16* __restrict__ CAT, const float* __restrict__ state, float* __restrict__ news,
                                           const float* __restrict__ sw, int seq, int t0, int nrows, int h, int lane) {
    const int c = h * 64 + lane;
    const size_t rowbase = SAMPLE ? (size_t)MP + (size_t)seq * ST : (size_t)seq * SEQ;
    const bf16* zc = Z + rowbase * INW + c;
    const float* st = state + (size_t)seq * 2 * GW + c;
    const float w0 = sw[c], w1 = sw[GW + c], w2 = sw[2 * GW + c];
#define SH_E(e) ((e) >= 0 ? bf2f(zc[(size_t)(e) * INW + 1536]) * bf2f(zc[(size_t)(e) * INW + 1792]) : (SAMPLE ? st[(2 + (e)) * GW] : 0.f))
    float e2 = SH_E(t0 - 2), e1 = SH_E(t0 - 1);
#pragma unroll 4
    for (int t = t0; t < t0 + nrows; ++t) {
        const float e0 = SH_E(t); const float bg = bf2f(zc[(size_t)t * INW + 1280]);
        CAT[(rowbase + t) * DM + 768 + c] = (bf16)f2bf(bg * (w0 * e2 + w1 * e1 + w2 * e0));
        e2 = e1; e1 = e0;
    }
    const int T = SAMPLE ? ST : SEQ;
    if (t0 + nrows == T) { news[((size_t)seq * 2 + 0) * GW + c] = e2; news[((size_t)seq * 2 + 1) * GW + c] = e1; }
#undef SH_E
}
template <bool SAMPLE>
__device__ __forceinline__ void conv_unit(const bf16* __restrict__ Z, bf16* __restrict__ CAT, const float* __restrict__ state, float* __restrict__ newc,
                                          const float* __restrict__ cw, const float* __restrict__ cb, const float* __restrict__ lg, const float* __restrict__ lb,
                                          int seq, int t0, int nrows, int h, LAS float* gL, int lane) {
    const int c = h * 64 + lane;
    const size_t rowbase = SAMPLE ? (size_t)MP + (size_t)seq * ST : (size_t)seq * SEQ;
    const bf16* zc = Z + rowbase * INW + c;
    bf16* oc = CAT + rowbase * DM + 256 + c;
    const int T = SAMPLE ? ST : SEQ;
    const bool last = (t0 + nrows == T);
    const int nin = nrows + 30;
#pragma unroll 4
    for (int r = 0; r < nin; ++r) { const int s = t0 - 30 + r; float gs = 0.f;
        if (s >= 0) { const unsigned off = (unsigned)s * INW; const float p = bf2f(zc[off + 256]), gt = bf2f(zc[off + 512]); gs = p * sigm(gt); }
        else if (SAMPLE) gs = state[((size_t)seq * 30 + 30 + s) * GW + c];
        if (last && s >= T - 30) newc[((size_t)seq * 30 + (s - (T - 30))) * GW + c] = gs;
        gL[r * 64 + lane] = gs; }
    LDS_WAIT();
    float wk[31];
#pragma unroll
    for (int k = 0; k < 31; ++k) wk[k] = cw[k * GW + c];
    const float bias = cb[c], gg = lg[c], bb = lb[c];
#pragma unroll 1
    for (int tq = 0; tq < nrows; tq += 4) {
        float acc[4] = {bias, bias, bias, bias};
#pragma unroll
        for (int r = 0; r < 34; ++r) { const float gv = gL[(tq + r) * 64 + lane];
#pragma unroll
            for (int q = 0; q < 4; ++q) { const int k = r - q; if (k >= 0 && k <= 30) acc[q] += wk[k] * gv; } }
#pragma unroll
        for (int q = 0; q < 4; ++q) { const float cv = acc[q];
            const float mean = wave_sum(cv) * (1.f / 64.f); const float d = cv - mean;
            const float var = wave_sum(d * d) * (1.f / 64.f);
            const float y = d * rsqrtf(var + EPS) * gg + bb;
            oc[(unsigned)(t0 + tq + q) * DM] = (bf16)f2bf(y * sigm(y)); }
    }
    LDS_WAIT();
}
template <int W>
__device__ __forceinline__ void pool_unit_p(const bf16* __restrict__ Z, bf16* __restrict__ CAT, float* __restrict__ newp, int seq, int t0, int g, int lane) {
    const int rr = lane >> 3, cg = lane & 7, c0 = g * 64 + cg * 8, tb = t0 + rr * 8;
    const size_t rowbase = (size_t)seq * SEQ;
    const bf16* zb = Z + (rowbase + tb) * INW + c0;
    v4u raw[W + 7];
#pragma unroll
    for (int j = 0; j < W + 7; ++j) { const int dj = j - (W - 1); raw[j] = (tb + dj >= 0) ? ld16(zb + (long)dj * INW) : (v4u){0u, 0u, 0u, 0u}; }
    float S[8];
#pragma unroll
    for (int i = 0; i < 8; ++i) S[i] = 0.f;
#pragma unroll
    for (int j = 0; j < W - 1; ++j) { float f[8]; unpack8(raw[j], f);
#pragma unroll
        for (int i = 0; i < 8; ++i) S[i] += f[i]; }
    bf16* ob = CAT + (rowbase + tb) * DM + c0;
    const bool lastseg = (t0 + 64 == SEQ);
#pragma unroll
    for (int j = 0; j < 8; ++j) { float a[8], o[8], od[8]; unpack8(raw[j + W - 1], a); unpack8(raw[j], od);
        const int t = tb + j; const float inv = 1.f / (float)(t + 1 < W ? t + 1 : W);
#pragma unroll
        for (int i = 0; i < 8; ++i) { S[i] += a[i]; o[i] = S[i] * inv - a[i]; S[i] -= od[i]; }
        *(v4u*)(ob + j * DM) = pack8(o);
        if (lastseg && t >= SEQ - 15) { float* np = newp + ((size_t)seq * 15 + (t - (SEQ - 15))) * GW + c0; *(f32x4*)np = (f32x4){a[0], a[1], a[2], a[3]}; *(f32x4*)(np + 4) = (f32x4){a[4], a[5], a[6], a[7]}; }
    }
}
__device__ __forceinline__ void short_unit_p(const bf16* __restrict__ Z, bf16* __restrict__ CAT, float* __restrict__ news, const float* __restrict__ sw, int seq, int t0, int h, int lane) {
    const int rr = lane >> 3, cg = lane & 7, c0 = h * 64 + cg * 8, tb = t0 + rr * 8;
    const size_t rowbase = (size_t)seq * SEQ;
    const bf16* zb = Z + (rowbase + tb) * INW + c0;
    v4u Bv[8], Cv[10], Hv[10];
#pragma unroll
    for (int j = 0; j < 10; ++j) { const int dj = j - 2; const bool ok = (tb + dj >= 0);
        Cv[j] = ok ? ld16(zb + (long)dj * INW + 1536) : (v4u){0u, 0u, 0u, 0u}; Hv[j] = ok ? ld16(zb + (long)dj * INW + 1792) : (v4u){0u, 0u, 0u, 0u};
        if (j >= 2) Bv[j - 2] = ld16(zb + (long)dj * INW + 1280); }
    float w0[8], w1[8], w2[8];
#pragma unroll
    for (int i = 0; i < 8; ++i) { w0[i] = sw[c0 + i]; w1[i] = sw[GW + c0 + i]; w2[i] = sw[2 * GW + c0 + i]; }
    float e2[8], e1[8];
    { float c[8], hh[8]; unpack8(Cv[0], c); unpack8(Hv[0], hh);
#pragma unroll
      for (int i = 0; i < 8; ++i) e2[i] = c[i] * hh[i];
      unpack8(Cv[1], c); unpack8(Hv[1], hh);
#pragma unroll
      for (int i = 0; i < 8; ++i) e1[i] = c[i] * hh[i]; }
    bf16* ob = CAT + (rowbase + tb) * DM + 768 + c0;
#pragma unroll
    for (int j = 0; j < 8; ++j) { float c[8], hh[8], b[8], o[8]; unpack8(Cv[j + 2], c); unpack8(Hv[j + 2], hh); unpack8(Bv[j], b);
#pragma unroll
        for (int i = 0; i < 8; ++i) { const float e0 = c[i] * hh[i]; o[i] = b[i] * (w0[i] * e2[i] + w1[i] * e1[i] + w2[i] * e0); e2[i] = e1[i]; e1[i] = e0; }
        *(v4u*)(ob + j * DM) = pack8(o); }
    if (t0 + 64 == SEQ && rr == 7) { float* np = news + (size_t)seq * 2 * GW + c0;
        *(f32x4*)np = (f32x4){e2[0], e2[1], e2[2], e2[3]}; *(f32x4*)(np + 4) = (f32x4){e2[4], e2[5], e2[6], e2[7]};
        *(f32x4*)(np + GW) = (f32x4){e1[0], e1[1], e1[2], e1[3]}; *(f32x4*)(np + GW + 4) = (f32x4){e1[4], e1[5], e1[6], e1[7]}; }
}
__device__ __forceinline__ void conv_unit_p(const bf16* __restrict__ Z, bf16* __restrict__ CAT, float* __restrict__ newc,
                                            const float* __restrict__ cw, const float* __restrict__ cb, const float* __restrict__ lg, const float* __restrict__ lb,
                                            int seq, int t0, int h, LAS float* gL, int lane) {
    const int rr = lane >> 3, cg = lane & 7, c0 = h * 64 + cg * 8;
    const size_t rowbase = (size_t)seq * SEQ;
    const bool last = (t0 + 32 == SEQ);
    { v4u pv[8], gv[8];
#pragma unroll
      for (int j = 0; j < 8; ++j) { const int r = 8 * j + rr, sx = t0 - 30 + r; const bool ok = (sx >= 0 && r < 62);
          const bf16* zp = Z + (rowbase + (ok ? sx : 0)) * INW + c0;
          pv[j] = ok ? ld16(zp + 256) : (v4u){0u, 0u, 0u, 0u}; gv[j] = ok ? ld16(zp + 512) : (v4u){0u, 0u, 0u, 0u}; }
#pragma unroll
      for (int j = 0; j < 8; ++j) { const int r = 8 * j + rr, sx = t0 - 30 + r; float p[8], gt[8]; unpack8(pv[j], p); unpack8(gv[j], gt);
#pragma unroll
          for (int i = 0; i < 8; ++i) p[i] = p[i] * sigm(gt[i]);
          if (r < 62) { *(LAS f32x4*)(gL + r * 64 + cg * 8) = (f32x4){p[0], p[1], p[2], p[3]}; *(LAS f32x4*)(gL + r * 64 + cg * 8 + 4) = (f32x4){p[4], p[5], p[6], p[7]}; }
          if (last && sx >= SEQ - 30 && r < 62) { float* np = newc + ((size_t)seq * 30 + (sx - (SEQ - 30))) * GW + c0; *(f32x4*)np = (f32x4){p[0], p[1], p[2], p[3]}; *(f32x4*)(np + 4) = (f32x4){p[4], p[5], p[6], p[7]}; } }
    }
    LDS_WAIT();
    const int c = h * 64 + lane;
    float wk[31];
#pragma unroll
    for (int k = 0; k < 31; ++k) wk[k] = cw[k * GW + c];
    const float bias = cb[c], gg = lg[c], bb = lb[c];
#pragma unroll 1
    for (int tq = 0; tq < 32; tq += 4) {
        float acc[4] = {bias, bias, bias, bias};
#pragma unroll
        for (int r = 0; r < 34; ++r) { const float gvv = gL[(tq + r) * 64 + lane];
#pragma unroll
            for (int q = 0; q < 4; ++q) { const int k = r - q; if (k >= 0 && k <= 30) acc[q] += wk[k] * gvv; } }
        float y[4];
#pragma unroll
        for (int q = 0; q < 4; ++q) { const float cv = acc[q];
            const float mean = wave_sum(cv) * (1.f / 64.f); const float d = cv - mean;
            const float var = wave_sum(d * d) * (1.f / 64.f);
            const float yy = d * rsqrtf(var + EPS) * gg + bb; y[q] = yy * sigm(yy); }
        LDS_WAIT();
#pragma unroll
        for (int q = 0; q < 4; ++q) gL[(tq + q) * 64 + lane] = y[q];
    }
    LDS_WAIT();
    bf16* ob = CAT + (rowbase + t0) * DM + 256 + c0;
#pragma unroll
    for (int j = 0; j < 4; ++j) { const int r = 8 * j + rr; const f32x4 a = *(const LAS f32x4*)(gL + r * 64 + cg * 8), b = *(const LAS f32x4*)(gL + r * 64 + cg * 8 + 4);
        const float o[8] = {a[0], a[1], a[2], a[3], b[0], b[1], b[2], b[3]}; *(v4u*)(ob + r * DM) = pack8(o); }
    LDS_WAIT();
}
__device__ __forceinline__ int sgu_swz(int c, int chunk) { return (chunk ^ ((c & 15) ^ (c >> 4))) << 3; }
__device__ __forceinline__ void sgu_unit(const bf16* __restrict__ Z, bf16* __restrict__ CAT, const bf16* __restrict__ Wb, const float* __restrict__ lg, const float* __restrict__ lb,
                                         const float* __restrict__ sb, int chunk, int h, LAS bf16* vT, int lane) {
    const size_t r0 = (size_t)chunk * 128;
    { const int rr = lane >> 3, cg = lane & 7, c0 = h * 64 + cg * 8;
      float gg[8], bb[8];
#pragma unroll
      for (int i = 0; i < 8; ++i) { gg[i] = lg[c0 + i]; bb[i] = lb[c0 + i]; }
#pragma unroll 1
      for (int jh = 0; jh < 16; jh += 8) {
          v4u raw[8];
#pragma unroll
          for (int j = 0; j < 8; ++j) raw[j] = ld16(Z + (r0 + 8 * (jh + j) + rr) * INW + 1024 + c0);
#pragma unroll
          for (int j = 0; j < 8; ++j) { float x[8]; unpack8(raw[j], x);
              float sm = ((x[0] + x[1]) + (x[2] + x[3])) + ((x[4] + x[5]) + (x[6] + x[7])); const float mean = sum8(sm) * (1.f / 64.f);
              float q = 0.f;
#pragma unroll
              for (int i = 0; i < 8; ++i) { x[i] -= mean; q += x[i] * x[i]; }
              const float rstd = rsqrtf(sum8(q) * (1.f / 64.f) + EPS);
#pragma unroll
              for (int i = 0; i < 8; ++i) { const int cl = cg * 8 + i; vT[cl * 128 + sgu_swz(cl, jh + j) + rr] = (bf16)f2bf(x[i] * rstd * gg[i] + bb[i]); } }
      }
    }
    LDS_WAIT();
    const int fr = lane & 15, fq = lane >> 4;
#pragma unroll 1
    for (int mt = 0; mt < 8; ++mt) {
        f32x4 acc[4];
#pragma unroll
        for (int nt = 0; nt < 4; ++nt) acc[nt] = (f32x4){0.f, 0.f, 0.f, 0.f};
        const int nks = (mt * 16 + 15) / 32 + 1;
        const int t = mt * 16 + fr;
        v2u uv[4];
#pragma unroll
        for (int nt = 0; nt < 4; ++nt) uv[nt] = *(const v2u*)(Z + (r0 + t) * INW + 768 + h * 64 + nt * 16 + 4 * fq);
        const float bt = sb[h * 128 + t];
#pragma unroll 1
        for (int ks = 0; ks < nks; ++ks) {
            const bf16x8 wf = *(const bf16x8*)(Wb + ((size_t)(h * 128 + t) * 128 + ks * 32 + fq * 8));
#pragma unroll
            for (int nt = 0; nt < 4; ++nt) { const int cl = nt * 16 + fr; const bf16x8 vf = *(const LAS bf16x8*)(vT + cl * 128 + sgu_swz(cl, ks * 4 + fq));
                acc[nt] = __builtin_amdgcn_mfma_f32_16x16x32_bf16(vf, wf, acc[nt], 0, 0, 0); }
        }
#pragma unroll
        for (int nt = 0; nt < 4; ++nt) { const float u0 = __uint_as_float(uv[nt].x << 16), u1 = __uint_as_float(uv[nt].x & 0xffff0000u), u2 = __uint_as_float(uv[nt].y << 16), u3 = __uint_as_float(uv[nt].y & 0xffff0000u);
            v2u w; w.x = pg8::cvt_pk_bf16(u0 * (acc[nt][0] + bt), u1 * (acc[nt][1] + bt)); w.y = pg8::cvt_pk_bf16(u2 * (acc[nt][2] + bt), u3 * (acc[nt][3] + bt));
            *(v2u*)(CAT + (r0 + t) * DM + 512 + h * 64 + nt * 16 + 4 * fq) = w; }
    }
    LDS_WAIT();
}
__device__ __forceinline__ void sgu_sample_unit(const bf16* __restrict__ Z, bf16* __restrict__ CAT, const float* __restrict__ Wf, const float* __restrict__ lg, const float* __restrict__ lb,
                                                const float* __restrict__ sb, float* __restrict__ vout, int seq, int h, int lane) {
    const int c = h * 64 + lane; const size_t rowbase = (size_t)MP + (size_t)seq * ST;
    const float gg = lg[c], bb = lb[c];
    float vn[ST];
#pragma unroll
    for (int t = 0; t < ST; ++t) { const float v = bf2f(Z[(rowbase + t) * INW + 1024 + c]); const float mean = wave_sum(v) * (1.f / 64.f); const float d = v - mean; const float var = wave_sum(d * d) * (1.f / 64.f);
        vn[t] = d * rsqrtf(var + EPS) * gg + bb; vout[((size_t)seq * ST + t) * GW + c] = vn[t]; }
#pragma unroll
    for (int t = 0; t < ST; ++t) { float sv = sb[h * 128 + t];
#pragma unroll
        for (int s = 0; s <= t; ++s) sv += Wf[((size_t)h * 128 + t) * 128 + s] * vn[s];
        const float u = bf2f(Z[(rowbase + t) * INW + 768 + c]);
        CAT[(rowbase + t) * DM + 512 + c] = (bf16)f2bf(u * sv); }
}

#define XB_TMO      128
#define XB_XCNT(j)  (256  + 64 * (j))
#define XB_XSUB(j)  (1280 + 64 * (j))
#define XB_XGEN(j)  (2304 + 64 * (j))
#define XB_TOP      3328
#define XB_TOPGEN   3392
#define XCD_BAR_WORDS 3456
#define XB_SPIN_CAP (1u << 18)

__device__ __forceinline__ unsigned xb_ld(unsigned* p)              { return __hip_atomic_load(p, __ATOMIC_RELAXED, __HIP_MEMORY_SCOPE_AGENT); }
__device__ __forceinline__ unsigned xb_add(unsigned* p, unsigned v) { return __hip_atomic_fetch_add(p, v, __ATOMIC_RELAXED, __HIP_MEMORY_SCOPE_AGENT); }
__device__ __forceinline__ unsigned xb_xcc_id() { return (unsigned)__builtin_amdgcn_s_getreg((3 << 11) | 20) & 0xFu; }
#define XB_SPIN(cond, bar) do { unsigned _sp = 0; while (cond) { __builtin_amdgcn_s_sleep(1); \
    if ((++_sp & 255u) == 0u) { if (xb_ld(&(bar)[XB_TMO])) break; if (_sp > XB_SPIN_CAP) { atomicAdd(&(bar)[XB_TMO], 1u); break; } } } } while (0)

struct XcdBarrier {
    unsigned* bar; unsigned x;
    volatile LAS unsigned* st;
};

__device__ __forceinline__ XcdBarrier xcd_barrier_post(unsigned* bar, volatile LAS unsigned* st) {
    XcdBarrier b; b.bar = bar; b.x = xb_xcc_id(); b.st = st;
    if (threadIdx.x == 0) (void)xb_add(&bar[XB_XCNT(b.x)], 1u);
    return b;
}
__device__ __forceinline__ void xcd_barrier_complete(unsigned* bar, unsigned x, unsigned& nloc, unsigned& nx) {
    const unsigned G = gridDim.x * gridDim.y * gridDim.z;
    unsigned sum, cnt, mine, sp = 0u;
    for (;;) {
        sum = 0u; cnt = 0u; mine = 0u;
#pragma unroll
        for (unsigned j = 0; j < 16; ++j) { const unsigned c = xb_ld(&bar[XB_XCNT(j)]); sum += c; cnt += (c > 0u) ? 1u : 0u; mine = (j == x) ? c : mine; }
        if (sum == G) break;
        __builtin_amdgcn_s_sleep(1);
        if ((++sp & 255u) == 0u) { if (xb_ld(&bar[XB_TMO])) break; if (sp > XB_SPIN_CAP) { atomicAdd(&bar[XB_TMO], 1u); break; } }
    }
    nloc = mine > 0u ? mine : 1u; nx = cnt > 0u ? cnt : 1u;
}

__device__ __forceinline__ void xcd_barrier(const XcdBarrier& b) {
    asm volatile("s_waitcnt vmcnt(0)" ::: "memory");
    __syncthreads();
    if (threadIdx.x == 0) {
        unsigned* bar = b.bar;
        __builtin_amdgcn_s_waitcnt(0);
        unsigned nloc = b.st[0], nx = b.st[1];
        if (nloc == 0u) { xcd_barrier_complete(bar, b.x, nloc, nx); b.st[0] = nloc; b.st[1] = nx; }
        const unsigned old = xb_add(&bar[XB_XSUB(b.x)], 1u);
        const unsigned gen = old / nloc;
        if (old + 1u == (gen + 1u) * nloc) {
            __builtin_amdgcn_fence(__ATOMIC_RELEASE, "agent");
            asm volatile("s_waitcnt vmcnt(0)" ::: "memory");
            const unsigned og = xb_add(&bar[XB_TOP], 1u);
            const unsigned tg = og / nx;
            if (og + 1u == (tg + 1u) * nx) xb_add(&bar[XB_TOPGEN], 1u);
            else XB_SPIN(xb_ld(&bar[XB_TOPGEN]) == tg, bar);
            __builtin_amdgcn_fence(__ATOMIC_ACQUIRE, "agent");
            xb_add(&bar[XB_XGEN(b.x)], 1u);
            asm volatile("s_waitcnt vmcnt(0)" ::: "memory");
        } else {
            XB_SPIN(xb_ld(&bar[XB_XGEN(b.x)]) == gen, bar);
            __builtin_amdgcn_fence(__ATOMIC_ACQUIRE, "agent");
            asm volatile("s_waitcnt vmcnt(0)" ::: "memory");
        }
    }
    __syncthreads();
}

template <int NT, int ACT, int K>
__device__ __forceinline__ void small_gemm_tile(LAS unsigned char* lds, const bf16* __restrict__ A, const bf16* __restrict__ Bt, bf16* __restrict__ O, int ldc, int m0, int n0, int tid) {
    constexpr int NC = 16 * NT, KW = K / 8, NCH = KW / 128;
    const int wave = __builtin_amdgcn_readfirstlane(tid >> 6), lane = tid & 63, fr = lane & 15, fq = lane >> 4;
    const bf16* ap = A + (size_t)(m0 + fr) * K + wave * KW + fq * 8;
    const bf16* bp = Bt + (size_t)(n0 + fr) * K + wave * KW + fq * 8;
    f32x4 acc[4][NT];
#pragma unroll
    for (int m = 0; m < 4; ++m)
#pragma unroll
        for (int n = 0; n < NT; ++n) acc[m][n] = (f32x4){0.f, 0.f, 0.f, 0.f};
    bf16x8 fa[4][4], fb[4][NT];
#pragma unroll
    for (int c = 0; c < NCH; ++c) {
#pragma unroll
        for (int s_ = 0; s_ < 4; ++s_) {
#pragma unroll
            for (int m = 0; m < 4; ++m) fa[s_][m] = *(const bf16x8*)(ap + (size_t)m * 16 * K + c * 128 + s_ * 32);
#pragma unroll
            for (int n = 0; n < NT; ++n) fb[s_][n] = *(const bf16x8*)(bp + (size_t)n * 16 * K + c * 128 + s_ * 32); }
        __builtin_amdgcn_sched_barrier(0);
#pragma unroll
        for (int s_ = 0; s_ < 4; ++s_)
#pragma unroll
            for (int m = 0; m < 4; ++m)
#pragma unroll
                for (int n = 0; n < NT; ++n) acc[m][n] = __builtin_amdgcn_mfma_f32_16x16x32_bf16(fa[s_][m], fb[s_][n], acc[m][n], 0, 0, 0);
        __builtin_amdgcn_sched_barrier(0);
    }
    LAS float* P = (LAS float*)lds + wave * (64 * NC);
#pragma unroll
    for (int m = 0; m < 4; ++m)
#pragma unroll
        for (int n = 0; n < NT; ++n)
#pragma unroll
            for (int i = 0; i < 4; ++i) P[(m * 16 + fq * 4 + i) * NC + n * 16 + fr] = acc[m][n][i];
    __syncthreads();
    constexpr int EPT = 64 * NC / 512;
    const int e0 = tid * EPT, row = e0 / NC, col = e0 % NC;
    float r[EPT];
#pragma unroll
    for (int j = 0; j < EPT; ++j) r[j] = 0.f;
#pragma unroll
    for (int w = 0; w < 8; ++w) { const LAS f32x4* q = (const LAS f32x4*)((LAS float*)lds + w * (64 * NC) + e0);
#pragma unroll
        for (int j = 0; j < EPT / 4; ++j) { const f32x4 v = q[j]; r[4 * j] += v[0]; r[4 * j + 1] += v[1]; r[4 * j + 2] += v[2]; r[4 * j + 3] += v[3]; } }
    if (ACT == 1) {
#pragma unroll
        for (int j = 0; j < EPT; ++j) { const float t = fmaxf(r[j], 0.f); r[j] = t * t; } }
    bf16* op = O + (size_t)(m0 + row) * ldc + n0 + col;
    if (EPT == 8) { v4u w; w.x = pk2(r[0], r[1]); w.y = pk2(r[2], r[3]); w.z = pk2(r[4 % EPT], r[5 % EPT]); w.w = pk2(r[6 % EPT], r[7 % EPT]); *(v4u*)op = w; }
    else { v2u w; w.x = pk2(r[0], r[1]); w.y = pk2(r[2], r[3]); *(v2u*)op = w; }
    __syncthreads();
}

#define SMALL_TN(j, ntn) ((((j) >> 8) * 32 + ((j) & 7) * 4 + (((j) >> 3) & 3)))
constexpr int NPH = 15;
#ifndef REP_PRO
#define REP_PRO 1
#endif
#ifndef REP_GEMM
#define REP_GEMM 1
#endif
#ifndef REP_MIX
#define REP_MIX 1
#endif
#ifndef REP_SYNC
#define REP_SYNC 1
#endif
struct Args { const float* in[24]; float* out; unsigned char* ws; int ph_lo, ph_hi; };
__global__ void __launch_bounds__(NWAVES * 64, 2) hybrid_fwd(Args args) {
    extern __shared__ __attribute__((aligned(16))) unsigned char lds_raw[];
    LAS unsigned char* lds = (LAS unsigned char*)lds_raw;
    volatile LAS unsigned* MISC = (volatile LAS unsigned*)(lds + MISC_OFF);
    if (threadIdx.x < 64) MISC[threadIdx.x] = 0u;
    __syncthreads();
    (void)xcd_barrier_post((unsigned*)(args.ws + WS_CTL), MISC + 8);
    for (int ph = args.ph_lo; ph < args.ph_hi;) {
        int tid = threadIdx.x; asm volatile("" : "+v"(tid));
        const int lane = tid & 63, wave = __builtin_amdgcn_readfirstlane(tid >> 6);
        const int G = gridDim.x; const int bx = blockIdx.x;
        unsigned char* ws = args.ws;
        if (ph == 0) {
            const int vcu = (G % 8 == 0) ? (bx % 8) * (G / 8) + bx / 8 : bx; const int gw = vcu * NWAVES + wave, NGW = G * NWAVES;
            LAS float* scr = (LAS float*)(lds + wave * WAVE_SCR);
            bf16* XN = (bf16*)(ws + WS_XN); bf16* SGW = (bf16*)(ws + WS_SGUW);
            constexpr int I_FOLD = 4 * (DM / 32), I_OUT = (DM / 64) * (DM / 32) - I_FOLD, I_IN = (DM / 64) * (INW / 32), I_UP = (DM / 64) * (FF / 32), I_DN = (FF / 64) * (DM / 32);
            constexpr int I_LAYER = I_OUT + I_IN + I_UP + I_DN, I_ALL = DEPTH * I_LAYER;
            for (int it = gw; it < DEPTH * I_FOLD; it += NGW) { const int l = it / I_FOLD, r = it % I_FOLD;
                fold_item(args.in[10] + (size_t)l * DM * DM, (bf16*)(ws + WS_W + (size_t)l * W_LAYER + W_OUT), args.in[11] + (size_t)l * 4 * 64 * 64, args.in[12] + (size_t)l * GW, scr, r, lane); }
#define TR_DECODE(it_, d_) do { const int l_ = (it_) / I_LAYER; int r_ = (it_) % I_LAYER; unsigned char* wl_ = ws + WS_W + (size_t)l_ * W_LAYER; int nblk_; \
                if (r_ < I_OUT) { r_ += I_FOLD; d_.W = args.in[10] + (size_t)l_ * DM * DM; d_.WT = (bf16*)(wl_ + W_OUT); d_.gk = nullptr; d_.K = DM; d_.N = DM; } \
                else if ((r_ -= I_OUT) < I_IN) { d_.W = args.in[9] + (size_t)l_ * DM * INW; d_.WT = (bf16*)(wl_ + W_IN); d_.gk = args.in[5] + (size_t)l_ * DM; d_.K = DM; d_.N = INW; } \
                else if ((r_ -= I_IN) < I_UP) { d_.W = args.in[22] + (size_t)l_ * DM * FF; d_.WT = (bf16*)(wl_ + W_UP); d_.gk = args.in[7] + (size_t)l_ * DM; d_.K = DM; d_.N = FF; } \
                else { r_ -= I_UP; d_.W = args.in[23] + (size_t)l_ * FF * DM; d_.WT = (bf16*)(wl_ + W_DN); d_.gk = nullptr; d_.K = FF; d_.N = DM; } \
                nblk_ = d_.N / 32; d_.k0 = 64 * (r_ / nblk_); d_.n0 = 32 * (r_ % nblk_); } while (0)
            { int it = NGW - 1 - gw;
              if (it < I_ALL) {
                TrDesc dc; TR_DECODE(it, dc);
                float va[32], vb[32];
                tr_load(va, dc, lane);
#pragma unroll 1
                for (;;) {
                    const int itn = it + NGW; const bool more = itn < I_ALL;
                    TrDesc dn; { const int q = more ? itn : it; TR_DECODE(q, dn); }
                    tr_load(vb, dn, lane);
                    tr_store(va, dc, scr, lane);
                    if (!more) break;
#pragma unroll
                    for (int i = 0; i < 32; ++i) va[i] = vb[i];
                    dc = dn; it = itn;
                }
              }
            }
#undef TR_DECODE
            for (int m = gw; m < MT; m += NGW) rms_row_to_bf16(m < MP ? args.in[0] + (size_t)m * DM : args.in[1] + (size_t)(m - MP) * DM, XN + (size_t)m * DM, lane);
            for (int e = bx * (NWAVES * 64) + tid; e < DEPTH * 4 * 128 * 128; e += G * NWAVES * 64) { const int t = (e >> 7) & 127, s = e & 127; SGW[e] = (bf16)(s <= t ? f2bf(args.in[19][e]) : 0u); }
        } else {
            const int l = (ph - 1) / 7, k = (ph - 1) - 7 * l;
            unsigned char* wl = ws + WS_W + (size_t)l * W_LAYER;
            if (k == 0 || k == 2 || k == 5) {
                const bf16* A = (const bf16*)(ws + (k == 0 ? WS_XN : k == 2 ? WS_CAT : WS_H));
                const bf16* Bt = (const bf16*)(wl + (k == 0 ? W_IN : k == 2 ? W_OUT : W_DN));
                bf16* O = (bf16*)(ws + (k == 0 ? WS_Z : WS_O));
                const int N = k == 0 ? INW : DM, K = k == 5 ? FF : DM;
                pg8::Gemm g{A, Bt, MP, N, K}; pg8::StaticOrder S; S.init(MP, N, G, bx);
                pg8::EpiBf16<0> E{O, N};
                pg8::gemm_phase<pg8::EpiBf16<0>, pg8::StaticOrder, true, true>(lds, g, S, E, tid);
                if (k == 0) { for (int j = bx; j < (MS / 64) * (INW / 64); j += G) small_gemm_tile<4, 0, DM>(lds, A, Bt, O, N, MP + ((j >> 5) & 7) * 64, SMALL_TN(j, INW / 64) * 64, tid); }
                else { for (int j = bx; j < (MS / 64) * (DM / 32); j += G) { if (k == 2) small_gemm_tile<2, 0, DM>(lds, A, Bt, O, N, MP + ((j >> 5) & 7) * 64, SMALL_TN(j, DM / 32) * 32, tid); else small_gemm_tile<2, 0, FF>(lds, A, Bt, O, N, MP + ((j >> 5) & 7) * 64, SMALL_TN(j, DM / 32) * 32, tid); } }
            } else if (k == 4) {
                pg8::Gemm g{(const bf16*)(ws + WS_XN), (const bf16*)(wl + W_UP), MP, FF, DM}; pg8::StaticOrder S; S.init(MP, FF, G, bx);
                pg8::EpiBf16<1> E{(bf16*)(ws + WS_H), FF};
                pg8::gemm_phase<pg8::EpiBf16<1>, pg8::StaticOrder, true, true>(lds, g, S, E, tid);
                for (int j = bx; j < (MS / 64) * (FF / 64); j += G) small_gemm_tile<4, 1, DM>(lds, (const bf16*)(ws + WS_XN), (const bf16*)(wl + W_UP), (bf16*)(ws + WS_H), FF, MP + ((j >> 5) & 7) * 64, SMALL_TN(j, FF / 64) * 64, tid);
            } else if (k == 1) {
                const int vcu = (G % 8 == 0) ? (bx % 8) * (G / 8) + bx / 8 : bx; const int gw = vcu * NWAVES + wave, NGW = G * NWAVES;
                LAS float* scr = (LAS float*)(lds + wave * WAVE_SCR);
                const bf16* ZB = (const bf16*)(ws + WS_Z); bf16* CAT = (bf16*)(ws + WS_CAT); const bf16* SGW = (const bf16*)(ws + WS_SGUW) + (size_t)l * 4 * 128 * 128;
                float* out = args.out;
                constexpr int NU_SGU = 512, NU_CONV = 2048, NU_SEG = 1024, NU_SMP = 2048, NU = NU_SGU + NU_CONV + 2 * NU_SEG + NU_SMP;
#pragma unroll 1
                for (int ui = 0; ui * NGW < NU; ++ui) {
                    const int u = ui * NGW + ((ui & 1) ? NGW - 1 - gw : gw);
                    if (u >= NU) continue;
                    int lane = tid & 63; asm volatile("" : "+v"(lane));
                    if (u < NU_SGU) { sgu_unit(ZB, CAT, SGW, args.in[17] + (size_t)l * GW, args.in[18] + (size_t)l * GW, args.in[20] + (size_t)l * 4 * 128, u >> 2, u & 3, (LAS bf16*)scr, lane); continue; }
                    int r = u - NU_SGU;
                    if (r < NU_CONV) { const int seg = r >> 2, h = r & 3, seq = seg >> 6, t0 = (seg & 63) * 32;
                        conv_unit_p(ZB, CAT, out + OUT_CONV_P + (size_t)l * NBP * 30 * GW, args.in[13] + (size_t)l * 31 * GW, args.in[14] + (size_t)l * GW, args.in[15] + (size_t)l * GW, args.in[16] + (size_t)l * GW, seq, t0, h, scr, lane);
                        continue; }
                    r -= NU_CONV;
                    if (r < 2 * NU_SEG) { const int ty = r / NU_SEG, q = r % NU_SEG, seg = q >> 2, h = q & 3, seq = seg >> 5, t0 = (seg & 31) * 64;
                        if (ty == 0) { float* np = out + OUT_POOL_P + (size_t)l * NBP * 15 * GW;
                            if (h == 0) pool_unit_p<2>(ZB, CAT, np, seq, t0, h, lane); else if (h == 1) pool_unit_p<4>(ZB, CAT, np, seq, t0, h, lane);
                            else if (h == 2) pool_unit_p<8>(ZB, CAT, np, seq, t0, h, lane); else pool_unit_p<16>(ZB, CAT, np, seq, t0, h, lane); }
                        else short_unit_p(ZB, CAT, out + OUT_SHORT_P + (size_t)l * NBP * 2 * GW, args.in[21] + (size_t)l * 3 * GW, seq, t0, h, lane);
                        continue; }
                    r -= 2 * NU_SEG;
                    { const int ty = r >> 9, q = r & 511, seq = q >> 2, h = q & 3;
                        if (ty == 0) conv_unit<true>(ZB, CAT, args.in[3] + (size_t)l * NSB * 30 * GW, out + OUT_CONV_S + (size_t)l * NSB * 30 * GW, args.in[13] + (size_t)l * 31 * GW, args.in[14] + (size_t)l * GW, args.in[15] + (size_t)l * GW, args.in[16] + (size_t)l * GW, seq, 0, ST, h, scr, lane);
                        else if (ty == 1) pool_unit<true>(ZB, CAT, args.in[2] + (size_t)l * NSB * 15 * GW, out + OUT_POOL_S + (size_t)l * NSB * 15 * GW, seq, 0, ST, h, lane);
                        else if (ty == 2) short_unit<true>(ZB, CAT, args.in[4] + (size_t)l * NSB * 2 * GW, out + OUT_SHORT_S + (size_t)l * NSB * 2 * GW, args.in[21] + (size_t)l * 3 * GW, seq, 0, ST, h, lane);
                        else sgu_sample_unit(ZB, CAT, args.in[19] + (size_t)l * 4 * 128 * 128, args.in[17] + (size_t)l * GW, args.in[18] + (size_t)l * GW, args.in[20] + (size_t)l * 4 * 128, out + OUT_V_S + (size_t)l * NSB * ST * GW, seq, h, lane); }
                }
            } else {
                const int vcu = (G % 8 == 0) ? (bx % 8) * (G / 8) + bx / 8 : bx; const int gw = vcu * NWAVES + wave, NGW = G * NWAVES;
                const float* g = args.in[k == 3 ? 6 : 8] + (size_t)l * DM;
                float* X = args.out; const bf16* OB = (const bf16*)(ws + WS_O); bf16* XN = (bf16*)(ws + WS_XN);
                const bool from_input = (l == 0 && k == 3), write_xn = !(l == DEPTH - 1 && k == 6);
                f32x4 gg[4];
#pragma unroll
                for (int j = 0; j < 4; ++j) gg[j] = ((const f32x4*)g + lane)[64 * j];
#define EW_XSRC(m) (from_input ? ((m) < MP ? args.in[0] + (size_t)(m) * DM : args.in[1] + (size_t)((m) - MP) * DM) : X + (size_t)(m) * DM)
                const int m_lo = 0;
#pragma unroll 1
                for (int m = m_lo + gw; m < MT; m += 2 * NGW) {
                    const int m2 = m + NGW; const bool two = m2 < MT;
                    EwRow ra, rb;
                    ew_load(ra, EW_XSRC(m), OB + (size_t)m * DM, lane);
                    { const int mc = two ? m2 : m; ew_load(rb, EW_XSRC(mc), OB + (size_t)mc * DM, lane); }
                    ew_finish(ra, gg, X + (size_t)m * DM, XN + (size_t)m * DM, write_xn, lane);
                    if (two) ew_finish(rb, gg, X + (size_t)m2 * DM, XN + (size_t)m2 * DM, write_xn, lane);
                }
#undef EW_XSRC
            }
        }
        ++ph;
        if (ph < args.ph_hi) {
            if (args.ph_lo < 0) cg::this_grid().sync();
            else { XcdBarrier b; b.bar = (unsigned*)(args.ws + WS_CTL); b.x = xb_xcc_id(); b.st = (volatile LAS unsigned*)(lds + MISC_OFF) + 8; xcd_barrier(b); }
        }
    }
}

#ifndef MK_N_LAUNCHES
#define MK_N_LAUNCHES 1
#endif
extern "C" void kernel_launch(void* const* d_in, const int* in_sizes, int n_in, void* d_out, int out_size, void* d_ws, size_t ws_size, hipStream_t stream) {
    static int grid = 0;
    if (grid == 0) {
        if (n_in != 24 || (size_t)out_size != OUT_END || ws_size < WS_END) { fprintf(stderr, "kernel_launch: unexpected shapes (n_in %d out %d ws %zu)\n", n_in, out_size, ws_size); grid = -1; return; }
        int dev = 0, cus = 0, per_cu = 0;
        if (hipGetDevice(&dev) != hipSuccess || hipDeviceGetAttribute(&cus, hipDeviceAttributeMultiprocessorCount, dev) != hipSuccess) { grid = -1; return; }
        if (hipFuncSetAttribute((const void*)hybrid_fwd, hipFuncAttributeMaxDynamicSharedMemorySize, LDS_BYTES) != hipSuccess) { fprintf(stderr, "kernel_launch: hipFuncSetAttribute failed\n"); grid = -1; return; }
        if (hipOccupancyMaxActiveBlocksPerMultiprocessor(&per_cu, (const void*)hybrid_fwd, NWAVES * 64, LDS_BYTES) != hipSuccess || per_cu < 1) per_cu = 1;
        (void)hipGetLastError();
        grid = cus * per_cu;
    }
    if (grid < 0) return;
    if (hipMemsetAsync((char*)d_ws + WS_CTL, 0, CTL_ZERO_BYTES, stream) != hipSuccess) { fprintf(stderr, "kernel_launch: hipMemsetAsync failed\n"); return; }
    Args a{};
    for (int i = 0; i < 24; ++i) a.in[i] = (const float*)d_in[i];
    a.out = (float*)d_out; a.ws = (unsigned char*)d_ws;
#if MK_N_LAUNCHES == 1
    a.ph_lo = 0; a.ph_hi = NPH;
    void* kargs[] = {&a};
    hipError_t e = hipLaunchCooperativeKernel((const void*)hybrid_fwd, dim3(grid), dim3(NWAVES * 64), kargs, LDS_BYTES, stream);
    if (e != hipSuccess) fprintf(stderr, "cooperative launch failed: %s (grid %d)\n", hipGetErrorString(e), grid);
#else
    for (int p = 0; p < NPH; ++p) { a.ph_lo = p; a.ph_hi = p + 1; hipLaunchKernelGGL(hybrid_fwd, dim3(grid), dim3(NWAVES * 64), LDS_BYTES, stream, a); }
#endif
}
```

```cpp
#include <hip/hip_runtime.h>
#include <hip/hip_cooperative_groups.h>
#include <cstdio>
#include <cstdint>
namespace pg8 {
#define PG8_LAS __attribute__((address_space(3)))
typedef unsigned short bf16_t;
typedef short bf16x8 __attribute__((ext_vector_type(8)));
typedef float f32x4 __attribute__((ext_vector_type(4)));
typedef unsigned u32x4 __attribute__((ext_vector_type(4)));
constexpr int BM = 256, BK = 64, HALF = 128, HTB = HALF * BK * 2  , STAGE_BYTES = 8 * HTB, NXCD = 8, WGM = 8;

__host__ __device__ __forceinline__ int lds_byte(int r, int c) { const int st = (r >> 4) * 2 + (c >> 5), rr = r & 15, cc = c & 31, ob = rr * 64 + cc * 2; return st * 1024 + (ob ^ (((ob >> 9) & 1) << 5)); }
__host__ __device__ __forceinline__ void stage_rc(int b, int& R, int& C) { const int st = b / 1024, sb = b % 1024, swz = sb ^ (((sb >> 9) & 1) << 5); R = (st >> 1) * 16 + swz / 64; C = (st & 1) * 32 + (swz % 64) / 2; }
__host__ __device__ __forceinline__ int perm32(int rho) { const int n = rho >> 4, i = rho & 15; return 8 * (i >> 2) + 4 * n + (i & 3); }

struct Unit { int pm, pn; };
struct Gemm { const bf16_t* A; const bf16_t* Bt; int M, N, K; };

struct StaticOrder {
    int nM, nN, nwg, G, c;
    __host__ __device__ void init(int M, int N, int G_, int c_) { nM = M / BM; nN = N / BM; nwg = nM * nN; G = G_; c = c_; }
    __host__ __device__ bool next(int i, Unit& u) const {
        const long L = (long)i * G + c; if (L >= nwg) return false;
        int wgid = (int)L; { const int q = nwg / NXCD, r = nwg % NXCD, xcd = wgid % NXCD, off = wgid / NXCD; wgid = (xcd < r ? xcd * (q + 1) : r * (q + 1) + (xcd - r) * q) + off; }
        const int nig = WGM * nN, gid = wgid / nig, fm = gid * WGM, gsz = (nM - fm) < WGM ? (nM - fm) : WGM;
        u.pm = fm + ((wgid % nig) % gsz); u.pn = (wgid % nig) / gsz; return true;
    }
    __device__ __forceinline__ void a_ready(const Unit&) const {}
    __device__ __forceinline__ void done(const Unit&) const {}
};

__device__ __forceinline__ unsigned cvt_pk_bf16(float lo, float hi) { unsigned r; asm volatile("v_cvt_pk_bf16_f32 %0, %1, %2" : "=v"(r) : "v"(lo), "v"(hi)); return r; }
__device__ __forceinline__ float relu_sq(float x) { float r; asm volatile("v_max_f32 %0, 0, %1" : "=v"(r) : "v"(x)); return r * r; }
__device__ __forceinline__ void st16_wt(void* p, u32x4 v) { asm volatile("global_store_dwordx4 %0, %1, off sc1" :: "v"(p), "v"(v) : "memory"); }
template <int ACT  > struct EpiBf16 {
    static constexpr bool PERM = true, AFTER_DRAIN = false;
    bf16_t* O; int ldc;
    __device__ __forceinline__ void operator()(const f32x4 (&acc)[2][2][4][2], const Unit& u, int wr, int wc, int fr, int fq) const {
        const int row0 = u.pm * BM + wr * 64 + fr; const int col0 = u.pn * BM + wc * 32 + 8 * fq;
#pragma unroll
        for (int ai = 0; ai < 2; ++ai)
#pragma unroll
            for (int m = 0; m < 4; ++m) { bf16_t* rowp = O + (size_t)(row0 + ai * HALF + m * 16) * ldc + col0;
#pragma unroll
                for (int bj = 0; bj < 2; ++bj) { f32x4 v0 = acc[ai][bj][m][0], v1 = acc[ai][bj][m][1];
                    if (ACT == 1) {
#pragma unroll
                        for (int e = 0; e < 4; ++e) { v0[e] = relu_sq(v0[e]); v1[e] = relu_sq(v1[e]); } }
                    u32x4 w; w.x = cvt_pk_bf16(v0[0], v0[1]); w.y = cvt_pk_bf16(v0[2], v0[3]); w.z = cvt_pk_bf16(v1[0], v1[1]); w.w = cvt_pk_bf16(v1[2], v1[3]);
                    *(u32x4*)(rowp + bj * HALF) = w; } }
    }
};

template <class Epi, class Sched, bool ALIGN_EPI = false, bool SP2 = false>
__device__ __forceinline__ void gemm_phase(PG8_LAS unsigned char* lds, const Gemm g, const Sched& S, const Epi& E, const int tid) {
    const int wid = __builtin_amdgcn_readfirstlane(tid >> 6), lane = tid & 63, wr = wid >> 2, wc = wid & 3, fr = lane & 15, fq = lane >> 4;
    const int K = g.K, nt = K / BK;
    unsigned voffA[2], voffB[2];
#pragma unroll
    for (int i = 0; i < 2; ++i) { int R, C; stage_rc(tid * 16 + i * 8192, R, C); const int Rb = Epi::PERM ? ((R & ~31) + perm32(R & 31)) : R;
        voffA[i] = (unsigned)(R * K + C) * 2u; voffB[i] = (unsigned)(Rb * K + C) * 2u; }
    const size_t kstep = (size_t)(BK * 2);
    const size_t hstep = (size_t)HALF * K * 2;
    const size_t tstep = 2 * hstep;
    const unsigned ldsw = (unsigned)wid * 1024u;
    const int aoff = lds_byte(wr * 64 + fr, fq * 8), boff = lds_byte(wc * 32 + fr, fq * 8);
#define PG8_SA(b, h) (((b) * 2 + (h)) * HTB)
#define PG8_SB(b, h) ((4 + (b) * 2 + (h)) * HTB)
#define PG8_STAGE(bufoff, gbase, voff) do { _Pragma("unroll") for (int _i = 0; _i < 2; ++_i) \
        __builtin_amdgcn_global_load_lds((const unsigned*)((const char*)(gbase) + (voff)[_i]), (PG8_LAS unsigned*)(lds + (bufoff) + ldsw + _i * 8192), 16, 0, 0); } while (0)
#define PG8_LDA(dst, b, h) do { _Pragma("unroll") for (int m = 0; m < 4; ++m) _Pragma("unroll") for (int k = 0; k < 2; ++k) dst[m][k] = *(const PG8_LAS bf16x8*)(lds + PG8_SA(b, h) + aoff + m * 2048 + k * 1024); } while (0)
#define PG8_LDB(dst, b, h) do { _Pragma("unroll") for (int n = 0; n < 2; ++n) _Pragma("unroll") for (int k = 0; k < 2; ++k) dst[n][k] = *(const PG8_LAS bf16x8*)(lds + PG8_SB(b, h) + boff + n * 2048 + k * 1024); } while (0)
#define PG8_MMA(ai, bj, At, Bt) do { __builtin_amdgcn_s_setprio(1); _Pragma("unroll") for (int m = 0; m < 4; ++m) _Pragma("unroll") for (int n = 0; n < 2; ++n) _Pragma("unroll") for (int k = 0; k < 2; ++k) \
        acc[ai][bj][m][n] = __builtin_amdgcn_mfma_f32_16x16x32_bf16(Bt[n][k], At[m][k], acc[ai][bj][m][n], 0, 0, 0); __builtin_amdgcn_s_setprio(0); } while (0)
#define PG8_WAIT_V(n) asm volatile("s_waitcnt vmcnt(" #n ")" ::: "memory")
#define PG8_WAIT_L(n) asm volatile("s_waitcnt lgkmcnt(" #n ")" ::: "memory")
#define PG8_BAR __builtin_amdgcn_s_barrier()
#define PG8_SCHED __builtin_amdgcn_sched_barrier(0)
    Unit cur, nxt; int ui = 0;
    if (!S.next(0, cur)) return;
    f32x4 acc[2][2][4][2];
#pragma unroll
    for (int a = 0; a < 2; ++a)
#pragma unroll
        for (int b = 0; b < 2; ++b)
#pragma unroll
            for (int m = 0; m < 4; ++m)
#pragma unroll
                for (int n = 0; n < 2; ++n) acc[a][b][m][n] = (f32x4){0.f, 0.f, 0.f, 0.f};
    bf16x8 At[4][2], B0[2][2], B1[2][2];
    const char* cA = (const char*)g.A + (size_t)cur.pm * tstep; const char* cB = (const char*)g.Bt + (size_t)cur.pn * tstep;
    S.a_ready(cur);
    if constexpr (SP2) {
        PG8_STAGE(PG8_SB(0, 0), cB, voffB); PG8_STAGE(PG8_SB(0, 1), cB + hstep, voffB); PG8_STAGE(PG8_SA(0, 0), cA, voffA); PG8_STAGE(PG8_SA(0, 1), cA + hstep, voffA);
        if (wr == 1) PG8_BAR;
        PG8_WAIT_V(2); PG8_BAR;
        PG8_STAGE(PG8_SB(1, 0), cB + kstep, voffB); PG8_STAGE(PG8_SA(1, 0), cA + kstep, voffA); PG8_STAGE(PG8_SB(1, 1), cB + hstep + kstep, voffB);
        PG8_WAIT_V(6); PG8_BAR;
    } else {
        PG8_STAGE(PG8_SB(0, 0), cB, voffB); PG8_STAGE(PG8_SA(0, 0), cA, voffA); PG8_STAGE(PG8_SB(0, 1), cB + hstep, voffB); PG8_STAGE(PG8_SA(0, 1), cA + hstep, voffA);
        if (wr == 1) PG8_BAR;
        PG8_WAIT_V(4); PG8_BAR;
        PG8_STAGE(PG8_SB(1, 0), cB + kstep, voffB); PG8_STAGE(PG8_SA(1, 0), cA + kstep, voffA); PG8_STAGE(PG8_SB(1, 1), cB + hstep + kstep, voffB);
        PG8_WAIT_V(6); PG8_BAR;
    }
    for (;;) {
        const bool has_next = S.next(ui + 1, nxt);
        const char* nA = has_next ? (const char*)g.A + (size_t)nxt.pm * tstep : cA; const char* nB = has_next ? (const char*)g.Bt + (size_t)nxt.pn * tstep : cB;
        for (int t = 0; t < nt; t += 2) {
            const bool last = (t == nt - 2);
            const char* a1 = cA + (size_t)(t + 1) * kstep;
            const char* a2 = last ? nA : cA + (size_t)(t + 2) * kstep; const char* b2 = last ? nB : cB + (size_t)(t + 2) * kstep;
            const char* a3 = a2 + kstep; const char* b3 = b2 + kstep;
            if (last && has_next) S.a_ready(nxt);
            if constexpr (SP2) {
            PG8_LDB(B0, 0, 0); PG8_LDB(B1, 0, 1); PG8_SCHED; PG8_LDA(At, 0, 0); PG8_STAGE(PG8_SA(1, 1), a1 + hstep, voffA);
            PG8_WAIT_V(8); PG8_WAIT_L(0); PG8_BAR; PG8_MMA(0, 0, At, B0); PG8_MMA(0, 1, At, B1); PG8_BAR; PG8_SCHED;
            PG8_LDA(At, 0, 1); PG8_STAGE(PG8_SB(0, 0), b2, voffB); PG8_STAGE(PG8_SB(0, 1), b2 + hstep, voffB); PG8_STAGE(PG8_SA(0, 0), a2, voffA);
            PG8_WAIT_V(8); PG8_WAIT_L(0); PG8_BAR; PG8_MMA(1, 0, At, B0); PG8_MMA(1, 1, At, B1); PG8_BAR; PG8_SCHED;
            PG8_LDB(B0, 1, 0); PG8_LDB(B1, 1, 1); PG8_SCHED; PG8_LDA(At, 1, 0); PG8_STAGE(PG8_SA(0, 1), a2 + hstep, voffA);
            PG8_WAIT_V(8); PG8_WAIT_L(0); PG8_BAR; PG8_MMA(0, 0, At, B0); PG8_MMA(0, 1, At, B1); PG8_BAR; PG8_SCHED;
            PG8_LDA(At, 1, 1); PG8_STAGE(PG8_SB(1, 0), b3, voffB); PG8_STAGE(PG8_SB(1, 1), b3 + hstep, voffB); PG8_STAGE(PG8_SA(1, 0), a3, voffA);
            PG8_WAIT_V(8); PG8_WAIT_L(0); PG8_BAR; PG8_MMA(1, 0, At, B0); PG8_MMA(1, 1, At, B1); PG8_BAR; PG8_SCHED;
            } else {
            PG8_LDB(B0, 0, 0); PG8_SCHED; PG8_LDA(At, 0, 0); PG8_STAGE(PG8_SA(1, 1), a1 + hstep, voffA);
            PG8_WAIT_L(8); PG8_BAR; PG8_WAIT_L(0); PG8_MMA(0, 0, At, B0); PG8_BAR; PG8_SCHED;
            PG8_LDB(B1, 0, 1); PG8_STAGE(PG8_SB(0, 0), b2, voffB);
            PG8_BAR; PG8_WAIT_L(0); PG8_MMA(0, 1, At, B1); PG8_BAR;
            PG8_LDA(At, 0, 1); PG8_STAGE(PG8_SA(0, 0), a2, voffA);
            PG8_BAR; PG8_WAIT_L(0); PG8_MMA(1, 0, At, B0); PG8_BAR; PG8_SCHED;
            PG8_STAGE(PG8_SB(0, 1), b2 + hstep, voffB);
            PG8_WAIT_V(6); PG8_BAR; PG8_MMA(1, 1, At, B1); PG8_BAR;
            PG8_LDB(B0, 1, 0); PG8_SCHED; PG8_LDA(At, 1, 0); PG8_STAGE(PG8_SA(0, 1), a2 + hstep, voffA);
            PG8_WAIT_L(8); PG8_BAR; PG8_WAIT_L(0); PG8_MMA(0, 0, At, B0); PG8_BAR; PG8_SCHED;
            PG8_LDB(B1, 1, 1); PG8_STAGE(PG8_SB(1, 0), b3, voffB);
            PG8_BAR; PG8_WAIT_L(0); PG8_MMA(0, 1, At, B1); PG8_BAR;
            PG8_LDA(At, 1, 1); PG8_STAGE(PG8_SA(1, 0), a3, voffA);
            PG8_BAR; PG8_WAIT_L(0); PG8_MMA(1, 0, At, B0); PG8_BAR; PG8_SCHED;
            PG8_STAGE(PG8_SB(1, 1), b3 + hstep, voffB);
            PG8_WAIT_V(6); PG8_BAR; PG8_MMA(1, 1, At, B1); PG8_BAR;
            }
        }
        if constexpr (ALIGN_EPI) { if (wr == 0) PG8_BAR; }
        if constexpr (!Epi::AFTER_DRAIN) { E(acc, cur, wr, wc, fr, fq); S.done(cur); }
        if (!has_next) break;
#pragma unroll
        for (int a = 0; a < 2; ++a)
#pragma unroll
            for (int b = 0; b < 2; ++b)
#pragma unroll
                for (int m = 0; m < 4; ++m)
#pragma unroll
                    for (int n = 0; n < 2; ++n) acc[a][b][m][n] = (f32x4){0.f, 0.f, 0.f, 0.f};
        cur = nxt; cA = nA; cB = nB; ++ui;
        if constexpr (ALIGN_EPI) { if (wr == 1) PG8_BAR; }
    }
    PG8_WAIT_V(0);
    if constexpr (!ALIGN_EPI) { if (wr == 0) PG8_BAR; }
    PG8_BAR;
    if constexpr (Epi::AFTER_DRAIN) { E.fused(acc, cur, wr, wc, fr, fq, lds, wid, lane); S.done(cur); }
#undef PG8_SA
#undef PG8_SB
#undef PG8_STAGE
#undef PG8_LDA
#undef PG8_LDB
#undef PG8_MMA
#undef PG8_WAIT_V
#undef PG8_WAIT_L
#undef PG8_BAR
#undef PG8_SCHED
}
}

namespace cg = cooperative_groups;
#define LAS __attribute__((address_space(3)))
typedef unsigned short bf16;
typedef unsigned v4u __attribute__((ext_vector_type(4)));
typedef unsigned v2u __attribute__((ext_vector_type(2)));
typedef float f32x4 __attribute__((ext_vector_type(4)));
typedef short bf16x8 __attribute__((ext_vector_type(8)));

constexpr int NWAVES = 8;
constexpr int DM = 1024, FF = 4096, INW = 2048, GW = 256;
constexpr int ZP = INW + 64;
constexpr int MP = 16384, MS = 512, MT = MP + MS;
constexpr int SEQ = 2048, NBP = 8, NSB = 128, ST = 4, DEPTH = 2;
constexpr float EPS = 1e-6f;
constexpr size_t MiB = 1u << 20;
constexpr size_t WS_SGUW = 1 * MiB;
constexpr size_t WS_W = 2 * MiB, W_LAYER = 22 * MiB, W_IN = 0, W_OUT = 4 * MiB, W_UP = 6 * MiB, W_DN = 14 * MiB;
constexpr size_t WS_XN = 46 * MiB, WS_O = 79 * MiB, WS_H = 112 * MiB, WS_Z = 112 * MiB, WS_CAT = 182 * MiB, WS_X = 244 * MiB  , WS_END = 246 * MiB;
constexpr int CW_SEAM = 4096, SEAM_BANK = 4096;
constexpr int LDS_BYTES = 147456;
constexpr int MISC_OFF = LDS_BYTES - 256;
constexpr size_t WS_CTL = 0, CTL_ZERO_BYTES = 128 * 1024;
constexpr int WAVE_SCR = 17408;
constexpr size_t OUT_Y = 0;
constexpr size_t OUT_POOL_P = (size_t)MT * DM;
constexpr size_t OUT_POOL_S = OUT_POOL_P + (size_t)DEPTH * NBP * 15 * GW;
constexpr size_t OUT_CONV_P = OUT_POOL_S + (size_t)DEPTH * NSB * 15 * GW;
constexpr size_t OUT_CONV_S = OUT_CONV_P + (size_t)DEPTH * NBP * 30 * GW;
constexpr size_t OUT_SHORT_P = OUT_CONV_S + (size_t)DEPTH * NSB * 30 * GW;
constexpr size_t OUT_SHORT_S = OUT_SHORT_P + (size_t)DEPTH * NBP * 2 * GW;
constexpr size_t OUT_V_S = OUT_SHORT_S + (size_t)DEPTH * NSB * 2 * GW;
constexpr size_t OUT_END = OUT_V_S + (size_t)DEPTH * NSB * ST * GW;

__device__ __forceinline__ float bf2f(bf16 b) { return __uint_as_float(((unsigned)b) << 16); }
__device__ __forceinline__ unsigned f2bf(float f) { unsigned u = __float_as_uint(f); return (u + 0x7fffu + ((u >> 16) & 1u)) >> 16; }
__device__ __forceinline__ unsigned pk2(float lo, float hi) { return f2bf(lo) | (f2bf(hi) << 16); }
template <int CTRL, int ROWMASK> __device__ __forceinline__ float dpp_get(float v) { return __int_as_float(__builtin_amdgcn_update_dpp(0, __float_as_int(v), CTRL, ROWMASK, 0xF, false)); }
__device__ __forceinline__ float sum8(float v) { v += dpp_get<0xB1, 0xF>(v); v += dpp_get<0x4E, 0xF>(v); v += dpp_get<0x141, 0xF>(v); return v; }
__device__ __forceinline__ float wave_sum(float v) {
    v = sum8(v); v += dpp_get<0x140, 0xF>(v); v += dpp_get<0x142, 0xA>(v); v += dpp_get<0x143, 0xC>(v);
    return __int_as_float(__builtin_amdgcn_readlane(__float_as_int(v), 63));
}
__device__ __forceinline__ void unpack8(const v4u w, float (&f)[8]) {
    f[0] = __uint_as_float(w.x << 16); f[1] = __uint_as_float(w.x & 0xffff0000u); f[2] = __uint_as_float(w.y << 16); f[3] = __uint_as_float(w.y & 0xffff0000u);
    f[4] = __uint_as_float(w.z << 16); f[5] = __uint_as_float(w.z & 0xffff0000u); f[6] = __uint_as_float(w.w << 16); f[7] = __uint_as_float(w.w & 0xffff0000u); }
__device__ __forceinline__ v4u pack8(const float (&f)[8]) { v4u w; w.x = pg8::cvt_pk_bf16(f[0], f[1]); w.y = pg8::cvt_pk_bf16(f[2], f[3]); w.z = pg8::cvt_pk_bf16(f[4], f[5]); w.w = pg8::cvt_pk_bf16(f[6], f[7]); return w; }
__device__ __forceinline__ v4u ld16(const bf16* p) { return *(const v4u*)p; }
__device__ __forceinline__ float sigm(float x) { return __builtin_amdgcn_rcpf(1.f + __builtin_amdgcn_exp2f(-1.44269504f * x)); }
#define LDS_WAIT() asm volatile("s_waitcnt lgkmcnt(0)" ::: "memory")

__device__ __forceinline__ void transpose_item(const float* __restrict__ W, int K, int N, bf16* __restrict__ WT, const float* __restrict__ gk, LAS float* scr, int item, int lane) {
    const int nblk = N / 32, kb = item / nblk, nb = item % nblk, k0 = 64 * kb, n0 = 32 * nb;
#pragma unroll 8
    for (int i = 0; i < 32; ++i) { const int kk = 2 * i + (lane >> 5); float v = W[(size_t)(k0 + kk) * N + n0 + (lane & 31)]; if (gk) v *= gk[k0 + kk]; scr[kk * 33 + (lane & 31)] = v; }
    LDS_WAIT();
    const int c = lane & 7;
#pragma unroll
    for (int j = 0; j < 4; ++j) { const int n = (lane >> 3) + 8 * j; const LAS float* s = scr + (8 * c) * 33 + n;
        v4u o; o.x = pk2(s[0 * 33], s[1 * 33]); o.y = pk2(s[2 * 33], s[3 * 33]); o.z = pk2(s[4 * 33], s[5 * 33]); o.w = pk2(s[6 * 33], s[7 * 33]);
        *(v4u*)(WT + (size_t)(n0 + n) * K + k0 + 8 * c) = o; }
    LDS_WAIT();
}
struct TrDesc { const float* W; bf16* WT; const float* gk; int K, N, k0, n0; };
__device__ __forceinline__ void tr_load(float (&v)[32], const TrDesc& d, int lane) {
    const float* p = d.W + (size_t)(d.k0 + (lane >> 5)) * d.N + d.n0 + (lane & 31);
#pragma unroll
    for (int i = 0; i < 32; ++i) v[i] = p[(size_t)(2 * i) * d.N];
}
__device__ __forceinline__ void tr_store(const float (&v)[32], const TrDesc& d, LAS float* scr, int lane) {
#pragma unroll
    for (int i = 0; i < 32; ++i) { const int kk = 2 * i + (lane >> 5); float x = v[i]; if (d.gk) x *= d.gk[d.k0 + kk]; scr[kk * 33 + (lane & 31)] = x; }
    LDS_WAIT();
    const int c = lane & 7;
#pragma unroll
    for (int j = 0; j < 4; ++j) { const int n = (lane >> 3) + 8 * j; const LAS float* s = scr + (8 * c) * 33 + n;
        v4u o; o.x = pg8::cvt_pk_bf16(s[0 * 33], s[1 * 33]); o.y = pg8::cvt_pk_bf16(s[2 * 33], s[3 * 33]); o.z = pg8::cvt_pk_bf16(s[4 * 33], s[5 * 33]); o.w = pg8::cvt_pk_bf16(s[6 * 33], s[7 * 33]);
        *(v4u*)(d.WT + (size_t)(d.n0 + n) * d.K + d.k0 + 8 * c) = o; }
    LDS_WAIT();
}
__device__ __forceinline__ void fold_item(const float* __restrict__ W, bf16* __restrict__ WT, const float* __restrict__ wp, const float* __restrict__ ps, LAS float* scr, int item, int lane) {
    const int K = DM, N = DM; const int nblk = N / 32, g = item / nblk, nb = item % nblk, k0 = 64 * g, n0 = 32 * nb;
    LAS float* scr2 = scr + 64 * 33;
#pragma unroll 8
    for (int i = 0; i < 32; ++i) { const int kk = 2 * i + (lane >> 5); scr[kk * 33 + (lane & 31)] = W[(size_t)(k0 + kk) * N + n0 + (lane & 31)] * ps[k0 + kk]; }
    LDS_WAIT();
    const int n = lane & 31;
    for (int i = 0; i < 32; ++i) { const int kk = 2 * i + (lane >> 5); const float* wr = wp + (size_t)(g * 64 + kk) * 64; float a = 0.f;
#pragma unroll 16
        for (int d = 0; d < 64; ++d) a += wr[d] * scr[d * 33 + n];
        scr2[kk * 33 + n] = a; }
    LDS_WAIT();
    const int c = lane & 7;
#pragma unroll
    for (int j = 0; j < 4; ++j) { const int nn = (lane >> 3) + 8 * j; const LAS float* s = scr2 + (8 * c) * 33 + nn;
        v4u o; o.x = pk2(s[0 * 33], s[1 * 33]); o.y = pk2(s[2 * 33], s[3 * 33]); o.z = pk2(s[4 * 33], s[5 * 33]); o.w = pk2(s[6 * 33], s[7 * 33]);
        *(v4u*)(WT + (size_t)(n0 + nn) * K + k0 + 8 * c) = o; }
    LDS_WAIT();
}
__device__ __forceinline__ void rms_row_to_bf16(const float* __restrict__ xrow, bf16* __restrict__ orow, int lane) {
    const f32x4* xr = (const f32x4*)xrow + lane;
    f32x4 v[4]; float s = 0.f;
#pragma unroll
    for (int j = 0; j < 4; ++j) { v[j] = xr[64 * j]; s += (v[j].x * v[j].x + v[j].y * v[j].y) + (v[j].z * v[j].z + v[j].w * v[j].w); }
    const float rstd = rsqrtf(wave_sum(s) * (1.f / DM) + EPS);
    v2u* o8 = (v2u*)orow + lane;
#pragma unroll
    for (int j = 0; j < 4; ++j) { v2u o; o.x = pk2(v[j].x * rstd, v[j].y * rstd); o.y = pk2(v[j].z * rstd, v[j].w * rstd); o8[64 * j] = o; }
}
struct EwRow { f32x4 x[4]; v2u o[4]; };
__device__ __forceinline__ void ew_load(EwRow& r, const float* __restrict__ xrow, const bf16* __restrict__ orow, int lane) {
    const f32x4* xr = (const f32x4*)xrow + lane; const v2u* orr = (const v2u*)orow + lane;
#pragma unroll
    for (int j = 0; j < 4; ++j) { r.x[j] = xr[64 * j]; r.o[j] = orr[64 * j]; }
}
__device__ __forceinline__ void ew_finish(EwRow& r, const f32x4 (&gg)[4], float* __restrict__ Xrow, bf16* __restrict__ xnrow, bool write_xn, int lane) {
    f32x4 o[4]; float so = 0.f;
#pragma unroll
    for (int j = 0; j < 4; ++j) { const v2u w = r.o[j];
        o[j].x = __uint_as_float(w.x << 16); o[j].y = __uint_as_float(w.x & 0xffff0000u); o[j].z = __uint_as_float(w.y << 16); o[j].w = __uint_as_float(w.y & 0xffff0000u);
        so += (o[j].x * o[j].x + o[j].y * o[j].y) + (o[j].z * o[j].z + o[j].w * o[j].w); }
    const float rs = rsqrtf(wave_sum(so) * (1.f / DM) + EPS); float s1 = 0.f;
    f32x4* Xr = (f32x4*)Xrow + lane;
#pragma unroll
    for (int j = 0; j < 4; ++j) { f32x4 x = r.x[j] + o[j] * rs * gg[j]; r.x[j] = x; s1 += (x.x * x.x + x.y * x.y) + (x.z * x.z + x.w * x.w); Xr[64 * j] = x; }
    if (write_xn) { const float r1 = rsqrtf(wave_sum(s1) * (1.f / DM) + EPS); v2u* o8 = (v2u*)xnrow + lane;
#pragma unroll
        for (int j = 0; j < 4; ++j) { v2u w; w.x = pg8::cvt_pk_bf16(r.x[j].x * r1, r.x[j].y * r1); w.y = pg8::cvt_pk_bf16(r.x[j].z * r1, r.x[j].w * r1); o8[64 * j] = w; } }
}

template <bool SAMPLE>
__device__ __forceinline__ void pool_unit(const bf16* __restrict__ Z, bf16* __restrict__ CAT, const float* __restrict__ state, float* __restrict__ newp,
                                          int seq, int t0, int nrows, int g, int lane) {
    const int c = g * 64 + lane, w = 2 << g;
    const size_t rowbase = SAMPLE ? (size_t)MP + (size_t)seq * ST : (size_t)seq * SEQ;
    const bf16* zc = Z + rowbase * ZP + c;
    const float* st = state + (size_t)seq * 15 * GW + c;
#define POOL_A(e) ((e) >= 0 ? bf2f(zc[(size_t)(e) * ZP]) : (SAMPLE ? st[(15 + (e)) * GW] : 0.f))
    float S = 0.f;
    for (int j = 1; j < w; ++j) S += POOL_A(t0 - j);
#pragma unroll 4
    for (int t = t0; t < t0 + nrows; ++t) {
        const float a = POOL_A(t); S += a;
        const float cnt = SAMPLE ? (float)w : (float)(t + 1 < w ? t + 1 : w);
        CAT[(rowbase + t) * DM + c] = (bf16)f2bf(S / cnt - a);
        const int e = t - w + 1; S -= POOL_A(e);
    }
    const int T = SAMPLE ? ST : SEQ;
    if (t0 + nrows == T) {
        for (int j = 0; j < 15; ++j) { const int e = T - 15 + j; newp[((size_t)seq * 15 + j) * GW + c] = POOL_A(e); }
    }
#undef POOL_A
}
template <bool SAMPLE>
__device__ __forceinline__ void short_unit(const bf16* __restrict__ Z, bf16* __restrict__ CAT, const float* __restrict__ state, float* __restrict__ news,
                                           const float* __restrict__ sw, int seq, int t0, int nrows, int h, int lane) {
    const int c = h * 64 + lane;
    const size_t rowbase = SAMPLE ? (size_t)MP + (size_t)seq * ST : (size_t)seq * SEQ;
    const bf16* zc = Z + rowbase * ZP + c;
    const float* st = state + (size_t)seq * 2 * GW + c;
    const float w0 = sw[c], w1 = sw[GW + c], w2 = sw[2 * GW + c];
#define SH_E(e) ((e) >= 0 ? bf2f(zc[(size_t)(e) * ZP + 1536]) * bf2f(zc[(size_t)(e) * ZP + 1792]) : (SAMPLE ? st[(2 + (e)) * GW] : 0.f))
    float e2 = SH_E(t0 - 2), e1 = SH_E(t0 - 1);
#pragma unroll 4
    for (int t = t0; t < t0 + nrows; ++t) {
        const float e0 = SH_E(t); const float bg = bf2f(zc[(size_t)t * ZP + 1280]);
        CAT[(rowbase + t) * DM + 768 + c] = (bf16)f2bf(bg * (w0 * e2 + w1 * e1 + w2 * e0));
        e2 = e1; e1 = e0;
    }
    const int T = SAMPLE ? ST : SEQ;
    if (t0 + nrows == T) { news[((size_t)seq * 2 + 0) * GW + c] = e2; news[((size_t)seq * 2 + 1) * GW + c] = e1; }
#undef SH_E
}
template <bool SAMPLE>
__device__ __forceinline__ void conv_unit(const bf16* __restrict__ Z, bf16* __restrict__ CAT, const float* __restrict__ state, float* __restrict__ newc,
                                          const float* __restrict__ cw, const float* __restrict__ cb, const float* __restrict__ lg, const float* __restrict__ lb,
                                          int seq, int t0, int nrows, int h, LAS float* gL, int lane) {
    const int c = h * 64 + lane;
    const size_t rowbase = SAMPLE ? (size_t)MP + (size_t)seq * ST : (size_t)seq * SEQ;
    const bf16* zc = Z + rowbase * ZP + c;
    bf16* oc = CAT + rowbase * DM + 256 + c;
    const int T = SAMPLE ? ST : SEQ;
    const bool last = (t0 + nrows == T);
    const int nin = nrows + 30;
#pragma unroll 4
    for (int r = 0; r < nin; ++r) { const int s = t0 - 30 + r; float gs = 0.f;
        if (s >= 0) { const unsigned off = (unsigned)s * ZP; const float p = bf2f(zc[off + 256]), gt = bf2f(zc[off + 512]); gs = p * sigm(gt); }
        else if (SAMPLE) gs = state[((size_t)seq * 30 + 30 + s) * GW + c];
        if (last && s >= T - 30) newc[((size_t)seq * 30 + (s - (T - 30))) * GW + c] = gs;
        gL[r * 64 + lane] = gs; }
    LDS_WAIT();
    float wk[31];
#pragma unroll
    for (int k = 0; k < 31; ++k) wk[k] = cw[k * GW + c];
    const float bias = cb[c], gg = lg[c], bb = lb[c];
#pragma unroll 1
    for (int tq = 0; tq < nrows; tq += 4) {
        float acc[4] = {bias, bias, bias, bias};
#pragma unroll
        for (int r = 0; r < 34; ++r) { const float gv = gL[(tq + r) * 64 + lane];
#pragma unroll
            for (int q = 0; q < 4; ++q) { const int k = r - q; if (k >= 0 && k <= 30) acc[q] += wk[k] * gv; } }
#pragma unroll
        for (int q = 0; q < 4; ++q) { const float cv = acc[q];
            const float mean = wave_sum(cv) * (1.f / 64.f); const float d = cv - mean;
            const float var = wave_sum(d * d) * (1.f / 64.f);
            const float y = d * rsqrtf(var + EPS) * gg + bb;
            oc[(unsigned)(t0 + tq + q) * DM] = (bf16)f2bf(y * sigm(y)); }
    }
    LDS_WAIT();
}
template <int W>
__device__ __forceinline__ void pool_unit_p(const bf16* __restrict__ Z, bf16* __restrict__ CAT, float* __restrict__ newp, int seq, int t0, int g, int lane) {
    const int rr = lane >> 3, cg = lane & 7, c0 = g * 64 + cg * 8, tb = t0 + rr * 8;
    const size_t rowbase = (size_t)seq * SEQ;
    const bf16* zb = Z + (rowbase + tb) * ZP + c0;
    v4u raw[W + 7];
#pragma unroll
    for (int j = 0; j < W + 7; ++j) { const int dj = j - (W - 1); raw[j] = (tb + dj >= 0) ? ld16(zb + (long)dj * ZP) : (v4u){0u, 0u, 0u, 0u}; }
    float S[8];
#pragma unroll
    for (int i = 0; i < 8; ++i) S[i] = 0.f;
#pragma unroll
    for (int j = 0; j < W - 1; ++j) { float f[8]; unpack8(raw[j], f);
#pragma unroll
        for (int i = 0; i < 8; ++i) S[i] += f[i]; }
    bf16* ob = CAT + (rowbase + tb) * DM + c0;
    const bool lastseg = (t0 + 64 == SEQ);
#pragma unroll
    for (int j = 0; j < 8; ++j) { float a[8], o[8], od[8]; unpack8(raw[j + W - 1], a); unpack8(raw[j], od);
        const int t = tb + j; const float inv = 1.f / (float)(t + 1 < W ? t + 1 : W);
#pragma unroll
        for (int i = 0; i < 8; ++i) { S[i] += a[i]; o[i] = S[i] * inv - a[i]; S[i] -= od[i]; }
        *(v4u*)(ob + j * DM) = pack8(o);
        if (lastseg && t >= SEQ - 15) { float* np = newp + ((size_t)seq * 15 + (t - (SEQ - 15))) * GW + c0; *(f32x4*)np = (f32x4){a[0], a[1], a[2], a[3]}; *(f32x4*)(np + 4) = (f32x4){a[4], a[5], a[6], a[7]}; }
    }
}
__device__ __forceinline__ void short_unit_p(const bf16* __restrict__ Z, bf16* __restrict__ CAT, float* __restrict__ news, const float* __restrict__ sw, int seq, int t0, int h, int lane) {
    const int rr = lane >> 3, cg = lane & 7, c0 = h * 64 + cg * 8, tb = t0 + rr * 8;
    const size_t rowbase = (size_t)seq * SEQ;
    const bf16* zb = Z + (rowbase + tb) * ZP + c0;
    v4u Bv[8], Cv[10], Hv[10];
#pragma unroll
    for (int j = 0; j < 10; ++j) { const int dj = j - 2; const bool ok = (tb + dj >= 0);
        Cv[j] = ok ? ld16(zb + (long)dj * ZP + 1536) : (v4u){0u, 0u, 0u, 0u}; Hv[j] = ok ? ld16(zb + (long)dj * ZP + 1792) : (v4u){0u, 0u, 0u, 0u};
        if (j >= 2) Bv[j - 2] = ld16(zb + (long)dj * ZP + 1280); }
    float w0[8], w1[8], w2[8];
#pragma unroll
    for (int i = 0; i < 8; ++i) { w0[i] = sw[c0 + i]; w1[i] = sw[GW + c0 + i]; w2[i] = sw[2 * GW + c0 + i]; }
    float e2[8], e1[8];
    { float c[8], hh[8]; unpack8(Cv[0], c); unpack8(Hv[0], hh);
#pragma unroll
      for (int i = 0; i < 8; ++i) e2[i] = c[i] * hh[i];
      unpack8(Cv[1], c); unpack8(Hv[1], hh);
#pragma unroll
      for (int i = 0; i < 8; ++i) e1[i] = c[i] * hh[i]; }
    bf16* ob = CAT + (rowbase + tb) * DM + 768 + c0;
#pragma unroll
    for (int j = 0; j < 8; ++j) { float c[8], hh[8], b[8], o[8]; unpack8(Cv[j + 2], c); unpack8(Hv[j + 2], hh); unpack8(Bv[j], b);
#pragma unroll
        for (int i = 0; i < 8; ++i) { const float e0 = c[i] * hh[i]; o[i] = b[i] * (w0[i] * e2[i] + w1[i] * e1[i] + w2[i] * e0); e2[i] = e1[i]; e1[i] = e0; }
        *(v4u*)(ob + j * DM) = pack8(o); }
    if (t0 + 64 == SEQ && rr == 7) { float* np = news + (size_t)seq * 2 * GW + c0;
        *(f32x4*)np = (f32x4){e2[0], e2[1], e2[2], e2[3]}; *(f32x4*)(np + 4) = (f32x4){e2[4], e2[5], e2[6], e2[7]};
        *(f32x4*)(np + GW) = (f32x4){e1[0], e1[1], e1[2], e1[3]}; *(f32x4*)(np + GW + 4) = (f32x4){e1[4], e1[5], e1[6], e1[7]}; }
}
__device__ __forceinline__ void conv_unit_p(const bf16* __restrict__ Z, bf16* __restrict__ CAT, float* __restrict__ newc,
                                            const float* __restrict__ cw, const float* __restrict__ cb, const float* __restrict__ lg, const float* __restrict__ lb,
                                            int seq, int t0, int h, LAS float* gL, int lane) {
    const int rr = lane >> 3, cg = lane & 7, c0 = h * 64 + cg * 8;
    const size_t rowbase = (size_t)seq * SEQ;
    const bool last = (t0 + 32 == SEQ);
    { v4u pv[8], gv[8];
#pragma unroll
      for (int j = 0; j < 8; ++j) { const int r = 8 * j + rr, sx = t0 - 30 + r; const bool ok = (sx >= 0 && r < 62);
          const bf16* zp = Z + (rowbase + (ok ? sx : 0)) * ZP + c0;
          pv[j] = ok ? ld16(zp + 256) : (v4u){0u, 0u, 0u, 0u}; gv[j] = ok ? ld16(zp + 512) : (v4u){0u, 0u, 0u, 0u}; }
#pragma unroll
      for (int j = 0; j < 8; ++j) { const int r = 8 * j + rr, sx = t0 - 30 + r; float p[8], gt[8]; unpack8(pv[j], p); unpack8(gv[j], gt);
#pragma unroll
          for (int i = 0; i < 8; ++i) p[i] = p[i] * sigm(gt[i]);
          if (r < 62) { *(LAS f32x4*)(gL + r * 64 + cg * 8) = (f32x4){p[0], p[1], p[2], p[3]}; *(LAS f32x4*)(gL + r * 64 + cg * 8 + 4) = (f32x4){p[4], p[5], p[6], p[7]}; }
          if (last && sx >= SEQ - 30 && r < 62) { float* np = newc + ((size_t)seq * 30 + (sx - (SEQ - 30))) * GW + c0; *(f32x4*)np = (f32x4){p[0], p[1], p[2], p[3]}; *(f32x4*)(np + 4) = (f32x4){p[4], p[5], p[6], p[7]}; } }
    }
    LDS_WAIT();
    const int c = h * 64 + lane;
    float wk[31];
#pragma unroll
    for (int k = 0; k < 31; ++k) wk[k] = cw[k * GW + c];
    const float bias = cb[c];
#pragma unroll 1
    for (int tq = 0; tq < 32; tq += 4) {
        float acc[4] = {bias, bias, bias, bias};
#pragma unroll
        for (int r = 0; r < 34; ++r) { const float gvv = gL[(tq + r) * 64 + lane];
#pragma unroll
            for (int q = 0; q < 4; ++q) { const int k = r - q; if (k >= 0 && k <= 30) acc[q] += wk[k] * gvv; } }
        LDS_WAIT();
#pragma unroll
        for (int q = 0; q < 4; ++q) gL[(tq + q) * 64 + lane] = acc[q];
    }
    LDS_WAIT();
    float gg[8], bb[8];
#pragma unroll
    for (int i = 0; i < 8; ++i) { gg[i] = lg[c0 + i]; bb[i] = lb[c0 + i]; }
    bf16* ob = CAT + (rowbase + t0) * DM + 256 + c0;
#pragma unroll
    for (int j = 0; j < 4; ++j) { const int r = 8 * j + rr; const f32x4 a = *(const LAS f32x4*)(gL + r * 64 + cg * 8), b = *(const LAS f32x4*)(gL + r * 64 + cg * 8 + 4);
        float x[8] = {a[0], a[1], a[2], a[3], b[0], b[1], b[2], b[3]};
        const float mean = sum8(((x[0] + x[1]) + (x[2] + x[3])) + ((x[4] + x[5]) + (x[6] + x[7]))) * (1.f / 64.f);
        float q = 0.f;
#pragma unroll
        for (int i = 0; i < 8; ++i) { x[i] -= mean; q += x[i] * x[i]; }
        const float rstd = rsqrtf(sum8(q) * (1.f / 64.f) + EPS);
#pragma unroll
        for (int i = 0; i < 8; ++i) { const float yy = x[i] * rstd * gg[i] + bb[i]; x[i] = yy * sigm(yy); }
        *(v4u*)(ob + r * DM) = pack8(x); }
    LDS_WAIT();
}
__device__ __forceinline__ int sgu_swz(int c, int chunk) { return (chunk ^ ((c & 15) ^ (c >> 4))) << 3; }
__device__ __forceinline__ void sgu_unit(const bf16* __restrict__ Z, bf16* __restrict__ CAT, const bf16* __restrict__ Wb, const float* __restrict__ lg, const float* __restrict__ lb,
                                         const float* __restrict__ sb, int chunk, int h, LAS bf16* vT, int lane) {
    const size_t r0 = (size_t)chunk * 128;
    { const int rr = lane >> 3, cg = lane & 7, c0 = h * 64 + cg * 8;
      float gg[8], bb[8];
#pragma unroll
      for (int i = 0; i < 8; ++i) { gg[i] = lg[c0 + i]; bb[i] = lb[c0 + i]; }
#pragma unroll 1
      for (int jh = 0; jh < 16; jh += 8) {
          v4u raw[8];
#pragma unroll
          for (int j = 0; j < 8; ++j) raw[j] = ld16(Z + (r0 + 8 * (jh + j) + rr) * ZP + 1024 + c0);
#pragma unroll
          for (int j = 0; j < 8; ++j) { float x[8]; unpack8(raw[j], x);
              float sm = ((x[0] + x[1]) + (x[2] + x[3])) + ((x[4] + x[5]) + (x[6] + x[7])); const float mean = sum8(sm) * (1.f / 64.f);
              float q = 0.f;
#pragma unroll
              for (int i = 0; i < 8; ++i) { x[i] -= mean; q += x[i] * x[i]; }
              const float rstd = rsqrtf(sum8(q) * (1.f / 64.f) + EPS);
#pragma unroll
              for (int i = 0; i < 8; ++i) { const int cl = cg * 8 + i; vT[cl * 128 + sgu_swz(cl, jh + j) + rr] = (bf16)f2bf(x[i] * rstd * gg[i] + bb[i]); } }
      }
    }
    LDS_WAIT();
    const int fr = lane & 15, fq = lane >> 4;
    bf16x8 wf[8][4];
#pragma unroll
    for (int mt = 0; mt < 8; ++mt)
#pragma unroll
        for (int ks = 0; ks < 4; ++ks) if (ks * 32 <= mt * 16 + 15) wf[mt][ks] = *(const bf16x8*)(Wb + ((size_t)(h * 128 + mt * 16 + fr) * 128 + ks * 32 + fq * 8));
#pragma unroll
    for (int mt = 0; mt < 8; ++mt) {
        f32x4 acc[4];
#pragma unroll
        for (int nt = 0; nt < 4; ++nt) acc[nt] = (f32x4){0.f, 0.f, 0.f, 0.f};
        const int t = mt * 16 + fr;
        v2u uv[4];
#pragma unroll
        for (int nt = 0; nt < 4; ++nt) uv[nt] = *(const v2u*)(Z + (r0 + t) * ZP + 768 + h * 64 + nt * 16 + 4 * fq);
        const float bt = sb[h * 128 + t];
#pragma unroll
        for (int ks = 0; ks < 4; ++ks) if (ks * 32 <= mt * 16 + 15) {
#pragma unroll
            for (int nt = 0; nt < 4; ++nt) { const int cl = nt * 16 + fr; const bf16x8 vf = *(const LAS bf16x8*)(vT + cl * 128 + sgu_swz(cl, ks * 4 + fq));
                acc[nt] = __builtin_amdgcn_mfma_f32_16x16x32_bf16(vf, wf[mt][ks], acc[nt], 0, 0, 0); }
        }
#pragma unroll
        for (int nt = 0; nt < 4; ++nt) { const float u0 = __uint_as_float(uv[nt].x << 16), u1 = __uint_as_float(uv[nt].x & 0xffff0000u), u2 = __uint_as_float(uv[nt].y << 16), u3 = __uint_as_float(uv[nt].y & 0xffff0000u);
            v2u w; w.x = pg8::cvt_pk_bf16(u0 * (acc[nt][0] + bt), u1 * (acc[nt][1] + bt)); w.y = pg8::cvt_pk_bf16(u2 * (acc[nt][2] + bt), u3 * (acc[nt][3] + bt));
            *(v2u*)(CAT + (r0 + t) * DM + 512 + h * 64 + nt * 16 + 4 * fq) = w; }
    }
    LDS_WAIT();
}
__device__ __forceinline__ void sgu_sample_unit(const bf16* __restrict__ Z, bf16* __restrict__ CAT, const float* __restrict__ Wf, const float* __restrict__ lg, const float* __restrict__ lb,
                                                const float* __restrict__ sb, float* __restrict__ vout, int seq, int h, int lane) {
    const int c = h * 64 + lane; const size_t rowbase = (size_t)MP + (size_t)seq * ST;
    const float gg = lg[c], bb = lb[c];
    float vn[ST];
#pragma unroll
    for (int t = 0; t < ST; ++t) { const float v = bf2f(Z[(rowbase + t) * ZP + 1024 + c]); const float mean = wave_sum(v) * (1.f / 64.f); const float d = v - mean; const float var = wave_sum(d * d) * (1.f / 64.f);
        vn[t] = d * rsqrtf(var + EPS) * gg + bb; vout[((size_t)seq * ST + t) * GW + c] = vn[t]; }
#pragma unroll
    for (int t = 0; t < ST; ++t) { float sv = sb[h * 128 + t];
#pragma unroll
        for (int s = 0; s <= t; ++s) sv += Wf[((size_t)h * 128 + t) * 128 + s] * vn[s];
        const float u = bf2f(Z[(rowbase + t) * ZP + 768 + c]);
        CAT[(rowbase + t) * DM + 512 + c] = (bf16)f2bf(u * sv); }
}

#define XB_TMO      128
#define XB_XCNT(j)  (256  + 64 * (j))
#define XB_XSUB(j)  (1280 + 64 * (j))
#define XB_XGEN(j)  (2304 + 64 * (j))
#define XB_TOP      3328
#define XB_TOPGEN   3392
#define XCD_BAR_WORDS 3456
#define XB_SPIN_CAP (1u << 18)

__device__ __forceinline__ unsigned xb_ld(unsigned* p)              { return __hip_atomic_load(p, __ATOMIC_RELAXED, __HIP_MEMORY_SCOPE_AGENT); }
__device__ __forceinline__ unsigned xb_add(unsigned* p, unsigned v) { return __hip_atomic_fetch_add(p, v, __ATOMIC_RELAXED, __HIP_MEMORY_SCOPE_AGENT); }
__device__ __forceinline__ unsigned xb_xcc_id() { return (unsigned)__builtin_amdgcn_s_getreg((3 << 11) | 20) & 0xFu; }
#define XB_SPIN(cond, bar) do { unsigned _sp = 0; while (cond) { __builtin_amdgcn_s_sleep(1); \
    if ((++_sp & 255u) == 0u) { if (xb_ld(&(bar)[XB_TMO])) break; if (_sp > XB_SPIN_CAP) { atomicAdd(&(bar)[XB_TMO], 1u); break; } } } } while (0)

struct XcdBarrier {
    unsigned* bar; unsigned x;
    volatile LAS unsigned* st;
};

__device__ __forceinline__ XcdBarrier xcd_barrier_post(unsigned* bar, volatile LAS unsigned* st) {
    XcdBarrier b; b.bar = bar; b.x = xb_xcc_id(); b.st = st;
    if (threadIdx.x == 0) (void)xb_add(&bar[XB_XCNT(b.x)], 1u);
    return b;
}
__device__ __forceinline__ void xcd_barrier_complete(unsigned* bar, unsigned x, unsigned& nloc, unsigned& nx) {
    const unsigned G = gridDim.x * gridDim.y * gridDim.z;
    unsigned sum, cnt, mine, sp = 0u;
    for (;;) {
        sum = 0u; cnt = 0u; mine = 0u;
#pragma unroll
        for (unsigned j = 0; j < 16; ++j) { const unsigned c = xb_ld(&bar[XB_XCNT(j)]); sum += c; cnt += (c > 0u) ? 1u : 0u; mine = (j == x) ? c : mine; }
        if (sum == G) break;
        __builtin_amdgcn_s_sleep(1);
        if ((++sp & 255u) == 0u) { if (xb_ld(&bar[XB_TMO])) break; if (sp > XB_SPIN_CAP) { atomicAdd(&bar[XB_TMO], 1u); break; } }
    }
    nloc = mine > 0u ? mine : 1u; nx = cnt > 0u ? cnt : 1u;
}

__device__ __forceinline__ void xcd_barrier(const XcdBarrier& b) {
    asm volatile("s_waitcnt vmcnt(0)" ::: "memory");
    __syncthreads();
    if (threadIdx.x == 0) {
        unsigned* bar = b.bar;
        __builtin_amdgcn_s_waitcnt(0);
        unsigned nloc = b.st[0], nx = b.st[1];
        if (nloc == 0u) { xcd_barrier_complete(bar, b.x, nloc, nx); b.st[0] = nloc; b.st[1] = nx; }
        const unsigned old = xb_add(&bar[XB_XSUB(b.x)], 1u);
        const unsigned gen = old / nloc;
        if (old + 1u == (gen + 1u) * nloc) {
            __builtin_amdgcn_fence(__ATOMIC_RELEASE, "agent");
            asm volatile("s_waitcnt vmcnt(0)" ::: "memory");
            const unsigned og = xb_add(&bar[XB_TOP], 1u);
            const unsigned tg = og / nx;
            if (og + 1u == (tg + 1u) * nx) xb_add(&bar[XB_TOPGEN], 1u);
            else XB_SPIN(xb_ld(&bar[XB_TOPGEN]) == tg, bar);
            __builtin_amdgcn_fence(__ATOMIC_ACQUIRE, "agent");
            xb_add(&bar[XB_XGEN(b.x)], 1u);
            asm volatile("s_waitcnt vmcnt(0)" ::: "memory");
        } else {
            XB_SPIN(xb_ld(&bar[XB_XGEN(b.x)]) == gen, bar);
            __builtin_amdgcn_fence(__ATOMIC_ACQUIRE, "agent");
            asm volatile("s_waitcnt vmcnt(0)" ::: "memory");
        }
    }
    __syncthreads();
}

template <int NT, int ACT, int K>
__device__ __forceinline__ void small_gemm_tile(LAS unsigned char* lds, const bf16* __restrict__ A, const bf16* __restrict__ Bt, bf16* __restrict__ O, int ldc, int m0, int n0, int tid) {
    constexpr int NC = 16 * NT, KW = K / 8, NCH = KW / 128;
    const int wave = __builtin_amdgcn_readfirstlane(tid >> 6), lane = tid & 63, fr = lane & 15, fq = lane >> 4;
    const bf16* ap = A + (size_t)(m0 + fr) * K + wave * KW + fq * 8;
    const bf16* bp = Bt + (size_t)(n0 + fr) * K + wave * KW + fq * 8;
    f32x4 acc[4][NT];
#pragma unroll
    for (int m = 0; m < 4; ++m)
#pragma unroll
        for (int n = 0; n < NT; ++n) acc[m][n] = (f32x4){0.f, 0.f, 0.f, 0.f};
    bf16x8 fa[4][4], fb[4][NT];
#pragma unroll
    for (int c = 0; c < NCH; ++c) {
#pragma unroll
        for (int s_ = 0; s_ < 4; ++s_) {
#pragma unroll
            for (int m = 0; m < 4; ++m) fa[s_][m] = *(const bf16x8*)(ap + (size_t)m * 16 * K + c * 128 + s_ * 32);
#pragma unroll
            for (int n = 0; n < NT; ++n) fb[s_][n] = *(const bf16x8*)(bp + (size_t)n * 16 * K + c * 128 + s_ * 32); }
        __builtin_amdgcn_sched_barrier(0);
#pragma unroll
        for (int s_ = 0; s_ < 4; ++s_)
#pragma unroll
            for (int m = 0; m < 4; ++m)
#pragma unroll
                for (int n = 0; n < NT; ++n) acc[m][n] = __builtin_amdgcn_mfma_f32_16x16x32_bf16(fa[s_][m], fb[s_][n], acc[m][n], 0, 0, 0);
        __builtin_amdgcn_sched_barrier(0);
    }
    LAS float* P = (LAS float*)lds + wave * (64 * NC);
#pragma unroll
    for (int m = 0; m < 4; ++m)
#pragma unroll
        for (int n = 0; n < NT; ++n)
#pragma unroll
            for (int i = 0; i < 4; ++i) P[(m * 16 + fq * 4 + i) * NC + n * 16 + fr] = acc[m][n][i];
    __syncthreads();
    constexpr int EPT = 64 * NC / 512;
    const int e0 = tid * EPT, row = e0 / NC, col = e0 % NC;
    float r[EPT];
#pragma unroll
    for (int j = 0; j < EPT; ++j) r[j] = 0.f;
#pragma unroll
    for (int w = 0; w < 8; ++w) { const LAS f32x4* q = (const LAS f32x4*)((LAS float*)lds + w * (64 * NC) + e0);
#pragma unroll
        for (int j = 0; j < EPT / 4; ++j) { const f32x4 v = q[j]; r[4 * j] += v[0]; r[4 * j + 1] += v[1]; r[4 * j + 2] += v[2]; r[4 * j + 3] += v[3]; } }
    if (ACT == 1) {
#pragma unroll
        for (int j = 0; j < EPT; ++j) { const float t = fmaxf(r[j], 0.f); r[j] = t * t; } }
    bf16* op = O + (size_t)(m0 + row) * ldc + n0 + col;
    if (EPT == 8) { v4u w; w.x = pk2(r[0], r[1]); w.y = pk2(r[2], r[3]); w.z = pk2(r[4 % EPT], r[5 % EPT]); w.w = pk2(r[6 % EPT], r[7 % EPT]); *(v4u*)op = w; }
    else { v2u w; w.x = pk2(r[0], r[1]); w.y = pk2(r[2], r[3]); *(v2u*)op = w; }
    __syncthreads();
}

#define SMALL_TN(j, ntn) ((((j) >> 8) * 32 + ((j) & 7) * 4 + (((j) >> 3) & 3)))
constexpr int NPH = 15;
#ifndef REP_PRO
#define REP_PRO 1
#endif
#ifndef REP_GEMM
#define REP_GEMM 1
#endif
#ifndef REP_MIX
#define REP_MIX 1
#endif
#ifndef REP_SYNC
#define REP_SYNC 1
#endif
struct Args { const float* in[24]; float* out; unsigned char* ws; int ph_lo, ph_hi; };
__global__ void __launch_bounds__(NWAVES * 64, 2) hybrid_fwd(Args args) {
    extern __shared__ __attribute__((aligned(16))) unsigned char lds_raw[];
    LAS unsigned char* lds = (LAS unsigned char*)lds_raw;
    volatile LAS unsigned* MISC = (volatile LAS unsigned*)(lds + MISC_OFF);
    if (threadIdx.x < 64) MISC[threadIdx.x] = 0u;
    __syncthreads();
    (void)xcd_barrier_post((unsigned*)(args.ws + WS_CTL), MISC + 8);
    for (int ph = args.ph_lo; ph < args.ph_hi;) {
        int tid = threadIdx.x; asm volatile("" : "+v"(tid));
        const int lane = tid & 63, wave = __builtin_amdgcn_readfirstlane(tid >> 6);
        const int G = gridDim.x; const int bx = blockIdx.x;
        unsigned char* ws = args.ws;
        if (ph == 0) {
            const int vcu = (G % 8 == 0) ? (bx % 8) * (G / 8) + bx / 8 : bx; const int gw = vcu * NWAVES + wave, NGW = G * NWAVES;
            LAS float* scr = (LAS float*)(lds + wave * WAVE_SCR);
            bf16* XN = (bf16*)(ws + WS_XN); bf16* SGW = (bf16*)(ws + WS_SGUW);
            constexpr int I_FOLD = 4 * (DM / 32), I_OUT = (DM / 64) * (DM / 32) - I_FOLD, I_IN = (DM / 64) * (INW / 32), I_UP = (DM / 64) * (FF / 32), I_DN = (FF / 64) * (DM / 32);
            constexpr int I_LAYER = I_OUT + I_IN + I_UP + I_DN, I_ALL = DEPTH * I_LAYER;
            for (int it = gw; it < DEPTH * I_FOLD; it += NGW) { const int l = it / I_FOLD, r = it % I_FOLD;
                fold_item(args.in[10] + (size_t)l * DM * DM, (bf16*)(ws + WS_W + (size_t)l * W_LAYER + W_OUT), args.in[11] + (size_t)l * 4 * 64 * 64, args.in[12] + (size_t)l * GW, scr, r, lane); }
#define TR_DECODE(it_, d_) do { const int l_ = (it_) / I_LAYER; int r_ = (it_) % I_LAYER; unsigned char* wl_ = ws + WS_W + (size_t)l_ * W_LAYER; int nblk_; \
                if (r_ < I_OUT) { r_ += I_FOLD; d_.W = args.in[10] + (size_t)l_ * DM * DM; d_.WT = (bf16*)(wl_ + W_OUT); d_.gk = nullptr; d_.K = DM; d_.N = DM; } \
                else if ((r_ -= I_OUT) < I_IN) { d_.W = args.in[9] + (size_t)l_ * DM * INW; d_.WT = (bf16*)(wl_ + W_IN); d_.gk = args.in[5] + (size_t)l_ * DM; d_.K = DM; d_.N = INW; } \
                else if ((r_ -= I_IN) < I_UP) { d_.W = args.in[22] + (size_t)l_ * DM * FF; d_.WT = (bf16*)(wl_ + W_UP); d_.gk = args.in[7] + (size_t)l_ * DM; d_.K = DM; d_.N = FF; } \
                else { r_ -= I_UP; d_.W = args.in[23] + (size_t)l_ * FF * DM; d_.WT = (bf16*)(wl_ + W_DN); d_.gk = nullptr; d_.K = FF; d_.N = DM; } \
                nblk_ = d_.N / 32; d_.k0 = 64 * (r_ / nblk_); d_.n0 = 32 * (r_ % nblk_); } while (0)
            { int it = NGW - 1 - gw;
              if (it < I_ALL) {
                TrDesc dc; TR_DECODE(it, dc);
                float va[32], vb[32];
                tr_load(va, dc, lane);
#pragma unroll 1
                for (;;) {
                    const int itn = it + NGW; const bool more = itn < I_ALL;
                    TrDesc dn; { const int q = more ? itn : it; TR_DECODE(q, dn); }
                    tr_load(vb, dn, lane);
                    tr_store(va, dc, scr, lane);
                    if (!more) break;
#pragma unroll
                    for (int i = 0; i < 32; ++i) va[i] = vb[i];
                    dc = dn; it = itn;
                }
              }
            }
#undef TR_DECODE
            for (int m = gw; m < MT; m += NGW) rms_row_to_bf16(m < MP ? args.in[0] + (size_t)m * DM : args.in[1] + (size_t)(m - MP) * DM, XN + (size_t)m * DM, lane);
            for (int e = bx * (NWAVES * 64) + tid; e < DEPTH * 4 * 128 * 128; e += G * NWAVES * 64) { const int t = (e >> 7) & 127, s = e & 127; SGW[e] = (bf16)(s <= t ? f2bf(args.in[19][e]) : 0u); }
        } else {
            const int l = (ph - 1) / 7, k = (ph - 1) - 7 * l;
            unsigned char* wl = ws + WS_W + (size_t)l * W_LAYER;
            if (k == 0 || k == 2 || k == 5) {
                const bf16* A = (const bf16*)(ws + (k == 0 ? WS_XN : k == 2 ? WS_CAT : WS_H));
                const bf16* Bt = (const bf16*)(wl + (k == 0 ? W_IN : k == 2 ? W_OUT : W_DN));
                bf16* O = (bf16*)(ws + (k == 0 ? WS_Z : WS_O));
                const int N = k == 0 ? INW : DM, K = k == 5 ? FF : DM;
                pg8::Gemm g{A, Bt, MP, N, K}; pg8::StaticOrder S; S.init(MP, N, G, bx);
                pg8::EpiBf16<0> E{O, k == 0 ? ZP : N};
                pg8::gemm_phase<pg8::EpiBf16<0>, pg8::StaticOrder, true, true>(lds, g, S, E, tid);
                if (k == 0) { for (int j = bx; j < (MS / 64) * (INW / 64); j += G) small_gemm_tile<4, 0, DM>(lds, A, Bt, O, ZP, MP + ((j >> 5) & 7) * 64, SMALL_TN(j, INW / 64) * 64, tid); }
                else { for (int j = bx; j < (MS / 64) * (DM / 32); j += G) { if (k == 2) small_gemm_tile<2, 0, DM>(lds, A, Bt, O, N, MP + ((j >> 5) & 7) * 64, SMALL_TN(j, DM / 32) * 32, tid); else small_gemm_tile<2, 0, FF>(lds, A, Bt, O, N, MP + ((j >> 5) & 7) * 64, SMALL_TN(j, DM / 32) * 32, tid); } }
            } else if (k == 4) {
                pg8::Gemm g{(const bf16*)(ws + WS_XN), (const bf16*)(wl + W_UP), MP, FF, DM}; pg8::StaticOrder S; S.init(MP, FF, G, bx);
                pg8::EpiBf16<1> E{(bf16*)(ws + WS_H), FF};
                pg8::gemm_phase<pg8::EpiBf16<1>, pg8::StaticOrder, true, true>(lds, g, S, E, tid);
                for (int j = bx; j < (MS / 64) * (FF / 64); j += G) small_gemm_tile<4, 1, DM>(lds, (const bf16*)(ws + WS_XN), (const bf16*)(wl + W_UP), (bf16*)(ws + WS_H), FF, MP + ((j >> 5) & 7) * 64, SMALL_TN(j, FF / 64) * 64, tid);
            } else if (k == 1) {
                const int vcu = (G % 8 == 0) ? (bx % 8) * (G / 8) + bx / 8 : bx; const int gw = vcu * NWAVES + wave, NGW = G * NWAVES;
                LAS float* scr = (LAS float*)(lds + wave * WAVE_SCR);
                const bf16* ZB = (const bf16*)(ws + WS_Z); bf16* CAT = (bf16*)(ws + WS_CAT); const bf16* SGW = (const bf16*)(ws + WS_SGUW) + (size_t)l * 4 * 128 * 128;
                float* out = args.out;
                constexpr int NU_SGU = 512, NU_CONV = 2048, NU_SEG = 1024, NU_SMP = 2048, NU = NU_SGU + NU_CONV + 2 * NU_SEG + NU_SMP;
#pragma unroll 1
                for (int ui = 0; ; ++ui) {
                    int u;
                    if (NGW != 2048) { u = ui * NGW + gw; if (u >= NU) break; }
                    else { if (ui >= 4) break;
                        if (gw < 512) { if (ui == 0) u = gw; else if (ui == 1) u = NU_SGU + 1536 + gw; else break; }
                        else { const int g5 = gw - 512; if (ui == 0) u = NU_SGU + g5; else { const int sidx = (ui - 1) * 1536 + g5; if (sidx >= 2 * NU_SEG + NU_SMP) break; u = NU_SGU + NU_CONV + sidx; } } }
                    int lane = tid & 63; asm volatile("" : "+v"(lane));
                    if (u < NU_SGU) { sgu_unit(ZB, CAT, SGW, args.in[17] + (size_t)l * GW, args.in[18] + (size_t)l * GW, args.in[20] + (size_t)l * 4 * 128, u >> 2, u & 3, (LAS bf16*)scr, lane); continue; }
                    int r = u - NU_SGU;
                    if (r < NU_CONV) { const int seg = r >> 2, h = r & 3, seq = seg >> 6, t0 = (seg & 63) * 32;
                        conv_unit_p(ZB, CAT, out + OUT_CONV_P + (size_t)l * NBP * 30 * GW, args.in[13] + (size_t)l * 31 * GW, args.in[14] + (size_t)l * GW, args.in[15] + (size_t)l * GW, args.in[16] + (size_t)l * GW, seq, t0, h, scr, lane);
                        continue; }
                    r -= NU_CONV;
                    if (r < 2 * NU_SEG) { const int ty = r / NU_SEG, q = r % NU_SEG, seg = q >> 2, h = q & 3, seq = seg >> 5, t0 = (seg & 31) * 64;
                        if (ty == 0) { float* np = out + OUT_POOL_P + (size_t)l * NBP * 15 * GW;
                            if (h == 0) pool_unit_p<2>(ZB, CAT, np, seq, t0, h, lane); else if (h == 1) pool_unit_p<4>(ZB, CAT, np, seq, t0, h, lane);
                            else if (h == 2) pool_unit_p<8>(ZB, CAT, np, seq, t0, h, lane); else pool_unit_p<16>(ZB, CAT, np, seq, t0, h, lane); }
                        else short_unit_p(ZB, CAT, out + OUT_SHORT_P + (size_t)l * NBP * 2 * GW, args.in[21] + (size_t)l * 3 * GW, seq, t0, h, lane);
                        continue; }
                    r -= 2 * NU_SEG;
                    { const int ty = r >> 9, q = r & 511, seq = q >> 2, h = q & 3;
                        if (ty == 0) conv_unit<true>(ZB, CAT, args.in[3] + (size_t)l * NSB * 30 * GW, out + OUT_CONV_S + (size_t)l * NSB * 30 * GW, args.in[13] + (size_t)l * 31 * GW, args.in[14] + (size_t)l * GW, args.in[15] + (size_t)l * GW, args.in[16] + (size_t)l * GW, seq, 0, ST, h, scr, lane);
                        else if (ty == 1) pool_unit<true>(ZB, CAT, args.in[2] + (size_t)l * NSB * 15 * GW, out + OUT_POOL_S + (size_t)l * NSB * 15 * GW, seq, 0, ST, h, lane);
                        else if (ty == 2) short_unit<true>(ZB, CAT, args.in[4] + (size_t)l * NSB * 2 * GW, out + OUT_SHORT_S + (size_t)l * NSB * 2 * GW, args.in[21] + (size_t)l * 3 * GW, seq, 0, ST, h, lane);
                        else sgu_sample_unit(ZB, CAT, args.in[19] + (size_t)l * 4 * 128 * 128, args.in[17] + (size_t)l * GW, args.in[18] + (size_t)l * GW, args.in[20] + (size_t)l * 4 * 128, out + OUT_V_S + (size_t)l * NSB * ST * GW, seq, h, lane); }
                }
            } else {
                const int vcu = (G % 8 == 0) ? (bx % 8) * (G / 8) + bx / 8 : bx; const int gw = vcu * NWAVES + wave, NGW = G * NWAVES;
                const float* g = args.in[k == 3 ? 6 : 8] + (size_t)l * DM;
                float* X = args.out; const bf16* OB = (const bf16*)(ws + WS_O); bf16* XN = (bf16*)(ws + WS_XN);
                const bool from_input = (l == 0 && k == 3), write_xn = !(l == DEPTH - 1 && k == 6);
                f32x4 gg[4];
#pragma unroll
                for (int j = 0; j < 4; ++j) gg[j] = ((const f32x4*)g + lane)[64 * j];
#define EW_XSRC(m) (from_input ? ((m) < MP ? args.in[0] + (size_t)(m) * DM : args.in[1] + (size_t)((m) - MP) * DM) : X + (size_t)(m) * DM)
                const int m_lo = 0;
#pragma unroll 1
                for (int m = m_lo + gw; m < MT; m += 2 * NGW) {
                    const int m2 = m + NGW; const bool two = m2 < MT;
                    EwRow ra, rb;
                    ew_load(ra, EW_XSRC(m), OB + (size_t)m * DM, lane);
                    { const int mc = two ? m2 : m; ew_load(rb, EW_XSRC(mc), OB + (size_t)mc * DM, lane); }
                    ew_finish(ra, gg, X + (size_t)m * DM, XN + (size_t)m * DM, write_xn, lane);
                    if (two) ew_finish(rb, gg, X + (size_t)m2 * DM, XN + (size_t)m2 * DM, write_xn, lane);
                }
#undef EW_XSRC
            }
        }
        ++ph;
        if (ph < args.ph_hi) {
            if (args.ph_lo < 0) cg::this_grid().sync();
            else { XcdBarrier b; b.bar = (unsigned*)(args.ws + WS_CTL); b.x = xb_xcc_id(); b.st = (volatile LAS unsigned*)(lds + MISC_OFF) + 8; xcd_barrier(b); }
        }
    }
}

#ifndef MK_N_LAUNCHES
#define MK_N_LAUNCHES 1
#endif
extern "C" void kernel_launch(void* const* d_in, const int* in_sizes, int n_in, void* d_out, int out_size, void* d_ws, size_t ws_size, hipStream_t stream) {
    static int grid = 0;
    if (grid == 0) {
        if (n_in != 24 || (size_t)out_size != OUT_END || ws_size < WS_END) { fprintf(stderr, "kernel_launch: unexpected shapes (n_in %d out %d ws %zu)\n", n_in, out_size, ws_size); grid = -1; return; }
        int dev = 0, cus = 0, per_cu = 0;
        if (hipGetDevice(&dev) != hipSuccess || hipDeviceGetAttribute(&cus, hipDeviceAttributeMultiprocessorCount, dev) != hipSuccess) { grid = -1; return; }
        if (hipFuncSetAttribute((const void*)hybrid_fwd, hipFuncAttributeMaxDynamicSharedMemorySize, LDS_BYTES) != hipSuccess) { fprintf(stderr, "kernel_launch: hipFuncSetAttribute failed\n"); grid = -1; return; }
        if (hipOccupancyMaxActiveBlocksPerMultiprocessor(&per_cu, (const void*)hybrid_fwd, NWAVES * 64, LDS_BYTES) != hipSuccess || per_cu < 1) per_cu = 1;
        (void)hipGetLastError();
        grid = cus * per_cu;
    }
    if (grid < 0) return;
    if (hipMemsetAsync((char*)d_ws + WS_CTL, 0, CTL_ZERO_BYTES, stream) != hipSuccess) { fprintf(stderr, "kernel_launch: hipMemsetAsync failed\n"); return; }
    Args a{};
    for (int i = 0; i < 24; ++i) a.in[i] = (const float*)d_in[i];
    a.out = (float*)d_out; a.ws = (unsigned char*)d_ws;
#if MK_N_LAUNCHES == 1
    a.ph_lo = 0; a.ph_hi = NPH;
    void* kargs[] = {&a};
    hipError_t e = hipLaunchCooperativeKernel((const void*)hybrid_fwd, dim3(grid), dim3(NWAVES * 64), kargs, LDS_BYTES, stream);
    if (e != hipSuccess) fprintf(stderr, "cooperative launch failed: %s (grid %d)\n", hipGetErrorString(e), grid);
#else
    for (int p = 0; p < NPH; ++p) { a.ph_lo = p; a.ph_hi = p + 1; hipLaunchKernelGGL(hybrid_fwd, dim3(grid), dim3(NWAVES * 64), LDS_BYTES, stream, a); }
#endif
}
```

```cpp
#include <hip/hip_runtime.h>
#include <hip/hip_cooperative_groups.h>
#include <cstdio>
#include <cstdint>
namespace pg8 {
#define PG8_LAS __attribute__((address_space(3)))
typedef unsigned short bf16_t;
typedef short bf16x8 __attribute__((ext_vector_type(8)));
typedef float f32x4 __attribute__((ext_vector_type(4)));
typedef unsigned u32x4 __attribute__((ext_vector_type(4)));
constexpr int KPAD = 64;
constexpr int BM = 256, BK = 64, HALF = 128, HTB = HALF * BK * 2  , STAGE_BYTES = 8 * HTB, NXCD = 8, WGM = 8;

__host__ __device__ __forceinline__ int lds_byte(int r, int c) { const int st = (r >> 4) * 2 + (c >> 5), rr = r & 15, cc = c & 31, ob = rr * 64 + cc * 2; return st * 1024 + (ob ^ (((ob >> 9) & 1) << 5)); }
__host__ __device__ __forceinline__ void stage_rc(int b, int& R, int& C) { const int st = b / 1024, sb = b % 1024, swz = sb ^ (((sb >> 9) & 1) << 5); R = (st >> 1) * 16 + swz / 64; C = (st & 1) * 32 + (swz % 64) / 2; }
__host__ __device__ __forceinline__ int perm32(int rho) { const int n = rho >> 4, i = rho & 15; return 8 * (i >> 2) + 4 * n + (i & 3); }

struct Unit { int pm, pn; };
struct Gemm { const bf16_t* A; const bf16_t* Bt; int M, N, K, lda, ldb; };

struct StaticOrder {
    int nM, nN, nwg, G, c;
    __host__ __device__ void init(int M, int N, int G_, int c_) { nM = M / BM; nN = N / BM; nwg = nM * nN; G = G_; c = c_; }
    __host__ __device__ bool next(int i, Unit& u) const {
        const long L = (long)i * G + c; if (L >= nwg) return false;
        int wgid = (int)L; { const int q = nwg / NXCD, r = nwg % NXCD, xcd = wgid % NXCD, off = wgid / NXCD; wgid = (xcd < r ? xcd * (q + 1) : r * (q + 1) + (xcd - r) * q) + off; }
        const int nig = WGM * nN, gid = wgid / nig, fm = gid * WGM, gsz = (nM - fm) < WGM ? (nM - fm) : WGM;
        u.pm = fm + ((wgid % nig) % gsz); u.pn = (wgid % nig) / gsz; return true;
    }
    __device__ __forceinline__ void a_ready(const Unit&) const {}
    __device__ __forceinline__ void done(const Unit&) const {}
};

__device__ __forceinline__ unsigned cvt_pk_bf16(float lo, float hi) { unsigned r; asm volatile("v_cvt_pk_bf16_f32 %0, %1, %2" : "=v"(r) : "v"(lo), "v"(hi)); return r; }
__device__ __forceinline__ float relu_sq(float x) { float r; asm volatile("v_max_f32 %0, 0, %1" : "=v"(r) : "v"(x)); return r * r; }
__device__ __forceinline__ void st16_wt(void* p, u32x4 v) { asm volatile("global_store_dwordx4 %0, %1, off sc1" :: "v"(p), "v"(v) : "memory"); }
template <int ACT  > struct EpiBf16 {
    static constexpr bool PERM = true, AFTER_DRAIN = false;
    bf16_t* O; int ldc;
    __device__ __forceinline__ void operator()(const f32x4 (&acc)[2][2][4][2], const Unit& u, int wr, int wc, int fr, int fq) const {
        const int row0 = u.pm * BM + wr * 64 + fr; const int col0 = u.pn * BM + wc * 32 + 8 * fq;
#pragma unroll
        for (int ai = 0; ai < 2; ++ai)
#pragma unroll
            for (int m = 0; m < 4; ++m) { bf16_t* rowp = O + (size_t)(row0 + ai * HALF + m * 16) * ldc + col0;
#pragma unroll
                for (int bj = 0; bj < 2; ++bj) { f32x4 v0 = acc[ai][bj][m][0], v1 = acc[ai][bj][m][1];
                    if (ACT == 1) {
#pragma unroll
                        for (int e = 0; e < 4; ++e) { v0[e] = relu_sq(v0[e]); v1[e] = relu_sq(v1[e]); } }
                    u32x4 w; w.x = cvt_pk_bf16(v0[0], v0[1]); w.y = cvt_pk_bf16(v0[2], v0[3]); w.z = cvt_pk_bf16(v1[0], v1[1]); w.w = cvt_pk_bf16(v1[2], v1[3]);
                    *(u32x4*)(rowp + bj * HALF) = w; } }
    }
};

template <class Epi, class Sched, bool ALIGN_EPI = false, bool SP2 = false>
__device__ __forceinline__ void gemm_phase(PG8_LAS unsigned char* lds, const Gemm g, const Sched& S, const Epi& E, const int tid) {
    const int wid = __builtin_amdgcn_readfirstlane(tid >> 6), lane = tid & 63, wr = wid >> 2, wc = wid & 3, fr = lane & 15, fq = lane >> 4;
    const int K = g.K, nt = K / BK;
    unsigned voffA[2], voffB[2];
#pragma unroll
    for (int i = 0; i < 2; ++i) { int R, C; stage_rc(tid * 16 + i * 8192, R, C); const int Rb = Epi::PERM ? ((R & ~31) + perm32(R & 31)) : R;
        voffA[i] = (unsigned)(R * g.lda + C) * 2u; voffB[i] = (unsigned)(Rb * g.ldb + C) * 2u; }
    const size_t kstep = (size_t)(BK * 2);
    const size_t hstepA = (size_t)HALF * g.lda * 2, hstepB = (size_t)HALF * g.ldb * 2;
    const size_t tstepA = 2 * hstepA, tstepB = 2 * hstepB;
    const unsigned ldsw = (unsigned)wid * 1024u;
    const int aoff = lds_byte(wr * 64 + fr, fq * 8), boff = lds_byte(wc * 32 + fr, fq * 8);
#define PG8_SA(b, h) (((b) * 2 + (h)) * HTB)
#define PG8_SB(b, h) ((4 + (b) * 2 + (h)) * HTB)
#define PG8_STAGE(bufoff, gbase, voff) do { _Pragma("unroll") for (int _i = 0; _i < 2; ++_i) \
        __builtin_amdgcn_global_load_lds((const unsigned*)((const char*)(gbase) + (voff)[_i]), (PG8_LAS unsigned*)(lds + (bufoff) + ldsw + _i * 8192), 16, 0, 0); } while (0)
#define PG8_LDA(dst, b, h) do { _Pragma("unroll") for (int m = 0; m < 4; ++m) _Pragma("unroll") for (int k = 0; k < 2; ++k) dst[m][k] = *(const PG8_LAS bf16x8*)(lds + PG8_SA(b, h) + aoff + m * 2048 + k * 1024); } while (0)
#define PG8_LDB(dst, b, h) do { _Pragma("unroll") for (int n = 0; n < 2; ++n) _Pragma("unroll") for (int k = 0; k < 2; ++k) dst[n][k] = *(const PG8_LAS bf16x8*)(lds + PG8_SB(b, h) + boff + n * 2048 + k * 1024); } while (0)
#define PG8_MMA(ai, bj, At, Bt) do { __builtin_amdgcn_s_setprio(1); _Pragma("unroll") for (int m = 0; m < 4; ++m) _Pragma("unroll") for (int n = 0; n < 2; ++n) _Pragma("unroll") for (int k = 0; k < 2; ++k) \
        acc[ai][bj][m][n] = __builtin_amdgcn_mfma_f32_16x16x32_bf16(Bt[n][k], At[m][k], acc[ai][bj][m][n], 0, 0, 0); __builtin_amdgcn_s_setprio(0); } while (0)
#define PG8_WAIT_V(n) asm volatile("s_waitcnt vmcnt(" #n ")" ::: "memory")
#define PG8_WAIT_L(n) asm volatile("s_waitcnt lgkmcnt(" #n ")" ::: "memory")
#define PG8_BAR __builtin_amdgcn_s_barrier()
#define PG8_SCHED __builtin_amdgcn_sched_barrier(0)
    Unit cur, nxt; int ui = 0;
    if (!S.next(0, cur)) return;
    f32x4 acc[2][2][4][2];
#pragma unroll
    for (int a = 0; a < 2; ++a)
#pragma unroll
        for (int b = 0; b < 2; ++b)
#pragma unroll
            for (int m = 0; m < 4; ++m)
#pragma unroll
                for (int n = 0; n < 2; ++n) acc[a][b][m][n] = (f32x4){0.f, 0.f, 0.f, 0.f};
    bf16x8 At[4][2], B0[2][2], B1[2][2];
    const char* cA = (const char*)g.A + (size_t)cur.pm * tstepA; const char* cB = (const char*)g.Bt + (size_t)cur.pn * tstepB;
    S.a_ready(cur);
    if constexpr (SP2) {
        PG8_STAGE(PG8_SB(0, 0), cB, voffB); PG8_STAGE(PG8_SB(0, 1), cB + hstepB, voffB); PG8_STAGE(PG8_SA(0, 0), cA, voffA); PG8_STAGE(PG8_SA(0, 1), cA + hstepA, voffA);
        if (wr == 1) PG8_BAR;
        PG8_WAIT_V(2); PG8_BAR;
        PG8_STAGE(PG8_SB(1, 0), cB + kstep, voffB); PG8_STAGE(PG8_SA(1, 0), cA + kstep, voffA); PG8_STAGE(PG8_SB(1, 1), cB + hstepB + kstep, voffB);
        PG8_WAIT_V(6); PG8_BAR;
    } else {
        PG8_STAGE(PG8_SB(0, 0), cB, voffB); PG8_STAGE(PG8_SA(0, 0), cA, voffA); PG8_STAGE(PG8_SB(0, 1), cB + hstepB, voffB); PG8_STAGE(PG8_SA(0, 1), cA + hstepA, voffA);
        if (wr == 1) PG8_BAR;
        PG8_WAIT_V(4); PG8_BAR;
        PG8_STAGE(PG8_SB(1, 0), cB + kstep, voffB); PG8_STAGE(PG8_SA(1, 0), cA + kstep, voffA); PG8_STAGE(PG8_SB(1, 1), cB + hstepB + kstep, voffB);
        PG8_WAIT_V(6); PG8_BAR;
    }
    for (;;) {
        const bool has_next = S.next(ui + 1, nxt);
        const char* nA = has_next ? (const char*)g.A + (size_t)nxt.pm * tstepA : cA; const char* nB = has_next ? (const char*)g.Bt + (size_t)nxt.pn * tstepB : cB;
        for (int t = 0; t < nt; t += 2) {
            const bool last = (t == nt - 2);
            const char* a1 = cA + (size_t)(t + 1) * kstep;
            const char* a2 = last ? nA : cA + (size_t)(t + 2) * kstep; const char* b2 = last ? nB : cB + (size_t)(t + 2) * kstep;
            const char* a3 = a2 + kstep; const char* b3 = b2 + kstep;
            if (last && has_next) S.a_ready(nxt);
            if constexpr (SP2) {
            PG8_LDB(B0, 0, 0); PG8_LDB(B1, 0, 1); PG8_SCHED; PG8_LDA(At, 0, 0); PG8_STAGE(PG8_SA(1, 1), a1 + hstepA, voffA);
            PG8_WAIT_V(8); PG8_WAIT_L(0); PG8_BAR; PG8_MMA(0, 0, At, B0); PG8_MMA(0, 1, At, B1); PG8_BAR; PG8_SCHED;
            PG8_LDA(At, 0, 1); PG8_STAGE(PG8_SB(0, 0), b2, voffB); PG8_STAGE(PG8_SB(0, 1), b2 + hstepB, voffB); PG8_STAGE(PG8_SA(0, 0), a2, voffA);
            PG8_WAIT_V(8); PG8_WAIT_L(0); PG8_BAR; PG8_MMA(1, 0, At, B0); PG8_MMA(1, 1, At, B1); PG8_BAR; PG8_SCHED;
            PG8_LDB(B0, 1, 0); PG8_LDB(B1, 1, 1); PG8_SCHED; PG8_LDA(At, 1, 0); PG8_STAGE(PG8_SA(0, 1), a2 + hstepA, voffA);
            PG8_WAIT_V(8); PG8_WAIT_L(0); PG8_BAR; PG8_MMA(0, 0, At, B0); PG8_MMA(0, 1, At, B1); PG8_BAR; PG8_SCHED;
            PG8_LDA(At, 1, 1); PG8_STAGE(PG8_SB(1, 0), b3, voffB); PG8_STAGE(PG8_SB(1, 1), b3 + hstepB, voffB); PG8_STAGE(PG8_SA(1, 0), a3, voffA);
            PG8_WAIT_V(8); PG8_WAIT_L(0); PG8_BAR; PG8_MMA(1, 0, At, B0); PG8_MMA(1, 1, At, B1); PG8_BAR; PG8_SCHED;
            } else {
            PG8_LDB(B0, 0, 0); PG8_SCHED; PG8_LDA(At, 0, 0); PG8_STAGE(PG8_SA(1, 1), a1 + hstepA, voffA);
            PG8_WAIT_L(8); PG8_BAR; PG8_WAIT_L(0); PG8_MMA(0, 0, At, B0); PG8_BAR; PG8_SCHED;
            PG8_LDB(B1, 0, 1); PG8_STAGE(PG8_SB(0, 0), b2, voffB);
            PG8_BAR; PG8_WAIT_L(0); PG8_MMA(0, 1, At, B1); PG8_BAR;
            PG8_LDA(At, 0, 1); PG8_STAGE(PG8_SA(0, 0), a2, voffA);
            PG8_BAR; PG8_WAIT_L(0); PG8_MMA(1, 0, At, B0); PG8_BAR; PG8_SCHED;
            PG8_STAGE(PG8_SB(0, 1), b2 + hstepB, voffB);
            PG8_WAIT_V(6); PG8_BAR; PG8_MMA(1, 1, At, B1); PG8_BAR;
            PG8_LDB(B0, 1, 0); PG8_SCHED; PG8_LDA(At, 1, 0); PG8_STAGE(PG8_SA(0, 1), a2 + hstepA, voffA);
            PG8_WAIT_L(8); PG8_BAR; PG8_WAIT_L(0); PG8_MMA(0, 0, At, B0); PG8_BAR; PG8_SCHED;
            PG8_LDB(B1, 1, 1); PG8_STAGE(PG8_SB(1, 0), b3, voffB);
            PG8_BAR; PG8_WAIT_L(0); PG8_MMA(0, 1, At, B1); PG8_BAR;
            PG8_LDA(At, 1, 1); PG8_STAGE(PG8_SA(1, 0), a3, voffA);
            PG8_BAR; PG8_WAIT_L(0); PG8_MMA(1, 0, At, B0); PG8_BAR; PG8_SCHED;
            PG8_STAGE(PG8_SB(1, 1), b3 + hstepB, voffB);
            PG8_WAIT_V(6); PG8_BAR; PG8_MMA(1, 1, At, B1); PG8_BAR;
            }
        }
        if constexpr (ALIGN_EPI) { if (wr == 0) PG8_BAR; }
        if constexpr (!Epi::AFTER_DRAIN) { E(acc, cur, wr, wc, fr, fq); S.done(cur); }
        if (!has_next) break;
#pragma unroll
        for (int a = 0; a < 2; ++a)
#pragma unroll
            for (int b = 0; b < 2; ++b)
#pragma unroll
                for (int m = 0; m < 4; ++m)
#pragma unroll
                    for (int n = 0; n < 2; ++n) acc[a][b][m][n] = (f32x4){0.f, 0.f, 0.f, 0.f};
        cur = nxt; cA = nA; cB = nB; ++ui;
        if constexpr (ALIGN_EPI) { if (wr == 1) PG8_BAR; }
    }
    PG8_WAIT_V(0);
    if constexpr (!ALIGN_EPI) { if (wr == 0) PG8_BAR; }
    PG8_BAR;
    if constexpr (Epi::AFTER_DRAIN) { E.fused(acc, cur, wr, wc, fr, fq, lds, wid, lane); S.done(cur); }
#undef PG8_SA
#undef PG8_SB
#undef PG8_STAGE
#undef PG8_LDA
#undef PG8_LDB
#undef PG8_MMA
#undef PG8_WAIT_V
#undef PG8_WAIT_L
#undef PG8_BAR
#undef PG8_SCHED
}
}

namespace cg = cooperative_groups;
#define LAS __attribute__((address_space(3)))
typedef unsigned short bf16;
typedef unsigned v4u __attribute__((ext_vector_type(4)));
typedef unsigned v2u __attribute__((ext_vector_type(2)));
typedef float f32x4 __attribute__((ext_vector_type(4)));
typedef short bf16x8 __attribute__((ext_vector_type(8)));

constexpr int NWAVES = 8;
constexpr int DM = 1024, FF = 4096, INW = 2048, GW = 256;
constexpr int ZP = INW + 64;
#ifndef HPAD
#define HPAD 0
#endif
#ifndef WPAD
#define WPAD 0
#endif
#ifndef APAD
#define APAD 0
#endif
constexpr int DP = DM + APAD;
#ifndef OPAD
#define OPAD 0
#endif
constexpr int OP = DM + OPAD;
constexpr int FP = FF + HPAD;
constexpr int MP = 16384, MS = 512, MT = MP + MS;
constexpr int SEQ = 2048, NBP = 8, NSB = 128, ST = 4, DEPTH = 2;
constexpr float EPS = 1e-6f;
constexpr size_t MiB = 1u << 20;
constexpr size_t WS_SGUW = 1 * MiB;
constexpr size_t WS_W = 2 * MiB, W_LAYER = 24 * MiB, W_IN = 0, W_OUT = 9 * MiB / 2, W_UP = 7 * MiB, W_DN = 31 * MiB / 2;
constexpr size_t WS_XN = 50 * MiB, WS_O = 84 * MiB, WS_H = 120 * MiB, WS_Z = 120 * MiB, WS_CAT = 189 * MiB, WS_END = 255 * MiB;
static_assert(WS_Z + (size_t)16896 * ZP * 2 <= WS_CAT && WS_XN + (size_t)16896 * DP * 2 <= WS_O && WS_CAT + (size_t)16896 * DP * 2 <= WS_H + (size_t)16896 * FP * 2 && WS_H + (size_t)16896 * FP * 2 <= WS_END, "d_ws map");
constexpr int LDS_BYTES = 147456;
constexpr int MISC_OFF = LDS_BYTES - 256;
constexpr size_t WS_CTL = 0, CTL_ZERO_BYTES = 128 * 1024;
constexpr int WAVE_SCR = 17408;
constexpr size_t OUT_Y = 0;
constexpr size_t OUT_POOL_P = (size_t)MT * DM;
constexpr size_t OUT_POOL_S = OUT_POOL_P + (size_t)DEPTH * NBP * 15 * GW;
constexpr size_t OUT_CONV_P = OUT_POOL_S + (size_t)DEPTH * NSB * 15 * GW;
constexpr size_t OUT_CONV_S = OUT_CONV_P + (size_t)DEPTH * NBP * 30 * GW;
constexpr size_t OUT_SHORT_P = OUT_CONV_S + (size_t)DEPTH * NSB * 30 * GW;
constexpr size_t OUT_SHORT_S = OUT_SHORT_P + (size_t)DEPTH * NBP * 2 * GW;
constexpr size_t OUT_V_S = OUT_SHORT_S + (size_t)DEPTH * NSB * 2 * GW;
constexpr size_t OUT_END = OUT_V_S + (size_t)DEPTH * NSB * ST * GW;

__device__ __forceinline__ float bf2f(bf16 b) { return __uint_as_float(((unsigned)b) << 16); }
__device__ __forceinline__ unsigned f2bf(float f) { unsigned u = __float_as_uint(f); return (u + 0x7fffu + ((u >> 16) & 1u)) >> 16; }
__device__ __forceinline__ unsigned pk2(float lo, float hi) { return f2bf(lo) | (f2bf(hi) << 16); }
template <int CTRL, int ROWMASK> __device__ __forceinline__ float dpp_get(float v) { return __int_as_float(__builtin_amdgcn_update_dpp(0, __float_as_int(v), CTRL, ROWMASK, 0xF, false)); }
__device__ __forceinline__ float sum8(float v) { v += dpp_get<0xB1, 0xF>(v); v += dpp_get<0x4E, 0xF>(v); v += dpp_get<0x141, 0xF>(v); return v; }
__device__ __forceinline__ float wave_sum(float v) {
    v = sum8(v); v += dpp_get<0x140, 0xF>(v); v += dpp_get<0x142, 0xA>(v); v += dpp_get<0x143, 0xC>(v);
    return __int_as_float(__builtin_amdgcn_readlane(__float_as_int(v), 63));
}
__device__ __forceinline__ void unpack8(const v4u w, float (&f)[8]) {
    f[0] = __uint_as_float(w.x << 16); f[1] = __uint_as_float(w.x & 0xffff0000u); f[2] = __uint_as_float(w.y << 16); f[3] = __uint_as_float(w.y & 0xffff0000u);
    f[4] = __uint_as_float(w.z << 16); f[5] = __uint_as_float(w.z & 0xffff0000u); f[6] = __uint_as_float(w.w << 16); f[7] = __uint_as_float(w.w & 0xffff0000u); }
__device__ __forceinline__ v4u pack8(const float (&f)[8]) { v4u w; w.x = pg8::cvt_pk_bf16(f[0], f[1]); w.y = pg8::cvt_pk_bf16(f[2], f[3]); w.z = pg8::cvt_pk_bf16(f[4], f[5]); w.w = pg8::cvt_pk_bf16(f[6], f[7]); return w; }
__device__ __forceinline__ v4u ld16(const bf16* p) { return *(const v4u*)p; }
__device__ __forceinline__ float sigm(float x) { return __builtin_amdgcn_rcpf(1.f + __builtin_amdgcn_exp2f(-1.44269504f * x)); }
#define LDS_WAIT() asm volatile("s_waitcnt lgkmcnt(0)" ::: "memory")

__device__ __forceinline__ void transpose_item(const float* __restrict__ W, int K, int N, bf16* __restrict__ WT, const float* __restrict__ gk, LAS float* scr, int item, int lane) {
    const int nblk = N / 32, kb = item / nblk, nb = item % nblk, k0 = 64 * kb, n0 = 32 * nb;
#pragma unroll 8
    for (int i = 0; i < 32; ++i) { const int kk = 2 * i + (lane >> 5); float v = W[(size_t)(k0 + kk) * N + n0 + (lane & 31)]; if (gk) v *= gk[k0 + kk]; scr[kk * 33 + (lane & 31)] = v; }
    LDS_WAIT();
    const int c = lane & 7;
#pragma unroll
    for (int j = 0; j < 4; ++j) { const int n = (lane >> 3) + 8 * j; const LAS float* s = scr + (8 * c) * 33 + n;
        v4u o; o.x = pk2(s[0 * 33], s[1 * 33]); o.y = pk2(s[2 * 33], s[3 * 33]); o.z = pk2(s[4 * 33], s[5 * 33]); o.w = pk2(s[6 * 33], s[7 * 33]);
        *(v4u*)(WT + (size_t)(n0 + n) * K + k0 + 8 * c) = o; }
    LDS_WAIT();
}
struct TrDesc { const float* W; bf16* WT; const float* gk; int K, N, k0, n0; };
__device__ __forceinline__ void tr_load(float (&v)[32], const TrDesc& d, int lane) {
    const float* p = d.W + (size_t)(d.k0 + (lane >> 5)) * d.N + d.n0 + (lane & 31);
#pragma unroll
    for (int i = 0; i < 32; ++i) v[i] = p[(size_t)(2 * i) * d.N];
}
__device__ __forceinline__ void tr_store(const float (&v)[32], const TrDesc& d, LAS float* scr, int lane) {
#pragma unroll
    for (int i = 0; i < 32; ++i) { const int kk = 2 * i + (lane >> 5); float x = v[i]; if (d.gk) x *= d.gk[d.k0 + kk]; scr[kk * 33 + (lane & 31)] = x; }
    LDS_WAIT();
    const int c = lane & 7;
#pragma unroll
    for (int j = 0; j < 4; ++j) { const int n = (lane >> 3) + 8 * j; const LAS float* s = scr + (8 * c) * 33 + n;
        v4u o; o.x = pg8::cvt_pk_bf16(s[0 * 33], s[1 * 33]); o.y = pg8::cvt_pk_bf16(s[2 * 33], s[3 * 33]); o.z = pg8::cvt_pk_bf16(s[4 * 33], s[5 * 33]); o.w = pg8::cvt_pk_bf16(s[6 * 33], s[7 * 33]);
        *(v4u*)(d.WT + (size_t)(d.n0 + n) * (d.K + WPAD) + d.k0 + 8 * c) = o; }
    LDS_WAIT();
}
__device__ __forceinline__ void fold_item(const float* __restrict__ W, bf16* __restrict__ WT, const float* __restrict__ wp, const float* __restrict__ ps, LAS float* scr, int item, int lane) {
    const int K = DM, N = DM; const int nblk = N / 32, g = item / nblk, nb = item % nblk, k0 = 64 * g, n0 = 32 * nb;
    LAS float* scr2 = scr + 64 * 33;
#pragma unroll 8
    for (int i = 0; i < 32; ++i) { const int kk = 2 * i + (lane >> 5); scr[kk * 33 + (lane & 31)] = W[(size_t)(k0 + kk) * N + n0 + (lane & 31)] * ps[k0 + kk]; }
    LDS_WAIT();
    const int n = lane & 31;
    for (int i = 0; i < 32; ++i) { const int kk = 2 * i + (lane >> 5); const float* wr = wp + (size_t)(g * 64 + kk) * 64; float a = 0.f;
#pragma unroll 16
        for (int d = 0; d < 64; ++d) a += wr[d] * scr[d * 33 + n];
        scr2[kk * 33 + n] = a; }
    LDS_WAIT();
    const int c = lane & 7;
#pragma unroll
    for (int j = 0; j < 4; ++j) { const int nn = (lane >> 3) + 8 * j; const LAS float* s = scr2 + (8 * c) * 33 + nn;
        v4u o; o.x = pk2(s[0 * 33], s[1 * 33]); o.y = pk2(s[2 * 33], s[3 * 33]); o.z = pk2(s[4 * 33], s[5 * 33]); o.w = pk2(s[6 * 33], s[7 * 33]);
        *(v4u*)(WT + (size_t)(n0 + nn) * (K + WPAD) + k0 + 8 * c) = o; }
    LDS_WAIT();
}
__device__ __forceinline__ void rms_row_to_bf16(const float* __restrict__ xrow, bf16* __restrict__ orow, int lane) {
    const f32x4* xr = (const f32x4*)xrow + lane;
    f32x4 v[4]; float s = 0.f;
#pragma unroll
    for (int j = 0; j < 4; ++j) { v[j] = xr[64 * j]; s += (v[j].x * v[j].x + v[j].y * v[j].y) + (v[j].z * v[j].z + v[j].w * v[j].w); }
    const float rstd = rsqrtf(wave_sum(s) * (1.f / DM) + EPS);
    v2u* o8 = (v2u*)orow + lane;
#pragma unroll
    for (int j = 0; j < 4; ++j) { v2u o; o.x = pk2(v[j].x * rstd, v[j].y * rstd); o.y = pk2(v[j].z * rstd, v[j].w * rstd); o8[64 * j] = o; }
}
struct EwRow { f32x4 x[4]; v2u o[4]; };
__device__ __forceinline__ f32x4 unpack4(const v2u w) { return (f32x4){__uint_as_float(w.x << 16), __uint_as_float(w.x & 0xffff0000u), __uint_as_float(w.y << 16), __uint_as_float(w.y & 0xffff0000u)}; }
__device__ __forceinline__ void ew_load(EwRow& r, const float* __restrict__ xrow32, const bf16* __restrict__ xrow16, bool src16, const bf16* __restrict__ orow, int lane) {
    const v2u* orr = (const v2u*)orow + lane;
    if (src16) { const v2u* xr = (const v2u*)xrow16 + lane;
#pragma unroll
        for (int j = 0; j < 4; ++j) r.x[j] = unpack4(xr[64 * j]); }
    else { const f32x4* xr = (const f32x4*)xrow32 + lane;
#pragma unroll
        for (int j = 0; j < 4; ++j) r.x[j] = xr[64 * j]; }
#pragma unroll
    for (int j = 0; j < 4; ++j) r.o[j] = orr[64 * j];
}
__device__ __forceinline__ void ew_finish(EwRow& r, const f32x4 (&gg)[4], float* __restrict__ Xrow32, bf16* __restrict__ Xrow16, bool dst16, bf16* __restrict__ xnrow, bool write_xn, int lane) {
    f32x4 o[4]; float so = 0.f;
#pragma unroll
    for (int j = 0; j < 4; ++j) { o[j] = unpack4(r.o[j]); so += (o[j].x * o[j].x + o[j].y * o[j].y) + (o[j].z * o[j].z + o[j].w * o[j].w); }
    const float rs = rsqrtf(wave_sum(so) * (1.f / DM) + EPS); float s1 = 0.f;
#pragma unroll
    for (int j = 0; j < 4; ++j) { f32x4 x = r.x[j] + o[j] * rs * gg[j]; r.x[j] = x; s1 += (x.x * x.x + x.y * x.y) + (x.z * x.z + x.w * x.w); }
    if (dst16) { v2u* Xr = (v2u*)Xrow16 + lane;
#pragma unroll
        for (int j = 0; j < 4; ++j) { v2u w; w.x = pg8::cvt_pk_bf16(r.x[j].x, r.x[j].y); w.y = pg8::cvt_pk_bf16(r.x[j].z, r.x[j].w); Xr[64 * j] = w; } }
    else { f32x4* Xr = (f32x4*)Xrow32 + lane;
#pragma unroll
        for (int j = 0; j < 4; ++j) Xr[64 * j] = r.x[j]; }
    if (write_xn) { const float r1 = rsqrtf(wave_sum(s1) * (1.f / DM) + EPS); v2u* o8 = (v2u*)xnrow + lane;
#pragma unroll
        for (int j = 0; j < 4; ++j) { v2u w; w.x = pg8::cvt_pk_bf16(r.x[j].x * r1, r.x[j].y * r1); w.y = pg8::cvt_pk_bf16(r.x[j].z * r1, r.x[j].w * r1); o8[64 * j] = w; } }
}

template <bool SAMPLE>
__device__ __forceinline__ void pool_unit(const bf16* __restrict__ Z, bf16* __restrict__ CAT, const float* __restrict__ state, float* __restrict__ newp,
                                          int seq, int t0, int nrows, int g, int lane) {
    const int c = g * 64 + lane, w = 2 << g;
    const size_t rowbase = SAMPLE ? (size_t)MP + (size_t)seq * ST : (size_t)seq * SEQ;
    const bf16* zc = Z + rowbase * ZP + c;
    const float* st = state + (size_t)seq * 15 * GW + c;
#define POOL_A(e) ((e) >= 0 ? bf2f(zc[(size_t)(e) * ZP]) : (SAMPLE ? st[(15 + (e)) * GW] : 0.f))
    float S = 0.f;
    for (int j = 1; j < w; ++j) S += POOL_A(t0 - j);
#pragma unroll 4
    for (int t = t0; t < t0 + nrows; ++t) {
        const float a = POOL_A(t); S += a;
        const float cnt = SAMPLE ? (float)w : (float)(t + 1 < w ? t + 1 : w);
        CAT[(rowbase + t) * DP + c] = (bf16)f2bf(S / cnt - a);
        const int e = t - w + 1; S -= POOL_A(e);
    }
    const int T = SAMPLE ? ST : SEQ;
    if (t0 + nrows == T) {
        for (int j = 0; j < 15; ++j) { const int e = T - 15 + j; newp[((size_t)seq * 15 + j) * GW + c] = POOL_A(e); }
    }
#undef POOL_A
}
template <bool SAMPLE>
__device__ __forceinline__ void short_unit(const bf16* __restrict__ Z, bf16* __restrict__ CAT, const float* __restrict__ state, float* __restrict__ news,
                                           const float* __restrict__ sw, int seq, int t0, int nrows, int h, int lane) {
    const int c = h * 64 + lane;
    const size_t rowbase = SAMPLE ? (size_t)MP + (size_t)seq * ST : (size_t)seq * SEQ;
    const bf16* zc = Z + rowbase * ZP + c;
    const float* st = state + (size_t)seq * 2 * GW + c;
    const float w0 = sw[c], w1 = sw[GW + c], w2 = sw[2 * GW + c];
#define SH_E(e) ((e) >= 0 ? bf2f(zc[(size_t)(e) * ZP + 1536]) * bf2f(zc[(size_t)(e) * ZP + 1792]) : (SAMPLE ? st[(2 + (e)) * GW] : 0.f))
    float e2 = SH_E(t0 - 2), e1 = SH_E(t0 - 1);
#pragma unroll 4
    for (int t = t0; t < t0 + nrows; ++t) {
        const float e0 = SH_E(t); const float bg = bf2f(zc[(size_t)t * ZP + 1280]);
        CAT[(rowbase + t) * DP + 768 + c] = (bf16)f2bf(bg * (w0 * e2 + w1 * e1 + w2 * e0));
        e2 = e1; e1 = e0;
    }
    const int T = SAMPLE ? ST : SEQ;
    if (t0 + nrows == T) { news[((size_t)seq * 2 + 0) * GW + c] = e2; news[((size_t)seq * 2 + 1) * GW + c] = e1; }
#undef SH_E
}
template <bool SAMPLE>
__device__ __forceinline__ void conv_unit(const bf16* __restrict__ Z, bf16* __restrict__ CAT, const float* __restrict__ state, float* __restrict__ newc,
                                          const float* __restrict__ cw, const float* __restrict__ cb, const float* __restrict__ lg, const float* __restrict__ lb,
                                          int seq, int t0, int nrows, int h, LAS float* gL, int lane) {
    const int c = h * 64 + lane;
    const size_t rowbase = SAMPLE ? (size_t)MP + (size_t)seq * ST : (size_t)seq * SEQ;
    const bf16* zc = Z + rowbase * ZP + c;
    bf16* oc = CAT + rowbase * DP + 256 + c;
    const int T = SAMPLE ? ST : SEQ;
    const bool last = (t0 + nrows == T);
    const int nin = nrows + 30;
#pragma unroll 4
    for (int r = 0; r < nin; ++r) { const int s = t0 - 30 + r; float gs = 0.f;
        if (s >= 0) { const unsigned off = (unsigned)s * ZP; const float p = bf2f(zc[off + 256]), gt = bf2f(zc[off + 512]); gs = p * sigm(gt); }
        else if (SAMPLE) gs = state[((size_t)seq * 30 + 30 + s) * GW + c];
        if (last && s >= T - 30) newc[((size_t)seq * 30 + (s - (T - 30))) * GW + c] = gs;
        gL[r * 64 + lane] = gs; }
    LDS_WAIT();
    float wk[31];
#pragma unroll
    for (int k = 0; k < 31; ++k) wk[k] = cw[k * GW + c];
    const float bias = cb[c], gg = lg[c], bb = lb[c];
#pragma unroll 1
    for (int tq = 0; tq < nrows; tq += 4) {
        float acc[4] = {bias, bias, bias, bias};
#pragma unroll
        for (int r = 0; r < 34; ++r) { const float gv = gL[(tq + r) * 64 + lane];
#pragma unroll
            for (int q = 0; q < 4; ++q) { const int k = r - q; if (k >= 0 && k <= 30) acc[q] += wk[k] * gv; } }
#pragma unroll
        for (int q = 0; q < 4; ++q) { const float cv = acc[q];
            const float mean = wave_sum(cv) * (1.f / 64.f); const float d = cv - mean;
            const float var = wave_sum(d * d) * (1.f / 64.f);
            const float y = d * rsqrtf(var + EPS) * gg + bb;
            oc[(unsigned)(t0 + tq + q) * DP] = (bf16)f2bf(y * sigm(y)); }
    }
    LDS_WAIT();
}
template <int W>
__device__ __forceinline__ void pool_unit_p(const bf16* __restrict__ Z, bf16* __restrict__ CAT, float* __restrict__ newp, int seq, int t0, int g, int lane) {
    const int rr = lane >> 3, cg = lane & 7, c0 = g * 64 + cg * 8, tb = t0 + rr * 8;
    const size_t rowbase = (size_t)seq * SEQ;
    const bf16* zb = Z + (rowbase + tb) * ZP + c0;
    v4u raw[W + 7];
#pragma unroll
    for (int j = 0; j < W + 7; ++j) { const int dj = j - (W - 1); raw[j] = (tb + dj >= 0) ? ld16(zb + (long)dj * ZP) : (v4u){0u, 0u, 0u, 0u}; }
    float S[8];
#pragma unroll
    for (int i = 0; i < 8; ++i) S[i] = 0.f;
#pragma unroll
    for (int j = 0; j < W - 1; ++j) { float f[8]; unpack8(raw[j], f);
#pragma unroll
        for (int i = 0; i < 8; ++i) S[i] += f[i]; }
    bf16* ob = CAT + (rowbase + tb) * DP + c0;
    const bool lastseg = (t0 + 64 == SEQ);
#pragma unroll
    for (int j = 0; j < 8; ++j) { float a[8], o[8], od[8]; unpack8(raw[j + W - 1], a); unpack8(raw[j], od);
        const int t = tb + j; const float inv = 1.f / (float)(t + 1 < W ? t + 1 : W);
#pragma unroll
        for (int i = 0; i < 8; ++i) { S[i] += a[i]; o[i] = S[i] * inv - a[i]; S[i] -= od[i]; }
        *(v4u*)(ob + j * DP) = pack8(o);
        if (lastseg && t >= SEQ - 15) { float* np = newp + ((size_t)seq * 15 + (t - (SEQ - 15))) * GW + c0; *(f32x4*)np = (f32x4){a[0], a[1], a[2], a[3]}; *(f32x4*)(np + 4) = (f32x4){a[4], a[5], a[6], a[7]}; }
    }
}
__device__ __forceinline__ void short_unit_p(const bf16* __restrict__ Z, bf16* __restrict__ CAT, float* __restrict__ news, const float* __restrict__ sw, int seq, int t0, int h, int lane) {
    const int rr = lane >> 3, cg = lane & 7, c0 = h * 64 + cg * 8, tb = t0 + rr * 8;
    const size_t rowbase = (size_t)seq * SEQ;
    const bf16* zb = Z + (rowbase + tb) * ZP + c0;
    v4u Bv[8], Cv[10], Hv[10];
#pragma unroll
    for (int j = 0; j < 10; ++j) { const int dj = j - 2; const bool ok = (tb + dj >= 0);
        Cv[j] = ok ? ld16(zb + (long)dj * ZP + 1536) : (v4u){0u, 0u, 0u, 0u}; Hv[j] = ok ? ld16(zb + (long)dj * ZP + 1792) : (v4u){0u, 0u, 0u, 0u};
        if (j >= 2) Bv[j - 2] = ld16(zb + (long)dj * ZP + 1280); }
    float w0[8], w1[8], w2[8];
#pragma unroll
    for (int i = 0; i < 8; ++i) { w0[i] = sw[c0 + i]; w1[i] = sw[GW + c0 + i]; w2[i] = sw[2 * GW + c0 + i]; }
    float e2[8], e1[8];
    { float c[8], hh[8]; unpack8(Cv[0], c); unpack8(Hv[0], hh);
#pragma unroll
      for (int i = 0; i < 8; ++i) e2[i] = c[i] * hh[i];
      unpack8(Cv[1], c); unpack8(Hv[1], hh);
#pragma unroll
      for (int i = 0; i < 8; ++i) e1[i] = c[i] * hh[i]; }
    bf16* ob = CAT + (rowbase + tb) * DP + 768 + c0;
#pragma unroll
    for (int j = 0; j < 8; ++j) { float c[8], hh[8], b[8], o[8]; unpack8(Cv[j + 2], c); unpack8(Hv[j + 2], hh); unpack8(Bv[j], b);
#pragma unroll
        for (int i = 0; i < 8; ++i) { const float e0 = c[i] * hh[i]; o[i] = b[i] * (w0[i] * e2[i] + w1[i] * e1[i] + w2[i] * e0); e2[i] = e1[i]; e1[i] = e0; }
        *(v4u*)(ob + j * DP) = pack8(o); }
    if (t0 + 64 == SEQ && rr == 7) { float* np = news + (size_t)seq * 2 * GW + c0;
        *(f32x4*)np = (f32x4){e2[0], e2[1], e2[2], e2[3]}; *(f32x4*)(np + 4) = (f32x4){e2[4], e2[5], e2[6], e2[7]};
        *(f32x4*)(np + GW) = (f32x4){e1[0], e1[1], e1[2], e1[3]}; *(f32x4*)(np + GW + 4) = (f32x4){e1[4], e1[5], e1[6], e1[7]}; }
}
__device__ __forceinline__ void conv_unit_p(const bf16* __restrict__ Z, bf16* __restrict__ CAT, float* __restrict__ newc,
                                            const float* __restrict__ cw, const float* __restrict__ cb, const float* __restrict__ lg, const float* __restrict__ lb,
                                            int seq, int t0, int h, LAS float* gL, int lane) {
    const int rr = lane >> 3, cg = lane & 7, c0 = h * 64 + cg * 8;
    const size_t rowbase = (size_t)seq * SEQ;
    const bool last = (t0 + 32 == SEQ);
    { v4u pv[8], gv[8];
#pragma unroll
      for (int j = 0; j < 8; ++j) { const int r = 8 * j + rr, sx = t0 - 30 + r; const bool ok = (sx >= 0 && r < 62);
          const bf16* zp = Z + (rowbase + (ok ? sx : 0)) * ZP + c0;
          pv[j] = ok ? ld16(zp + 256) : (v4u){0u, 0u, 0u, 0u}; gv[j] = ok ? ld16(zp + 512) : (v4u){0u, 0u, 0u, 0u}; }
#pragma unroll
      for (int j = 0; j < 8; ++j) { const int r = 8 * j + rr, sx = t0 - 30 + r; float p[8], gt[8]; unpack8(pv[j], p); unpack8(gv[j], gt);
#pragma unroll
          for (int i = 0; i < 8; ++i) p[i] = p[i] * sigm(gt[i]);
          if (r < 62) { *(LAS f32x4*)(gL + r * 64 + cg * 8) = (f32x4){p[0], p[1], p[2], p[3]}; *(LAS f32x4*)(gL + r * 64 + cg * 8 + 4) = (f32x4){p[4], p[5], p[6], p[7]}; }
          if (last && sx >= SEQ - 30 && r < 62) { float* np = newc + ((size_t)seq * 30 + (sx - (SEQ - 30))) * GW + c0; *(f32x4*)np = (f32x4){p[0], p[1], p[2], p[3]}; *(f32x4*)(np + 4) = (f32x4){p[4], p[5], p[6], p[7]}; } }
    }
    LDS_WAIT();
    const int c = h * 64 + lane;
    float wk[31];
#pragma unroll
    for (int k = 0; k < 31; ++k) wk[k] = cw[k * GW + c];
    const float bias = cb[c];
#pragma unroll 1
    for (int tq = 0; tq < 32; tq += 4) {
        float acc[4] = {bias, bias, bias, bias};
#pragma unroll
        for (int r = 0; r < 34; ++r) { const float gvv = gL[(tq + r) * 64 + lane];
#pragma unroll
            for (int q = 0; q < 4; ++q) { const int k = r - q; if (k >= 0 && k <= 30) acc[q] += wk[k] * gvv; } }
        LDS_WAIT();
#pragma unroll
        for (int q = 0; q < 4; ++q) gL[(tq + q) * 64 + lane] = acc[q];
    }
    LDS_WAIT();
    float gg[8], bb[8];
#pragma unroll
    for (int i = 0; i < 8; ++i) { gg[i] = lg[c0 + i]; bb[i] = lb[c0 + i]; }
    bf16* ob = CAT + (rowbase + t0) * DP + 256 + c0;
#pragma unroll
    for (int j = 0; j < 4; ++j) { const int r = 8 * j + rr; const f32x4 a = *(const LAS f32x4*)(gL + r * 64 + cg * 8), b = *(const LAS f32x4*)(gL + r * 64 + cg * 8 + 4);
        float x[8] = {a[0], a[1], a[2], a[3], b[0], b[1], b[2], b[3]};
        const float mean = sum8(((x[0] + x[1]) + (x[2] + x[3])) + ((x[4] + x[5]) + (x[6] + x[7]))) * (1.f / 64.f);
        float q = 0.f;
#pragma unroll
        for (int i = 0; i < 8; ++i) { x[i] -= mean; q += x[i] * x[i]; }
        const float rstd = rsqrtf(sum8(q) * (1.f / 64.f) + EPS);
#pragma unroll
        for (int i = 0; i < 8; ++i) { const float yy = x[i] * rstd * gg[i] + bb[i]; x[i] = yy * sigm(yy); }
        *(v4u*)(ob + r * DP) = pack8(x); }
    LDS_WAIT();
}
__device__ __forceinline__ int sgu_swz(int c, int chunk) { return (chunk ^ ((c & 15) ^ (c >> 4))) << 3; }
__device__ __forceinline__ void sgu_unit(const bf16* __restrict__ Z, bf16* __restrict__ CAT, const bf16* __restrict__ Wb, const float* __restrict__ lg, const float* __restrict__ lb,
                                         const float* __restrict__ sb, int chunk, int h, LAS bf16* vT, int lane) {
    const size_t r0 = (size_t)chunk * 128;
    { const int rr = lane >> 3, cg = lane & 7, c0 = h * 64 + cg * 8;
      float gg[8], bb[8];
#pragma unroll
      for (int i = 0; i < 8; ++i) { gg[i] = lg[c0 + i]; bb[i] = lb[c0 + i]; }
#pragma unroll 1
      for (int jh = 0; jh < 16; jh += 8) {
          v4u raw[8];
#pragma unroll
          for (int j = 0; j < 8; ++j) raw[j] = ld16(Z + (r0 + 8 * (jh + j) + rr) * ZP + 1024 + c0);
#pragma unroll
          for (int j = 0; j < 8; ++j) { float x[8]; unpack8(raw[j], x);
              float sm = ((x[0] + x[1]) + (x[2] + x[3])) + ((x[4] + x[5]) + (x[6] + x[7])); const float mean = sum8(sm) * (1.f / 64.f);
              float q = 0.f;
#pragma unroll
              for (int i = 0; i < 8; ++i) { x[i] -= mean; q += x[i] * x[i]; }
              const float rstd = rsqrtf(sum8(q) * (1.f / 64.f) + EPS);
#pragma unroll
              for (int i = 0; i < 8; ++i) { const int cl = cg * 8 + i; vT[cl * 128 + sgu_swz(cl, jh + j) + rr] = (bf16)f2bf(x[i] * rstd * gg[i] + bb[i]); } }
      }
    }
    LDS_WAIT();
    const int fr = lane & 15, fq = lane >> 4;
    bf16x8 wf[8][4];
#pragma unroll
    for (int mt = 0; mt < 8; ++mt)
#pragma unroll
        for (int ks = 0; ks < 4; ++ks) if (ks * 32 <= mt * 16 + 15) wf[mt][ks] = *(const bf16x8*)(Wb + ((size_t)(h * 128 + mt * 16 + fr) * 128 + ks * 32 + fq * 8));
#pragma unroll
    for (int mt = 0; mt < 8; ++mt) {
        f32x4 acc[4];
#pragma unroll
        for (int nt = 0; nt < 4; ++nt) acc[nt] = (f32x4){0.f, 0.f, 0.f, 0.f};
        const int t = mt * 16 + fr;
        v2u uv[4];
#pragma unroll
        for (int nt = 0; nt < 4; ++nt) uv[nt] = *(const v2u*)(Z + (r0 + t) * ZP + 768 + h * 64 + nt * 16 + 4 * fq);
        const float bt = sb[h * 128 + t];
#pragma unroll
        for (int ks = 0; ks < 4; ++ks) if (ks * 32 <= mt * 16 + 15) {
#pragma unroll
            for (int nt = 0; nt < 4; ++nt) { const int cl = nt * 16 + fr; const bf16x8 vf = *(const LAS bf16x8*)(vT + cl * 128 + sgu_swz(cl, ks * 4 + fq));
                acc[nt] = __builtin_amdgcn_mfma_f32_16x16x32_bf16(vf, wf[mt][ks], acc[nt], 0, 0, 0); }
        }
#pragma unroll
        for (int nt = 0; nt < 4; ++nt) { const float u0 = __uint_as_float(uv[nt].x << 16), u1 = __uint_as_float(uv[nt].x & 0xffff0000u), u2 = __uint_as_float(uv[nt].y << 16), u3 = __uint_as_float(uv[nt].y & 0xffff0000u);
            v2u w; w.x = pg8::cvt_pk_bf16(u0 * (acc[nt][0] + bt), u1 * (acc[nt][1] + bt)); w.y = pg8::cvt_pk_bf16(u2 * (acc[nt][2] + bt), u3 * (acc[nt][3] + bt));
            *(v2u*)(CAT + (r0 + t) * DP + 512 + h * 64 + nt * 16 + 4 * fq) = w; }
    }
    LDS_WAIT();
}
__device__ __forceinline__ void sgu_sample_unit(const bf16* __restrict__ Z, bf16* __restrict__ CAT, const float* __restrict__ Wf, const float* __restrict__ lg, const float* __restrict__ lb,
                                                const float* __restrict__ sb, float* __restrict__ vout, int seq, int h, int lane) {
    const int c = h * 64 + lane; const size_t rowbase = (size_t)MP + (size_t)seq * ST;
    const float gg = lg[c], bb = lb[c];
    float vn[ST];
#pragma unroll
    for (int t = 0; t < ST; ++t) { const float v = bf2f(Z[(rowbase + t) * ZP + 1024 + c]); const float mean = wave_sum(v) * (1.f / 64.f); const float d = v - mean; const float var = wave_sum(d * d) * (1.f / 64.f);
        vn[t] = d * rsqrtf(var + EPS) * gg + bb; vout[((size_t)seq * ST + t) * GW + c] = vn[t]; }
#pragma unroll
    for (int t = 0; t < ST; ++t) { float sv = sb[h * 128 + t];
#pragma unroll
        for (int s = 0; s <= t; ++s) sv += Wf[((size_t)h * 128 + t) * 128 + s] * vn[s];
        const float u = bf2f(Z[(rowbase + t) * ZP + 768 + c]);
        CAT[(rowbase + t) * DP + 512 + c] = (bf16)f2bf(u * sv); }
}

#define XB_TMO      128
#define XB_XCNT(j)  (256  + 64 * (j))
#define XB_XSUB(j)  (1280 + 64 * (j))
#define XB_XGEN(j)  (2304 + 64 * (j))
#define XB_TOP      3328
#define XB_TOPGEN   3392
#define XCD_BAR_WORDS 3456
#define XB_SPIN_CAP (1u << 18)

__device__ __forceinline__ unsigned xb_ld(unsigned* p)              { return __hip_atomic_load(p, __ATOMIC_RELAXED, __HIP_MEMORY_SCOPE_AGENT); }
__device__ __forceinline__ unsigned xb_add(unsigned* p, unsigned v) { return __hip_atomic_fetch_add(p, v, __ATOMIC_RELAXED, __HIP_MEMORY_SCOPE_AGENT); }
__device__ __forceinline__ unsigned xb_xcc_id() { return (unsigned)__builtin_amdgcn_s_getreg((3 << 11) | 20) & 0xFu; }
#define XB_SPIN(cond, bar) do { unsigned _sp = 0; while (cond) { __builtin_amdgcn_s_sleep(1); \
    if ((++_sp & 255u) == 0u) { if (xb_ld(&(bar)[XB_TMO])) break; if (_sp > XB_SPIN_CAP) { atomicAdd(&(bar)[XB_TMO], 1u); break; } } } } while (0)

struct XcdBarrier {
    unsigned* bar; unsigned x;
    volatile LAS unsigned* st;
};

__device__ __forceinline__ XcdBarrier xcd_barrier_post(unsigned* bar, volatile LAS unsigned* st) {
    XcdBarrier b; b.bar = bar; b.x = xb_xcc_id(); b.st = st;
    if (threadIdx.x == 0) (void)xb_add(&bar[XB_XCNT(b.x)], 1u);
    return b;
}
__device__ __forceinline__ void xcd_barrier_complete(unsigned* bar, unsigned x, unsigned& nloc, unsigned& nx) {
    const unsigned G = gridDim.x * gridDim.y * gridDim.z;
    unsigned sum, cnt, mine, sp = 0u;
    for (;;) {
        sum = 0u; cnt = 0u; mine = 0u;
#pragma unroll
        for (unsigned j = 0; j < 16; ++j) { const unsigned c = xb_ld(&bar[XB_XCNT(j)]); sum += c; cnt += (c > 0u) ? 1u : 0u; mine = (j == x) ? c : mine; }
        if (sum == G) break;
        __builtin_amdgcn_s_sleep(1);
        if ((++sp & 255u) == 0u) { if (xb_ld(&bar[XB_TMO])) break; if (sp > XB_SPIN_CAP) { atomicAdd(&bar[XB_TMO], 1u); break; } }
    }
    nloc = mine > 0u ? mine : 1u; nx = cnt > 0u ? cnt : 1u;
}

__device__ __forceinline__ void xcd_barrier(const XcdBarrier& b) {
    asm volatile("s_waitcnt vmcnt(0)" ::: "memory");
    __syncthreads();
    if (threadIdx.x == 0) {
        unsigned* bar = b.bar;
        __builtin_amdgcn_s_waitcnt(0);
        unsigned nloc = b.st[0], nx = b.st[1];
        if (nloc == 0u) { xcd_barrier_complete(bar, b.x, nloc, nx); b.st[0] = nloc; b.st[1] = nx; }
        const unsigned old = xb_add(&bar[XB_XSUB(b.x)], 1u);
        const unsigned gen = old / nloc;
        if (old + 1u == (gen + 1u) * nloc) {
            __builtin_amdgcn_fence(__ATOMIC_RELEASE, "agent");
            asm volatile("s_waitcnt vmcnt(0)" ::: "memory");
            const unsigned og = xb_add(&bar[XB_TOP], 1u);
            const unsigned tg = og / nx;
            if (og + 1u == (tg + 1u) * nx) xb_add(&bar[XB_TOPGEN], 1u);
            else XB_SPIN(xb_ld(&bar[XB_TOPGEN]) == tg, bar);
            __builtin_amdgcn_fence(__ATOMIC_ACQUIRE, "agent");
            xb_add(&bar[XB_XGEN(b.x)], 1u);
            asm volatile("s_waitcnt vmcnt(0)" ::: "memory");
        } else {
            XB_SPIN(xb_ld(&bar[XB_XGEN(b.x)]) == gen, bar);
            __builtin_amdgcn_fence(__ATOMIC_ACQUIRE, "agent");
            asm volatile("s_waitcnt vmcnt(0)" ::: "memory");
        }
    }
    __syncthreads();
}

template <int NT, int ACT, int K>
__device__ __forceinline__ void small_gemm_tile(LAS unsigned char* lds, const bf16* __restrict__ A, const bf16* __restrict__ Bt, bf16* __restrict__ O, int ldc, int lda, int ldb, int m0, int n0, int tid) {
    constexpr int NC = 16 * NT, KW = K / 8, NCH = KW / 128;
    const int wave = __builtin_amdgcn_readfirstlane(tid >> 6), lane = tid & 63, fr = lane & 15, fq = lane >> 4;
    const bf16* ap = A + (size_t)(m0 + fr) * lda + wave * KW + fq * 8;
    const bf16* bp = Bt + (size_t)(n0 + fr) * ldb + wave * KW + fq * 8;
    f32x4 acc[4][NT];
#pragma unroll
    for (int m = 0; m < 4; ++m)
#pragma unroll
        for (int n = 0; n < NT; ++n) acc[m][n] = (f32x4){0.f, 0.f, 0.f, 0.f};
    if constexpr (NCH == 1) {
        bf16x8 fa[4][4], fb[4][NT];
#pragma unroll
        for (int s_ = 0; s_ < 4; ++s_) {
#pragma unroll
            for (int m = 0; m < 4; ++m) fa[s_][m] = *(const bf16x8*)(ap + (size_t)m * 16 * lda + s_ * 32);
#pragma unroll
            for (int n = 0; n < NT; ++n) fb[s_][n] = *(const bf16x8*)(bp + (size_t)n * 16 * ldb + s_ * 32); }
        __builtin_amdgcn_sched_barrier(0);
#pragma unroll
        for (int s_ = 0; s_ < 4; ++s_)
#pragma unroll
            for (int m = 0; m < 4; ++m)
#pragma unroll
                for (int n = 0; n < NT; ++n) acc[m][n] = __builtin_amdgcn_mfma_f32_16x16x32_bf16(fa[s_][m], fb[s_][n], acc[m][n], 0, 0, 0);
        __builtin_amdgcn_sched_barrier(0);
    } else {
        constexpr int NC2 = KW / 64;
        bf16x8 fa[3][2][4], fb[3][2][NT];
#define SG_LD(buf, c) do { _Pragma("unroll") for (int s_ = 0; s_ < 2; ++s_) { \
            _Pragma("unroll") for (int m = 0; m < 4; ++m) fa[buf][s_][m] = *(const bf16x8*)(ap + (size_t)m * 16 * lda + (c) * 64 + s_ * 32); \
            _Pragma("unroll") for (int n = 0; n < NT; ++n) fb[buf][s_][n] = *(const bf16x8*)(bp + (size_t)n * 16 * ldb + (c) * 64 + s_ * 32); } } while (0)
        SG_LD(0, 0); SG_LD(1, 1);
        __builtin_amdgcn_sched_barrier(0);
#pragma unroll
        for (int c = 0; c < NC2; ++c) {
            if (c + 2 < NC2) SG_LD((c + 2) % 3, c + 2);
            __builtin_amdgcn_sched_barrier(0);
#pragma unroll
            for (int s_ = 0; s_ < 2; ++s_)
#pragma unroll
                for (int m = 0; m < 4; ++m)
#pragma unroll
                    for (int n = 0; n < NT; ++n) acc[m][n] = __builtin_amdgcn_mfma_f32_16x16x32_bf16(fa[c % 3][s_][m], fb[c % 3][s_][n], acc[m][n], 0, 0, 0);
            __builtin_amdgcn_sched_barrier(0);
        }
#undef SG_LD
    }
    LAS float* P = (LAS float*)lds + wave * (64 * NC);
#pragma unroll
    for (int m = 0; m < 4; ++m)
#pragma unroll
        for (int n = 0; n < NT; ++n)
#pragma unroll
            for (int i = 0; i < 4; ++i) P[(m * 16 + fq * 4 + i) * NC + n * 16 + fr] = acc[m][n][i];
    __syncthreads();
    constexpr int EPT = 64 * NC / 512;
    const int e0 = tid * EPT, row = e0 / NC, col = e0 % NC;
    float r[EPT];
#pragma unroll
    for (int j = 0; j < EPT; ++j) r[j] = 0.f;
#pragma unroll
    for (int w = 0; w < 8; ++w) { const LAS f32x4* q = (const LAS f32x4*)((LAS float*)lds + w * (64 * NC) + e0);
#pragma unroll
        for (int j = 0; j < EPT / 4; ++j) { const f32x4 v = q[j]; r[4 * j] += v[0]; r[4 * j + 1] += v[1]; r[4 * j + 2] += v[2]; r[4 * j + 3] += v[3]; } }
    if (ACT == 1) {
#pragma unroll
        for (int j = 0; j < EPT; ++j) { const float t = fmaxf(r[j], 0.f); r[j] = t * t; } }
    bf16* op = O + (size_t)(m0 + row) * ldc + n0 + col;
    if (EPT == 8) { v4u w; w.x = pk2(r[0], r[1]); w.y = pk2(r[2], r[3]); w.z = pk2(r[4 % EPT], r[5 % EPT]); w.w = pk2(r[6 % EPT], r[7 % EPT]); *(v4u*)op = w; }
    else { v2u w; w.x = pk2(r[0], r[1]); w.y = pk2(r[2], r[3]); *(v2u*)op = w; }
    __syncthreads();
}

#define SMALL_TN(j, ntn) ((((j) >> 8) * 32 + ((j) & 7) * 4 + (((j) >> 3) & 3)))
constexpr int NPH = 15;
#ifndef REP_PRO
#define REP_PRO 1
#endif
#ifndef REP_GEMM
#define REP_GEMM 1
#endif
#ifndef REP_MIX
#define REP_MIX 1
#endif
#ifndef REP_SYNC
#define REP_SYNC 1
#endif
struct Args { const float* in[24]; float* out; unsigned char* ws; int ph_lo, ph_hi; };
__global__ void __launch_bounds__(NWAVES * 64, 2) hybrid_fwd(Args args) {
    extern __shared__ __attribute__((aligned(16))) unsigned char lds_raw[];
    LAS unsigned char* lds = (LAS unsigned char*)lds_raw;
    volatile LAS unsigned* MISC = (volatile LAS unsigned*)(lds + MISC_OFF);
    if (threadIdx.x < 64) MISC[threadIdx.x] = 0u;
    __syncthreads();
    (void)xcd_barrier_post((unsigned*)(args.ws + WS_CTL), MISC + 8);
    for (int ph = args.ph_lo; ph < args.ph_hi;) {
        int tid = threadIdx.x; asm volatile("" : "+v"(tid));
        const int lane = tid & 63, wave = __builtin_amdgcn_readfirstlane(tid >> 6);
        const int G = gridDim.x; const int bx = blockIdx.x;
        unsigned char* ws = args.ws;
        if (ph == 0) {
            const int vcu = (G % 8 == 0) ? (bx % 8) * (G / 8) + bx / 8 : bx; const int gw = vcu * NWAVES + wave, NGW = G * NWAVES;
            LAS float* scr = (LAS float*)(lds + wave * WAVE_SCR);
            bf16* XN = (bf16*)(ws + WS_XN); bf16* SGW = (bf16*)(ws + WS_SGUW);
            constexpr int I_FOLD = 4 * (DM / 32), I_OUT = (DM / 64) * (DM / 32) - I_FOLD, I_IN = (DM / 64) * (INW / 32), I_UP = (DM / 64) * (FF / 32), I_DN = (FF / 64) * (DM / 32);
            constexpr int I_LAYER = I_OUT + I_IN + I_UP + I_DN, I_ALL = DEPTH * I_LAYER;
            for (int it = gw; it < DEPTH * I_FOLD; it += NGW) { const int l = it / I_FOLD, r = it % I_FOLD;
                fold_item(args.in[10] + (size_t)l * DM * DM, (bf16*)(ws + WS_W + (size_t)l * W_LAYER + W_OUT), args.in[11] + (size_t)l * 4 * 64 * 64, args.in[12] + (size_t)l * GW, scr, r, lane); }
#define TR_DECODE(it_, d_) do { const int l_ = (it_) / I_LAYER; int r_ = (it_) % I_LAYER; unsigned char* wl_ = ws + WS_W + (size_t)l_ * W_LAYER; int nblk_; \
                if (r_ < I_OUT) { r_ += I_FOLD; d_.W = args.in[10] + (size_t)l_ * DM * DM; d_.WT = (bf16*)(wl_ + W_OUT); d_.gk = nullptr; d_.K = DM; d_.N = DM; } \
                else if ((r_ -= I_OUT) < I_IN) { d_.W = args.in[9] + (size_t)l_ * DM * INW; d_.WT = (bf16*)(wl_ + W_IN); d_.gk = args.in[5] + (size_t)l_ * DM; d_.K = DM; d_.N = INW; } \
                else if ((r_ -= I_IN) < I_UP) { d_.W = args.in[22] + (size_t)l_ * DM * FF; d_.WT = (bf16*)(wl_ + W_UP); d_.gk = args.in[7] + (size_t)l_ * DM; d_.K = DM; d_.N = FF; } \
                else { r_ -= I_UP; d_.W = args.in[23] + (size_t)l_ * FF * DM; d_.WT = (bf16*)(wl_ + W_DN); d_.gk = nullptr; d_.K = FF; d_.N = DM; } \
                nblk_ = d_.N / 32; d_.k0 = 64 * (r_ / nblk_); d_.n0 = 32 * (r_ % nblk_); } while (0)
            { int it = NGW - 1 - gw;
              if (it < I_ALL) {
                TrDesc dc; TR_DECODE(it, dc);
                float va[32], vb[32];
                tr_load(va, dc, lane);
#pragma unroll 1
                for (;;) {
                    const int itn = it + NGW; const bool more = itn < I_ALL;
                    TrDesc dn; { const int q = more ? itn : it; TR_DECODE(q, dn); }
                    tr_load(vb, dn, lane);
                    tr_store(va, dc, scr, lane);
                    if (!more) break;
#pragma unroll
                    for (int i = 0; i < 32; ++i) va[i] = vb[i];
                    dc = dn; it = itn;
                }
              }
            }
#undef TR_DECODE
            for (int m = gw; m < MT; m += NGW) rms_row_to_bf16(m < MP ? args.in[0] + (size_t)m * DM : args.in[1] + (size_t)(m - MP) * DM, XN + (size_t)m * DP, lane);
            for (int e = bx * (NWAVES * 64) + tid; e < DEPTH * 4 * 128 * 128; e += G * NWAVES * 64) { const int t = (e >> 7) & 127, s = e & 127; SGW[e] = (bf16)(s <= t ? f2bf(args.in[19][e]) : 0u); }
        } else {
            const int l = (ph - 1) / 7, k = (ph - 1) - 7 * l;
            unsigned char* wl = ws + WS_W + (size_t)l * W_LAYER;
            if (k == 0 || k == 2 || k == 5) {
                const bf16* A = (const bf16*)(ws + (k == 0 ? WS_XN : k == 2 ? WS_CAT : WS_H));
                const bf16* Bt = (const bf16*)(wl + (k == 0 ? W_IN : k == 2 ? W_OUT : W_DN));
                bf16* O = (bf16*)(ws + (k == 0 ? WS_Z : WS_O));
                const int N = k == 0 ? INW : DM, K = k == 5 ? FF : DM;
                pg8::Gemm g{A, Bt, MP, N, K, k == 5 ? FP : DP, K + WPAD}; pg8::StaticOrder S; S.init(MP, N, G, bx);
                pg8::EpiBf16<0> E{O, k == 0 ? ZP : OP};
                pg8::gemm_phase<pg8::EpiBf16<0>, pg8::StaticOrder, true, true>(lds, g, S, E, tid);
                if (k == 0) { for (int j = bx; j < (MS / 64) * (INW / 64); j += G) small_gemm_tile<4, 0, DM>(lds, A, Bt, O, ZP, DP, DM + WPAD, MP + ((j >> 5) & 7) * 64, SMALL_TN(j, INW / 64) * 64, tid); }
                else { for (int j = bx; j < (MS / 64) * (DM / 32); j += G) { if (k == 2) small_gemm_tile<2, 0, DM>(lds, A, Bt, O, OP, DP, DM + WPAD, MP + ((j >> 5) & 7) * 64, SMALL_TN(j, DM / 32) * 32, tid); else small_gemm_tile<2, 0, FF>(lds, A, Bt, O, OP, FP, FF + WPAD, MP + ((j >> 5) & 7) * 64, SMALL_TN(j, DM / 32) * 32, tid); } }
            } else if (k == 4) {
                pg8::Gemm g{(const bf16*)(ws + WS_XN), (const bf16*)(wl + W_UP), MP, FF, DM, DP, DM + WPAD}; pg8::StaticOrder S; S.init(MP, FF, G, bx);
                pg8::EpiBf16<1> E{(bf16*)(ws + WS_H), FP};
                pg8::gemm_phase<pg8::EpiBf16<1>, pg8::StaticOrder, true, true>(lds, g, S, E, tid);
                for (int j = bx; j < (MS / 64) * (FF / 64); j += G) small_gemm_tile<4, 1, DM>(lds, (const bf16*)(ws + WS_XN), (const bf16*)(wl + W_UP), (bf16*)(ws + WS_H), FP, DP, DM + WPAD, MP + ((j >> 5) & 7) * 64, SMALL_TN(j, FF / 64) * 64, tid);
            } else if (k == 1) {
                const int vcu = (G % 8 == 0) ? (bx % 8) * (G / 8) + bx / 8 : bx; const int gw = vcu * NWAVES + wave, NGW = G * NWAVES;
                LAS float* scr = (LAS float*)(lds + wave * WAVE_SCR);
                const bf16* ZB = (const bf16*)(ws + WS_Z); bf16* CAT = (bf16*)(ws + WS_CAT); const bf16* SGW = (const bf16*)(ws + WS_SGUW) + (size_t)l * 4 * 128 * 128;
                float* out = args.out;
                constexpr int NU_SGU = 512, NU_CONV = 2048, NU_SEG = 1024, NU_SMP = 2048, NU = NU_SGU + NU_CONV + 2 * NU_SEG + NU_SMP;
#pragma unroll 1
                for (int ui = 0; ; ++ui) {
                    int u;
                    if (NGW != 2048) { u = ui * NGW + gw; if (u >= NU) break; }
                    else { if (ui >= 4) break;
                        if (gw < 512) { if (ui == 0) u = gw; else if (ui == 1) u = NU_SGU + 1536 + gw; else break; }
                        else { const int g5 = gw - 512; if (ui == 0) u = NU_SGU + g5; else { const int sidx = (ui - 1) * 1536 + g5; if (sidx >= 2 * NU_SEG + NU_SMP) break; u = NU_SGU + NU_CONV + sidx; } } }
                    int lane = tid & 63; asm volatile("" : "+v"(lane));
                    if (u < NU_SGU) { sgu_unit(ZB, CAT, SGW, args.in[17] + (size_t)l * GW, args.in[18] + (size_t)l * GW, args.in[20] + (size_t)l * 4 * 128, u >> 2, u & 3, (LAS bf16*)scr, lane); continue; }
                    int r = u - NU_SGU;
                    if (r < NU_CONV) { const int seg = r >> 2, h = r & 3, seq = seg >> 6, t0 = (seg & 63) * 32;
                        conv_unit_p(ZB, CAT, out + OUT_CONV_P + (size_t)l * NBP * 30 * GW, args.in[13] + (size_t)l * 31 * GW, args.in[14] + (size_t)l * GW, args.in[15] + (size_t)l * GW, args.in[16] + (size_t)l * GW, seq, t0, h, scr, lane);
                        continue; }
                    r -= NU_CONV;
                    if (r < 2 * NU_SEG) { const int ty = r / NU_SEG, q = r % NU_SEG, seg = q >> 2, h = q & 3, seq = seg >> 5, t0 = (seg & 31) * 64;
                        if (ty == 0) { float* np = out + OUT_POOL_P + (size_t)l * NBP * 15 * GW;
                            if (h == 0) pool_unit_p<2>(ZB, CAT, np, seq, t0, h, lane); else if (h == 1) pool_unit_p<4>(ZB, CAT, np, seq, t0, h, lane);
                            else if (h == 2) pool_unit_p<8>(ZB, CAT, np, seq, t0, h, lane); else pool_unit_p<16>(ZB, CAT, np, seq, t0, h, lane); }
                        else short_unit_p(ZB, CAT, out + OUT_SHORT_P + (size_t)l * NBP * 2 * GW, args.in[21] + (size_t)l * 3 * GW, seq, t0, h, lane);
                        continue; }
                    r -= 2 * NU_SEG;
                    { const int ty = r >> 9, q = r & 511, seq = q >> 2, h = q & 3;
                        if (ty == 0) conv_unit<true>(ZB, CAT, args.in[3] + (size_t)l * NSB * 30 * GW, out + OUT_CONV_S + (size_t)l * NSB * 30 * GW, args.in[13] + (size_t)l * 31 * GW, args.in[14] + (size_t)l * GW, args.in[15] + (size_t)l * GW, args.in[16] + (size_t)l * GW, seq, 0, ST, h, scr, lane);
                        else if (ty == 1) pool_unit<true>(ZB, CAT, args.in[2] + (size_t)l * NSB * 15 * GW, out + OUT_POOL_S + (size_t)l * NSB * 15 * GW, seq, 0, ST, h, lane);
                        else if (ty == 2) short_unit<true>(ZB, CAT, args.in[4] + (size_t)l * NSB * 2 * GW, out + OUT_SHORT_S + (size_t)l * NSB * 2 * GW, args.in[21] + (size_t)l * 3 * GW, seq, 0, ST, h, lane);
                        else sgu_sample_unit(ZB, CAT, args.in[19] + (size_t)l * 4 * 128 * 128, args.in[17] + (size_t)l * GW, args.in[18] + (size_t)l * GW, args.in[20] + (size_t)l * 4 * 128, out + OUT_V_S + (size_t)l * NSB * ST * GW, seq, h, lane); }
                }
            } else {
                const int vcu = (G % 8 == 0) ? (bx % 8) * (G / 8) + bx / 8 : bx; const int gw = vcu * NWAVES + wave, NGW = G * NWAVES;
                const float* g = args.in[k == 3 ? 6 : 8] + (size_t)l * DM;
                float* X = args.out; const bf16* OB = (const bf16*)(ws + WS_O); bf16* XN = (bf16*)(ws + WS_XN);
                const bool from_input = (l == 0 && k == 3), write_xn = !(l == DEPTH - 1 && k == 6);
                f32x4 gg[4];
#pragma unroll
                for (int j = 0; j < 4; ++j) gg[j] = ((const f32x4*)g + lane)[64 * j];
                const int m_lo = 0;
#define EW_X32(m) ((m) < MP ? args.in[0] + (size_t)(m) * DM : args.in[1] + (size_t)((m) - MP) * DM)
                bf16* X16 = (bf16*)args.out;
                const bool dst16 = write_xn;
#pragma unroll 1
                for (int m = m_lo + gw; m < MT; m += 2 * NGW) {
                    const int m2 = m + NGW; const bool two = m2 < MT;
                    EwRow ra, rb;
                    ew_load(ra, EW_X32(m), X16 + (size_t)m * 2 * DM, !from_input, OB + (size_t)m * OP, lane);
                    { const int mc = two ? m2 : m; ew_load(rb, EW_X32(mc), X16 + (size_t)mc * 2 * DM, !from_input, OB + (size_t)mc * OP, lane); }
                    ew_finish(ra, gg, X + (size_t)m * DM, X16 + (size_t)m * 2 * DM, dst16, XN + (size_t)m * DP, write_xn, lane);
                    if (two) ew_finish(rb, gg, X + (size_t)m2 * DM, X16 + (size_t)m2 * 2 * DM, dst16, XN + (size_t)m2 * DP, write_xn, lane);
                }
#undef EW_X32
            }
        }
        ++ph;
        if (ph < args.ph_hi) {
            if (args.ph_lo < 0) cg::this_grid().sync();
            else { XcdBarrier b; b.bar = (unsigned*)(args.ws + WS_CTL); b.x = xb_xcc_id(); b.st = (volatile LAS unsigned*)(lds + MISC_OFF) + 8; xcd_barrier(b); }
        }
    }
}

#ifndef MK_N_LAUNCHES
#define MK_N_LAUNCHES 1
#endif
extern "C" void kernel_launch(void* const* d_in, const int* in_sizes, int n_in, void* d_out, int out_size, void* d_ws, size_t ws_size, hipStream_t stream) {
    static int grid = 0;
    if (grid == 0) {
        if (n_in != 24 || (size_t)out_size != OUT_END || ws_size < WS_END) { fprintf(stderr, "kernel_launch: unexpected shapes (n_in %d out %d ws %zu)\n", n_in, out_size, ws_size); grid = -1; return; }
        int dev = 0, cus = 0, per_cu = 0;
        if (hipGetDevice(&dev) != hipSuccess || hipDeviceGetAttribute(&cus, hipDeviceAttributeMultiprocessorCount, dev) != hipSuccess) { grid = -1; return; }
        if (hipFuncSetAttribute((const void*)hybrid_fwd, hipFuncAttributeMaxDynamicSharedMemorySize, LDS_BYTES) != hipSuccess) { fprintf(stderr, "kernel_launch: hipFuncSetAttribute failed\n"); grid = -1; return; }
        if (hipOccupancyMaxActiveBlocksPerMultiprocessor(&per_cu, (const void*)hybrid_fwd, NWAVES * 64, LDS_BYTES) != hipSuccess || per_cu < 1) per_cu = 1;
        (void)hipGetLastError();
        grid = cus * per_cu;
    }
    if (grid < 0) return;
    if (hipMemsetAsync((char*)d_ws + WS_CTL, 0, CTL_ZERO_BYTES, stream) != hipSuccess) { fprintf(stderr, "kernel_launch: hipMemsetAsync failed\n"); return; }
    Args a{};
    for (int i = 0; i < 24; ++i) a.in[i] = (const float*)d_in[i];
    a.out = (float*)d_out; a.ws = (unsigned char*)d_ws;
#if MK_N_LAUNCHES == 1
    a.ph_lo = 0; a.ph_hi = NPH;
    void* kargs[] = {&a};
    hipError_t e = hipLaunchCooperativeKernel((const void*)hybrid_fwd, dim3(grid), dim3(NWAVES * 64), kargs, LDS_BYTES, stream);
    if (e != hipSuccess) fprintf(stderr, "cooperative launch failed: %s (grid %d)\n", hipGetErrorString(e), grid);
#else
    for (int p = 0; p < NPH; ++p) { a.ph_lo = p; a.ph_hi = p + 1; hipLaunchKernelGGL(hybrid_fwd, dim3(grid), dim3(NWAVES * 64), LDS_BYTES, stream, a); }
#endif
}
```

```cpp
#include <hip/hip_runtime.h>
#include <hip/hip_cooperative_groups.h>
#include <cstdio>
#include <cstdint>
namespace pg8 {
#define PG8_LAS __attribute__((address_space(3)))
typedef unsigned short bf16_t;
typedef short bf16x8 __attribute__((ext_vector_type(8)));
typedef float f32x4 __attribute__((ext_vector_type(4)));
typedef unsigned u32x4 __attribute__((ext_vector_type(4)));
constexpr int KPAD = 64;
constexpr int BM = 256, BK = 64, HALF = 128, HTB = HALF * BK * 2  , STAGE_BYTES = 8 * HTB, NXCD = 8, WGM = 8;

__host__ __device__ __forceinline__ int lds_byte(int r, int c) { const int st = (r >> 4) * 2 + (c >> 5), rr = r & 15, cc = c & 31, ob = rr * 64 + cc * 2; return st * 1024 + (ob ^ (((ob >> 9) & 1) << 5)); }
__host__ __device__ __forceinline__ void stage_rc(int b, int& R, int& C) { const int st = b / 1024, sb = b % 1024, swz = sb ^ (((sb >> 9) & 1) << 5); R = (st >> 1) * 16 + swz / 64; C = (st & 1) * 32 + (swz % 64) / 2; }
__host__ __device__ __forceinline__ int perm32(int rho) { const int n = rho >> 4, i = rho & 15; return 8 * (i >> 2) + 4 * n + (i & 3); }

struct Unit { int pm, pn; };
struct Gemm { const bf16_t* A; const bf16_t* Bt; int M, N, K, lda, ldb; };

struct StaticOrder {
    int nM, nN, nwg, G, c;
    __host__ __device__ void init(int M, int N, int G_, int c_) { nM = M / BM; nN = N / BM; nwg = nM * nN; G = G_; c = c_; }
    __host__ __device__ bool next(int i, Unit& u) const {
        const long L = (long)i * G + c; if (L >= nwg) return false;
        int wgid = (int)L; { const int q = nwg / NXCD, r = nwg % NXCD, xcd = wgid % NXCD, off = wgid / NXCD; wgid = (xcd < r ? xcd * (q + 1) : r * (q + 1) + (xcd - r) * q) + off; }
        const int nig = WGM * nN, gid = wgid / nig, fm = gid * WGM, gsz = (nM - fm) < WGM ? (nM - fm) : WGM;
        u.pm = fm + ((wgid % nig) % gsz); u.pn = (wgid % nig) / gsz; return true;
    }
    __device__ __forceinline__ void a_ready(const Unit&) const {}
    __device__ __forceinline__ void done(const Unit&) const {}
};

__device__ __forceinline__ unsigned cvt_pk_bf16(float lo, float hi) { unsigned r; asm volatile("v_cvt_pk_bf16_f32 %0, %1, %2" : "=v"(r) : "v"(lo), "v"(hi)); return r; }
__device__ __forceinline__ float relu_sq(float x) { float r; asm volatile("v_max_f32 %0, 0, %1" : "=v"(r) : "v"(x)); return r * r; }
__device__ __forceinline__ void st16_wt(void* p, u32x4 v) { asm volatile("global_store_dwordx4 %0, %1, off sc1" :: "v"(p), "v"(v) : "memory"); }
template <int ACT  > struct EpiBf16 {
    static constexpr bool PERM = true, AFTER_DRAIN = false;
    bf16_t* O; int ldc; const float* rs;
    __device__ __forceinline__ void operator()(const f32x4 (&acc)[2][2][4][2], const Unit& u, int wr, int wc, int fr, int fq) const {
        const int row0 = u.pm * BM + wr * 64 + fr; const int col0 = u.pn * BM + wc * 32 + 8 * fq;
#pragma unroll
        for (int ai = 0; ai < 2; ++ai)
#pragma unroll
            for (int m = 0; m < 4; ++m) { bf16_t* rowp = O + (size_t)(row0 + ai * HALF + m * 16) * ldc + col0; const float sc = rs ? rs[row0 + ai * HALF + m * 16] : 1.f;
#pragma unroll
                for (int bj = 0; bj < 2; ++bj) { f32x4 v0 = acc[ai][bj][m][0] * sc, v1 = acc[ai][bj][m][1] * sc;
                    if (ACT == 1) {
#pragma unroll
                        for (int e = 0; e < 4; ++e) { v0[e] = relu_sq(v0[e]); v1[e] = relu_sq(v1[e]); } }
                    u32x4 w; w.x = cvt_pk_bf16(v0[0], v0[1]); w.y = cvt_pk_bf16(v0[2], v0[3]); w.z = cvt_pk_bf16(v1[0], v1[1]); w.w = cvt_pk_bf16(v1[2], v1[3]);
                    *(u32x4*)(rowp + bj * HALF) = w; } }
    }
};

template <class Epi, class Sched, bool ALIGN_EPI = false, bool SP2 = false>
__device__ __forceinline__ void gemm_phase(PG8_LAS unsigned char* lds, const Gemm g, const Sched& S, const Epi& E, const int tid) {
    const int wid = __builtin_amdgcn_readfirstlane(tid >> 6), lane = tid & 63, wr = wid >> 2, wc = wid & 3, fr = lane & 15, fq = lane >> 4;
    const int K = g.K, nt = K / BK;
    unsigned voffA[2], voffB[2];
#pragma unroll
    for (int i = 0; i < 2; ++i) { int R, C; stage_rc(tid * 16 + i * 8192, R, C); const int Rb = Epi::PERM ? ((R & ~31) + perm32(R & 31)) : R;
        voffA[i] = (unsigned)(R * g.lda + C) * 2u; voffB[i] = (unsigned)(Rb * g.ldb + C) * 2u; }
    const size_t kstep = (size_t)(BK * 2);
    const size_t hstepA = (size_t)HALF * g.lda * 2, hstepB = (size_t)HALF * g.ldb * 2;
    const size_t tstepA = 2 * hstepA, tstepB = 2 * hstepB;
    const unsigned ldsw = (unsigned)wid * 1024u;
    const int aoff = lds_byte(wr * 64 + fr, fq * 8), boff = lds_byte(wc * 32 + fr, fq * 8);
#define PG8_SA(b, h) (((b) * 2 + (h)) * HTB)
#define PG8_SB(b, h) ((4 + (b) * 2 + (h)) * HTB)
#define PG8_STAGE(bufoff, gbase, voff) do { _Pragma("unroll") for (int _i = 0; _i < 2; ++_i) \
        __builtin_amdgcn_global_load_lds((const unsigned*)((const char*)(gbase) + (voff)[_i]), (PG8_LAS unsigned*)(lds + (bufoff) + ldsw + _i * 8192), 16, 0, 0); } while (0)
#define PG8_LDA(dst, b, h) do { _Pragma("unroll") for (int m = 0; m < 4; ++m) _Pragma("unroll") for (int k = 0; k < 2; ++k) dst[m][k] = *(const PG8_LAS bf16x8*)(lds + PG8_SA(b, h) + aoff + m * 2048 + k * 1024); } while (0)
#define PG8_LDB(dst, b, h) do { _Pragma("unroll") for (int n = 0; n < 2; ++n) _Pragma("unroll") for (int k = 0; k < 2; ++k) dst[n][k] = *(const PG8_LAS bf16x8*)(lds + PG8_SB(b, h) + boff + n * 2048 + k * 1024); } while (0)
#define PG8_MMA(ai, bj, At, Bt) do { __builtin_amdgcn_s_setprio(1); _Pragma("unroll") for (int m = 0; m < 4; ++m) _Pragma("unroll") for (int n = 0; n < 2; ++n) _Pragma("unroll") for (int k = 0; k < 2; ++k) \
        acc[ai][bj][m][n] = __builtin_amdgcn_mfma_f32_16x16x32_bf16(Bt[n][k], At[m][k], acc[ai][bj][m][n], 0, 0, 0); __builtin_amdgcn_s_setprio(0); } while (0)
#define PG8_WAIT_V(n) asm volatile("s_waitcnt vmcnt(" #n ")" ::: "memory")
#define PG8_WAIT_L(n) asm volatile("s_waitcnt lgkmcnt(" #n ")" ::: "memory")
#define PG8_BAR __builtin_amdgcn_s_barrier()
#define PG8_SCHED __builtin_amdgcn_sched_barrier(0)
    Unit cur, nxt; int ui = 0;
    if (!S.next(0, cur)) return;
    f32x4 acc[2][2][4][2];
#pragma unroll
    for (int a = 0; a < 2; ++a)
#pragma unroll
        for (int b = 0; b < 2; ++b)
#pragma unroll
            for (int m = 0; m < 4; ++m)
#pragma unroll
                for (int n = 0; n < 2; ++n) acc[a][b][m][n] = (f32x4){0.f, 0.f, 0.f, 0.f};
    bf16x8 At[4][2], B0[2][2], B1[2][2];
    const char* cA = (const char*)g.A + (size_t)cur.pm * tstepA; const char* cB = (const char*)g.Bt + (size_t)cur.pn * tstepB;
    S.a_ready(cur);
    if constexpr (SP2) {
        PG8_STAGE(PG8_SB(0, 0), cB, voffB); PG8_STAGE(PG8_SB(0, 1), cB + hstepB, voffB); PG8_STAGE(PG8_SA(0, 0), cA, voffA); PG8_STAGE(PG8_SA(0, 1), cA + hstepA, voffA);
        if (wr == 1) PG8_BAR;
        PG8_WAIT_V(2); PG8_BAR;
        PG8_STAGE(PG8_SB(1, 0), cB + kstep, voffB); PG8_STAGE(PG8_SA(1, 0), cA + kstep, voffA); PG8_STAGE(PG8_SB(1, 1), cB + hstepB + kstep, voffB);
        PG8_WAIT_V(6); PG8_BAR;
    } else {
        PG8_STAGE(PG8_SB(0, 0), cB, voffB); PG8_STAGE(PG8_SA(0, 0), cA, voffA); PG8_STAGE(PG8_SB(0, 1), cB + hstepB, voffB); PG8_STAGE(PG8_SA(0, 1), cA + hstepA, voffA);
        if (wr == 1) PG8_BAR;
        PG8_WAIT_V(4); PG8_BAR;
        PG8_STAGE(PG8_SB(1, 0), cB + kstep, voffB); PG8_STAGE(PG8_SA(1, 0), cA + kstep, voffA); PG8_STAGE(PG8_SB(1, 1), cB + hstepB + kstep, voffB);
        PG8_WAIT_V(6); PG8_BAR;
    }
    for (;;) {
        const bool has_next = S.next(ui + 1, nxt);
        const char* nA = has_next ? (const char*)g.A + (size_t)nxt.pm * tstepA : cA; const char* nB = has_next ? (const char*)g.Bt + (size_t)nxt.pn * tstepB : cB;
        for (int t = 0; t < nt; t += 2) {
            const bool last = (t == nt - 2);
            const char* a1 = cA + (size_t)(t + 1) * kstep;
            const char* a2 = last ? nA : cA + (size_t)(t + 2) * kstep; const char* b2 = last ? nB : cB + (size_t)(t + 2) * kstep;
            const char* a3 = a2 + kstep; const char* b3 = b2 + kstep;
            if (last && has_next) S.a_ready(nxt);
            if constexpr (SP2) {
            PG8_LDB(B0, 0, 0); PG8_LDB(B1, 0, 1); PG8_SCHED; PG8_LDA(At, 0, 0); PG8_STAGE(PG8_SA(1, 1), a1 + hstepA, voffA);
            PG8_WAIT_V(8); PG8_WAIT_L(0); PG8_BAR; PG8_MMA(0, 0, At, B0); PG8_MMA(0, 1, At, B1); PG8_BAR; PG8_SCHED;
            PG8_LDA(At, 0, 1); PG8_STAGE(PG8_SB(0, 0), b2, voffB); PG8_STAGE(PG8_SB(0, 1), b2 + hstepB, voffB); PG8_STAGE(PG8_SA(0, 0), a2, voffA);
            PG8_WAIT_V(8); PG8_WAIT_L(0); PG8_BAR; PG8_MMA(1, 0, At, B0); PG8_MMA(1, 1, At, B1); PG8_BAR; PG8_SCHED;
            PG8_LDB(B0, 1, 0); PG8_LDB(B1, 1, 1); PG8_SCHED; PG8_LDA(At, 1, 0); PG8_STAGE(PG8_SA(0, 1), a2 + hstepA, voffA);
            PG8_WAIT_V(8); PG8_WAIT_L(0); PG8_BAR; PG8_MMA(0, 0, At, B0); PG8_MMA(0, 1, At, B1); PG8_BAR; PG8_SCHED;
            PG8_LDA(At, 1, 1); PG8_STAGE(PG8_SB(1, 0), b3, voffB); PG8_STAGE(PG8_SB(1, 1), b3 + hstepB, voffB); PG8_STAGE(PG8_SA(1, 0), a3, voffA);
            PG8_WAIT_V(8); PG8_WAIT_L(0); PG8_BAR; PG8_MMA(1, 0, At, B0); PG8_MMA(1, 1, At, B1); PG8_BAR; PG8_SCHED;
            } else {
            PG8_LDB(B0, 0, 0); PG8_SCHED; PG8_LDA(At, 0, 0); PG8_STAGE(PG8_SA(1, 1), a1 + hstepA, voffA);
            PG8_WAIT_L(8); PG8_BAR; PG8_WAIT_L(0); PG8_MMA(0, 0, At, B0); PG8_BAR; PG8_SCHED;
            PG8_LDB(B1, 0, 1); PG8_STAGE(PG8_SB(0, 0), b2, voffB);
            PG8_BAR; PG8_WAIT_L(0); PG8_MMA(0, 1, At, B1); PG8_BAR;
            PG8_LDA(At, 0, 1); PG8_STAGE(PG8_SA(0, 0), a2, voffA);
            PG8_BAR; PG8_WAIT_L(0); PG8_MMA(1, 0, At, B0); PG8_BAR; PG8_SCHED;
            PG8_STAGE(PG8_SB(0, 1), b2 + hstepB, voffB);
            PG8_WAIT_V(6); PG8_BAR; PG8_MMA(1, 1, At, B1); PG8_BAR;
            PG8_LDB(B0, 1, 0); PG8_SCHED; PG8_LDA(At, 1, 0); PG8_STAGE(PG8_SA(0, 1), a2 + hstepA, voffA);
            PG8_WAIT_L(8); PG8_BAR; PG8_WAIT_L(0); PG8_MMA(0, 0, At, B0); PG8_BAR; PG8_SCHED;
            PG8_LDB(B1, 1, 1); PG8_STAGE(PG8_SB(1, 0), b3, voffB);
            PG8_BAR; PG8_WAIT_L(0); PG8_MMA(0, 1, At, B1); PG8_BAR;
            PG8_LDA(At, 1, 1); PG8_STAGE(PG8_SA(1, 0), a3, voffA);
            PG8_BAR; PG8_WAIT_L(0); PG8_MMA(1, 0, At, B0); PG8_BAR; PG8_SCHED;
            PG8_STAGE(PG8_SB(1, 1), b3 + hstepB, voffB);
            PG8_WAIT_V(6); PG8_BAR; PG8_MMA(1, 1, At, B1); PG8_BAR;
            }
        }
        if constexpr (ALIGN_EPI) { if (wr == 0) PG8_BAR; }
        if constexpr (!Epi::AFTER_DRAIN) { E(acc, cur, wr, wc, fr, fq); S.done(cur); }
        if (!has_next) break;
#pragma unroll
        for (int a = 0; a < 2; ++a)
#pragma unroll
            for (int b = 0; b < 2; ++b)
#pragma unroll
                for (int m = 0; m < 4; ++m)
#pragma unroll
                    for (int n = 0; n < 2; ++n) acc[a][b][m][n] = (f32x4){0.f, 0.f, 0.f, 0.f};
        cur = nxt; cA = nA; cB = nB; ++ui;
        if constexpr (ALIGN_EPI) { if (wr == 1) PG8_BAR; }
    }
    PG8_WAIT_V(0);
    if constexpr (!ALIGN_EPI) { if (wr == 0) PG8_BAR; }
    PG8_BAR;
    if constexpr (Epi::AFTER_DRAIN) { E.fused(acc, cur, wr, wc, fr, fq, lds, wid, lane); S.done(cur); }
#undef PG8_SA
#undef PG8_SB
#undef PG8_STAGE
#undef PG8_LDA
#undef PG8_LDB
#undef PG8_MMA
#undef PG8_WAIT_V
#undef PG8_WAIT_L
#undef PG8_BAR
#undef PG8_SCHED
}
}

namespace cg = cooperative_groups;
#define LAS __attribute__((address_space(3)))
typedef unsigned short bf16;
typedef unsigned v4u __attribute__((ext_vector_type(4)));
typedef unsigned v2u __attribute__((ext_vector_type(2)));
typedef float f32x4 __attribute__((ext_vector_type(4)));
typedef short bf16x8 __attribute__((ext_vector_type(8)));

constexpr int NWAVES = 8;
constexpr int DM = 1024, FF = 4096, INW = 2048, GW = 256;
constexpr int ZP = INW + 64;
#ifndef HPAD
#define HPAD 0
#endif
#ifndef WPAD
#define WPAD 0
#endif
#ifndef APAD
#define APAD 0
#endif
constexpr int DP = DM + APAD;
#ifndef OPAD
#define OPAD 0
#endif
constexpr int OP = DM + OPAD;
constexpr int FP = FF + HPAD;
constexpr int MP = 16384, MS = 512, MT = MP + MS;
constexpr int SEQ = 2048, NBP = 8, NSB = 128, ST = 4, DEPTH = 2;
constexpr float EPS = 1e-6f;
constexpr size_t MiB = 1u << 20;
constexpr size_t WS_SGUW = 1 * MiB;
constexpr size_t WS_W = 2 * MiB, W_LAYER = 24 * MiB, W_IN = 0, W_OUT = 9 * MiB / 2, W_UP = 7 * MiB, W_DN = 31 * MiB / 2;
constexpr size_t WS_XN = 50 * MiB, WS_O = 84 * MiB, WS_H = 120 * MiB, WS_Z = 120 * MiB, WS_CAT = 189 * MiB, WS_RS = 254 * MiB  , WS_END = 255 * MiB;
static_assert(WS_Z + (size_t)16896 * ZP * 2 <= WS_CAT && WS_XN + (size_t)16896 * DP * 2 <= WS_O && WS_CAT + (size_t)16896 * DP * 2 <= WS_H + (size_t)16896 * FP * 2 && WS_H + (size_t)16896 * FP * 2 <= WS_END, "d_ws map");
constexpr int LDS_BYTES = 147456;
constexpr int MISC_OFF = LDS_BYTES - 256;
constexpr size_t WS_CTL = 0, CTL_ZERO_BYTES = 128 * 1024;
constexpr int WAVE_SCR = 17408;
constexpr size_t OUT_Y = 0;
constexpr size_t OUT_POOL_P = (size_t)MT * DM;
constexpr size_t OUT_POOL_S = OUT_POOL_P + (size_t)DEPTH * NBP * 15 * GW;
constexpr size_t OUT_CONV_P = OUT_POOL_S + (size_t)DEPTH * NSB * 15 * GW;
constexpr size_t OUT_CONV_S = OUT_CONV_P + (size_t)DEPTH * NBP * 30 * GW;
constexpr size_t OUT_SHORT_P = OUT_CONV_S + (size_t)DEPTH * NSB * 30 * GW;
constexpr size_t OUT_SHORT_S = OUT_SHORT_P + (size_t)DEPTH * NBP * 2 * GW;
constexpr size_t OUT_V_S = OUT_SHORT_S + (size_t)DEPTH * NSB * 2 * GW;
constexpr size_t OUT_END = OUT_V_S + (size_t)DEPTH * NSB * ST * GW;

__device__ __forceinline__ float bf2f(bf16 b) { return __uint_as_float(((unsigned)b) << 16); }
__device__ __forceinline__ unsigned f2bf(float f) { unsigned u = __float_as_uint(f); return (u + 0x7fffu + ((u >> 16) & 1u)) >> 16; }
__device__ __forceinline__ unsigned pk2(float lo, float hi) { return f2bf(lo) | (f2bf(hi) << 16); }
template <int CTRL, int ROWMASK> __device__ __forceinline__ float dpp_get(float v) { return __int_as_float(__builtin_amdgcn_update_dpp(0, __float_as_int(v), CTRL, ROWMASK, 0xF, false)); }
__device__ __forceinline__ float sum8(float v) { v += dpp_get<0xB1, 0xF>(v); v += dpp_get<0x4E, 0xF>(v); v += dpp_get<0x141, 0xF>(v); return v; }
__device__ __forceinline__ float wave_sum(float v) {
    v = sum8(v); v += dpp_get<0x140, 0xF>(v); v += dpp_get<0x142, 0xA>(v); v += dpp_get<0x143, 0xC>(v);
    return __int_as_float(__builtin_amdgcn_readlane(__float_as_int(v), 63));
}
__device__ __forceinline__ void unpack8(const v4u w, float (&f)[8]) {
    f[0] = __uint_as_float(w.x << 16); f[1] = __uint_as_float(w.x & 0xffff0000u); f[2] = __uint_as_float(w.y << 16); f[3] = __uint_as_float(w.y & 0xffff0000u);
    f[4] = __uint_as_float(w.z << 16); f[5] = __uint_as_float(w.z & 0xffff0000u); f[6] = __uint_as_float(w.w << 16); f[7] = __uint_as_float(w.w & 0xffff0000u); }
__device__ __forceinline__ v4u pack8(const float (&f)[8]) { v4u w; w.x = pg8::cvt_pk_bf16(f[0], f[1]); w.y = pg8::cvt_pk_bf16(f[2], f[3]); w.z = pg8::cvt_pk_bf16(f[4], f[5]); w.w = pg8::cvt_pk_bf16(f[6], f[7]); return w; }
__device__ __forceinline__ v4u ld16(const bf16* p) { return *(const v4u*)p; }
__device__ __forceinline__ float sigm(float x) { return __builtin_amdgcn_rcpf(1.f + __builtin_amdgcn_exp2f(-1.44269504f * x)); }
#define LDS_WAIT() asm volatile("s_waitcnt lgkmcnt(0)" ::: "memory")

__device__ __forceinline__ void transpose_item(const float* __restrict__ W, int K, int N, bf16* __restrict__ WT, const float* __restrict__ gk, LAS float* scr, int item, int lane) {
    const int nblk = N / 32, kb = item / nblk, nb = item % nblk, k0 = 64 * kb, n0 = 32 * nb;
#pragma unroll 8
    for (int i = 0; i < 32; ++i) { const int kk = 2 * i + (lane >> 5); float v = W[(size_t)(k0 + kk) * N + n0 + (lane & 31)]; if (gk) v *= gk[k0 + kk]; scr[kk * 33 + (lane & 31)] = v; }
    LDS_WAIT();
    const int c = lane & 7;
#pragma unroll
    for (int j = 0; j < 4; ++j) { const int n = (lane >> 3) + 8 * j; const LAS float* s = scr + (8 * c) * 33 + n;
        v4u o; o.x = pk2(s[0 * 33], s[1 * 33]); o.y = pk2(s[2 * 33], s[3 * 33]); o.z = pk2(s[4 * 33], s[5 * 33]); o.w = pk2(s[6 * 33], s[7 * 33]);
        *(v4u*)(WT + (size_t)(n0 + n) * K + k0 + 8 * c) = o; }
    LDS_WAIT();
}
struct TrDesc { const float* W; bf16* WT; const float* gk; int K, N, k0, n0; };
__device__ __forceinline__ void tr_load(float (&v)[32], const TrDesc& d, int lane) {
    const float* p = d.W + (size_t)(d.k0 + (lane >> 5)) * d.N + d.n0 + (lane & 31);
#pragma unroll
    for (int i = 0; i < 32; ++i) v[i] = p[(size_t)(2 * i) * d.N];
}
__device__ __forceinline__ void tr_store(const float (&v)[32], const TrDesc& d, LAS float* scr, int lane) {
#pragma unroll
    for (int i = 0; i < 32; ++i) { const int kk = 2 * i + (lane >> 5); float x = v[i]; if (d.gk) x *= d.gk[d.k0 + kk]; scr[kk * 33 + (lane & 31)] = x; }
    LDS_WAIT();
    const int c = lane & 7;
#pragma unroll
    for (int j = 0; j < 4; ++j) { const int n = (lane >> 3) + 8 * j; const LAS float* s = scr + (8 * c) * 33 + n;
        v4u o; o.x = pg8::cvt_pk_bf16(s[0 * 33], s[1 * 33]); o.y = pg8::cvt_pk_bf16(s[2 * 33], s[3 * 33]); o.z = pg8::cvt_pk_bf16(s[4 * 33], s[5 * 33]); o.w = pg8::cvt_pk_bf16(s[6 * 33], s[7 * 33]);
        *(v4u*)(d.WT + (size_t)(d.n0 + n) * (d.K + WPAD) + d.k0 + 8 * c) = o; }
    LDS_WAIT();
}
__device__ __forceinline__ void fold_item(const float* __restrict__ W, bf16* __restrict__ WT, const float* __restrict__ wp, const float* __restrict__ ps, LAS float* scr, int item, int lane) {
    const int K = DM, N = DM; const int nblk = N / 32, g = item / nblk, nb = item % nblk, k0 = 64 * g, n0 = 32 * nb;
    LAS float* scr2 = scr + 64 * 33;
#pragma unroll 8
    for (int i = 0; i < 32; ++i) { const int kk = 2 * i + (lane >> 5); scr[kk * 33 + (lane & 31)] = W[(size_t)(k0 + kk) * N + n0 + (lane & 31)] * ps[k0 + kk]; }
    LDS_WAIT();
    const int n = lane & 31;
    for (int i = 0; i < 32; ++i) { const int kk = 2 * i + (lane >> 5); const float* wr = wp + (size_t)(g * 64 + kk) * 64; float a = 0.f;
#pragma unroll 16
        for (int d = 0; d < 64; ++d) a += wr[d] * scr[d * 33 + n];
        scr2[kk * 33 + n] = a; }
    LDS_WAIT();
    const int c = lane & 7;
#pragma unroll
    for (int j = 0; j < 4; ++j) { const int nn = (lane >> 3) + 8 * j; const LAS float* s = scr2 + (8 * c) * 33 + nn;
        v4u o; o.x = pk2(s[0 * 33], s[1 * 33]); o.y = pk2(s[2 * 33], s[3 * 33]); o.z = pk2(s[4 * 33], s[5 * 33]); o.w = pk2(s[6 * 33], s[7 * 33]);
        *(v4u*)(WT + (size_t)(n0 + nn) * (K + WPAD) + k0 + 8 * c) = o; }
    LDS_WAIT();
}
__device__ __forceinline__ void rms_row_to_bf16(const float* __restrict__ xrow, bf16* __restrict__ orow, float* __restrict__ rsp, int lane) {
    const f32x4* xr = (const f32x4*)xrow + lane;
    f32x4 v[4]; float s = 0.f;
#pragma unroll
    for (int j = 0; j < 4; ++j) { v[j] = xr[64 * j]; s += (v[j].x * v[j].x + v[j].y * v[j].y) + (v[j].z * v[j].z + v[j].w * v[j].w); }
    const float rstd = rsqrtf(wave_sum(s) * (1.f / DM) + EPS);
    if (lane == 0) *rsp = rstd;
    v2u* o8 = (v2u*)orow + lane;
#pragma unroll
    for (int j = 0; j < 4; ++j) { v2u o; o.x = pg8::cvt_pk_bf16(v[j].x, v[j].y); o.y = pg8::cvt_pk_bf16(v[j].z, v[j].w); o8[64 * j] = o; }
}
struct EwRow { f32x4 x[4]; v2u o[4]; };
__device__ __forceinline__ f32x4 unpack4(const v2u w) { return (f32x4){__uint_as_float(w.x << 16), __uint_as_float(w.x & 0xffff0000u), __uint_as_float(w.y << 16), __uint_as_float(w.y & 0xffff0000u)}; }
__device__ __forceinline__ void ew_load(EwRow& r, const float* __restrict__ xrow32, const bf16* __restrict__ xrow16, bool src16, const bf16* __restrict__ orow, int lane) {
    const v2u* orr = (const v2u*)orow + lane;
    if (src16) { const v2u* xr = (const v2u*)xrow16 + lane;
#pragma unroll
        for (int j = 0; j < 4; ++j) r.x[j] = unpack4(xr[64 * j]); }
    else { const f32x4* xr = (const f32x4*)xrow32 + lane;
#pragma unroll
        for (int j = 0; j < 4; ++j) r.x[j] = xr[64 * j]; }
#pragma unroll
    for (int j = 0; j < 4; ++j) r.o[j] = orr[64 * j];
}
__device__ __forceinline__ void ew_finish(EwRow& r, const f32x4 (&gg)[4], float* __restrict__ Xrow32, bf16* __restrict__ Xrow16, bool dst16, float* __restrict__ rsp, bool write_xn, int lane) {
    f32x4 o[4]; float so = 0.f;
#pragma unroll
    for (int j = 0; j < 4; ++j) { o[j] = unpack4(r.o[j]); so += (o[j].x * o[j].x + o[j].y * o[j].y) + (o[j].z * o[j].z + o[j].w * o[j].w); }
    const float rs = rsqrtf(wave_sum(so) * (1.f / DM) + EPS); float s1 = 0.f;
#pragma unroll
    for (int j = 0; j < 4; ++j) { f32x4 x = r.x[j] + o[j] * rs * gg[j]; r.x[j] = x; s1 += (x.x * x.x + x.y * x.y) + (x.z * x.z + x.w * x.w); }
    if (dst16) { v2u* Xr = (v2u*)Xrow16 + lane;
#pragma unroll
        for (int j = 0; j < 4; ++j) { v2u w; w.x = pg8::cvt_pk_bf16(r.x[j].x, r.x[j].y); w.y = pg8::cvt_pk_bf16(r.x[j].z, r.x[j].w); Xr[64 * j] = w; } }
    else { f32x4* Xr = (f32x4*)Xrow32 + lane;
#pragma unroll
        for (int j = 0; j < 4; ++j) Xr[64 * j] = r.x[j]; }
    if (write_xn) { const float r1 = rsqrtf(wave_sum(s1) * (1.f / DM) + EPS); if (lane == 0) *rsp = r1; }
}

template <bool SAMPLE>
__device__ __forceinline__ void pool_unit(const bf16* __restrict__ Z, bf16* __restrict__ CAT, const float* __restrict__ state, float* __restrict__ newp,
                                          int seq, int t0, int nrows, int g, int lane) {
    const int c = g * 64 + lane, w = 2 << g;
    const size_t rowbase = SAMPLE ? (size_t)MP + (size_t)seq * ST : (size_t)seq * SEQ;
    const bf16* zc = Z + rowbase * ZP + c;
    const float* st = state + (size_t)seq * 15 * GW + c;
#define POOL_A(e) ((e) >= 0 ? bf2f(zc[(size_t)(e) * ZP]) : (SAMPLE ? st[(15 + (e)) * GW] : 0.f))
    float S = 0.f;
    for (int j = 1; j < w; ++j) S += POOL_A(t0 - j);
#pragma unroll 4
    for (int t = t0; t < t0 + nrows; ++t) {
        const float a = POOL_A(t); S += a;
        const float cnt = SAMPLE ? (float)w : (float)(t + 1 < w ? t + 1 : w);
        CAT[(rowbase + t) * DP + c] = (bf16)f2bf(S / cnt - a);
        const int e = t - w + 1; S -= POOL_A(e);
    }
    const int T = SAMPLE ? ST : SEQ;
    if (t0 + nrows == T) {
        for (int j = 0; j < 15; ++j) { const int e = T - 15 + j; newp[((size_t)seq * 15 + j) * GW + c] = POOL_A(e); }
    }
#undef POOL_A
}
template <bool SAMPLE>
__device__ __forceinline__ void short_unit(const bf16* __restrict__ Z, bf16* __restrict__ CAT, const float* __restrict__ state, float* __restrict__ news,
                                           const float* __restrict__ sw, int seq, int t0, int nrows, int h, int lane) {
    const int c = h * 64 + lane;
    const size_t rowbase = SAMPLE ? (size_t)MP + (size_t)seq * ST : (size_t)seq * SEQ;
    const bf16* zc = Z + rowbase * ZP + c;
    const float* st = state + (size_t)seq * 2 * GW + c;
    const float w0 = sw[c], w1 = sw[GW + c], w2 = sw[2 * GW + c];
#define SH_E(e) ((e) >= 0 ? bf2f(zc[(size_t)(e) * ZP + 1536]) * bf2f(zc[(size_t)(e) * ZP + 1792]) : (SAMPLE ? st[(2 + (e)) * GW] : 0.f))
    float e2 = SH_E(t0 - 2), e1 = SH_E(t0 - 1);
#pragma unroll 4
    for (int t = t0; t < t0 + nrows; ++t) {
        const float e0 = SH_E(t); const float bg = bf2f(zc[(size_t)t * ZP + 1280]);
        CAT[(rowbase + t) * DP + 768 + c] = (bf16)f2bf(bg * (w0 * e2 + w1 * e1 + w2 * e0));
        e2 = e1; e1 = e0;
    }
    const int T = SAMPLE ? ST : SEQ;
    if (t0 + nrows == T) { news[((size_t)seq * 2 + 0) * GW + c] = e2; news[((size_t)seq * 2 + 1) * GW + c] = e1; }
#undef SH_E
}
template <bool SAMPLE>
__device__ __forceinline__ void conv_unit(const bf16* __restrict__ Z, bf16* __restrict__ CAT, const float* __restrict__ state, float* __restrict__ newc,
                                          const float* __restrict__ cw, const float* __restrict__ cb, const float* __restrict__ lg, const float* __restrict__ lb,
                                          int seq, int t0, int nrows, int h, LAS float* gL, int lane) {
    const int c = h * 64 + lane;
    const size_t rowbase = SAMPLE ? (size_t)MP + (size_t)seq * ST : (size_t)seq * SEQ;
    const bf16* zc = Z + rowbase * ZP + c;
    bf16* oc = CAT + rowbase * DP + 256 + c;
    const int T = SAMPLE ? ST : SEQ;
    const bool last = (t0 + nrows == T);
    const int nin = nrows + 30;
#pragma unroll 4
    for (int r = 0; r < nin; ++r) { const int s = t0 - 30 + r; float gs = 0.f;
        if (s >= 0) { const unsigned off = (unsigned)s * ZP; const float p = bf2f(zc[off + 256]), gt = bf2f(zc[off + 512]); gs = p * sigm(gt); }
        else if (SAMPLE) gs = state[((size_t)seq * 30 + 30 + s) * GW + c];
        if (last && s >= T - 30) newc[((size_t)seq * 30 + (s - (T - 30))) * GW + c] = gs;
        gL[r * 64 + lane] = gs; }
    LDS_WAIT();
    float wk[31];
#pragma unroll
    for (int k = 0; k < 31; ++k) wk[k] = cw[k * GW + c];
    const float bias = cb[c], gg = lg[c], bb = lb[c];
#pragma unroll 1
    for (int tq = 0; tq < nrows; tq += 4) {
        float acc[4] = {bias, bias, bias, bias};
#pragma unroll
        for (int r = 0; r < 34; ++r) { const float gv = gL[(tq + r) * 64 + lane];
#pragma unroll
            for (int q = 0; q < 4; ++q) { const int k = r - q; if (k >= 0 && k <= 30) acc[q] += wk[k] * gv; } }
#pragma unroll
        for (int q = 0; q < 4; ++q) { const float cv = acc[q];
            const float mean = wave_sum(cv) * (1.f / 64.f); const float d = cv - mean;
            const float var = wave_sum(d * d) * (1.f / 64.f);
            const float y = d * rsqrtf(var + EPS) * gg + bb;
            oc[(unsigned)(t0 + tq + q) * DP] = (bf16)f2bf(y * sigm(y)); }
    }
    LDS_WAIT();
}
template <int W>
__device__ __forceinline__ void pool_unit_p(const bf16* __restrict__ Z, bf16* __restrict__ CAT, float* __restrict__ newp, int seq, int t0, int g, int lane) {
    const int rr = lane >> 3, cg = lane & 7, c0 = g * 64 + cg * 8, tb = t0 + rr * 8;
    const size_t rowbase = (size_t)seq * SEQ;
    const bf16* zb = Z + (rowbase + tb) * ZP + c0;
    v4u raw[W + 7];
#pragma unroll
    for (int j = 0; j < W + 7; ++j) { const int dj = j - (W - 1); raw[j] = (tb + dj >= 0) ? ld16(zb + (long)dj * ZP) : (v4u){0u, 0u, 0u, 0u}; }
    float S[8];
#pragma unroll
    for (int i = 0; i < 8; ++i) S[i] = 0.f;
#pragma unroll
    for (int j = 0; j < W - 1; ++j) { float f[8]; unpack8(raw[j], f);
#pragma unroll
        for (int i = 0; i < 8; ++i) S[i] += f[i]; }
    bf16* ob = CAT + (rowbase + tb) * DP + c0;
    const bool lastseg = (t0 + 64 == SEQ);
#pragma unroll
    for (int j = 0; j < 8; ++j) { float a[8], o[8], od[8]; unpack8(raw[j + W - 1], a); unpack8(raw[j], od);
        const int t = tb + j; const float inv = 1.f / (float)(t + 1 < W ? t + 1 : W);
#pragma unroll
        for (int i = 0; i < 8; ++i) { S[i] += a[i]; o[i] = S[i] * inv - a[i]; S[i] -= od[i]; }
        *(v4u*)(ob + j * DP) = pack8(o);
        if (lastseg && t >= SEQ - 15) { float* np = newp + ((size_t)seq * 15 + (t - (SEQ - 15))) * GW + c0; *(f32x4*)np = (f32x4){a[0], a[1], a[2], a[3]}; *(f32x4*)(np + 4) = (f32x4){a[4], a[5], a[6], a[7]}; }
    }
}
__device__ __forceinline__ void short_unit_p(const bf16* __restrict__ Z, bf16* __restrict__ CAT, float* __restrict__ news, const float* __restrict__ sw, int seq, int t0, int h, int lane) {
    const int rr = lane >> 3, cg = lane & 7, c0 = h * 64 + cg * 8, tb = t0 + rr * 8;
    const size_t rowbase = (size_t)seq * SEQ;
    const bf16* zb = Z + (rowbase + tb) * ZP + c0;
    v4u Bv[8], Cv[10], Hv[10];
#pragma unroll
    for (int j = 0; j < 10; ++j) { const int dj = j - 2; const bool ok = (tb + dj >= 0);
        Cv[j] = ok ? ld16(zb + (long)dj * ZP + 1536) : (v4u){0u, 0u, 0u, 0u}; Hv[j] = ok ? ld16(zb + (long)dj * ZP + 1792) : (v4u){0u, 0u, 0u, 0u};
        if (j >= 2) Bv[j - 2] = ld16(zb + (long)dj * ZP + 1280); }
    float w0[8], w1[8], w2[8];
#pragma unroll
    for (int i = 0; i < 8; ++i) { w0[i] = sw[c0 + i]; w1[i] = sw[GW + c0 + i]; w2[i] = sw[2 * GW + c0 + i]; }
    float e2[8], e1[8];
    { float c[8], hh[8]; unpack8(Cv[0], c); unpack8(Hv[0], hh);
#pragma unroll
      for (int i = 0; i < 8; ++i) e2[i] = c[i] * hh[i];
      unpack8(Cv[1], c); unpack8(Hv[1], hh);
#pragma unroll
      for (int i = 0; i < 8; ++i) e1[i] = c[i] * hh[i]; }
    bf16* ob = CAT + (rowbase + tb) * DP + 768 + c0;
#pragma unroll
    for (int j = 0; j < 8; ++j) { float c[8], hh[8], b[8], o[8]; unpack8(Cv[j + 2], c); unpack8(Hv[j + 2], hh); unpack8(Bv[j], b);
#pragma unroll
        for (int i = 0; i < 8; ++i) { const float e0 = c[i] * hh[i]; o[i] = b[i] * (w0[i] * e2[i] + w1[i] * e1[i] + w2[i] * e0); e2[i] = e1[i]; e1[i] = e0; }
        *(v4u*)(ob + j * DP) = pack8(o); }
    if (t0 + 64 == SEQ && rr == 7) { float* np = news + (size_t)seq * 2 * GW + c0;
        *(f32x4*)np = (f32x4){e2[0], e2[1], e2[2], e2[3]}; *(f32x4*)(np + 4) = (f32x4){e2[4], e2[5], e2[6], e2[7]};
        *(f32x4*)(np + GW) = (f32x4){e1[0], e1[1], e1[2], e1[3]}; *(f32x4*)(np + GW + 4) = (f32x4){e1[4], e1[5], e1[6], e1[7]}; }
}
__device__ __forceinline__ void conv_unit_p(const bf16* __restrict__ Z, bf16* __restrict__ CAT, float* __restrict__ newc,
                                            const float* __restrict__ cw, const float* __restrict__ cb, const float* __restrict__ lg, const float* __restrict__ lb,
                                            int seq, int t0, int h, LAS float* gL, int lane) {
    const int rr = lane >> 3, cg = lane & 7, c0 = h * 64 + cg * 8;
    const size_t rowbase = (size_t)seq * SEQ;
    const bool last = (t0 + 32 == SEQ);
    { v4u pv[8], gv[8];
#pragma unroll
      for (int j = 0; j < 8; ++j) { const int r = 8 * j + rr, sx = t0 - 30 + r; const bool ok = (sx >= 0 && r < 62);
          const bf16* zp = Z + (rowbase + (ok ? sx : 0)) * ZP + c0;
          pv[j] = ok ? ld16(zp + 256) : (v4u){0u, 0u, 0u, 0u}; gv[j] = ok ? ld16(zp + 512) : (v4u){0u, 0u, 0u, 0u}; }
#pragma unroll
      for (int j = 0; j < 8; ++j) { const int r = 8 * j + rr, sx = t0 - 30 + r; float p[8], gt[8]; unpack8(pv[j], p); unpack8(gv[j], gt);
#pragma unroll
          for (int i = 0; i < 8; ++i) p[i] = p[i] * sigm(gt[i]);
          if (r < 62) { *(LAS f32x4*)(gL + r * 64 + cg * 8) = (f32x4){p[0], p[1], p[2], p[3]}; *(LAS f32x4*)(gL + r * 64 + cg * 8 + 4) = (f32x4){p[4], p[5], p[6], p[7]}; }
          if (last && sx >= SEQ - 30 && r < 62) { float* np = newc + ((size_t)seq * 30 + (sx - (SEQ - 30))) * GW + c0; *(f32x4*)np = (f32x4){p[0], p[1], p[2], p[3]}; *(f32x4*)(np + 4) = (f32x4){p[4], p[5], p[6], p[7]}; } }
    }
    LDS_WAIT();
    const int c = h * 64 + lane;
    float wk[31];
#pragma unroll
    for (int k = 0; k < 31; ++k) wk[k] = cw[k * GW + c];
    const float bias = cb[c];
#pragma unroll 1
    for (int tq = 0; tq < 32; tq += 4) {
        float acc[4] = {bias, bias, bias, bias};
#pragma unroll
        for (int r = 0; r < 34; ++r) { const float gvv = gL[(tq + r) * 64 + lane];
#pragma unroll
            for (int q = 0; q < 4; ++q) { const int k = r - q; if (k >= 0 && k <= 30) acc[q] += wk[k] * gvv; } }
        LDS_WAIT();
#pragma unroll
        for (int q = 0; q < 4; ++q) gL[(tq + q) * 64 + lane] = acc[q];
    }
    LDS_WAIT();
    float gg[8], bb[8];
#pragma unroll
    for (int i = 0; i < 8; ++i) { gg[i] = lg[c0 + i]; bb[i] = lb[c0 + i]; }
    bf16* ob = CAT + (rowbase + t0) * DP + 256 + c0;
#pragma unroll
    for (int j = 0; j < 4; ++j) { const int r = 8 * j + rr; const f32x4 a = *(const LAS f32x4*)(gL + r * 64 + cg * 8), b = *(const LAS f32x4*)(gL + r * 64 + cg * 8 + 4);
        float x[8] = {a[0], a[1], a[2], a[3], b[0], b[1], b[2], b[3]};
        const float mean = sum8(((x[0] + x[1]) + (x[2] + x[3])) + ((x[4] + x[5]) + (x[6] + x[7]))) * (1.f / 64.f);
        float q = 0.f;
#pragma unroll
        for (int i = 0; i < 8; ++i) { x[i] -= mean; q += x[i] * x[i]; }
        const float rstd = rsqrtf(sum8(q) * (1.f / 64.f) + EPS);
#pragma unroll
        for (int i = 0; i < 8; ++i) { const float yy = x[i] * rstd * gg[i] + bb[i]; x[i] = yy * sigm(yy); }
        *(v4u*)(ob + r * DP) = pack8(x); }
    LDS_WAIT();
}
__device__ __forceinline__ int sgu_swz(int c, int chunk) { return (chunk ^ ((c & 15) ^ (c >> 4))) << 3; }
__device__ __forceinline__ void sgu_unit(const bf16* __restrict__ Z, bf16* __restrict__ CAT, const bf16* __restrict__ Wb, const float* __restrict__ lg, const float* __restrict__ lb,
                                         const float* __restrict__ sb, int chunk, int h, LAS bf16* vT, int lane) {
    const size_t r0 = (size_t)chunk * 128;
    { const int rr = lane >> 3, cg = lane & 7, c0 = h * 64 + cg * 8;
      float gg[8], bb[8];
#pragma unroll
      for (int i = 0; i < 8; ++i) { gg[i] = lg[c0 + i]; bb[i] = lb[c0 + i]; }
#pragma unroll 1
      for (int jh = 0; jh < 16; jh += 8) {
          v4u raw[8];
#pragma unroll
          for (int j = 0; j < 8; ++j) raw[j] = ld16(Z + (r0 + 8 * (jh + j) + rr) * ZP + 1024 + c0);
#pragma unroll
          for (int j = 0; j < 8; ++j) { float x[8]; unpack8(raw[j], x);
              float sm = ((x[0] + x[1]) + (x[2] + x[3])) + ((x[4] + x[5]) + (x[6] + x[7])); const float mean = sum8(sm) * (1.f / 64.f);
              float q = 0.f;
#pragma unroll
              for (int i = 0; i < 8; ++i) { x[i] -= mean; q += x[i] * x[i]; }
              const float rstd = rsqrtf(sum8(q) * (1.f / 64.f) + EPS);
#pragma unroll
              for (int i = 0; i < 8; ++i) { const int cl = cg * 8 + i; vT[cl * 128 + sgu_swz(cl, jh + j) + rr] = (bf16)f2bf(x[i] * rstd * gg[i] + bb[i]); } }
      }
    }
    LDS_WAIT();
    const int fr = lane & 15, fq = lane >> 4;
    bf16x8 wf[8][4];
#pragma unroll
    for (int mt = 0; mt < 8; ++mt)
#pragma unroll
        for (int ks = 0; ks < 4; ++ks) if (ks * 32 <= mt * 16 + 15) wf[mt][ks] = *(const bf16x8*)(Wb + ((size_t)(h * 128 + mt * 16 + fr) * 128 + ks * 32 + fq * 8));
#pragma unroll
    for (int mt = 0; mt < 8; ++mt) {
        f32x4 acc[4];
#pragma unroll
        for (int nt = 0; nt < 4; ++nt) acc[nt] = (f32x4){0.f, 0.f, 0.f, 0.f};
        const int t = mt * 16 + fr;
        v2u uv[4];
#pragma unroll
        for (int nt = 0; nt < 4; ++nt) uv[nt] = *(const v2u*)(Z + (r0 + t) * ZP + 768 + h * 64 + nt * 16 + 4 * fq);
        const float bt = sb[h * 128 + t];
#pragma unroll
        for (int ks = 0; ks < 4; ++ks) if (ks * 32 <= mt * 16 + 15) {
#pragma unroll
            for (int nt = 0; nt < 4; ++nt) { const int cl = nt * 16 + fr; const bf16x8 vf = *(const LAS bf16x8*)(vT + cl * 128 + sgu_swz(cl, ks * 4 + fq));
                acc[nt] = __builtin_amdgcn_mfma_f32_16x16x32_bf16(vf, wf[mt][ks], acc[nt], 0, 0, 0); }
        }
#pragma unroll
        for (int nt = 0; nt < 4; ++nt) { const float u0 = __uint_as_float(uv[nt].x << 16), u1 = __uint_as_float(uv[nt].x & 0xffff0000u), u2 = __uint_as_float(uv[nt].y << 16), u3 = __uint_as_float(uv[nt].y & 0xffff0000u);
            v2u w; w.x = pg8::cvt_pk_bf16(u0 * (acc[nt][0] + bt), u1 * (acc[nt][1] + bt)); w.y = pg8::cvt_pk_bf16(u2 * (acc[nt][2] + bt), u3 * (acc[nt][3] + bt));
            *(v2u*)(CAT + (r0 + t) * DP + 512 + h * 64 + nt * 16 + 4 * fq) = w; }
    }
    LDS_WAIT();
}
__device__ __forceinline__ void sgu_sample_unit(const bf16* __restrict__ Z, bf16* __restrict__ CAT, const float* __restrict__ Wf, const float* __restrict__ lg, const float* __restrict__ lb,
                                                const float* __restrict__ sb, float* __restrict__ vout, int seq, int h, int lane) {
    const int c = h * 64 + lane; const size_t rowbase = (size_t)MP + (size_t)seq * ST;
    const float gg = lg[c], bb = lb[c];
    float vn[ST];
#pragma unroll
    for (int t = 0; t < ST; ++t) { const float v = bf2f(Z[(rowbase + t) * ZP + 1024 + c]); const float mean = wave_sum(v) * (1.f / 64.f); const float d = v - mean; const float var = wave_sum(d * d) * (1.f / 64.f);
        vn[t] = d * rsqrtf(var + EPS) * gg + bb; vout[((size_t)seq * ST + t) * GW + c] = vn[t]; }
#pragma unroll
    for (int t = 0; t < ST; ++t) { float sv = sb[h * 128 + t];
#pragma unroll
        for (int s = 0; s <= t; ++s) sv += Wf[((size_t)h * 128 + t) * 128 + s] * vn[s];
        const float u = bf2f(Z[(rowbase + t) * ZP + 768 + c]);
        CAT[(rowbase + t) * DP + 512 + c] = (bf16)f2bf(u * sv); }
}

#define XB_TMO      128
#define XB_XCNT(j)  (256  + 64 * (j))
#define XB_XSUB(j)  (1280 + 64 * (j))
#define XB_XGEN(j)  (2304 + 64 * (j))
#define XB_TOP      3328
#define XB_TOPGEN   3392
#define XCD_BAR_WORDS 3456
#define XB_SPIN_CAP (1u << 18)

__device__ __forceinline__ unsigned xb_ld(unsigned* p)              { return __hip_atomic_load(p, __ATOMIC_RELAXED, __HIP_MEMORY_SCOPE_AGENT); }
__device__ __forceinline__ unsigned xb_add(unsigned* p, unsigned v) { return __hip_atomic_fetch_add(p, v, __ATOMIC_RELAXED, __HIP_MEMORY_SCOPE_AGENT); }
__device__ __forceinline__ unsigned xb_xcc_id() { return (unsigned)__builtin_amdgcn_s_getreg((3 << 11) | 20) & 0xFu; }
#define XB_SPIN(cond, bar) do { unsigned _sp = 0; while (cond) { __builtin_amdgcn_s_sleep(1); \
    if ((++_sp & 255u) == 0u) { if (xb_ld(&(bar)[XB_TMO])) break; if (_sp > XB_SPIN_CAP) { atomicAdd(&(bar)[XB_TMO], 1u); break; } } } } while (0)

struct XcdBarrier {
    unsigned* bar; unsigned x;
    volatile LAS unsigned* st;
};

__device__ __forceinline__ XcdBarrier xcd_barrier_post(unsigned* bar, volatile LAS unsigned* st) {
    XcdBarrier b; b.bar = bar; b.x = xb_xcc_id(); b.st = st;
    if (threadIdx.x == 0) (void)xb_add(&bar[XB_XCNT(b.x)], 1u);
    return b;
}
__device__ __forceinline__ void xcd_barrier_complete(unsigned* bar, unsigned x, unsigned& nloc, unsigned& nx) {
    const unsigned G = gridDim.x * gridDim.y * gridDim.z;
    unsigned sum, cnt, mine, sp = 0u;
    for (;;) {
        sum = 0u; cnt = 0u; mine = 0u;
#pragma unroll
        for (unsigned j = 0; j < 16; ++j) { const unsigned c = xb_ld(&bar[XB_XCNT(j)]); sum += c; cnt += (c > 0u) ? 1u : 0u; mine = (j == x) ? c : mine; }
        if (sum == G) break;
        __builtin_amdgcn_s_sleep(1);
        if ((++sp & 255u) == 0u) { if (xb_ld(&bar[XB_TMO])) break; if (sp > XB_SPIN_CAP) { atomicAdd(&bar[XB_TMO], 1u); break; } }
    }
    nloc = mine > 0u ? mine : 1u; nx = cnt > 0u ? cnt : 1u;
}

__device__ __forceinline__ void xcd_barrier(const XcdBarrier& b) {
    asm volatile("s_waitcnt vmcnt(0)" ::: "memory");
    __syncthreads();
    if (threadIdx.x == 0) {
        unsigned* bar = b.bar;
        __builtin_amdgcn_s_waitcnt(0);
        unsigned nloc = b.st[0], nx = b.st[1];
        if (nloc == 0u) { xcd_barrier_complete(bar, b.x, nloc, nx); b.st[0] = nloc; b.st[1] = nx; }
        const unsigned old = xb_add(&bar[XB_XSUB(b.x)], 1u);
        const unsigned gen = old / nloc;
        if (old + 1u == (gen + 1u) * nloc) {
            __builtin_amdgcn_fence(__ATOMIC_RELEASE, "agent");
            asm volatile("s_waitcnt vmcnt(0)" ::: "memory");
            const unsigned og = xb_add(&bar[XB_TOP], 1u);
            const unsigned tg = og / nx;
            if (og + 1u == (tg + 1u) * nx) xb_add(&bar[XB_TOPGEN], 1u);
            else XB_SPIN(xb_ld(&bar[XB_TOPGEN]) == tg, bar);
            __builtin_amdgcn_fence(__ATOMIC_ACQUIRE, "agent");
            xb_add(&bar[XB_XGEN(b.x)], 1u);
            asm volatile("s_waitcnt vmcnt(0)" ::: "memory");
        } else {
            XB_SPIN(xb_ld(&bar[XB_XGEN(b.x)]) == gen, bar);
            __builtin_amdgcn_fence(__ATOMIC_ACQUIRE, "agent");
            asm volatile("s_waitcnt vmcnt(0)" ::: "memory");
        }
    }
    __syncthreads();
}

template <int NT, int ACT, int K>
__device__ __forceinline__ void small_gemm_tile(LAS unsigned char* lds, const bf16* __restrict__ A, const bf16* __restrict__ Bt, bf16* __restrict__ O, int ldc, int lda, int ldb, const float* __restrict__ rs, int m0, int n0, int tid) {
    constexpr int NC = 16 * NT, KW = K / 8, NCH = KW / 128;
    const int wave = __builtin_amdgcn_readfirstlane(tid >> 6), lane = tid & 63, fr = lane & 15, fq = lane >> 4;
    const bf16* ap = A + (size_t)(m0 + fr) * lda + wave * KW + fq * 8;
    const bf16* bp = Bt + (size_t)(n0 + fr) * ldb + wave * KW + fq * 8;
    f32x4 acc[4][NT];
#pragma unroll
    for (int m = 0; m < 4; ++m)
#pragma unroll
        for (int n = 0; n < NT; ++n) acc[m][n] = (f32x4){0.f, 0.f, 0.f, 0.f};
    if constexpr (NCH == 1) {
        bf16x8 fa[4][4], fb[4][NT];
#pragma unroll
        for (int s_ = 0; s_ < 4; ++s_) {
#pragma unroll
            for (int m = 0; m < 4; ++m) fa[s_][m] = *(const bf16x8*)(ap + (size_t)m * 16 * lda + s_ * 32);
#pragma unroll
            for (int n = 0; n < NT; ++n) fb[s_][n] = *(const bf16x8*)(bp + (size_t)n * 16 * ldb + s_ * 32); }
        __builtin_amdgcn_sched_barrier(0);
#pragma unroll
        for (int s_ = 0; s_ < 4; ++s_)
#pragma unroll
            for (int m = 0; m < 4; ++m)
#pragma unroll
                for (int n = 0; n < NT; ++n) acc[m][n] = __builtin_amdgcn_mfma_f32_16x16x32_bf16(fa[s_][m], fb[s_][n], acc[m][n], 0, 0, 0);
        __builtin_amdgcn_sched_barrier(0);
    } else {
        constexpr int NC2 = KW / 64;
        bf16x8 fa[3][2][4], fb[3][2][NT];
#define SG_LD(buf, c) do { _Pragma("unroll") for (int s_ = 0; s_ < 2; ++s_) { \
            _Pragma("unroll") for (int m = 0; m < 4; ++m) fa[buf][s_][m] = *(const bf16x8*)(ap + (size_t)m * 16 * lda + (c) * 64 + s_ * 32); \
            _Pragma("unroll") for (int n = 0; n < NT; ++n) fb[buf][s_][n] = *(const bf16x8*)(bp + (size_t)n * 16 * ldb + (c) * 64 + s_ * 32); } } while (0)
        SG_LD(0, 0); SG_LD(1, 1);
        __builtin_amdgcn_sched_barrier(0);
#pragma unroll
        for (int c = 0; c < NC2; ++c) {
            if (c + 2 < NC2) SG_LD((c + 2) % 3, c + 2);
            __builtin_amdgcn_sched_barrier(0);
#pragma unroll
            for (int s_ = 0; s_ < 2; ++s_)
#pragma unroll
                for (int m = 0; m < 4; ++m)
#pragma unroll
                    for (int n = 0; n < NT; ++n) acc[m][n] = __builtin_amdgcn_mfma_f32_16x16x32_bf16(fa[c % 3][s_][m], fb[c % 3][s_][n], acc[m][n], 0, 0, 0);
            __builtin_amdgcn_sched_barrier(0);
        }
#undef SG_LD
    }
    LAS float* P = (LAS float*)lds + wave * (64 * NC);
#pragma unroll
    for (int m = 0; m < 4; ++m)
#pragma unroll
        for (int n = 0; n < NT; ++n)
#pragma unroll
            for (int i = 0; i < 4; ++i) P[(m * 16 + fq * 4 + i) * NC + n * 16 + fr] = acc[m][n][i];
    __syncthreads();
    constexpr int EPT = 64 * NC / 512;
    const int e0 = tid * EPT, row = e0 / NC, col = e0 % NC;
    float r[EPT];
#pragma unroll
    for (int j = 0; j < EPT; ++j) r[j] = 0.f;
#pragma unroll
    for (int w = 0; w < 8; ++w) { const LAS f32x4* q = (const LAS f32x4*)((LAS float*)lds + w * (64 * NC) + e0);
#pragma unroll
        for (int j = 0; j < EPT / 4; ++j) { const f32x4 v = q[j]; r[4 * j] += v[0]; r[4 * j + 1] += v[1]; r[4 * j + 2] += v[2]; r[4 * j + 3] += v[3]; } }
    if (rs) { const float sc = rs[m0 + row];
#pragma unroll
        for (int j = 0; j < EPT; ++j) r[j] *= sc; }
    if (ACT == 1) {
#pragma unroll
        for (int j = 0; j < EPT; ++j) { const float t = fmaxf(r[j], 0.f); r[j] = t * t; } }
    bf16* op = O + (size_t)(m0 + row) * ldc + n0 + col;
    if (EPT == 8) { v4u w; w.x = pk2(r[0], r[1]); w.y = pk2(r[2], r[3]); w.z = pk2(r[4 % EPT], r[5 % EPT]); w.w = pk2(r[6 % EPT], r[7 % EPT]); *(v4u*)op = w; }
    else { v2u w; w.x = pk2(r[0], r[1]); w.y = pk2(r[2], r[3]); *(v2u*)op = w; }
    __syncthreads();
}

#define SMALL_TN(j, ntn) ((((j) >> 8) * 32 + ((j) & 7) * 4 + (((j) >> 3) & 3)))
constexpr int NPH = 15;
#ifndef REP_PRO
#define REP_PRO 1
#endif
#ifndef REP_GEMM
#define REP_GEMM 1
#endif
#ifndef REP_MIX
#define REP_MIX 1
#endif
#ifndef REP_SYNC
#define REP_SYNC 1
#endif
struct Args { const float* in[24]; float* out; unsigned char* ws; int ph_lo, ph_hi; };
__global__ void __launch_bounds__(NWAVES * 64, 2) hybrid_fwd(Args args) {
    extern __shared__ __attribute__((aligned(16))) unsigned char lds_raw[];
    LAS unsigned char* lds = (LAS unsigned char*)lds_raw;
    volatile LAS unsigned* MISC = (volatile LAS unsigned*)(lds + MISC_OFF);
    if (threadIdx.x < 64) MISC[threadIdx.x] = 0u;
    __syncthreads();
    (void)xcd_barrier_post((unsigned*)(args.ws + WS_CTL), MISC + 8);
    for (int ph = args.ph_lo; ph < args.ph_hi;) {
        int tid = threadIdx.x; asm volatile("" : "+v"(tid));
        const int lane = tid & 63, wave = __builtin_amdgcn_readfirstlane(tid >> 6);
        const int G = gridDim.x; const int bx = blockIdx.x;
        unsigned char* ws = args.ws;
        if (ph == 0) {
            const int vcu = (G % 8 == 0) ? (bx % 8) * (G / 8) + bx / 8 : bx; const int gw = vcu * NWAVES + wave, NGW = G * NWAVES;
            LAS float* scr = (LAS float*)(lds + wave * WAVE_SCR);
            bf16* XN = (bf16*)(ws + WS_XN); bf16* SGW = (bf16*)(ws + WS_SGUW);
            constexpr int I_FOLD = 4 * (DM / 32), I_OUT = (DM / 64) * (DM / 32) - I_FOLD, I_IN = (DM / 64) * (INW / 32), I_UP = (DM / 64) * (FF / 32), I_DN = (FF / 64) * (DM / 32);
            constexpr int I_LAYER = I_OUT + I_IN + I_UP + I_DN, I_ALL = DEPTH * I_LAYER;
            for (int it = gw; it < DEPTH * I_FOLD; it += NGW) { const int l = it / I_FOLD, r = it % I_FOLD;
                fold_item(args.in[10] + (size_t)l * DM * DM, (bf16*)(ws + WS_W + (size_t)l * W_LAYER + W_OUT), args.in[11] + (size_t)l * 4 * 64 * 64, args.in[12] + (size_t)l * GW, scr, r, lane); }
#define TR_DECODE(it_, d_) do { const int l_ = (it_) / I_LAYER; int r_ = (it_) % I_LAYER; unsigned char* wl_ = ws + WS_W + (size_t)l_ * W_LAYER; int nblk_; \
                if (r_ < I_OUT) { r_ += I_FOLD; d_.W = args.in[10] + (size_t)l_ * DM * DM; d_.WT = (bf16*)(wl_ + W_OUT); d_.gk = nullptr; d_.K = DM; d_.N = DM; } \
                else if ((r_ -= I_OUT) < I_IN) { d_.W = args.in[9] + (size_t)l_ * DM * INW; d_.WT = (bf16*)(wl_ + W_IN); d_.gk = args.in[5] + (size_t)l_ * DM; d_.K = DM; d_.N = INW; } \
                else if ((r_ -= I_IN) < I_UP) { d_.W = args.in[22] + (size_t)l_ * DM * FF; d_.WT = (bf16*)(wl_ + W_UP); d_.gk = args.in[7] + (size_t)l_ * DM; d_.K = DM; d_.N = FF; } \
                else { r_ -= I_UP; d_.W = args.in[23] + (size_t)l_ * FF * DM; d_.WT = (bf16*)(wl_ + W_DN); d_.gk = nullptr; d_.K = FF; d_.N = DM; } \
                nblk_ = d_.N / 32; d_.k0 = 64 * (r_ / nblk_); d_.n0 = 32 * (r_ % nblk_); } while (0)
            { int it = NGW - 1 - gw;
              if (it < I_ALL) {
                TrDesc dc; TR_DECODE(it, dc);
                float va[32], vb[32];
                tr_load(va, dc, lane);
#pragma unroll 1
                for (;;) {
                    const int itn = it + NGW; const bool more = itn < I_ALL;
                    TrDesc dn; { const int q = more ? itn : it; TR_DECODE(q, dn); }
                    tr_load(vb, dn, lane);
                    tr_store(va, dc, scr, lane);
                    if (!more) break;
#pragma unroll
                    for (int i = 0; i < 32; ++i) va[i] = vb[i];
                    dc = dn; it = itn;
                }
              }
            }
#undef TR_DECODE
            for (int m = gw; m < MT; m += NGW) rms_row_to_bf16(m < MP ? args.in[0] + (size_t)m * DM : args.in[1] + (size_t)(m - MP) * DM, (bf16*)args.out + (size_t)m * 2 * DM, (float*)(ws + WS_RS) + m, lane);
            for (int e = bx * (NWAVES * 64) + tid; e < DEPTH * 4 * 128 * 128; e += G * NWAVES * 64) { const int t = (e >> 7) & 127, s = e & 127; SGW[e] = (bf16)(s <= t ? f2bf(args.in[19][e]) : 0u); }
        } else {
            const int l = (ph - 1) / 7, k = (ph - 1) - 7 * l;
            unsigned char* wl = ws + WS_W + (size_t)l * W_LAYER;
            if (k == 0 || k == 2 || k == 5) {
                const bf16* A = k == 0 ? (const bf16*)args.out : (const bf16*)(ws + (k == 2 ? WS_CAT : WS_H));
                const bf16* Bt = (const bf16*)(wl + (k == 0 ? W_IN : k == 2 ? W_OUT : W_DN));
                bf16* O = (bf16*)(ws + (k == 0 ? WS_Z : WS_O));
                const int N = k == 0 ? INW : DM, K = k == 5 ? FF : DM;
                pg8::Gemm g{A, Bt, MP, N, K, k == 5 ? FP : k == 0 ? 2 * DM : DP, K + WPAD}; pg8::StaticOrder S; S.init(MP, N, G, bx);
                pg8::EpiBf16<0> E{O, k == 0 ? ZP : OP, k == 0 ? (const float*)(ws + WS_RS) : nullptr};
                pg8::gemm_phase<pg8::EpiBf16<0>, pg8::StaticOrder, true, true>(lds, g, S, E, tid);
                if (k == 0) { for (int j = bx; j < (MS / 64) * (INW / 64); j += G) small_gemm_tile<4, 0, DM>(lds, A, Bt, O, ZP, 2 * DM, DM + WPAD, (const float*)(ws + WS_RS), MP + ((j >> 5) & 7) * 64, SMALL_TN(j, INW / 64) * 64, tid); }
                else { for (int j = bx; j < (MS / 64) * (DM / 32); j += G) { if (k == 2) small_gemm_tile<2, 0, DM>(lds, A, Bt, O, OP, DP, DM + WPAD, nullptr, MP + ((j >> 5) & 7) * 64, SMALL_TN(j, DM / 32) * 32, tid); else small_gemm_tile<2, 0, FF>(lds, A, Bt, O, OP, FP, FF + WPAD, nullptr, MP + ((j >> 5) & 7) * 64, SMALL_TN(j, DM / 32) * 32, tid); } }
            } else if (k == 4) {
                pg8::Gemm g{(const bf16*)args.out, (const bf16*)(wl + W_UP), MP, FF, DM, 2 * DM, DM + WPAD}; pg8::StaticOrder S; S.init(MP, FF, G, bx);
                pg8::EpiBf16<1> E{(bf16*)(ws + WS_H), FP, (const float*)(ws + WS_RS)};
                pg8::gemm_phase<pg8::EpiBf16<1>, pg8::StaticOrder, true, true>(lds, g, S, E, tid);
                for (int j = bx; j < (MS / 64) * (FF / 64); j += G) small_gemm_tile<4, 1, DM>(lds, (const bf16*)args.out, (const bf16*)(wl + W_UP), (bf16*)(ws + WS_H), FP, 2 * DM, DM + WPAD, (const float*)(ws + WS_RS), MP + ((j >> 5) & 7) * 64, SMALL_TN(j, FF / 64) * 64, tid);
            } else if (k == 1) {
                const int vcu = (G % 8 == 0) ? (bx % 8) * (G / 8) + bx / 8 : bx; const int gw = vcu * NWAVES + wave, NGW = G * NWAVES;
                LAS float* scr = (LAS float*)(lds + wave * WAVE_SCR);
                const bf16* ZB = (const bf16*)(ws + WS_Z); bf16* CAT = (bf16*)(ws + WS_CAT); const bf16* SGW = (const bf16*)(ws + WS_SGUW) + (size_t)l * 4 * 128 * 128;
                float* out = args.out;
                constexpr int NU_SGU = 512, NU_CONV = 2048, NU_SEG = 1024, NU_SMP = 2048, NU = NU_SGU + NU_CONV + 2 * NU_SEG + NU_SMP;
#pragma unroll 1
                for (int ui = 0; ; ++ui) {
                    int u;
                    if (NGW != 2048) { u = ui * NGW + gw; if (u >= NU) break; }
                    else { if (ui >= 4) break;
                        if (gw < 512) { if (ui == 0) u = gw; else if (ui == 1) u = NU_SGU + 1536 + gw; else break; }
                        else { const int g5 = gw - 512; if (ui == 0) u = NU_SGU + g5; else { const int sidx = (ui - 1) * 1536 + g5; if (sidx >= 2 * NU_SEG + NU_SMP) break; u = NU_SGU + NU_CONV + sidx; } } }
                    int lane = tid & 63; asm volatile("" : "+v"(lane));
                    if (u < NU_SGU) { sgu_unit(ZB, CAT, SGW, args.in[17] + (size_t)l * GW, args.in[18] + (size_t)l * GW, args.in[20] + (size_t)l * 4 * 128, u >> 2, u & 3, (LAS bf16*)scr, lane); continue; }
                    int r = u - NU_SGU;
                    if (r < NU_CONV) { const int seg = r >> 2, h = r & 3, seq = seg >> 6, t0 = (seg & 63) * 32;
                        conv_unit_p(ZB, CAT, out + OUT_CONV_P + (size_t)l * NBP * 30 * GW, args.in[13] + (size_t)l * 31 * GW, args.in[14] + (size_t)l * GW, args.in[15] + (size_t)l * GW, args.in[16] + (size_t)l * GW, seq, t0, h, scr, lane);
                        continue; }
                    r -= NU_CONV;
                    if (r < 2 * NU_SEG) { const int ty = r / NU_SEG, q = r % NU_SEG, seg = q >> 2, h = q & 3, seq = seg >> 5, t0 = (seg & 31) * 64;
                        if (ty == 0) { float* np = out + OUT_POOL_P + (size_t)l * NBP * 15 * GW;
                            if (h == 0) pool_unit_p<2>(ZB, CAT, np, seq, t0, h, lane); else if (h == 1) pool_unit_p<4>(ZB, CAT, np, seq, t0, h, lane);
                            else if (h == 2) pool_unit_p<8>(ZB, CAT, np, seq, t0, h, lane); else pool_unit_p<16>(ZB, CAT, np, seq, t0, h, lane); }
                        else short_unit_p(ZB, CAT, out + OUT_SHORT_P + (size_t)l * NBP * 2 * GW, args.in[21] + (size_t)l * 3 * GW, seq, t0, h, lane);
                        continue; }
                    r -= 2 * NU_SEG;
                    { const int ty = r >> 9, q = r & 511, seq = q >> 2, h = q & 3;
                        if (ty == 0) conv_unit<true>(ZB, CAT, args.in[3] + (size_t)l * NSB * 30 * GW, out + OUT_CONV_S + (size_t)l * NSB * 30 * GW, args.in[13] + (size_t)l * 31 * GW, args.in[14] + (size_t)l * GW, args.in[15] + (size_t)l * GW, args.in[16] + (size_t)l * GW, seq, 0, ST, h, scr, lane);
                        else if (ty == 1) pool_unit<true>(ZB, CAT, args.in[2] + (size_t)l * NSB * 15 * GW, out + OUT_POOL_S + (size_t)l * NSB * 15 * GW, seq, 0, ST, h, lane);
                        else if (ty == 2) short_unit<true>(ZB, CAT, args.in[4] + (size_t)l * NSB * 2 * GW, out + OUT_SHORT_S + (size_t)l * NSB * 2 * GW, args.in[21] + (size_t)l * 3 * GW, seq, 0, ST, h, lane);
                        else sgu_sample_unit(ZB, CAT, args.in[19] + (size_t)l * 4 * 128 * 128, args.in[17] + (size_t)l * GW, args.in[18] + (size_t)l * GW, args.in[20] + (size_t)l * 4 * 128, out + OUT_V_S + (size_t)l * NSB * ST * GW, seq, h, lane); }
                }
            } else {
                const int vcu = (G % 8 == 0) ? (bx % 8) * (G / 8) + bx / 8 : bx; const int gw = vcu * NWAVES + wave, NGW = G * NWAVES;
                const float* g = args.in[k == 3 ? 6 : 8] + (size_t)l * DM;
                float* X = args.out; const bf16* OB = (const bf16*)(ws + WS_O); float* RS = (float*)(ws + WS_RS);
                const bool from_input = (l == 0 && k == 3), write_xn = !(l == DEPTH - 1 && k == 6);
                f32x4 gg[4];
#pragma unroll
                for (int j = 0; j < 4; ++j) gg[j] = ((const f32x4*)g + lane)[64 * j];
                const int m_lo = 0;
#define EW_X32(m) ((m) < MP ? args.in[0] + (size_t)(m) * DM : args.in[1] + (size_t)((m) - MP) * DM)
                bf16* X16 = (bf16*)args.out;
                const bool dst16 = write_xn;
#pragma unroll 1
                for (int m = m_lo + gw; m < MT; m += 2 * NGW) {
                    const int m2 = m + NGW; const bool two = m2 < MT;
                    EwRow ra, rb;
                    ew_load(ra, nullptr, X16 + (size_t)m * 2 * DM, true, OB + (size_t)m * OP, lane);
                    { const int mc = two ? m2 : m; ew_load(rb, nullptr, X16 + (size_t)mc * 2 * DM, true, OB + (size_t)mc * OP, lane); }
                    ew_finish(ra, gg, X + (size_t)m * DM, X16 + (size_t)m * 2 * DM, dst16, RS + m, write_xn, lane);
                    if (two) ew_finish(rb, gg, X + (size_t)m2 * DM, X16 + (size_t)m2 * 2 * DM, dst16, RS + m2, write_xn, lane);
                }
#undef EW_X32
            }
        }
        ++ph;
        if (ph < args.ph_hi) {
            if (args.ph_lo < 0) cg::this_grid().sync();
            else { XcdBarrier b; b.bar = (unsigned*)(args.ws + WS_CTL); b.x = xb_xcc_id(); b.st = (volatile LAS unsigned*)(lds + MISC_OFF) + 8; xcd_barrier(b); }
        }
    }
}

#ifndef MK_N_LAUNCHES
#define MK_N_LAUNCHES 1
#endif
extern "C" void kernel_launch(void* const* d_in, const int* in_sizes, int n_in, void* d_out, int out_size, void* d_ws, size_t ws_size, hipStream_t stream) {
    static int grid = 0;
    if (grid == 0) {
        if (n_in != 24 || (size_t)out_size != OUT_END || ws_size < WS_END) { fprintf(stderr, "kernel_launch: unexpected shapes (n_in %d out %d ws %zu)\n", n_in, out_size, ws_size); grid = -1; return; }
        int dev = 0, cus = 0, per_cu = 0;
        if (hipGetDevice(&dev) != hipSuccess || hipDeviceGetAttribute(&cus, hipDeviceAttributeMultiprocessorCount, dev) != hipSuccess) { grid = -1; return; }
        if (hipFuncSetAttribute((const void*)hybrid_fwd, hipFuncAttributeMaxDynamicSharedMemorySize, LDS_BYTES) != hipSuccess) { fprintf(stderr, "kernel_launch: hipFuncSetAttribute failed\n"); grid = -1; return; }
        if (hipOccupancyMaxActiveBlocksPerMultiprocessor(&per_cu, (const void*)hybrid_fwd, NWAVES * 64, LDS_BYTES) != hipSuccess || per_cu < 1) per_cu = 1;
        (void)hipGetLastError();
        grid = cus * per_cu;
    }
    if (grid < 0) return;
    if (hipMemsetAsync((char*)d_ws + WS_CTL, 0, CTL_ZERO_BYTES, stream) != hipSuccess) { fprintf(stderr, "kernel_launch: hipMemsetAsync failed\n"); return; }
    Args a{};
    for (int i = 0; i < 24; ++i) a.in[i] = (const float*)d_in[i];
    a.out = (float*)d_out; a.ws = (unsigned char*)d_ws;
#if MK_N_LAUNCHES == 1
    a.ph_lo = 0; a.ph_hi = NPH;
    void* kargs[] = {&a};
    hipError_t e = hipLaunchCooperativeKernel((const void*)hybrid_fwd, dim3(grid), dim3(NWAVES * 64), kargs, LDS_BYTES, stream);
    if (e != hipSuccess) fprintf(stderr, "cooperative launch failed: %s (grid %d)\n", hipGetErrorString(e), grid);
#else
    for (int p = 0; p < NPH; ++p) { a.ph_lo = p; a.ph_hi = p + 1; hipLaunchKernelGGL(hybrid_fwd, dim3(grid), dim3(NWAVES * 64), LDS_BYTES, stream, a); }
#endif
}
```

```cpp
#include <hip/hip_runtime.h>
#include <hip/hip_cooperative_groups.h>
#include <cstdio>
#include <cstdint>
namespace pg8 {
#define PG8_LAS __attribute__((address_space(3)))
typedef unsigned short bf16_t;
typedef short bf16x8 __attribute__((ext_vector_type(8)));
typedef float f32x4 __attribute__((ext_vector_type(4)));
typedef unsigned u32x4 __attribute__((ext_vector_type(4)));
constexpr int KPAD = 64;
constexpr int BM = 256, BK = 64, HALF = 128, HTB = HALF * BK * 2  , STAGE_BYTES = 8 * HTB, NXCD = 8, WGM = 1;

__host__ __device__ __forceinline__ int lds_byte(int r, int c) { const int st = (r >> 4) * 2 + (c >> 5), rr = r & 15, cc = c & 31, ob = rr * 64 + cc * 2; return st * 1024 + (ob ^ (((ob >> 9) & 1) << 5)); }
__host__ __device__ __forceinline__ void stage_rc(int b, int& R, int& C) { const int st = b / 1024, sb = b % 1024, swz = sb ^ (((sb >> 9) & 1) << 5); R = (st >> 1) * 16 + swz / 64; C = (st & 1) * 32 + (swz % 64) / 2; }
__host__ __device__ __forceinline__ int perm32(int rho) { const int n = rho >> 4, i = rho & 15; return 8 * (i >> 2) + 4 * n + (i & 3); }

struct Unit { int pm, pn; };
struct Gemm { const bf16_t* A; const bf16_t* Bt; int M, N, K, lda, ldb; };

struct StaticOrder {
    int nM, nN, nwg, G, c;
    __host__ __device__ void init(int M, int N, int G_, int c_) { nM = M / BM; nN = N / BM; nwg = nM * nN; G = G_; c = c_; }
    __host__ __device__ bool next(int i, Unit& u) const {
        const long L = (long)i * G + c; if (L >= nwg) return false;
        int wgid = (int)L; { const int q = nwg / NXCD, r = nwg % NXCD, xcd = wgid % NXCD, off = wgid / NXCD; wgid = (xcd < r ? xcd * (q + 1) : r * (q + 1) + (xcd - r) * q) + off; }
        const int nig = WGM * nN, gid = wgid / nig, fm = gid * WGM, gsz = (nM - fm) < WGM ? (nM - fm) : WGM;
        u.pm = fm + ((wgid % nig) % gsz); u.pn = (wgid % nig) / gsz; return true;
    }
    __device__ __forceinline__ void a_ready(const Unit&) const {}
    __device__ __forceinline__ void done(const Unit&) const {}
};

__device__ __forceinline__ unsigned cvt_pk_bf16(float lo, float hi) { unsigned r; asm volatile("v_cvt_pk_bf16_f32 %0, %1, %2" : "=v"(r) : "v"(lo), "v"(hi)); return r; }
__device__ __forceinline__ float relu_sq(float x) { float r; asm volatile("v_max_f32 %0, 0, %1" : "=v"(r) : "v"(x)); return r * r; }
__device__ __forceinline__ void st16_wt(void* p, u32x4 v) { asm volatile("global_store_dwordx4 %0, %1, off sc1" :: "v"(p), "v"(v) : "memory"); }
template <int ACT  > struct EpiBf16 {
    static constexpr bool PERM = true, AFTER_DRAIN = false;
    bf16_t* O; int ldc; const float* rs;
    __device__ __forceinline__ void operator()(const f32x4 (&acc)[2][2][4][2], const Unit& u, int wr, int wc, int fr, int fq) const {
        const int row0 = u.pm * BM + wr * 64 + fr; const int col0 = u.pn * BM + wc * 32 + 8 * fq;
#pragma unroll
        for (int ai = 0; ai < 2; ++ai)
#pragma unroll
            for (int m = 0; m < 4; ++m) { bf16_t* rowp = O + (size_t)(row0 + ai * HALF + m * 16) * ldc + col0; const float sc = rs ? rs[row0 + ai * HALF + m * 16] : 1.f;
#pragma unroll
                for (int bj = 0; bj < 2; ++bj) { f32x4 v0 = acc[ai][bj][m][0] * sc, v1 = acc[ai][bj][m][1] * sc;
                    if (ACT == 1) {
#pragma unroll
                        for (int e = 0; e < 4; ++e) { v0[e] = relu_sq(v0[e]); v1[e] = relu_sq(v1[e]); } }
                    u32x4 w; w.x = cvt_pk_bf16(v0[0], v0[1]); w.y = cvt_pk_bf16(v0[2], v0[3]); w.z = cvt_pk_bf16(v1[0], v1[1]); w.w = cvt_pk_bf16(v1[2], v1[3]);
                    *(u32x4*)(rowp + bj * HALF) = w; } }
    }
};

template <class Epi, class Sched, bool ALIGN_EPI = false, bool SP2 = false>
__device__ __forceinline__ void gemm_phase(PG8_LAS unsigned char* lds, const Gemm g, const Sched& S, const Epi& E, const int tid) {
    const int wid = __builtin_amdgcn_readfirstlane(tid >> 6), lane = tid & 63, wr = wid >> 2, wc = wid & 3, fr = lane & 15, fq = lane >> 4;
    const int K = g.K, nt = K / BK;
    unsigned voffA[2], voffB[2];
#pragma unroll
    for (int i = 0; i < 2; ++i) { int R, C; stage_rc(tid * 16 + i * 8192, R, C); const int Rb = Epi::PERM ? ((R & ~31) + perm32(R & 31)) : R;
        voffA[i] = (unsigned)(R * g.lda + C) * 2u; voffB[i] = (unsigned)(Rb * g.ldb + C) * 2u; }
    const size_t kstep = (size_t)(BK * 2);
    const size_t hstepA = (size_t)HALF * g.lda * 2, hstepB = (size_t)HALF * g.ldb * 2;
    const size_t tstepA = 2 * hstepA, tstepB = 2 * hstepB;
    const unsigned ldsw = (unsigned)wid * 1024u;
    const int aoff = lds_byte(wr * 64 + fr, fq * 8), boff = lds_byte(wc * 32 + fr, fq * 8);
#define PG8_SA(b, h) (((b) * 2 + (h)) * HTB)
#define PG8_SB(b, h) ((4 + (b) * 2 + (h)) * HTB)
#define PG8_STAGE(bufoff, gbase, voff) do { _Pragma("unroll") for (int _i = 0; _i < 2; ++_i) \
        __builtin_amdgcn_global_load_lds((const unsigned*)((const char*)(gbase) + (voff)[_i]), (PG8_LAS unsigned*)(lds + (bufoff) + ldsw + _i * 8192), 16, 0, 0); } while (0)
#define PG8_LDA(dst, b, h) do { _Pragma("unroll") for (int m = 0; m < 4; ++m) _Pragma("unroll") for (int k = 0; k < 2; ++k) dst[m][k] = *(const PG8_LAS bf16x8*)(lds + PG8_SA(b, h) + aoff + m * 2048 + k * 1024); } while (0)
#define PG8_LDB(dst, b, h) do { _Pragma("unroll") for (int n = 0; n < 2; ++n) _Pragma("unroll") for (int k = 0; k < 2; ++k) dst[n][k] = *(const PG8_LAS bf16x8*)(lds + PG8_SB(b, h) + boff + n * 2048 + k * 1024); } while (0)
#define PG8_MMA(ai, bj, At, Bt) do { __builtin_amdgcn_s_setprio(1); _Pragma("unroll") for (int m = 0; m < 4; ++m) _Pragma("unroll") for (int n = 0; n < 2; ++n) _Pragma("unroll") for (int k = 0; k < 2; ++k) \
        acc[ai][bj][m][n] = __builtin_amdgcn_mfma_f32_16x16x32_bf16(Bt[n][k], At[m][k], acc[ai][bj][m][n], 0, 0, 0); __builtin_amdgcn_s_setprio(0); } while (0)
#define PG8_WAIT_V(n) asm volatile("s_waitcnt vmcnt(" #n ")" ::: "memory")
#define PG8_WAIT_L(n) asm volatile("s_waitcnt lgkmcnt(" #n ")" ::: "memory")
#define PG8_BAR __builtin_amdgcn_s_barrier()
#define PG8_SCHED __builtin_amdgcn_sched_barrier(0)
    Unit cur, nxt; int ui = 0;
    if (!S.next(0, cur)) return;
    f32x4 acc[2][2][4][2];
#pragma unroll
    for (int a = 0; a < 2; ++a)
#pragma unroll
        for (int b = 0; b < 2; ++b)
#pragma unroll
            for (int m = 0; m < 4; ++m)
#pragma unroll
                for (int n = 0; n < 2; ++n) acc[a][b][m][n] = (f32x4){0.f, 0.f, 0.f, 0.f};
    bf16x8 At[4][2], B0[2][2], B1[2][2];
    const char* cA = (const char*)g.A + (size_t)cur.pm * tstepA; const char* cB = (const char*)g.Bt + (size_t)cur.pn * tstepB;
    S.a_ready(cur);
    if constexpr (SP2) {
        PG8_STAGE(PG8_SB(0, 0), cB, voffB); PG8_STAGE(PG8_SB(0, 1), cB + hstepB, voffB); PG8_STAGE(PG8_SA(0, 0), cA, voffA); PG8_STAGE(PG8_SA(0, 1), cA + hstepA, voffA);
        if (wr == 1) PG8_BAR;
        PG8_WAIT_V(2); PG8_BAR;
        PG8_STAGE(PG8_SB(1, 0), cB + kstep, voffB); PG8_STAGE(PG8_SA(1, 0), cA + kstep, voffA); PG8_STAGE(PG8_SB(1, 1), cB + hstepB + kstep, voffB);
        PG8_WAIT_V(6); PG8_BAR;
    } else {
        PG8_STAGE(PG8_SB(0, 0), cB, voffB); PG8_STAGE(PG8_SA(0, 0), cA, voffA); PG8_STAGE(PG8_SB(0, 1), cB + hstepB, voffB); PG8_STAGE(PG8_SA(0, 1), cA + hstepA, voffA);
        if (wr == 1) PG8_BAR;
        PG8_WAIT_V(4); PG8_BAR;
        PG8_STAGE(PG8_SB(1, 0), cB + kstep, voffB); PG8_STAGE(PG8_SA(1, 0), cA + kstep, voffA); PG8_STAGE(PG8_SB(1, 1), cB + hstepB + kstep, voffB);
        PG8_WAIT_V(6); PG8_BAR;
    }
    for (;;) {
        const bool has_next = S.next(ui + 1, nxt);
        const char* nA = has_next ? (const char*)g.A + (size_t)nxt.pm * tstepA : cA; const char* nB = has_next ? (const char*)g.Bt + (size_t)nxt.pn * tstepB : cB;
        for (int t = 0; t < nt; t += 2) {
            const bool last = (t == nt - 2);
            const char* a1 = cA + (size_t)(t + 1) * kstep;
            const char* a2 = last ? nA : cA + (size_t)(t + 2) * kstep; const char* b2 = last ? nB : cB + (size_t)(t + 2) * kstep;
            const char* a3 = a2 + kstep; const char* b3 = b2 + kstep;
            if (last && has_next) S.a_ready(nxt);
            if constexpr (SP2) {
            PG8_LDB(B0, 0, 0); PG8_LDB(B1, 0, 1); PG8_SCHED; PG8_LDA(At, 0, 0); PG8_STAGE(PG8_SA(1, 1), a1 + hstepA, voffA);
            PG8_WAIT_V(8); PG8_WAIT_L(0); PG8_BAR; PG8_MMA(0, 0, At, B0); PG8_MMA(0, 1, At, B1); PG8_BAR; PG8_SCHED;
            PG8_LDA(At, 0, 1); PG8_STAGE(PG8_SB(0, 0), b2, voffB); PG8_STAGE(PG8_SB(0, 1), b2 + hstepB, voffB); PG8_STAGE(PG8_SA(0, 0), a2, voffA);
            PG8_WAIT_V(8); PG8_WAIT_L(0); PG8_BAR; PG8_MMA(1, 0, At, B0); PG8_MMA(1, 1, At, B1); PG8_BAR; PG8_SCHED;
            PG8_LDB(B0, 1, 0); PG8_LDB(B1, 1, 1); PG8_SCHED; PG8_LDA(At, 1, 0); PG8_STAGE(PG8_SA(0, 1), a2 + hstepA, voffA);
            PG8_WAIT_V(8); PG8_WAIT_L(0); PG8_BAR; PG8_MMA(0, 0, At, B0); PG8_MMA(0, 1, At, B1); PG8_BAR; PG8_SCHED;
            PG8_LDA(At, 1, 1); PG8_STAGE(PG8_SB(1, 0), b3, voffB); PG8_STAGE(PG8_SB(1, 1), b3 + hstepB, voffB); PG8_STAGE(PG8_SA(1, 0), a3, voffA);
            PG8_WAIT_V(8); PG8_WAIT_L(0); PG8_BAR; PG8_MMA(1, 0, At, B0); PG8_MMA(1, 1, At, B1); PG8_BAR; PG8_SCHED;
            } else {
            PG8_LDB(B0, 0, 0); PG8_SCHED; PG8_LDA(At, 0, 0); PG8_STAGE(PG8_SA(1, 1), a1 + hstepA, voffA);
            PG8_WAIT_L(8); PG8_BAR; PG8_WAIT_L(0); PG8_MMA(0, 0, At, B0); PG8_BAR; PG8_SCHED;
            PG8_LDB(B1, 0, 1); PG8_STAGE(PG8_SB(0, 0), b2, voffB);
            PG8_BAR; PG8_WAIT_L(0); PG8_MMA(0, 1, At, B1); PG8_BAR;
            PG8_LDA(At, 0, 1); PG8_STAGE(PG8_SA(0, 0), a2, voffA);
            PG8_BAR; PG8_WAIT_L(0); PG8_MMA(1, 0, At, B0); PG8_BAR; PG8_SCHED;
            PG8_STAGE(PG8_SB(0, 1), b2 + hstepB, voffB);
            PG8_WAIT_V(6); PG8_BAR; PG8_MMA(1, 1, At, B1); PG8_BAR;
            PG8_LDB(B0, 1, 0); PG8_SCHED; PG8_LDA(At, 1, 0); PG8_STAGE(PG8_SA(0, 1), a2 + hstepA, voffA);
            PG8_WAIT_L(8); PG8_BAR; PG8_WAIT_L(0); PG8_MMA(0, 0, At, B0); PG8_BAR; PG8_SCHED;
            PG8_LDB(B1, 1, 1); PG8_STAGE(PG8_SB(1, 0), b3, voffB);
            PG8_BAR; PG8_WAIT_L(0); PG8_MMA(0, 1, At, B1); PG8_BAR;
            PG8_LDA(At, 1, 1); PG8_STAGE(PG8_SA(1, 0), a3, voffA);
            PG8_BAR; PG8_WAIT_L(0); PG8_MMA(1, 0, At, B0); PG8_BAR; PG8_SCHED;
            PG8_STAGE(PG8_SB(1, 1), b3 + hstepB, voffB);
            PG8_WAIT_V(6); PG8_BAR; PG8_MMA(1, 1, At, B1); PG8_BAR;
            }
        }
        if constexpr (ALIGN_EPI) { if (wr == 0) PG8_BAR; }
        if constexpr (!Epi::AFTER_DRAIN) { E(acc, cur, wr, wc, fr, fq); S.done(cur); }
        if (!has_next) break;
#pragma unroll
        for (int a = 0; a < 2; ++a)
#pragma unroll
            for (int b = 0; b < 2; ++b)
#pragma unroll
                for (int m = 0; m < 4; ++m)
#pragma unroll
                    for (int n = 0; n < 2; ++n) acc[a][b][m][n] = (f32x4){0.f, 0.f, 0.f, 0.f};
        cur = nxt; cA = nA; cB = nB; ++ui;
        if constexpr (ALIGN_EPI) { if (wr == 1) PG8_BAR; }
    }
    PG8_WAIT_V(0);
    if constexpr (!ALIGN_EPI) { if (wr == 0) PG8_BAR; }
    PG8_BAR;
    if constexpr (Epi::AFTER_DRAIN) { E.fused(acc, cur, wr, wc, fr, fq, lds, wid, lane); S.done(cur); }
#undef PG8_SA
#undef PG8_SB
#undef PG8_STAGE
#undef PG8_LDA
#undef PG8_LDB
#undef PG8_MMA
#undef PG8_WAIT_V
#undef PG8_WAIT_L
#undef PG8_BAR
#undef PG8_SCHED
}
}

namespace cg = cooperative_groups;
#define LAS __attribute__((address_space(3)))
typedef unsigned short bf16;
typedef unsigned v4u __attribute__((ext_vector_type(4)));
typedef unsigned v2u __attribute__((ext_vector_type(2)));
typedef float f32x4 __attribute__((ext_vector_type(4)));
typedef short bf16x8 __attribute__((ext_vector_type(8)));

constexpr int NWAVES = 8;
constexpr int DM = 1024, FF = 4096, INW = 2048, GW = 256;
constexpr int ZP = INW + 64;
#ifndef HPAD
#define HPAD 0
#endif
#ifndef WPAD
#define WPAD 0
#endif
#ifndef APAD
#define APAD 0
#endif
constexpr int DP = DM + APAD;
#ifndef OPAD
#define OPAD 0
#endif
constexpr int OP = DM + OPAD;
constexpr int FP = FF + HPAD;
constexpr int MP = 16384, MS = 512, MT = MP + MS;
constexpr int SEQ = 2048, NBP = 8, NSB = 128, ST = 4, DEPTH = 2;
constexpr float EPS = 1e-6f;
constexpr size_t MiB = 1u << 20;
constexpr size_t WS_SGUW = 1 * MiB;
constexpr size_t WS_W = 2 * MiB, W_LAYER = 24 * MiB, W_IN = 0, W_OUT = 9 * MiB / 2, W_UP = 7 * MiB, W_DN = 31 * MiB / 2;
constexpr size_t WS_XN = 50 * MiB, WS_O = 84 * MiB, WS_H = 120 * MiB, WS_Z = 120 * MiB, WS_CAT = 189 * MiB, WS_RS = 254 * MiB  , WS_END = 255 * MiB;
static_assert(WS_Z + (size_t)16896 * ZP * 2 <= WS_CAT && WS_XN + (size_t)16896 * DP * 2 <= WS_O && WS_CAT + (size_t)16896 * DP * 2 <= WS_H + (size_t)16896 * FP * 2 && WS_H + (size_t)16896 * FP * 2 <= WS_END, "d_ws map");
constexpr int LDS_BYTES = 147456;
constexpr int MISC_OFF = LDS_BYTES - 256;
constexpr size_t WS_CTL = 0, CTL_ZERO_BYTES = 128 * 1024;
constexpr int WAVE_SCR = 17408;
constexpr size_t OUT_Y = 0;
constexpr size_t OUT_POOL_P = (size_t)MT * DM;
constexpr size_t OUT_POOL_S = OUT_POOL_P + (size_t)DEPTH * NBP * 15 * GW;
constexpr size_t OUT_CONV_P = OUT_POOL_S + (size_t)DEPTH * NSB * 15 * GW;
constexpr size_t OUT_CONV_S = OUT_CONV_P + (size_t)DEPTH * NBP * 30 * GW;
constexpr size_t OUT_SHORT_P = OUT_CONV_S + (size_t)DEPTH * NSB * 30 * GW;
constexpr size_t OUT_SHORT_S = OUT_SHORT_P + (size_t)DEPTH * NBP * 2 * GW;
constexpr size_t OUT_V_S = OUT_SHORT_S + (size_t)DEPTH * NSB * 2 * GW;
constexpr size_t OUT_END = OUT_V_S + (size_t)DEPTH * NSB * ST * GW;

__device__ __forceinline__ float bf2f(bf16 b) { return __uint_as_float(((unsigned)b) << 16); }
__device__ __forceinline__ unsigned f2bf(float f) { unsigned u = __float_as_uint(f); return (u + 0x7fffu + ((u >> 16) & 1u)) >> 16; }
__device__ __forceinline__ unsigned pk2(float lo, float hi) { return f2bf(lo) | (f2bf(hi) << 16); }
template <int CTRL, int ROWMASK> __device__ __forceinline__ float dpp_get(float v) { return __int_as_float(__builtin_amdgcn_update_dpp(0, __float_as_int(v), CTRL, ROWMASK, 0xF, false)); }
__device__ __forceinline__ float sum8(float v) { v += dpp_get<0xB1, 0xF>(v); v += dpp_get<0x4E, 0xF>(v); v += dpp_get<0x141, 0xF>(v); return v; }
__device__ __forceinline__ float wave_sum(float v) {
    v = sum8(v); v += dpp_get<0x140, 0xF>(v); v += dpp_get<0x142, 0xA>(v); v += dpp_get<0x143, 0xC>(v);
    return __int_as_float(__builtin_amdgcn_readlane(__float_as_int(v), 63));
}
__device__ __forceinline__ void unpack8(const v4u w, float (&f)[8]) {
    f[0] = __uint_as_float(w.x << 16); f[1] = __uint_as_float(w.x & 0xffff0000u); f[2] = __uint_as_float(w.y << 16); f[3] = __uint_as_float(w.y & 0xffff0000u);
    f[4] = __uint_as_float(w.z << 16); f[5] = __uint_as_float(w.z & 0xffff0000u); f[6] = __uint_as_float(w.w << 16); f[7] = __uint_as_float(w.w & 0xffff0000u); }
__device__ __forceinline__ v4u pack8(const float (&f)[8]) { v4u w; w.x = pg8::cvt_pk_bf16(f[0], f[1]); w.y = pg8::cvt_pk_bf16(f[2], f[3]); w.z = pg8::cvt_pk_bf16(f[4], f[5]); w.w = pg8::cvt_pk_bf16(f[6], f[7]); return w; }
__device__ __forceinline__ v4u ld16(const bf16* p) { return *(const v4u*)p; }
__device__ __forceinline__ float sigm(float x) { return __builtin_amdgcn_rcpf(1.f + __builtin_amdgcn_exp2f(-1.44269504f * x)); }
#define LDS_WAIT() asm volatile("s_waitcnt lgkmcnt(0)" ::: "memory")

__device__ __forceinline__ void transpose_item(const float* __restrict__ W, int K, int N, bf16* __restrict__ WT, const float* __restrict__ gk, LAS float* scr, int item, int lane) {
    const int nblk = N / 32, kb = item / nblk, nb = item % nblk, k0 = 64 * kb, n0 = 32 * nb;
#pragma unroll 8
    for (int i = 0; i < 32; ++i) { const int kk = 2 * i + (lane >> 5); float v = W[(size_t)(k0 + kk) * N + n0 + (lane & 31)]; if (gk) v *= gk[k0 + kk]; scr[kk * 33 + (lane & 31)] = v; }
    LDS_WAIT();
    const int c = lane & 7;
#pragma unroll
    for (int j = 0; j < 4; ++j) { const int n = (lane >> 3) + 8 * j; const LAS float* s = scr + (8 * c) * 33 + n;
        v4u o; o.x = pk2(s[0 * 33], s[1 * 33]); o.y = pk2(s[2 * 33], s[3 * 33]); o.z = pk2(s[4 * 33], s[5 * 33]); o.w = pk2(s[6 * 33], s[7 * 33]);
        *(v4u*)(WT + (size_t)(n0 + n) * K + k0 + 8 * c) = o; }
    LDS_WAIT();
}
struct TrDesc { const float* W; bf16* WT; const float* gk; int K, N, k0, n0; };
__device__ __forceinline__ void tr_load(float (&v)[32], const TrDesc& d, int lane) {
    const float* p = d.W + (size_t)(d.k0 + (lane >> 5)) * d.N + d.n0 + (lane & 31);
#pragma unroll
    for (int i = 0; i < 32; ++i) v[i] = p[(size_t)(2 * i) * d.N];
}
__device__ __forceinline__ void tr_store(const float (&v)[32], const TrDesc& d, LAS float* scr, int lane) {
#pragma unroll
    for (int i = 0; i < 32; ++i) { const int kk = 2 * i + (lane >> 5); float x = v[i]; if (d.gk) x *= d.gk[d.k0 + kk]; scr[kk * 33 + (lane & 31)] = x; }
    LDS_WAIT();
    const int c = lane & 7;
#pragma unroll
    for (int j = 0; j < 4; ++j) { const int n = (lane >> 3) + 8 * j; const LAS float* s = scr + (8 * c) * 33 + n;
        v4u o; o.x = pg8::cvt_pk_bf16(s[0 * 33], s[1 * 33]); o.y = pg8::cvt_pk_bf16(s[2 * 33], s[3 * 33]); o.z = pg8::cvt_pk_bf16(s[4 * 33], s[5 * 33]); o.w = pg8::cvt_pk_bf16(s[6 * 33], s[7 * 33]);
        *(v4u*)(d.WT + (size_t)(d.n0 + n) * (d.K + WPAD) + d.k0 + 8 * c) = o; }
    LDS_WAIT();
}
__device__ __forceinline__ void fold_item(const float* __restrict__ W, bf16* __restrict__ WT, const float* __restrict__ wp, const float* __restrict__ ps, LAS float* scr, int item, int lane) {
    const int K = DM, N = DM; const int nblk = N / 32, g = item / nblk, nb = item % nblk, k0 = 64 * g, n0 = 32 * nb;
    LAS float* scr2 = scr + 64 * 33;
#pragma unroll 8
    for (int i = 0; i < 32; ++i) { const int kk = 2 * i + (lane >> 5); scr[kk * 33 + (lane & 31)] = W[(size_t)(k0 + kk) * N + n0 + (lane & 31)] * ps[k0 + kk]; }
    LDS_WAIT();
    const int n = lane & 31;
    for (int i = 0; i < 32; ++i) { const int kk = 2 * i + (lane >> 5); const float* wr = wp + (size_t)(g * 64 + kk) * 64; float a = 0.f;
#pragma unroll 16
        for (int d = 0; d < 64; ++d) a += wr[d] * scr[d * 33 + n];
        scr2[kk * 33 + n] = a; }
    LDS_WAIT();
    const int c = lane & 7;
#pragma unroll
    for (int j = 0; j < 4; ++j) { const int nn = (lane >> 3) + 8 * j; const LAS float* s = scr2 + (8 * c) * 33 + nn;
        v4u o; o.x = pk2(s[0 * 33], s[1 * 33]); o.y = pk2(s[2 * 33], s[3 * 33]); o.z = pk2(s[4 * 33], s[5 * 33]); o.w = pk2(s[6 * 33], s[7 * 33]);
        *(v4u*)(WT + (size_t)(n0 + nn) * (K + WPAD) + k0 + 8 * c) = o; }
    LDS_WAIT();
}
__device__ __forceinline__ void rms_row_to_bf16(const float* __restrict__ xrow, bf16* __restrict__ orow, float* __restrict__ rsp, int lane) {
    const f32x4* xr = (const f32x4*)xrow + lane;
    f32x4 v[4]; float s = 0.f;
#pragma unroll
    for (int j = 0; j < 4; ++j) { v[j] = xr[64 * j]; s += (v[j].x * v[j].x + v[j].y * v[j].y) + (v[j].z * v[j].z + v[j].w * v[j].w); }
    const float rstd = rsqrtf(wave_sum(s) * (1.f / DM) + EPS);
    if (lane == 0) *rsp = rstd;
    v2u* o8 = (v2u*)orow + lane;
#pragma unroll
    for (int j = 0; j < 4; ++j) { v2u o; o.x = pg8::cvt_pk_bf16(v[j].x, v[j].y); o.y = pg8::cvt_pk_bf16(v[j].z, v[j].w); o8[64 * j] = o; }
}
struct EwRow { f32x4 x[4]; v2u o[4]; };
__device__ __forceinline__ f32x4 unpack4(const v2u w) { return (f32x4){__uint_as_float(w.x << 16), __uint_as_float(w.x & 0xffff0000u), __uint_as_float(w.y << 16), __uint_as_float(w.y & 0xffff0000u)}; }
__device__ __forceinline__ void ew_load(EwRow& r, const float* __restrict__ xrow32, const bf16* __restrict__ xrow16, bool src16, const bf16* __restrict__ orow, int lane) {
    const v2u* orr = (const v2u*)orow + lane;
    if (src16) { const v2u* xr = (const v2u*)xrow16 + lane;
#pragma unroll
        for (int j = 0; j < 4; ++j) r.x[j] = unpack4(xr[64 * j]); }
    else { const f32x4* xr = (const f32x4*)xrow32 + lane;
#pragma unroll
        for (int j = 0; j < 4; ++j) r.x[j] = xr[64 * j]; }
#pragma unroll
    for (int j = 0; j < 4; ++j) r.o[j] = orr[64 * j];
}
__device__ __forceinline__ void ew_finish(EwRow& r, const f32x4 (&gg)[4], float* __restrict__ Xrow32, bf16* __restrict__ Xrow16, bool dst16, float* __restrict__ rsp, bool write_xn, int lane) {
    f32x4 o[4]; float so = 0.f;
#pragma unroll
    for (int j = 0; j < 4; ++j) { o[j] = unpack4(r.o[j]); so += (o[j].x * o[j].x + o[j].y * o[j].y) + (o[j].z * o[j].z + o[j].w * o[j].w); }
    const float rs = rsqrtf(wave_sum(so) * (1.f / DM) + EPS); float s1 = 0.f;
#pragma unroll
    for (int j = 0; j < 4; ++j) { f32x4 x = r.x[j] + o[j] * rs * gg[j]; r.x[j] = x; s1 += (x.x * x.x + x.y * x.y) + (x.z * x.z + x.w * x.w); }
    if (dst16) { v2u* Xr = (v2u*)Xrow16 + lane;
#pragma unroll
        for (int j = 0; j < 4; ++j) { v2u w; w.x = pg8::cvt_pk_bf16(r.x[j].x, r.x[j].y); w.y = pg8::cvt_pk_bf16(r.x[j].z, r.x[j].w); Xr[64 * j] = w; } }
    else { f32x4* Xr = (f32x4*)Xrow32 + lane;
#pragma unroll
        for (int j = 0; j < 4; ++j) Xr[64 * j] = r.x[j]; }
    if (write_xn) { const float r1 = rsqrtf(wave_sum(s1) * (1.f / DM) + EPS); if (lane == 0) *rsp = r1; }
}

template <bool SAMPLE>
__device__ __forceinline__ void pool_unit(const bf16* __restrict__ Z, bf16* __restrict__ CAT, const float* __restrict__ state, float* __restrict__ newp,
                                          int seq, int t0, int nrows, int g, int lane) {
    const int c = g * 64 + lane, w = 2 << g;
    const size_t rowbase = SAMPLE ? (size_t)MP + (size_t)seq * ST : (size_t)seq * SEQ;
    const bf16* zc = Z + rowbase * ZP + c;
    const float* st = state + (size_t)seq * 15 * GW + c;
#define POOL_A(e) ((e) >= 0 ? bf2f(zc[(size_t)(e) * ZP]) : (SAMPLE ? st[(15 + (e)) * GW] : 0.f))
    float S = 0.f;
    for (int j = 1; j < w; ++j) S += POOL_A(t0 - j);
#pragma unroll 4
    for (int t = t0; t < t0 + nrows; ++t) {
        const float a = POOL_A(t); S += a;
        const float cnt = SAMPLE ? (float)w : (float)(t + 1 < w ? t + 1 : w);
        CAT[(rowbase + t) * DP + c] = (bf16)f2bf(S / cnt - a);
        const int e = t - w + 1; S -= POOL_A(e);
    }
    const int T = SAMPLE ? ST : SEQ;
    if (t0 + nrows == T) {
        for (int j = 0; j < 15; ++j) { const int e = T - 15 + j; newp[((size_t)seq * 15 + j) * GW + c] = POOL_A(e); }
    }
#undef POOL_A
}
template <bool SAMPLE>
__device__ __forceinline__ void short_unit(const bf16* __restrict__ Z, bf16* __restrict__ CAT, const float* __restrict__ state, float* __restrict__ news,
                                           const float* __restrict__ sw, int seq, int t0, int nrows, int h, int lane) {
    const int c = h * 64 + lane;
    const size_t rowbase = SAMPLE ? (size_t)MP + (size_t)seq * ST : (size_t)seq * SEQ;
    const bf16* zc = Z + rowbase * ZP + c;
    const float* st = state + (size_t)seq * 2 * GW + c;
    const float w0 = sw[c], w1 = sw[GW + c], w2 = sw[2 * GW + c];
#define SH_E(e) ((e) >= 0 ? bf2f(zc[(size_t)(e) * ZP + 1536]) * bf2f(zc[(size_t)(e) * ZP + 1792]) : (SAMPLE ? st[(2 + (e)) * GW] : 0.f))
    float e2 = SH_E(t0 - 2), e1 = SH_E(t0 - 1);
#pragma unroll 4
    for (int t = t0; t < t0 + nrows; ++t) {
        const float e0 = SH_E(t); const float bg = bf2f(zc[(size_t)t * ZP + 1280]);
        CAT[(rowbase + t) * DP + 768 + c] = (bf16)f2bf(bg * (w0 * e2 + w1 * e1 + w2 * e0));
        e2 = e1; e1 = e0;
    }
    const int T = SAMPLE ? ST : SEQ;
    if (t0 + nrows == T) { news[((size_t)seq * 2 + 0) * GW + c] = e2; news[((size_t)seq * 2 + 1) * GW + c] = e1; }
#undef SH_E
}
template <bool SAMPLE>
__device__ __forceinline__ void conv_unit(const bf16* __restrict__ Z, bf16* __restrict__ CAT, const float* __restrict__ state, float* __restrict__ newc,
                                          const float* __restrict__ cw, const float* __restrict__ cb, const float* __restrict__ lg, const float* __restrict__ lb,
                                          int seq, int t0, int nrows, int h, LAS float* gL, int lane) {
    const int c = h * 64 + lane;
    const size_t rowbase = SAMPLE ? (size_t)MP + (size_t)seq * ST : (size_t)seq * SEQ;
    const bf16* zc = Z + rowbase * ZP + c;
    bf16* oc = CAT + rowbase * DP + 256 + c;
    const int T = SAMPLE ? ST : SEQ;
    const bool last = (t0 + nrows == T);
    const int nin = nrows + 30;
#pragma unroll 4
    for (int r = 0; r < nin; ++r) { const int s = t0 - 30 + r; float gs = 0.f;
        if (s >= 0) { const unsigned off = (unsigned)s * ZP; const float p = bf2f(zc[off + 256]), gt = bf2f(zc[off + 512]); gs = p * sigm(gt); }
        else if (SAMPLE) gs = state[((size_t)seq * 30 + 30 + s) * GW + c];
        if (last && s >= T - 30) newc[((size_t)seq * 30 + (s - (T - 30))) * GW + c] = gs;
        gL[r * 64 + lane] = gs; }
    LDS_WAIT();
    float wk[31];
#pragma unroll
    for (int k = 0; k < 31; ++k) wk[k] = cw[k * GW + c];
    const float bias = cb[c], gg = lg[c], bb = lb[c];
#pragma unroll 1
    for (int tq = 0; tq < nrows; tq += 4) {
        float acc[4] = {bias, bias, bias, bias};
#pragma unroll
        for (int r = 0; r < 34; ++r) { const float gv = gL[(tq + r) * 64 + lane];
#pragma unroll
            for (int q = 0; q < 4; ++q) { const int k = r - q; if (k >= 0 && k <= 30) acc[q] += wk[k] * gv; } }
#pragma unroll
        for (int q = 0; q < 4; ++q) { const float cv = acc[q];
            const float mean = wave_sum(cv) * (1.f / 64.f); const float d = cv - mean;
            const float var = wave_sum(d * d) * (1.f / 64.f);
            const float y = d * rsqrtf(var + EPS) * gg + bb;
            oc[(unsigned)(t0 + tq + q) * DP] = (bf16)f2bf(y * sigm(y)); }
    }
    LDS_WAIT();
}
template <int W>
__device__ __forceinline__ void pool_unit_p(const bf16* __restrict__ Z, bf16* __restrict__ CAT, float* __restrict__ newp, int seq, int t0, int g, int lane) {
    const int rr = lane >> 3, cg = lane & 7, c0 = g * 64 + cg * 8, tb = t0 + rr * 8;
    const size_t rowbase = (size_t)seq * SEQ;
    const bf16* zb = Z + (rowbase + tb) * ZP + c0;
    v4u raw[W + 7];
#pragma unroll
    for (int j = 0; j < W + 7; ++j) { const int dj = j - (W - 1); raw[j] = (tb + dj >= 0) ? ld16(zb + (long)dj * ZP) : (v4u){0u, 0u, 0u, 0u}; }
    float S[8];
#pragma unroll
    for (int i = 0; i < 8; ++i) S[i] = 0.f;
#pragma unroll
    for (int j = 0; j < W - 1; ++j) { float f[8]; unpack8(raw[j], f);
#pragma unroll
        for (int i = 0; i < 8; ++i) S[i] += f[i]; }
    bf16* ob = CAT + (rowbase + tb) * DP + c0;
    const bool lastseg = (t0 + 64 == SEQ);
#pragma unroll
    for (int j = 0; j < 8; ++j) { float a[8], o[8], od[8]; unpack8(raw[j + W - 1], a); unpack8(raw[j], od);
        const int t = tb + j; const float inv = 1.f / (float)(t + 1 < W ? t + 1 : W);
#pragma unroll
        for (int i = 0; i < 8; ++i) { S[i] += a[i]; o[i] = S[i] * inv - a[i]; S[i] -= od[i]; }
        *(v4u*)(ob + j * DP) = pack8(o);
        if (lastseg && t >= SEQ - 15) { float* np = newp + ((size_t)seq * 15 + (t - (SEQ - 15))) * GW + c0; *(f32x4*)np = (f32x4){a[0], a[1], a[2], a[3]}; *(f32x4*)(np + 4) = (f32x4){a[4], a[5], a[6], a[7]}; }
    }
}
__device__ __forceinline__ void short_unit_p(const bf16* __restrict__ Z, bf16* __restrict__ CAT, float* __restrict__ news, const float* __restrict__ sw, int seq, int t0, int h, int lane) {
    const int rr = lane >> 3, cg = lane & 7, c0 = h * 64 + cg * 8, tb = t0 + rr * 8;
    const size_t rowbase = (size_t)seq * SEQ;
    const bf16* zb = Z + (rowbase + tb) * ZP + c0;
    v4u Bv[8], Cv[10], Hv[10];
#pragma unroll
    for (int j = 0; j < 10; ++j) { const int dj = j - 2; const bool ok = (tb + dj >= 0);
        Cv[j] = ok ? ld16(zb + (long)dj * ZP + 1536) : (v4u){0u, 0u, 0u, 0u}; Hv[j] = ok ? ld16(zb + (long)dj * ZP + 1792) : (v4u){0u, 0u, 0u, 0u};
        if (j >= 2) Bv[j - 2] = ld16(zb + (long)dj * ZP + 1280); }
    float w0[8], w1[8], w2[8];
#pragma unroll
    for (int i = 0; i < 8; ++i) { w0[i] = sw[c0 + i]; w1[i] = sw[GW + c0 + i]; w2[i] = sw[2 * GW + c0 + i]; }
    float e2[8], e1[8];
    { float c[8], hh[8]; unpack8(Cv[0], c); unpack8(Hv[0], hh);
#pragma unroll
      for (int i = 0; i < 8; ++i) e2[i] = c[i] * hh[i];
      unpack8(Cv[1], c); unpack8(Hv[1], hh);
#pragma unroll
      for (int i = 0; i < 8; ++i) e1[i] = c[i] * hh[i]; }
    bf16* ob = CAT + (rowbase + tb) * DP + 768 + c0;
#pragma unroll
    for (int j = 0; j < 8; ++j) { float c[8], hh[8], b[8], o[8]; unpack8(Cv[j + 2], c); unpack8(Hv[j + 2], hh); unpack8(Bv[j], b);
#pragma unroll
        for (int i = 0; i < 8; ++i) { const float e0 = c[i] * hh[i]; o[i] = b[i] * (w0[i] * e2[i] + w1[i] * e1[i] + w2[i] * e0); e2[i] = e1[i]; e1[i] = e0; }
        *(v4u*)(ob + j * DP) = pack8(o); }
    if (t0 + 64 == SEQ && rr == 7) { float* np = news + (size_t)seq * 2 * GW + c0;
        *(f32x4*)np = (f32x4){e2[0], e2[1], e2[2], e2[3]}; *(f32x4*)(np + 4) = (f32x4){e2[4], e2[5], e2[6], e2[7]};
        *(f32x4*)(np + GW) = (f32x4){e1[0], e1[1], e1[2], e1[3]}; *(f32x4*)(np + GW + 4) = (f32x4){e1[4], e1[5], e1[6], e1[7]}; }
}
__device__ __forceinline__ void conv_unit_p(const bf16* __restrict__ Z, bf16* __restrict__ CAT, float* __restrict__ newc,
                                            const float* __restrict__ cw, const float* __restrict__ cb, const float* __restrict__ lg, const float* __restrict__ lb,
                                            int seq, int t0, int h, LAS float* gL, int lane) {
    const int rr = lane >> 3, cg = lane & 7, c0 = h * 64 + cg * 8;
    const size_t rowbase = (size_t)seq * SEQ;
    const bool last = (t0 + 32 == SEQ);
    { v4u pv[8], gv[8];
#pragma unroll
      for (int j = 0; j < 8; ++j) { const int r = 8 * j + rr, sx = t0 - 30 + r; const bool ok = (sx >= 0 && r < 62);
          const bf16* zp = Z + (rowbase + (ok ? sx : 0)) * ZP + c0;
          pv[j] = ok ? ld16(zp + 256) : (v4u){0u, 0u, 0u, 0u}; gv[j] = ok ? ld16(zp + 512) : (v4u){0u, 0u, 0u, 0u}; }
#pragma unroll
      for (int j = 0; j < 8; ++j) { const int r = 8 * j + rr, sx = t0 - 30 + r; float p[8], gt[8]; unpack8(pv[j], p); unpack8(gv[j], gt);
#pragma unroll
          for (int i = 0; i < 8; ++i) p[i] = p[i] * sigm(gt[i]);
          if (r < 62) { *(LAS f32x4*)(gL + r * 64 + cg * 8) = (f32x4){p[0], p[1], p[2], p[3]}; *(LAS f32x4*)(gL + r * 64 + cg * 8 + 4) = (f32x4){p[4], p[5], p[6], p[7]}; }
          if (last && sx >= SEQ - 30 && r < 62) { float* np = newc + ((size_t)seq * 30 + (sx - (SEQ - 30))) * GW + c0; *(f32x4*)np = (f32x4){p[0], p[1], p[2], p[3]}; *(f32x4*)(np + 4) = (f32x4){p[4], p[5], p[6], p[7]}; } }
    }
    LDS_WAIT();
    const int c = h * 64 + lane;
    float wk[31];
#pragma unroll
    for (int k = 0; k < 31; ++k) wk[k] = cw[k * GW + c];
    const float bias = cb[c];
#pragma unroll 1
    for (int tq = 0; tq < 32; tq += 4) {
        float acc[4] = {bias, bias, bias, bias};
#pragma unroll
        for (int r = 0; r < 34; ++r) { const float gvv = gL[(tq + r) * 64 + lane];
#pragma unroll
            for (int q = 0; q < 4; ++q) { const int k = r - q; if (k >= 0 && k <= 30) acc[q] += wk[k] * gvv; } }
        LDS_WAIT();
#pragma unroll
        for (int q = 0; q < 4; ++q) gL[(tq + q) * 64 + lane] = acc[q];
    }
    LDS_WAIT();
    float gg[8], bb[8];
#pragma unroll
    for (int i = 0; i < 8; ++i) { gg[i] = lg[c0 + i]; bb[i] = lb[c0 + i]; }
    bf16* ob = CAT + (rowbase + t0) * DP + 256 + c0;
#pragma unroll
    for (int j = 0; j < 4; ++j) { const int r = 8 * j + rr; const f32x4 a = *(const LAS f32x4*)(gL + r * 64 + cg * 8), b = *(const LAS f32x4*)(gL + r * 64 + cg * 8 + 4);
        float x[8] = {a[0], a[1], a[2], a[3], b[0], b[1], b[2], b[3]};
        const float mean = sum8(((x[0] + x[1]) + (x[2] + x[3])) + ((x[4] + x[5]) + (x[6] + x[7]))) * (1.f / 64.f);
        float q = 0.f;
#pragma unroll
        for (int i = 0; i < 8; ++i) { x[i] -= mean; q += x[i] * x[i]; }
        const float rstd = rsqrtf(sum8(q) * (1.f / 64.f) + EPS);
#pragma unroll
        for (int i = 0; i < 8; ++i) { const float yy = x[i] * rstd * gg[i] + bb[i]; x[i] = yy * sigm(yy); }
        *(v4u*)(ob + r * DP) = pack8(x); }
    LDS_WAIT();
}
__device__ __forceinline__ int sgu_swz(int c, int chunk) { return (chunk ^ ((c & 15) ^ (c >> 4))) << 3; }
__device__ __forceinline__ void sgu_unit(const bf16* __restrict__ Z, bf16* __restrict__ CAT, const bf16* __restrict__ Wb, const float* __restrict__ lg, const float* __restrict__ lb,
                                         const float* __restrict__ sb, int chunk, int h, LAS bf16* vT, int lane) {
    const size_t r0 = (size_t)chunk * 128;
    { const int rr = lane >> 3, cg = lane & 7, c0 = h * 64 + cg * 8;
      float gg[8], bb[8];
#pragma unroll
      for (int i = 0; i < 8; ++i) { gg[i] = lg[c0 + i]; bb[i] = lb[c0 + i]; }
#pragma unroll 1
      for (int jh = 0; jh < 16; jh += 8) {
          v4u raw[8];
#pragma unroll
          for (int j = 0; j < 8; ++j) raw[j] = ld16(Z + (r0 + 8 * (jh + j) + rr) * ZP + 1024 + c0);
#pragma unroll
          for (int j = 0; j < 8; ++j) { float x[8]; unpack8(raw[j], x);
              float sm = ((x[0] + x[1]) + (x[2] + x[3])) + ((x[4] + x[5]) + (x[6] + x[7])); const float mean = sum8(sm) * (1.f / 64.f);
              float q = 0.f;
#pragma unroll
              for (int i = 0; i < 8; ++i) { x[i] -= mean; q += x[i] * x[i]; }
              const float rstd = rsqrtf(sum8(q) * (1.f / 64.f) + EPS);
#pragma unroll
              for (int i = 0; i < 8; ++i) { const int cl = cg * 8 + i; vT[cl * 128 + sgu_swz(cl, jh + j) + rr] = (bf16)f2bf(x[i] * rstd * gg[i] + bb[i]); } }
      }
    }
    LDS_WAIT();
    const int fr = lane & 15, fq = lane >> 4;
    bf16x8 wf[8][4];
#pragma unroll
    for (int mt = 0; mt < 8; ++mt)
#pragma unroll
        for (int ks = 0; ks < 4; ++ks) if (ks * 32 <= mt * 16 + 15) wf[mt][ks] = *(const bf16x8*)(Wb + ((size_t)(h * 128 + mt * 16 + fr) * 128 + ks * 32 + fq * 8));
#pragma unroll
    for (int mt = 0; mt < 8; ++mt) {
        f32x4 acc[4];
#pragma unroll
        for (int nt = 0; nt < 4; ++nt) acc[nt] = (f32x4){0.f, 0.f, 0.f, 0.f};
        const int t = mt * 16 + fr;
        v2u uv[4];
#pragma unroll
        for (int nt = 0; nt < 4; ++nt) uv[nt] = *(const v2u*)(Z + (r0 + t) * ZP + 768 + h * 64 + nt * 16 + 4 * fq);
        const float bt = sb[h * 128 + t];
#pragma unroll
        for (int ks = 0; ks < 4; ++ks) if (ks * 32 <= mt * 16 + 15) {
#pragma unroll
            for (int nt = 0; nt < 4; ++nt) { const int cl = nt * 16 + fr; const bf16x8 vf = *(const LAS bf16x8*)(vT + cl * 128 + sgu_swz(cl, ks * 4 + fq));
                acc[nt] = __builtin_amdgcn_mfma_f32_16x16x32_bf16(vf, wf[mt][ks], acc[nt], 0, 0, 0); }
        }
#pragma unroll
        for (int nt = 0; nt < 4; ++nt) { const float u0 = __uint_as_float(uv[nt].x << 16), u1 = __uint_as_float(uv[nt].x & 0xffff0000u), u2 = __uint_as_float(uv[nt].y << 16), u3 = __uint_as_float(uv[nt].y & 0xffff0000u);
            v2u w; w.x = pg8::cvt_pk_bf16(u0 * (acc[nt][0] + bt), u1 * (acc[nt][1] + bt)); w.y = pg8::cvt_pk_bf16(u2 * (acc[nt][2] + bt), u3 * (acc[nt][3] + bt));
            *(v2u*)(CAT + (r0 + t) * DP + 512 + h * 64 + nt * 16 + 4 * fq) = w; }
    }
    LDS_WAIT();
}
__device__ __forceinline__ void sgu_sample_unit(const bf16* __restrict__ Z, bf16* __restrict__ CAT, const float* __restrict__ Wf, const float* __restrict__ lg, const float* __restrict__ lb,
                                                const float* __restrict__ sb, float* __restrict__ vout, int seq, int h, int lane) {
    const int c = h * 64 + lane; const size_t rowbase = (size_t)MP + (size_t)seq * ST;
    const float gg = lg[c], bb = lb[c];
    float vn[ST];
#pragma unroll
    for (int t = 0; t < ST; ++t) { const float v = bf2f(Z[(rowbase + t) * ZP + 1024 + c]); const float mean = wave_sum(v) * (1.f / 64.f); const float d = v - mean; const float var = wave_sum(d * d) * (1.f / 64.f);
        vn[t] = d * rsqrtf(var + EPS) * gg + bb; vout[((size_t)seq * ST + t) * GW + c] = vn[t]; }
#pragma unroll
    for (int t = 0; t < ST; ++t) { float sv = sb[h * 128 + t];
#pragma unroll
        for (int s = 0; s <= t; ++s) sv += Wf[((size_t)h * 128 + t) * 128 + s] * vn[s];
        const float u = bf2f(Z[(rowbase + t) * ZP + 768 + c]);
        CAT[(rowbase + t) * DP + 512 + c] = (bf16)f2bf(u * sv); }
}

#define XB_TMO      128
#define XB_XCNT(j)  (256  + 64 * (j))
#define XB_XSUB(j)  (1280 + 64 * (j))
#define XB_XGEN(j)  (2304 + 64 * (j))
#define XB_TOP      3328
#define XB_TOPGEN   3392
#define XCD_BAR_WORDS 3456
#define XB_SPIN_CAP (1u << 18)

__device__ __forceinline__ unsigned xb_ld(unsigned* p)              { return __hip_atomic_load(p, __ATOMIC_RELAXED, __HIP_MEMORY_SCOPE_AGENT); }
__device__ __forceinline__ unsigned xb_add(unsigned* p, unsigned v) { return __hip_atomic_fetch_add(p, v, __ATOMIC_RELAXED, __HIP_MEMORY_SCOPE_AGENT); }
__device__ __forceinline__ unsigned xb_xcc_id() { return (unsigned)__builtin_amdgcn_s_getreg((3 << 11) | 20) & 0xFu; }
#define XB_SPIN(cond, bar) do { unsigned _sp = 0; while (cond) { __builtin_amdgcn_s_sleep(1); \
    if ((++_sp & 255u) == 0u) { if (xb_ld(&(bar)[XB_TMO])) break; if (_sp > XB_SPIN_CAP) { atomicAdd(&(bar)[XB_TMO], 1u); break; } } } } while (0)

struct XcdBarrier {
    unsigned* bar; unsigned x;
    volatile LAS unsigned* st;
};

__device__ __forceinline__ XcdBarrier xcd_barrier_post(unsigned* bar, volatile LAS unsigned* st) {
    XcdBarrier b; b.bar = bar; b.x = xb_xcc_id(); b.st = st;
    if (threadIdx.x == 0) (void)xb_add(&bar[XB_XCNT(b.x)], 1u);
    return b;
}
__device__ __forceinline__ void xcd_barrier_complete(unsigned* bar, unsigned x, unsigned& nloc, unsigned& nx) {
    const unsigned G = gridDim.x * gridDim.y * gridDim.z;
    unsigned sum, cnt, mine, sp = 0u;
    for (;;) {
        sum = 0u; cnt = 0u; mine = 0u;
#pragma unroll
        for (unsigned j = 0; j < 16; ++j) { const unsigned c = xb_ld(&bar[XB_XCNT(j)]); sum += c; cnt += (c > 0u) ? 1u : 0u; mine = (j == x) ? c : mine; }
        if (sum == G) break;
        __builtin_amdgcn_s_sleep(1);
        if ((++sp & 255u) == 0u) { if (xb_ld(&bar[XB_TMO])) break; if (sp > XB_SPIN_CAP) { atomicAdd(&bar[XB_TMO], 1u); break; } }
    }
    nloc = mine > 0u ? mine : 1u; nx = cnt > 0u ? cnt : 1u;
}

__device__ __forceinline__ void xcd_barrier(const XcdBarrier& b) {
    asm volatile("s_waitcnt vmcnt(0)" ::: "memory");
    __syncthreads();
    if (threadIdx.x == 0) {
        unsigned* bar = b.bar;
        __builtin_amdgcn_s_waitcnt(0);
        unsigned nloc = b.st[0], nx = b.st[1];
        if (nloc == 0u) { xcd_barrier_complete(bar, b.x, nloc, nx); b.st[0] = nloc; b.st[1] = nx; }
        const unsigned old = xb_add(&bar[XB_XSUB(b.x)], 1u);
        const unsigned gen = old / nloc;
        if (old + 1u == (gen + 1u) * nloc) {
            __builtin_amdgcn_fence(__ATOMIC_RELEASE, "agent");
            asm volatile("s_waitcnt vmcnt(0)" ::: "memory");
            const unsigned og = xb_add(&bar[XB_TOP], 1u);
            const unsigned tg = og / nx;
            if (og + 1u == (tg + 1u) * nx) xb_add(&bar[XB_TOPGEN], 1u);
            else XB_SPIN(xb_ld(&bar[XB_TOPGEN]) == tg, bar);
            __builtin_amdgcn_fence(__ATOMIC_ACQUIRE, "agent");
            xb_add(&bar[XB_XGEN(b.x)], 1u);
            asm volatile("s_waitcnt vmcnt(0)" ::: "memory");
        } else {
            XB_SPIN(xb_ld(&bar[XB_XGEN(b.x)]) == gen, bar);
            __builtin_amdgcn_fence(__ATOMIC_ACQUIRE, "agent");
            asm volatile("s_waitcnt vmcnt(0)" ::: "memory");
        }
    }
    __syncthreads();
}

template <int NT, int ACT, int K>
__device__ __forceinline__ void small_gemm_tile(LAS unsigned char* lds, const bf16* __restrict__ A, const bf16* __restrict__ Bt, bf16* __restrict__ O, int ldc, int lda, int ldb, const float* __restrict__ rs, int m0, int n0, int tid) {
    constexpr int NC = 16 * NT, KW = K / 8, NCH = KW / 128;
    const int wave = __builtin_amdgcn_readfirstlane(tid >> 6), lane = tid & 63, fr = lane & 15, fq = lane >> 4;
    const bf16* ap = A + (size_t)(m0 + fr) * lda + wave * KW + fq * 8;
    const bf16* bp = Bt + (size_t)(n0 + fr) * ldb + wave * KW + fq * 8;
    f32x4 acc[4][NT];
#pragma unroll
    for (int m = 0; m < 4; ++m)
#pragma unroll
        for (int n = 0; n < NT; ++n) acc[m][n] = (f32x4){0.f, 0.f, 0.f, 0.f};
    if constexpr (NCH == 1) {
        bf16x8 fa[4][4], fb[4][NT];
#pragma unroll
        for (int s_ = 0; s_ < 4; ++s_) {
#pragma unroll
            for (int m = 0; m < 4; ++m) fa[s_][m] = *(const bf16x8*)(ap + (size_t)m * 16 * lda + s_ * 32);
#pragma unroll
            for (int n = 0; n < NT; ++n) fb[s_][n] = *(const bf16x8*)(bp + (size_t)n * 16 * ldb + s_ * 32); }
        __builtin_amdgcn_sched_barrier(0);
#pragma unroll
        for (int s_ = 0; s_ < 4; ++s_)
#pragma unroll
            for (int m = 0; m < 4; ++m)
#pragma unroll
                for (int n = 0; n < NT; ++n) acc[m][n] = __builtin_amdgcn_mfma_f32_16x16x32_bf16(fa[s_][m], fb[s_][n], acc[m][n], 0, 0, 0);
        __builtin_amdgcn_sched_barrier(0);
    } else {
        constexpr int NC2 = KW / 64;
        bf16x8 fa[3][2][4], fb[3][2][NT];
#define SG_LD(buf, c) do { _Pragma("unroll") for (int s_ = 0; s_ < 2; ++s_) { \
            _Pragma("unroll") for (int m = 0; m < 4; ++m) fa[buf][s_][m] = *(const bf16x8*)(ap + (size_t)m * 16 * lda + (c) * 64 + s_ * 32); \
            _Pragma("unroll") for (int n = 0; n < NT; ++n) fb[buf][s_][n] = *(const bf16x8*)(bp + (size_t)n * 16 * ldb + (c) * 64 + s_ * 32); } } while (0)
        SG_LD(0, 0); SG_LD(1, 1);
        __builtin_amdgcn_sched_barrier(0);
#pragma unroll
        for (int c = 0; c < NC2; ++c) {
            if (c + 2 < NC2) SG_LD((c + 2) % 3, c + 2);
            __builtin_amdgcn_sched_barrier(0);
#pragma unroll
            for (int s_ = 0; s_ < 2; ++s_)
#pragma unroll
                for (int m = 0; m < 4; ++m)
#pragma unroll
                    for (int n = 0; n < NT; ++n) acc[m][n] = __builtin_amdgcn_mfma_f32_16x16x32_bf16(fa[c % 3][s_][m], fb[c % 3][s_][n], acc[m][n], 0, 0, 0);
            __builtin_amdgcn_sched_barrier(0);
        }
#undef SG_LD
    }
    LAS float* P = (LAS float*)lds + wave * (64 * NC);
#pragma unroll
    for (int m = 0; m < 4; ++m)
#pragma unroll
        for (int n = 0; n < NT; ++n)
#pragma unroll
            for (int i = 0; i < 4; ++i) P[(m * 16 + fq * 4 + i) * NC + n * 16 + fr] = acc[m][n][i];
    __syncthreads();
    constexpr int EPT = 64 * NC / 512;
    const int e0 = tid * EPT, row = e0 / NC, col = e0 % NC;
    float r[EPT];
#pragma unroll
    for (int j = 0; j < EPT; ++j) r[j] = 0.f;
#pragma unroll
    for (int w = 0; w < 8; ++w) { const LAS f32x4* q = (const LAS f32x4*)((LAS float*)lds + w * (64 * NC) + e0);
#pragma unroll
        for (int j = 0; j < EPT / 4; ++j) { const f32x4 v = q[j]; r[4 * j] += v[0]; r[4 * j + 1] += v[1]; r[4 * j + 2] += v[2]; r[4 * j + 3] += v[3]; } }
    if (rs) { const float sc = rs[m0 + row];
#pragma unroll
        for (int j = 0; j < EPT; ++j) r[j] *= sc; }
    if (ACT == 1) {
#pragma unroll
        for (int j = 0; j < EPT; ++j) { const float t = fmaxf(r[j], 0.f); r[j] = t * t; } }
    bf16* op = O + (size_t)(m0 + row) * ldc + n0 + col;
    if (EPT == 8) { v4u w; w.x = pk2(r[0], r[1]); w.y = pk2(r[2], r[3]); w.z = pk2(r[4 % EPT], r[5 % EPT]); w.w = pk2(r[6 % EPT], r[7 % EPT]); *(v4u*)op = w; }
    else { v2u w; w.x = pk2(r[0], r[1]); w.y = pk2(r[2], r[3]); *(v2u*)op = w; }
    __syncthreads();
}

#define SMALL_TN(j, ntn) ((((j) >> 8) * 32 + ((j) & 7) * 4 + (((j) >> 3) & 3)))
constexpr int NPH = 15;
#ifndef REP_PRO
#define REP_PRO 1
#endif
#ifndef REP_GEMM
#define REP_GEMM 1
#endif
#ifndef REP_MIX
#define REP_MIX 1
#endif
#ifndef REP_SYNC
#define REP_SYNC 1
#endif
struct Args { const float* in[24]; float* out; unsigned char* ws; int ph_lo, ph_hi; };
__global__ void __launch_bounds__(NWAVES * 64, 2) hybrid_fwd(Args args) {
    extern __shared__ __attribute__((aligned(16))) unsigned char lds_raw[];
    LAS unsigned char* lds = (LAS unsigned char*)lds_raw;
    volatile LAS unsigned* MISC = (volatile LAS unsigned*)(lds + MISC_OFF);
    if (threadIdx.x < 64) MISC[threadIdx.x] = 0u;
    __syncthreads();
    (void)xcd_barrier_post((unsigned*)(args.ws + WS_CTL), MISC + 8);
    for (int ph = args.ph_lo; ph < args.ph_hi;) {
        int tid = threadIdx.x; asm volatile("" : "+v"(tid));
        const int lane = tid & 63, wave = __builtin_amdgcn_readfirstlane(tid >> 6);
        const int G = gridDim.x; const int bx = blockIdx.x;
        unsigned char* ws = args.ws;
        if (ph == 0) {
            const int vcu = (G % 8 == 0) ? (bx % 8) * (G / 8) + bx / 8 : bx; const int gw = vcu * NWAVES + wave, NGW = G * NWAVES;
            LAS float* scr = (LAS float*)(lds + wave * WAVE_SCR);
            bf16* XN = (bf16*)(ws + WS_XN); bf16* SGW = (bf16*)(ws + WS_SGUW);
            constexpr int I_FOLD = 4 * (DM / 32), I_OUT = (DM / 64) * (DM / 32) - I_FOLD, I_IN = (DM / 64) * (INW / 32), I_UP = (DM / 64) * (FF / 32), I_DN = (FF / 64) * (DM / 32);
            constexpr int I_LAYER = I_OUT + I_IN + I_UP + I_DN, I_ALL = DEPTH * I_LAYER;
            for (int it = gw; it < DEPTH * I_FOLD; it += NGW) { const int l = it / I_FOLD, r = it % I_FOLD;
                fold_item(args.in[10] + (size_t)l * DM * DM, (bf16*)(ws + WS_W + (size_t)l * W_LAYER + W_OUT), args.in[11] + (size_t)l * 4 * 64 * 64, args.in[12] + (size_t)l * GW, scr, r, lane); }
#define TR_DECODE(it_, d_) do { const int l_ = (it_) / I_LAYER; int r_ = (it_) % I_LAYER; unsigned char* wl_ = ws + WS_W + (size_t)l_ * W_LAYER; int nblk_; \
                if (r_ < I_OUT) { r_ += I_FOLD; d_.W = args.in[10] + (size_t)l_ * DM * DM; d_.WT = (bf16*)(wl_ + W_OUT); d_.gk = nullptr; d_.K = DM; d_.N = DM; } \
                else if ((r_ -= I_OUT) < I_IN) { d_.W = args.in[9] + (size_t)l_ * DM * INW; d_.WT = (bf16*)(wl_ + W_IN); d_.gk = args.in[5] + (size_t)l_ * DM; d_.K = DM; d_.N = INW; } \
                else if ((r_ -= I_IN) < I_UP) { d_.W = args.in[22] + (size_t)l_ * DM * FF; d_.WT = (bf16*)(wl_ + W_UP); d_.gk = args.in[7] + (size_t)l_ * DM; d_.K = DM; d_.N = FF; } \
                else { r_ -= I_UP; d_.W = args.in[23] + (size_t)l_ * FF * DM; d_.WT = (bf16*)(wl_ + W_DN); d_.gk = nullptr; d_.K = FF; d_.N = DM; } \
                nblk_ = d_.N / 32; d_.k0 = 64 * (r_ / nblk_); d_.n0 = 32 * (r_ % nblk_); } while (0)
            { int it = NGW - 1 - gw;
              if (it < I_ALL) {
                TrDesc dc; TR_DECODE(it, dc);
                float va[32], vb[32];
                tr_load(va, dc, lane);
#pragma unroll 1
                for (;;) {
                    const int itn = it + NGW; const bool more = itn < I_ALL;
                    TrDesc dn; { const int q = more ? itn : it; TR_DECODE(q, dn); }
                    tr_load(vb, dn, lane);
                    tr_store(va, dc, scr, lane);
                    if (!more) break;
#pragma unroll
                    for (int i = 0; i < 32; ++i) va[i] = vb[i];
                    dc = dn; it = itn;
                }
              }
            }
#undef TR_DECODE
            for (int m = gw; m < MT; m += NGW) rms_row_to_bf16(m < MP ? args.in[0] + (size_t)m * DM : args.in[1] + (size_t)(m - MP) * DM, (bf16*)args.out + (size_t)m * 2 * DM, (float*)(ws + WS_RS) + m, lane);
            for (int e = bx * (NWAVES * 64) + tid; e < DEPTH * 4 * 128 * 128; e += G * NWAVES * 64) { const int t = (e >> 7) & 127, s = e & 127; SGW[e] = (bf16)(s <= t ? f2bf(args.in[19][e]) : 0u); }
        } else {
            const int l = (ph - 1) / 7, k = (ph - 1) - 7 * l;
            unsigned char* wl = ws + WS_W + (size_t)l * W_LAYER;
            if (k == 0 || k == 2 || k == 5) {
                const bf16* A = k == 0 ? (const bf16*)args.out : (const bf16*)(ws + (k == 2 ? WS_CAT : WS_H));
                const bf16* Bt = (const bf16*)(wl + (k == 0 ? W_IN : k == 2 ? W_OUT : W_DN));
                bf16* O = (bf16*)(ws + (k == 0 ? WS_Z : WS_O));
                const int N = k == 0 ? INW : DM, K = k == 5 ? FF : DM;
                pg8::Gemm g{A, Bt, MP, N, K, k == 5 ? FP : k == 0 ? 2 * DM : DP, K + WPAD}; pg8::StaticOrder S; S.init(MP, N, G, bx);
                pg8::EpiBf16<0> E{O, k == 0 ? ZP : OP, k == 0 ? (const float*)(ws + WS_RS) : nullptr};
                pg8::gemm_phase<pg8::EpiBf16<0>, pg8::StaticOrder, true, true>(lds, g, S, E, tid);
                if (k == 0) { for (int j = bx; j < (MS / 64) * (INW / 64); j += G) small_gemm_tile<4, 0, DM>(lds, A, Bt, O, ZP, 2 * DM, DM + WPAD, (const float*)(ws + WS_RS), MP + ((j >> 5) & 7) * 64, SMALL_TN(j, INW / 64) * 64, tid); }
                else { for (int j = bx; j < (MS / 64) * (DM / 32); j += G) { if (k == 2) small_gemm_tile<2, 0, DM>(lds, A, Bt, O, OP, DP, DM + WPAD, nullptr, MP + ((j >> 5) & 7) * 64, SMALL_TN(j, DM / 32) * 32, tid); else small_gemm_tile<2, 0, FF>(lds, A, Bt, O, OP, FP, FF + WPAD, nullptr, MP + ((j >> 5) & 7) * 64, SMALL_TN(j, DM / 32) * 32, tid); } }
            } else if (k == 4) {
                pg8::Gemm g{(const bf16*)args.out, (const bf16*)(wl + W_UP), MP, FF, DM, 2 * DM, DM + WPAD}; pg8::StaticOrder S; S.init(MP, FF, G, bx);
                pg8::EpiBf16<1> E{(bf16*)(ws + WS_H), FP, (const float*)(ws + WS_RS)};
                pg8::gemm_phase<pg8::EpiBf16<1>, pg8::StaticOrder, true, true>(lds, g, S, E, tid);
                for (int j = bx; j < (MS / 64) * (FF / 64); j += G) small_gemm_tile<4, 1, DM>(lds, (const bf16*)args.out, (const bf16*)(wl + W_UP), (bf16*)(ws + WS_H), FP, 2 * DM, DM + WPAD, (const float*)(ws + WS_RS), MP + ((j >> 5) & 7) * 64, SMALL_TN(j, FF / 64) * 64, tid);
            } else if (k == 1) {
                const int vcu = (G % 8 == 0) ? (bx % 8) * (G / 8) + bx / 8 : bx; const int gw = vcu * NWAVES + wave, NGW = G * NWAVES;
                LAS float* scr = (LAS float*)(lds + wave * WAVE_SCR);
                const bf16* ZB = (const bf16*)(ws + WS_Z); bf16* CAT = (bf16*)(ws + WS_CAT); const bf16* SGW = (const bf16*)(ws + WS_SGUW) + (size_t)l * 4 * 128 * 128;
                float* out = args.out;
                constexpr int NU_SGU = 512, NU_CONV = 2048, NU_SEG = 1024, NU_SMP = 2048, NU = NU_SGU + NU_CONV + 2 * NU_SEG + NU_SMP;
#pragma unroll 1
                for (int ui = 0; ; ++ui) {
                    int u;
                    if (NGW != 2048) { u = ui * NGW + gw; if (u >= NU) break; }
                    else { if (ui >= 4) break;
                        if (gw < 512) { if (ui == 0) u = gw; else if (ui == 1) u = NU_SGU + 1536 + gw; else break; }
                        else { const int g5 = gw - 512; if (ui == 0) u = NU_SGU + g5; else { const int sidx = (ui - 1) * 1536 + g5; if (sidx >= 2 * NU_SEG + NU_SMP) break; u = NU_SGU + NU_CONV + sidx; } } }
                    int lane = tid & 63; asm volatile("" : "+v"(lane));
                    if (u < NU_SGU) { sgu_unit(ZB, CAT, SGW, args.in[17] + (size_t)l * GW, args.in[18] + (size_t)l * GW, args.in[20] + (size_t)l * 4 * 128, u >> 2, u & 3, (LAS bf16*)scr, lane); continue; }
                    int r = u - NU_SGU;
                    if (r < NU_CONV) { const int seg = r >> 2, h = r & 3, seq = seg >> 6, t0 = (seg & 63) * 32;
                        conv_unit_p(ZB, CAT, out + OUT_CONV_P + (size_t)l * NBP * 30 * GW, args.in[13] + (size_t)l * 31 * GW, args.in[14] + (size_t)l * GW, args.in[15] + (size_t)l * GW, args.in[16] + (size_t)l * GW, seq, t0, h, scr, lane);
                        continue; }
                    r -= NU_CONV;
                    if (r < 2 * NU_SEG) { const int ty = r / NU_SEG, q = r % NU_SEG, seg = q >> 2, h = q & 3, seq = seg >> 5, t0 = (seg & 31) * 64;
                        if (ty == 0) { float* np = out + OUT_POOL_P + (size_t)l * NBP * 15 * GW;
                            if (h == 0) pool_unit_p<2>(ZB, CAT, np, seq, t0, h, lane); else if (h == 1) pool_unit_p<4>(ZB, CAT, np, seq, t0, h, lane);
                            else if (h == 2) pool_unit_p<8>(ZB, CAT, np, seq, t0, h, lane); else pool_unit_p<16>(ZB, CAT, np, seq, t0, h, lane); }
                        else short_unit_p(ZB, CAT, out + OUT_SHORT_P + (size_t)l * NBP * 2 * GW, args.in[21] + (size_t)l * 3 * GW, seq, t0, h, lane);
                        continue; }
                    r -= 2 * NU_SEG;
                    { const int ty = r >> 9, q = r & 511, seq = q >> 2, h = q & 3;
                        if (ty == 0) conv_unit<true>(ZB, CAT, args.in[3] + (size_t)l * NSB * 30 * GW, out + OUT_CONV_S + (size_t)l * NSB * 30 * GW, args.in[13] + (size_t)l * 31 * GW, args.in[14] + (size_t)l * GW, args.in[15] + (size_t)l * GW, args.in[16] + (size_t)l * GW, seq, 0, ST, h, scr, lane);
                        else if (ty == 1) pool_unit<true>(ZB, CAT, args.in[2] + (size_t)l * NSB * 15 * GW, out + OUT_POOL_S + (size_t)l * NSB * 15 * GW, seq, 0, ST, h, lane);
                        else if (ty == 2) short_unit<true>(ZB, CAT, args.in[4] + (size_t)l * NSB * 2 * GW, out + OUT_SHORT_S + (size_t)l * NSB * 2 * GW, args.in[21] + (size_t)l * 3 * GW, seq, 0, ST, h, lane);
                        else sgu_sample_unit(ZB, CAT, args.in[19] + (size_t)l * 4 * 128 * 128, args.in[17] + (size_t)l * GW, args.in[18] + (size_t)l * GW, args.in[20] + (size_t)l * 4 * 128, out + OUT_V_S + (size_t)l * NSB * ST * GW, seq, h, lane); }
                }
            } else {
                const int vcu = (G % 8 == 0) ? (bx % 8) * (G / 8) + bx / 8 : bx; const int gw = vcu * NWAVES + wave, NGW = G * NWAVES;
                const float* g = args.in[k == 3 ? 6 : 8] + (size_t)l * DM;
                float* X = args.out; const bf16* OB = (const bf16*)(ws + WS_O); float* RS = (float*)(ws + WS_RS);
                const bool from_input = (l == 0 && k == 3), write_xn = !(l == DEPTH - 1 && k == 6);
                f32x4 gg[4];
#pragma unroll
                for (int j = 0; j < 4; ++j) gg[j] = ((const f32x4*)g + lane)[64 * j];
                const int m_lo = 0;
#define EW_X32(m) ((m) < MP ? args.in[0] + (size_t)(m) * DM : args.in[1] + (size_t)((m) - MP) * DM)
                bf16* X16 = (bf16*)args.out;
                const bool dst16 = write_xn;
#pragma unroll 1
                for (int m = m_lo + gw; m < MT; m += 2 * NGW) {
                    const int m2 = m + NGW; const bool two = m2 < MT;
                    EwRow ra, rb;
                    ew_load(ra, nullptr, X16 + (size_t)m * 2 * DM, true, OB + (size_t)m * OP, lane);
                    { const int mc = two ? m2 : m; ew_load(rb, nullptr, X16 + (size_t)mc * 2 * DM, true, OB + (size_t)mc * OP, lane); }
                    ew_finish(ra, gg, X + (size_t)m * DM, X16 + (size_t)m * 2 * DM, dst16, RS + m, write_xn, lane);
                    if (two) ew_finish(rb, gg, X + (size_t)m2 * DM, X16 + (size_t)m2 * 2 * DM, dst16, RS + m2, write_xn, lane);
                }
#undef EW_X32
            }
        }
        ++ph;
        if (ph < args.ph_hi) {
            if (args.ph_lo < 0) cg::this_grid().sync();
            else { XcdBarrier b; b.bar = (unsigned*)(args.ws + WS_CTL); b.x = xb_xcc_id(); b.st = (volatile LAS unsigned*)(lds + MISC_OFF) + 8; xcd_barrier(b); }
        }
    }
}

#ifndef MK_N_LAUNCHES
#define MK_N_LAUNCHES 1
#endif
extern "C" void kernel_launch(void* const* d_in, const int* in_sizes, int n_in, void* d_out, int out_size, void* d_ws, size_t ws_size, hipStream_t stream) {
    static int grid = 0;
    if (grid == 0) {
        if (n_in != 24 || (size_t)out_size != OUT_END || ws_size < WS_END) { fprintf(stderr, "kernel_launch: unexpected shapes (n_in %d out %d ws %zu)\n", n_in, out_size, ws_size); grid = -1; return; }
        int dev = 0, cus = 0, per_cu = 0;
        if (hipGetDevice(&dev) != hipSuccess || hipDeviceGetAttribute(&cus, hipDeviceAttributeMultiprocessorCount, dev) != hipSuccess) { grid = -1; return; }
        if (hipFuncSetAttribute((const void*)hybrid_fwd, hipFuncAttributeMaxDynamicSharedMemorySize, LDS_BYTES) != hipSuccess) { fprintf(stderr, "kernel_launch: hipFuncSetAttribute failed\n"); grid = -1; return; }
        if (hipOccupancyMaxActiveBlocksPerMultiprocessor(&per_cu, (const void*)hybrid_fwd, NWAVES * 64, LDS_BYTES) != hipSuccess || per_cu < 1) per_cu = 1;
        (void)hipGetLastError();
        grid = cus * per_cu;
    }
    if (grid < 0) return;
    if (hipMemsetAsync((char*)d_ws + WS_CTL, 0, CTL_ZERO_BYTES, stream) != hipSuccess) { fprintf(stderr, "kernel_launch: hipMemsetAsync failed\n"); return; }
    Args a{};
    for (int i = 0; i < 24; ++i) a.in[i] = (const float*)d_in[i];
    a.out = (float*)d_out; a.ws = (unsigned char*)d_ws;
#if MK_N_LAUNCHES == 1
    a.ph_lo = 0; a.ph_hi = NPH;
    void* kargs[] = {&a};
    hipError_t e = hipLaunchCooperativeKernel((const void*)hybrid_fwd, dim3(grid), dim3(NWAVES * 64), kargs, LDS_BYTES, stream);
    if (e != hipSuccess) fprintf(stderr, "cooperative launch failed: %s (grid %d)\n", hipGetErrorString(e), grid);
#else
    for (int p = 0; p < NPH; ++p) { a.ph_lo = p; a.ph_hi = p + 1; hipLaunchKernelGGL(hybrid_fwd, dim3(grid), dim3(NWAVES * 64), LDS_BYTES, stream, a); }
#endif
}
```

```cpp
#include <hip/hip_runtime.h>
#include <hip/hip_cooperative_groups.h>
#include <cstdio>
#include <cstdint>
namespace pg8 {
#define PG8_LAS __attribute__((address_space(3)))
typedef unsigned short bf16_t;
typedef short bf16x8 __attribute__((ext_vector_type(8)));
typedef float f32x4 __attribute__((ext_vector_type(4)));
typedef unsigned u32x4 __attribute__((ext_vector_type(4)));
constexpr int KPAD = 64;
constexpr int BM = 256, BK = 64, HALF = 128, HTB = HALF * BK * 2  , STAGE_BYTES = 8 * HTB, NXCD = 8, WGM = 1;

__host__ __device__ __forceinline__ int lds_byte(int r, int c) { const int st = (r >> 4) * 2 + (c >> 5), rr = r & 15, cc = c & 31, ob = rr * 64 + cc * 2; return st * 1024 + (ob ^ (((ob >> 9) & 1) << 5)); }
__host__ __device__ __forceinline__ void stage_rc(int b, int& R, int& C) { const int st = b / 1024, sb = b % 1024, swz = sb ^ (((sb >> 9) & 1) << 5); R = (st >> 1) * 16 + swz / 64; C = (st & 1) * 32 + (swz % 64) / 2; }
__host__ __device__ __forceinline__ int perm32(int rho) { const int n = rho >> 4, i = rho & 15; return 8 * (i >> 2) + 4 * n + (i & 3); }

struct Unit { int pm, pn; };
struct Gemm { const bf16_t* A; const bf16_t* Bt; int M, N, K, lda, ldb; };

struct StaticOrder {
    int nM, nN, nwg, G, c;
    __host__ __device__ void init(int M, int N, int G_, int c_) { nM = M / BM; nN = N / BM; nwg = nM * nN; G = G_; c = c_; }
    __host__ __device__ bool next(int i, Unit& u) const {
        const long L = (long)i * G + c; if (L >= nwg) return false;
        int wgid = (int)L; { const int q = nwg / NXCD, r = nwg % NXCD, xcd = wgid % NXCD, off = wgid / NXCD; wgid = (xcd < r ? xcd * (q + 1) : r * (q + 1) + (xcd - r) * q) + off; }
        const int nig = WGM * nN, gid = wgid / nig, fm = gid * WGM, gsz = (nM - fm) < WGM ? (nM - fm) : WGM;
        u.pm = fm + ((wgid % nig) % gsz); u.pn = (wgid % nig) / gsz; return true;
    }
    __device__ __forceinline__ void a_ready(const Unit&) const {}
    __device__ __forceinline__ void done(const Unit&) const {}
};

__device__ __forceinline__ unsigned cvt_pk_bf16(float lo, float hi) { unsigned r; asm volatile("v_cvt_pk_bf16_f32 %0, %1, %2" : "=v"(r) : "v"(lo), "v"(hi)); return r; }
__device__ __forceinline__ float relu_sq(float x) { float r; asm volatile("v_max_f32 %0, 0, %1" : "=v"(r) : "v"(x)); return r * r; }
__device__ __forceinline__ void st16_wt(void* p, u32x4 v) { asm volatile("global_store_dwordx4 %0, %1, off sc1" :: "v"(p), "v"(v) : "memory"); }
template <int ACT  > struct EpiBf16 {
    static constexpr bool PERM = true, AFTER_DRAIN = false;
    bf16_t* O; int ldc; const float* rs;
    __device__ __forceinline__ void operator()(const f32x4 (&acc)[2][2][4][2], const Unit& u, int wr, int wc, int fr, int fq) const {
        const int row0 = u.pm * BM + wr * 64 + fr; const int col0 = u.pn * BM + wc * 32 + 8 * fq;
#pragma unroll
        for (int ai = 0; ai < 2; ++ai)
#pragma unroll
            for (int m = 0; m < 4; ++m) { bf16_t* rowp = O + (size_t)(row0 + ai * HALF + m * 16) * ldc + col0; const float sc = rs ? rs[row0 + ai * HALF + m * 16] : 1.f;
#pragma unroll
                for (int bj = 0; bj < 2; ++bj) { f32x4 v0 = acc[ai][bj][m][0] * sc, v1 = acc[ai][bj][m][1] * sc;
                    if (ACT == 1) {
#pragma unroll
                        for (int e = 0; e < 4; ++e) { v0[e] = relu_sq(v0[e]); v1[e] = relu_sq(v1[e]); } }
                    u32x4 w; w.x = cvt_pk_bf16(v0[0], v0[1]); w.y = cvt_pk_bf16(v0[2], v0[3]); w.z = cvt_pk_bf16(v1[0], v1[1]); w.w = cvt_pk_bf16(v1[2], v1[3]);
                    *(u32x4*)(rowp + bj * HALF) = w; } }
    }
};

template <class Epi, class Sched, bool ALIGN_EPI = false, bool SP2 = false>
__device__ __forceinline__ void gemm_phase(PG8_LAS unsigned char* lds, const Gemm g, const Sched& S, const Epi& E, const int tid) {
    const int wid = __builtin_amdgcn_readfirstlane(tid >> 6), lane = tid & 63, wr = wid >> 2, wc = wid & 3, fr = lane & 15, fq = lane >> 4;
    const int K = g.K, nt = K / BK;
    unsigned voffA[2], voffB[2];
#pragma unroll
    for (int i = 0; i < 2; ++i) { int R, C; stage_rc(tid * 16 + i * 8192, R, C); const int Rb = Epi::PERM ? ((R & ~31) + perm32(R & 31)) : R;
        voffA[i] = (unsigned)(R * g.lda + C) * 2u; voffB[i] = (unsigned)(Rb * g.ldb + C) * 2u; }
    const size_t kstep = (size_t)(BK * 2);
    const size_t hstepA = (size_t)HALF * g.lda * 2, hstepB = (size_t)HALF * g.ldb * 2;
    const size_t tstepA = 2 * hstepA, tstepB = 2 * hstepB;
    const unsigned ldsw = (unsigned)wid * 1024u;
    const int aoff = lds_byte(wr * 64 + fr, fq * 8), boff = lds_byte(wc * 32 + fr, fq * 8);
#define PG8_SA(b, h) (((b) * 2 + (h)) * HTB)
#define PG8_SB(b, h) ((4 + (b) * 2 + (h)) * HTB)
#define PG8_STAGE(bufoff, gbase, voff) do { _Pragma("unroll") for (int _i = 0; _i < 2; ++_i) \
        __builtin_amdgcn_global_load_lds((const unsigned*)((const char*)(gbase) + (voff)[_i]), (PG8_LAS unsigned*)(lds + (bufoff) + ldsw + _i * 8192), 16, 0, 0); } while (0)
#define PG8_LDA(dst, b, h) do { _Pragma("unroll") for (int m = 0; m < 4; ++m) _Pragma("unroll") for (int k = 0; k < 2; ++k) dst[m][k] = *(const PG8_LAS bf16x8*)(lds + PG8_SA(b, h) + aoff + m * 2048 + k * 1024); } while (0)
#define PG8_LDB(dst, b, h) do { _Pragma("unroll") for (int n = 0; n < 2; ++n) _Pragma("unroll") for (int k = 0; k < 2; ++k) dst[n][k] = *(const PG8_LAS bf16x8*)(lds + PG8_SB(b, h) + boff + n * 2048 + k * 1024); } while (0)
#define PG8_MMA(ai, bj, At, Bt) do { __builtin_amdgcn_s_setprio(1); _Pragma("unroll") for (int m = 0; m < 4; ++m) _Pragma("unroll") for (int n = 0; n < 2; ++n) _Pragma("unroll") for (int k = 0; k < 2; ++k) \
        acc[ai][bj][m][n] = __builtin_amdgcn_mfma_f32_16x16x32_bf16(Bt[n][k], At[m][k], acc[ai][bj][m][n], 0, 0, 0); __builtin_amdgcn_s_setprio(0); } while (0)
#define PG8_WAIT_V(n) asm volatile("s_waitcnt vmcnt(" #n ")" ::: "memory")
#define PG8_WAIT_L(n) asm volatile("s_waitcnt lgkmcnt(" #n ")" ::: "memory")
#define PG8_BAR __builtin_amdgcn_s_barrier()
#define PG8_SCHED __builtin_amdgcn_sched_barrier(0)
    Unit cur, nxt; int ui = 0;
    if (!S.next(0, cur)) return;
    f32x4 acc[2][2][4][2];
#pragma unroll
    for (int a = 0; a < 2; ++a)
#pragma unroll
        for (int b = 0; b < 2; ++b)
#pragma unroll
            for (int m = 0; m < 4; ++m)
#pragma unroll
                for (int n = 0; n < 2; ++n) acc[a][b][m][n] = (f32x4){0.f, 0.f, 0.f, 0.f};
    bf16x8 At[4][2], B0[2][2], B1[2][2];
    const char* cA = (const char*)g.A + (size_t)cur.pm * tstepA; const char* cB = (const char*)g.Bt + (size_t)cur.pn * tstepB;
    S.a_ready(cur);
    if constexpr (SP2) {
        PG8_STAGE(PG8_SB(0, 0), cB, voffB); PG8_STAGE(PG8_SB(0, 1), cB + hstepB, voffB); PG8_STAGE(PG8_SA(0, 0), cA, voffA); PG8_STAGE(PG8_SA(0, 1), cA + hstepA, voffA);
        if (wr == 1) PG8_BAR;
        PG8_WAIT_V(2); PG8_BAR;
        PG8_STAGE(PG8_SB(1, 0), cB + kstep, voffB); PG8_STAGE(PG8_SA(1, 0), cA + kstep, voffA); PG8_STAGE(PG8_SB(1, 1), cB + hstepB + kstep, voffB);
        PG8_WAIT_V(6); PG8_BAR;
    } else {
        PG8_STAGE(PG8_SB(0, 0), cB, voffB); PG8_STAGE(PG8_SA(0, 0), cA, voffA); PG8_STAGE(PG8_SB(0, 1), cB + hstepB, voffB); PG8_STAGE(PG8_SA(0, 1), cA + hstepA, voffA);
        if (wr == 1) PG8_BAR;
        PG8_WAIT_V(4); PG8_BAR;
        PG8_STAGE(PG8_SB(1, 0), cB + kstep, voffB); PG8_STAGE(PG8_SA(1, 0), cA + kstep, voffA); PG8_STAGE(PG8_SB(1, 1), cB + hstepB + kstep, voffB);
        PG8_WAIT_V(6); PG8_BAR;
    }
    for (;;) {
        const bool has_next = S.next(ui + 1, nxt);
        const char* nA = has_next ? (const char*)g.A + (size_t)nxt.pm * tstepA : cA; const char* nB = has_next ? (const char*)g.Bt + (size_t)nxt.pn * tstepB : cB;
        for (int t = 0; t < nt; t += 2) {
            const bool last = (t == nt - 2);
            const char* a1 = cA + (size_t)(t + 1) * kstep;
            const char* a2 = last ? nA : cA + (size_t)(t + 2) * kstep; const char* b2 = last ? nB : cB + (size_t)(t + 2) * kstep;
            const char* a3 = a2 + kstep; const char* b3 = b2 + kstep;
            if (last && has_next) S.a_ready(nxt);
            if constexpr (SP2) {
            PG8_LDB(B0, 0, 0); PG8_LDB(B1, 0, 1); PG8_SCHED; PG8_LDA(At, 0, 0); PG8_STAGE(PG8_SA(1, 1), a1 + hstepA, voffA);
            PG8_WAIT_V(8); PG8_WAIT_L(0); PG8_BAR; PG8_MMA(0, 0, At, B0); PG8_MMA(0, 1, At, B1); PG8_BAR; PG8_SCHED;
            PG8_LDA(At, 0, 1); PG8_STAGE(PG8_SB(0, 0), b2, voffB); PG8_STAGE(PG8_SB(0, 1), b2 + hstepB, voffB); PG8_STAGE(PG8_SA(0, 0), a2, voffA);
            PG8_WAIT_V(8); PG8_WAIT_L(0); PG8_BAR; PG8_MMA(1, 0, At, B0); PG8_MMA(1, 1, At, B1); PG8_BAR; PG8_SCHED;
            PG8_LDB(B0, 1, 0); PG8_LDB(B1, 1, 1); PG8_SCHED; PG8_LDA(At, 1, 0); PG8_STAGE(PG8_SA(0, 1), a2 + hstepA, voffA);
            PG8_WAIT_V(8); PG8_WAIT_L(0); PG8_BAR; PG8_MMA(0, 0, At, B0); PG8_MMA(0, 1, At, B1); PG8_BAR; PG8_SCHED;
            PG8_LDA(At, 1, 1); PG8_STAGE(PG8_SB(1, 0), b3, voffB); PG8_STAGE(PG8_SB(1, 1), b3 + hstepB, voffB); PG8_STAGE(PG8_SA(1, 0), a3, voffA);
            PG8_WAIT_V(8); PG8_WAIT_L(0); PG8_BAR; PG8_MMA(1, 0, At, B0); PG8_MMA(1, 1, At, B1); PG8_BAR; PG8_SCHED;
            } else {
            PG8_LDB(B0, 0, 0); PG8_SCHED; PG8_LDA(At, 0, 0); PG8_STAGE(PG8_SA(1, 1), a1 + hstepA, voffA);
            PG8_WAIT_L(8); PG8_BAR; PG8_WAIT_L(0); PG8_MMA(0, 0, At, B0); PG8_BAR; PG8_SCHED;
            PG8_LDB(B1, 0, 1); PG8_STAGE(PG8_SB(0, 0), b2, voffB);
            PG8_BAR; PG8_WAIT_L(0); PG8_MMA(0, 1, At, B1); PG8_BAR;
            PG8_LDA(At, 0, 1); PG8_STAGE(PG8_SA(0, 0), a2, voffA);
            PG8_BAR; PG8_WAIT_L(0); PG8_MMA(1, 0, At, B0); PG8_BAR; PG8_SCHED;
            PG8_STAGE(PG8_SB(0, 1), b2 + hstepB, voffB);
            PG8_WAIT_V(6); PG8_BAR; PG8_MMA(1, 1, At, B1); PG8_BAR;
            PG8_LDB(B0, 1, 0); PG8_SCHED; PG8_LDA(At, 1, 0); PG8_STAGE(PG8_SA(0, 1), a2 + hstepA, voffA);
            PG8_WAIT_L(8); PG8_BAR; PG8_WAIT_L(0); PG8_MMA(0, 0, At, B0); PG8_BAR; PG8_SCHED;
            PG8_LDB(B1, 1, 1); PG8_STAGE(PG8_SB(1, 0), b3, voffB);
            PG8_BAR; PG8_WAIT_L(0); PG8_MMA(0, 1, At, B1); PG8_BAR;
            PG8_LDA(At, 1, 1); PG8_STAGE(PG8_SA(1, 0), a3, voffA);
            PG8_BAR; PG8_WAIT_L(0); PG8_MMA(1, 0, At, B0); PG8_BAR; PG8_SCHED;
            PG8_STAGE(PG8_SB(1, 1), b3 + hstepB, voffB);
            PG8_WAIT_V(6); PG8_BAR; PG8_MMA(1, 1, At, B1); PG8_BAR;
            }
        }
        if constexpr (ALIGN_EPI) { if (wr == 0) PG8_BAR; }
        if constexpr (!Epi::AFTER_DRAIN) { E(acc, cur, wr, wc, fr, fq); S.done(cur); }
        if (!has_next) break;
#pragma unroll
        for (int a = 0; a < 2; ++a)
#pragma unroll
            for (int b = 0; b < 2; ++b)
#pragma unroll
                for (int m = 0; m < 4; ++m)
#pragma unroll
                    for (int n = 0; n < 2; ++n) acc[a][b][m][n] = (f32x4){0.f, 0.f, 0.f, 0.f};
        cur = nxt; cA = nA; cB = nB; ++ui;
        if constexpr (ALIGN_EPI) { if (wr == 1) PG8_BAR; }
    }
    PG8_WAIT_V(0);
    if constexpr (!ALIGN_EPI) { if (wr == 0) PG8_BAR; }
    PG8_BAR;
    if constexpr (Epi::AFTER_DRAIN) { E.fused(acc, cur, wr, wc, fr, fq, lds, wid, lane); S.done(cur); }
#undef PG8_SA
#undef PG8_SB
#undef PG8_STAGE
#undef PG8_LDA
#undef PG8_LDB
#undef PG8_MMA
#undef PG8_WAIT_V
#undef PG8_WAIT_L
#undef PG8_BAR
#undef PG8_SCHED
}
}

namespace cg = cooperative_groups;
#define LAS __attribute__((address_space(3)))
typedef unsigned short bf16;
typedef unsigned v4u __attribute__((ext_vector_type(4)));
typedef unsigned v2u __attribute__((ext_vector_type(2)));
typedef float f32x4 __attribute__((ext_vector_type(4)));
typedef short bf16x8 __attribute__((ext_vector_type(8)));

constexpr int NWAVES = 8;
constexpr int DM = 1024, FF = 4096, INW = 2048, GW = 256;
constexpr int ZP = INW + 64;
#ifndef HPAD
#define HPAD 0
#endif
#ifndef WPAD
#define WPAD 0
#endif
#ifndef APAD
#define APAD 0
#endif
constexpr int DP = DM + APAD;
#ifndef OPAD
#define OPAD 0
#endif
constexpr int OP = DM + OPAD;
constexpr int FP = FF + HPAD;
constexpr int MP = 16384, MS = 512, MT = MP + MS;
constexpr int SEQ = 2048, NBP = 8, NSB = 128, ST = 4, DEPTH = 2;
constexpr float EPS = 1e-6f;
constexpr size_t MiB = 1u << 20;
constexpr size_t WS_SGUW = 1 * MiB;
constexpr size_t WS_W = 2 * MiB, W_LAYER = 24 * MiB, W_IN = 0, W_OUT = 9 * MiB / 2, W_UP = 7 * MiB, W_DN = 31 * MiB / 2;
constexpr size_t WS_XN = 50 * MiB, WS_O = 84 * MiB, WS_H = 120 * MiB, WS_Z = 120 * MiB, WS_CAT = 189 * MiB, WS_RS = 254 * MiB  , WS_END = 255 * MiB;
static_assert(WS_Z + (size_t)16896 * ZP * 2 <= WS_CAT && WS_XN + (size_t)16896 * DP * 2 <= WS_O && WS_CAT + (size_t)16896 * DP * 2 <= WS_H + (size_t)16896 * FP * 2 && WS_H + (size_t)16896 * FP * 2 <= WS_END, "d_ws map");
constexpr int LDS_BYTES = 147456;
constexpr int MISC_OFF = LDS_BYTES - 256;
constexpr size_t WS_CTL = 0, CTL_ZERO_BYTES = 128 * 1024;
constexpr int WAVE_SCR = 17408;
constexpr size_t OUT_Y = 0;
constexpr size_t OUT_POOL_P = (size_t)MT * DM;
constexpr size_t OUT_POOL_S = OUT_POOL_P + (size_t)DEPTH * NBP * 15 * GW;
constexpr size_t OUT_CONV_P = OUT_POOL_S + (size_t)DEPTH * NSB * 15 * GW;
constexpr size_t OUT_CONV_S = OUT_CONV_P + (size_t)DEPTH * NBP * 30 * GW;
constexpr size_t OUT_SHORT_P = OUT_CONV_S + (size_t)DEPTH * NSB * 30 * GW;
constexpr size_t OUT_SHORT_S = OUT_SHORT_P + (size_t)DEPTH * NBP * 2 * GW;
constexpr size_t OUT_V_S = OUT_SHORT_S + (size_t)DEPTH * NSB * 2 * GW;
constexpr size_t OUT_END = OUT_V_S + (size_t)DEPTH * NSB * ST * GW;

__device__ __forceinline__ float bf2f(bf16 b) { return __uint_as_float(((unsigned)b) << 16); }
__device__ __forceinline__ unsigned f2bf(float f) { unsigned u = __float_as_uint(f); return (u + 0x7fffu + ((u >> 16) & 1u)) >> 16; }
__device__ __forceinline__ unsigned pk2(float lo, float hi) { return f2bf(lo) | (f2bf(hi) << 16); }
template <int CTRL, int ROWMASK> __device__ __forceinline__ float dpp_get(float v) { return __int_as_float(__builtin_amdgcn_update_dpp(0, __float_as_int(v), CTRL, ROWMASK, 0xF, false)); }
__device__ __forceinline__ float sum8(float v) { v += dpp_get<0xB1, 0xF>(v); v += dpp_get<0x4E, 0xF>(v); v += dpp_get<0x141, 0xF>(v); return v; }
__device__ __forceinline__ float wave_sum(float v) {
    v = sum8(v); v += dpp_get<0x140, 0xF>(v); v += dpp_get<0x142, 0xA>(v); v += dpp_get<0x143, 0xC>(v);
    return __int_as_float(__builtin_amdgcn_readlane(__float_as_int(v), 63));
}
__device__ __forceinline__ void unpack8(const v4u w, float (&f)[8]) {
    f[0] = __uint_as_float(w.x << 16); f[1] = __uint_as_float(w.x & 0xffff0000u); f[2] = __uint_as_float(w.y << 16); f[3] = __uint_as_float(w.y & 0xffff0000u);
    f[4] = __uint_as_float(w.z << 16); f[5] = __uint_as_float(w.z & 0xffff0000u); f[6] = __uint_as_float(w.w << 16); f[7] = __uint_as_float(w.w & 0xffff0000u); }
__device__ __forceinline__ v4u pack8(const float (&f)[8]) { v4u w; w.x = pg8::cvt_pk_bf16(f[0], f[1]); w.y = pg8::cvt_pk_bf16(f[2], f[3]); w.z = pg8::cvt_pk_bf16(f[4], f[5]); w.w = pg8::cvt_pk_bf16(f[6], f[7]); return w; }
__device__ __forceinline__ v4u ld16(const bf16* p) { return *(const v4u*)p; }
__device__ __forceinline__ float sigm(float x) { return __builtin_amdgcn_rcpf(1.f + __builtin_amdgcn_exp2f(-1.44269504f * x)); }
#define LDS_WAIT() asm volatile("s_waitcnt lgkmcnt(0)" ::: "memory")

__device__ __forceinline__ void transpose_item(const float* __restrict__ W, int K, int N, bf16* __restrict__ WT, const float* __restrict__ gk, LAS float* scr, int item, int lane) {
    const int nblk = N / 32, kb = item / nblk, nb = item % nblk, k0 = 64 * kb, n0 = 32 * nb;
#pragma unroll 8
    for (int i = 0; i < 32; ++i) { const int kk = 2 * i + (lane >> 5); float v = W[(size_t)(k0 + kk) * N + n0 + (lane & 31)]; if (gk) v *= gk[k0 + kk]; scr[kk * 33 + (lane & 31)] = v; }
    LDS_WAIT();
    const int c = lane & 7;
#pragma unroll
    for (int j = 0; j < 4; ++j) { const int n = (lane >> 3) + 8 * j; const LAS float* s = scr + (8 * c) * 33 + n;
        v4u o; o.x = pk2(s[0 * 33], s[1 * 33]); o.y = pk2(s[2 * 33], s[3 * 33]); o.z = pk2(s[4 * 33], s[5 * 33]); o.w = pk2(s[6 * 33], s[7 * 33]);
        *(v4u*)(WT + (size_t)(n0 + n) * K + k0 + 8 * c) = o; }
    LDS_WAIT();
}
struct TrDesc { const float* W; bf16* WT; const float* gk; int K, N, k0, n0; };
__device__ __forceinline__ void tr_load(float (&v)[32], const TrDesc& d, int lane) {
    const float* p = d.W + (size_t)(d.k0 + (lane >> 5)) * d.N + d.n0 + (lane & 31);
#pragma unroll
    for (int i = 0; i < 32; ++i) v[i] = p[(size_t)(2 * i) * d.N];
}
__device__ __forceinline__ void tr_store(const float (&v)[32], const TrDesc& d, LAS float* scr, int lane) {
#pragma unroll
    for (int i = 0; i < 32; ++i) { const int kk = 2 * i + (lane >> 5); float x = v[i]; if (d.gk) x *= d.gk[d.k0 + kk]; scr[kk * 33 + (lane & 31)] = x; }
    LDS_WAIT();
    const int c = lane & 7;
#pragma unroll
    for (int j = 0; j < 4; ++j) { const int n = (lane >> 3) + 8 * j; const LAS float* s = scr + (8 * c) * 33 + n;
        v4u o; o.x = pg8::cvt_pk_bf16(s[0 * 33], s[1 * 33]); o.y = pg8::cvt_pk_bf16(s[2 * 33], s[3 * 33]); o.z = pg8::cvt_pk_bf16(s[4 * 33], s[5 * 33]); o.w = pg8::cvt_pk_bf16(s[6 * 33], s[7 * 33]);
        *(v4u*)(d.WT + (size_t)(d.n0 + n) * (d.K + WPAD) + d.k0 + 8 * c) = o; }
    LDS_WAIT();
}
__device__ __forceinline__ void fold_item(const float* __restrict__ W, bf16* __restrict__ WT, const float* __restrict__ wp, const float* __restrict__ ps, LAS float* scr, int item4, int lane) {
    const int K = DM, N = DM; const int item = item4 >> 2, q = item4 & 3; const int nblk = N / 32, g = item / nblk, nb = item % nblk, k0 = 64 * g, n0 = 32 * nb;
    LAS float* scr2 = scr + 64 * 33;
#pragma unroll 8
    for (int i = 0; i < 32; ++i) { const int kk = 2 * i + (lane >> 5); scr[kk * 33 + (lane & 31)] = W[(size_t)(k0 + kk) * N + n0 + (lane & 31)] * ps[k0 + kk]; }
    LDS_WAIT();
    const int n = lane & 31;
#pragma unroll 1
    for (int i = 0; i < 8; ++i) { const int kl = 2 * i + (lane >> 5), kk = 16 * q + kl; const float* wr = wp + (size_t)(g * 64 + kk) * 64; float a = 0.f;
#pragma unroll 16
        for (int d = 0; d < 64; ++d) a += wr[d] * scr[d * 33 + n];
        scr2[kl * 33 + n] = a; }
    LDS_WAIT();
    { const int ch = lane >> 5; const LAS float* s = scr2 + (8 * ch) * 33 + n;
        v4u o; o.x = pk2(s[0 * 33], s[1 * 33]); o.y = pk2(s[2 * 33], s[3 * 33]); o.z = pk2(s[4 * 33], s[5 * 33]); o.w = pk2(s[6 * 33], s[7 * 33]);
        *(v4u*)(WT + (size_t)(n0 + n) * (K + WPAD) + k0 + 16 * q + 8 * ch) = o; }
    LDS_WAIT();
}
__device__ __forceinline__ void rms_row_to_bf16(const float* __restrict__ xrow, bf16* __restrict__ orow, float* __restrict__ rsp, int lane) {
    const f32x4* xr = (const f32x4*)xrow + lane;
    f32x4 v[4]; float s = 0.f;
#pragma unroll
    for (int j = 0; j < 4; ++j) { v[j] = xr[64 * j]; s += (v[j].x * v[j].x + v[j].y * v[j].y) + (v[j].z * v[j].z + v[j].w * v[j].w); }
    const float rstd = rsqrtf(wave_sum(s) * (1.f / DM) + EPS);
    if (lane == 0) *rsp = rstd;
    v2u* o8 = (v2u*)orow + lane;
#pragma unroll
    for (int j = 0; j < 4; ++j) { v2u o; o.x = pg8::cvt_pk_bf16(v[j].x, v[j].y); o.y = pg8::cvt_pk_bf16(v[j].z, v[j].w); o8[64 * j] = o; }
}
struct EwRow { f32x4 x[4]; v2u o[4]; };
__device__ __forceinline__ f32x4 unpack4(const v2u w) { return (f32x4){__uint_as_float(w.x << 16), __uint_as_float(w.x & 0xffff0000u), __uint_as_float(w.y << 16), __uint_as_float(w.y & 0xffff0000u)}; }
__device__ __forceinline__ void ew_load(EwRow& r, const float* __restrict__ xrow32, const bf16* __restrict__ xrow16, bool src16, const bf16* __restrict__ orow, int lane) {
    const v2u* orr = (const v2u*)orow + lane;
    if (src16) { const v2u* xr = (const v2u*)xrow16 + lane;
#pragma unroll
        for (int j = 0; j < 4; ++j) r.x[j] = unpack4(xr[64 * j]); }
    else { const f32x4* xr = (const f32x4*)xrow32 + lane;
#pragma unroll
        for (int j = 0; j < 4; ++j) r.x[j] = xr[64 * j]; }
#pragma unroll
    for (int j = 0; j < 4; ++j) r.o[j] = orr[64 * j];
}
__device__ __forceinline__ void ew_finish(EwRow& r, const f32x4 (&gg)[4], float* __restrict__ Xrow32, bf16* __restrict__ Xrow16, bool dst16, float* __restrict__ rsp, bool write_xn, int lane) {
    f32x4 o[4]; float so = 0.f;
#pragma unroll
    for (int j = 0; j < 4; ++j) { o[j] = unpack4(r.o[j]); so += (o[j].x * o[j].x + o[j].y * o[j].y) + (o[j].z * o[j].z + o[j].w * o[j].w); }
    const float rs = rsqrtf(wave_sum(so) * (1.f / DM) + EPS); float s1 = 0.f;
#pragma unroll
    for (int j = 0; j < 4; ++j) { f32x4 x = r.x[j] + o[j] * rs * gg[j]; r.x[j] = x; s1 += (x.x * x.x + x.y * x.y) + (x.z * x.z + x.w * x.w); }
    if (dst16) { v2u* Xr = (v2u*)Xrow16 + lane;
#pragma unroll
        for (int j = 0; j < 4; ++j) { v2u w; w.x = pg8::cvt_pk_bf16(r.x[j].x, r.x[j].y); w.y = pg8::cvt_pk_bf16(r.x[j].z, r.x[j].w); Xr[64 * j] = w; } }
    else { f32x4* Xr = (f32x4*)Xrow32 + lane;
#pragma unroll
        for (int j = 0; j < 4; ++j) Xr[64 * j] = r.x[j]; }
    if (write_xn) { const float r1 = rsqrtf(wave_sum(s1) * (1.f / DM) + EPS); if (lane == 0) *rsp = r1; }
}

template <bool SAMPLE>
__device__ __forceinline__ void pool_unit(const bf16* __restrict__ Z, bf16* __restrict__ CAT, const float* __restrict__ state, float* __restrict__ newp,
                                          int seq, int t0, int nrows, int g, int lane) {
    const int c = g * 64 + lane, w = 2 << g;
    const size_t rowbase = SAMPLE ? (size_t)MP + (size_t)seq * ST : (size_t)seq * SEQ;
    const bf16* zc = Z + rowbase * ZP + c;
    const float* st = state + (size_t)seq * 15 * GW + c;
#define POOL_A(e) ((e) >= 0 ? bf2f(zc[(size_t)(e) * ZP]) : (SAMPLE ? st[(15 + (e)) * GW] : 0.f))
    float S = 0.f;
    for (int j = 1; j < w; ++j) S += POOL_A(t0 - j);
#pragma unroll 4
    for (int t = t0; t < t0 + nrows; ++t) {
        const float a = POOL_A(t); S += a;
        const float cnt = SAMPLE ? (float)w : (float)(t + 1 < w ? t + 1 : w);
        CAT[(rowbase + t) * DP + c] = (bf16)f2bf(S / cnt - a);
        const int e = t - w + 1; S -= POOL_A(e);
    }
    const int T = SAMPLE ? ST : SEQ;
    if (t0 + nrows == T) {
        for (int j = 0; j < 15; ++j) { const int e = T - 15 + j; newp[((size_t)seq * 15 + j) * GW + c] = POOL_A(e); }
    }
#undef POOL_A
}
template <bool SAMPLE>
__device__ __forceinline__ void short_unit(const bf16* __restrict__ Z, bf16* __restrict__ CAT, const float* __restrict__ state, float* __restrict__ news,
                                           const float* __restrict__ sw, int seq, int t0, int nrows, int h, int lane) {
    const int c = h * 64 + lane;
    const size_t rowbase = SAMPLE ? (size_t)MP + (size_t)seq * ST : (size_t)seq * SEQ;
    const bf16* zc = Z + rowbase * ZP + c;
    const float* st = state + (size_t)seq * 2 * GW + c;
    const float w0 = sw[c], w1 = sw[GW + c], w2 = sw[2 * GW + c];
#define SH_E(e) ((e) >= 0 ? bf2f(zc[(size_t)(e) * ZP + 1536]) * bf2f(zc[(size_t)(e) * ZP + 1792]) : (SAMPLE ? st[(2 + (e)) * GW] : 0.f))
    float e2 = SH_E(t0 - 2), e1 = SH_E(t0 - 1);
#pragma unroll 4
    for (int t = t0; t < t0 + nrows; ++t) {
        const float e0 = SH_E(t); const float bg = bf2f(zc[(size_t)t * ZP + 1280]);
        CAT[(rowbase + t) * DP + 768 + c] = (bf16)f2bf(bg * (w0 * e2 + w1 * e1 + w2 * e0));
        e2 = e1; e1 = e0;
    }
    const int T = SAMPLE ? ST : SEQ;
    if (t0 + nrows == T) { news[((size_t)seq * 2 + 0) * GW + c] = e2; news[((size_t)seq * 2 + 1) * GW + c] = e1; }
#undef SH_E
}
template <bool SAMPLE>
__device__ __forceinline__ void conv_unit(const bf16* __restrict__ Z, bf16* __restrict__ CAT, const float* __restrict__ state, float* __restrict__ newc,
                                          const float* __restrict__ cw, const float* __restrict__ cb, const float* __restrict__ lg, const float* __restrict__ lb,
                                          int seq, int t0, int nrows, int h, LAS float* gL, int lane) {
    const int c = h * 64 + lane;
    const size_t rowbase = SAMPLE ? (size_t)MP + (size_t)seq * ST : (size_t)seq * SEQ;
    const bf16* zc = Z + rowbase * ZP + c;
    bf16* oc = CAT + rowbase * DP + 256 + c;
    const int T = SAMPLE ? ST : SEQ;
    const bool last = (t0 + nrows == T);
    const int nin = nrows + 30;
#pragma unroll 4
    for (int r = 0; r < nin; ++r) { const int s = t0 - 30 + r; float gs = 0.f;
        if (s >= 0) { const unsigned off = (unsigned)s * ZP; const float p = bf2f(zc[off + 256]), gt = bf2f(zc[off + 512]); gs = p * sigm(gt); }
        else if (SAMPLE) gs = state[((size_t)seq * 30 + 30 + s) * GW + c];
        if (last && s >= T - 30) newc[((size_t)seq * 30 + (s - (T - 30))) * GW + c] = gs;
        gL[r * 64 + lane] = gs; }
    LDS_WAIT();
    float wk[31];
#pragma unroll
    for (int k = 0; k < 31; ++k) wk[k] = cw[k * GW + c];
    const float bias = cb[c], gg = lg[c], bb = lb[c];
#pragma unroll 1
    for (int tq = 0; tq < nrows; tq += 4) {
        float acc[4] = {bias, bias, bias, bias};
#pragma unroll
        for (int r = 0; r < 34; ++r) { const float gv = gL[(tq + r) * 64 + lane];
#pragma unroll
            for (int q = 0; q < 4; ++q) { const int k = r - q; if (k >= 0 && k <= 30) acc[q] += wk[k] * gv; } }
#pragma unroll
        for (int q = 0; q < 4; ++q) { const float cv = acc[q];
            const float mean = wave_sum(cv) * (1.f / 64.f); const float d = cv - mean;
            const float var = wave_sum(d * d) * (1.f / 64.f);
            const float y = d * rsqrtf(var + EPS) * gg + bb;
            oc[(unsigned)(t0 + tq + q) * DP] = (bf16)f2bf(y * sigm(y)); }
    }
    LDS_WAIT();
}
template <int W>
__device__ __forceinline__ void pool_unit_p(const bf16* __restrict__ Z, bf16* __restrict__ CAT, float* __restrict__ newp, int seq, int t0, int g, int lane) {
    const int rr = lane >> 3, cg = lane & 7, c0 = g * 64 + cg * 8, tb = t0 + rr * 8;
    const size_t rowbase = (size_t)seq * SEQ;
    const bf16* zb = Z + (rowbase + tb) * ZP + c0;
    v4u raw[W + 7];
#pragma unroll
    for (int j = 0; j < W + 7; ++j) { const int dj = j - (W - 1); raw[j] = (tb + dj >= 0) ? ld16(zb + (long)dj * ZP) : (v4u){0u, 0u, 0u, 0u}; }
    float S[8];
#pragma unroll
    for (int i = 0; i < 8; ++i) S[i] = 0.f;
#pragma unroll
    for (int j = 0; j < W - 1; ++j) { float f[8]; unpack8(raw[j], f);
#pragma unroll
        for (int i = 0; i < 8; ++i) S[i] += f[i]; }
    bf16* ob = CAT + (rowbase + tb) * DP + c0;
    const bool lastseg = (t0 + 64 == SEQ);
#pragma unroll
    for (int j = 0; j < 8; ++j) { float a[8], o[8], od[8]; unpack8(raw[j + W - 1], a); unpack8(raw[j], od);
        const int t = tb + j; const float inv = 1.f / (float)(t + 1 < W ? t + 1 : W);
#pragma unroll
        for (int i = 0; i < 8; ++i) { S[i] += a[i]; o[i] = S[i] * inv - a[i]; S[i] -= od[i]; }
        *(v4u*)(ob + j * DP) = pack8(o);
        if (lastseg && t >= SEQ - 15) { float* np = newp + ((size_t)seq * 15 + (t - (SEQ - 15))) * GW + c0; *(f32x4*)np = (f32x4){a[0], a[1], a[2], a[3]}; *(f32x4*)(np + 4) = (f32x4){a[4], a[5], a[6], a[7]}; }
    }
}
__device__ __forceinline__ void short_unit_p(const bf16* __restrict__ Z, bf16* __restrict__ CAT, float* __restrict__ news, const float* __restrict__ sw, int seq, int t0, int h, int lane) {
    const int rr = lane >> 3, cg = lane & 7, c0 = h * 64 + cg * 8, tb = t0 + rr * 8;
    const size_t rowbase = (size_t)seq * SEQ;
    const bf16* zb = Z + (rowbase + tb) * ZP + c0;
    v4u Bv[8], Cv[10], Hv[10];
#pragma unroll
    for (int j = 0; j < 10; ++j) { const int dj = j - 2; const bool ok = (tb + dj >= 0);
        Cv[j] = ok ? ld16(zb + (long)dj * ZP + 1536) : (v4u){0u, 0u, 0u, 0u}; Hv[j] = ok ? ld16(zb + (long)dj * ZP + 1792) : (v4u){0u, 0u, 0u, 0u};
        if (j >= 2) Bv[j - 2] = ld16(zb + (long)dj * ZP + 1280); }
    float w0[8], w1[8], w2[8];
#pragma unroll
    for (int i = 0; i < 8; ++i) { w0[i] = sw[c0 + i]; w1[i] = sw[GW + c0 + i]; w2[i] = sw[2 * GW + c0 + i]; }
    float e2[8], e1[8];
    { float c[8], hh[8]; unpack8(Cv[0], c); unpack8(Hv[0], hh);
#pragma unroll
      for (int i = 0; i < 8; ++i) e2[i] = c[i] * hh[i];
      unpack8(Cv[1], c); unpack8(Hv[1], hh);
#pragma unroll
      for (int i = 0; i < 8; ++i) e1[i] = c[i] * hh[i]; }
    bf16* ob = CAT + (rowbase + tb) * DP + 768 + c0;
#pragma unroll
    for (int j = 0; j < 8; ++j) { float c[8], hh[8], b[8], o[8]; unpack8(Cv[j + 2], c); unpack8(Hv[j + 2], hh); unpack8(Bv[j], b);
#pragma unroll
        for (int i = 0; i < 8; ++i) { const float e0 = c[i] * hh[i]; o[i] = b[i] * (w0[i] * e2[i] + w1[i] * e1[i] + w2[i] * e0); e2[i] = e1[i]; e1[i] = e0; }
        *(v4u*)(ob + j * DP) = pack8(o); }
    if (t0 + 64 == SEQ && rr == 7) { float* np = news + (size_t)seq * 2 * GW + c0;
        *(f32x4*)np = (f32x4){e2[0], e2[1], e2[2], e2[3]}; *(f32x4*)(np + 4) = (f32x4){e2[4], e2[5], e2[6], e2[7]};
        *(f32x4*)(np + GW) = (f32x4){e1[0], e1[1], e1[2], e1[3]}; *(f32x4*)(np + GW + 4) = (f32x4){e1[4], e1[5], e1[6], e1[7]}; }
}
__device__ __forceinline__ void conv_unit_p(const bf16* __restrict__ Z, bf16* __restrict__ CAT, float* __restrict__ newc,
                                            const float* __restrict__ cw, const float* __restrict__ cb, const float* __restrict__ lg, const float* __restrict__ lb,
                                            int seq, int t0, int h, LAS float* gL, int lane) {
    const int rr = lane >> 3, cg = lane & 7, c0 = h * 64 + cg * 8;
    const size_t rowbase = (size_t)seq * SEQ;
    const bool last = (t0 + 32 == SEQ);
    { v4u pv[8], gv[8];
#pragma unroll
      for (int j = 0; j < 8; ++j) { const int r = 8 * j + rr, sx = t0 - 30 + r; const bool ok = (sx >= 0 && r < 62);
          const bf16* zp = Z + (rowbase + (ok ? sx : 0)) * ZP + c0;
          pv[j] = ok ? ld16(zp + 256) : (v4u){0u, 0u, 0u, 0u}; gv[j] = ok ? ld16(zp + 512) : (v4u){0u, 0u, 0u, 0u}; }
#pragma unroll
      for (int j = 0; j < 8; ++j) { const int r = 8 * j + rr, sx = t0 - 30 + r; float p[8], gt[8]; unpack8(pv[j], p); unpack8(gv[j], gt);
#pragma unroll
          for (int i = 0; i < 8; ++i) p[i] = p[i] * sigm(gt[i]);
          if (r < 62) { *(LAS f32x4*)(gL + r * 64 + cg * 8) = (f32x4){p[0], p[1], p[2], p[3]}; *(LAS f32x4*)(gL + r * 64 + cg * 8 + 4) = (f32x4){p[4], p[5], p[6], p[7]}; }
          if (last && sx >= SEQ - 30 && r < 62) { float* np = newc + ((size_t)seq * 30 + (sx - (SEQ - 30))) * GW + c0; *(f32x4*)np = (f32x4){p[0], p[1], p[2], p[3]}; *(f32x4*)(np + 4) = (f32x4){p[4], p[5], p[6], p[7]}; } }
    }
    LDS_WAIT();
    const int c = h * 64 + lane;
    float wk[31];
#pragma unroll
    for (int k = 0; k < 31; ++k) wk[k] = cw[k * GW + c];
    const float bias = cb[c];
#pragma unroll 1
    for (int tq = 0; tq < 32; tq += 4) {
        float acc[4] = {bias, bias, bias, bias};
#pragma unroll
        for (int r = 0; r < 34; ++r) { const float gvv = gL[(tq + r) * 64 + lane];
#pragma unroll
            for (int q = 0; q < 4; ++q) { const int k = r - q; if (k >= 0 && k <= 30) acc[q] += wk[k] * gvv; } }
        LDS_WAIT();
#pragma unroll
        for (int q = 0; q < 4; ++q) gL[(tq + q) * 64 + lane] = acc[q];
    }
    LDS_WAIT();
    float gg[8], bb[8];
#pragma unroll
    for (int i = 0; i < 8; ++i) { gg[i] = lg[c0 + i]; bb[i] = lb[c0 + i]; }
    bf16* ob = CAT + (rowbase + t0) * DP + 256 + c0;
#pragma unroll
    for (int j = 0; j < 4; ++j) { const int r = 8 * j + rr; const f32x4 a = *(const LAS f32x4*)(gL + r * 64 + cg * 8), b = *(const LAS f32x4*)(gL + r * 64 + cg * 8 + 4);
        float x[8] = {a[0], a[1], a[2], a[3], b[0], b[1], b[2], b[3]};
        const float mean = sum8(((x[0] + x[1]) + (x[2] + x[3])) + ((x[4] + x[5]) + (x[6] + x[7]))) * (1.f / 64.f);
        float q = 0.f;
#pragma unroll
        for (int i = 0; i < 8; ++i) { x[i] -= mean; q += x[i] * x[i]; }
        const float rstd = rsqrtf(sum8(q) * (1.f / 64.f) + EPS);
#pragma unroll
        for (int i = 0; i < 8; ++i) { const float yy = x[i] * rstd * gg[i] + bb[i]; x[i] = yy * sigm(yy); }
        *(v4u*)(ob + r * DP) = pack8(x); }
    LDS_WAIT();
}
__device__ __forceinline__ int sgu_swz(int c, int chunk) { return (chunk ^ ((c & 15) ^ (c >> 4))) << 3; }
__device__ __forceinline__ void sgu_unit(const bf16* __restrict__ Z, bf16* __restrict__ CAT, const bf16* __restrict__ Wb, const float* __restrict__ lg, const float* __restrict__ lb,
                                         const float* __restrict__ sb, int chunk, int h, LAS bf16* vT, int lane) {
    const size_t r0 = (size_t)chunk * 128;
    { const int rr = lane >> 3, cg = lane & 7, c0 = h * 64 + cg * 8;
      float gg[8], bb[8];
#pragma unroll
      for (int i = 0; i < 8; ++i) { gg[i] = lg[c0 + i]; bb[i] = lb[c0 + i]; }
#pragma unroll 1
      for (int jh = 0; jh < 16; jh += 8) {
          v4u raw[8];
#pragma unroll
          for (int j = 0; j < 8; ++j) raw[j] = ld16(Z + (r0 + 8 * (jh + j) + rr) * ZP + 1024 + c0);
#pragma unroll
          for (int j = 0; j < 8; ++j) { float x[8]; unpack8(raw[j], x);
              float sm = ((x[0] + x[1]) + (x[2] + x[3])) + ((x[4] + x[5]) + (x[6] + x[7])); const float mean = sum8(sm) * (1.f / 64.f);
              float q = 0.f;
#pragma unroll
              for (int i = 0; i < 8; ++i) { x[i] -= mean; q += x[i] * x[i]; }
              const float rstd = rsqrtf(sum8(q) * (1.f / 64.f) + EPS);
#pragma unroll
              for (int i = 0; i < 8; ++i) { const int cl = cg * 8 + i; vT[cl * 128 + sgu_swz(cl, jh + j) + rr] = (bf16)f2bf(x[i] * rstd * gg[i] + bb[i]); } }
      }
    }
    LDS_WAIT();
    const int fr = lane & 15, fq = lane >> 4;
    bf16x8 wf[8][4];
#pragma unroll
    for (int mt = 0; mt < 8; ++mt)
#pragma unroll
        for (int ks = 0; ks < 4; ++ks) if (ks * 32 <= mt * 16 + 15) wf[mt][ks] = *(const bf16x8*)(Wb + ((size_t)(h * 128 + mt * 16 + fr) * 128 + ks * 32 + fq * 8));
#pragma unroll
    for (int mt = 0; mt < 8; ++mt) {
        f32x4 acc[4];
#pragma unroll
        for (int nt = 0; nt < 4; ++nt) acc[nt] = (f32x4){0.f, 0.f, 0.f, 0.f};
        const int t = mt * 16 + fr;
        v2u uv[4];
#pragma unroll
        for (int nt = 0; nt < 4; ++nt) uv[nt] = *(const v2u*)(Z + (r0 + t) * ZP + 768 + h * 64 + nt * 16 + 4 * fq);
        const float bt = sb[h * 128 + t];
#pragma unroll
        for (int ks = 0; ks < 4; ++ks) if (ks * 32 <= mt * 16 + 15) {
#pragma unroll
            for (int nt = 0; nt < 4; ++nt) { const int cl = nt * 16 + fr; const bf16x8 vf = *(const LAS bf16x8*)(vT + cl * 128 + sgu_swz(cl, ks * 4 + fq));
                acc[nt] = __builtin_amdgcn_mfma_f32_16x16x32_bf16(vf, wf[mt][ks], acc[nt], 0, 0, 0); }
        }
#pragma unroll
        for (int nt = 0; nt < 4; ++nt) { const float u0 = __uint_as_float(uv[nt].x << 16), u1 = __uint_as_float(uv[nt].x & 0xffff0000u), u2 = __uint_as_float(uv[nt].y << 16), u3 = __uint_as_float(uv[nt].y & 0xffff0000u);
            v2u w; w.x = pg8::cvt_pk_bf16(u0 * (acc[nt][0] + bt), u1 * (acc[nt][1] + bt)); w.y = pg8::cvt_pk_bf16(u2 * (acc[nt][2] + bt), u3 * (acc[nt][3] + bt));
            *(v2u*)(CAT + (r0 + t) * DP + 512 + h * 64 + nt * 16 + 4 * fq) = w; }
    }
    LDS_WAIT();
}
__device__ __forceinline__ void sgu_sample_unit(const bf16* __restrict__ Z, bf16* __restrict__ CAT, const float* __restrict__ Wf, const float* __restrict__ lg, const float* __restrict__ lb,
                                                const float* __restrict__ sb, float* __restrict__ vout, int seq, int h, int lane) {
    const int c = h * 64 + lane; const size_t rowbase = (size_t)MP + (size_t)seq * ST;
    const float gg = lg[c], bb = lb[c];
    float vn[ST];
#pragma unroll
    for (int t = 0; t < ST; ++t) { const float v = bf2f(Z[(rowbase + t) * ZP + 1024 + c]); const float mean = wave_sum(v) * (1.f / 64.f); const float d = v - mean; const float var = wave_sum(d * d) * (1.f / 64.f);
        vn[t] = d * rsqrtf(var + EPS) * gg + bb; vout[((size_t)seq * ST + t) * GW + c] = vn[t]; }
#pragma unroll
    for (int t = 0; t < ST; ++t) { float sv = sb[h * 128 + t];
#pragma unroll
        for (int s = 0; s <= t; ++s) sv += Wf[((size_t)h * 128 + t) * 128 + s] * vn[s];
        const float u = bf2f(Z[(rowbase + t) * ZP + 768 + c]);
        CAT[(rowbase + t) * DP + 512 + c] = (bf16)f2bf(u * sv); }
}

#define XB_TMO      128
#define XB_XCNT(j)  (256  + 64 * (j))
#define XB_XSUB(j)  (1280 + 64 * (j))
#define XB_XGEN(j)  (2304 + 64 * (j))
#define XB_TOP      3328
#define XB_TOPGEN   3392
#define XCD_BAR_WORDS 3456
#define XB_SPIN_CAP (1u << 18)

__device__ __forceinline__ unsigned xb_ld(unsigned* p)              { return __hip_atomic_load(p, __ATOMIC_RELAXED, __HIP_MEMORY_SCOPE_AGENT); }
__device__ __forceinline__ unsigned xb_add(unsigned* p, unsigned v) { return __hip_atomic_fetch_add(p, v, __ATOMIC_RELAXED, __HIP_MEMORY_SCOPE_AGENT); }
__device__ __forceinline__ unsigned xb_xcc_id() { return (unsigned)__builtin_amdgcn_s_getreg((3 << 11) | 20) & 0xFu; }
#define XB_SPIN(cond, bar) do { unsigned _sp = 0; while (cond) { __builtin_amdgcn_s_sleep(1); \
    if ((++_sp & 255u) == 0u) { if (xb_ld(&(bar)[XB_TMO])) break; if (_sp > XB_SPIN_CAP) { atomicAdd(&(bar)[XB_TMO], 1u); break; } } } } while (0)

struct XcdBarrier {
    unsigned* bar; unsigned x;
    volatile LAS unsigned* st;
};

__device__ __forceinline__ XcdBarrier xcd_barrier_post(unsigned* bar, volatile LAS unsigned* st) {
    XcdBarrier b; b.bar = bar; b.x = xb_xcc_id(); b.st = st;
    if (threadIdx.x == 0) (void)xb_add(&bar[XB_XCNT(b.x)], 1u);
    return b;
}
__device__ __forceinline__ void xcd_barrier_complete(unsigned* bar, unsigned x, unsigned& nloc, unsigned& nx) {
    const unsigned G = gridDim.x * gridDim.y * gridDim.z;
    unsigned sum, cnt, mine, sp = 0u;
    for (;;) {
        sum = 0u; cnt = 0u; mine = 0u;
#pragma unroll
        for (unsigned j = 0; j < 16; ++j) { const unsigned c = xb_ld(&bar[XB_XCNT(j)]); sum += c; cnt += (c > 0u) ? 1u : 0u; mine = (j == x) ? c : mine; }
        if (sum == G) break;
        __builtin_amdgcn_s_sleep(1);
        if ((++sp & 255u) == 0u) { if (xb_ld(&bar[XB_TMO])) break; if (sp > XB_SPIN_CAP) { atomicAdd(&bar[XB_TMO], 1u); break; } }
    }
    nloc = mine > 0u ? mine : 1u; nx = cnt > 0u ? cnt : 1u;
}

__device__ __forceinline__ void xcd_barrier(const XcdBarrier& b) {
    asm volatile("s_waitcnt vmcnt(0)" ::: "memory");
    __syncthreads();
    if (threadIdx.x == 0) {
        unsigned* bar = b.bar;
        __builtin_amdgcn_s_waitcnt(0);
        unsigned nloc = b.st[0], nx = b.st[1];
        if (nloc == 0u) { xcd_barrier_complete(bar, b.x, nloc, nx); b.st[0] = nloc; b.st[1] = nx; }
        const unsigned old = xb_add(&bar[XB_XSUB(b.x)], 1u);
        const unsigned gen = old / nloc;
        if (old + 1u == (gen + 1u) * nloc) {
            __builtin_amdgcn_fence(__ATOMIC_RELEASE, "agent");
            asm volatile("s_waitcnt vmcnt(0)" ::: "memory");
            const unsigned og = xb_add(&bar[XB_TOP], 1u);
            const unsigned tg = og / nx;
            if (og + 1u == (tg + 1u) * nx) xb_add(&bar[XB_TOPGEN], 1u);
            else XB_SPIN(xb_ld(&bar[XB_TOPGEN]) == tg, bar);
            __builtin_amdgcn_fence(__ATOMIC_ACQUIRE, "agent");
            xb_add(&bar[XB_XGEN(b.x)], 1u);
            asm volatile("s_waitcnt vmcnt(0)" ::: "memory");
        } else {
            XB_SPIN(xb_ld(&bar[XB_XGEN(b.x)]) == gen, bar);
            __builtin_amdgcn_fence(__ATOMIC_ACQUIRE, "agent");
            asm volatile("s_waitcnt vmcnt(0)" ::: "memory");
        }
    }
    __syncthreads();
}

template <int NT, int ACT, int K>
__device__ __forceinline__ void small_gemm_tile(LAS unsigned char* lds, const bf16* __restrict__ A, const bf16* __restrict__ Bt, bf16* __restrict__ O, int ldc, int lda, int ldb, const float* __restrict__ rs, int m0, int n0, int tid) {
    constexpr int NC = 16 * NT, KW = K / 8, NCH = KW / 128;
    const int wave = __builtin_amdgcn_readfirstlane(tid >> 6), lane = tid & 63, fr = lane & 15, fq = lane >> 4;
    const bf16* ap = A + (size_t)(m0 + fr) * lda + wave * KW + fq * 8;
    const bf16* bp = Bt + (size_t)(n0 + fr) * ldb + wave * KW + fq * 8;
    f32x4 acc[4][NT];
#pragma unroll
    for (int m = 0; m < 4; ++m)
#pragma unroll
        for (int n = 0; n < NT; ++n) acc[m][n] = (f32x4){0.f, 0.f, 0.f, 0.f};
    if constexpr (NCH == 1) {
        bf16x8 fa[4][4], fb[4][NT];
#pragma unroll
        for (int s_ = 0; s_ < 4; ++s_) {
#pragma unroll
            for (int m = 0; m < 4; ++m) fa[s_][m] = *(const bf16x8*)(ap + (size_t)m * 16 * lda + s_ * 32);
#pragma unroll
            for (int n = 0; n < NT; ++n) fb[s_][n] = *(const bf16x8*)(bp + (size_t)n * 16 * ldb + s_ * 32); }
        __builtin_amdgcn_sched_barrier(0);
#pragma unroll
        for (int s_ = 0; s_ < 4; ++s_)
#pragma unroll
            for (int m = 0; m < 4; ++m)
#pragma unroll
                for (int n = 0; n < NT; ++n) acc[m][n] = __builtin_amdgcn_mfma_f32_16x16x32_bf16(fa[s_][m], fb[s_][n], acc[m][n], 0, 0, 0);
        __builtin_amdgcn_sched_barrier(0);
    } else {
        constexpr int NC2 = KW / 64;
        bf16x8 fa[3][2][4], fb[3][2][NT];
#define SG_LD(buf, c) do { _Pragma("unroll") for (int s_ = 0; s_ < 2; ++s_) { \
            _Pragma("unroll") for (int m = 0; m < 4; ++m) fa[buf][s_][m] = *(const bf16x8*)(ap + (size_t)m * 16 * lda + (c) * 64 + s_ * 32); \
            _Pragma("unroll") for (int n = 0; n < NT; ++n) fb[buf][s_][n] = *(const bf16x8*)(bp + (size_t)n * 16 * ldb + (c) * 64 + s_ * 32); } } while (0)
        SG_LD(0, 0); SG_LD(1, 1);
        __builtin_amdgcn_sched_barrier(0);
#pragma unroll
        for (int c = 0; c < NC2; ++c) {
            if (c + 2 < NC2) SG_LD((c + 2) % 3, c + 2);
            __builtin_amdgcn_sched_barrier(0);
#pragma unroll
            for (int s_ = 0; s_ < 2; ++s_)
#pragma unroll
                for (int m = 0; m < 4; ++m)
#pragma unroll
                    for (int n = 0; n < NT; ++n) acc[m][n] = __builtin_amdgcn_mfma_f32_16x16x32_bf16(fa[c % 3][s_][m], fb[c % 3][s_][n], acc[m][n], 0, 0, 0);
            __builtin_amdgcn_sched_barrier(0);
        }
#undef SG_LD
    }
    LAS float* P = (LAS float*)lds + wave * (64 * NC);
#pragma unroll
    for (int m = 0; m < 4; ++m)
#pragma unroll
        for (int n = 0; n < NT; ++n)
#pragma unroll
            for (int i = 0; i < 4; ++i) P[(m * 16 + fq * 4 + i) * NC + n * 16 + fr] = acc[m][n][i];
    __syncthreads();
    constexpr int EPT = 64 * NC / 512;
    const int e0 = tid * EPT, row = e0 / NC, col = e0 % NC;
    float r[EPT];
#pragma unroll
    for (int j = 0; j < EPT; ++j) r[j] = 0.f;
#pragma unroll
    for (int w = 0; w < 8; ++w) { const LAS f32x4* q = (const LAS f32x4*)((LAS float*)lds + w * (64 * NC) + e0);
#pragma unroll
        for (int j = 0; j < EPT / 4; ++j) { const f32x4 v = q[j]; r[4 * j] += v[0]; r[4 * j + 1] += v[1]; r[4 * j + 2] += v[2]; r[4 * j + 3] += v[3]; } }
    if (rs) { const float sc = rs[m0 + row];
#pragma unroll
        for (int j = 0; j < EPT; ++j) r[j] *= sc; }
    if (ACT == 1) {
#pragma unroll
        for (int j = 0; j < EPT; ++j) { const float t = fmaxf(r[j], 0.f); r[j] = t * t; } }
    bf16* op = O + (size_t)(m0 + row) * ldc + n0 + col;
    if (EPT == 8) { v4u w; w.x = pk2(r[0], r[1]); w.y = pk2(r[2], r[3]); w.z = pk2(r[4 % EPT], r[5 % EPT]); w.w = pk2(r[6 % EPT], r[7 % EPT]); *(v4u*)op = w; }
    else { v2u w; w.x = pk2(r[0], r[1]); w.y = pk2(r[2], r[3]); *(v2u*)op = w; }
    __syncthreads();
}

#define SMALL_TN(j, ntn) ((((j) >> 8) * 32 + ((j) & 7) * 4 + (((j) >> 3) & 3)))
constexpr int NPH = 15;
#ifndef REP_PRO
#define REP_PRO 1
#endif
#ifndef REP_GEMM
#define REP_GEMM 1
#endif
#ifndef REP_MIX
#define REP_MIX 1
#endif
#ifndef REP_SYNC
#define REP_SYNC 1
#endif
struct Args { const float* in[24]; float* out; unsigned char* ws; int ph_lo, ph_hi; };
__global__ void __launch_bounds__(NWAVES * 64, 2) hybrid_fwd(Args args) {
    extern __shared__ __attribute__((aligned(16))) unsigned char lds_raw[];
    LAS unsigned char* lds = (LAS unsigned char*)lds_raw;
    volatile LAS unsigned* MISC = (volatile LAS unsigned*)(lds + MISC_OFF);
    if (threadIdx.x < 64) MISC[threadIdx.x] = 0u;
    __syncthreads();
    (void)xcd_barrier_post((unsigned*)(args.ws + WS_CTL), MISC + 8);
    for (int ph = args.ph_lo; ph < args.ph_hi;) {
        int tid = threadIdx.x; asm volatile("" : "+v"(tid));
        const int lane = tid & 63, wave = __builtin_amdgcn_readfirstlane(tid >> 6);
        const int G = gridDim.x; const int bx = blockIdx.x;
        unsigned char* ws = args.ws;
        if (ph == 0) {
            const int vcu = (G % 8 == 0) ? (bx % 8) * (G / 8) + bx / 8 : bx; const int gw = vcu * NWAVES + wave, NGW = G * NWAVES;
            LAS float* scr = (LAS float*)(lds + wave * WAVE_SCR);
            bf16* XN = (bf16*)(ws + WS_XN); bf16* SGW = (bf16*)(ws + WS_SGUW);
            constexpr int I_FOLD = 4 * (DM / 32), I_OUT = (DM / 64) * (DM / 32) - I_FOLD, I_IN = (DM / 64) * (INW / 32), I_UP = (DM / 64) * (FF / 32), I_DN = (FF / 64) * (DM / 32);
            constexpr int I_LAYER = I_OUT + I_IN + I_UP + I_DN, I_ALL = DEPTH * I_LAYER;
            for (int it = gw; it < DEPTH * I_FOLD * 4; it += NGW) { const int l = it / (I_FOLD * 4), r = it % (I_FOLD * 4);
                fold_item(args.in[10] + (size_t)l * DM * DM, (bf16*)(ws + WS_W + (size_t)l * W_LAYER + W_OUT), args.in[11] + (size_t)l * 4 * 64 * 64, args.in[12] + (size_t)l * GW, scr, r, lane); }
#define TR_DECODE(it_, d_) do { const int l_ = (it_) / I_LAYER; int r_ = (it_) % I_LAYER; unsigned char* wl_ = ws + WS_W + (size_t)l_ * W_LAYER; int nblk_; \
                if (r_ < I_OUT) { r_ += I_FOLD; d_.W = args.in[10] + (size_t)l_ * DM * DM; d_.WT = (bf16*)(wl_ + W_OUT); d_.gk = nullptr; d_.K = DM; d_.N = DM; } \
                else if ((r_ -= I_OUT) < I_IN) { d_.W = args.in[9] + (size_t)l_ * DM * INW; d_.WT = (bf16*)(wl_ + W_IN); d_.gk = args.in[5] + (size_t)l_ * DM; d_.K = DM; d_.N = INW; } \
                else if ((r_ -= I_IN) < I_UP) { d_.W = args.in[22] + (size_t)l_ * DM * FF; d_.WT = (bf16*)(wl_ + W_UP); d_.gk = args.in[7] + (size_t)l_ * DM; d_.K = DM; d_.N = FF; } \
                else { r_ -= I_UP; d_.W = args.in[23] + (size_t)l_ * FF * DM; d_.WT = (bf16*)(wl_ + W_DN); d_.gk = nullptr; d_.K = FF; d_.N = DM; } \
                nblk_ = d_.N / 32; d_.k0 = 64 * (r_ / nblk_); d_.n0 = 32 * (r_ % nblk_); } while (0)
            { const int TSTEP = NGW; int it = NGW - 1 - gw;
              if (it >= 0 && it < I_ALL) {
                TrDesc dc; TR_DECODE(it, dc);
                float va[32], vb[32];
                tr_load(va, dc, lane);
#pragma unroll 1
                for (;;) {
                    const int itn = it + TSTEP; const bool more = itn < I_ALL;
                    TrDesc dn; { const int q = more ? itn : it; TR_DECODE(q, dn); }
                    tr_load(vb, dn, lane);
                    tr_store(va, dc, scr, lane);
                    if (!more) break;
#pragma unroll
                    for (int i = 0; i < 32; ++i) va[i] = vb[i];
                    dc = dn; it = itn;
                }
              }
            }
#undef TR_DECODE
            for (int m = gw; m < MT; m += NGW) rms_row_to_bf16(m < MP ? args.in[0] + (size_t)m * DM : args.in[1] + (size_t)(m - MP) * DM, (bf16*)args.out + (size_t)m * 2 * DM, (float*)(ws + WS_RS) + m, lane);
            for (int e = bx * (NWAVES * 64) + tid; e < DEPTH * 4 * 128 * 128; e += G * NWAVES * 64) { const int t = (e >> 7) & 127, s = e & 127; SGW[e] = (bf16)(s <= t ? f2bf(args.in[19][e]) : 0u); }
        } else {
            const int l = (ph - 1) / 7, k = (ph - 1) - 7 * l;
            unsigned char* wl = ws + WS_W + (size_t)l * W_LAYER;
            if (k == 0 || k == 2 || k == 5) {
                const bf16* A = k == 0 ? (const bf16*)args.out : (const bf16*)(ws + (k == 2 ? WS_CAT : WS_H));
                const bf16* Bt = (const bf16*)(wl + (k == 0 ? W_IN : k == 2 ? W_OUT : W_DN));
                bf16* O = (bf16*)(ws + (k == 0 ? WS_Z : WS_O));
                const int N = k == 0 ? INW : DM, K = k == 5 ? FF : DM;
                pg8::Gemm g{A, Bt, MP, N, K, k == 5 ? FP : k == 0 ? 2 * DM : DP, K + WPAD}; pg8::StaticOrder S; S.init(MP, N, G, bx);
                pg8::EpiBf16<0> E{O, k == 0 ? ZP : OP, k == 0 ? (const float*)(ws + WS_RS) : nullptr};
                pg8::gemm_phase<pg8::EpiBf16<0>, pg8::StaticOrder, true, true>(lds, g, S, E, tid);
                if (k == 0) { for (int j = bx; j < (MS / 64) * (INW / 64); j += G) small_gemm_tile<4, 0, DM>(lds, A, Bt, O, ZP, 2 * DM, DM + WPAD, (const float*)(ws + WS_RS), MP + ((j >> 5) & 7) * 64, SMALL_TN(j, INW / 64) * 64, tid); }
                else { for (int j = bx; j < (MS / 64) * (DM / 32); j += G) { if (k == 2) small_gemm_tile<2, 0, DM>(lds, A, Bt, O, OP, DP, DM + WPAD, nullptr, MP + ((j >> 5) & 7) * 64, SMALL_TN(j, DM / 32) * 32, tid); else small_gemm_tile<2, 0, FF>(lds, A, Bt, O, OP, FP, FF + WPAD, nullptr, MP + ((j >> 5) & 7) * 64, SMALL_TN(j, DM / 32) * 32, tid); } }
            } else if (k == 4) {
                pg8::Gemm g{(const bf16*)args.out, (const bf16*)(wl + W_UP), MP, FF, DM, 2 * DM, DM + WPAD}; pg8::StaticOrder S; S.init(MP, FF, G, bx);
                pg8::EpiBf16<1> E{(bf16*)(ws + WS_H), FP, (const float*)(ws + WS_RS)};
                pg8::gemm_phase<pg8::EpiBf16<1>, pg8::StaticOrder, true, true>(lds, g, S, E, tid);
                for (int j = bx; j < (MS / 64) * (FF / 64); j += G) small_gemm_tile<4, 1, DM>(lds, (const bf16*)args.out, (const bf16*)(wl + W_UP), (bf16*)(ws + WS_H), FP, 2 * DM, DM + WPAD, (const float*)(ws + WS_RS), MP + ((j >> 5) & 7) * 64, SMALL_TN(j, FF / 64) * 64, tid);
            } else if (k == 1) {
                const int vcu = (G % 8 == 0) ? (bx % 8) * (G / 8) + bx / 8 : bx; const int gw = vcu * NWAVES + wave, NGW = G * NWAVES;
                LAS float* scr = (LAS float*)(lds + wave * WAVE_SCR);
                const bf16* ZB = (const bf16*)(ws + WS_Z); bf16* CAT = (bf16*)(ws + WS_CAT); const bf16* SGW = (const bf16*)(ws + WS_SGUW) + (size_t)l * 4 * 128 * 128;
                float* out = args.out;
                constexpr int NU_SGU = 512, NU_CONV = 2048, NU_SEG = 1024, NU_SMP = 2048, NU = NU_SGU + NU_CONV + 2 * NU_SEG + NU_SMP;
#pragma unroll 1
                for (int ui = 0; ; ++ui) {
                    int u;
                    if (NGW != 2048) { u = ui * NGW + gw; if (u >= NU) break; }
                    else { if (ui >= 4) break;
                        if (gw < 512) { if (ui == 0) u = gw; else if (ui == 1) u = NU_SGU + 1536 + gw; else break; }
                        else { const int g5 = gw - 512; if (ui == 0) u = NU_SGU + g5; else { const int sidx = (ui - 1) * 1536 + g5; if (sidx >= 2 * NU_SEG + NU_SMP) break; u = NU_SGU + NU_CONV + sidx; } } }
                    int lane = tid & 63; asm volatile("" : "+v"(lane));
                    if (u < NU_SGU) { sgu_unit(ZB, CAT, SGW, args.in[17] + (size_t)l * GW, args.in[18] + (size_t)l * GW, args.in[20] + (size_t)l * 4 * 128, u >> 2, u & 3, (LAS bf16*)scr, lane); continue; }
                    int r = u - NU_SGU;
                    if (r < NU_CONV) { const int seg = r >> 2, h = r & 3, seq = seg >> 6, t0 = (seg & 63) * 32;
                        conv_unit_p(ZB, CAT, out + OUT_CONV_P + (size_t)l * NBP * 30 * GW, args.in[13] + (size_t)l * 31 * GW, args.in[14] + (size_t)l * GW, args.in[15] + (size_t)l * GW, args.in[16] + (size_t)l * GW, seq, t0, h, scr, lane);
                        continue; }
                    r -= NU_CONV;
                    if (r < 2 * NU_SEG) { const int ty = r / NU_SEG, q = r % NU_SEG, seg = q >> 2, h = q & 3, seq = seg >> 5, t0 = (seg & 31) * 64;
                        if (ty == 0) { float* np = out + OUT_POOL_P + (size_t)l * NBP * 15 * GW;
                            if (h == 0) pool_unit_p<2>(ZB, CAT, np, seq, t0, h, lane); else if (h == 1) pool_unit_p<4>(ZB, CAT, np, seq, t0, h, lane);
                            else if (h == 2) pool_unit_p<8>(ZB, CAT, np, seq, t0, h, lane); else pool_unit_p<16>(ZB, CAT, np, seq, t0, h, lane); }
                        else short_unit_p(ZB, CAT, out + OUT_SHORT_P + (size_t)l * NBP * 2 * GW, args.in[21] + (size_t)l * 3 * GW, seq, t0, h, lane);
                        continue; }
                    r -= 2 * NU_SEG;
                    { const int ty = r >> 9, q = r & 511, seq = q >> 2, h = q & 3;
                        if (ty == 0) conv_unit<true>(ZB, CAT, args.in[3] + (size_t)l * NSB * 30 * GW, out + OUT_CONV_S + (size_t)l * NSB * 30 * GW, args.in[13] + (size_t)l * 31 * GW, args.in[14] + (size_t)l * GW, args.in[15] + (size_t)l * GW, args.in[16] + (size_t)l * GW, seq, 0, ST, h, scr, lane);
                        else if (ty == 1) pool_unit<true>(ZB, CAT, args.in[2] + (size_t)l * NSB * 15 * GW, out + OUT_POOL_S + (size_t)l * NSB * 15 * GW, seq, 0, ST, h, lane);
                        else if (ty == 2) short_unit<true>(ZB, CAT, args.in[4] + (size_t)l * NSB * 2 * GW, out + OUT_SHORT_S + (size_t)l * NSB * 2 * GW, args.in[21] + (size_t)l * 3 * GW, seq, 0, ST, h, lane);
                        else sgu_sample_unit(ZB, CAT, args.in[19] + (size_t)l * 4 * 128 * 128, args.in[17] + (size_t)l * GW, args.in[18] + (size_t)l * GW, args.in[20] + (size_t)l * 4 * 128, out + OUT_V_S + (size_t)l * NSB * ST * GW, seq, h, lane); }
                }
            } else {
                const int vcu = (G % 8 == 0) ? (bx % 8) * (G / 8) + bx / 8 : bx; const int gw = vcu * NWAVES + wave, NGW = G * NWAVES;
                const float* g = args.in[k == 3 ? 6 : 8] + (size_t)l * DM;
                float* X = args.out; const bf16* OB = (const bf16*)(ws + WS_O); float* RS = (float*)(ws + WS_RS);
                const bool from_input = (l == 0 && k == 3), write_xn = !(l == DEPTH - 1 && k == 6);
                f32x4 gg[4];
#pragma unroll
                for (int j = 0; j < 4; ++j) gg[j] = ((const f32x4*)g + lane)[64 * j];
                const int m_lo = 0;
#define EW_X32(m) ((m) < MP ? args.in[0] + (size_t)(m) * DM : args.in[1] + (size_t)((m) - MP) * DM)
                bf16* X16 = (bf16*)args.out;
                const bool dst16 = write_xn;
#pragma unroll 1
                for (int m = m_lo + gw; m < MT; m += 2 * NGW) {
                    const int m2 = m + NGW; const bool two = m2 < MT;
                    EwRow ra, rb;
                    ew_load(ra, nullptr, X16 + (size_t)m * 2 * DM, true, OB + (size_t)m * OP, lane);
                    { const int mc = two ? m2 : m; ew_load(rb, nullptr, X16 + (size_t)mc * 2 * DM, true, OB + (size_t)mc * OP, lane); }
                    ew_finish(ra, gg, X + (size_t)m * DM, X16 + (size_t)m * 2 * DM, dst16, RS + m, write_xn, lane);
                    if (two) ew_finish(rb, gg, X + (size_t)m2 * DM, X16 + (size_t)m2 * 2 * DM, dst16, RS + m2, write_xn, lane);
                }
#undef EW_X32
            }
        }
        ++ph;
        if (ph < args.ph_hi) {
            if (args.ph_lo < 0) cg::this_grid().sync();
            else { XcdBarrier b; b.bar = (unsigned*)(args.ws + WS_CTL); b.x = xb_xcc_id(); b.st = (volatile LAS unsigned*)(lds + MISC_OFF) + 8; xcd_barrier(b); }
        }
    }
}

#ifndef MK_N_LAUNCHES
#define MK_N_LAUNCHES 1
#endif
extern "C" void kernel_launch(void* const* d_in, const int* in_sizes, int n_in, void* d_out, int out_size, void* d_ws, size_t ws_size, hipStream_t stream) {
    static int grid = 0;
    if (grid == 0) {
        if (n_in != 24 || (size_t)out_size != OUT_END || ws_size < WS_END) { fprintf(stderr, "kernel_launch: unexpected shapes (n_in %d out %d ws %zu)\n", n_in, out_size, ws_size); grid = -1; return; }
        int dev = 0, cus = 0, per_cu = 0;
        if (hipGetDevice(&dev) != hipSuccess || hipDeviceGetAttribute(&cus, hipDeviceAttributeMultiprocessorCount, dev) != hipSuccess) { grid = -1; return; }
        if (hipFuncSetAttribute((const void*)hybrid_fwd, hipFuncAttributeMaxDynamicSharedMemorySize, LDS_BYTES) != hipSuccess) { fprintf(stderr, "kernel_launch: hipFuncSetAttribute failed\n"); grid = -1; return; }
        if (hipOccupancyMaxActiveBlocksPerMultiprocessor(&per_cu, (const void*)hybrid_fwd, NWAVES * 64, LDS_BYTES) != hipSuccess || per_cu < 1) per_cu = 1;
        (void)hipGetLastError();
        grid = cus * per_cu;
    }
    if (grid < 0) return;
    if (hipMemsetAsync((char*)d_ws + WS_CTL, 0, CTL_ZERO_BYTES, stream) != hipSuccess) { fprintf(stderr, "kernel_launch: hipMemsetAsync failed\n"); return; }
    Args a{};
    for (int i = 0; i < 24; ++i) a.in[i] = (const float*)d_in[i];
    a.out = (float*)d_out; a.ws = (unsigned char*)d_ws;
#if MK_N_LAUNCHES == 1
    a.ph_lo = 0; a.ph_hi = NPH;
    void* kargs[] = {&a};
    hipError_t e = hipLaunchCooperativeKernel((const void*)hybrid_fwd, dim3(grid), dim3(NWAVES * 64), kargs, LDS_BYTES, stream);
    if (e != hipSuccess) fprintf(stderr, "cooperative launch failed: %s (grid %d)\n", hipGetErrorString(e), grid);
#else
    for (int p = 0; p < NPH; ++p) { a.ph_lo = p; a.ph_hi = p + 1; hipLaunchKernelGGL(hybrid_fwd, dim3(grid), dim3(NWAVES * 64), LDS_BYTES, stream, a); }
#endif
}
```

```cpp
#include <hip/hip_runtime.h>
#include <hip/hip_cooperative_groups.h>
#include <cstdio>
#include <cstdint>
namespace pg8 {
#define PG8_LAS __attribute__((address_space(3)))
typedef unsigned short bf16_t;
typedef short bf16x8 __attribute__((ext_vector_type(8)));
typedef float f32x4 __attribute__((ext_vector_type(4)));
typedef unsigned u32x4 __attribute__((ext_vector_type(4)));
constexpr int KPAD = 64;
constexpr int BM = 256, BK = 64, HALF = 128, HTB = HALF * BK * 2  , STAGE_BYTES = 8 * HTB, NXCD = 8, WGM = 1;

__host__ __device__ __forceinline__ int lds_byte(int r, int c) { const int st = (r >> 4) * 2 + (c >> 5), rr = r & 15, cc = c & 31, ob = rr * 64 + cc * 2; return st * 1024 + (ob ^ (((ob >> 9) & 1) << 5)); }
__host__ __device__ __forceinline__ void stage_rc(int b, int& R, int& C) { const int st = b / 1024, sb = b % 1024, swz = sb ^ (((sb >> 9) & 1) << 5); R = (st >> 1) * 16 + swz / 64; C = (st & 1) * 32 + (swz % 64) / 2; }
__host__ __device__ __forceinline__ int perm32(int rho) { const int n = rho >> 4, i = rho & 15; return 8 * (i >> 2) + 4 * n + (i & 3); }

struct Unit { int pm, pn; };
struct Gemm { const bf16_t* A; const bf16_t* Bt; int M, N, K, lda, ldb; };

struct StaticOrder {
    int nM, nN, nwg, G, c;
    __host__ __device__ void init(int M, int N, int G_, int c_) { nM = M / BM; nN = N / BM; nwg = nM * nN; G = G_; c = c_; }
    __host__ __device__ bool next(int i, Unit& u) const {
        const long L = (long)i * G + c; if (L >= nwg) return false;
        int wgid = (int)L; { const int q = nwg / NXCD, r = nwg % NXCD, xcd = wgid % NXCD, off = wgid / NXCD; wgid = (xcd < r ? xcd * (q + 1) : r * (q + 1) + (xcd - r) * q) + off; }
        const int nig = WGM * nN, gid = wgid / nig, fm = gid * WGM, gsz = (nM - fm) < WGM ? (nM - fm) : WGM;
        u.pm = fm + ((wgid % nig) % gsz); u.pn = (wgid % nig) / gsz; return true;
    }
    __device__ __forceinline__ void a_ready(const Unit&) const {}
    __device__ __forceinline__ void done(const Unit&) const {}
};

__device__ __forceinline__ unsigned cvt_pk_bf16(float lo, float hi) { unsigned r; asm volatile("v_cvt_pk_bf16_f32 %0, %1, %2" : "=v"(r) : "v"(lo), "v"(hi)); return r; }
__device__ __forceinline__ float relu_sq(float x) { float r; asm volatile("v_max_f32 %0, 0, %1" : "=v"(r) : "v"(x)); return r * r; }
__device__ __forceinline__ void st16_wt(void* p, u32x4 v) { asm volatile("global_store_dwordx4 %0, %1, off sc1" :: "v"(p), "v"(v) : "memory"); }
template <int ACT  > struct EpiBf16 {
    static constexpr bool PERM = true, AFTER_DRAIN = false;
    bf16_t* O; int ldc; const float* rs;
    __device__ __forceinline__ void operator()(const f32x4 (&acc)[2][2][4][2], const Unit& u, int wr, int wc, int fr, int fq) const {
        const int row0 = u.pm * BM + wr * 64 + fr; const int col0 = u.pn * BM + wc * 32 + 8 * fq;
#pragma unroll
        for (int ai = 0; ai < 2; ++ai)
#pragma unroll
            for (int m = 0; m < 4; ++m) { bf16_t* rowp = O + (size_t)(row0 + ai * HALF + m * 16) * ldc + col0; const float sc = rs ? rs[row0 + ai * HALF + m * 16] : 1.f;
#pragma unroll
                for (int bj = 0; bj < 2; ++bj) { f32x4 v0 = acc[ai][bj][m][0] * sc, v1 = acc[ai][bj][m][1] * sc;
                    if (ACT == 1) {
#pragma unroll
                        for (int e = 0; e < 4; ++e) { v0[e] = relu_sq(v0[e]); v1[e] = relu_sq(v1[e]); } }
                    u32x4 w; w.x = cvt_pk_bf16(v0[0], v0[1]); w.y = cvt_pk_bf16(v0[2], v0[3]); w.z = cvt_pk_bf16(v1[0], v1[1]); w.w = cvt_pk_bf16(v1[2], v1[3]);
                    *(u32x4*)(rowp + bj * HALF) = w; } }
    }
};

template <class Epi, class Sched, bool ALIGN_EPI = false, bool SP2 = false>
__device__ __forceinline__ void gemm_phase(PG8_LAS unsigned char* lds, const Gemm g, const Sched& S, const Epi& E, const int tid) {
    const int wid = __builtin_amdgcn_readfirstlane(tid >> 6), lane = tid & 63, wr = wid >> 2, wc = wid & 3, fr = lane & 15, fq = lane >> 4;
    const int K = g.K, nt = K / BK;
    unsigned voffA[2], voffB[2];
#pragma unroll
    for (int i = 0; i < 2; ++i) { int R, C; stage_rc(tid * 16 + i * 8192, R, C); const int Rb = Epi::PERM ? ((R & ~31) + perm32(R & 31)) : R;
        voffA[i] = (unsigned)(R * g.lda + C) * 2u; voffB[i] = (unsigned)(Rb * g.ldb + C) * 2u; }
    const size_t kstep = (size_t)(BK * 2);
    const size_t hstepA = (size_t)HALF * g.lda * 2, hstepB = (size_t)HALF * g.ldb * 2;
    const size_t tstepA = 2 * hstepA, tstepB = 2 * hstepB;
    const unsigned ldsw = (unsigned)wid * 1024u;
    const int aoff = lds_byte(wr * 64 + fr, fq * 8), boff = lds_byte(wc * 32 + fr, fq * 8);
#define PG8_SA(b, h) (((b) * 2 + (h)) * HTB)
#define PG8_SB(b, h) ((4 + (b) * 2 + (h)) * HTB)
#define PG8_STAGE(bufoff, gbase, voff) do { _Pragma("unroll") for (int _i = 0; _i < 2; ++_i) \
        __builtin_amdgcn_global_load_lds((const unsigned*)((const char*)(gbase) + (voff)[_i]), (PG8_LAS unsigned*)(lds + (bufoff) + ldsw + _i * 8192), 16, 0, 0); } while (0)
#define PG8_LDA(dst, b, h) do { _Pragma("unroll") for (int m = 0; m < 4; ++m) _Pragma("unroll") for (int k = 0; k < 2; ++k) dst[m][k] = *(const PG8_LAS bf16x8*)(lds + PG8_SA(b, h) + aoff + m * 2048 + k * 1024); } while (0)
#define PG8_LDB(dst, b, h) do { _Pragma("unroll") for (int n = 0; n < 2; ++n) _Pragma("unroll") for (int k = 0; k < 2; ++k) dst[n][k] = *(const PG8_LAS bf16x8*)(lds + PG8_SB(b, h) + boff + n * 2048 + k * 1024); } while (0)
#define PG8_MMA(ai, bj, At, Bt) do { __builtin_amdgcn_s_setprio(1); _Pragma("unroll") for (int m = 0; m < 4; ++m) _Pragma("unroll") for (int n = 0; n < 2; ++n) _Pragma("unroll") for (int k = 0; k < 2; ++k) \
        acc[ai][bj][m][n] = __builtin_amdgcn_mfma_f32_16x16x32_bf16(Bt[n][k], At[m][k], acc[ai][bj][m][n], 0, 0, 0); __builtin_amdgcn_s_setprio(0); } while (0)
#define PG8_WAIT_V(n) asm volatile("s_waitcnt vmcnt(" #n ")" ::: "memory")
#define PG8_WAIT_L(n) asm volatile("s_waitcnt lgkmcnt(" #n ")" ::: "memory")
#define PG8_BAR __builtin_amdgcn_s_barrier()
#define PG8_SCHED __builtin_amdgcn_sched_barrier(0)
    Unit cur, nxt; int ui = 0;
    if (!S.next(0, cur)) return;
    f32x4 acc[2][2][4][2];
#pragma unroll
    for (int a = 0; a < 2; ++a)
#pragma unroll
        for (int b = 0; b < 2; ++b)
#pragma unroll
            for (int m = 0; m < 4; ++m)
#pragma unroll
                for (int n = 0; n < 2; ++n) acc[a][b][m][n] = (f32x4){0.f, 0.f, 0.f, 0.f};
    bf16x8 At[4][2], B0[2][2], B1[2][2];
    const char* cA = (const char*)g.A + (size_t)cur.pm * tstepA; const char* cB = (const char*)g.Bt + (size_t)cur.pn * tstepB;
    S.a_ready(cur);
    if constexpr (SP2) {
        PG8_STAGE(PG8_SB(0, 0), cB, voffB); PG8_STAGE(PG8_SB(0, 1), cB + hstepB, voffB); PG8_STAGE(PG8_SA(0, 0), cA, voffA); PG8_STAGE(PG8_SA(0, 1), cA + hstepA, voffA);
        if (wr == 1) PG8_BAR;
        PG8_WAIT_V(2); PG8_BAR;
        PG8_STAGE(PG8_SB(1, 0), cB + kstep, voffB); PG8_STAGE(PG8_SA(1, 0), cA + kstep, voffA); PG8_STAGE(PG8_SB(1, 1), cB + hstepB + kstep, voffB);
        PG8_WAIT_V(6); PG8_BAR;
    } else {
        PG8_STAGE(PG8_SB(0, 0), cB, voffB); PG8_STAGE(PG8_SA(0, 0), cA, voffA); PG8_STAGE(PG8_SB(0, 1), cB + hstepB, voffB); PG8_STAGE(PG8_SA(0, 1), cA + hstepA, voffA);
        if (wr == 1) PG8_BAR;
        PG8_WAIT_V(4); PG8_BAR;
        PG8_STAGE(PG8_SB(1, 0), cB + kstep, voffB); PG8_STAGE(PG8_SA(1, 0), cA + kstep, voffA); PG8_STAGE(PG8_SB(1, 1), cB + hstepB + kstep, voffB);
        PG8_WAIT_V(6); PG8_BAR;
    }
    for (;;) {
        const bool has_next = S.next(ui + 1, nxt);
        const char* nA = has_next ? (const char*)g.A + (size_t)nxt.pm * tstepA : cA; const char* nB = has_next ? (const char*)g.Bt + (size_t)nxt.pn * tstepB : cB;
        for (int t = 0; t < nt; t += 2) {
            const bool last = (t == nt - 2);
            const char* a1 = cA + (size_t)(t + 1) * kstep;
            const char* a2 = last ? nA : cA + (size_t)(t + 2) * kstep; const char* b2 = last ? nB : cB + (size_t)(t + 2) * kstep;
            const char* a3 = a2 + kstep; const char* b3 = b2 + kstep;
            if (last && has_next) S.a_ready(nxt);
            if constexpr (SP2) {
            PG8_LDB(B0, 0, 0); PG8_LDB(B1, 0, 1); PG8_SCHED; PG8_LDA(At, 0, 0); PG8_STAGE(PG8_SA(1, 1), a1 + hstepA, voffA);
            PG8_WAIT_V(8); PG8_WAIT_L(0); PG8_BAR; PG8_MMA(0, 0, At, B0); PG8_MMA(0, 1, At, B1); PG8_BAR; PG8_SCHED;
            PG8_LDA(At, 0, 1); PG8_STAGE(PG8_SB(0, 0), b2, voffB); PG8_STAGE(PG8_SB(0, 1), b2 + hstepB, voffB); PG8_STAGE(PG8_SA(0, 0), a2, voffA);
            PG8_WAIT_V(8); PG8_WAIT_L(0); PG8_BAR; PG8_MMA(1, 0, At, B0); PG8_MMA(1, 1, At, B1); PG8_BAR; PG8_SCHED;
            PG8_LDB(B0, 1, 0); PG8_LDB(B1, 1, 1); PG8_SCHED; PG8_LDA(At, 1, 0); PG8_STAGE(PG8_SA(0, 1), a2 + hstepA, voffA);
            PG8_WAIT_V(8); PG8_WAIT_L(0); PG8_BAR; PG8_MMA(0, 0, At, B0); PG8_MMA(0, 1, At, B1); PG8_BAR; PG8_SCHED;
            PG8_LDA(At, 1, 1); PG8_STAGE(PG8_SB(1, 0), b3, voffB); PG8_STAGE(PG8_SB(1, 1), b3 + hstepB, voffB); PG8_STAGE(PG8_SA(1, 0), a3, voffA);
            PG8_WAIT_V(8); PG8_WAIT_L(0); PG8_BAR; PG8_MMA(1, 0, At, B0); PG8_MMA(1, 1, At, B1); PG8_BAR; PG8_SCHED;
            } else {
            PG8_LDB(B0, 0, 0); PG8_SCHED; PG8_LDA(At, 0, 0); PG8_STAGE(PG8_SA(1, 1), a1 + hstepA, voffA);
            PG8_WAIT_L(8); PG8_BAR; PG8_WAIT_L(0); PG8_MMA(0, 0, At, B0); PG8_BAR; PG8_SCHED;
            PG8_LDB(B1, 0, 1); PG8_STAGE(PG8_SB(0, 0), b2, voffB);
            PG8_BAR; PG8_WAIT_L(0); PG8_MMA(0, 1, At, B1); PG8_BAR;
            PG8_LDA(At, 0, 1); PG8_STAGE(PG8_SA(0, 0), a2, voffA);
            PG8_BAR; PG8_WAIT_L(0); PG8_MMA(1, 0, At, B0); PG8_BAR; PG8_SCHED;
            PG8_STAGE(PG8_SB(0, 1), b2 + hstepB, voffB);
            PG8_WAIT_V(6); PG8_BAR; PG8_MMA(1, 1, At, B1); PG8_BAR;
            PG8_LDB(B0, 1, 0); PG8_SCHED; PG8_LDA(At, 1, 0); PG8_STAGE(PG8_SA(0, 1), a2 + hstepA, voffA);
            PG8_WAIT_L(8); PG8_BAR; PG8_WAIT_L(0); PG8_MMA(0, 0, At, B0); PG8_BAR; PG8_SCHED;
            PG8_LDB(B1, 1, 1); PG8_STAGE(PG8_SB(1, 0), b3, voffB);
            PG8_BAR; PG8_WAIT_L(0); PG8_MMA(0, 1, At, B1); PG8_BAR;
            PG8_LDA(At, 1, 1); PG8_STAGE(PG8_SA(1, 0), a3, voffA);
            PG8_BAR; PG8_WAIT_L(0); PG8_MMA(1, 0, At, B0); PG8_BAR; PG8_SCHED;
            PG8_STAGE(PG8_SB(1, 1), b3 + hstepB, voffB);
            PG8_WAIT_V(6); PG8_BAR; PG8_MMA(1, 1, At, B1); PG8_BAR;
            }
        }
        if constexpr (ALIGN_EPI) { if (wr == 0) PG8_BAR; }
        if constexpr (!Epi::AFTER_DRAIN) { E(acc, cur, wr, wc, fr, fq); S.done(cur); }
        if (!has_next) break;
#pragma unroll
        for (int a = 0; a < 2; ++a)
#pragma unroll
            for (int b = 0; b < 2; ++b)
#pragma unroll
                for (int m = 0; m < 4; ++m)
#pragma unroll
                    for (int n = 0; n < 2; ++n) acc[a][b][m][n] = (f32x4){0.f, 0.f, 0.f, 0.f};
        cur = nxt; cA = nA; cB = nB; ++ui;
        if constexpr (ALIGN_EPI) { if (wr == 1) PG8_BAR; }
    }
    PG8_WAIT_V(0);
    if constexpr (!ALIGN_EPI) { if (wr == 0) PG8_BAR; }
    PG8_BAR;
    if constexpr (Epi::AFTER_DRAIN) { E.fused(acc, cur, wr, wc, fr, fq, lds, wid, lane); S.done(cur); }
#undef PG8_SA
#undef PG8_SB
#undef PG8_STAGE
#undef PG8_LDA
#undef PG8_LDB
#undef PG8_MMA
#undef PG8_WAIT_V
#undef PG8_WAIT_L
#undef PG8_BAR
#undef PG8_SCHED
}
}

namespace cg = cooperative_groups;
#define LAS __attribute__((address_space(3)))
typedef unsigned short bf16;
typedef unsigned v4u __attribute__((ext_vector_type(4)));
typedef unsigned v2u __attribute__((ext_vector_type(2)));
typedef float f32x4 __attribute__((ext_vector_type(4)));
typedef short bf16x8 __attribute__((ext_vector_type(8)));

constexpr int NWAVES = 8;
constexpr int DM = 1024, FF = 4096, INW = 2048, GW = 256;
constexpr int ZP = INW + 64;
#ifndef HPAD
#define HPAD 0
#endif
#ifndef WPAD
#define WPAD 0
#endif
#ifndef APAD
#define APAD 0
#endif
constexpr int DP = DM + APAD;
#ifndef OPAD
#define OPAD 0
#endif
constexpr int OP = DM + OPAD;
constexpr int FP = FF + HPAD;
constexpr int MP = 16384, MS = 512, MT = MP + MS;
constexpr int SEQ = 2048, NBP = 8, NSB = 128, ST = 4, DEPTH = 2;
constexpr float EPS = 1e-6f;
constexpr size_t MiB = 1u << 20;
constexpr size_t WS_SGUW = 1 * MiB;
constexpr size_t WS_W = 2 * MiB, W_LAYER = 24 * MiB, W_IN = 0, W_OUT = 9 * MiB / 2, W_UP = 7 * MiB, W_DN = 31 * MiB / 2;
constexpr size_t WS_XN = 50 * MiB, WS_O = 84 * MiB, WS_H = 120 * MiB, WS_Z = 120 * MiB, WS_CAT = 189 * MiB, WS_RS = 254 * MiB  , WS_END = 255 * MiB;
static_assert(WS_Z + (size_t)16896 * ZP * 2 <= WS_CAT && WS_XN + (size_t)16896 * DP * 2 <= WS_O && WS_CAT + (size_t)16896 * DP * 2 <= WS_H + (size_t)16896 * FP * 2 && WS_H + (size_t)16896 * FP * 2 <= WS_END, "d_ws map");
constexpr int LDS_BYTES = 147456;
constexpr int MISC_OFF = LDS_BYTES - 256;
constexpr size_t WS_CTL = 0, CTL_ZERO_BYTES = 128 * 1024;
constexpr int WAVE_SCR = 17408;
constexpr size_t OUT_Y = 0;
constexpr size_t OUT_POOL_P = (size_t)MT * DM;
constexpr size_t OUT_POOL_S = OUT_POOL_P + (size_t)DEPTH * NBP * 15 * GW;
constexpr size_t OUT_CONV_P = OUT_POOL_S + (size_t)DEPTH * NSB * 15 * GW;
constexpr size_t OUT_CONV_S = OUT_CONV_P + (size_t)DEPTH * NBP * 30 * GW;
constexpr size_t OUT_SHORT_P = OUT_CONV_S + (size_t)DEPTH * NSB * 30 * GW;
constexpr size_t OUT_SHORT_S = OUT_SHORT_P + (size_t)DEPTH * NBP * 2 * GW;
constexpr size_t OUT_V_S = OUT_SHORT_S + (size_t)DEPTH * NSB * 2 * GW;
constexpr size_t OUT_END = OUT_V_S + (size_t)DEPTH * NSB * ST * GW;

__device__ __forceinline__ float bf2f(bf16 b) { return __uint_as_float(((unsigned)b) << 16); }
__device__ __forceinline__ unsigned f2bf(float f) { unsigned u = __float_as_uint(f); return (u + 0x7fffu + ((u >> 16) & 1u)) >> 16; }
__device__ __forceinline__ unsigned pk2(float lo, float hi) { return f2bf(lo) | (f2bf(hi) << 16); }
template <int CTRL, int ROWMASK> __device__ __forceinline__ float dpp_get(float v) { return __int_as_float(__builtin_amdgcn_update_dpp(0, __float_as_int(v), CTRL, ROWMASK, 0xF, false)); }
__device__ __forceinline__ float sum8(float v) { v += dpp_get<0xB1, 0xF>(v); v += dpp_get<0x4E, 0xF>(v); v += dpp_get<0x141, 0xF>(v); return v; }
__device__ __forceinline__ float wave_sum(float v) {
    v = sum8(v); v += dpp_get<0x140, 0xF>(v); v += dpp_get<0x142, 0xA>(v); v += dpp_get<0x143, 0xC>(v);
    return __int_as_float(__builtin_amdgcn_readlane(__float_as_int(v), 63));
}
__device__ __forceinline__ void unpack8(const v4u w, float (&f)[8]) {
    f[0] = __uint_as_float(w.x << 16); f[1] = __uint_as_float(w.x & 0xffff0000u); f[2] = __uint_as_float(w.y << 16); f[3] = __uint_as_float(w.y & 0xffff0000u);
    f[4] = __uint_as_float(w.z << 16); f[5] = __uint_as_float(w.z & 0xffff0000u); f[6] = __uint_as_float(w.w << 16); f[7] = __uint_as_float(w.w & 0xffff0000u); }
__device__ __forceinline__ v4u pack8(const float (&f)[8]) { v4u w; w.x = pg8::cvt_pk_bf16(f[0], f[1]); w.y = pg8::cvt_pk_bf16(f[2], f[3]); w.z = pg8::cvt_pk_bf16(f[4], f[5]); w.w = pg8::cvt_pk_bf16(f[6], f[7]); return w; }
__device__ __forceinline__ v4u ld16(const bf16* p) { return *(const v4u*)p; }
__device__ __forceinline__ float sigm(float x) { return __builtin_amdgcn_rcpf(1.f + __builtin_amdgcn_exp2f(-1.44269504f * x)); }
#define LDS_WAIT() asm volatile("s_waitcnt lgkmcnt(0)" ::: "memory")

__device__ __forceinline__ void transpose_item(const float* __restrict__ W, int K, int N, bf16* __restrict__ WT, const float* __restrict__ gk, LAS float* scr, int item, int lane) {
    const int nblk = N / 32, kb = item / nblk, nb = item % nblk, k0 = 64 * kb, n0 = 32 * nb;
#pragma unroll 8
    for (int i = 0; i < 32; ++i) { const int kk = 2 * i + (lane >> 5); float v = W[(size_t)(k0 + kk) * N + n0 + (lane & 31)]; if (gk) v *= gk[k0 + kk]; scr[kk * 33 + (lane & 31)] = v; }
    LDS_WAIT();
    const int c = lane & 7;
#pragma unroll
    for (int j = 0; j < 4; ++j) { const int n = (lane >> 3) + 8 * j; const LAS float* s = scr + (8 * c) * 33 + n;
        v4u o; o.x = pk2(s[0 * 33], s[1 * 33]); o.y = pk2(s[2 * 33], s[3 * 33]); o.z = pk2(s[4 * 33], s[5 * 33]); o.w = pk2(s[6 * 33], s[7 * 33]);
        *(v4u*)(WT + (size_t)(n0 + n) * K + k0 + 8 * c) = o; }
    LDS_WAIT();
}
struct TrDesc { const float* W; bf16* WT; const float* gk; int K, N, k0, n0; };
__device__ __forceinline__ void tr_load(float (&v)[32], const TrDesc& d, int lane) {
    const float* p = d.W + (size_t)(d.k0 + (lane >> 5)) * d.N + d.n0 + (lane & 31);
#pragma unroll
    for (int i = 0; i < 32; ++i) v[i] = p[(size_t)(2 * i) * d.N];
}
__device__ __forceinline__ void tr_store(const float (&v)[32], const TrDesc& d, LAS float* scr, int lane) {
#pragma unroll
    for (int i = 0; i < 32; ++i) { const int kk = 2 * i + (lane >> 5); float x = v[i]; if (d.gk) x *= d.gk[d.k0 + kk]; scr[kk * 33 + (lane & 31)] = x; }
    LDS_WAIT();
    const int c = lane & 7;
#pragma unroll
    for (int j = 0; j < 4; ++j) { const int n = (lane >> 3) + 8 * j; const LAS float* s = scr + (8 * c) * 33 + n;
        v4u o; o.x = pg8::cvt_pk_bf16(s[0 * 33], s[1 * 33]); o.y = pg8::cvt_pk_bf16(s[2 * 33], s[3 * 33]); o.z = pg8::cvt_pk_bf16(s[4 * 33], s[5 * 33]); o.w = pg8::cvt_pk_bf16(s[6 * 33], s[7 * 33]);
        *(v4u*)(d.WT + (size_t)(d.n0 + n) * (d.K + WPAD) + d.k0 + 8 * c) = o; }
    LDS_WAIT();
}
__device__ __forceinline__ void fold_item(const float* __restrict__ W, bf16* __restrict__ WT, const float* __restrict__ wp, const float* __restrict__ ps, LAS float* scr, int item4, int lane) {
    const int K = DM, N = DM; const int item = item4 >> 2, q = item4 & 3; const int nblk = N / 32, g = item / nblk, nb = item % nblk, k0 = 64 * g, n0 = 32 * nb;
    LAS float* scr2 = scr + 64 * 33;
#pragma unroll 8
    for (int i = 0; i < 32; ++i) { const int kk = 2 * i + (lane >> 5); scr[kk * 33 + (lane & 31)] = W[(size_t)(k0 + kk) * N + n0 + (lane & 31)] * ps[k0 + kk]; }
    LDS_WAIT();
    const int n = lane & 31;
#pragma unroll 1
    for (int i = 0; i < 8; ++i) { const int kl = 2 * i + (lane >> 5), kk = 16 * q + kl; const float* wr = wp + (size_t)(g * 64 + kk) * 64; float a = 0.f;
#pragma unroll 16
        for (int d = 0; d < 64; ++d) a += wr[d] * scr[d * 33 + n];
        scr2[kl * 33 + n] = a; }
    LDS_WAIT();
    { const int ch = lane >> 5; const LAS float* s = scr2 + (8 * ch) * 33 + n;
        v4u o; o.x = pk2(s[0 * 33], s[1 * 33]); o.y = pk2(s[2 * 33], s[3 * 33]); o.z = pk2(s[4 * 33], s[5 * 33]); o.w = pk2(s[6 * 33], s[7 * 33]);
        *(v4u*)(WT + (size_t)(n0 + n) * (K + WPAD) + k0 + 16 * q + 8 * ch) = o; }
    LDS_WAIT();
}
__device__ __forceinline__ void rms_row_to_bf16(const float* __restrict__ xrow, bf16* __restrict__ orow, float* __restrict__ rsp, int lane) {
    const f32x4* xr = (const f32x4*)xrow + lane;
    f32x4 v[4]; float s = 0.f;
#pragma unroll
    for (int j = 0; j < 4; ++j) { v[j] = xr[64 * j]; s += (v[j].x * v[j].x + v[j].y * v[j].y) + (v[j].z * v[j].z + v[j].w * v[j].w); }
    const float rstd = rsqrtf(wave_sum(s) * (1.f / DM) + EPS);
    if (lane == 0) *rsp = rstd;
    v2u* o8 = (v2u*)orow + lane;
#pragma unroll
    for (int j = 0; j < 4; ++j) { v2u o; o.x = pg8::cvt_pk_bf16(v[j].x, v[j].y); o.y = pg8::cvt_pk_bf16(v[j].z, v[j].w); o8[64 * j] = o; }
}
struct EwRow { v2u x[4]; v2u o[4]; };
__device__ __forceinline__ f32x4 unpack4(const v2u w) { return (f32x4){__uint_as_float(w.x << 16), __uint_as_float(w.x & 0xffff0000u), __uint_as_float(w.y << 16), __uint_as_float(w.y & 0xffff0000u)}; }
__device__ __forceinline__ void ew_load(EwRow& r, const bf16* __restrict__ xrow16, const bf16* __restrict__ orow, int lane) {
    const v2u* xr = (const v2u*)xrow16 + lane; const v2u* orr = (const v2u*)orow + lane;
#pragma unroll
    for (int j = 0; j < 4; ++j) { r.x[j] = xr[64 * j]; r.o[j] = orr[64 * j]; }
}
__device__ __forceinline__ void ew_finish(const EwRow& r, const f32x4 (&gg)[4], float* __restrict__ Xrow32, bf16* __restrict__ Xrow16, bool dst16, float* __restrict__ rsp, bool write_xn, int lane) {
    f32x4 o[4], x[4]; float so = 0.f;
#pragma unroll
    for (int j = 0; j < 4; ++j) { o[j] = unpack4(r.o[j]); so += (o[j].x * o[j].x + o[j].y * o[j].y) + (o[j].z * o[j].z + o[j].w * o[j].w); }
    const float rs = rsqrtf(wave_sum(so) * (1.f / DM) + EPS); float s1 = 0.f;
#pragma unroll
    for (int j = 0; j < 4; ++j) { x[j] = unpack4(r.x[j]) + o[j] * rs * gg[j]; s1 += (x[j].x * x[j].x + x[j].y * x[j].y) + (x[j].z * x[j].z + x[j].w * x[j].w); }
    if (dst16) { v2u* Xr = (v2u*)Xrow16 + lane;
#pragma unroll
        for (int j = 0; j < 4; ++j) { v2u w; w.x = pg8::cvt_pk_bf16(x[j].x, x[j].y); w.y = pg8::cvt_pk_bf16(x[j].z, x[j].w); Xr[64 * j] = w; } }
    else { f32x4* Xr = (f32x4*)Xrow32 + lane;
#pragma unroll
        for (int j = 0; j < 4; ++j) Xr[64 * j] = x[j]; }
    if (write_xn) { const float r1 = rsqrtf(wave_sum(s1) * (1.f / DM) + EPS); if (lane == 0) *rsp = r1; }
}

template <bool SAMPLE>
__device__ __forceinline__ void pool_unit(const bf16* __restrict__ Z, bf16* __restrict__ CAT, const float* __restrict__ state, float* __restrict__ newp,
                                          int seq, int t0, int nrows, int g, int lane) {
    const int c = g * 64 + lane, w = 2 << g;
    const size_t rowbase = SAMPLE ? (size_t)MP + (size_t)seq * ST : (size_t)seq * SEQ;
    const bf16* zc = Z + rowbase * ZP + c;
    const float* st = state + (size_t)seq * 15 * GW + c;
#define POOL_A(e) ((e) >= 0 ? bf2f(zc[(size_t)(e) * ZP]) : (SAMPLE ? st[(15 + (e)) * GW] : 0.f))
    float S = 0.f;
    for (int j = 1; j < w; ++j) S += POOL_A(t0 - j);
#pragma unroll 4
    for (int t = t0; t < t0 + nrows; ++t) {
        const float a = POOL_A(t); S += a;
        const float cnt = SAMPLE ? (float)w : (float)(t + 1 < w ? t + 1 : w);
        CAT[(rowbase + t) * DP + c] = (bf16)f2bf(S / cnt - a);
        const int e = t - w + 1; S -= POOL_A(e);
    }
    const int T = SAMPLE ? ST : SEQ;
    if (t0 + nrows == T) {
        for (int j = 0; j < 15; ++j) { const int e = T - 15 + j; newp[((size_t)seq * 15 + j) * GW + c] = POOL_A(e); }
    }
#undef POOL_A
}
template <int W>
__device__ __forceinline__ void pool_sample_unit(const bf16* __restrict__ Z, bf16* __restrict__ CAT, const float* __restrict__ state, float* __restrict__ newp, int seq, int g, int lane) {
    const int c = g * 64 + lane;
    const size_t rowbase = (size_t)MP + (size_t)seq * ST;
    float ext[15 + ST];
#pragma unroll
    for (int j = 0; j < 15; ++j) ext[j] = state[((size_t)seq * 15 + j) * GW + c];
#pragma unroll
    for (int t = 0; t < ST; ++t) ext[15 + t] = bf2f(Z[(rowbase + t) * ZP + c]);
#pragma unroll
    for (int t = 0; t < ST; ++t) { float S = 0.f;
#pragma unroll
        for (int i = 0; i < W; ++i) S += ext[15 + t - i];
        CAT[(rowbase + t) * DP + c] = (bf16)f2bf(S * (1.f / W) - ext[15 + t]); }
#pragma unroll
    for (int j = 0; j < 15; ++j) newp[((size_t)seq * 15 + j) * GW + c] = ext[ST + j];
}
template <bool SAMPLE>
__device__ __forceinline__ void short_unit(const bf16* __restrict__ Z, bf16* __restrict__ CAT, const float* __restrict__ state, float* __restrict__ news,
                                           const float* __restrict__ sw, int seq, int t0, int nrows, int h, int lane) {
    const int c = h * 64 + lane;
    const size_t rowbase = SAMPLE ? (size_t)MP + (size_t)seq * ST : (size_t)seq * SEQ;
    const bf16* zc = Z + rowbase * ZP + c;
    const float* st = state + (size_t)seq * 2 * GW + c;
    const float w0 = sw[c], w1 = sw[GW + c], w2 = sw[2 * GW + c];
#define SH_E(e) ((e) >= 0 ? bf2f(zc[(size_t)(e) * ZP + 1536]) * bf2f(zc[(size_t)(e) * ZP + 1792]) : (SAMPLE ? st[(2 + (e)) * GW] : 0.f))
    float e2 = SH_E(t0 - 2), e1 = SH_E(t0 - 1);
#pragma unroll 4
    for (int t = t0; t < t0 + nrows; ++t) {
        const float e0 = SH_E(t); const float bg = bf2f(zc[(size_t)t * ZP + 1280]);
        CAT[(rowbase + t) * DP + 768 + c] = (bf16)f2bf(bg * (w0 * e2 + w1 * e1 + w2 * e0));
        e2 = e1; e1 = e0;
    }
    const int T = SAMPLE ? ST : SEQ;
    if (t0 + nrows == T) { news[((size_t)seq * 2 + 0) * GW + c] = e2; news[((size_t)seq * 2 + 1) * GW + c] = e1; }
#undef SH_E
}
template <bool SAMPLE>
__device__ __forceinline__ void conv_unit(const bf16* __restrict__ Z, bf16* __restrict__ CAT, const float* __restrict__ state, float* __restrict__ newc,
                                          const float* __restrict__ cw, const float* __restrict__ cb, const float* __restrict__ lg, const float* __restrict__ lb,
                                          int seq, int t0, int nrows, int h, LAS float* gL, int lane) {
    const int c = h * 64 + lane;
    const size_t rowbase = SAMPLE ? (size_t)MP + (size_t)seq * ST : (size_t)seq * SEQ;
    const bf16* zc = Z + rowbase * ZP + c;
    bf16* oc = CAT + rowbase * DP + 256 + c;
    const int T = SAMPLE ? ST : SEQ;
    const bool last = (t0 + nrows == T);
    const int nin = nrows + 30;
#pragma unroll
    for (int r = 0; r < nin; ++r) { const int s = t0 - 30 + r; float gs = 0.f;
        if (s >= 0) { const unsigned off = (unsigned)s * ZP; const float p = bf2f(zc[off + 256]), gt = bf2f(zc[off + 512]); gs = p * sigm(gt); }
        else if (SAMPLE) gs = state[((size_t)seq * 30 + 30 + s) * GW + c];
        if (last && s >= T - 30) newc[((size_t)seq * 30 + (s - (T - 30))) * GW + c] = gs;
        gL[r * 64 + lane] = gs; }
    LDS_WAIT();
    float wk[31];
#pragma unroll
    for (int k = 0; k < 31; ++k) wk[k] = cw[k * GW + c];
    const float bias = cb[c], gg = lg[c], bb = lb[c];
#pragma unroll 1
    for (int tq = 0; tq < nrows; tq += 4) {
        float acc[4] = {bias, bias, bias, bias};
#pragma unroll
        for (int r = 0; r < 34; ++r) { const float gv = gL[(tq + r) * 64 + lane];
#pragma unroll
            for (int q = 0; q < 4; ++q) { const int k = r - q; if (k >= 0 && k <= 30) acc[q] += wk[k] * gv; } }
#pragma unroll
        for (int q = 0; q < 4; ++q) { const float cv = acc[q];
            const float mean = wave_sum(cv) * (1.f / 64.f); const float d = cv - mean;
            const float var = wave_sum(d * d) * (1.f / 64.f);
            const float y = d * rsqrtf(var + EPS) * gg + bb;
            oc[(unsigned)(t0 + tq + q) * DP] = (bf16)f2bf(y * sigm(y)); }
    }
    LDS_WAIT();
}
template <int W>
__device__ __forceinline__ void pool_unit_p(const bf16* __restrict__ Z, bf16* __restrict__ CAT, float* __restrict__ newp, int seq, int t0, int g, int lane) {
    const int rr = lane >> 3, cg = lane & 7, c0 = g * 64 + cg * 8, tb = t0 + rr * 8;
    const size_t rowbase = (size_t)seq * SEQ;
    const bf16* zb = Z + (rowbase + tb) * ZP + c0;
    v4u raw[W + 7];
#pragma unroll
    for (int j = 0; j < W + 7; ++j) { const int dj = j - (W - 1); raw[j] = (tb + dj >= 0) ? ld16(zb + (long)dj * ZP) : (v4u){0u, 0u, 0u, 0u}; }
    float S[8];
#pragma unroll
    for (int i = 0; i < 8; ++i) S[i] = 0.f;
#pragma unroll
    for (int j = 0; j < W - 1; ++j) { float f[8]; unpack8(raw[j], f);
#pragma unroll
        for (int i = 0; i < 8; ++i) S[i] += f[i]; }
    bf16* ob = CAT + (rowbase + tb) * DP + c0;
    const bool lastseg = (t0 + 64 == SEQ);
#pragma unroll
    for (int j = 0; j < 8; ++j) { float a[8], o[8], od[8]; unpack8(raw[j + W - 1], a); unpack8(raw[j], od);
        const int t = tb + j; const float inv = 1.f / (float)(t + 1 < W ? t + 1 : W);
#pragma unroll
        for (int i = 0; i < 8; ++i) { S[i] += a[i]; o[i] = S[i] * inv - a[i]; S[i] -= od[i]; }
        *(v4u*)(ob + j * DP) = pack8(o);
        if (lastseg && t >= SEQ - 15) { float* np = newp + ((size_t)seq * 15 + (t - (SEQ - 15))) * GW + c0; *(f32x4*)np = (f32x4){a[0], a[1], a[2], a[3]}; *(f32x4*)(np + 4) = (f32x4){a[4], a[5], a[6], a[7]}; }
    }
}
__device__ __forceinline__ void short_unit_p(const bf16* __restrict__ Z, bf16* __restrict__ CAT, float* __restrict__ news, const float* __restrict__ sw, int seq, int t0, int h, int lane) {
    const int rr = lane >> 3, cg = lane & 7, c0 = h * 64 + cg * 8, tb = t0 + rr * 8;
    const size_t rowbase = (size_t)seq * SEQ;
    const bf16* zb = Z + (rowbase + tb) * ZP + c0;
    v4u Bv[8], Cv[10], Hv[10];
#pragma unroll
    for (int j = 0; j < 10; ++j) { const int dj = j - 2; const bool ok = (tb + dj >= 0);
        Cv[j] = ok ? ld16(zb + (long)dj * ZP + 1536) : (v4u){0u, 0u, 0u, 0u}; Hv[j] = ok ? ld16(zb + (long)dj * ZP + 1792) : (v4u){0u, 0u, 0u, 0u};
        if (j >= 2) Bv[j - 2] = ld16(zb + (long)dj * ZP + 1280); }
    float w0[8], w1[8], w2[8];
#pragma unroll
    for (int i = 0; i < 8; ++i) { w0[i] = sw[c0 + i]; w1[i] = sw[GW + c0 + i]; w2[i] = sw[2 * GW + c0 + i]; }
    float e2[8], e1[8];
    { float c[8], hh[8]; unpack8(Cv[0], c); unpack8(Hv[0], hh);
#pragma unroll
      for (int i = 0; i < 8; ++i) e2[i] = c[i] * hh[i];
      unpack8(Cv[1], c); unpack8(Hv[1], hh);
#pragma unroll
      for (int i = 0; i < 8; ++i) e1[i] = c[i] * hh[i]; }
    bf16* ob = CAT + (rowbase + tb) * DP + 768 + c0;
#pragma unroll
    for (int j = 0; j < 8; ++j) { float c[8], hh[8], b[8], o[8]; unpack8(Cv[j + 2], c); unpack8(Hv[j + 2], hh); unpack8(Bv[j], b);
#pragma unroll
        for (int i = 0; i < 8; ++i) { const float e0 = c[i] * hh[i]; o[i] = b[i] * (w0[i] * e2[i] + w1[i] * e1[i] + w2[i] * e0); e2[i] = e1[i]; e1[i] = e0; }
        *(v4u*)(ob + j * DP) = pack8(o); }
    if (t0 + 64 == SEQ && rr == 7) { float* np = news + (size_t)seq * 2 * GW + c0;
        *(f32x4*)np = (f32x4){e2[0], e2[1], e2[2], e2[3]}; *(f32x4*)(np + 4) = (f32x4){e2[4], e2[5], e2[6], e2[7]};
        *(f32x4*)(np + GW) = (f32x4){e1[0], e1[1], e1[2], e1[3]}; *(f32x4*)(np + GW + 4) = (f32x4){e1[4], e1[5], e1[6], e1[7]}; }
}
__device__ __forceinline__ void conv_unit_p(const bf16* __restrict__ Z, bf16* __restrict__ CAT, float* __restrict__ newc,
                                            const float* __restrict__ cw, const float* __restrict__ cb, const float* __restrict__ lg, const float* __restrict__ lb,
                                            int seq, int t0, int h, LAS float* gL, int lane) {
    const int rr = lane >> 3, cg = lane & 7, c0 = h * 64 + cg * 8;
    const size_t rowbase = (size_t)seq * SEQ;
    const bool last = (t0 + 32 == SEQ);
    { v4u pv[8], gv[8];
#pragma unroll
      for (int j = 0; j < 8; ++j) { const int r = 8 * j + rr, sx = t0 - 30 + r; const bool ok = (sx >= 0 && r < 62);
          const bf16* zp = Z + (rowbase + (ok ? sx : 0)) * ZP + c0;
          pv[j] = ok ? ld16(zp + 256) : (v4u){0u, 0u, 0u, 0u}; gv[j] = ok ? ld16(zp + 512) : (v4u){0u, 0u, 0u, 0u}; }
#pragma unroll
      for (int j = 0; j < 8; ++j) { const int r = 8 * j + rr, sx = t0 - 30 + r; float p[8], gt[8]; unpack8(pv[j], p); unpack8(gv[j], gt);
#pragma unroll
          for (int i = 0; i < 8; ++i) p[i] = p[i] * sigm(gt[i]);
          if (r < 62) { *(LAS f32x4*)(gL + r * 64 + cg * 8) = (f32x4){p[0], p[1], p[2], p[3]}; *(LAS f32x4*)(gL + r * 64 + cg * 8 + 4) = (f32x4){p[4], p[5], p[6], p[7]}; }
          if (last && sx >= SEQ - 30 && r < 62) { float* np = newc + ((size_t)seq * 30 + (sx - (SEQ - 30))) * GW + c0; *(f32x4*)np = (f32x4){p[0], p[1], p[2], p[3]}; *(f32x4*)(np + 4) = (f32x4){p[4], p[5], p[6], p[7]}; } }
    }
    LDS_WAIT();
    const int c = h * 64 + lane;
    float wk[31];
#pragma unroll
    for (int k = 0; k < 31; ++k) wk[k] = cw[k * GW + c];
    const float bias = cb[c];
#pragma unroll 1
    for (int tq = 0; tq < 32; tq += 4) {
        float acc[4] = {bias, bias, bias, bias};
#pragma unroll
        for (int r = 0; r < 34; ++r) { const float gvv = gL[(tq + r) * 64 + lane];
#pragma unroll
            for (int q = 0; q < 4; ++q) { const int k = r - q; if (k >= 0 && k <= 30) acc[q] += wk[k] * gvv; } }
        LDS_WAIT();
#pragma unroll
        for (int q = 0; q < 4; ++q) gL[(tq + q) * 64 + lane] = acc[q];
    }
    LDS_WAIT();
    float gg[8], bb[8];
#pragma unroll
    for (int i = 0; i < 8; ++i) { gg[i] = lg[c0 + i]; bb[i] = lb[c0 + i]; }
    bf16* ob = CAT + (rowbase + t0) * DP + 256 + c0;
#pragma unroll
    for (int j = 0; j < 4; ++j) { const int r = 8 * j + rr; const f32x4 a = *(const LAS f32x4*)(gL + r * 64 + cg * 8), b = *(const LAS f32x4*)(gL + r * 64 + cg * 8 + 4);
        float x[8] = {a[0], a[1], a[2], a[3], b[0], b[1], b[2], b[3]};
        const float mean = sum8(((x[0] + x[1]) + (x[2] + x[3])) + ((x[4] + x[5]) + (x[6] + x[7]))) * (1.f / 64.f);
        float q = 0.f;
#pragma unroll
        for (int i = 0; i < 8; ++i) { x[i] -= mean; q += x[i] * x[i]; }
        const float rstd = rsqrtf(sum8(q) * (1.f / 64.f) + EPS);
#pragma unroll
        for (int i = 0; i < 8; ++i) { const float yy = x[i] * rstd * gg[i] + bb[i]; x[i] = yy * sigm(yy); }
        *(v4u*)(ob + r * DP) = pack8(x); }
    LDS_WAIT();
}
__device__ __forceinline__ int sgu_swz(int c, int chunk) { return (chunk ^ ((c & 15) ^ (c >> 4))) << 3; }
__device__ __forceinline__ void sgu_unit(const bf16* __restrict__ Z, bf16* __restrict__ CAT, const bf16* __restrict__ Wb, const float* __restrict__ lg, const float* __restrict__ lb,
                                         const float* __restrict__ sb, int chunk, int h, LAS bf16* vT, int lane) {
    const size_t r0 = (size_t)chunk * 128;
    { const int rr = lane >> 3, cg = lane & 7, c0 = h * 64 + cg * 8;
      float gg[8], bb[8];
#pragma unroll
      for (int i = 0; i < 8; ++i) { gg[i] = lg[c0 + i]; bb[i] = lb[c0 + i]; }
#pragma unroll 1
      for (int jh = 0; jh < 16; jh += 8) {
          v4u raw[8];
#pragma unroll
          for (int j = 0; j < 8; ++j) raw[j] = ld16(Z + (r0 + 8 * (jh + j) + rr) * ZP + 1024 + c0);
#pragma unroll
          for (int j = 0; j < 8; ++j) { float x[8]; unpack8(raw[j], x);
              float sm = ((x[0] + x[1]) + (x[2] + x[3])) + ((x[4] + x[5]) + (x[6] + x[7])); const float mean = sum8(sm) * (1.f / 64.f);
              float q = 0.f;
#pragma unroll
              for (int i = 0; i < 8; ++i) { x[i] -= mean; q += x[i] * x[i]; }
              const float rstd = rsqrtf(sum8(q) * (1.f / 64.f) + EPS);
#pragma unroll
              for (int i = 0; i < 8; ++i) { const int cl = cg * 8 + i; vT[cl * 128 + sgu_swz(cl, jh + j) + rr] = (bf16)f2bf(x[i] * rstd * gg[i] + bb[i]); } }
      }
    }
    LDS_WAIT();
    const int fr = lane & 15, fq = lane >> 4;
    bf16x8 wf[8][4];
#pragma unroll
    for (int mt = 0; mt < 8; ++mt)
#pragma unroll
        for (int ks = 0; ks < 4; ++ks) if (ks * 32 <= mt * 16 + 15) wf[mt][ks] = *(const bf16x8*)(Wb + ((size_t)(h * 128 + mt * 16 + fr) * 128 + ks * 32 + fq * 8));
#pragma unroll
    for (int mt = 0; mt < 8; ++mt) {
        f32x4 acc[4];
#pragma unroll
        for (int nt = 0; nt < 4; ++nt) acc[nt] = (f32x4){0.f, 0.f, 0.f, 0.f};
        const int t = mt * 16 + fr;
        v2u uv[4];
#pragma unroll
        for (int nt = 0; nt < 4; ++nt) uv[nt] = *(const v2u*)(Z + (r0 + t) * ZP + 768 + h * 64 + nt * 16 + 4 * fq);
        const float bt = sb[h * 128 + t];
#pragma unroll
        for (int ks = 0; ks < 4; ++ks) if (ks * 32 <= mt * 16 + 15) {
#pragma unroll
            for (int nt = 0; nt < 4; ++nt) { const int cl = nt * 16 + fr; const bf16x8 vf = *(const LAS bf16x8*)(vT + cl * 128 + sgu_swz(cl, ks * 4 + fq));
                acc[nt] = __builtin_amdgcn_mfma_f32_16x16x32_bf16(vf, wf[mt][ks], acc[nt], 0, 0, 0); }
        }
#pragma unroll
        for (int nt = 0; nt < 4; ++nt) { const float u0 = __uint_as_float(uv[nt].x << 16), u1 = __uint_as_float(uv[nt].x & 0xffff0000u), u2 = __uint_as_float(uv[nt].y << 16), u3 = __uint_as_float(uv[nt].y & 0xffff0000u);
            v2u w; w.x = pg8::cvt_pk_bf16(u0 * (acc[nt][0] + bt), u1 * (acc[nt][1] + bt)); w.y = pg8::cvt_pk_bf16(u2 * (acc[nt][2] + bt), u3 * (acc[nt][3] + bt));
            *(v2u*)(CAT + (r0 + t) * DP + 512 + h * 64 + nt * 16 + 4 * fq) = w; }
    }
    LDS_WAIT();
}
__device__ __forceinline__ void sgu_sample_unit(const bf16* __restrict__ Z, bf16* __restrict__ CAT, const float* __restrict__ Wf, const float* __restrict__ lg, const float* __restrict__ lb,
                                                const float* __restrict__ sb, float* __restrict__ vout, int seq, int h, int lane) {
    const int c = h * 64 + lane; const size_t rowbase = (size_t)MP + (size_t)seq * ST;
    const float gg = lg[c], bb = lb[c];
    float vn[ST];
#pragma unroll
    for (int t = 0; t < ST; ++t) { const float v = bf2f(Z[(rowbase + t) * ZP + 1024 + c]); const float mean = wave_sum(v) * (1.f / 64.f); const float d = v - mean; const float var = wave_sum(d * d) * (1.f / 64.f);
        vn[t] = d * rsqrtf(var + EPS) * gg + bb; vout[((size_t)seq * ST + t) * GW + c] = vn[t]; }
#pragma unroll
    for (int t = 0; t < ST; ++t) { float sv = sb[h * 128 + t];
#pragma unroll
        for (int s = 0; s <= t; ++s) sv += Wf[((size_t)h * 128 + t) * 128 + s] * vn[s];
        const float u = bf2f(Z[(rowbase + t) * ZP + 768 + c]);
        CAT[(rowbase + t) * DP + 512 + c] = (bf16)f2bf(u * sv); }
}

#define XB_TMO      128
#define XB_XCNT(j)  (256  + 64 * (j))
#define XB_XSUB(j)  (1280 + 64 * (j))
#define XB_XGEN(j)  (2304 + 64 * (j))
#define XB_TOP      3328
#define XB_TOPGEN   3392
#define XCD_BAR_WORDS 3456
#define XB_SPIN_CAP (1u << 18)

__device__ __forceinline__ unsigned xb_ld(unsigned* p)              { return __hip_atomic_load(p, __ATOMIC_RELAXED, __HIP_MEMORY_SCOPE_AGENT); }
__device__ __forceinline__ unsigned xb_add(unsigned* p, unsigned v) { return __hip_atomic_fetch_add(p, v, __ATOMIC_RELAXED, __HIP_MEMORY_SCOPE_AGENT); }
__device__ __forceinline__ unsigned xb_xcc_id() { return (unsigned)__builtin_amdgcn_s_getreg((3 << 11) | 20) & 0xFu; }
#define XB_SPIN(cond, bar) do { unsigned _sp = 0; while (cond) { __builtin_amdgcn_s_sleep(1); \
    if ((++_sp & 255u) == 0u) { if (xb_ld(&(bar)[XB_TMO])) break; if (_sp > XB_SPIN_CAP) { atomicAdd(&(bar)[XB_TMO], 1u); break; } } } } while (0)

struct XcdBarrier {
    unsigned* bar; unsigned x;
    volatile LAS unsigned* st;
};

__device__ __forceinline__ XcdBarrier xcd_barrier_post(unsigned* bar, volatile LAS unsigned* st) {
    XcdBarrier b; b.bar = bar; b.x = xb_xcc_id(); b.st = st;
    if (threadIdx.x == 0) (void)xb_add(&bar[XB_XCNT(b.x)], 1u);
    return b;
}
__device__ __forceinline__ void xcd_barrier_complete(unsigned* bar, unsigned x, unsigned& nloc, unsigned& nx) {
    const unsigned G = gridDim.x * gridDim.y * gridDim.z;
    unsigned sum, cnt, mine, sp = 0u;
    for (;;) {
        sum = 0u; cnt = 0u; mine = 0u;
#pragma unroll
        for (unsigned j = 0; j < 16; ++j) { const unsigned c = xb_ld(&bar[XB_XCNT(j)]); sum += c; cnt += (c > 0u) ? 1u : 0u; mine = (j == x) ? c : mine; }
        if (sum == G) break;
        __builtin_amdgcn_s_sleep(1);
        if ((++sp & 255u) == 0u) { if (xb_ld(&bar[XB_TMO])) break; if (sp > XB_SPIN_CAP) { atomicAdd(&bar[XB_TMO], 1u); break; } }
    }
    nloc = mine > 0u ? mine : 1u; nx = cnt > 0u ? cnt : 1u;
}

__device__ __forceinline__ void xcd_barrier(const XcdBarrier& b) {
    asm volatile("s_waitcnt vmcnt(0)" ::: "memory");
    __syncthreads();
    if (threadIdx.x == 0) {
        unsigned* bar = b.bar;
        __builtin_amdgcn_s_waitcnt(0);
        unsigned nloc = b.st[0], nx = b.st[1];
        if (nloc == 0u) { xcd_barrier_complete(bar, b.x, nloc, nx); b.st[0] = nloc; b.st[1] = nx; }
        const unsigned old = xb_add(&bar[XB_XSUB(b.x)], 1u);
        const unsigned gen = old / nloc;
        if (old + 1u == (gen + 1u) * nloc) {
            __builtin_amdgcn_fence(__ATOMIC_RELEASE, "agent");
            asm volatile("s_waitcnt vmcnt(0)" ::: "memory");
            const unsigned og = xb_add(&bar[XB_TOP], 1u);
            const unsigned tg = og / nx;
            if (og + 1u == (tg + 1u) * nx) xb_add(&bar[XB_TOPGEN], 1u);
            else XB_SPIN(xb_ld(&bar[XB_TOPGEN]) == tg, bar);
            __builtin_amdgcn_fence(__ATOMIC_ACQUIRE, "agent");
            xb_add(&bar[XB_XGEN(b.x)], 1u);
            asm volatile("s_waitcnt vmcnt(0)" ::: "memory");
        } else {
            XB_SPIN(xb_ld(&bar[XB_XGEN(b.x)]) == gen, bar);
            __builtin_amdgcn_fence(__ATOMIC_ACQUIRE, "agent");
            asm volatile("s_waitcnt vmcnt(0)" ::: "memory");
        }
    }
    __syncthreads();
}

template <int NT, int ACT, int K>
__device__ __forceinline__ void small_gemm_tile(LAS unsigned char* lds, const bf16* __restrict__ A, const bf16* __restrict__ Bt, bf16* __restrict__ O, int ldc, int lda, int ldb, const float* __restrict__ rs, int m0, int n0, int tid) {
    constexpr int NC = 16 * NT, KW = K / 8, NCH = KW / 128;
    const int wave = __builtin_amdgcn_readfirstlane(tid >> 6), lane = tid & 63, fr = lane & 15, fq = lane >> 4;
    const bf16* ap = A + (size_t)(m0 + fr) * lda + wave * KW + fq * 8;
    const bf16* bp = Bt + (size_t)(n0 + fr) * ldb + wave * KW + fq * 8;
    f32x4 acc[4][NT];
#pragma unroll
    for (int m = 0; m < 4; ++m)
#pragma unroll
        for (int n = 0; n < NT; ++n) acc[m][n] = (f32x4){0.f, 0.f, 0.f, 0.f};
    if constexpr (NCH == 1) {
        bf16x8 fa[4][4], fb[4][NT];
#pragma unroll
        for (int s_ = 0; s_ < 4; ++s_) {
#pragma unroll
            for (int m = 0; m < 4; ++m) fa[s_][m] = *(const bf16x8*)(ap + (size_t)m * 16 * lda + s_ * 32);
#pragma unroll
            for (int n = 0; n < NT; ++n) fb[s_][n] = *(const bf16x8*)(bp + (size_t)n * 16 * ldb + s_ * 32); }
        __builtin_amdgcn_sched_barrier(0);
#pragma unroll
        for (int s_ = 0; s_ < 4; ++s_)
#pragma unroll
            for (int m = 0; m < 4; ++m)
#pragma unroll
                for (int n = 0; n < NT; ++n) acc[m][n] = __builtin_amdgcn_mfma_f32_16x16x32_bf16(fa[s_][m], fb[s_][n], acc[m][n], 0, 0, 0);
        __builtin_amdgcn_sched_barrier(0);
    } else {
        constexpr int NC2 = KW / 64;
        bf16x8 fa[3][2][4], fb[3][2][NT];
#define SG_LD(buf, c) do { _Pragma("unroll") for (int s_ = 0; s_ < 2; ++s_) { \
            _Pragma("unroll") for (int m = 0; m < 4; ++m) fa[buf][s_][m] = *(const bf16x8*)(ap + (size_t)m * 16 * lda + (c) * 64 + s_ * 32); \
            _Pragma("unroll") for (int n = 0; n < NT; ++n) fb[buf][s_][n] = *(const bf16x8*)(bp + (size_t)n * 16 * ldb + (c) * 64 + s_ * 32); } } while (0)
        SG_LD(0, 0); SG_LD(1, 1);
        __builtin_amdgcn_sched_barrier(0);
#pragma unroll
        for (int c = 0; c < NC2; ++c) {
            if (c + 2 < NC2) SG_LD((c + 2) % 3, c + 2);
            __builtin_amdgcn_sched_barrier(0);
#pragma unroll
            for (int s_ = 0; s_ < 2; ++s_)
#pragma unroll
                for (int m = 0; m < 4; ++m)
#pragma unroll
                    for (int n = 0; n < NT; ++n) acc[m][n] = __builtin_amdgcn_mfma_f32_16x16x32_bf16(fa[c % 3][s_][m], fb[c % 3][s_][n], acc[m][n], 0, 0, 0);
            __builtin_amdgcn_sched_barrier(0);
        }
#undef SG_LD
    }
    LAS float* P = (LAS float*)lds + wave * (64 * NC);
#pragma unroll
    for (int m = 0; m < 4; ++m)
#pragma unroll
        for (int n = 0; n < NT; ++n)
#pragma unroll
            for (int i = 0; i < 4; ++i) P[(m * 16 + fq * 4 + i) * NC + n * 16 + fr] = acc[m][n][i];
    __syncthreads();
    constexpr int EPT = 64 * NC / 512;
    const int e0 = tid * EPT, row = e0 / NC, col = e0 % NC;
    float r[EPT];
#pragma unroll
    for (int j = 0; j < EPT; ++j) r[j] = 0.f;
#pragma unroll
    for (int w = 0; w < 8; ++w) { const LAS f32x4* q = (const LAS f32x4*)((LAS float*)lds + w * (64 * NC) + e0);
#pragma unroll
        for (int j = 0; j < EPT / 4; ++j) { const f32x4 v = q[j]; r[4 * j] += v[0]; r[4 * j + 1] += v[1]; r[4 * j + 2] += v[2]; r[4 * j + 3] += v[3]; } }
    if (rs) { const float sc = rs[m0 + row];
#pragma unroll
        for (int j = 0; j < EPT; ++j) r[j] *= sc; }
    if (ACT == 1) {
#pragma unroll
        for (int j = 0; j < EPT; ++j) { const float t = fmaxf(r[j], 0.f); r[j] = t * t; } }
    bf16* op = O + (size_t)(m0 + row) * ldc + n0 + col;
    if (EPT == 8) { v4u w; w.x = pk2(r[0], r[1]); w.y = pk2(r[2], r[3]); w.z = pk2(r[4 % EPT], r[5 % EPT]); w.w = pk2(r[6 % EPT], r[7 % EPT]); *(v4u*)op = w; }
    else { v2u w; w.x = pk2(r[0], r[1]); w.y = pk2(r[2], r[3]); *(v2u*)op = w; }
    __syncthreads();
}

#define SMALL_TN(j, ntn) ((((j) >> 8) * 32 + ((j) & 7) * 4 + (((j) >> 3) & 3)))
constexpr int NPH = 15;
#ifndef REP_PRO
#define REP_PRO 1
#endif
#ifndef REP_GEMM
#define REP_GEMM 1
#endif
#ifndef REP_MIX
#define REP_MIX 1
#endif
#ifndef REP_SYNC
#define REP_SYNC 1
#endif
struct Args { const float* in[24]; float* out; unsigned char* ws; int ph_lo, ph_hi; };
__global__ void __launch_bounds__(NWAVES * 64, 2) hybrid_fwd(Args args) {
    extern __shared__ __attribute__((aligned(16))) unsigned char lds_raw[];
    LAS unsigned char* lds = (LAS unsigned char*)lds_raw;
    volatile LAS unsigned* MISC = (volatile LAS unsigned*)(lds + MISC_OFF);
    if (threadIdx.x < 64) MISC[threadIdx.x] = 0u;
    __syncthreads();
    (void)xcd_barrier_post((unsigned*)(args.ws + WS_CTL), MISC + 8);
    for (int ph = args.ph_lo; ph < args.ph_hi;) {
        int tid = threadIdx.x; asm volatile("" : "+v"(tid));
        const int lane = tid & 63, wave = __builtin_amdgcn_readfirstlane(tid >> 6);
        const int G = gridDim.x; const int bx = blockIdx.x;
        unsigned char* ws = args.ws;
        if (ph == 0) {
            const int vcu = (G % 8 == 0) ? (bx % 8) * (G / 8) + bx / 8 : bx; const int gw = vcu * NWAVES + wave, NGW = G * NWAVES;
            LAS float* scr = (LAS float*)(lds + wave * WAVE_SCR);
            bf16* XN = (bf16*)(ws + WS_XN); bf16* SGW = (bf16*)(ws + WS_SGUW);
            constexpr int I_FOLD = 4 * (DM / 32), I_OUT = (DM / 64) * (DM / 32) - I_FOLD, I_IN = (DM / 64) * (INW / 32), I_UP = (DM / 64) * (FF / 32), I_DN = (FF / 64) * (DM / 32);
            constexpr int I_LAYER = I_OUT + I_IN + I_UP + I_DN, I_ALL = DEPTH * I_LAYER;
            for (int it = gw; it < DEPTH * I_FOLD * 4; it += NGW) { const int l = it / (I_FOLD * 4), r = it % (I_FOLD * 4);
                fold_item(args.in[10] + (size_t)l * DM * DM, (bf16*)(ws + WS_W + (size_t)l * W_LAYER + W_OUT), args.in[11] + (size_t)l * 4 * 64 * 64, args.in[12] + (size_t)l * GW, scr, r, lane); }
#define TR_DECODE(it_, d_) do { const int l_ = (it_) / I_LAYER; int r_ = (it_) % I_LAYER; unsigned char* wl_ = ws + WS_W + (size_t)l_ * W_LAYER; int nblk_; \
                if (r_ < I_OUT) { r_ += I_FOLD; d_.W = args.in[10] + (size_t)l_ * DM * DM; d_.WT = (bf16*)(wl_ + W_OUT); d_.gk = nullptr; d_.K = DM; d_.N = DM; } \
                else if ((r_ -= I_OUT) < I_IN) { d_.W = args.in[9] + (size_t)l_ * DM * INW; d_.WT = (bf16*)(wl_ + W_IN); d_.gk = args.in[5] + (size_t)l_ * DM; d_.K = DM; d_.N = INW; } \
                else if ((r_ -= I_IN) < I_UP) { d_.W = args.in[22] + (size_t)l_ * DM * FF; d_.WT = (bf16*)(wl_ + W_UP); d_.gk = args.in[7] + (size_t)l_ * DM; d_.K = DM; d_.N = FF; } \
                else { r_ -= I_UP; d_.W = args.in[23] + (size_t)l_ * FF * DM; d_.WT = (bf16*)(wl_ + W_DN); d_.gk = nullptr; d_.K = FF; d_.N = DM; } \
                nblk_ = d_.N / 32; d_.k0 = 64 * (r_ / nblk_); d_.n0 = 32 * (r_ % nblk_); } while (0)
            { const int TSTEP = NGW; int it = NGW - 1 - gw;
              if (it >= 0 && it < I_ALL) {
                TrDesc dc; TR_DECODE(it, dc);
                float va[32], vb[32];
                tr_load(va, dc, lane);
#pragma unroll 1
                for (;;) {
                    const int itn = it + TSTEP; const bool more = itn < I_ALL;
                    TrDesc dn; { const int q = more ? itn : it; TR_DECODE(q, dn); }
                    tr_load(vb, dn, lane);
                    tr_store(va, dc, scr, lane);
                    if (!more) break;
#pragma unroll
                    for (int i = 0; i < 32; ++i) va[i] = vb[i];
                    dc = dn; it = itn;
                }
              }
            }
#undef TR_DECODE
            for (int m = gw; m < MT; m += NGW) rms_row_to_bf16(m < MP ? args.in[0] + (size_t)m * DM : args.in[1] + (size_t)(m - MP) * DM, (bf16*)args.out + (size_t)m * 2 * DM, (float*)(ws + WS_RS) + m, lane);
            for (int e = bx * (NWAVES * 64) + tid; e < DEPTH * 4 * 128 * 128; e += G * NWAVES * 64) { const int t = (e >> 7) & 127, s = e & 127; SGW[e] = (bf16)(s <= t ? f2bf(args.in[19][e]) : 0u); }
        } else {
            const int l = (ph - 1) / 7, k = (ph - 1) - 7 * l;
            unsigned char* wl = ws + WS_W + (size_t)l * W_LAYER;
            if (k == 0 || k == 2 || k == 5) {
                const bf16* A = k == 0 ? (const bf16*)args.out : (const bf16*)(ws + (k == 2 ? WS_CAT : WS_H));
                const bf16* Bt = (const bf16*)(wl + (k == 0 ? W_IN : k == 2 ? W_OUT : W_DN));
                bf16* O = (bf16*)(ws + (k == 0 ? WS_Z : WS_O));
                const int N = k == 0 ? INW : DM, K = k == 5 ? FF : DM;
                pg8::Gemm g{A, Bt, MP, N, K, k == 5 ? FP : k == 0 ? 2 * DM : DP, K + WPAD}; pg8::StaticOrder S; S.init(MP, N, G, bx);
                pg8::EpiBf16<0> E{O, k == 0 ? ZP : OP, k == 0 ? (const float*)(ws + WS_RS) : nullptr};
                pg8::gemm_phase<pg8::EpiBf16<0>, pg8::StaticOrder, true, true>(lds, g, S, E, tid);
                if (k == 0) { for (int j = bx; j < (MS / 64) * (INW / 64); j += G) small_gemm_tile<4, 0, DM>(lds, A, Bt, O, ZP, 2 * DM, DM + WPAD, (const float*)(ws + WS_RS), MP + ((j >> 5) & 7) * 64, SMALL_TN(j, INW / 64) * 64, tid); }
                else { for (int j = bx; j < (MS / 64) * (DM / 32); j += G) { if (k == 2) small_gemm_tile<2, 0, DM>(lds, A, Bt, O, OP, DP, DM + WPAD, nullptr, MP + ((j >> 5) & 7) * 64, SMALL_TN(j, DM / 32) * 32, tid); else small_gemm_tile<2, 0, FF>(lds, A, Bt, O, OP, FP, FF + WPAD, nullptr, MP + ((j >> 5) & 7) * 64, SMALL_TN(j, DM / 32) * 32, tid); } }
            } else if (k == 4) {
                pg8::Gemm g{(const bf16*)args.out, (const bf16*)(wl + W_UP), MP, FF, DM, 2 * DM, DM + WPAD}; pg8::StaticOrder S; S.init(MP, FF, G, bx);
                pg8::EpiBf16<1> E{(bf16*)(ws + WS_H), FP, (const float*)(ws + WS_RS)};
                pg8::gemm_phase<pg8::EpiBf16<1>, pg8::StaticOrder, true, true>(lds, g, S, E, tid);
                for (int j = bx; j < (MS / 64) * (FF / 64); j += G) small_gemm_tile<4, 1, DM>(lds, (const bf16*)args.out, (const bf16*)(wl + W_UP), (bf16*)(ws + WS_H), FP, 2 * DM, DM + WPAD, (const float*)(ws + WS_RS), MP + ((j >> 5) & 7) * 64, SMALL_TN(j, FF / 64) * 64, tid);
            } else if (k == 1) {
                const int vcu = (G % 8 == 0) ? (bx % 8) * (G / 8) + bx / 8 : bx; const int gw = vcu * NWAVES + wave, NGW = G * NWAVES;
                LAS float* scr = (LAS float*)(lds + wave * WAVE_SCR);
                const bf16* ZB = (const bf16*)(ws + WS_Z); bf16* CAT = (bf16*)(ws + WS_CAT); const bf16* SGW = (const bf16*)(ws + WS_SGUW) + (size_t)l * 4 * 128 * 128;
                float* out = args.out;
                constexpr int NU_SGU = 512, NU_CONV = 2048, NU_SEG = 1024, NU_SMP = 2048, NU = NU_SGU + NU_CONV + 2 * NU_SEG + NU_SMP;
#pragma unroll 1
                for (int ui = 0; ; ++ui) {
                    int u;
                    if (NGW != 2048) { u = ui * NGW + gw; if (u >= NU) break; }
                    else { if (ui >= 4) break;
                        if (gw < 512) { if (ui == 0) u = gw; else if (ui == 1) u = NU_SGU + 1536 + gw; else break; }
                        else { const int g5 = gw - 512; if (ui == 0) u = NU_SGU + g5; else { const int sidx = (ui - 1) * 1536 + g5; if (sidx >= 2 * NU_SEG + NU_SMP) break; u = NU_SGU + NU_CONV + sidx; } } }
                    int lane = tid & 63; asm volatile("" : "+v"(lane));
                    if (u < NU_SGU) { sgu_unit(ZB, CAT, SGW, args.in[17] + (size_t)l * GW, args.in[18] + (size_t)l * GW, args.in[20] + (size_t)l * 4 * 128, u >> 2, u & 3, (LAS bf16*)scr, lane); continue; }
                    int r = u - NU_SGU;
                    if (r < NU_CONV) { const int seg = r >> 2, h = r & 3, seq = seg >> 6, t0 = (seg & 63) * 32;
                        conv_unit_p(ZB, CAT, out + OUT_CONV_P + (size_t)l * NBP * 30 * GW, args.in[13] + (size_t)l * 31 * GW, args.in[14] + (size_t)l * GW, args.in[15] + (size_t)l * GW, args.in[16] + (size_t)l * GW, seq, t0, h, scr, lane);
                        continue; }
                    r -= NU_CONV;
                    if (r < 2 * NU_SEG) { const int ty = r / NU_SEG, q = r % NU_SEG, seg = q >> 2, h = q & 3, seq = seg >> 5, t0 = (seg & 31) * 64;
                        if (ty == 0) { float* np = out + OUT_POOL_P + (size_t)l * NBP * 15 * GW;
                            if (h == 0) pool_unit_p<2>(ZB, CAT, np, seq, t0, h, lane); else if (h == 1) pool_unit_p<4>(ZB, CAT, np, seq, t0, h, lane);
                            else if (h == 2) pool_unit_p<8>(ZB, CAT, np, seq, t0, h, lane); else pool_unit_p<16>(ZB, CAT, np, seq, t0, h, lane); }
                        else short_unit_p(ZB, CAT, out + OUT_SHORT_P + (size_t)l * NBP * 2 * GW, args.in[21] + (size_t)l * 3 * GW, seq, t0, h, lane);
                        continue; }
                    r -= 2 * NU_SEG;
                    { const int ty = r >> 9, q = r & 511, seq = q >> 2, h = q & 3;
                        if (ty == 0) conv_unit<true>(ZB, CAT, args.in[3] + (size_t)l * NSB * 30 * GW, out + OUT_CONV_S + (size_t)l * NSB * 30 * GW, args.in[13] + (size_t)l * 31 * GW, args.in[14] + (size_t)l * GW, args.in[15] + (size_t)l * GW, args.in[16] + (size_t)l * GW, seq, 0, ST, h, scr, lane);
                        else if (ty == 1) { const float* sp = args.in[2] + (size_t)l * NSB * 15 * GW; float* np = out + OUT_POOL_S + (size_t)l * NSB * 15 * GW;
                            if (h == 0) pool_sample_unit<2>(ZB, CAT, sp, np, seq, h, lane); else if (h == 1) pool_sample_unit<4>(ZB, CAT, sp, np, seq, h, lane); else if (h == 2) pool_sample_unit<8>(ZB, CAT, sp, np, seq, h, lane); else pool_sample_unit<16>(ZB, CAT, sp, np, seq, h, lane); }
                        else if (ty == 2) short_unit<true>(ZB, CAT, args.in[4] + (size_t)l * NSB * 2 * GW, out + OUT_SHORT_S + (size_t)l * NSB * 2 * GW, args.in[21] + (size_t)l * 3 * GW, seq, 0, ST, h, lane);
                        else sgu_sample_unit(ZB, CAT, args.in[19] + (size_t)l * 4 * 128 * 128, args.in[17] + (size_t)l * GW, args.in[18] + (size_t)l * GW, args.in[20] + (size_t)l * 4 * 128, out + OUT_V_S + (size_t)l * NSB * ST * GW, seq, h, lane); }
                }
            } else {
                const int vcu = (G % 8 == 0) ? (bx % 8) * (G / 8) + bx / 8 : bx; const int gw = vcu * NWAVES + wave, NGW = G * NWAVES;
                const float* g = args.in[k == 3 ? 6 : 8] + (size_t)l * DM;
                float* X = args.out; const bf16* OB = (const bf16*)(ws + WS_O); float* RS = (float*)(ws + WS_RS);
                const bool from_input = (l == 0 && k == 3), write_xn = !(l == DEPTH - 1 && k == 6);
                f32x4 gg[4];
#pragma unroll
                for (int j = 0; j < 4; ++j) gg[j] = ((const f32x4*)g + lane)[64 * j];
                const int m_lo = 0;
#define EW_X32(m) ((m) < MP ? args.in[0] + (size_t)(m) * DM : args.in[1] + (size_t)((m) - MP) * DM)
                bf16* X16 = (bf16*)args.out;
                const bool dst16 = write_xn;
                { EwRow r0, r1, r2;
                  const int ma = m_lo + gw;
                  if (ma < MT) {
                    ew_load(r0, X16 + (size_t)ma * 2 * DM, OB + (size_t)ma * OP, lane);
                    { const int mb = ma + NGW < MT ? ma + NGW : ma; ew_load(r1, X16 + (size_t)mb * 2 * DM, OB + (size_t)mb * OP, lane); }
#pragma unroll 1
                    for (int m = ma; m < MT; m += NGW) {
                        { const int mc = m + 2 * NGW < MT ? m + 2 * NGW : m; ew_load(r2, X16 + (size_t)mc * 2 * DM, OB + (size_t)mc * OP, lane); }
                        ew_finish(r0, gg, X + (size_t)m * DM, X16 + (size_t)m * 2 * DM, dst16, RS + m, write_xn, lane);
                        r0 = r1; r1 = r2;
                    }
                  }
                }
#undef EW_X32
            }
        }
        ++ph;
        if (ph < args.ph_hi) {
            if (args.ph_lo < 0) cg::this_grid().sync();
            else { XcdBarrier b; b.bar = (unsigned*)(args.ws + WS_CTL); b.x = xb_xcc_id(); b.st = (volatile LAS unsigned*)(lds + MISC_OFF) + 8; xcd_barrier(b); }
        }
    }
}

#ifndef MK_N_LAUNCHES
#define MK_N_LAUNCHES 1
#endif
extern "C" void kernel_launch(void* const* d_in, const int* in_sizes, int n_in, void* d_out, int out_size, void* d_ws, size_t ws_size, hipStream_t stream) {
    static int grid = 0;
    if (grid == 0) {
        if (n_in != 24 || (size_t)out_size != OUT_END || ws_size < WS_END) { fprintf(stderr, "kernel_launch: unexpected shapes (n_in %d out %d ws %zu)\n", n_in, out_size, ws_size); grid = -1; return; }
        int dev = 0, cus = 0, per_cu = 0;
        if (hipGetDevice(&dev) != hipSuccess || hipDeviceGetAttribute(&cus, hipDeviceAttributeMultiprocessorCount, dev) != hipSuccess) { grid = -1; return; }
        if (hipFuncSetAttribute((const void*)hybrid_fwd, hipFuncAttributeMaxDynamicSharedMemorySize, LDS_BYTES) != hipSuccess) { fprintf(stderr, "kernel_launch: hipFuncSetAttribute failed\n"); grid = -1; return; }
        if (hipOccupancyMaxActiveBlocksPerMultiprocessor(&per_cu, (const void*)hybrid_fwd, NWAVES * 64, LDS_BYTES) != hipSuccess || per_cu < 1) per_cu = 1;
        (void)hipGetLastError();
        grid = cus * per_cu;
    }
    if (grid < 0) return;
    if (hipMemsetAsync((char*)d_ws + WS_CTL, 0, CTL_ZERO_BYTES, stream) != hipSuccess) { fprintf(stderr, "kernel_launch: hipMemsetAsync failed\n"); return; }
    Args a{};
    for (int i = 0; i < 24; ++i) a.in[i] = (const float*)d_in[i];
    a.out = (float*)d_out; a.ws = (unsigned char*)d_ws;
#if MK_N_LAUNCHES == 1
    a.ph_lo = 0; a.ph_hi = NPH;
    void* kargs[] = {&a};
    hipError_t e = hipLaunchCooperativeKernel((const void*)hybrid_fwd, dim3(grid), dim3(NWAVES * 64), kargs, LDS_BYTES, stream);
    if (e != hipSuccess) fprintf(stderr, "cooperative launch failed: %s (grid %d)\n", hipGetErrorString(e), grid);
#else
    for (int p = 0; p < NPH; ++p) { a.ph_lo = p; a.ph_hi = p + 1; hipLaunchKernelGGL(hybrid_fwd, dim3(grid), dim3(NWAVES * 64), LDS_BYTES, stream, a); }
#endif
}
```

```cpp
#include <hip/hip_runtime.h>
#include <hip/hip_cooperative_groups.h>
#include <cstdio>
#include <cstdint>
namespace pg8 {
#define PG8_LAS __attribute__((address_space(3)))
typedef unsigned short bf16_t;
typedef short bf16x8 __attribute__((ext_vector_type(8)));
typedef float f32x4 __attribute__((ext_vector_type(4)));
typedef unsigned u32x4 __attribute__((ext_vector_type(4)));
constexpr int KPAD = 64;
constexpr int BM = 256, BK = 64, HALF = 128, HTB = HALF * BK * 2  , STAGE_BYTES = 8 * HTB, NXCD = 8, WGM = 1;

__host__ __device__ __forceinline__ int lds_byte(int r, int c) { const int st = (r >> 4) * 2 + (c >> 5), rr = r & 15, cc = c & 31, ob = rr * 64 + cc * 2; return st * 1024 + (ob ^ (((ob >> 9) & 1) << 5)); }
__host__ __device__ __forceinline__ void stage_rc(int b, int& R, int& C) { const int st = b / 1024, sb = b % 1024, swz = sb ^ (((sb >> 9) & 1) << 5); R = (st >> 1) * 16 + swz / 64; C = (st & 1) * 32 + (swz % 64) / 2; }
__host__ __device__ __forceinline__ int perm32(int rho) { const int n = rho >> 4, i = rho & 15; return 8 * (i >> 2) + 4 * n + (i & 3); }

struct Unit { int pm, pn; };
struct Gemm { const bf16_t* A; const bf16_t* Bt; int M, N, K, lda, ldb; };

struct StaticOrder {
    int nM, nN, nwg, G, c;
    __host__ __device__ void init(int M, int N, int G_, int c_) { nM = M / BM; nN = N / BM; nwg = nM * nN; G = G_; c = c_; }
    __host__ __device__ bool next(int i, Unit& u) const {
        const long L = (long)i * G + c; if (L >= nwg) return false;
        int wgid = (int)L; { const int q = nwg / NXCD, r = nwg % NXCD, xcd = wgid % NXCD, off = wgid / NXCD; wgid = (xcd < r ? xcd * (q + 1) : r * (q + 1) + (xcd - r) * q) + off; }
        const int nig = WGM * nN, gid = wgid / nig, fm = gid * WGM, gsz = (nM - fm) < WGM ? (nM - fm) : WGM;
        u.pm = fm + ((wgid % nig) % gsz); u.pn = (wgid % nig) / gsz; return true;
    }
    __device__ __forceinline__ void a_ready(const Unit&) const {}
    __device__ __forceinline__ void done(const Unit&) const {}
};

__device__ __forceinline__ unsigned cvt_pk_bf16(float lo, float hi) { unsigned r; asm volatile("v_cvt_pk_bf16_f32 %0, %1, %2" : "=v"(r) : "v"(lo), "v"(hi)); return r; }
__device__ __forceinline__ float relu_sq(float x) { float r; asm volatile("v_max_f32 %0, 0, %1" : "=v"(r) : "v"(x)); return r * r; }
__device__ __forceinline__ void st16_wt(void* p, u32x4 v) { asm volatile("global_store_dwordx4 %0, %1, off sc1" :: "v"(p), "v"(v) : "memory"); }
template <int ACT  > struct EpiBf16 {
    static constexpr bool PERM = true, AFTER_DRAIN = false;
    bf16_t* O; int ldc; const float* rs;
    __device__ __forceinline__ void operator()(const f32x4 (&acc)[2][2][4][2], const Unit& u, int wr, int wc, int fr, int fq) const {
        const int row0 = u.pm * BM + wr * 64 + fr; const int col0 = u.pn * BM + wc * 32 + 8 * fq;
#pragma unroll
        for (int ai = 0; ai < 2; ++ai)
#pragma unroll
            for (int m = 0; m < 4; ++m) { bf16_t* rowp = O + (size_t)(row0 + ai * HALF + m * 16) * ldc + col0; const float sc = rs ? rs[row0 + ai * HALF + m * 16] : 1.f;
#pragma unroll
                for (int bj = 0; bj < 2; ++bj) { f32x4 v0 = acc[ai][bj][m][0] * sc, v1 = acc[ai][bj][m][1] * sc;
                    if (ACT == 1) {
#pragma unroll
                        for (int e = 0; e < 4; ++e) { v0[e] = relu_sq(v0[e]); v1[e] = relu_sq(v1[e]); } }
                    u32x4 w; w.x = cvt_pk_bf16(v0[0], v0[1]); w.y = cvt_pk_bf16(v0[2], v0[3]); w.z = cvt_pk_bf16(v1[0], v1[1]); w.w = cvt_pk_bf16(v1[2], v1[3]);
                    *(u32x4*)(rowp + bj * HALF) = w; } }
    }
};

template <class Epi, class Sched, bool ALIGN_EPI = false, bool SP2 = false>
__device__ __forceinline__ void gemm_phase(PG8_LAS unsigned char* lds, const Gemm g, const Sched& S, const Epi& E, const int tid) {
    const int wid = __builtin_amdgcn_readfirstlane(tid >> 6), lane = tid & 63, wr = wid >> 2, wc = wid & 3, fr = lane & 15, fq = lane >> 4;
    const int K = g.K, nt = K / BK;
    unsigned voffA[2], voffB[2];
#pragma unroll
    for (int i = 0; i < 2; ++i) { int R, C; stage_rc(tid * 16 + i * 8192, R, C); const int Rb = Epi::PERM ? ((R & ~31) + perm32(R & 31)) : R;
        voffA[i] = (unsigned)(R * g.lda + C) * 2u; voffB[i] = (unsigned)(Rb * g.ldb + C) * 2u; }
    const size_t kstep = (size_t)(BK * 2);
    const size_t hstepA = (size_t)HALF * g.lda * 2, hstepB = (size_t)HALF * g.ldb * 2;
    const size_t tstepA = 2 * hstepA, tstepB = 2 * hstepB;
    const unsigned ldsw = (unsigned)wid * 1024u;
    const int aoff = lds_byte(wr * 64 + fr, fq * 8), boff = lds_byte(wc * 32 + fr, fq * 8);
#define PG8_SA(b, h) (((b) * 2 + (h)) * HTB)
#define PG8_SB(b, h) ((4 + (b) * 2 + (h)) * HTB)
#define PG8_STAGE(bufoff, gbase, voff) do { _Pragma("unroll") for (int _i = 0; _i < 2; ++_i) \
        __builtin_amdgcn_global_load_lds((const unsigned*)((const char*)(gbase) + (voff)[_i]), (PG8_LAS unsigned*)(lds + (bufoff) + ldsw + _i * 8192), 16, 0, 0); } while (0)
#define PG8_LDA(dst, b, h) do { _Pragma("unroll") for (int m = 0; m < 4; ++m) _Pragma("unroll") for (int k = 0; k < 2; ++k) dst[m][k] = *(const PG8_LAS bf16x8*)(lds + PG8_SA(b, h) + aoff + m * 2048 + k * 1024); } while (0)
#define PG8_LDB(dst, b, h) do { _Pragma("unroll") for (int n = 0; n < 2; ++n) _Pragma("unroll") for (int k = 0; k < 2; ++k) dst[n][k] = *(const PG8_LAS bf16x8*)(lds + PG8_SB(b, h) + boff + n * 2048 + k * 1024); } while (0)
#define PG8_MMA(ai, bj, At, Bt) do { __builtin_amdgcn_s_setprio(1); _Pragma("unroll") for (int m = 0; m < 4; ++m) _Pragma("unroll") for (int n = 0; n < 2; ++n) _Pragma("unroll") for (int k = 0; k < 2; ++k) \
        acc[ai][bj][m][n] = __builtin_amdgcn_mfma_f32_16x16x32_bf16(Bt[n][k], At[m][k], acc[ai][bj][m][n], 0, 0, 0); __builtin_amdgcn_s_setprio(0); } while (0)
#define PG8_WAIT_V(n) asm volatile("s_waitcnt vmcnt(" #n ")" ::: "memory")
#define PG8_WAIT_L(n) asm volatile("s_waitcnt lgkmcnt(" #n ")" ::: "memory")
#define PG8_BAR __builtin_amdgcn_s_barrier()
#define PG8_SCHED __builtin_amdgcn_sched_barrier(0)
    Unit cur, nxt; int ui = 0;
    if (!S.next(0, cur)) return;
    f32x4 acc[2][2][4][2];
#pragma unroll
    for (int a = 0; a < 2; ++a)
#pragma unroll
        for (int b = 0; b < 2; ++b)
#pragma unroll
            for (int m = 0; m < 4; ++m)
#pragma unroll
                for (int n = 0; n < 2; ++n) acc[a][b][m][n] = (f32x4){0.f, 0.f, 0.f, 0.f};
    bf16x8 At[4][2], B0[2][2], B1[2][2];
    const char* cA = (const char*)g.A + (size_t)cur.pm * tstepA; const char* cB = (const char*)g.Bt + (size_t)cur.pn * tstepB;
    S.a_ready(cur);
    if constexpr (SP2) {
        PG8_STAGE(PG8_SB(0, 0), cB, voffB); PG8_STAGE(PG8_SB(0, 1), cB + hstepB, voffB); PG8_STAGE(PG8_SA(0, 0), cA, voffA); PG8_STAGE(PG8_SA(0, 1), cA + hstepA, voffA);
        if (wr == 1) PG8_BAR;
        PG8_WAIT_V(2); PG8_BAR;
        PG8_STAGE(PG8_SB(1, 0), cB + kstep, voffB); PG8_STAGE(PG8_SA(1, 0), cA + kstep, voffA); PG8_STAGE(PG8_SB(1, 1), cB + hstepB + kstep, voffB);
        PG8_WAIT_V(6); PG8_BAR;
    } else {
        PG8_STAGE(PG8_SB(0, 0), cB, voffB); PG8_STAGE(PG8_SA(0, 0), cA, voffA); PG8_STAGE(PG8_SB(0, 1), cB + hstepB, voffB); PG8_STAGE(PG8_SA(0, 1), cA + hstepA, voffA);
        if (wr == 1) PG8_BAR;
        PG8_WAIT_V(4); PG8_BAR;
        PG8_STAGE(PG8_SB(1, 0), cB + kstep, voffB); PG8_STAGE(PG8_SA(1, 0), cA + kstep, voffA); PG8_STAGE(PG8_SB(1, 1), cB + hstepB + kstep, voffB);
        PG8_WAIT_V(6); PG8_BAR;
    }
    for (;;) {
        const bool has_next = S.next(ui + 1, nxt);
        const char* nA = has_next ? (const char*)g.A + (size_t)nxt.pm * tstepA : cA; const char* nB = has_next ? (const char*)g.Bt + (size_t)nxt.pn * tstepB : cB;
        for (int t = 0; t < nt; t += 2) {
            const bool last = (t == nt - 2);
            const char* a1 = cA + (size_t)(t + 1) * kstep;
            const char* a2 = last ? nA : cA + (size_t)(t + 2) * kstep; const char* b2 = last ? nB : cB + (size_t)(t + 2) * kstep;
            const char* a3 = a2 + kstep; const char* b3 = b2 + kstep;
            if (last && has_next) S.a_ready(nxt);
            if constexpr (SP2) {
            PG8_LDB(B0, 0, 0); PG8_LDB(B1, 0, 1); PG8_SCHED; PG8_LDA(At, 0, 0); PG8_STAGE(PG8_SA(1, 1), a1 + hstepA, voffA);
            PG8_WAIT_V(8); PG8_WAIT_L(0); PG8_BAR; PG8_MMA(0, 0, At, B0); PG8_MMA(0, 1, At, B1); PG8_BAR; PG8_SCHED;
            PG8_LDA(At, 0, 1); PG8_STAGE(PG8_SB(0, 0), b2, voffB); PG8_STAGE(PG8_SB(0, 1), b2 + hstepB, voffB); PG8_STAGE(PG8_SA(0, 0), a2, voffA);
            PG8_WAIT_V(8); PG8_WAIT_L(0); PG8_BAR; PG8_MMA(1, 0, At, B0); PG8_MMA(1, 1, At, B1); PG8_BAR; PG8_SCHED;
            PG8_LDB(B0, 1, 0); PG8_LDB(B1, 1, 1); PG8_SCHED; PG8_LDA(At, 1, 0); PG8_STAGE(PG8_SA(0, 1), a2 + hstepA, voffA);
            PG8_WAIT_V(8); PG8_WAIT_L(0); PG8_BAR; PG8_MMA(0, 0, At, B0); PG8_MMA(0, 1, At, B1); PG8_BAR; PG8_SCHED;
            PG8_LDA(At, 1, 1); PG8_STAGE(PG8_SB(1, 0), b3, voffB); PG8_STAGE(PG8_SB(1, 1), b3 + hstepB, voffB); PG8_STAGE(PG8_SA(1, 0), a3, voffA);
            PG8_WAIT_V(8); PG8_WAIT_L(0); PG8_BAR; PG8_MMA(1, 0, At, B0); PG8_MMA(1, 1, At, B1); PG8_BAR; PG8_SCHED;
            } else {
            PG8_LDB(B0, 0, 0); PG8_SCHED; PG8_LDA(At, 0, 0); PG8_STAGE(PG8_SA(1, 1), a1 + hstepA, voffA);
            PG8_WAIT_L(8); PG8_BAR; PG8_WAIT_L(0); PG8_MMA(0, 0, At, B0); PG8_BAR; PG8_SCHED;
            PG8_LDB(B1, 0, 1); PG8_STAGE(PG8_SB(0, 0), b2, voffB);
            PG8_BAR; PG8_WAIT_L(0); PG8_MMA(0, 1, At, B1); PG8_BAR;
            PG8_LDA(At, 0, 1); PG8_STAGE(PG8_SA(0, 0), a2, voffA);
            PG8_BAR; PG8_WAIT_L(0); PG8_MMA(1, 0, At, B0); PG8_BAR; PG8_SCHED;
            PG8_STAGE(PG8_SB(0, 1), b2 + hstepB, voffB);
            PG8_WAIT_V(6); PG8_BAR; PG8_MMA(1, 1, At, B1); PG8_BAR;
            PG8_LDB(B0, 1, 0); PG8_SCHED; PG8_LDA(At, 1, 0); PG8_STAGE(PG8_SA(0, 1), a2 + hstepA, voffA);
            PG8_WAIT_L(8); PG8_BAR; PG8_WAIT_L(0); PG8_MMA(0, 0, At, B0); PG8_BAR; PG8_SCHED;
            PG8_LDB(B1, 1, 1); PG8_STAGE(PG8_SB(1, 0), b3, voffB);
            PG8_BAR; PG8_WAIT_L(0); PG8_MMA(0, 1, At, B1); PG8_BAR;
            PG8_LDA(At, 1, 1); PG8_STAGE(PG8_SA(1, 0), a3, voffA);
            PG8_BAR; PG8_WAIT_L(0); PG8_MMA(1, 0, At, B0); PG8_BAR; PG8_SCHED;
            PG8_STAGE(PG8_SB(1, 1), b3 + hstepB, voffB);
            PG8_WAIT_V(6); PG8_BAR; PG8_MMA(1, 1, At, B1); PG8_BAR;
            }
        }
        if constexpr (ALIGN_EPI) { if (wr == 0) PG8_BAR; }
        if constexpr (!Epi::AFTER_DRAIN) { E(acc, cur, wr, wc, fr, fq); S.done(cur); }
        if (!has_next) break;
#pragma unroll
        for (int a = 0; a < 2; ++a)
#pragma unroll
            for (int b = 0; b < 2; ++b)
#pragma unroll
                for (int m = 0; m < 4; ++m)
#pragma unroll
                    for (int n = 0; n < 2; ++n) acc[a][b][m][n] = (f32x4){0.f, 0.f, 0.f, 0.f};
        cur = nxt; cA = nA; cB = nB; ++ui;
        if constexpr (ALIGN_EPI) { if (wr == 1) PG8_BAR; }
    }
    PG8_WAIT_V(0);
    if constexpr (!ALIGN_EPI) { if (wr == 0) PG8_BAR; }
    PG8_BAR;
    if constexpr (Epi::AFTER_DRAIN) { E.fused(acc, cur, wr, wc, fr, fq, lds, wid, lane); S.done(cur); }
#undef PG8_SA
#undef PG8_SB
#undef PG8_STAGE
#undef PG8_LDA
#undef PG8_LDB
#undef PG8_MMA
#undef PG8_WAIT_V
#undef PG8_WAIT_L
#undef PG8_BAR
#undef PG8_SCHED
}
}

namespace cg = cooperative_groups;
#define LAS __attribute__((address_space(3)))
typedef unsigned short bf16;
typedef unsigned v4u __attribute__((ext_vector_type(4)));
typedef unsigned v2u __attribute__((ext_vector_type(2)));
typedef float f32x4 __attribute__((ext_vector_type(4)));
typedef short bf16x8 __attribute__((ext_vector_type(8)));

constexpr int NWAVES = 8;
constexpr int DM = 1024, FF = 4096, INW = 2048, GW = 256;
constexpr int ZP = INW + 64;
#ifndef HPAD
#define HPAD 0
#endif
#ifndef WPAD
#define WPAD 0
#endif
#ifndef APAD
#define APAD 0
#endif
constexpr int DP = DM + APAD;
#ifndef OPAD
#define OPAD 0
#endif
constexpr int OP = DM + OPAD;
constexpr int FP = FF + HPAD;
constexpr int MP = 16384, MS = 512, MT = MP + MS;
constexpr int SEQ = 2048, NBP = 8, NSB = 128, ST = 4, DEPTH = 2;
constexpr float EPS = 1e-6f;
constexpr size_t MiB = 1u << 20;
constexpr size_t WS_SGUW = 1 * MiB;
constexpr size_t WS_W = 2 * MiB, W_LAYER = 24 * MiB, W_IN = 0, W_OUT = 9 * MiB / 2, W_UP = 7 * MiB, W_DN = 31 * MiB / 2;
constexpr size_t WS_XN = 50 * MiB, WS_O = 84 * MiB, WS_H = 120 * MiB, WS_Z = 120 * MiB, WS_CAT = 189 * MiB, WS_RS = 254 * MiB  , WS_END = 255 * MiB;
static_assert(WS_Z + (size_t)16896 * ZP * 2 <= WS_CAT && WS_XN + (size_t)16896 * DP * 2 <= WS_O && WS_CAT + (size_t)16896 * DP * 2 <= WS_H + (size_t)16896 * FP * 2 && WS_H + (size_t)16896 * FP * 2 <= WS_END, "d_ws map");
constexpr int LDS_BYTES = 147456;
constexpr int MISC_OFF = LDS_BYTES - 256;
constexpr size_t WS_CTL = 0, CTL_ZERO_BYTES = 16 * 1024;
constexpr int WAVE_SCR = 17408;
constexpr size_t OUT_Y = 0;
constexpr size_t OUT_POOL_P = (size_t)MT * DM;
constexpr size_t OUT_POOL_S = OUT_POOL_P + (size_t)DEPTH * NBP * 15 * GW;
constexpr size_t OUT_CONV_P = OUT_POOL_S + (size_t)DEPTH * NSB * 15 * GW;
constexpr size_t OUT_CONV_S = OUT_CONV_P + (size_t)DEPTH * NBP * 30 * GW;
constexpr size_t OUT_SHORT_P = OUT_CONV_S + (size_t)DEPTH * NSB * 30 * GW;
constexpr size_t OUT_SHORT_S = OUT_SHORT_P + (size_t)DEPTH * NBP * 2 * GW;
constexpr size_t OUT_V_S = OUT_SHORT_S + (size_t)DEPTH * NSB * 2 * GW;
constexpr size_t OUT_END = OUT_V_S + (size_t)DEPTH * NSB * ST * GW;

__device__ __forceinline__ float bf2f(bf16 b) { return __uint_as_float(((unsigned)b) << 16); }
__device__ __forceinline__ unsigned f2bf(float f) { unsigned u = __float_as_uint(f); return (u + 0x7fffu + ((u >> 16) & 1u)) >> 16; }
__device__ __forceinline__ unsigned pk2(float lo, float hi) { return f2bf(lo) | (f2bf(hi) << 16); }
template <int CTRL, int ROWMASK> __device__ __forceinline__ float dpp_get(float v) { return __int_as_float(__builtin_amdgcn_update_dpp(0, __float_as_int(v), CTRL, ROWMASK, 0xF, false)); }
__device__ __forceinline__ float sum8(float v) { v += dpp_get<0xB1, 0xF>(v); v += dpp_get<0x4E, 0xF>(v); v += dpp_get<0x141, 0xF>(v); return v; }
__device__ __forceinline__ float wave_sum(float v) {
    v = sum8(v); v += dpp_get<0x140, 0xF>(v); v += dpp_get<0x142, 0xA>(v); v += dpp_get<0x143, 0xC>(v);
    return __int_as_float(__builtin_amdgcn_readlane(__float_as_int(v), 63));
}
__device__ __forceinline__ void unpack8(const v4u w, float (&f)[8]) {
    f[0] = __uint_as_float(w.x << 16); f[1] = __uint_as_float(w.x & 0xffff0000u); f[2] = __uint_as_float(w.y << 16); f[3] = __uint_as_float(w.y & 0xffff0000u);
    f[4] = __uint_as_float(w.z << 16); f[5] = __uint_as_float(w.z & 0xffff0000u); f[6] = __uint_as_float(w.w << 16); f[7] = __uint_as_float(w.w & 0xffff0000u); }
__device__ __forceinline__ v4u pack8(const float (&f)[8]) { v4u w; w.x = pg8::cvt_pk_bf16(f[0], f[1]); w.y = pg8::cvt_pk_bf16(f[2], f[3]); w.z = pg8::cvt_pk_bf16(f[4], f[5]); w.w = pg8::cvt_pk_bf16(f[6], f[7]); return w; }
__device__ __forceinline__ v4u ld16(const bf16* p) { return *(const v4u*)p; }
__device__ __forceinline__ float sigm(float x) { return __builtin_amdgcn_rcpf(1.f + __builtin_amdgcn_exp2f(-1.44269504f * x)); }
#define LDS_WAIT() asm volatile("s_waitcnt lgkmcnt(0)" ::: "memory")

__device__ __forceinline__ void transpose_item(const float* __restrict__ W, int K, int N, bf16* __restrict__ WT, const float* __restrict__ gk, LAS float* scr, int item, int lane) {
    const int nblk = N / 32, kb = item / nblk, nb = item % nblk, k0 = 64 * kb, n0 = 32 * nb;
#pragma unroll 8
    for (int i = 0; i < 32; ++i) { const int kk = 2 * i + (lane >> 5); float v = W[(size_t)(k0 + kk) * N + n0 + (lane & 31)]; if (gk) v *= gk[k0 + kk]; scr[kk * 33 + (lane & 31)] = v; }
    LDS_WAIT();
    const int c = lane & 7;
#pragma unroll
    for (int j = 0; j < 4; ++j) { const int n = (lane >> 3) + 8 * j; const LAS float* s = scr + (8 * c) * 33 + n;
        v4u o; o.x = pk2(s[0 * 33], s[1 * 33]); o.y = pk2(s[2 * 33], s[3 * 33]); o.z = pk2(s[4 * 33], s[5 * 33]); o.w = pk2(s[6 * 33], s[7 * 33]);
        *(v4u*)(WT + (size_t)(n0 + n) * K + k0 + 8 * c) = o; }
    LDS_WAIT();
}
struct TrDesc { const float* W; bf16* WT; const float* gk; int K, N, k0, n0; };
__device__ __forceinline__ void tr_load(float (&v)[32], const TrDesc& d, int lane) {
    const float* p = d.W + (size_t)(d.k0 + (lane >> 5)) * d.N + d.n0 + (lane & 31);
#pragma unroll
    for (int i = 0; i < 32; ++i) v[i] = p[(size_t)(2 * i) * d.N];
}
__device__ __forceinline__ void tr_store(const float (&v)[32], const TrDesc& d, LAS float* scr, int lane) {
#pragma unroll
    for (int i = 0; i < 32; ++i) { const int kk = 2 * i + (lane >> 5); float x = v[i]; if (d.gk) x *= d.gk[d.k0 + kk]; scr[kk * 33 + (lane & 31)] = x; }
    LDS_WAIT();
    const int c = lane & 7;
#pragma unroll
    for (int j = 0; j < 4; ++j) { const int n = (lane >> 3) + 8 * j; const LAS float* s = scr + (8 * c) * 33 + n;
        v4u o; o.x = pg8::cvt_pk_bf16(s[0 * 33], s[1 * 33]); o.y = pg8::cvt_pk_bf16(s[2 * 33], s[3 * 33]); o.z = pg8::cvt_pk_bf16(s[4 * 33], s[5 * 33]); o.w = pg8::cvt_pk_bf16(s[6 * 33], s[7 * 33]);
        *(v4u*)(d.WT + (size_t)(d.n0 + n) * (d.K + WPAD) + d.k0 + 8 * c) = o; }
    LDS_WAIT();
}
__device__ __forceinline__ void fold_item(const float* __restrict__ W, bf16* __restrict__ WT, const float* __restrict__ wp, const float* __restrict__ ps, LAS float* scr, int item4, int lane) {
    const int K = DM, N = DM; const int item = item4 >> 2, q = item4 & 3; const int nblk = N / 32, g = item / nblk, nb = item % nblk, k0 = 64 * g, n0 = 32 * nb;
    LAS float* scr2 = scr + 64 * 33;
#pragma unroll 8
    for (int i = 0; i < 32; ++i) { const int kk = 2 * i + (lane >> 5); scr[kk * 33 + (lane & 31)] = W[(size_t)(k0 + kk) * N + n0 + (lane & 31)] * ps[k0 + kk]; }
    LDS_WAIT();
    const int n = lane & 31;
#pragma unroll 1
    for (int i = 0; i < 8; ++i) { const int kl = 2 * i + (lane >> 5), kk = 16 * q + kl; const float* wr = wp + (size_t)(g * 64 + kk) * 64; float a = 0.f;
#pragma unroll 16
        for (int d = 0; d < 64; ++d) a += wr[d] * scr[d * 33 + n];
        scr2[kl * 33 + n] = a; }
    LDS_WAIT();
    { const int ch = lane >> 5; const LAS float* s = scr2 + (8 * ch) * 33 + n;
        v4u o; o.x = pk2(s[0 * 33], s[1 * 33]); o.y = pk2(s[2 * 33], s[3 * 33]); o.z = pk2(s[4 * 33], s[5 * 33]); o.w = pk2(s[6 * 33], s[7 * 33]);
        *(v4u*)(WT + (size_t)(n0 + n) * (K + WPAD) + k0 + 16 * q + 8 * ch) = o; }
    LDS_WAIT();
}
__device__ __forceinline__ void rms_row_to_bf16(const float* __restrict__ xrow, bf16* __restrict__ orow, float* __restrict__ rsp, int lane) {
    const f32x4* xr = (const f32x4*)xrow + lane;
    f32x4 v[4]; float s = 0.f;
#pragma unroll
    for (int j = 0; j < 4; ++j) { v[j] = xr[64 * j]; s += (v[j].x * v[j].x + v[j].y * v[j].y) + (v[j].z * v[j].z + v[j].w * v[j].w); }
    const float rstd = rsqrtf(wave_sum(s) * (1.f / DM) + EPS);
    if (lane == 0) *rsp = rstd;
    v2u* o8 = (v2u*)orow + lane;
#pragma unroll
    for (int j = 0; j < 4; ++j) { v2u o; o.x = pg8::cvt_pk_bf16(v[j].x, v[j].y); o.y = pg8::cvt_pk_bf16(v[j].z, v[j].w); o8[64 * j] = o; }
}
struct EwRow { v2u x[4]; v2u o[4]; };
__device__ __forceinline__ f32x4 unpack4(const v2u w) { return (f32x4){__uint_as_float(w.x << 16), __uint_as_float(w.x & 0xffff0000u), __uint_as_float(w.y << 16), __uint_as_float(w.y & 0xffff0000u)}; }
__device__ __forceinline__ void ew_load(EwRow& r, const bf16* __restrict__ xrow16, const bf16* __restrict__ orow, int lane) {
    const v2u* xr = (const v2u*)xrow16 + lane; const v2u* orr = (const v2u*)orow + lane;
#pragma unroll
    for (int j = 0; j < 4; ++j) { r.x[j] = xr[64 * j]; r.o[j] = orr[64 * j]; }
}
__device__ __forceinline__ void ew_finish(const EwRow& r, const f32x4 (&gg)[4], float* __restrict__ Xrow32, bf16* __restrict__ Xrow16, bool dst16, float* __restrict__ rsp, bool write_xn, int lane) {
    f32x4 o[4], x[4]; float so = 0.f;
#pragma unroll
    for (int j = 0; j < 4; ++j) { o[j] = unpack4(r.o[j]); so += (o[j].x * o[j].x + o[j].y * o[j].y) + (o[j].z * o[j].z + o[j].w * o[j].w); }
    const float rs = rsqrtf(wave_sum(so) * (1.f / DM) + EPS); float s1 = 0.f;
#pragma unroll
    for (int j = 0; j < 4; ++j) { x[j] = unpack4(r.x[j]) + o[j] * rs * gg[j]; s1 += (x[j].x * x[j].x + x[j].y * x[j].y) + (x[j].z * x[j].z + x[j].w * x[j].w); }
    if (dst16) { v2u* Xr = (v2u*)Xrow16 + lane;
#pragma unroll
        for (int j = 0; j < 4; ++j) { v2u w; w.x = pg8::cvt_pk_bf16(x[j].x, x[j].y); w.y = pg8::cvt_pk_bf16(x[j].z, x[j].w); Xr[64 * j] = w; } }
    else { f32x4* Xr = (f32x4*)Xrow32 + lane;
#pragma unroll
        for (int j = 0; j < 4; ++j) Xr[64 * j] = x[j]; }
    if (write_xn) { const float r1 = rsqrtf(wave_sum(s1) * (1.f / DM) + EPS); if (lane == 0) *rsp = r1; }
}

template <bool SAMPLE>
__device__ __forceinline__ void pool_unit(const bf16* __restrict__ Z, bf16* __restrict__ CAT, const float* __restrict__ state, float* __restrict__ newp,
                                          int seq, int t0, int nrows, int g, int lane) {
    const int c = g * 64 + lane, w = 2 << g;
    const size_t rowbase = SAMPLE ? (size_t)MP + (size_t)seq * ST : (size_t)seq * SEQ;
    const bf16* zc = Z + rowbase * ZP + c;
    const float* st = state + (size_t)seq * 15 * GW + c;
#define POOL_A(e) ((e) >= 0 ? bf2f(zc[(size_t)(e) * ZP]) : (SAMPLE ? st[(15 + (e)) * GW] : 0.f))
    float S = 0.f;
    for (int j = 1; j < w; ++j) S += POOL_A(t0 - j);
#pragma unroll 4
    for (int t = t0; t < t0 + nrows; ++t) {
        const float a = POOL_A(t); S += a;
        const float cnt = SAMPLE ? (float)w : (float)(t + 1 < w ? t + 1 : w);
        CAT[(rowbase + t) * DP + c] = (bf16)f2bf(S / cnt - a);
        const int e = t - w + 1; S -= POOL_A(e);
    }
    const int T = SAMPLE ? ST : SEQ;
    if (t0 + nrows == T) {
        for (int j = 0; j < 15; ++j) { const int e = T - 15 + j; newp[((size_t)seq * 15 + j) * GW + c] = POOL_A(e); }
    }
#undef POOL_A
}
template <int W>
__device__ __forceinline__ void pool_sample_unit(const bf16* __restrict__ Z, bf16* __restrict__ CAT, const float* __restrict__ state, float* __restrict__ newp, int seq, int g, int lane) {
    const int c = g * 64 + lane;
    const size_t rowbase = (size_t)MP + (size_t)seq * ST;
    float ext[15 + ST];
#pragma unroll
    for (int j = 0; j < 15; ++j) ext[j] = state[((size_t)seq * 15 + j) * GW + c];
#pragma unroll
    for (int t = 0; t < ST; ++t) ext[15 + t] = bf2f(Z[(rowbase + t) * ZP + c]);
#pragma unroll
    for (int t = 0; t < ST; ++t) { float S = 0.f;
#pragma unroll
        for (int i = 0; i < W; ++i) S += ext[15 + t - i];
        CAT[(rowbase + t) * DP + c] = (bf16)f2bf(S * (1.f / W) - ext[15 + t]); }
#pragma unroll
    for (int j = 0; j < 15; ++j) newp[((size_t)seq * 15 + j) * GW + c] = ext[ST + j];
}
template <bool SAMPLE>
__device__ __forceinline__ void short_unit(const bf16* __restrict__ Z, bf16* __restrict__ CAT, const float* __restrict__ state, float* __restrict__ news,
                                           const float* __restrict__ sw, int seq, int t0, int nrows, int h, int lane) {
    const int c = h * 64 + lane;
    const size_t rowbase = SAMPLE ? (size_t)MP + (size_t)seq * ST : (size_t)seq * SEQ;
    const bf16* zc = Z + rowbase * ZP + c;
    const float* st = state + (size_t)seq * 2 * GW + c;
    const float w0 = sw[c], w1 = sw[GW + c], w2 = sw[2 * GW + c];
#define SH_E(e) ((e) >= 0 ? bf2f(zc[(size_t)(e) * ZP + 1536]) * bf2f(zc[(size_t)(e) * ZP + 1792]) : (SAMPLE ? st[(2 + (e)) * GW] : 0.f))
    float e2 = SH_E(t0 - 2), e1 = SH_E(t0 - 1);
#pragma unroll 4
    for (int t = t0; t < t0 + nrows; ++t) {
        const float e0 = SH_E(t); const float bg = bf2f(zc[(size_t)t * ZP + 1280]);
        CAT[(rowbase + t) * DP + 768 + c] = (bf16)f2bf(bg * (w0 * e2 + w1 * e1 + w2 * e0));
        e2 = e1; e1 = e0;
    }
    const int T = SAMPLE ? ST : SEQ;
    if (t0 + nrows == T) { news[((size_t)seq * 2 + 0) * GW + c] = e2; news[((size_t)seq * 2 + 1) * GW + c] = e1; }
#undef SH_E
}
template <bool SAMPLE>
__device__ __forceinline__ void conv_unit(const bf16* __restrict__ Z, bf16* __restrict__ CAT, const float* __restrict__ state, float* __restrict__ newc,
                                          const float* __restrict__ cw, const float* __restrict__ cb, const float* __restrict__ lg, const float* __restrict__ lb,
                                          int seq, int t0, int nrows, int h, LAS float* gL, int lane) {
    const int c = h * 64 + lane;
    const size_t rowbase = SAMPLE ? (size_t)MP + (size_t)seq * ST : (size_t)seq * SEQ;
    const bf16* zc = Z + rowbase * ZP + c;
    bf16* oc = CAT + rowbase * DP + 256 + c;
    const int T = SAMPLE ? ST : SEQ;
    const bool last = (t0 + nrows == T);
    const int nin = nrows + 30;
#pragma unroll
    for (int r = 0; r < nin; ++r) { const int s = t0 - 30 + r; float gs = 0.f;
        if (s >= 0) { const unsigned off = (unsigned)s * ZP; const float p = bf2f(zc[off + 256]), gt = bf2f(zc[off + 512]); gs = p * sigm(gt); }
        else if (SAMPLE) gs = state[((size_t)seq * 30 + 30 + s) * GW + c];
        if (last && s >= T - 30) newc[((size_t)seq * 30 + (s - (T - 30))) * GW + c] = gs;
        gL[r * 64 + lane] = gs; }
    LDS_WAIT();
    float wk[31];
#pragma unroll
    for (int k = 0; k < 31; ++k) wk[k] = cw[k * GW + c];
    const float bias = cb[c], gg = lg[c], bb = lb[c];
#pragma unroll 1
    for (int tq = 0; tq < nrows; tq += 4) {
        float acc[4] = {bias, bias, bias, bias};
#pragma unroll
        for (int r = 0; r < 34; ++r) { const float gv = gL[(tq + r) * 64 + lane];
#pragma unroll
            for (int q = 0; q < 4; ++q) { const int k = r - q; if (k >= 0 && k <= 30) acc[q] += wk[k] * gv; } }
#pragma unroll
        for (int q = 0; q < 4; ++q) { const float cv = acc[q];
            const float mean = wave_sum(cv) * (1.f / 64.f); const float d = cv - mean;
            const float var = wave_sum(d * d) * (1.f / 64.f);
            const float y = d * rsqrtf(var + EPS) * gg + bb;
            oc[(unsigned)(t0 + tq + q) * DP] = (bf16)f2bf(y * sigm(y)); }
    }
    LDS_WAIT();
}
template <int W>
__device__ __forceinline__ void pool_unit_p(const bf16* __restrict__ Z, bf16* __restrict__ CAT, float* __restrict__ newp, int seq, int t0, int g, int lane) {
    const int rr = lane >> 3, cg = lane & 7, c0 = g * 64 + cg * 8, tb = t0 + rr * 8;
    const size_t rowbase = (size_t)seq * SEQ;
    const bf16* zb = Z + (rowbase + tb) * ZP + c0;
    v4u raw[W + 7];
#pragma unroll
    for (int j = 0; j < W + 7; ++j) { const int dj = j - (W - 1); raw[j] = (tb + dj >= 0) ? ld16(zb + (long)dj * ZP) : (v4u){0u, 0u, 0u, 0u}; }
    float S[8];
#pragma unroll
    for (int i = 0; i < 8; ++i) S[i] = 0.f;
#pragma unroll
    for (int j = 0; j < W - 1; ++j) { float f[8]; unpack8(raw[j], f);
#pragma unroll
        for (int i = 0; i < 8; ++i) S[i] += f[i]; }
    bf16* ob = CAT + (rowbase + tb) * DP + c0;
    const bool lastseg = (t0 + 64 == SEQ);
#pragma unroll
    for (int j = 0; j < 8; ++j) { float a[8], o[8], od[8]; unpack8(raw[j + W - 1], a); unpack8(raw[j], od);
        const int t = tb + j; const float inv = 1.f / (float)(t + 1 < W ? t + 1 : W);
#pragma unroll
        for (int i = 0; i < 8; ++i) { S[i] += a[i]; o[i] = S[i] * inv - a[i]; S[i] -= od[i]; }
        *(v4u*)(ob + j * DP) = pack8(o);
        if (lastseg && t >= SEQ - 15) { float* np = newp + ((size_t)seq * 15 + (t - (SEQ - 15))) * GW + c0; *(f32x4*)np = (f32x4){a[0], a[1], a[2], a[3]}; *(f32x4*)(np + 4) = (f32x4){a[4], a[5], a[6], a[7]}; }
    }
}
__device__ __forceinline__ void short_unit_p(const bf16* __restrict__ Z, bf16* __restrict__ CAT, float* __restrict__ news, const float* __restrict__ sw, int seq, int t0, int h, int lane) {
    const int rr = lane >> 3, cg = lane & 7, c0 = h * 64 + cg * 8, tb = t0 + rr * 8;
    const size_t rowbase = (size_t)seq * SEQ;
    const bf16* zb = Z + (rowbase + tb) * ZP + c0;
    v4u Bv[8], Cv[10], Hv[10];
#pragma unroll
    for (int j = 0; j < 10; ++j) { const int dj = j - 2; const bool ok = (tb + dj >= 0);
        Cv[j] = ok ? ld16(zb + (long)dj * ZP + 1536) : (v4u){0u, 0u, 0u, 0u}; Hv[j] = ok ? ld16(zb + (long)dj * ZP + 1792) : (v4u){0u, 0u, 0u, 0u};
        if (j >= 2) Bv[j - 2] = ld16(zb + (long)dj * ZP + 1280); }
    float w0[8], w1[8], w2[8];
#pragma unroll
    for (int i = 0; i < 8; ++i) { w0[i] = sw[c0 + i]; w1[i] = sw[GW + c0 + i]; w2[i] = sw[2 * GW + c0 + i]; }
    float e2[8], e1[8];
    { float c[8], hh[8]; unpack8(Cv[0], c); unpack8(Hv[0], hh);
#pragma unroll
      for (int i = 0; i < 8; ++i) e2[i] = c[i] * hh[i];
      unpack8(Cv[1], c); unpack8(Hv[1], hh);
#pragma unroll
      for (int i = 0; i < 8; ++i) e1[i] = c[i] * hh[i]; }
    bf16* ob = CAT + (rowbase + tb) * DP + 768 + c0;
#pragma unroll
    for (int j = 0; j < 8; ++j) { float c[8], hh[8], b[8], o[8]; unpack8(Cv[j + 2], c); unpack8(Hv[j + 2], hh); unpack8(Bv[j], b);
#pragma unroll
        for (int i = 0; i < 8; ++i) { const float e0 = c[i] * hh[i]; o[i] = b[i] * (w0[i] * e2[i] + w1[i] * e1[i] + w2[i] * e0); e2[i] = e1[i]; e1[i] = e0; }
        *(v4u*)(ob + j * DP) = pack8(o); }
    if (t0 + 64 == SEQ && rr == 7) { float* np = news + (size_t)seq * 2 * GW + c0;
        *(f32x4*)np = (f32x4){e2[0], e2[1], e2[2], e2[3]}; *(f32x4*)(np + 4) = (f32x4){e2[4], e2[5], e2[6], e2[7]};
        *(f32x4*)(np + GW) = (f32x4){e1[0], e1[1], e1[2], e1[3]}; *(f32x4*)(np + GW + 4) = (f32x4){e1[4], e1[5], e1[6], e1[7]}; }
}
__device__ __forceinline__ void conv_unit_p(const bf16* __restrict__ Z, bf16* __restrict__ CAT, float* __restrict__ newc,
                                            const float* __restrict__ cw, const float* __restrict__ cb, const float* __restrict__ lg, const float* __restrict__ lb,
                                            int seq, int t0, int h, LAS float* gL, int lane) {
    const int rr = lane >> 3, cg = lane & 7, c0 = h * 64 + cg * 8;
    const size_t rowbase = (size_t)seq * SEQ;
    const bool last = (t0 + 32 == SEQ);
    const int c = h * 64 + lane;
    float wk[31];
#pragma unroll
    for (int k = 0; k < 31; ++k) wk[k] = cw[k * GW + c];
    const float bias = cb[c];
    { v4u pv[8], gv[8];
#pragma unroll
      for (int j = 0; j < 8; ++j) { const int r = 8 * j + rr, sx = t0 - 30 + r; const bool ok = (sx >= 0 && r < 62);
          const bf16* zp = Z + (rowbase + (ok ? sx : 0)) * ZP + c0;
          pv[j] = ok ? ld16(zp + 256) : (v4u){0u, 0u, 0u, 0u}; gv[j] = ok ? ld16(zp + 512) : (v4u){0u, 0u, 0u, 0u}; }
#pragma unroll
      for (int j = 0; j < 8; ++j) { const int r = 8 * j + rr, sx = t0 - 30 + r; float p[8], gt[8]; unpack8(pv[j], p); unpack8(gv[j], gt);
#pragma unroll
          for (int i = 0; i < 8; ++i) p[i] = p[i] * sigm(gt[i]);
          if (r < 62) { *(LAS f32x4*)(gL + r * 64 + cg * 8) = (f32x4){p[0], p[1], p[2], p[3]}; *(LAS f32x4*)(gL + r * 64 + cg * 8 + 4) = (f32x4){p[4], p[5], p[6], p[7]}; }
          if (last && sx >= SEQ - 30 && r < 62) { float* np = newc + ((size_t)seq * 30 + (sx - (SEQ - 30))) * GW + c0; *(f32x4*)np = (f32x4){p[0], p[1], p[2], p[3]}; *(f32x4*)(np + 4) = (f32x4){p[4], p[5], p[6], p[7]}; } }
    }
    LDS_WAIT();
#pragma unroll 1
    for (int tq = 0; tq < 32; tq += 4) {
        float acc[4] = {bias, bias, bias, bias};
#pragma unroll
        for (int r = 0; r < 34; ++r) { const float gvv = gL[(tq + r) * 64 + lane];
#pragma unroll
            for (int q = 0; q < 4; ++q) { const int k = r - q; if (k >= 0 && k <= 30) acc[q] += wk[k] * gvv; } }
        LDS_WAIT();
#pragma unroll
        for (int q = 0; q < 4; ++q) gL[(tq + q) * 64 + lane] = acc[q];
    }
    LDS_WAIT();
    float gg[8], bb[8];
#pragma unroll
    for (int i = 0; i < 8; ++i) { gg[i] = lg[c0 + i]; bb[i] = lb[c0 + i]; }
    bf16* ob = CAT + (rowbase + t0) * DP + 256 + c0;
#pragma unroll
    for (int j = 0; j < 4; ++j) { const int r = 8 * j + rr; const f32x4 a = *(const LAS f32x4*)(gL + r * 64 + cg * 8), b = *(const LAS f32x4*)(gL + r * 64 + cg * 8 + 4);
        float x[8] = {a[0], a[1], a[2], a[3], b[0], b[1], b[2], b[3]};
        const float mean = sum8(((x[0] + x[1]) + (x[2] + x[3])) + ((x[4] + x[5]) + (x[6] + x[7]))) * (1.f / 64.f);
        float q = 0.f;
#pragma unroll
        for (int i = 0; i < 8; ++i) { x[i] -= mean; q += x[i] * x[i]; }
        const float rstd = rsqrtf(sum8(q) * (1.f / 64.f) + EPS);
#pragma unroll
        for (int i = 0; i < 8; ++i) { const float yy = x[i] * rstd * gg[i] + bb[i]; x[i] = yy * sigm(yy); }
        *(v4u*)(ob + r * DP) = pack8(x); }
    LDS_WAIT();
}
__device__ __forceinline__ int sgu_swz(int c, int chunk) { return (chunk ^ ((c & 15) ^ (c >> 4))) << 3; }
__device__ __forceinline__ void sgu_unit(const bf16* __restrict__ Z, bf16* __restrict__ CAT, const bf16* __restrict__ Wb, const float* __restrict__ lg, const float* __restrict__ lb,
                                         const float* __restrict__ sb, int chunk, int h, LAS bf16* vT, int lane) {
    const size_t r0 = (size_t)chunk * 128;
    const int fr = lane & 15, fq = lane >> 4;
    bf16x8 wf[8][4];
#pragma unroll
    for (int mt = 0; mt < 8; ++mt)
#pragma unroll
        for (int ks = 0; ks < 4; ++ks) if (ks * 32 <= mt * 16 + 15) wf[mt][ks] = *(const bf16x8*)(Wb + ((size_t)(h * 128 + mt * 16 + fr) * 128 + ks * 32 + fq * 8));
    { const int rr = lane >> 3, cg = lane & 7, c0 = h * 64 + cg * 8;
      float gg[8], bb[8];
#pragma unroll
      for (int i = 0; i < 8; ++i) { gg[i] = lg[c0 + i]; bb[i] = lb[c0 + i]; }
#pragma unroll 1
      for (int jh = 0; jh < 16; jh += 8) {
          v4u raw[8];
#pragma unroll
          for (int j = 0; j < 8; ++j) raw[j] = ld16(Z + (r0 + 8 * (jh + j) + rr) * ZP + 1024 + c0);
#pragma unroll
          for (int j = 0; j < 8; ++j) { float x[8]; unpack8(raw[j], x);
              float sm = ((x[0] + x[1]) + (x[2] + x[3])) + ((x[4] + x[5]) + (x[6] + x[7])); const float mean = sum8(sm) * (1.f / 64.f);
              float q = 0.f;
#pragma unroll
              for (int i = 0; i < 8; ++i) { x[i] -= mean; q += x[i] * x[i]; }
              const float rstd = rsqrtf(sum8(q) * (1.f / 64.f) + EPS);
#pragma unroll
              for (int i = 0; i < 8; ++i) { const int cl = cg * 8 + i; vT[cl * 128 + sgu_swz(cl, jh + j) + rr] = (bf16)f2bf(x[i] * rstd * gg[i] + bb[i]); } }
      }
    }
    LDS_WAIT();
#pragma unroll
    for (int mt = 0; mt < 8; ++mt) {
        f32x4 acc[4];
#pragma unroll
        for (int nt = 0; nt < 4; ++nt) acc[nt] = (f32x4){0.f, 0.f, 0.f, 0.f};
        const int t = mt * 16 + fr;
        v2u uv[4];
#pragma unroll
        for (int nt = 0; nt < 4; ++nt) uv[nt] = *(const v2u*)(Z + (r0 + t) * ZP + 768 + h * 64 + nt * 16 + 4 * fq);
        const float bt = sb[h * 128 + t];
#pragma unroll
        for (int ks = 0; ks < 4; ++ks) if (ks * 32 <= mt * 16 + 15) {
#pragma unroll
            for (int nt = 0; nt < 4; ++nt) { const int cl = nt * 16 + fr; const bf16x8 vf = *(const LAS bf16x8*)(vT + cl * 128 + sgu_swz(cl, ks * 4 + fq));
                acc[nt] = __builtin_amdgcn_mfma_f32_16x16x32_bf16(vf, wf[mt][ks], acc[nt], 0, 0, 0); }
        }
#pragma unroll
        for (int nt = 0; nt < 4; ++nt) { const float u0 = __uint_as_float(uv[nt].x << 16), u1 = __uint_as_float(uv[nt].x & 0xffff0000u), u2 = __uint_as_float(uv[nt].y << 16), u3 = __uint_as_float(uv[nt].y & 0xffff0000u);
            v2u w; w.x = pg8::cvt_pk_bf16(u0 * (acc[nt][0] + bt), u1 * (acc[nt][1] + bt)); w.y = pg8::cvt_pk_bf16(u2 * (acc[nt][2] + bt), u3 * (acc[nt][3] + bt));
            *(v2u*)(CAT + (r0 + t) * DP + 512 + h * 64 + nt * 16 + 4 * fq) = w; }
    }
    LDS_WAIT();
}
__device__ __forceinline__ void sgu_sample_unit(const bf16* __restrict__ Z, bf16* __restrict__ CAT, const float* __restrict__ Wf, const float* __restrict__ lg, const float* __restrict__ lb,
                                                const float* __restrict__ sb, float* __restrict__ vout, int seq, int h, int lane) {
    const int c = h * 64 + lane; const size_t rowbase = (size_t)MP + (size_t)seq * ST;
    const float gg = lg[c], bb = lb[c];
    float vn[ST];
#pragma unroll
    for (int t = 0; t < ST; ++t) { const float v = bf2f(Z[(rowbase + t) * ZP + 1024 + c]); const float mean = wave_sum(v) * (1.f / 64.f); const float d = v - mean; const float var = wave_sum(d * d) * (1.f / 64.f);
        vn[t] = d * rsqrtf(var + EPS) * gg + bb; vout[((size_t)seq * ST + t) * GW + c] = vn[t]; }
#pragma unroll
    for (int t = 0; t < ST; ++t) { float sv = sb[h * 128 + t];
#pragma unroll
        for (int s = 0; s <= t; ++s) sv += Wf[((size_t)h * 128 + t) * 128 + s] * vn[s];
        const float u = bf2f(Z[(rowbase + t) * ZP + 768 + c]);
        CAT[(rowbase + t) * DP + 512 + c] = (bf16)f2bf(u * sv); }
}

#define XB_TMO      128
#define XB_XCNT(j)  (256  + 64 * (j))
#define XB_XSUB(j)  (1280 + 64 * (j))
#define XB_XGEN(j)  (2304 + 64 * (j))
#define XB_TOP      3328
#define XB_TOPGEN   3392
#define XCD_BAR_WORDS 3456
#define XB_SPIN_CAP (1u << 18)

__device__ __forceinline__ unsigned xb_ld(unsigned* p)              { return __hip_atomic_load(p, __ATOMIC_RELAXED, __HIP_MEMORY_SCOPE_AGENT); }
__device__ __forceinline__ unsigned xb_add(unsigned* p, unsigned v) { return __hip_atomic_fetch_add(p, v, __ATOMIC_RELAXED, __HIP_MEMORY_SCOPE_AGENT); }
__device__ __forceinline__ unsigned xb_xcc_id() { return (unsigned)__builtin_amdgcn_s_getreg((3 << 11) | 20) & 0xFu; }
#define XB_SPIN(cond, bar) do { unsigned _sp = 0; while (cond) { __builtin_amdgcn_s_sleep(1); \
    if ((++_sp & 255u) == 0u) { if (xb_ld(&(bar)[XB_TMO])) break; if (_sp > XB_SPIN_CAP) { atomicAdd(&(bar)[XB_TMO], 1u); break; } } } } while (0)

struct XcdBarrier {
    unsigned* bar; unsigned x;
    volatile LAS unsigned* st;
};

__device__ __forceinline__ XcdBarrier xcd_barrier_post(unsigned* bar, volatile LAS unsigned* st) {
    XcdBarrier b; b.bar = bar; b.x = xb_xcc_id(); b.st = st;
    if (threadIdx.x == 0) (void)xb_add(&bar[XB_XCNT(b.x)], 1u);
    return b;
}
__device__ __forceinline__ void xcd_barrier_complete(unsigned* bar, unsigned x, unsigned& nloc, unsigned& nx) {
    const unsigned G = gridDim.x * gridDim.y * gridDim.z;
    unsigned sum, cnt, mine, sp = 0u;
    for (;;) {
        sum = 0u; cnt = 0u; mine = 0u;
#pragma unroll
        for (unsigned j = 0; j < 16; ++j) { const unsigned c = xb_ld(&bar[XB_XCNT(j)]); sum += c; cnt += (c > 0u) ? 1u : 0u; mine = (j == x) ? c : mine; }
        if (sum == G) break;
        __builtin_amdgcn_s_sleep(1);
        if ((++sp & 255u) == 0u) { if (xb_ld(&bar[XB_TMO])) break; if (sp > XB_SPIN_CAP) { atomicAdd(&bar[XB_TMO], 1u); break; } }
    }
    nloc = mine > 0u ? mine : 1u; nx = cnt > 0u ? cnt : 1u;
}

__device__ __forceinline__ void xcd_barrier(const XcdBarrier& b) {
    asm volatile("s_waitcnt vmcnt(0)" ::: "memory");
    __syncthreads();
    if (threadIdx.x == 0) {
        unsigned* bar = b.bar;
        __builtin_amdgcn_s_waitcnt(0);
        unsigned nloc = b.st[0], nx = b.st[1];
        if (nloc == 0u) { xcd_barrier_complete(bar, b.x, nloc, nx); b.st[0] = nloc; b.st[1] = nx; }
        const unsigned old = xb_add(&bar[XB_XSUB(b.x)], 1u);
        const unsigned gen = old / nloc;
        if (old + 1u == (gen + 1u) * nloc) {
            __builtin_amdgcn_fence(__ATOMIC_RELEASE, "agent");
            asm volatile("s_waitcnt vmcnt(0)" ::: "memory");
            const unsigned og = xb_add(&bar[XB_TOP], 1u);
            const unsigned tg = og / nx;
            if (og + 1u == (tg + 1u) * nx) xb_add(&bar[XB_TOPGEN], 1u);
            else XB_SPIN(xb_ld(&bar[XB_TOPGEN]) == tg, bar);
            __builtin_amdgcn_fence(__ATOMIC_ACQUIRE, "agent");
            xb_add(&bar[XB_XGEN(b.x)], 1u);
            asm volatile("s_waitcnt vmcnt(0)" ::: "memory");
        } else {
            XB_SPIN(xb_ld(&bar[XB_XGEN(b.x)]) == gen, bar);
            __builtin_amdgcn_fence(__ATOMIC_ACQUIRE, "agent");
            asm volatile("s_waitcnt vmcnt(0)" ::: "memory");
        }
    }
    __syncthreads();
}

template <int NT, int ACT, int K>
__device__ __forceinline__ void small_gemm_tile(LAS unsigned char* lds, const bf16* __restrict__ A, const bf16* __restrict__ Bt, bf16* __restrict__ O, int ldc, int lda, int ldb, const float* __restrict__ rs, int m0, int n0, int tid) {
    constexpr int NC = 16 * NT, KW = K / 8, NCH = KW / 128;
    const int wave = __builtin_amdgcn_readfirstlane(tid >> 6), lane = tid & 63, fr = lane & 15, fq = lane >> 4;
    const bf16* ap = A + (size_t)(m0 + fr) * lda + wave * KW + fq * 8;
    const bf16* bp = Bt + (size_t)(n0 + fr) * ldb + wave * KW + fq * 8;
    f32x4 acc[4][NT];
#pragma unroll
    for (int m = 0; m < 4; ++m)
#pragma unroll
        for (int n = 0; n < NT; ++n) acc[m][n] = (f32x4){0.f, 0.f, 0.f, 0.f};
    if constexpr (NCH == 1) {
        bf16x8 fa[4][4], fb[4][NT];
#pragma unroll
        for (int s_ = 0; s_ < 4; ++s_) {
#pragma unroll
            for (int m = 0; m < 4; ++m) fa[s_][m] = *(const bf16x8*)(ap + (size_t)m * 16 * lda + s_ * 32);
#pragma unroll
            for (int n = 0; n < NT; ++n) fb[s_][n] = *(const bf16x8*)(bp + (size_t)n * 16 * ldb + s_ * 32); }
        __builtin_amdgcn_sched_barrier(0);
#pragma unroll
        for (int s_ = 0; s_ < 4; ++s_)
#pragma unroll
            for (int m = 0; m < 4; ++m)
#pragma unroll
                for (int n = 0; n < NT; ++n) acc[m][n] = __builtin_amdgcn_mfma_f32_16x16x32_bf16(fa[s_][m], fb[s_][n], acc[m][n], 0, 0, 0);
        __builtin_amdgcn_sched_barrier(0);
    } else {
        constexpr int NC2 = KW / 64;
        bf16x8 fa[3][2][4], fb[3][2][NT];
#define SG_LD(buf, c) do { _Pragma("unroll") for (int s_ = 0; s_ < 2; ++s_) { \
            _Pragma("unroll") for (int m = 0; m < 4; ++m) fa[buf][s_][m] = *(const bf16x8*)(ap + (size_t)m * 16 * lda + (c) * 64 + s_ * 32); \
            _Pragma("unroll") for (int n = 0; n < NT; ++n) fb[buf][s_][n] = *(const bf16x8*)(bp + (size_t)n * 16 * ldb + (c) * 64 + s_ * 32); } } while (0)
        SG_LD(0, 0); SG_LD(1, 1);
        __builtin_amdgcn_sched_barrier(0);
#pragma unroll
        for (int c = 0; c < NC2; ++c) {
            if (c + 2 < NC2) SG_LD((c + 2) % 3, c + 2);
            __builtin_amdgcn_sched_barrier(0);
#pragma unroll
            for (int s_ = 0; s_ < 2; ++s_)
#pragma unroll
                for (int m = 0; m < 4; ++m)
#pragma unroll
                    for (int n = 0; n < NT; ++n) acc[m][n] = __builtin_amdgcn_mfma_f32_16x16x32_bf16(fa[c % 3][s_][m], fb[c % 3][s_][n], acc[m][n], 0, 0, 0);
            __builtin_amdgcn_sched_barrier(0);
        }
#undef SG_LD
    }
    LAS float* P = (LAS float*)lds + wave * (64 * NC);
#pragma unroll
    for (int m = 0; m < 4; ++m)
#pragma unroll
        for (int n = 0; n < NT; ++n)
#pragma unroll
            for (int i = 0; i < 4; ++i) P[(m * 16 + fq * 4 + i) * NC + n * 16 + fr] = acc[m][n][i];
    __syncthreads();
    constexpr int EPT = 64 * NC / 512;
    const int e0 = tid * EPT, row = e0 / NC, col = e0 % NC;
    float r[EPT];
#pragma unroll
    for (int j = 0; j < EPT; ++j) r[j] = 0.f;
#pragma unroll
    for (int w = 0; w < 8; ++w) { const LAS f32x4* q = (const LAS f32x4*)((LAS float*)lds + w * (64 * NC) + e0);
#pragma unroll
        for (int j = 0; j < EPT / 4; ++j) { const f32x4 v = q[j]; r[4 * j] += v[0]; r[4 * j + 1] += v[1]; r[4 * j + 2] += v[2]; r[4 * j + 3] += v[3]; } }
    if (rs) { const float sc = rs[m0 + row];
#pragma unroll
        for (int j = 0; j < EPT; ++j) r[j] *= sc; }
    if (ACT == 1) {
#pragma unroll
        for (int j = 0; j < EPT; ++j) { const float t = fmaxf(r[j], 0.f); r[j] = t * t; } }
    bf16* op = O + (size_t)(m0 + row) * ldc + n0 + col;
    if (EPT == 8) { v4u w; w.x = pk2(r[0], r[1]); w.y = pk2(r[2], r[3]); w.z = pk2(r[4 % EPT], r[5 % EPT]); w.w = pk2(r[6 % EPT], r[7 % EPT]); *(v4u*)op = w; }
    else { v2u w; w.x = pk2(r[0], r[1]); w.y = pk2(r[2], r[3]); *(v2u*)op = w; }
    __syncthreads();
}

#define SMALL_TN(j, ntn) ((((j) >> 8) * 32 + ((j) & 7) * 4 + (((j) >> 3) & 3)))
constexpr int NPH = 15;
#ifndef REP_PRO
#define REP_PRO 1
#endif
#ifndef REP_GEMM
#define REP_GEMM 1
#endif
#ifndef REP_MIX
#define REP_MIX 1
#endif
#ifndef REP_SYNC
#define REP_SYNC 1
#endif
struct Args { const float* in[24]; float* out; unsigned char* ws; int ph_lo, ph_hi; };
__global__ void __launch_bounds__(NWAVES * 64, 2) hybrid_fwd(Args args) {
    extern __shared__ __attribute__((aligned(16))) unsigned char lds_raw[];
    LAS unsigned char* lds = (LAS unsigned char*)lds_raw;
    volatile LAS unsigned* MISC = (volatile LAS unsigned*)(lds + MISC_OFF);
    if (threadIdx.x < 64) MISC[threadIdx.x] = 0u;
    __syncthreads();
    (void)xcd_barrier_post((unsigned*)(args.ws + WS_CTL), MISC + 8);
    for (int ph = args.ph_lo; ph < args.ph_hi;) {
        int tid = threadIdx.x; asm volatile("" : "+v"(tid));
        const int lane = tid & 63, wave = __builtin_amdgcn_readfirstlane(tid >> 6);
        const int G = gridDim.x; const int bx = blockIdx.x;
        unsigned char* ws = args.ws;
        if (ph == 0) {
            const int vcu = (G % 8 == 0) ? (bx % 8) * (G / 8) + bx / 8 : bx; const int gw = vcu * NWAVES + wave, NGW = G * NWAVES;
            LAS float* scr = (LAS float*)(lds + wave * WAVE_SCR);
            bf16* XN = (bf16*)(ws + WS_XN); bf16* SGW = (bf16*)(ws + WS_SGUW);
            constexpr int I_FOLD = 4 * (DM / 32), I_OUT = (DM / 64) * (DM / 32) - I_FOLD, I_IN = (DM / 64) * (INW / 32), I_UP = (DM / 64) * (FF / 32), I_DN = (FF / 64) * (DM / 32);
            constexpr int I_LAYER = I_OUT + I_IN + I_UP + I_DN, I_ALL = DEPTH * I_LAYER;
            for (int it = gw; it < DEPTH * I_FOLD * 4; it += NGW) { const int l = it / (I_FOLD * 4), r = it % (I_FOLD * 4);
                fold_item(args.in[10] + (size_t)l * DM * DM, (bf16*)(ws + WS_W + (size_t)l * W_LAYER + W_OUT), args.in[11] + (size_t)l * 4 * 64 * 64, args.in[12] + (size_t)l * GW, scr, r, lane); }
#define TR_DECODE(it_, d_) do { const int l_ = (it_) / I_LAYER; int r_ = (it_) % I_LAYER; unsigned char* wl_ = ws + WS_W + (size_t)l_ * W_LAYER; int nblk_; \
                if (r_ < I_OUT) { r_ += I_FOLD; d_.W = args.in[10] + (size_t)l_ * DM * DM; d_.WT = (bf16*)(wl_ + W_OUT); d_.gk = nullptr; d_.K = DM; d_.N = DM; } \
                else if ((r_ -= I_OUT) < I_IN) { d_.W = args.in[9] + (size_t)l_ * DM * INW; d_.WT = (bf16*)(wl_ + W_IN); d_.gk = args.in[5] + (size_t)l_ * DM; d_.K = DM; d_.N = INW; } \
                else if ((r_ -= I_IN) < I_UP) { d_.W = args.in[22] + (size_t)l_ * DM * FF; d_.WT = (bf16*)(wl_ + W_UP); d_.gk = args.in[7] + (size_t)l_ * DM; d_.K = DM; d_.N = FF; } \
                else { r_ -= I_UP; d_.W = args.in[23] + (size_t)l_ * FF * DM; d_.WT = (bf16*)(wl_ + W_DN); d_.gk = nullptr; d_.K = FF; d_.N = DM; } \
                nblk_ = d_.N / 32; d_.k0 = 64 * (r_ / nblk_); d_.n0 = 32 * (r_ % nblk_); } while (0)
            { const int TSTEP = NGW; int it = NGW - 1 - gw;
              if (it >= 0 && it < I_ALL) {
                TrDesc dc; TR_DECODE(it, dc);
                float va[32], vb[32];
                tr_load(va, dc, lane);
#pragma unroll 1
                for (;;) {
                    const int itn = it + TSTEP; const bool more = itn < I_ALL;
                    TrDesc dn; { const int q = more ? itn : it; TR_DECODE(q, dn); }
                    tr_load(vb, dn, lane);
                    tr_store(va, dc, scr, lane);
                    if (!more) break;
#pragma unroll
                    for (int i = 0; i < 32; ++i) va[i] = vb[i];
                    dc = dn; it = itn;
                }
              }
            }
#undef TR_DECODE
            for (int m = gw; m < MT; m += NGW) rms_row_to_bf16(m < MP ? args.in[0] + (size_t)m * DM : args.in[1] + (size_t)(m - MP) * DM, (bf16*)args.out + (size_t)m * 2 * DM, (float*)(ws + WS_RS) + m, lane);
            for (int e = bx * (NWAVES * 64) + tid; e < DEPTH * 4 * 128 * 128; e += G * NWAVES * 64) { const int t = (e >> 7) & 127, s = e & 127; SGW[e] = (bf16)(s <= t ? f2bf(args.in[19][e]) : 0u); }
        } else {
            const int l = (ph - 1) / 7, k = (ph - 1) - 7 * l;
            unsigned char* wl = ws + WS_W + (size_t)l * W_LAYER;
            if (k == 0 || k == 2 || k == 5) {
                const bf16* A = k == 0 ? (const bf16*)args.out : (const bf16*)(ws + (k == 2 ? WS_CAT : WS_H));
                const bf16* Bt = (const bf16*)(wl + (k == 0 ? W_IN : k == 2 ? W_OUT : W_DN));
                bf16* O = (bf16*)(ws + (k == 0 ? WS_Z : WS_O));
                const int N = k == 0 ? INW : DM, K = k == 5 ? FF : DM;
                pg8::Gemm g{A, Bt, MP, N, K, k == 5 ? FP : k == 0 ? 2 * DM : DP, K + WPAD}; pg8::StaticOrder S; S.init(MP, N, G, bx);
                pg8::EpiBf16<0> E{O, k == 0 ? ZP : OP, k == 0 ? (const float*)(ws + WS_RS) : nullptr};
                pg8::gemm_phase<pg8::EpiBf16<0>, pg8::StaticOrder, true, true>(lds, g, S, E, tid);
                if (k == 0) { for (int j = bx; j < (MS / 64) * (INW / 64); j += G) small_gemm_tile<4, 0, DM>(lds, A, Bt, O, ZP, 2 * DM, DM + WPAD, (const float*)(ws + WS_RS), MP + ((j >> 5) & 7) * 64, SMALL_TN(j, INW / 64) * 64, tid); }
                else { for (int j = bx; j < (MS / 64) * (DM / 32); j += G) { if (k == 2) small_gemm_tile<2, 0, DM>(lds, A, Bt, O, OP, DP, DM + WPAD, nullptr, MP + ((j >> 5) & 7) * 64, SMALL_TN(j, DM / 32) * 32, tid); else small_gemm_tile<2, 0, FF>(lds, A, Bt, O, OP, FP, FF + WPAD, nullptr, MP + ((j >> 5) & 7) * 64, SMALL_TN(j, DM / 32) * 32, tid); } }
            } else if (k == 4) {
                pg8::Gemm g{(const bf16*)args.out, (const bf16*)(wl + W_UP), MP, FF, DM, 2 * DM, DM + WPAD}; pg8::StaticOrder S; S.init(MP, FF, G, bx);
                pg8::EpiBf16<1> E{(bf16*)(ws + WS_H), FP, (const float*)(ws + WS_RS)};
                pg8::gemm_phase<pg8::EpiBf16<1>, pg8::StaticOrder, true, true>(lds, g, S, E, tid);
                for (int j = bx; j < (MS / 64) * (FF / 64); j += G) small_gemm_tile<4, 1, DM>(lds, (const bf16*)args.out, (const bf16*)(wl + W_UP), (bf16*)(ws + WS_H), FP, 2 * DM, DM + WPAD, (const float*)(ws + WS_RS), MP + ((j >> 5) & 7) * 64, SMALL_TN(j, FF / 64) * 64, tid);
            } else if (k == 1) {
                const int vcu = (G % 8 == 0) ? (bx % 8) * (G / 8) + bx / 8 : bx; const int gw = vcu * NWAVES + wave, NGW = G * NWAVES;
                LAS float* scr = (LAS float*)(lds + wave * WAVE_SCR);
                const bf16* ZB = (const bf16*)(ws + WS_Z); bf16* CAT = (bf16*)(ws + WS_CAT); const bf16* SGW = (const bf16*)(ws + WS_SGUW) + (size_t)l * 4 * 128 * 128;
                float* out = args.out;
                constexpr int NU_SGU = 512, NU_CONV = 2048, NU_SEG = 1024, NU_SMP = 2048, NU = NU_SGU + NU_CONV + 2 * NU_SEG + NU_SMP;
#pragma unroll 1
                for (int ui = 0; ; ++ui) {
                    int u;
                    if (NGW != 2048) { u = ui * NGW + gw; if (u >= NU) break; }
                    else { if (ui >= 4) break;
                        if (gw < 512) { if (ui == 0) u = gw; else if (ui == 1) u = NU_SGU + 1536 + gw; else break; }
                        else { const int g5 = gw - 512; if (ui == 0) u = NU_SGU + g5; else { const int sidx = (ui - 1) * 1536 + g5; if (sidx >= 2 * NU_SEG + NU_SMP) break; u = NU_SGU + NU_CONV + sidx; } } }
                    int lane = tid & 63; asm volatile("" : "+v"(lane));
                    if (u < NU_SGU) { sgu_unit(ZB, CAT, SGW, args.in[17] + (size_t)l * GW, args.in[18] + (size_t)l * GW, args.in[20] + (size_t)l * 4 * 128, u >> 2, u & 3, (LAS bf16*)scr, lane); continue; }
                    int r = u - NU_SGU;
                    if (r < NU_CONV) { const int seg = r >> 2, h = r & 3, seq = seg >> 6, t0 = (seg & 63) * 32;
                        conv_unit_p(ZB, CAT, out + OUT_CONV_P + (size_t)l * NBP * 30 * GW, args.in[13] + (size_t)l * 31 * GW, args.in[14] + (size_t)l * GW, args.in[15] + (size_t)l * GW, args.in[16] + (size_t)l * GW, seq, t0, h, scr, lane);
                        continue; }
                    r -= NU_CONV;
                    if (r < 2 * NU_SEG) { const int ty = r / NU_SEG, q = r % NU_SEG, seg = q >> 2, h = q & 3, seq = seg >> 5, t0 = (seg & 31) * 64;
                        if (ty == 0) { float* np = out + OUT_POOL_P + (size_t)l * NBP * 15 * GW;
                            if (h == 0) pool_unit_p<2>(ZB, CAT, np, seq, t0, h, lane); else if (h == 1) pool_unit_p<4>(ZB, CAT, np, seq, t0, h, lane);
                            else if (h == 2) pool_unit_p<8>(ZB, CAT, np, seq, t0, h, lane); else pool_unit_p<16>(ZB, CAT, np, seq, t0, h, lane); }
                        else short_unit_p(ZB, CAT, out + OUT_SHORT_P + (size_t)l * NBP * 2 * GW, args.in[21] + (size_t)l * 3 * GW, seq, t0, h, lane);
                        continue; }
                    r -= 2 * NU_SEG;
                    { const int ty = r >> 9, q = r & 511, seq = q >> 2, h = q & 3;
                        if (ty == 0) conv_unit<true>(ZB, CAT, args.in[3] + (size_t)l * NSB * 30 * GW, out + OUT_CONV_S + (size_t)l * NSB * 30 * GW, args.in[13] + (size_t)l * 31 * GW, args.in[14] + (size_t)l * GW, args.in[15] + (size_t)l * GW, args.in[16] + (size_t)l * GW, seq, 0, ST, h, scr, lane);
                        else if (ty == 1) { const float* sp = args.in[2] + (size_t)l * NSB * 15 * GW; float* np = out + OUT_POOL_S + (size_t)l * NSB * 15 * GW;
                            if (h == 0) pool_sample_unit<2>(ZB, CAT, sp, np, seq, h, lane); else if (h == 1) pool_sample_unit<4>(ZB, CAT, sp, np, seq, h, lane); else if (h == 2) pool_sample_unit<8>(ZB, CAT, sp, np, seq, h, lane); else pool_sample_unit<16>(ZB, CAT, sp, np, seq, h, lane); }
                        else if (ty == 2) short_unit<true>(ZB, CAT, args.in[4] + (size_t)l * NSB * 2 * GW, out + OUT_SHORT_S + (size_t)l * NSB * 2 * GW, args.in[21] + (size_t)l * 3 * GW, seq, 0, ST, h, lane);
                        else sgu_sample_unit(ZB, CAT, args.in[19] + (size_t)l * 4 * 128 * 128, args.in[17] + (size_t)l * GW, args.in[18] + (size_t)l * GW, args.in[20] + (size_t)l * 4 * 128, out + OUT_V_S + (size_t)l * NSB * ST * GW, seq, h, lane); }
                }
            } else {
                const int vcu = (G % 8 == 0) ? (bx % 8) * (G / 8) + bx / 8 : bx; const int gw = vcu * NWAVES + wave, NGW = G * NWAVES;
                const float* g = args.in[k == 3 ? 6 : 8] + (size_t)l * DM;
                float* X = args.out; const bf16* OB = (const bf16*)(ws + WS_O); float* RS = (float*)(ws + WS_RS);
                const bool from_input = (l == 0 && k == 3), write_xn = !(l == DEPTH - 1 && k == 6);
                f32x4 gg[4];
#pragma unroll
                for (int j = 0; j < 4; ++j) gg[j] = ((const f32x4*)g + lane)[64 * j];
                const int m_lo = 0;
#define EW_X32(m) ((m) < MP ? args.in[0] + (size_t)(m) * DM : args.in[1] + (size_t)((m) - MP) * DM)
                bf16* X16 = (bf16*)args.out;
                const bool dst16 = write_xn;
                { EwRow r0, r1, r2;
                  const int ma = m_lo + gw;
                  if (ma < MT) {
                    ew_load(r0, X16 + (size_t)ma * 2 * DM, OB + (size_t)ma * OP, lane);
                    { const int mb = ma + NGW < MT ? ma + NGW : ma; ew_load(r1, X16 + (size_t)mb * 2 * DM, OB + (size_t)mb * OP, lane); }
#pragma unroll 1
                    for (int m = ma; m < MT; m += NGW) {
                        { const int mc = m + 2 * NGW < MT ? m + 2 * NGW : m; ew_load(r2, X16 + (size_t)mc * 2 * DM, OB + (size_t)mc * OP, lane); }
                        ew_finish(r0, gg, X + (size_t)m * DM, X16 + (size_t)m * 2 * DM, dst16, RS + m, write_xn, lane);
                        r0 = r1; r1 = r2;
                    }
                  }
                }
#undef EW_X32
            }
        }
        ++ph;
        if (ph < args.ph_hi) {
            if (args.ph_lo < 0) cg::this_grid().sync();
            else { XcdBarrier b; b.bar = (unsigned*)(args.ws + WS_CTL); b.x = xb_xcc_id(); b.st = (volatile LAS unsigned*)(lds + MISC_OFF) + 8; xcd_barrier(b); }
        }
    }
}

#ifndef MK_N_LAUNCHES
#define MK_N_LAUNCHES 1
#endif
extern "C" void kernel_launch(void* const* d_in, const int* in_sizes, int n_in, void* d_out, int out_size, void* d_ws, size_t ws_size, hipStream_t stream) {
    static int grid = 0;
    if (grid == 0) {
        if (n_in != 24 || (size_t)out_size != OUT_END || ws_size < WS_END) { fprintf(stderr, "kernel_launch: unexpected shapes (n_in %d out %d ws %zu)\n", n_in, out_size, ws_size); grid = -1; return; }
        int dev = 0, cus = 0, per_cu = 0;
        if (hipGetDevice(&dev) != hipSuccess || hipDeviceGetAttribute(&cus, hipDeviceAttributeMultiprocessorCount, dev) != hipSuccess) { grid = -1; return; }
        if (hipFuncSetAttribute((const void*)hybrid_fwd, hipFuncAttributeMaxDynamicSharedMemorySize, LDS_BYTES) != hipSuccess) { fprintf(stderr, "kernel_launch: hipFuncSetAttribute failed\n"); grid = -1; return; }
        if (hipOccupancyMaxActiveBlocksPerMultiprocessor(&per_cu, (const void*)hybrid_fwd, NWAVES * 64, LDS_BYTES) != hipSuccess || per_cu < 1) per_cu = 1;
        (void)hipGetLastError();
        grid = cus * per_cu;
    }
    if (grid < 0) return;
    if (hipMemsetAsync((char*)d_ws + WS_CTL, 0, CTL_ZERO_BYTES, stream) != hipSuccess) { fprintf(stderr, "kernel_launch: hipMemsetAsync failed\n"); return; }
    Args a{};
    for (int i = 0; i < 24; ++i) a.in[i] = (const float*)d_in[i];
    a.out = (float*)d_out; a.ws = (unsigned char*)d_ws;
#if MK_N_LAUNCHES == 1
    a.ph_lo = 0; a.ph_hi = NPH;
    void* kargs[] = {&a};
    hipError_t e = hipLaunchCooperativeKernel((const void*)hybrid_fwd, dim3(grid), dim3(NWAVES * 64), kargs, LDS_BYTES, stream);
    if (e != hipSuccess) fprintf(stderr, "cooperative launch failed: %s (grid %d)\n", hipGetErrorString(e), grid);
#else
    for (int p = 0; p < NPH; ++p) { a.ph_lo = p; a.ph_hi = p + 1; hipLaunchKernelGGL(hybrid_fwd, dim3(grid), dim3(NWAVES * 64), LDS_BYTES, stream, a); }
#endif
}
```

```cpp
#include <hip/hip_runtime.h>
#include <hip/hip_cooperative_groups.h>
#include <cstdio>
#include <cstdint>
namespace pg8 {
#define PG8_LAS __attribute__((address_space(3)))
typedef unsigned short bf16_t;
typedef short bf16x8 __attribute__((ext_vector_type(8)));
typedef float f32x4 __attribute__((ext_vector_type(4)));
typedef unsigned u32x4 __attribute__((ext_vector_type(4)));
constexpr int KPAD = 64;
constexpr int BM = 256, BK = 64, HALF = 128, HTB = HALF * BK * 2  , STAGE_BYTES = 8 * HTB, NXCD = 8, WGM = 1;

__host__ __device__ __forceinline__ int lds_byte(int r, int c) { const int st = (r >> 4) * 2 + (c >> 5), rr = r & 15, cc = c & 31, ob = rr * 64 + cc * 2; return st * 1024 + (ob ^ (((ob >> 9) & 1) << 5)); }
__host__ __device__ __forceinline__ void stage_rc(int b, int& R, int& C) { const int st = b / 1024, sb = b % 1024, swz = sb ^ (((sb >> 9) & 1) << 5); R = (st >> 1) * 16 + swz / 64; C = (st & 1) * 32 + (swz % 64) / 2; }
__host__ __device__ __forceinline__ int perm32(int rho) { const int n = rho >> 4, i = rho & 15; return 8 * (i >> 2) + 4 * n + (i & 3); }

struct Unit { int pm, pn; };
struct Gemm { const bf16_t* A; const bf16_t* Bt; int M, N, K, lda, ldb; };

struct StaticOrder {
    int nM, nN, nwg, G, c;
    __host__ __device__ void init(int M, int N, int G_, int c_) { nM = M / BM; nN = N / BM; nwg = nM * nN; G = G_; c = c_; }
    __host__ __device__ bool next(int i, Unit& u) const {
        const long L = (long)i * G + c; if (L >= nwg) return false;
        int wgid = (int)L; { const int q = nwg / NXCD, r = nwg % NXCD, xcd = wgid % NXCD, off = wgid / NXCD; wgid = (xcd < r ? xcd * (q + 1) : r * (q + 1) + (xcd - r) * q) + off; }
        const int nig = WGM * nN, gid = wgid / nig, fm = gid * WGM, gsz = (nM - fm) < WGM ? (nM - fm) : WGM;
        u.pm = fm + ((wgid % nig) % gsz); u.pn = (wgid % nig) / gsz; return true;
    }
    __device__ __forceinline__ void a_ready(const Unit&) const {}
    __device__ __forceinline__ void done(const Unit&) const {}
};

__device__ __forceinline__ unsigned cvt_pk_bf16(float lo, float hi) { unsigned r; asm volatile("v_cvt_pk_bf16_f32 %0, %1, %2" : "=v"(r) : "v"(lo), "v"(hi)); return r; }
__device__ __forceinline__ float relu_sq(float x) { float r; asm volatile("v_max_f32 %0, 0, %1" : "=v"(r) : "v"(x)); return r * r; }
__device__ __forceinline__ void st16_wt(void* p, u32x4 v) { asm volatile("global_store_dwordx4 %0, %1, off sc1" :: "v"(p), "v"(v) : "memory"); }
template <int ACT  > struct EpiBf16 {
    static constexpr bool PERM = true, AFTER_DRAIN = false;
    bf16_t* O; int ldc; const float* rs;
    __device__ __forceinline__ void operator()(const f32x4 (&acc)[2][2][4][2], const Unit& u, int wr, int wc, int fr, int fq) const {
        const int row0 = u.pm * BM + wr * 64 + fr; const int col0 = u.pn * BM + wc * 32 + 8 * fq;
#pragma unroll
        for (int ai = 0; ai < 2; ++ai)
#pragma unroll
            for (int m = 0; m < 4; ++m) { bf16_t* rowp = O + (size_t)(row0 + ai * HALF + m * 16) * ldc + col0; const float sc = rs ? rs[row0 + ai * HALF + m * 16] : 1.f;
#pragma unroll
                for (int bj = 0; bj < 2; ++bj) { f32x4 v0 = acc[ai][bj][m][0] * sc, v1 = acc[ai][bj][m][1] * sc;
                    if (ACT == 1) {
#pragma unroll
                        for (int e = 0; e < 4; ++e) { v0[e] = relu_sq(v0[e]); v1[e] = relu_sq(v1[e]); } }
                    u32x4 w; w.x = cvt_pk_bf16(v0[0], v0[1]); w.y = cvt_pk_bf16(v0[2], v0[3]); w.z = cvt_pk_bf16(v1[0], v1[1]); w.w = cvt_pk_bf16(v1[2], v1[3]);
                    *(u32x4*)(rowp + bj * HALF) = w; } }
    }
};

template <class Epi, class Sched, bool ALIGN_EPI = false, bool SP2 = false>
__device__ __forceinline__ void gemm_phase(PG8_LAS unsigned char* lds, const Gemm g, const Sched& S, const Epi& E, const int tid) {
    const int wid = __builtin_amdgcn_readfirstlane(tid >> 6), lane = tid & 63, wr = wid >> 2, wc = wid & 3, fr = lane & 15, fq = lane >> 4;
    const int K = g.K, nt = K / BK;
    unsigned voffA[2], voffB[2];
#pragma unroll
    for (int i = 0; i < 2; ++i) { int R, C; stage_rc(tid * 16 + i * 8192, R, C); const int Rb = Epi::PERM ? ((R & ~31) + perm32(R & 31)) : R;
        voffA[i] = (unsigned)(R * g.lda + C) * 2u; voffB[i] = (unsigned)(Rb * g.ldb + C) * 2u; }
    const size_t kstep = (size_t)(BK * 2);
    const size_t hstepA = (size_t)HALF * g.lda * 2, hstepB = (size_t)HALF * g.ldb * 2;
    const size_t tstepA = 2 * hstepA, tstepB = 2 * hstepB;
    const unsigned ldsw = (unsigned)wid * 1024u;
    const int aoff = lds_byte(wr * 64 + fr, fq * 8), boff = lds_byte(wc * 32 + fr, fq * 8);
#define PG8_SA(b, h) (((b) * 2 + (h)) * HTB)
#define PG8_SB(b, h) ((4 + (b) * 2 + (h)) * HTB)
#define PG8_STAGE(bufoff, gbase, voff) do { _Pragma("unroll") for (int _i = 0; _i < 2; ++_i) \
        __builtin_amdgcn_global_load_lds((const unsigned*)((const char*)(gbase) + (voff)[_i]), (PG8_LAS unsigned*)(lds + (bufoff) + ldsw + _i * 8192), 16, 0, 0); } while (0)
#define PG8_LDA(dst, b, h) do { _Pragma("unroll") for (int m = 0; m < 4; ++m) _Pragma("unroll") for (int k = 0; k < 2; ++k) dst[m][k] = *(const PG8_LAS bf16x8*)(lds + PG8_SA(b, h) + aoff + m * 2048 + k * 1024); } while (0)
#define PG8_LDB(dst, b, h) do { _Pragma("unroll") for (int n = 0; n < 2; ++n) _Pragma("unroll") for (int k = 0; k < 2; ++k) dst[n][k] = *(const PG8_LAS bf16x8*)(lds + PG8_SB(b, h) + boff + n * 2048 + k * 1024); } while (0)
#define PG8_MMA(ai, bj, At, Bt) do { __builtin_amdgcn_s_setprio(1); _Pragma("unroll") for (int m = 0; m < 4; ++m) _Pragma("unroll") for (int n = 0; n < 2; ++n) _Pragma("unroll") for (int k = 0; k < 2; ++k) \
        acc[ai][bj][m][n] = __builtin_amdgcn_mfma_f32_16x16x32_bf16(Bt[n][k], At[m][k], acc[ai][bj][m][n], 0, 0, 0); __builtin_amdgcn_s_setprio(0); } while (0)
#define PG8_WAIT_V(n) asm volatile("s_waitcnt vmcnt(" #n ")" ::: "memory")
#define PG8_WAIT_L(n) asm volatile("s_waitcnt lgkmcnt(" #n ")" ::: "memory")
#define PG8_BAR __builtin_amdgcn_s_barrier()
#define PG8_SCHED __builtin_amdgcn_sched_barrier(0)
    Unit cur, nxt; int ui = 0;
    if (!S.next(0, cur)) return;
    f32x4 acc[2][2][4][2];
#pragma unroll
    for (int a = 0; a < 2; ++a)
#pragma unroll
        for (int b = 0; b < 2; ++b)
#pragma unroll
            for (int m = 0; m < 4; ++m)
#pragma unroll
                for (int n = 0; n < 2; ++n) acc[a][b][m][n] = (f32x4){0.f, 0.f, 0.f, 0.f};
    bf16x8 At[4][2], B0[2][2], B1[2][2];
    const char* cA = (const char*)g.A + (size_t)cur.pm * tstepA; const char* cB = (const char*)g.Bt + (size_t)cur.pn * tstepB;
    S.a_ready(cur);
    if constexpr (SP2) {
        PG8_STAGE(PG8_SB(0, 0), cB, voffB); PG8_STAGE(PG8_SB(0, 1), cB + hstepB, voffB); PG8_STAGE(PG8_SA(0, 0), cA, voffA); PG8_STAGE(PG8_SA(0, 1), cA + hstepA, voffA);
        if (wr == 1) PG8_BAR;
        PG8_WAIT_V(2); PG8_BAR;
        PG8_STAGE(PG8_SB(1, 0), cB + kstep, voffB); PG8_STAGE(PG8_SA(1, 0), cA + kstep, voffA); PG8_STAGE(PG8_SB(1, 1), cB + hstepB + kstep, voffB);
        PG8_WAIT_V(6); PG8_BAR;
    } else {
        PG8_STAGE(PG8_SB(0, 0), cB, voffB); PG8_STAGE(PG8_SA(0, 0), cA, voffA); PG8_STAGE(PG8_SB(0, 1), cB + hstepB, voffB); PG8_STAGE(PG8_SA(0, 1), cA + hstepA, voffA);
        if (wr == 1) PG8_BAR;
        PG8_WAIT_V(4); PG8_BAR;
        PG8_STAGE(PG8_SB(1, 0), cB + kstep, voffB); PG8_STAGE(PG8_SA(1, 0), cA + kstep, voffA); PG8_STAGE(PG8_SB(1, 1), cB + hstepB + kstep, voffB);
        PG8_WAIT_V(6); PG8_BAR;
    }
    for (;;) {
        const bool has_next = S.next(ui + 1, nxt);
        const char* nA = has_next ? (const char*)g.A + (size_t)nxt.pm * tstepA : cA; const char* nB = has_next ? (const char*)g.Bt + (size_t)nxt.pn * tstepB : cB;
        for (int t = 0; t < nt; t += 2) {
            const bool last = (t == nt - 2);
            const char* a1 = cA + (size_t)(t + 1) * kstep;
            const char* a2 = last ? nA : cA + (size_t)(t + 2) * kstep; const char* b2 = last ? nB : cB + (size_t)(t + 2) * kstep;
            const char* a3 = a2 + kstep; const char* b3 = b2 + kstep;
            if (last && has_next) S.a_ready(nxt);
            if constexpr (SP2) {
            PG8_LDB(B0, 0, 0); PG8_LDB(B1, 0, 1); PG8_SCHED; PG8_LDA(At, 0, 0); PG8_STAGE(PG8_SA(1, 1), a1 + hstepA, voffA);
            PG8_WAIT_V(8); PG8_WAIT_L(0); PG8_BAR; PG8_MMA(0, 0, At, B0); PG8_MMA(0, 1, At, B1); PG8_BAR; PG8_SCHED;
            PG8_LDA(At, 0, 1); PG8_STAGE(PG8_SB(0, 0), b2, voffB); PG8_STAGE(PG8_SB(0, 1), b2 + hstepB, voffB); PG8_STAGE(PG8_SA(0, 0), a2, voffA);
            PG8_WAIT_V(8); PG8_WAIT_L(0); PG8_BAR; PG8_MMA(1, 0, At, B0); PG8_MMA(1, 1, At, B1); PG8_BAR; PG8_SCHED;
            PG8_LDB(B0, 1, 0); PG8_LDB(B1, 1, 1); PG8_SCHED; PG8_LDA(At, 1, 0); PG8_STAGE(PG8_SA(0, 1), a2 + hstepA, voffA);
            PG8_WAIT_V(8); PG8_WAIT_L(0); PG8_BAR; PG8_MMA(0, 0, At, B0); PG8_MMA(0, 1, At, B1); PG8_BAR; PG8_SCHED;
            PG8_LDA(At, 1, 1); PG8_STAGE(PG8_SB(1, 0), b3, voffB); PG8_STAGE(PG8_SB(1, 1), b3 + hstepB, voffB); PG8_STAGE(PG8_SA(1, 0), a3, voffA);
            PG8_WAIT_V(8); PG8_WAIT_L(0); PG8_BAR; PG8_MMA(1, 0, At, B0); PG8_MMA(1, 1, At, B1); PG8_BAR; PG8_SCHED;
            } else {
            PG8_LDB(B0, 0, 0); PG8_SCHED; PG8_LDA(At, 0, 0); PG8_STAGE(PG8_SA(1, 1), a1 + hstepA, voffA);
            PG8_WAIT_L(8); PG8_BAR; PG8_WAIT_L(0); PG8_MMA(0, 0, At, B0); PG8_BAR; PG8_SCHED;
            PG8_LDB(B1, 0, 1); PG8_STAGE(PG8_SB(0, 0), b2, voffB);
            PG8_BAR; PG8_WAIT_L(0); PG8_MMA(0, 1, At, B1); PG8_BAR;
            PG8_LDA(At, 0, 1); PG8_STAGE(PG8_SA(0, 0), a2, voffA);
            PG8_BAR; PG8_WAIT_L(0); PG8_MMA(1, 0, At, B0); PG8_BAR; PG8_SCHED;
            PG8_STAGE(PG8_SB(0, 1), b2 + hstepB, voffB);
            PG8_WAIT_V(6); PG8_BAR; PG8_MMA(1, 1, At, B1); PG8_BAR;
            PG8_LDB(B0, 1, 0); PG8_SCHED; PG8_LDA(At, 1, 0); PG8_STAGE(PG8_SA(0, 1), a2 + hstepA, voffA);
            PG8_WAIT_L(8); PG8_BAR; PG8_WAIT_L(0); PG8_MMA(0, 0, At, B0); PG8_BAR; PG8_SCHED;
            PG8_LDB(B1, 1, 1); PG8_STAGE(PG8_SB(1, 0), b3, voffB);
            PG8_BAR; PG8_WAIT_L(0); PG8_MMA(0, 1, At, B1); PG8_BAR;
            PG8_LDA(At, 1, 1); PG8_STAGE(PG8_SA(1, 0), a3, voffA);
            PG8_BAR; PG8_WAIT_L(0); PG8_MMA(1, 0, At, B0); PG8_BAR; PG8_SCHED;
            PG8_STAGE(PG8_SB(1, 1), b3 + hstepB, voffB);
            PG8_WAIT_V(6); PG8_BAR; PG8_MMA(1, 1, At, B1); PG8_BAR;
            }
        }
        if constexpr (ALIGN_EPI) { if (wr == 0) PG8_BAR; }
        if constexpr (!Epi::AFTER_DRAIN) { E(acc, cur, wr, wc, fr, fq); S.done(cur); }
        if (!has_next) break;
#pragma unroll
        for (int a = 0; a < 2; ++a)
#pragma unroll
            for (int b = 0; b < 2; ++b)
#pragma unroll
                for (int m = 0; m < 4; ++m)
#pragma unroll
                    for (int n = 0; n < 2; ++n) acc[a][b][m][n] = (f32x4){0.f, 0.f, 0.f, 0.f};
        cur = nxt; cA = nA; cB = nB; ++ui;
        if constexpr (ALIGN_EPI) { if (wr == 1) PG8_BAR; }
    }
    PG8_WAIT_V(0);
    if constexpr (!ALIGN_EPI) { if (wr == 0) PG8_BAR; }
    PG8_BAR;
    if constexpr (Epi::AFTER_DRAIN) { E.fused(acc, cur, wr, wc, fr, fq, lds, wid, lane); S.done(cur); }
#undef PG8_SA
#undef PG8_SB
#undef PG8_STAGE
#undef PG8_LDA
#undef PG8_LDB
#undef PG8_MMA
#undef PG8_WAIT_V
#undef PG8_WAIT_L
#undef PG8_BAR
#undef PG8_SCHED
}
}

namespace cg = cooperative_groups;
#define LAS __attribute__((address_space(3)))
typedef unsigned short bf16;
typedef unsigned v4u __attribute__((ext_vector_type(4)));
typedef unsigned v2u __attribute__((ext_vector_type(2)));
typedef float f32x4 __attribute__((ext_vector_type(4)));
typedef short bf16x8 __attribute__((ext_vector_type(8)));

constexpr int NWAVES = 8;
constexpr int DM = 1024, FF = 4096, INW = 2048, GW = 256;
constexpr int ZP = INW + 64;
#ifndef HPAD
#define HPAD 0
#endif
#ifndef WPAD
#define WPAD 0
#endif
#ifndef APAD
#define APAD 0
#endif
constexpr int DP = DM + APAD;
#ifndef OPAD
#define OPAD 0
#endif
constexpr int OP = DM + OPAD;
constexpr int FP = FF + HPAD;
constexpr int MP = 16384, MS = 512, MT = MP + MS;
constexpr int SEQ = 2048, NBP = 8, NSB = 128, ST = 4, DEPTH = 2;
constexpr float EPS = 1e-6f;
constexpr size_t MiB = 1u << 20;
constexpr size_t WS_SGUW = 1 * MiB;
constexpr size_t WS_W = 2 * MiB, W_LAYER = 24 * MiB, W_IN = 0, W_OUT = 9 * MiB / 2, W_UP = 7 * MiB, W_DN = 31 * MiB / 2;
constexpr size_t WS_XN = 50 * MiB, WS_O = 84 * MiB, WS_H = 120 * MiB, WS_Z = 120 * MiB, WS_CAT = 189 * MiB, WS_RS = 254 * MiB  , WS_END = 255 * MiB;
static_assert(WS_Z + (size_t)16896 * ZP * 2 <= WS_CAT && WS_XN + (size_t)16896 * DP * 2 <= WS_O && WS_CAT + (size_t)16896 * DP * 2 <= WS_H + (size_t)16896 * FP * 2 && WS_H + (size_t)16896 * FP * 2 <= WS_END, "d_ws map");
constexpr int LDS_BYTES = 147456;
constexpr int MISC_OFF = LDS_BYTES - 256;
constexpr size_t WS_CTL = 0, CTL_ZERO_BYTES = 16 * 1024;
constexpr int WAVE_SCR = 17408;
constexpr size_t OUT_Y = 0;
constexpr size_t OUT_POOL_P = (size_t)MT * DM;
constexpr size_t OUT_POOL_S = OUT_POOL_P + (size_t)DEPTH * NBP * 15 * GW;
constexpr size_t OUT_CONV_P = OUT_POOL_S + (size_t)DEPTH * NSB * 15 * GW;
constexpr size_t OUT_CONV_S = OUT_CONV_P + (size_t)DEPTH * NBP * 30 * GW;
constexpr size_t OUT_SHORT_P = OUT_CONV_S + (size_t)DEPTH * NSB * 30 * GW;
constexpr size_t OUT_SHORT_S = OUT_SHORT_P + (size_t)DEPTH * NBP * 2 * GW;
constexpr size_t OUT_V_S = OUT_SHORT_S + (size_t)DEPTH * NSB * 2 * GW;
constexpr size_t OUT_END = OUT_V_S + (size_t)DEPTH * NSB * ST * GW;

__device__ __forceinline__ float bf2f(bf16 b) { return __uint_as_float(((unsigned)b) << 16); }
__device__ __forceinline__ unsigned f2bf(float f) { unsigned u = __float_as_uint(f); return (u + 0x7fffu + ((u >> 16) & 1u)) >> 16; }
__device__ __forceinline__ unsigned pk2(float lo, float hi) { return f2bf(lo) | (f2bf(hi) << 16); }
template <int CTRL, int ROWMASK> __device__ __forceinline__ float dpp_get(float v) { return __int_as_float(__builtin_amdgcn_update_dpp(0, __float_as_int(v), CTRL, ROWMASK, 0xF, false)); }
__device__ __forceinline__ float sum8(float v) { v += dpp_get<0xB1, 0xF>(v); v += dpp_get<0x4E, 0xF>(v); v += dpp_get<0x141, 0xF>(v); return v; }
__device__ __forceinline__ float wave_sum(float v) {
    v = sum8(v); v += dpp_get<0x140, 0xF>(v); v += dpp_get<0x142, 0xA>(v); v += dpp_get<0x143, 0xC>(v);
    return __int_as_float(__builtin_amdgcn_readlane(__float_as_int(v), 63));
}
__device__ __forceinline__ void unpack8(const v4u w, float (&f)[8]) {
    f[0] = __uint_as_float(w.x << 16); f[1] = __uint_as_float(w.x & 0xffff0000u); f[2] = __uint_as_float(w.y << 16); f[3] = __uint_as_float(w.y & 0xffff0000u);
    f[4] = __uint_as_float(w.z << 16); f[5] = __uint_as_float(w.z & 0xffff0000u); f[6] = __uint_as_float(w.w << 16); f[7] = __uint_as_float(w.w & 0xffff0000u); }
__device__ __forceinline__ v4u pack8(const float (&f)[8]) { v4u w; w.x = pg8::cvt_pk_bf16(f[0], f[1]); w.y = pg8::cvt_pk_bf16(f[2], f[3]); w.z = pg8::cvt_pk_bf16(f[4], f[5]); w.w = pg8::cvt_pk_bf16(f[6], f[7]); return w; }
__device__ __forceinline__ v4u ld16(const bf16* p) { return *(const v4u*)p; }
__device__ __forceinline__ float sigm(float x) { return __builtin_amdgcn_rcpf(1.f + __builtin_amdgcn_exp2f(-1.44269504f * x)); }
#define LDS_WAIT() asm volatile("s_waitcnt lgkmcnt(0)" ::: "memory")

__device__ __forceinline__ void transpose_item(const float* __restrict__ W, int K, int N, bf16* __restrict__ WT, const float* __restrict__ gk, LAS float* scr, int item, int lane) {
    const int nblk = N / 32, kb = item / nblk, nb = item % nblk, k0 = 64 * kb, n0 = 32 * nb;
#pragma unroll 8
    for (int i = 0; i < 32; ++i) { const int kk = 2 * i + (lane >> 5); float v = W[(size_t)(k0 + kk) * N + n0 + (lane & 31)]; if (gk) v *= gk[k0 + kk]; scr[kk * 33 + (lane & 31)] = v; }
    LDS_WAIT();
    const int c = lane & 7;
#pragma unroll
    for (int j = 0; j < 4; ++j) { const int n = (lane >> 3) + 8 * j; const LAS float* s = scr + (8 * c) * 33 + n;
        v4u o; o.x = pk2(s[0 * 33], s[1 * 33]); o.y = pk2(s[2 * 33], s[3 * 33]); o.z = pk2(s[4 * 33], s[5 * 33]); o.w = pk2(s[6 * 33], s[7 * 33]);
        *(v4u*)(WT + (size_t)(n0 + n) * K + k0 + 8 * c) = o; }
    LDS_WAIT();
}
struct TrDesc { const float* W; bf16* WT; const float* gk; int K, N, k0, n0; };
__device__ __forceinline__ void tr_load(float (&v)[32], const TrDesc& d, int lane) {
    const float* p = d.W + (size_t)(d.k0 + (lane >> 5)) * d.N + d.n0 + (lane & 31);
#pragma unroll
    for (int i = 0; i < 32; ++i) v[i] = p[(size_t)(2 * i) * d.N];
}
__device__ __forceinline__ void tr_store(const float (&v)[32], const TrDesc& d, LAS float* scr, int lane) {
#pragma unroll
    for (int i = 0; i < 32; ++i) { const int kk = 2 * i + (lane >> 5); float x = v[i]; if (d.gk) x *= d.gk[d.k0 + kk]; scr[kk * 33 + (lane & 31)] = x; }
    LDS_WAIT();
    const int c = lane & 7;
#pragma unroll
    for (int j = 0; j < 4; ++j) { const int n = (lane >> 3) + 8 * j; const LAS float* s = scr + (8 * c) * 33 + n;
        v4u o; o.x = pg8::cvt_pk_bf16(s[0 * 33], s[1 * 33]); o.y = pg8::cvt_pk_bf16(s[2 * 33], s[3 * 33]); o.z = pg8::cvt_pk_bf16(s[4 * 33], s[5 * 33]); o.w = pg8::cvt_pk_bf16(s[6 * 33], s[7 * 33]);
        *(v4u*)(d.WT + (size_t)(d.n0 + n) * (d.K + WPAD) + d.k0 + 8 * c) = o; }
    LDS_WAIT();
}
__device__ __forceinline__ void fold_item(const float* __restrict__ W, bf16* __restrict__ WT, const float* __restrict__ wp, const float* __restrict__ ps, LAS float* scr, int item4, int lane) {
    const int K = DM, N = DM; const int item = item4 >> 2, q = item4 & 3; const int nblk = N / 32, g = item / nblk, nb = item % nblk, k0 = 64 * g, n0 = 32 * nb;
    LAS float* scr2 = scr + 64 * 33;
#pragma unroll 8
    for (int i = 0; i < 32; ++i) { const int kk = 2 * i + (lane >> 5); scr[kk * 33 + (lane & 31)] = W[(size_t)(k0 + kk) * N + n0 + (lane & 31)] * ps[k0 + kk]; }
    LDS_WAIT();
    const int n = lane & 31;
    LAS float* wpL = scr2 + 16 * 33;
    { const f32x4* src = (const f32x4*)(wp + (size_t)(g * 64 + 16 * q) * 64) + lane;
#pragma unroll
      for (int j = 0; j < 4; ++j) *(LAS f32x4*)(wpL + 4 * lane + 256 * j) = src[64 * j]; }
    LDS_WAIT();
#pragma unroll 2
    for (int i = 0; i < 8; ++i) { const int kl = 2 * i + (lane >> 5); const LAS float* wr = wpL + kl * 64; float a = 0.f;
#pragma unroll 16
        for (int d = 0; d < 64; ++d) a += wr[d] * scr[d * 33 + n];
        scr2[kl * 33 + n] = a; }
    LDS_WAIT();
    { const int ch = lane >> 5; const LAS float* s = scr2 + (8 * ch) * 33 + n;
        v4u o; o.x = pk2(s[0 * 33], s[1 * 33]); o.y = pk2(s[2 * 33], s[3 * 33]); o.z = pk2(s[4 * 33], s[5 * 33]); o.w = pk2(s[6 * 33], s[7 * 33]);
        *(v4u*)(WT + (size_t)(n0 + n) * (K + WPAD) + k0 + 16 * q + 8 * ch) = o; }
    LDS_WAIT();
}
struct XRow { f32x4 v[4]; };
__device__ __forceinline__ void xrow_load(XRow& r, const float* __restrict__ xrow, int lane) {
    const f32x4* xr = (const f32x4*)xrow + lane;
#pragma unroll
    for (int j = 0; j < 4; ++j) r.v[j] = xr[64 * j];
}
__device__ __forceinline__ void xrow_finish(const XRow& r, bf16* __restrict__ orow, float* __restrict__ rsp, int lane) {
    float s = 0.f;
#pragma unroll
    for (int j = 0; j < 4; ++j) s += (r.v[j].x * r.v[j].x + r.v[j].y * r.v[j].y) + (r.v[j].z * r.v[j].z + r.v[j].w * r.v[j].w);
    const float rstd = rsqrtf(wave_sum(s) * (1.f / DM) + EPS);
    if (lane == 0) *rsp = rstd;
    v2u* o8 = (v2u*)orow + lane;
#pragma unroll
    for (int j = 0; j < 4; ++j) { v2u o; o.x = pg8::cvt_pk_bf16(r.v[j].x, r.v[j].y); o.y = pg8::cvt_pk_bf16(r.v[j].z, r.v[j].w); o8[64 * j] = o; }
}
struct EwRow { v2u x[4]; v2u o[4]; };
__device__ __forceinline__ f32x4 unpack4(const v2u w) { return (f32x4){__uint_as_float(w.x << 16), __uint_as_float(w.x & 0xffff0000u), __uint_as_float(w.y << 16), __uint_as_float(w.y & 0xffff0000u)}; }
__device__ __forceinline__ void ew_load(EwRow& r, const bf16* __restrict__ xrow16, const bf16* __restrict__ orow, int lane) {
    const v2u* xr = (const v2u*)xrow16 + lane; const v2u* orr = (const v2u*)orow + lane;
#pragma unroll
    for (int j = 0; j < 4; ++j) { r.x[j] = xr[64 * j]; r.o[j] = orr[64 * j]; }
}
__device__ __forceinline__ void ew_finish(const EwRow& r, const f32x4 (&gg)[4], float* __restrict__ Xrow32, bf16* __restrict__ Xrow16, bool dst16, float* __restrict__ rsp, bool write_xn, int lane) {
    f32x4 o[4], x[4]; float so = 0.f;
#pragma unroll
    for (int j = 0; j < 4; ++j) { o[j] = unpack4(r.o[j]); so += (o[j].x * o[j].x + o[j].y * o[j].y) + (o[j].z * o[j].z + o[j].w * o[j].w); }
    const float rs = rsqrtf(wave_sum(so) * (1.f / DM) + EPS); float s1 = 0.f;
#pragma unroll
    for (int j = 0; j < 4; ++j) { x[j] = unpack4(r.x[j]) + o[j] * rs * gg[j]; s1 += (x[j].x * x[j].x + x[j].y * x[j].y) + (x[j].z * x[j].z + x[j].w * x[j].w); }
    if (dst16) { v2u* Xr = (v2u*)Xrow16 + lane;
#pragma unroll
        for (int j = 0; j < 4; ++j) { v2u w; w.x = pg8::cvt_pk_bf16(x[j].x, x[j].y); w.y = pg8::cvt_pk_bf16(x[j].z, x[j].w); Xr[64 * j] = w; } }
    else { f32x4* Xr = (f32x4*)Xrow32 + lane;
#pragma unroll
        for (int j = 0; j < 4; ++j) Xr[64 * j] = x[j]; }
    if (write_xn) { const float r1 = rsqrtf(wave_sum(s1) * (1.f / DM) + EPS); if (lane == 0) *rsp = r1; }
}

template <bool SAMPLE>
__device__ __forceinline__ void pool_unit(const bf16* __restrict__ Z, bf16* __restrict__ CAT, const float* __restrict__ state, float* __restrict__ newp,
                                          int seq, int t0, int nrows, int g, int lane) {
    const int c = g * 64 + lane, w = 2 << g;
    const size_t rowbase = SAMPLE ? (size_t)MP + (size_t)seq * ST : (size_t)seq * SEQ;
    const bf16* zc = Z + rowbase * ZP + c;
    const float* st = state + (size_t)seq * 15 * GW + c;
#define POOL_A(e) ((e) >= 0 ? bf2f(zc[(size_t)(e) * ZP]) : (SAMPLE ? st[(15 + (e)) * GW] : 0.f))
    float S = 0.f;
    for (int j = 1; j < w; ++j) S += POOL_A(t0 - j);
#pragma unroll 4
    for (int t = t0; t < t0 + nrows; ++t) {
        const float a = POOL_A(t); S += a;
        const float cnt = SAMPLE ? (float)w : (float)(t + 1 < w ? t + 1 : w);
        CAT[(rowbase + t) * DP + c] = (bf16)f2bf(S / cnt - a);
        const int e = t - w + 1; S -= POOL_A(e);
    }
    const int T = SAMPLE ? ST : SEQ;
    if (t0 + nrows == T) {
        for (int j = 0; j < 15; ++j) { const int e = T - 15 + j; newp[((size_t)seq * 15 + j) * GW + c] = POOL_A(e); }
    }
#undef POOL_A
}
template <int W>
__device__ __forceinline__ void pool_sample_unit(const bf16* __restrict__ Z, bf16* __restrict__ CAT, const float* __restrict__ state, float* __restrict__ newp, int seq, int g, int lane) {
    const int c = g * 64 + lane;
    const size_t rowbase = (size_t)MP + (size_t)seq * ST;
    float ext[15 + ST];
#pragma unroll
    for (int j = 0; j < 15; ++j) ext[j] = state[((size_t)seq * 15 + j) * GW + c];
#pragma unroll
    for (int t = 0; t < ST; ++t) ext[15 + t] = bf2f(Z[(rowbase + t) * ZP + c]);
#pragma unroll
    for (int t = 0; t < ST; ++t) { float S = 0.f;
#pragma unroll
        for (int i = 0; i < W; ++i) S += ext[15 + t - i];
        CAT[(rowbase + t) * DP + c] = (bf16)f2bf(S * (1.f / W) - ext[15 + t]); }
#pragma unroll
    for (int j = 0; j < 15; ++j) newp[((size_t)seq * 15 + j) * GW + c] = ext[ST + j];
}
template <bool SAMPLE>
__device__ __forceinline__ void short_unit(const bf16* __restrict__ Z, bf16* __restrict__ CAT, const float* __restrict__ state, float* __restrict__ news,
                                           const float* __restrict__ sw, int seq, int t0, int nrows, int h, int lane) {
    const int c = h * 64 + lane;
    const size_t rowbase = SAMPLE ? (size_t)MP + (size_t)seq * ST : (size_t)seq * SEQ;
    const bf16* zc = Z + rowbase * ZP + c;
    const float* st = state + (size_t)seq * 2 * GW + c;
    const float w0 = sw[c], w1 = sw[GW + c], w2 = sw[2 * GW + c];
#define SH_E(e) ((e) >= 0 ? bf2f(zc[(size_t)(e) * ZP + 1536]) * bf2f(zc[(size_t)(e) * ZP + 1792]) : (SAMPLE ? st[(2 + (e)) * GW] : 0.f))
    float e2 = SH_E(t0 - 2), e1 = SH_E(t0 - 1);
#pragma unroll 4
    for (int t = t0; t < t0 + nrows; ++t) {
        const float e0 = SH_E(t); const float bg = bf2f(zc[(size_t)t * ZP + 1280]);
        CAT[(rowbase + t) * DP + 768 + c] = (bf16)f2bf(bg * (w0 * e2 + w1 * e1 + w2 * e0));
        e2 = e1; e1 = e0;
    }
    const int T = SAMPLE ? ST : SEQ;
    if (t0 + nrows == T) { news[((size_t)seq * 2 + 0) * GW + c] = e2; news[((size_t)seq * 2 + 1) * GW + c] = e1; }
#undef SH_E
}
template <bool SAMPLE>
__device__ __forceinline__ void conv_unit(const bf16* __restrict__ Z, bf16* __restrict__ CAT, const float* __restrict__ state, float* __restrict__ newc,
                                          const float* __restrict__ cw, const float* __restrict__ cb, const float* __restrict__ lg, const float* __restrict__ lb,
                                          int seq, int t0, int nrows, int h, LAS float* gL, int lane) {
    const int c = h * 64 + lane;
    const size_t rowbase = SAMPLE ? (size_t)MP + (size_t)seq * ST : (size_t)seq * SEQ;
    const bf16* zc = Z + rowbase * ZP + c;
    bf16* oc = CAT + rowbase * DP + 256 + c;
    const int T = SAMPLE ? ST : SEQ;
    const bool last = (t0 + nrows == T);
    const int nin = nrows + 30;
#pragma unroll
    for (int r = 0; r < nin; ++r) { const int s = t0 - 30 + r; float gs = 0.f;
        if (s >= 0) { const unsigned off = (unsigned)s * ZP; const float p = bf2f(zc[off + 256]), gt = bf2f(zc[off + 512]); gs = p * sigm(gt); }
        else if (SAMPLE) gs = state[((size_t)seq * 30 + 30 + s) * GW + c];
        if (last && s >= T - 30) newc[((size_t)seq * 30 + (s - (T - 30))) * GW + c] = gs;
        gL[r * 64 + lane] = gs; }
    LDS_WAIT();
    float wk[31];
#pragma unroll
    for (int k = 0; k < 31; ++k) wk[k] = cw[k * GW + c];
    const float bias = cb[c], gg = lg[c], bb = lb[c];
#pragma unroll 1
    for (int tq = 0; tq < nrows; tq += 4) {
        float acc[4] = {bias, bias, bias, bias};
#pragma unroll
        for (int r = 0; r < 34; ++r) { const float gv = gL[(tq + r) * 64 + lane];
#pragma unroll
            for (int q = 0; q < 4; ++q) { const int k = r - q; if (k >= 0 && k <= 30) acc[q] += wk[k] * gv; } }
#pragma unroll
        for (int q = 0; q < 4; ++q) { const float cv = acc[q];
            const float mean = wave_sum(cv) * (1.f / 64.f); const float d = cv - mean;
            const float var = wave_sum(d * d) * (1.f / 64.f);
            const float y = d * rsqrtf(var + EPS) * gg + bb;
            oc[(unsigned)(t0 + tq + q) * DP] = (bf16)f2bf(y * sigm(y)); }
    }
    LDS_WAIT();
}
template <int W>
__device__ __forceinline__ void pool_unit_p(const bf16* __restrict__ Z, bf16* __restrict__ CAT, float* __restrict__ newp, int seq, int t0, int g, int lane) {
    const int rr = lane >> 3, cg = lane & 7, c0 = g * 64 + cg * 8, tb = t0 + rr * 8;
    const size_t rowbase = (size_t)seq * SEQ;
    const bf16* zb = Z + (rowbase + tb) * ZP + c0;
    v4u raw[W + 7];
#pragma unroll
    for (int j = 0; j < W + 7; ++j) { const int dj = j - (W - 1); raw[j] = (tb + dj >= 0) ? ld16(zb + (long)dj * ZP) : (v4u){0u, 0u, 0u, 0u}; }
    float S[8];
#pragma unroll
    for (int i = 0; i < 8; ++i) S[i] = 0.f;
#pragma unroll
    for (int j = 0; j < W - 1; ++j) { float f[8]; unpack8(raw[j], f);
#pragma unroll
        for (int i = 0; i < 8; ++i) S[i] += f[i]; }
    bf16* ob = CAT + (rowbase + tb) * DP + c0;
    const bool lastseg = (t0 + 64 == SEQ);
#pragma unroll
    for (int j = 0; j < 8; ++j) { float a[8], o[8], od[8]; unpack8(raw[j + W - 1], a); unpack8(raw[j], od);
        const int t = tb + j; const float inv = 1.f / (float)(t + 1 < W ? t + 1 : W);
#pragma unroll
        for (int i = 0; i < 8; ++i) { S[i] += a[i]; o[i] = S[i] * inv - a[i]; S[i] -= od[i]; }
        *(v4u*)(ob + j * DP) = pack8(o);
        if (lastseg && t >= SEQ - 15) { float* np = newp + ((size_t)seq * 15 + (t - (SEQ - 15))) * GW + c0; *(f32x4*)np = (f32x4){a[0], a[1], a[2], a[3]}; *(f32x4*)(np + 4) = (f32x4){a[4], a[5], a[6], a[7]}; }
    }
}
__device__ __forceinline__ void short_unit_p(const bf16* __restrict__ Z, bf16* __restrict__ CAT, float* __restrict__ news, const float* __restrict__ sw, int seq, int t0, int h, int lane) {
    const int rr = lane >> 3, cg = lane & 7, c0 = h * 64 + cg * 8, tb = t0 + rr * 8;
    const size_t rowbase = (size_t)seq * SEQ;
    const bf16* zb = Z + (rowbase + tb) * ZP + c0;
    v4u Bv[8], Cv[10], Hv[10];
#pragma unroll
    for (int j = 0; j < 10; ++j) { const int dj = j - 2; const bool ok = (tb + dj >= 0);
        Cv[j] = ok ? ld16(zb + (long)dj * ZP + 1536) : (v4u){0u, 0u, 0u, 0u}; Hv[j] = ok ? ld16(zb + (long)dj * ZP + 1792) : (v4u){0u, 0u, 0u, 0u};
        if (j >= 2) Bv[j - 2] = ld16(zb + (long)dj * ZP + 1280); }
    float w0[8], w1[8], w2[8];
#pragma unroll
    for (int i = 0; i < 8; ++i) { w0[i] = sw[c0 + i]; w1[i] = sw[GW + c0 + i]; w2[i] = sw[2 * GW + c0 + i]; }
    float e2[8], e1[8];
    { float c[8], hh[8]; unpack8(Cv[0], c); unpack8(Hv[0], hh);
#pragma unroll
      for (int i = 0; i < 8; ++i) e2[i] = c[i] * hh[i];
      unpack8(Cv[1], c); unpack8(Hv[1], hh);
#pragma unroll
      for (int i = 0; i < 8; ++i) e1[i] = c[i] * hh[i]; }
    bf16* ob = CAT + (rowbase + tb) * DP + 768 + c0;
#pragma unroll
    for (int j = 0; j < 8; ++j) { float c[8], hh[8], b[8], o[8]; unpack8(Cv[j + 2], c); unpack8(Hv[j + 2], hh); unpack8(Bv[j], b);
#pragma unroll
        for (int i = 0; i < 8; ++i) { const float e0 = c[i] * hh[i]; o[i] = b[i] * (w0[i] * e2[i] + w1[i] * e1[i] + w2[i] * e0); e2[i] = e1[i]; e1[i] = e0; }
        *(v4u*)(ob + j * DP) = pack8(o); }
    if (t0 + 64 == SEQ && rr == 7) { float* np = news + (size_t)seq * 2 * GW + c0;
        *(f32x4*)np = (f32x4){e2[0], e2[1], e2[2], e2[3]}; *(f32x4*)(np + 4) = (f32x4){e2[4], e2[5], e2[6], e2[7]};
        *(f32x4*)(np + GW) = (f32x4){e1[0], e1[1], e1[2], e1[3]}; *(f32x4*)(np + GW + 4) = (f32x4){e1[4], e1[5], e1[6], e1[7]}; }
}
__device__ __forceinline__ void conv_unit_p(const bf16* __restrict__ Z, bf16* __restrict__ CAT, float* __restrict__ newc,
                                            const float* __restrict__ cw, const float* __restrict__ cb, const float* __restrict__ lg, const float* __restrict__ lb,
                                            int seq, int t0, int h, LAS float* gL, int lane) {
    const int rr = lane >> 3, cg = lane & 7, c0 = h * 64 + cg * 8;
    const size_t rowbase = (size_t)seq * SEQ;
    const bool last = (t0 + 32 == SEQ);
    const int c = h * 64 + lane;
    float wk[31];
#pragma unroll
    for (int k = 0; k < 31; ++k) wk[k] = cw[k * GW + c];
    const float bias = cb[c];
    { v4u pv[8], gv[8];
#pragma unroll
      for (int j = 0; j < 8; ++j) { const int r = 8 * j + rr, sx = t0 - 30 + r; const bool ok = (sx >= 0 && r < 62);
          const bf16* zp = Z + (rowbase + (ok ? sx : 0)) * ZP + c0;
          pv[j] = ok ? ld16(zp + 256) : (v4u){0u, 0u, 0u, 0u}; gv[j] = ok ? ld16(zp + 512) : (v4u){0u, 0u, 0u, 0u}; }
#pragma unroll
      for (int j = 0; j < 8; ++j) { const int r = 8 * j + rr, sx = t0 - 30 + r; float p[8], gt[8]; unpack8(pv[j], p); unpack8(gv[j], gt);
#pragma unroll
          for (int i = 0; i < 8; ++i) p[i] = p[i] * sigm(gt[i]);
          if (r < 62) { *(LAS f32x4*)(gL + r * 64 + cg * 8) = (f32x4){p[0], p[1], p[2], p[3]}; *(LAS f32x4*)(gL + r * 64 + cg * 8 + 4) = (f32x4){p[4], p[5], p[6], p[7]}; }
          if (last && sx >= SEQ - 30 && r < 62) { float* np = newc + ((size_t)seq * 30 + (sx - (SEQ - 30))) * GW + c0; *(f32x4*)np = (f32x4){p[0], p[1], p[2], p[3]}; *(f32x4*)(np + 4) = (f32x4){p[4], p[5], p[6], p[7]}; } }
    }
    LDS_WAIT();
#pragma unroll 1
    for (int tq = 0; tq < 32; tq += 4) {
        float acc[4] = {bias, bias, bias, bias};
#pragma unroll
        for (int r = 0; r < 34; ++r) { const float gvv = gL[(tq + r) * 64 + lane];
#pragma unroll
            for (int q = 0; q < 4; ++q) { const int k = r - q; if (k >= 0 && k <= 30) acc[q] += wk[k] * gvv; } }
        LDS_WAIT();
#pragma unroll
        for (int q = 0; q < 4; ++q) gL[(tq + q) * 64 + lane] = acc[q];
    }
    LDS_WAIT();
    float gg[8], bb[8];
#pragma unroll
    for (int i = 0; i < 8; ++i) { gg[i] = lg[c0 + i]; bb[i] = lb[c0 + i]; }
    bf16* ob = CAT + (rowbase + t0) * DP + 256 + c0;
#pragma unroll
    for (int j = 0; j < 4; ++j) { const int r = 8 * j + rr; const f32x4 a = *(const LAS f32x4*)(gL + r * 64 + cg * 8), b = *(const LAS f32x4*)(gL + r * 64 + cg * 8 + 4);
        float x[8] = {a[0], a[1], a[2], a[3], b[0], b[1], b[2], b[3]};
        const float mean = sum8(((x[0] + x[1]) + (x[2] + x[3])) + ((x[4] + x[5]) + (x[6] + x[7]))) * (1.f / 64.f);
        float q = 0.f;
#pragma unroll
        for (int i = 0; i < 8; ++i) { x[i] -= mean; q += x[i] * x[i]; }
        const float rstd = rsqrtf(sum8(q) * (1.f / 64.f) + EPS);
#pragma unroll
        for (int i = 0; i < 8; ++i) { const float yy = x[i] * rstd * gg[i] + bb[i]; x[i] = yy * sigm(yy); }
        *(v4u*)(ob + r * DP) = pack8(x); }
    LDS_WAIT();
}
__device__ __forceinline__ int sgu_swz(int c, int chunk) { return (chunk ^ ((c & 15) ^ (c >> 4))) << 3; }
__device__ __forceinline__ void sgu_unit(const bf16* __restrict__ Z, bf16* __restrict__ CAT, const bf16* __restrict__ Wb, const float* __restrict__ lg, const float* __restrict__ lb,
                                         const float* __restrict__ sb, int chunk, int h, LAS bf16* vT, int lane) {
    const size_t r0 = (size_t)chunk * 128;
    const int fr = lane & 15, fq = lane >> 4;
    bf16x8 wf[8][4];
#pragma unroll
    for (int mt = 0; mt < 8; ++mt)
#pragma unroll
        for (int ks = 0; ks < 4; ++ks) if (ks * 32 <= mt * 16 + 15) wf[mt][ks] = *(const bf16x8*)(Wb + ((size_t)(h * 128 + mt * 16 + fr) * 128 + ks * 32 + fq * 8));
    { const int rr = lane >> 3, cg = lane & 7, c0 = h * 64 + cg * 8;
      float gg[8], bb[8];
#pragma unroll
      for (int i = 0; i < 8; ++i) { gg[i] = lg[c0 + i]; bb[i] = lb[c0 + i]; }
#pragma unroll 1
      for (int jh = 0; jh < 16; jh += 8) {
          v4u raw[8];
#pragma unroll
          for (int j = 0; j < 8; ++j) raw[j] = ld16(Z + (r0 + 8 * (jh + j) + rr) * ZP + 1024 + c0);
#pragma unroll
          for (int j = 0; j < 8; ++j) { float x[8]; unpack8(raw[j], x);
              float sm = ((x[0] + x[1]) + (x[2] + x[3])) + ((x[4] + x[5]) + (x[6] + x[7])); const float mean = sum8(sm) * (1.f / 64.f);
              float q = 0.f;
#pragma unroll
              for (int i = 0; i < 8; ++i) { x[i] -= mean; q += x[i] * x[i]; }
              const float rstd = rsqrtf(sum8(q) * (1.f / 64.f) + EPS);
#pragma unroll
              for (int i = 0; i < 8; ++i) { const int cl = cg * 8 + i; vT[cl * 128 + sgu_swz(cl, jh + j) + rr] = (bf16)f2bf(x[i] * rstd * gg[i] + bb[i]); } }
      }
    }
    LDS_WAIT();
#pragma unroll
    for (int mt = 0; mt < 8; ++mt) {
        f32x4 acc[4];
#pragma unroll
        for (int nt = 0; nt < 4; ++nt) acc[nt] = (f32x4){0.f, 0.f, 0.f, 0.f};
        const int t = mt * 16 + fr;
        v2u uv[4];
#pragma unroll
        for (int nt = 0; nt < 4; ++nt) uv[nt] = *(const v2u*)(Z + (r0 + t) * ZP + 768 + h * 64 + nt * 16 + 4 * fq);
        const float bt = sb[h * 128 + t];
#pragma unroll
        for (int ks = 0; ks < 4; ++ks) if (ks * 32 <= mt * 16 + 15) {
#pragma unroll
            for (int nt = 0; nt < 4; ++nt) { const int cl = nt * 16 + fr; const bf16x8 vf = *(const LAS bf16x8*)(vT + cl * 128 + sgu_swz(cl, ks * 4 + fq));
                acc[nt] = __builtin_amdgcn_mfma_f32_16x16x32_bf16(vf, wf[mt][ks], acc[nt], 0, 0, 0); }
        }
#pragma unroll
        for (int nt = 0; nt < 4; ++nt) { const float u0 = __uint_as_float(uv[nt].x << 16), u1 = __uint_as_float(uv[nt].x & 0xffff0000u), u2 = __uint_as_float(uv[nt].y << 16), u3 = __uint_as_float(uv[nt].y & 0xffff0000u);
            v2u w; w.x = pg8::cvt_pk_bf16(u0 * (acc[nt][0] + bt), u1 * (acc[nt][1] + bt)); w.y = pg8::cvt_pk_bf16(u2 * (acc[nt][2] + bt), u3 * (acc[nt][3] + bt));
            *(v2u*)(CAT + (r0 + t) * DP + 512 + h * 64 + nt * 16 + 4 * fq) = w; }
    }
    LDS_WAIT();
}
__device__ __forceinline__ void sgu_sample_unit(const bf16* __restrict__ Z, bf16* __restrict__ CAT, const float* __restrict__ Wf, const float* __restrict__ lg, const float* __restrict__ lb,
                                                const float* __restrict__ sb, float* __restrict__ vout, int seq, int h, int lane) {
    const int c = h * 64 + lane; const size_t rowbase = (size_t)MP + (size_t)seq * ST;
    const float gg = lg[c], bb = lb[c];
    float vn[ST];
#pragma unroll
    for (int t = 0; t < ST; ++t) { const float v = bf2f(Z[(rowbase + t) * ZP + 1024 + c]); const float mean = wave_sum(v) * (1.f / 64.f); const float d = v - mean; const float var = wave_sum(d * d) * (1.f / 64.f);
        vn[t] = d * rsqrtf(var + EPS) * gg + bb; vout[((size_t)seq * ST + t) * GW + c] = vn[t]; }
#pragma unroll
    for (int t = 0; t < ST; ++t) { float sv = sb[h * 128 + t];
#pragma unroll
        for (int s = 0; s <= t; ++s) sv += Wf[((size_t)h * 128 + t) * 128 + s] * vn[s];
        const float u = bf2f(Z[(rowbase + t) * ZP + 768 + c]);
        CAT[(rowbase + t) * DP + 512 + c] = (bf16)f2bf(u * sv); }
}

#define XB_TMO      128
#define XB_XCNT(j)  (256  + 64 * (j))
#define XB_XSUB(j)  (1280 + 64 * (j))
#define XB_XGEN(j)  (2304 + 64 * (j))
#define XB_TOP      3328
#define XB_TOPGEN   3392
#define XCD_BAR_WORDS 3456
#define XB_SPIN_CAP (1u << 18)

__device__ __forceinline__ unsigned xb_ld(unsigned* p)              { return __hip_atomic_load(p, __ATOMIC_RELAXED, __HIP_MEMORY_SCOPE_AGENT); }
__device__ __forceinline__ unsigned xb_add(unsigned* p, unsigned v) { return __hip_atomic_fetch_add(p, v, __ATOMIC_RELAXED, __HIP_MEMORY_SCOPE_AGENT); }
__device__ __forceinline__ unsigned xb_xcc_id() { return (unsigned)__builtin_amdgcn_s_getreg((3 << 11) | 20) & 0xFu; }
#define XB_SPIN(cond, bar) do { unsigned _sp = 0; while (cond) { __builtin_amdgcn_s_sleep(1); \
    if ((++_sp & 255u) == 0u) { if (xb_ld(&(bar)[XB_TMO])) break; if (_sp > XB_SPIN_CAP) { atomicAdd(&(bar)[XB_TMO], 1u); break; } } } } while (0)

struct XcdBarrier {
    unsigned* bar; unsigned x;
    volatile LAS unsigned* st;
};

__device__ __forceinline__ XcdBarrier xcd_barrier_post(unsigned* bar, volatile LAS unsigned* st) {
    XcdBarrier b; b.bar = bar; b.x = xb_xcc_id(); b.st = st;
    if (threadIdx.x == 0) (void)xb_add(&bar[XB_XCNT(b.x)], 1u);
    return b;
}
__device__ __forceinline__ void xcd_barrier_complete(unsigned* bar, unsigned x, unsigned& nloc, unsigned& nx) {
    const unsigned G = gridDim.x * gridDim.y * gridDim.z;
    unsigned sum, cnt, mine, sp = 0u;
    for (;;) {
        sum = 0u; cnt = 0u; mine = 0u;
#pragma unroll
        for (unsigned j = 0; j < 16; ++j) { const unsigned c = xb_ld(&bar[XB_XCNT(j)]); sum += c; cnt += (c > 0u) ? 1u : 0u; mine = (j == x) ? c : mine; }
        if (sum == G) break;
        __builtin_amdgcn_s_sleep(1);
        if ((++sp & 255u) == 0u) { if (xb_ld(&bar[XB_TMO])) break; if (sp > XB_SPIN_CAP) { atomicAdd(&bar[XB_TMO], 1u); break; } }
    }
    nloc = mine > 0u ? mine : 1u; nx = cnt > 0u ? cnt : 1u;
}

__device__ __forceinline__ void xcd_barrier(const XcdBarrier& b) {
    asm volatile("s_waitcnt vmcnt(0)" ::: "memory");
    __syncthreads();
    if (threadIdx.x == 0) {
        unsigned* bar = b.bar;
        __builtin_amdgcn_s_waitcnt(0);
        unsigned nloc = b.st[0], nx = b.st[1];
        if (nloc == 0u) { xcd_barrier_complete(bar, b.x, nloc, nx); b.st[0] = nloc; b.st[1] = nx; }
        const unsigned old = xb_add(&bar[XB_XSUB(b.x)], 1u);
        const unsigned gen = old / nloc;
        if (old + 1u == (gen + 1u) * nloc) {
            __builtin_amdgcn_fence(__ATOMIC_RELEASE, "agent");
            asm volatile("s_waitcnt vmcnt(0)" ::: "memory");
            const unsigned og = xb_add(&bar[XB_TOP], 1u);
            const unsigned tg = og / nx;
            if (og + 1u == (tg + 1u) * nx) xb_add(&bar[XB_TOPGEN], 1u);
            else XB_SPIN(xb_ld(&bar[XB_TOPGEN]) == tg, bar);
            __builtin_amdgcn_fence(__ATOMIC_ACQUIRE, "agent");
            xb_add(&bar[XB_XGEN(b.x)], 1u);
            asm volatile("s_waitcnt vmcnt(0)" ::: "memory");
        } else {
            XB_SPIN(xb_ld(&bar[XB_XGEN(b.x)]) == gen, bar);
            __builtin_amdgcn_fence(__ATOMIC_ACQUIRE, "agent");
            asm volatile("s_waitcnt vmcnt(0)" ::: "memory");
        }
    }
    __syncthreads();
}

template <int NT, int ACT, int K>
__device__ __forceinline__ void small_gemm_tile(LAS unsigned char* lds, const bf16* __restrict__ A, const bf16* __restrict__ Bt, bf16* __restrict__ O, int ldc, int lda, int ldb, const float* __restrict__ rs, int m0, int n0, int tid) {
    constexpr int NC = 16 * NT, KW = K / 8, NCH = KW / 128;
    const int wave = __builtin_amdgcn_readfirstlane(tid >> 6), lane = tid & 63, fr = lane & 15, fq = lane >> 4;
    const bf16* ap = A + (size_t)(m0 + fr) * lda + wave * KW + fq * 8;
    const bf16* bp = Bt + (size_t)(n0 + fr) * ldb + wave * KW + fq * 8;
    f32x4 acc[4][NT];
#pragma unroll
    for (int m = 0; m < 4; ++m)
#pragma unroll
        for (int n = 0; n < NT; ++n) acc[m][n] = (f32x4){0.f, 0.f, 0.f, 0.f};
    if constexpr (NCH == 1) {
        bf16x8 fa[4][4], fb[4][NT];
#pragma unroll
        for (int s_ = 0; s_ < 4; ++s_) {
#pragma unroll
            for (int m = 0; m < 4; ++m) fa[s_][m] = *(const bf16x8*)(ap + (size_t)m * 16 * lda + s_ * 32);
#pragma unroll
            for (int n = 0; n < NT; ++n) fb[s_][n] = *(const bf16x8*)(bp + (size_t)n * 16 * ldb + s_ * 32); }
        __builtin_amdgcn_sched_barrier(0);
#pragma unroll
        for (int s_ = 0; s_ < 4; ++s_)
#pragma unroll
            for (int m = 0; m < 4; ++m)
#pragma unroll
                for (int n = 0; n < NT; ++n) acc[m][n] = __builtin_amdgcn_mfma_f32_16x16x32_bf16(fa[s_][m], fb[s_][n], acc[m][n], 0, 0, 0);
        __builtin_amdgcn_sched_barrier(0);
    } else {
        constexpr int NC2 = KW / 64;
        bf16x8 fa[3][2][4], fb[3][2][NT];
#define SG_LD(buf, c) do { _Pragma("unroll") for (int s_ = 0; s_ < 2; ++s_) { \
            _Pragma("unroll") for (int m = 0; m < 4; ++m) fa[buf][s_][m] = *(const bf16x8*)(ap + (size_t)m * 16 * lda + (c) * 64 + s_ * 32); \
            _Pragma("unroll") for (int n = 0; n < NT; ++n) fb[buf][s_][n] = *(const bf16x8*)(bp + (size_t)n * 16 * ldb + (c) * 64 + s_ * 32); } } while (0)
        SG_LD(0, 0); SG_LD(1, 1);
        __builtin_amdgcn_sched_barrier(0);
#pragma unroll
        for (int c = 0; c < NC2; ++c) {
            if (c + 2 < NC2) SG_LD((c + 2) % 3, c + 2);
            __builtin_amdgcn_sched_barrier(0);
#pragma unroll
            for (int s_ = 0; s_ < 2; ++s_)
#pragma unroll
                for (int m = 0; m < 4; ++m)
#pragma unroll
                    for (int n = 0; n < NT; ++n) acc[m][n] = __builtin_amdgcn_mfma_f32_16x16x32_bf16(fa[c % 3][s_][m], fb[c % 3][s_][n], acc[m][n], 0, 0, 0);
            __builtin_amdgcn_sched_barrier(0);
        }
#undef SG_LD
    }
    LAS float* P = (LAS float*)lds + wave * (64 * NC);
#pragma unroll
    for (int m = 0; m < 4; ++m)
#pragma unroll
        for (int n = 0; n < NT; ++n)
#pragma unroll
            for (int i = 0; i < 4; ++i) P[(m * 16 + fq * 4 + i) * NC + n * 16 + fr] = acc[m][n][i];
    __syncthreads();
    constexpr int EPT = 64 * NC / 512;
    const int e0 = tid * EPT, row = e0 / NC, col = e0 % NC;
    float r[EPT];
#pragma unroll
    for (int j = 0; j < EPT; ++j) r[j] = 0.f;
#pragma unroll
    for (int w = 0; w < 8; ++w) { const LAS f32x4* q = (const LAS f32x4*)((LAS float*)lds + w * (64 * NC) + e0);
#pragma unroll
        for (int j = 0; j < EPT / 4; ++j) { const f32x4 v = q[j]; r[4 * j] += v[0]; r[4 * j + 1] += v[1]; r[4 * j + 2] += v[2]; r[4 * j + 3] += v[3]; } }
    if (rs) { const float sc = rs[m0 + row];
#pragma unroll
        for (int j = 0; j < EPT; ++j) r[j] *= sc; }
    if (ACT == 1) {
#pragma unroll
        for (int j = 0; j < EPT; ++j) { const float t = fmaxf(r[j], 0.f); r[j] = t * t; } }
    bf16* op = O + (size_t)(m0 + row) * ldc + n0 + col;
    if (EPT == 8) { v4u w; w.x = pk2(r[0], r[1]); w.y = pk2(r[2], r[3]); w.z = pk2(r[4 % EPT], r[5 % EPT]); w.w = pk2(r[6 % EPT], r[7 % EPT]); *(v4u*)op = w; }
    else { v2u w; w.x = pk2(r[0], r[1]); w.y = pk2(r[2], r[3]); *(v2u*)op = w; }
    __syncthreads();
}

#define SMALL_TN(j, ntn) ((((j) >> 8) * 32 + ((j) & 7) * 4 + (((j) >> 3) & 3)))
constexpr int NPH = 15;
#ifndef REP_PRO
#define REP_PRO 1
#endif
#ifndef REP_GEMM
#define REP_GEMM 1
#endif
#ifndef REP_MIX
#define REP_MIX 1
#endif
#ifndef REP_SYNC
#define REP_SYNC 1
#endif
struct Args { const float* in[24]; float* out; unsigned char* ws; int ph_lo, ph_hi; };
__global__ void __launch_bounds__(NWAVES * 64, 2) hybrid_fwd(Args args) {
    extern __shared__ __attribute__((aligned(16))) unsigned char lds_raw[];
    LAS unsigned char* lds = (LAS unsigned char*)lds_raw;
    volatile LAS unsigned* MISC = (volatile LAS unsigned*)(lds + MISC_OFF);
    if (threadIdx.x < 64) MISC[threadIdx.x] = 0u;
    __syncthreads();
    (void)xcd_barrier_post((unsigned*)(args.ws + WS_CTL), MISC + 8);
    for (int ph = args.ph_lo; ph < args.ph_hi;) {
        int tid = threadIdx.x; asm volatile("" : "+v"(tid));
        const int lane = tid & 63, wave = __builtin_amdgcn_readfirstlane(tid >> 6);
        const int G = gridDim.x; const int bx = blockIdx.x;
        unsigned char* ws = args.ws;
        if (ph == 0) {
            const int vcu = (G % 8 == 0) ? (bx % 8) * (G / 8) + bx / 8 : bx; const int gw = vcu * NWAVES + wave, NGW = G * NWAVES;
            LAS float* scr = (LAS float*)(lds + wave * WAVE_SCR);
            bf16* XN = (bf16*)(ws + WS_XN); bf16* SGW = (bf16*)(ws + WS_SGUW);
            constexpr int I_FOLD = 4 * (DM / 32), I_OUT = (DM / 64) * (DM / 32) - I_FOLD, I_IN = (DM / 64) * (INW / 32), I_UP = (DM / 64) * (FF / 32), I_DN = (FF / 64) * (DM / 32);
            constexpr int I_LAYER = I_OUT + I_IN + I_UP + I_DN, I_ALL = DEPTH * I_LAYER;
            const int gwf = (NGW == 2048) ? (wave < 4 ? vcu * 4 + wave : 1024 + vcu * 4 + (wave - 4)) : gw;
            for (int it = gwf; it < DEPTH * I_FOLD * 4; it += NGW) { const int l = it / (I_FOLD * 4), r = it % (I_FOLD * 4);
                fold_item(args.in[10] + (size_t)l * DM * DM, (bf16*)(ws + WS_W + (size_t)l * W_LAYER + W_OUT), args.in[11] + (size_t)l * 4 * 64 * 64, args.in[12] + (size_t)l * GW, scr, r, lane); }
#define TR_DECODE(it_, d_) do { const int l_ = (it_) / I_LAYER; int r_ = (it_) % I_LAYER; unsigned char* wl_ = ws + WS_W + (size_t)l_ * W_LAYER; int nblk_; \
                if (r_ < I_OUT) { r_ += I_FOLD; d_.W = args.in[10] + (size_t)l_ * DM * DM; d_.WT = (bf16*)(wl_ + W_OUT); d_.gk = nullptr; d_.K = DM; d_.N = DM; } \
                else if ((r_ -= I_OUT) < I_IN) { d_.W = args.in[9] + (size_t)l_ * DM * INW; d_.WT = (bf16*)(wl_ + W_IN); d_.gk = args.in[5] + (size_t)l_ * DM; d_.K = DM; d_.N = INW; } \
                else if ((r_ -= I_IN) < I_UP) { d_.W = args.in[22] + (size_t)l_ * DM * FF; d_.WT = (bf16*)(wl_ + W_UP); d_.gk = args.in[7] + (size_t)l_ * DM; d_.K = DM; d_.N = FF; } \
                else { r_ -= I_UP; d_.W = args.in[23] + (size_t)l_ * FF * DM; d_.WT = (bf16*)(wl_ + W_DN); d_.gk = nullptr; d_.K = FF; d_.N = DM; } \
                nblk_ = d_.N / 32; d_.k0 = 64 * (r_ / nblk_); d_.n0 = 32 * (r_ % nblk_); } while (0)
            { const int TSTEP = NGW; int it = NGW - 1 - gwf;
              if (it >= 0 && it < I_ALL) {
                TrDesc d0, d1, d2; TR_DECODE(it, d0);
                float va[32], vb[32], vc[32];
                tr_load(va, d0, lane);
                { const int q = it + TSTEP < I_ALL ? it + TSTEP : it; TR_DECODE(q, d1); }
                tr_load(vb, d1, lane);
#pragma unroll 1
                for (; it < I_ALL; it += TSTEP) {
                    { const int q = it + 2 * TSTEP < I_ALL ? it + 2 * TSTEP : it; TR_DECODE(q, d2); }
                    tr_load(vc, d2, lane);
                    tr_store(va, d0, scr, lane);
#pragma unroll
                    for (int i = 0; i < 32; ++i) { va[i] = vb[i]; vb[i] = vc[i]; }
                    d0 = d1; d1 = d2;
                }
              }
            }
#undef TR_DECODE
#define X_SRC(m) ((m) < MP ? args.in[0] + (size_t)(m) * DM : args.in[1] + (size_t)((m) - MP) * DM)
            if (gw < MT) { XRow x0, x1, x2;
                xrow_load(x0, X_SRC(gw), lane);
                { const int mb = gw + NGW < MT ? gw + NGW : gw; xrow_load(x1, X_SRC(mb), lane); }
#pragma unroll 1
                for (int m = gw; m < MT; m += NGW) {
                    { const int mc = m + 2 * NGW < MT ? m + 2 * NGW : m; xrow_load(x2, X_SRC(mc), lane); }
                    xrow_finish(x0, (bf16*)args.out + (size_t)m * 2 * DM, (float*)(ws + WS_RS) + m, lane);
                    x0 = x1; x1 = x2;
                } }
#undef X_SRC

            for (int e = bx * (NWAVES * 64) + tid; e < DEPTH * 4 * 128 * 128; e += G * NWAVES * 64) { const int t = (e >> 7) & 127, s = e & 127; SGW[e] = (bf16)(s <= t ? f2bf(args.in[19][e]) : 0u); }
        } else {
            const int l = (ph - 1) / 7, k = (ph - 1) - 7 * l;
            unsigned char* wl = ws + WS_W + (size_t)l * W_LAYER;
            if (k == 0 || k == 2 || k == 5) {
                const bf16* A = k == 0 ? (const bf16*)args.out : (const bf16*)(ws + (k == 2 ? WS_CAT : WS_H));
                const bf16* Bt = (const bf16*)(wl + (k == 0 ? W_IN : k == 2 ? W_OUT : W_DN));
                bf16* O = (bf16*)(ws + (k == 0 ? WS_Z : WS_O));
                const int N = k == 0 ? INW : DM, K = k == 5 ? FF : DM;
                pg8::Gemm g{A, Bt, MP, N, K, k == 5 ? FP : k == 0 ? 2 * DM : DP, K + WPAD}; pg8::StaticOrder S; S.init(MP, N, G, bx);
                pg8::EpiBf16<0> E{O, k == 0 ? ZP : OP, k == 0 ? (const float*)(ws + WS_RS) : nullptr};
                pg8::gemm_phase<pg8::EpiBf16<0>, pg8::StaticOrder, true, true>(lds, g, S, E, tid);
                if (k == 0) { for (int j = bx; j < (MS / 64) * (INW / 64); j += G) small_gemm_tile<4, 0, DM>(lds, A, Bt, O, ZP, 2 * DM, DM + WPAD, (const float*)(ws + WS_RS), MP + ((j >> 5) & 7) * 64, SMALL_TN(j, INW / 64) * 64, tid); }
                else { for (int j = bx; j < (MS / 64) * (DM / 32); j += G) { if (k == 2) small_gemm_tile<2, 0, DM>(lds, A, Bt, O, OP, DP, DM + WPAD, nullptr, MP + ((j >> 5) & 7) * 64, SMALL_TN(j, DM / 32) * 32, tid); else small_gemm_tile<2, 0, FF>(lds, A, Bt, O, OP, FP, FF + WPAD, nullptr, MP + ((j >> 5) & 7) * 64, SMALL_TN(j, DM / 32) * 32, tid); } }
            } else if (k == 4) {
                pg8::Gemm g{(const bf16*)args.out, (const bf16*)(wl + W_UP), MP, FF, DM, 2 * DM, DM + WPAD}; pg8::StaticOrder S; S.init(MP, FF, G, bx);
                pg8::EpiBf16<1> E{(bf16*)(ws + WS_H), FP, (const float*)(ws + WS_RS)};
                pg8::gemm_phase<pg8::EpiBf16<1>, pg8::StaticOrder, true, true>(lds, g, S, E, tid);
                for (int j = bx; j < (MS / 64) * (FF / 64); j += G) small_gemm_tile<4, 1, DM>(lds, (const bf16*)args.out, (const bf16*)(wl + W_UP), (bf16*)(ws + WS_H), FP, 2 * DM, DM + WPAD, (const float*)(ws + WS_RS), MP + ((j >> 5) & 7) * 64, SMALL_TN(j, FF / 64) * 64, tid);
            } else if (k == 1) {
                const int vcu = (G % 8 == 0) ? (bx % 8) * (G / 8) + bx / 8 : bx; const int NGW = G * NWAVES;
                const int gw = (NGW == 2048) ? (wave < 2 ? vcu * 2 + wave : 512 + vcu * 6 + (wave - 2)) : vcu * NWAVES + wave;
                LAS float* scr = (LAS float*)(lds + wave * WAVE_SCR);
                const bf16* ZB = (const bf16*)(ws + WS_Z); bf16* CAT = (bf16*)(ws + WS_CAT); const bf16* SGW = (const bf16*)(ws + WS_SGUW) + (size_t)l * 4 * 128 * 128;
                float* out = args.out;
                constexpr int NU_SGU = 512, NU_CONV = 2048, NU_SEG = 1024, NU_SMP = 2048, NU = NU_SGU + NU_CONV + 2 * NU_SEG + NU_SMP;
#pragma unroll 1
                for (int ui = 0; ; ++ui) {
                    int u;
                    if (NGW != 2048) { u = ui * NGW + gw; if (u >= NU) break; }
                    else { if (ui >= 4) break;
                        if (gw < 512) { if (ui == 0) u = gw; else if (ui == 1) u = NU_SGU + 1536 + gw; else break; }
                        else { const int g5 = gw - 512; if (ui == 0) u = NU_SGU + g5; else { const int sidx = (ui - 1) * 1536 + g5; if (sidx >= 2 * NU_SEG + NU_SMP) break; u = NU_SGU + NU_CONV + sidx; } } }
                    int lane = tid & 63; asm volatile("" : "+v"(lane));
                    if (u < NU_SGU) { sgu_unit(ZB, CAT, SGW, args.in[17] + (size_t)l * GW, args.in[18] + (size_t)l * GW, args.in[20] + (size_t)l * 4 * 128, u >> 2, u & 3, (LAS bf16*)scr, lane); continue; }
                    int r = u - NU_SGU;
                    if (r < NU_CONV) { const int seg = r >> 2, h = r & 3, seq = seg >> 6, t0 = (seg & 63) * 32;
                        conv_unit_p(ZB, CAT, out + OUT_CONV_P + (size_t)l * NBP * 30 * GW, args.in[13] + (size_t)l * 31 * GW, args.in[14] + (size_t)l * GW, args.in[15] + (size_t)l * GW, args.in[16] + (size_t)l * GW, seq, t0, h, scr, lane);
                        continue; }
                    r -= NU_CONV;
                    if (r < 2 * NU_SEG) { const int ty = r / NU_SEG, q = r % NU_SEG, seg = q >> 2, h = q & 3, seq = seg >> 5, t0 = (seg & 31) * 64;
                        if (ty == 0) { float* np = out + OUT_POOL_P + (size_t)l * NBP * 15 * GW;
                            if (h == 0) pool_unit_p<2>(ZB, CAT, np, seq, t0, h, lane); else if (h == 1) pool_unit_p<4>(ZB, CAT, np, seq, t0, h, lane);
                            else if (h == 2) pool_unit_p<8>(ZB, CAT, np, seq, t0, h, lane); else pool_unit_p<16>(ZB, CAT, np, seq, t0, h, lane); }
                        else short_unit_p(ZB, CAT, out + OUT_SHORT_P + (size_t)l * NBP * 2 * GW, args.in[21] + (size_t)l * 3 * GW, seq, t0, h, lane);
                        continue; }
                    r -= 2 * NU_SEG;
                    { const int ty = r >> 9, q = r & 511, seq = q >> 2, h = q & 3;
                        if (ty == 0) conv_unit<true>(ZB, CAT, args.in[3] + (size_t)l * NSB * 30 * GW, out + OUT_CONV_S + (size_t)l * NSB * 30 * GW, args.in[13] + (size_t)l * 31 * GW, args.in[14] + (size_t)l * GW, args.in[15] + (size_t)l * GW, args.in[16] + (size_t)l * GW, seq, 0, ST, h, scr, lane);
                        else if (ty == 1) { const float* sp = args.in[2] + (size_t)l * NSB * 15 * GW; float* np = out + OUT_POOL_S + (size_t)l * NSB * 15 * GW;
                            if (h == 0) pool_sample_unit<2>(ZB, CAT, sp, np, seq, h, lane); else if (h == 1) pool_sample_unit<4>(ZB, CAT, sp, np, seq, h, lane); else if (h == 2) pool_sample_unit<8>(ZB, CAT, sp, np, seq, h, lane); else pool_sample_unit<16>(ZB, CAT, sp, np, seq, h, lane); }
                        else if (ty == 2) short_unit<true>(ZB, CAT, args.in[4] + (size_t)l * NSB * 2 * GW, out + OUT_SHORT_S + (size_t)l * NSB * 2 * GW, args.in[21] + (size_t)l * 3 * GW, seq, 0, ST, h, lane);
                        else sgu_sample_unit(ZB, CAT, args.in[19] + (size_t)l * 4 * 128 * 128, args.in[17] + (size_t)l * GW, args.in[18] + (size_t)l * GW, args.in[20] + (size_t)l * 4 * 128, out + OUT_V_S + (size_t)l * NSB * ST * GW, seq, h, lane); }
                }
            } else {
                const int vcu = (G % 8 == 0) ? (bx % 8) * (G / 8) + bx / 8 : bx; const int gw = vcu * NWAVES + wave, NGW = G * NWAVES;
                const float* g = args.in[k == 3 ? 6 : 8] + (size_t)l * DM;
                float* X = args.out; const bf16* OB = (const bf16*)(ws + WS_O); float* RS = (float*)(ws + WS_RS);
                const bool from_input = (l == 0 && k == 3), write_xn = !(l == DEPTH - 1 && k == 6);
                f32x4 gg[4];
#pragma unroll
                for (int j = 0; j < 4; ++j) gg[j] = ((const f32x4*)g + lane)[64 * j];
                const int m_lo = 0;
#define EW_X32(m) ((m) < MP ? args.in[0] + (size_t)(m) * DM : args.in[1] + (size_t)((m) - MP) * DM)
                bf16* X16 = (bf16*)args.out;
                const bool dst16 = write_xn;
                { EwRow r0, r1, r2;
                  const int ma = m_lo + gw;
                  if (ma < MT) {
                    ew_load(r0, X16 + (size_t)ma * 2 * DM, OB + (size_t)ma * OP, lane);
                    { const int mb = ma + NGW < MT ? ma + NGW : ma; ew_load(r1, X16 + (size_t)mb * 2 * DM, OB + (size_t)mb * OP, lane); }
#pragma unroll 1
                    for (int m = ma; m < MT; m += NGW) {
                        { const int mc = m + 2 * NGW < MT ? m + 2 * NGW : m; ew_load(r2, X16 + (size_t)mc * 2 * DM, OB + (size_t)mc * OP, lane); }
                        ew_finish(r0, gg, X + (size_t)m * DM, X16 + (size_t)m * 2 * DM, dst16, RS + m, write_xn, lane);
                        r0 = r1; r1 = r2;
                    }
                  }
                }
#undef EW_X32
            }
        }
        ++ph;
        if (ph < args.ph_hi) {
            if (args.ph_lo < 0) cg::this_grid().sync();
            else { XcdBarrier b; b.bar = (unsigned*)(args.ws + WS_CTL); b.x = xb_xcc_id(); b.st = (volatile LAS unsigned*)(lds + MISC_OFF) + 8; xcd_barrier(b); }
        }
    }
}

#ifndef MK_N_LAUNCHES
#define MK_N_LAUNCHES 1
#endif
extern "C" void kernel_launch(void* const* d_in, const int* in_sizes, int n_in, void* d_out, int out_size, void* d_ws, size_t ws_size, hipStream_t stream) {
    static int grid = 0;
    if (grid == 0) {
        if (n_in != 24 || (size_t)out_size != OUT_END || ws_size < WS_END) { fprintf(stderr, "kernel_launch: unexpected shapes (n_in %d out %d ws %zu)\n", n_in, out_size, ws_size); grid = -1; return; }
        int dev = 0, cus = 0, per_cu = 0;
        if (hipGetDevice(&dev) != hipSuccess || hipDeviceGetAttribute(&cus, hipDeviceAttributeMultiprocessorCount, dev) != hipSuccess) { grid = -1; return; }
        if (hipFuncSetAttribute((const void*)hybrid_fwd, hipFuncAttributeMaxDynamicSharedMemorySize, LDS_BYTES) != hipSuccess) { fprintf(stderr, "kernel_launch: hipFuncSetAttribute failed\n"); grid = -1; return; }
        if (hipOccupancyMaxActiveBlocksPerMultiprocessor(&per_cu, (const void*)hybrid_fwd, NWAVES * 64, LDS_BYTES) != hipSuccess || per_cu < 1) per_cu = 1;
        (void)hipGetLastError();
        grid = cus * per_cu;
    }
    if (grid < 0) return;
    if (hipMemsetAsync((char*)d_ws + WS_CTL, 0, CTL_ZERO_BYTES, stream) != hipSuccess) { fprintf(stderr, "kernel_launch: hipMemsetAsync failed\n"); return; }
    Args a{};
    for (int i = 0; i < 24; ++i) a.in[i] = (const float*)d_in[i];
    a.out = (float*)d_out; a.ws = (unsigned char*)d_ws;
#if MK_N_LAUNCHES == 1
    a.ph_lo = 0; a.ph_hi = NPH;
    void* kargs[] = {&a};
    hipError_t e = hipLaunchCooperativeKernel((const void*)hybrid_fwd, dim3(grid), dim3(NWAVES * 64), kargs, LDS_BYTES, stream);
    if (e != hipSuccess) fprintf(stderr, "cooperative launch failed: %s (grid %d)\n", hipGetErrorString(e), grid);
#else
    for (int p = 0; p < NPH; ++p) { a.ph_lo = p; a.ph_hi = p + 1; hipLaunchKernelGGL(hybrid_fwd, dim3(grid), dim3(NWAVES * 64), LDS_BYTES, stream, a); }
#endif
}
```

```cpp
#include <hip/hip_runtime.h>
#include <hip/hip_cooperative_groups.h>
#include <cstdio>
#include <cstdint>
namespace pg8 {
#define PG8_LAS __attribute__((address_space(3)))
typedef unsigned short bf16_t;
typedef short bf16x8 __attribute__((ext_vector_type(8)));
typedef float f32x4 __attribute__((ext_vector_type(4)));
typedef unsigned u32x4 __attribute__((ext_vector_type(4)));
constexpr int KPAD = 64;
constexpr int BM = 256, BK = 64, HALF = 128, HTB = HALF * BK * 2  , STAGE_BYTES = 8 * HTB, NXCD = 8, WGM = 1;

__host__ __device__ __forceinline__ int lds_byte(int r, int c) { const int st = (r >> 4) * 2 + (c >> 5), rr = r & 15, cc = c & 31, ob = rr * 64 + cc * 2; return st * 1024 + (ob ^ (((ob >> 9) & 1) << 5)); }
__host__ __device__ __forceinline__ void stage_rc(int b, int& R, int& C) { const int st = b / 1024, sb = b % 1024, swz = sb ^ (((sb >> 9) & 1) << 5); R = (st >> 1) * 16 + swz / 64; C = (st & 1) * 32 + (swz % 64) / 2; }
__host__ __device__ __forceinline__ int perm32(int rho) { const int n = rho >> 4, i = rho & 15; return 8 * (i >> 2) + 4 * n + (i & 3); }

struct Unit { int pm, pn; };
struct Gemm { const bf16_t* A; const bf16_t* Bt; int M, N, K, lda, ldb; };

struct StaticOrder {
    int nM, nN, nwg, G, c;
    __host__ __device__ void init(int M, int N, int G_, int c_) { nM = M / BM; nN = N / BM; nwg = nM * nN; G = G_; c = c_; }
    __host__ __device__ bool next(int i, Unit& u) const {
        const long L = (long)i * G + c; if (L >= nwg) return false;
        int wgid = (int)L; { const int q = nwg / NXCD, r = nwg % NXCD, xcd = wgid % NXCD, off = wgid / NXCD; wgid = (xcd < r ? xcd * (q + 1) : r * (q + 1) + (xcd - r) * q) + off; }
        const int nig = WGM * nN, gid = wgid / nig, fm = gid * WGM, gsz = (nM - fm) < WGM ? (nM - fm) : WGM;
        u.pm = fm + ((wgid % nig) % gsz); u.pn = (wgid % nig) / gsz; return true;
    }
    __device__ __forceinline__ void a_ready(const Unit&) const {}
    __device__ __forceinline__ void done(const Unit&) const {}
};

__device__ __forceinline__ unsigned cvt_pk_bf16(float lo, float hi) { unsigned r; asm volatile("v_cvt_pk_bf16_f32 %0, %1, %2" : "=v"(r) : "v"(lo), "v"(hi)); return r; }
__device__ __forceinline__ float relu_sq(float x) { float r; asm volatile("v_max_f32 %0, 0, %1" : "=v"(r) : "v"(x)); return r * r; }
__device__ __forceinline__ void st16_wt(void* p, u32x4 v) { asm volatile("global_store_dwordx4 %0, %1, off sc1" :: "v"(p), "v"(v) : "memory"); }
template <int ACT  > struct EpiBf16 {
    static constexpr bool PERM = true, AFTER_DRAIN = false;
    bf16_t* O; int ldc; const float* rs;
    __device__ __forceinline__ void operator()(const f32x4 (&acc)[2][2][4][2], const Unit& u, int wr, int wc, int fr, int fq) const {
        const int row0 = u.pm * BM + wr * 64 + fr; const int col0 = u.pn * BM + wc * 32 + 8 * fq;
#pragma unroll
        for (int ai = 0; ai < 2; ++ai)
#pragma unroll
            for (int m = 0; m < 4; ++m) { bf16_t* rowp = O + (size_t)(row0 + ai * HALF + m * 16) * ldc + col0; const float sc = rs ? rs[row0 + ai * HALF + m * 16] : 1.f;
#pragma unroll
                for (int bj = 0; bj < 2; ++bj) { f32x4 v0 = acc[ai][bj][m][0] * sc, v1 = acc[ai][bj][m][1] * sc;
                    if (ACT == 1) {
#pragma unroll
                        for (int e = 0; e < 4; ++e) { v0[e] = relu_sq(v0[e]); v1[e] = relu_sq(v1[e]); } }
                    u32x4 w; w.x = cvt_pk_bf16(v0[0], v0[1]); w.y = cvt_pk_bf16(v0[2], v0[3]); w.z = cvt_pk_bf16(v1[0], v1[1]); w.w = cvt_pk_bf16(v1[2], v1[3]);
                    *(u32x4*)(rowp + bj * HALF) = w; } }
    }
};

template <class Epi, class Sched, bool ALIGN_EPI = false, bool SP2 = false>
__device__ __forceinline__ void gemm_phase(PG8_LAS unsigned char* lds, const Gemm g, const Sched& S, const Epi& E, const int tid) {
    const int wid = __builtin_amdgcn_readfirstlane(tid >> 6), lane = tid & 63, wr = wid >> 2, wc = wid & 3, fr = lane & 15, fq = lane >> 4;
    const int K = g.K, nt = K / BK;
    unsigned voffA[2], voffB[2];
#pragma unroll
    for (int i = 0; i < 2; ++i) { int R, C; stage_rc(tid * 16 + i * 8192, R, C); const int Rb = Epi::PERM ? ((R & ~31) + perm32(R & 31)) : R;
        voffA[i] = (unsigned)(R * g.lda + C) * 2u; voffB[i] = (unsigned)(Rb * g.ldb + C) * 2u; }
    const size_t kstep = (size_t)(BK * 2);
    const size_t hstepA = (size_t)HALF * g.lda * 2, hstepB = (size_t)HALF * g.ldb * 2;
    const size_t tstepA = 2 * hstepA, tstepB = 2 * hstepB;
    const unsigned ldsw = (unsigned)wid * 1024u;
    const int aoff = lds_byte(wr * 64 + fr, fq * 8), boff = lds_byte(wc * 32 + fr, fq * 8);
#define PG8_SA(b, h) (((b) * 2 + (h)) * HTB)
#define PG8_SB(b, h) ((4 + (b) * 2 + (h)) * HTB)
#define PG8_STAGE(bufoff, gbase, voff) do { _Pragma("unroll") for (int _i = 0; _i < 2; ++_i) \
        __builtin_amdgcn_global_load_lds((const unsigned*)((const char*)(gbase) + (voff)[_i]), (PG8_LAS unsigned*)(lds + (bufoff) + ldsw + _i * 8192), 16, 0, 0); } while (0)
#define PG8_LDA(dst, b, h) do { _Pragma("unroll") for (int m = 0; m < 4; ++m) _Pragma("unroll") for (int k = 0; k < 2; ++k) dst[m][k] = *(const PG8_LAS bf16x8*)(lds + PG8_SA(b, h) + aoff + m * 2048 + k * 1024); } while (0)
#define PG8_LDB(dst, b, h) do { _Pragma("unroll") for (int n = 0; n < 2; ++n) _Pragma("unroll") for (int k = 0; k < 2; ++k) dst[n][k] = *(const PG8_LAS bf16x8*)(lds + PG8_SB(b, h) + boff + n * 2048 + k * 1024); } while (0)
#define PG8_MMA(ai, bj, At, Bt) do { __builtin_amdgcn_s_setprio(1); _Pragma("unroll") for (int m = 0; m < 4; ++m) _Pragma("unroll") for (int n = 0; n < 2; ++n) _Pragma("unroll") for (int k = 0; k < 2; ++k) \
        acc[ai][bj][m][n] = __builtin_amdgcn_mfma_f32_16x16x32_bf16(Bt[n][k], At[m][k], acc[ai][bj][m][n], 0, 0, 0); __builtin_amdgcn_s_setprio(0); } while (0)
#define PG8_WAIT_V(n) asm volatile("s_waitcnt vmcnt(" #n ")" ::: "memory")
#define PG8_WAIT_L(n) asm volatile("s_waitcnt lgkmcnt(" #n ")" ::: "memory")
#define PG8_BAR __builtin_amdgcn_s_barrier()
#define PG8_SCHED __builtin_amdgcn_sched_barrier(0)
    Unit cur, nxt; int ui = 0;
    if (!S.next(0, cur)) return;
    f32x4 acc[2][2][4][2];
#pragma unroll
    for (int a = 0; a < 2; ++a)
#pragma unroll
        for (int b = 0; b < 2; ++b)
#pragma unroll
            for (int m = 0; m < 4; ++m)
#pragma unroll
                for (int n = 0; n < 2; ++n) acc[a][b][m][n] = (f32x4){0.f, 0.f, 0.f, 0.f};
    bf16x8 At[4][2], B0[2][2], B1[2][2];
    const char* cA = (const char*)g.A + (size_t)cur.pm * tstepA; const char* cB = (const char*)g.Bt + (size_t)cur.pn * tstepB;
    S.a_ready(cur);
    if constexpr (SP2) {
        PG8_STAGE(PG8_SB(0, 0), cB, voffB); PG8_STAGE(PG8_SB(0, 1), cB + hstepB, voffB); PG8_STAGE(PG8_SA(0, 0), cA, voffA); PG8_STAGE(PG8_SA(0, 1), cA + hstepA, voffA);
        if (wr == 1) PG8_BAR;
        PG8_WAIT_V(2); PG8_BAR;
        PG8_STAGE(PG8_SB(1, 0), cB + kstep, voffB); PG8_STAGE(PG8_SA(1, 0), cA + kstep, voffA); PG8_STAGE(PG8_SB(1, 1), cB + hstepB + kstep, voffB);
        PG8_WAIT_V(6); PG8_BAR;
    } else {
        PG8_STAGE(PG8_SB(0, 0), cB, voffB); PG8_STAGE(PG8_SA(0, 0), cA, voffA); PG8_STAGE(PG8_SB(0, 1), cB + hstepB, voffB); PG8_STAGE(PG8_SA(0, 1), cA + hstepA, voffA);
        if (wr == 1) PG8_BAR;
        PG8_WAIT_V(4); PG8_BAR;
        PG8_STAGE(PG8_SB(1, 0), cB + kstep, voffB); PG8_STAGE(PG8_SA(1, 0), cA + kstep, voffA); PG8_STAGE(PG8_SB(1, 1), cB + hstepB + kstep, voffB);
        PG8_WAIT_V(6); PG8_BAR;
    }
    for (;;) {
        const bool has_next = S.next(ui + 1, nxt);
        const char* nA = has_next ? (const char*)g.A + (size_t)nxt.pm * tstepA : cA; const char* nB = has_next ? (const char*)g.Bt + (size_t)nxt.pn * tstepB : cB;
        for (int t = 0; t < nt; t += 2) {
            const bool last = (t == nt - 2);
            const char* a1 = cA + (size_t)(t + 1) * kstep;
            const char* a2 = last ? nA : cA + (size_t)(t + 2) * kstep; const char* b2 = last ? nB : cB + (size_t)(t + 2) * kstep;
            const char* a3 = a2 + kstep; const char* b3 = b2 + kstep;
            if (last && has_next) S.a_ready(nxt);
            if constexpr (SP2) {
            PG8_LDB(B0, 0, 0); PG8_LDB(B1, 0, 1); PG8_SCHED; PG8_LDA(At, 0, 0); PG8_STAGE(PG8_SA(1, 1), a1 + hstepA, voffA);
            PG8_WAIT_V(8); PG8_WAIT_L(0); PG8_BAR; PG8_MMA(0, 0, At, B0); PG8_MMA(0, 1, At, B1); PG8_BAR; PG8_SCHED;
            PG8_LDA(At, 0, 1); PG8_STAGE(PG8_SB(0, 0), b2, voffB); PG8_STAGE(PG8_SB(0, 1), b2 + hstepB, voffB); PG8_STAGE(PG8_SA(0, 0), a2, voffA);
            PG8_WAIT_V(8); PG8_WAIT_L(0); PG8_BAR; PG8_MMA(1, 0, At, B0); PG8_MMA(1, 1, At, B1); PG8_BAR; PG8_SCHED;
            PG8_LDB(B0, 1, 0); PG8_LDB(B1, 1, 1); PG8_SCHED; PG8_LDA(At, 1, 0); PG8_STAGE(PG8_SA(0, 1), a2 + hstepA, voffA);
            PG8_WAIT_V(8); PG8_WAIT_L(0); PG8_BAR; PG8_MMA(0, 0, At, B0); PG8_MMA(0, 1, At, B1); PG8_BAR; PG8_SCHED;
            PG8_LDA(At, 1, 1); PG8_STAGE(PG8_SB(1, 0), b3, voffB); PG8_STAGE(PG8_SB(1, 1), b3 + hstepB, voffB); PG8_STAGE(PG8_SA(1, 0), a3, voffA);
            PG8_WAIT_V(8); PG8_WAIT_L(0); PG8_BAR; PG8_MMA(1, 0, At, B0); PG8_MMA(1, 1, At, B1); PG8_BAR; PG8_SCHED;
            } else {
            PG8_LDB(B0, 0, 0); PG8_SCHED; PG8_LDA(At, 0, 0); PG8_STAGE(PG8_SA(1, 1), a1 + hstepA, voffA);
            PG8_WAIT_L(8); PG8_BAR; PG8_WAIT_L(0); PG8_MMA(0, 0, At, B0); PG8_BAR; PG8_SCHED;
            PG8_LDB(B1, 0, 1); PG8_STAGE(PG8_SB(0, 0), b2, voffB);
            PG8_BAR; PG8_WAIT_L(0); PG8_MMA(0, 1, At, B1); PG8_BAR;
            PG8_LDA(At, 0, 1); PG8_STAGE(PG8_SA(0, 0), a2, voffA);
            PG8_BAR; PG8_WAIT_L(0); PG8_MMA(1, 0, At, B0); PG8_BAR; PG8_SCHED;
            PG8_STAGE(PG8_SB(0, 1), b2 + hstepB, voffB);
            PG8_WAIT_V(6); PG8_BAR; PG8_MMA(1, 1, At, B1); PG8_BAR;
            PG8_LDB(B0, 1, 0); PG8_SCHED; PG8_LDA(At, 1, 0); PG8_STAGE(PG8_SA(0, 1), a2 + hstepA, voffA);
            PG8_WAIT_L(8); PG8_BAR; PG8_WAIT_L(0); PG8_MMA(0, 0, At, B0); PG8_BAR; PG8_SCHED;
            PG8_LDB(B1, 1, 1); PG8_STAGE(PG8_SB(1, 0), b3, voffB);
            PG8_BAR; PG8_WAIT_L(0); PG8_MMA(0, 1, At, B1); PG8_BAR;
            PG8_LDA(At, 1, 1); PG8_STAGE(PG8_SA(1, 0), a3, voffA);
            PG8_BAR; PG8_WAIT_L(0); PG8_MMA(1, 0, At, B0); PG8_BAR; PG8_SCHED;
            PG8_STAGE(PG8_SB(1, 1), b3 + hstepB, voffB);
            PG8_WAIT_V(6); PG8_BAR; PG8_MMA(1, 1, At, B1); PG8_BAR;
            }
        }
        if constexpr (ALIGN_EPI) { if (wr == 0) PG8_BAR; }
        if constexpr (!Epi::AFTER_DRAIN) { E(acc, cur, wr, wc, fr, fq); S.done(cur); }
        if (!has_next) break;
#pragma unroll
        for (int a = 0; a < 2; ++a)
#pragma unroll
            for (int b = 0; b < 2; ++b)
#pragma unroll
                for (int m = 0; m < 4; ++m)
#pragma unroll
                    for (int n = 0; n < 2; ++n) acc[a][b][m][n] = (f32x4){0.f, 0.f, 0.f, 0.f};
        cur = nxt; cA = nA; cB = nB; ++ui;
        if constexpr (ALIGN_EPI) { if (wr == 1) PG8_BAR; }
    }
    PG8_WAIT_V(0);
    if constexpr (!ALIGN_EPI) { if (wr == 0) PG8_BAR; }
    PG8_BAR;
    if constexpr (Epi::AFTER_DRAIN) { E.fused(acc, cur, wr, wc, fr, fq, lds, wid, lane); S.done(cur); }
#undef PG8_SA
#undef PG8_SB
#undef PG8_STAGE
#undef PG8_LDA
#undef PG8_LDB
#undef PG8_MMA
#undef PG8_WAIT_V
#undef PG8_WAIT_L
#undef PG8_BAR
#undef PG8_SCHED
}
}

namespace cg = cooperative_groups;
#define LAS __attribute__((address_space(3)))
typedef unsigned short bf16;
typedef unsigned v4u __attribute__((ext_vector_type(4)));
typedef unsigned v2u __attribute__((ext_vector_type(2)));
typedef float f32x4 __attribute__((ext_vector_type(4)));
typedef short bf16x8 __attribute__((ext_vector_type(8)));

constexpr int NWAVES = 8;
constexpr int DM = 1024, FF = 4096, INW = 2048, GW = 256;
constexpr int ZP = INW + 64;
#ifndef HPAD
#define HPAD 0
#endif
#ifndef WPAD
#define WPAD 0
#endif
#ifndef APAD
#define APAD 0
#endif
constexpr int DP = DM + APAD;
#ifndef OPAD
#define OPAD 0
#endif
constexpr int OP = DM + OPAD;
constexpr int FP = FF + HPAD;
constexpr int MP = 16384, MS = 512, MT = MP + MS;
constexpr int SEQ = 2048, NBP = 8, NSB = 128, ST = 4, DEPTH = 2;
constexpr float EPS = 1e-6f;
constexpr size_t MiB = 1u << 20;
constexpr size_t WS_SGUW = 1 * MiB;
constexpr size_t WS_W = 2 * MiB, W_LAYER = 24 * MiB, W_IN = 0, W_OUT = 9 * MiB / 2, W_UP = 7 * MiB, W_DN = 31 * MiB / 2;
constexpr size_t WS_XN = 50 * MiB, WS_O = 84 * MiB, WS_H = 120 * MiB, WS_Z = 120 * MiB, WS_CAT = 189 * MiB, WS_RS = 254 * MiB  , WS_END = 255 * MiB;
static_assert(WS_Z + (size_t)16896 * ZP * 2 <= WS_CAT && WS_XN + (size_t)16896 * DP * 2 <= WS_O && WS_CAT + (size_t)16896 * DP * 2 <= WS_H + (size_t)16896 * FP * 2 && WS_H + (size_t)16896 * FP * 2 <= WS_END, "d_ws map");
constexpr int LDS_BYTES = 147456;
constexpr int MISC_OFF = LDS_BYTES - 256;
constexpr size_t WS_CTL = 0, CTL_ZERO_BYTES = 16 * 1024;
constexpr int WAVE_SCR = 17408;
constexpr size_t OUT_Y = 0;
constexpr size_t OUT_POOL_P = (size_t)MT * DM;
constexpr size_t OUT_POOL_S = OUT_POOL_P + (size_t)DEPTH * NBP * 15 * GW;
constexpr size_t OUT_CONV_P = OUT_POOL_S + (size_t)DEPTH * NSB * 15 * GW;
constexpr size_t OUT_CONV_S = OUT_CONV_P + (size_t)DEPTH * NBP * 30 * GW;
constexpr size_t OUT_SHORT_P = OUT_CONV_S + (size_t)DEPTH * NSB * 30 * GW;
constexpr size_t OUT_SHORT_S = OUT_SHORT_P + (size_t)DEPTH * NBP * 2 * GW;
constexpr size_t OUT_V_S = OUT_SHORT_S + (size_t)DEPTH * NSB * 2 * GW;
constexpr size_t OUT_END = OUT_V_S + (size_t)DEPTH * NSB * ST * GW;

__device__ __forceinline__ float bf2f(bf16 b) { return __uint_as_float(((unsigned)b) << 16); }
__device__ __forceinline__ unsigned f2bf(float f) { unsigned u = __float_as_uint(f); return (u + 0x7fffu + ((u >> 16) & 1u)) >> 16; }
__device__ __forceinline__ unsigned pk2(float lo, float hi) { return f2bf(lo) | (f2bf(hi) << 16); }
template <int CTRL, int ROWMASK> __device__ __forceinline__ float dpp_get(float v) { return __int_as_float(__builtin_amdgcn_update_dpp(0, __float_as_int(v), CTRL, ROWMASK, 0xF, false)); }
__device__ __forceinline__ float sum8(float v) { v += dpp_get<0xB1, 0xF>(v); v += dpp_get<0x4E, 0xF>(v); v += dpp_get<0x141, 0xF>(v); return v; }
__device__ __forceinline__ float wave_sum(float v) {
    v = sum8(v); v += dpp_get<0x140, 0xF>(v); v += dpp_get<0x142, 0xA>(v); v += dpp_get<0x143, 0xC>(v);
    return __int_as_float(__builtin_amdgcn_readlane(__float_as_int(v), 63));
}
__device__ __forceinline__ void unpack8(const v4u w, float (&f)[8]) {
    f[0] = __uint_as_float(w.x << 16); f[1] = __uint_as_float(w.x & 0xffff0000u); f[2] = __uint_as_float(w.y << 16); f[3] = __uint_as_float(w.y & 0xffff0000u);
    f[4] = __uint_as_float(w.z << 16); f[5] = __uint_as_float(w.z & 0xffff0000u); f[6] = __uint_as_float(w.w << 16); f[7] = __uint_as_float(w.w & 0xffff0000u); }
__device__ __forceinline__ v4u pack8(const float (&f)[8]) { v4u w; w.x = pg8::cvt_pk_bf16(f[0], f[1]); w.y = pg8::cvt_pk_bf16(f[2], f[3]); w.z = pg8::cvt_pk_bf16(f[4], f[5]); w.w = pg8::cvt_pk_bf16(f[6], f[7]); return w; }
__device__ __forceinline__ v4u ld16(const bf16* p) { return *(const v4u*)p; }
__device__ __forceinline__ float sigm(float x) { return __builtin_amdgcn_rcpf(1.f + __builtin_amdgcn_exp2f(-1.44269504f * x)); }
#define LDS_WAIT() asm volatile("s_waitcnt lgkmcnt(0)" ::: "memory")

__device__ __forceinline__ void transpose_item(const float* __restrict__ W, int K, int N, bf16* __restrict__ WT, const float* __restrict__ gk, LAS float* scr, int item, int lane) {
    const int nblk = N / 32, kb = item / nblk, nb = item % nblk, k0 = 64 * kb, n0 = 32 * nb;
#pragma unroll 8
    for (int i = 0; i < 32; ++i) { const int kk = 2 * i + (lane >> 5); float v = W[(size_t)(k0 + kk) * N + n0 + (lane & 31)]; if (gk) v *= gk[k0 + kk]; scr[kk * 33 + (lane & 31)] = v; }
    LDS_WAIT();
    const int c = lane & 7;
#pragma unroll
    for (int j = 0; j < 4; ++j) { const int n = (lane >> 3) + 8 * j; const LAS float* s = scr + (8 * c) * 33 + n;
        v4u o; o.x = pk2(s[0 * 33], s[1 * 33]); o.y = pk2(s[2 * 33], s[3 * 33]); o.z = pk2(s[4 * 33], s[5 * 33]); o.w = pk2(s[6 * 33], s[7 * 33]);
        *(v4u*)(WT + (size_t)(n0 + n) * K + k0 + 8 * c) = o; }
    LDS_WAIT();
}
struct TrDesc { const float* W; bf16* WT; const float* gk; int K, N, k0, n0; };
__device__ __forceinline__ void tr_load(float (&v)[32], const TrDesc& d, int lane) {
    const float* p = d.W + (size_t)(d.k0 + (lane >> 5)) * d.N + d.n0 + (lane & 31);
#pragma unroll
    for (int i = 0; i < 32; ++i) v[i] = __builtin_nontemporal_load(p + (size_t)(2 * i) * d.N);
}
__device__ __forceinline__ void tr_store(const float (&v)[32], const TrDesc& d, LAS float* scr, int lane) {
#pragma unroll
    for (int i = 0; i < 32; ++i) { const int kk = 2 * i + (lane >> 5); float x = v[i]; if (d.gk) x *= d.gk[d.k0 + kk]; scr[kk * 33 + (lane & 31)] = x; }
    LDS_WAIT();
    const int c = lane & 7;
#pragma unroll
    for (int j = 0; j < 4; ++j) { const int n = (lane >> 3) + 8 * j; const LAS float* s = scr + (8 * c) * 33 + n;
        v4u o; o.x = pg8::cvt_pk_bf16(s[0 * 33], s[1 * 33]); o.y = pg8::cvt_pk_bf16(s[2 * 33], s[3 * 33]); o.z = pg8::cvt_pk_bf16(s[4 * 33], s[5 * 33]); o.w = pg8::cvt_pk_bf16(s[6 * 33], s[7 * 33]);
        *(v4u*)(d.WT + (size_t)(d.n0 + n) * (d.K + WPAD) + d.k0 + 8 * c) = o; }
    LDS_WAIT();
}
__device__ __forceinline__ void fold_item(const float* __restrict__ W, bf16* __restrict__ WT, const float* __restrict__ wp, const float* __restrict__ ps, LAS float* scr, int item4, int lane) {
    const int K = DM, N = DM; const int item = item4 >> 2, q = item4 & 3; const int nblk = N / 32, g = item / nblk, nb = item % nblk, k0 = 64 * g, n0 = 32 * nb;
    LAS float* scr2 = scr + 64 * 33;
#pragma unroll 8
    for (int i = 0; i < 32; ++i) { const int kk = 2 * i + (lane >> 5); scr[kk * 33 + (lane & 31)] = W[(size_t)(k0 + kk) * N + n0 + (lane & 31)] * ps[k0 + kk]; }
    LDS_WAIT();
    const int n = lane & 31;
    LAS float* wpL = scr2 + 16 * 33;
    { const f32x4* src = (const f32x4*)(wp + (size_t)(g * 64 + 16 * q) * 64) + lane;
#pragma unroll
      for (int j = 0; j < 4; ++j) *(LAS f32x4*)(wpL + 4 * lane + 256 * j) = src[64 * j]; }
    LDS_WAIT();
#pragma unroll 2
    for (int i = 0; i < 8; ++i) { const int kl = 2 * i + (lane >> 5); const LAS float* wr = wpL + kl * 64; float a = 0.f;
#pragma unroll 16
        for (int d = 0; d < 64; ++d) a += wr[d] * scr[d * 33 + n];
        scr2[kl * 33 + n] = a; }
    LDS_WAIT();
    { const int ch = lane >> 5; const LAS float* s = scr2 + (8 * ch) * 33 + n;
        v4u o; o.x = pk2(s[0 * 33], s[1 * 33]); o.y = pk2(s[2 * 33], s[3 * 33]); o.z = pk2(s[4 * 33], s[5 * 33]); o.w = pk2(s[6 * 33], s[7 * 33]);
        *(v4u*)(WT + (size_t)(n0 + n) * (K + WPAD) + k0 + 16 * q + 8 * ch) = o; }
    LDS_WAIT();
}
struct XRow { f32x4 v[4]; };
__device__ __forceinline__ void xrow_load(XRow& r, const float* __restrict__ xrow, int lane) {
    const f32x4* xr = (const f32x4*)xrow + lane;
#pragma unroll
    for (int j = 0; j < 4; ++j) r.v[j] = __builtin_nontemporal_load(xr + 64 * j);
}
__device__ __forceinline__ void xrow_finish(const XRow& r, bf16* __restrict__ orow, float* __restrict__ rsp, int lane) {
    float s = 0.f;
#pragma unroll
    for (int j = 0; j < 4; ++j) s += (r.v[j].x * r.v[j].x + r.v[j].y * r.v[j].y) + (r.v[j].z * r.v[j].z + r.v[j].w * r.v[j].w);
    const float rstd = rsqrtf(wave_sum(s) * (1.f / DM) + EPS);
    if (lane == 0) *rsp = rstd;
    v2u* o8 = (v2u*)orow + lane;
#pragma unroll
    for (int j = 0; j < 4; ++j) { v2u o; o.x = pg8::cvt_pk_bf16(r.v[j].x, r.v[j].y); o.y = pg8::cvt_pk_bf16(r.v[j].z, r.v[j].w); o8[64 * j] = o; }
}
struct EwRow { v2u x[4]; v2u o[4]; };
__device__ __forceinline__ f32x4 unpack4(const v2u w) { return (f32x4){__uint_as_float(w.x << 16), __uint_as_float(w.x & 0xffff0000u), __uint_as_float(w.y << 16), __uint_as_float(w.y & 0xffff0000u)}; }
__device__ __forceinline__ void ew_load(EwRow& r, const bf16* __restrict__ xrow16, const bf16* __restrict__ orow, int lane) {
    const v2u* xr = (const v2u*)xrow16 + lane; const v2u* orr = (const v2u*)orow + lane;
#pragma unroll
    for (int j = 0; j < 4; ++j) { r.x[j] = xr[64 * j]; r.o[j] = orr[64 * j]; }
}
__device__ __forceinline__ void ew_finish(const EwRow& r, const f32x4 (&gg)[4], float* __restrict__ Xrow32, bf16* __restrict__ Xrow16, bool dst16, float* __restrict__ rsp, bool write_xn, int lane) {
    f32x4 o[4], x[4]; float so = 0.f;
#pragma unroll
    for (int j = 0; j < 4; ++j) { o[j] = unpack4(r.o[j]); so += (o[j].x * o[j].x + o[j].y * o[j].y) + (o[j].z * o[j].z + o[j].w * o[j].w); }
    const float rs = rsqrtf(wave_sum(so) * (1.f / DM) + EPS); float s1 = 0.f;
#pragma unroll
    for (int j = 0; j < 4; ++j) { x[j] = unpack4(r.x[j]) + o[j] * rs * gg[j]; s1 += (x[j].x * x[j].x + x[j].y * x[j].y) + (x[j].z * x[j].z + x[j].w * x[j].w); }
    if (dst16) { v2u* Xr = (v2u*)Xrow16 + lane;
#pragma unroll
        for (int j = 0; j < 4; ++j) { v2u w; w.x = pg8::cvt_pk_bf16(x[j].x, x[j].y); w.y = pg8::cvt_pk_bf16(x[j].z, x[j].w); Xr[64 * j] = w; } }
    else { f32x4* Xr = (f32x4*)Xrow32 + lane;
#pragma unroll
        for (int j = 0; j < 4; ++j) Xr[64 * j] = x[j]; }
    if (write_xn) { const float r1 = rsqrtf(wave_sum(s1) * (1.f / DM) + EPS); if (lane == 0) *rsp = r1; }
}

template <bool SAMPLE>
__device__ __forceinline__ void pool_unit(const bf16* __restrict__ Z, bf16* __restrict__ CAT, const float* __restrict__ state, float* __restrict__ newp,
                                          int seq, int t0, int nrows, int g, int lane) {
    const int c = g * 64 + lane, w = 2 << g;
    const size_t rowbase = SAMPLE ? (size_t)MP + (size_t)seq * ST : (size_t)seq * SEQ;
    const bf16* zc = Z + rowbase * ZP + c;
    const float* st = state + (size_t)seq * 15 * GW + c;
#define POOL_A(e) ((e) >= 0 ? bf2f(zc[(size_t)(e) * ZP]) : (SAMPLE ? st[(15 + (e)) * GW] : 0.f))
    float S = 0.f;
    for (int j = 1; j < w; ++j) S += POOL_A(t0 - j);
#pragma unroll 4
    for (int t = t0; t < t0 + nrows; ++t) {
        const float a = POOL_A(t); S += a;
        const float cnt = SAMPLE ? (float)w : (float)(t + 1 < w ? t + 1 : w);
        CAT[(rowbase + t) * DP + c] = (bf16)f2bf(S / cnt - a);
        const int e = t - w + 1; S -= POOL_A(e);
    }
    const int T = SAMPLE ? ST : SEQ;
    if (t0 + nrows == T) {
        for (int j = 0; j < 15; ++j) { const int e = T - 15 + j; newp[((size_t)seq * 15 + j) * GW + c] = POOL_A(e); }
    }
#undef POOL_A
}
template <int W>
__device__ __forceinline__ void pool_sample_unit(const bf16* __restrict__ Z, bf16* __restrict__ CAT, const float* __restrict__ state, float* __restrict__ newp, int seq, int g, int lane) {
    const int c = g * 64 + lane;
    const size_t rowbase = (size_t)MP + (size_t)seq * ST;
    float ext[15 + ST];
#pragma unroll
    for (int j = 0; j < 15; ++j) ext[j] = state[((size_t)seq * 15 + j) * GW + c];
#pragma unroll
    for (int t = 0; t < ST; ++t) ext[15 + t] = bf2f(Z[(rowbase + t) * ZP + c]);
#pragma unroll
    for (int t = 0; t < ST; ++t) { float S = 0.f;
#pragma unroll
        for (int i = 0; i < W; ++i) S += ext[15 + t - i];
        CAT[(rowbase + t) * DP + c] = (bf16)f2bf(S * (1.f / W) - ext[15 + t]); }
#pragma unroll
    for (int j = 0; j < 15; ++j) newp[((size_t)seq * 15 + j) * GW + c] = ext[ST + j];
}
template <bool SAMPLE>
__device__ __forceinline__ void short_unit(const bf16* __restrict__ Z, bf16* __restrict__ CAT, const float* __restrict__ state, float* __restrict__ news,
                                           const float* __restrict__ sw, int seq, int t0, int nrows, int h, int lane) {
    const int c = h * 64 + lane;
    const size_t rowbase = SAMPLE ? (size_t)MP + (size_t)seq * ST : (size_t)seq * SEQ;
    const bf16* zc = Z + rowbase * ZP + c;
    const float* st = state + (size_t)seq * 2 * GW + c;
    const float w0 = sw[c], w1 = sw[GW + c], w2 = sw[2 * GW + c];
#define SH_E(e) ((e) >= 0 ? bf2f(zc[(size_t)(e) * ZP + 1536]) * bf2f(zc[(size_t)(e) * ZP + 1792]) : (SAMPLE ? st[(2 + (e)) * GW] : 0.f))
    float e2 = SH_E(t0 - 2), e1 = SH_E(t0 - 1);
#pragma unroll 4
    for (int t = t0; t < t0 + nrows; ++t) {
        const float e0 = SH_E(t); const float bg = bf2f(zc[(size_t)t * ZP + 1280]);
        CAT[(rowbase + t) * DP + 768 + c] = (bf16)f2bf(bg * (w0 * e2 + w1 * e1 + w2 * e0));
        e2 = e1; e1 = e0;
    }
    const int T = SAMPLE ? ST : SEQ;
    if (t0 + nrows == T) { news[((size_t)seq * 2 + 0) * GW + c] = e2; news[((size_t)seq * 2 + 1) * GW + c] = e1; }
#undef SH_E
}
template <bool SAMPLE>
__device__ __forceinline__ void conv_unit(const bf16* __restrict__ Z, bf16* __restrict__ CAT, const float* __restrict__ state, float* __restrict__ newc,
                                          const float* __restrict__ cw, const float* __restrict__ cb, const float* __restrict__ lg, const float* __restrict__ lb,
                                          int seq, int t0, int nrows, int h, LAS float* gL, int lane) {
    const int c = h * 64 + lane;
    const size_t rowbase = SAMPLE ? (size_t)MP + (size_t)seq * ST : (size_t)seq * SEQ;
    const bf16* zc = Z + rowbase * ZP + c;
    bf16* oc = CAT + rowbase * DP + 256 + c;
    const int T = SAMPLE ? ST : SEQ;
    const bool last = (t0 + nrows == T);
    const int nin = nrows + 30;
#pragma unroll
    for (int r = 0; r < nin; ++r) { const int s = t0 - 30 + r; float gs = 0.f;
        if (s >= 0) { const unsigned off = (unsigned)s * ZP; const float p = bf2f(zc[off + 256]), gt = bf2f(zc[off + 512]); gs = p * sigm(gt); }
        else if (SAMPLE) gs = state[((size_t)seq * 30 + 30 + s) * GW + c];
        if (last && s >= T - 30) newc[((size_t)seq * 30 + (s - (T - 30))) * GW + c] = gs;
        gL[r * 64 + lane] = gs; }
    LDS_WAIT();
    float wk[31];
#pragma unroll
    for (int k = 0; k < 31; ++k) wk[k] = cw[k * GW + c];
    const float bias = cb[c], gg = lg[c], bb = lb[c];
#pragma unroll 1
    for (int tq = 0; tq < nrows; tq += 4) {
        float acc[4] = {bias, bias, bias, bias};
#pragma unroll
        for (int r = 0; r < 34; ++r) { const float gv = gL[(tq + r) * 64 + lane];
#pragma unroll
            for (int q = 0; q < 4; ++q) { const int k = r - q; if (k >= 0 && k <= 30) acc[q] += wk[k] * gv; } }
#pragma unroll
        for (int q = 0; q < 4; ++q) { const float cv = acc[q];
            const float mean = wave_sum(cv) * (1.f / 64.f); const float d = cv - mean;
            const float var = wave_sum(d * d) * (1.f / 64.f);
            const float y = d * rsqrtf(var + EPS) * gg + bb;
            oc[(unsigned)(t0 + tq + q) * DP] = (bf16)f2bf(y * sigm(y)); }
    }
    LDS_WAIT();
}
template <int W>
__device__ __forceinline__ void pool_unit_p(const bf16* __restrict__ Z, bf16* __restrict__ CAT, float* __restrict__ newp, int seq, int t0, int g, int lane) {
    const int rr = lane >> 3, cg = lane & 7, c0 = g * 64 + cg * 8, tb = t0 + rr * 8;
    const size_t rowbase = (size_t)seq * SEQ;
    const bf16* zb = Z + (rowbase + tb) * ZP + c0;
    v4u raw[W + 7];
#pragma unroll
    for (int j = 0; j < W + 7; ++j) { const int dj = j - (W - 1); raw[j] = (tb + dj >= 0) ? ld16(zb + (long)dj * ZP) : (v4u){0u, 0u, 0u, 0u}; }
    float S[8];
#pragma unroll
    for (int i = 0; i < 8; ++i) S[i] = 0.f;
#pragma unroll
    for (int j = 0; j < W - 1; ++j) { float f[8]; unpack8(raw[j], f);
#pragma unroll
        for (int i = 0; i < 8; ++i) S[i] += f[i]; }
    bf16* ob = CAT + (rowbase + tb) * DP + c0;
    const bool lastseg = (t0 + 64 == SEQ);
#pragma unroll
    for (int j = 0; j < 8; ++j) { float a[8], o[8], od[8]; unpack8(raw[j + W - 1], a); unpack8(raw[j], od);
        const int t = tb + j; const float inv = 1.f / (float)(t + 1 < W ? t + 1 : W);
#pragma unroll
        for (int i = 0; i < 8; ++i) { S[i] += a[i]; o[i] = S[i] * inv - a[i]; S[i] -= od[i]; }
        *(v4u*)(ob + j * DP) = pack8(o);
        if (lastseg && t >= SEQ - 15) { float* np = newp + ((size_t)seq * 15 + (t - (SEQ - 15))) * GW + c0; *(f32x4*)np = (f32x4){a[0], a[1], a[2], a[3]}; *(f32x4*)(np + 4) = (f32x4){a[4], a[5], a[6], a[7]}; }
    }
}
__device__ __forceinline__ void short_unit_p(const bf16* __restrict__ Z, bf16* __restrict__ CAT, float* __restrict__ news, const float* __restrict__ sw, int seq, int t0, int h, int lane) {
    const int rr = lane >> 3, cg = lane & 7, c0 = h * 64 + cg * 8, tb = t0 + rr * 8;
    const size_t rowbase = (size_t)seq * SEQ;
    const bf16* zb = Z + (rowbase + tb) * ZP + c0;
    v4u Bv[8], Cv[10], Hv[10];
#pragma unroll
    for (int j = 0; j < 10; ++j) { const int dj = j - 2; const bool ok = (tb + dj >= 0);
        Cv[j] = ok ? ld16(zb + (long)dj * ZP + 1536) : (v4u){0u, 0u, 0u, 0u}; Hv[j] = ok ? ld16(zb + (long)dj * ZP + 1792) : (v4u){0u, 0u, 0u, 0u};
        if (j >= 2) Bv[j - 2] = ld16(zb + (long)dj * ZP + 1280); }
    float w0[8], w1[8], w2[8];
#pragma unroll
    for (int i = 0; i < 8; ++i) { w0[i] = sw[c0 + i]; w1[i] = sw[GW + c0 + i]; w2[i] = sw[2 * GW + c0 + i]; }
    float e2[8], e1[8];
    { float c[8], hh[8]; unpack8(Cv[0], c); unpack8(Hv[0], hh);
#pragma unroll
      for (int i = 0; i < 8; ++i) e2[i] = c[i] * hh[i];
      unpack8(Cv[1], c); unpack8(Hv[1], hh);
#pragma unroll
      for (int i = 0; i < 8; ++i) e1[i] = c[i] * hh[i]; }
    bf16* ob = CAT + (rowbase + tb) * DP + 768 + c0;
#pragma unroll
    for (int j = 0; j < 8; ++j) { float c[8], hh[8], b[8], o[8]; unpack8(Cv[j + 2], c); unpack8(Hv[j + 2], hh); unpack8(Bv[j], b);
#pragma unroll
        for (int i = 0; i < 8; ++i) { const float e0 = c[i] * hh[i]; o[i] = b[i] * (w0[i] * e2[i] + w1[i] * e1[i] + w2[i] * e0); e2[i] = e1[i]; e1[i] = e0; }
        *(v4u*)(ob + j * DP) = pack8(o); }
    if (t0 + 64 == SEQ && rr == 7) { float* np = news + (size_t)seq * 2 * GW + c0;
        *(f32x4*)np = (f32x4){e2[0], e2[1], e2[2], e2[3]}; *(f32x4*)(np + 4) = (f32x4){e2[4], e2[5], e2[6], e2[7]};
        *(f32x4*)(np + GW) = (f32x4){e1[0], e1[1], e1[2], e1[3]}; *(f32x4*)(np + GW + 4) = (f32x4){e1[4], e1[5], e1[6], e1[7]}; }
}
__device__ __forceinline__ void conv_unit_p(const bf16* __restrict__ Z, bf16* __restrict__ CAT, float* __restrict__ newc,
                                            const float* __restrict__ cw, const float* __restrict__ cb, const float* __restrict__ lg, const float* __restrict__ lb,
                                            int seq, int t0, int h, LAS float* gL, int lane) {
    const int rr = lane >> 3, cg = lane & 7, c0 = h * 64 + cg * 8;
    const size_t rowbase = (size_t)seq * SEQ;
    const bool last = (t0 + 32 == SEQ);
    const int c = h * 64 + lane;
    float wk[31];
#pragma unroll
    for (int k = 0; k < 31; ++k) wk[k] = cw[k * GW + c];
    const float bias = cb[c];
    { v4u pv[8], gv[8];
#pragma unroll
      for (int j = 0; j < 8; ++j) { const int r = 8 * j + rr, sx = t0 - 30 + r; const bool ok = (sx >= 0 && r < 62);
          const bf16* zp = Z + (rowbase + (ok ? sx : 0)) * ZP + c0;
          pv[j] = ok ? ld16(zp + 256) : (v4u){0u, 0u, 0u, 0u}; gv[j] = ok ? ld16(zp + 512) : (v4u){0u, 0u, 0u, 0u}; }
#pragma unroll
      for (int j = 0; j < 8; ++j) { const int r = 8 * j + rr, sx = t0 - 30 + r; float p[8], gt[8]; unpack8(pv[j], p); unpack8(gv[j], gt);
#pragma unroll
          for (int i = 0; i < 8; ++i) p[i] = p[i] * sigm(gt[i]);
          if (r < 62) { *(LAS f32x4*)(gL + r * 64 + cg * 8) = (f32x4){p[0], p[1], p[2], p[3]}; *(LAS f32x4*)(gL + r * 64 + cg * 8 + 4) = (f32x4){p[4], p[5], p[6], p[7]}; }
          if (last && sx >= SEQ - 30 && r < 62) { float* np = newc + ((size_t)seq * 30 + (sx - (SEQ - 30))) * GW + c0; *(f32x4*)np = (f32x4){p[0], p[1], p[2], p[3]}; *(f32x4*)(np + 4) = (f32x4){p[4], p[5], p[6], p[7]}; } }
    }
    LDS_WAIT();
#pragma unroll 1
    for (int tq = 0; tq < 32; tq += 4) {
        float acc[4] = {bias, bias, bias, bias};
#pragma unroll
        for (int r = 0; r < 34; ++r) { const float gvv = gL[(tq + r) * 64 + lane];
#pragma unroll
            for (int q = 0; q < 4; ++q) { const int k = r - q; if (k >= 0 && k <= 30) acc[q] += wk[k] * gvv; } }
        LDS_WAIT();
#pragma unroll
        for (int q = 0; q < 4; ++q) gL[(tq + q) * 64 + lane] = acc[q];
    }
    LDS_WAIT();
    float gg[8], bb[8];
#pragma unroll
    for (int i = 0; i < 8; ++i) { gg[i] = lg[c0 + i]; bb[i] = lb[c0 + i]; }
    bf16* ob = CAT + (rowbase + t0) * DP + 256 + c0;
#pragma unroll
    for (int j = 0; j < 4; ++j) { const int r = 8 * j + rr; const f32x4 a = *(const LAS f32x4*)(gL + r * 64 + cg * 8), b = *(const LAS f32x4*)(gL + r * 64 + cg * 8 + 4);
        float x[8] = {a[0], a[1], a[2], a[3], b[0], b[1], b[2], b[3]};
        const float mean = sum8(((x[0] + x[1]) + (x[2] + x[3])) + ((x[4] + x[5]) + (x[6] + x[7]))) * (1.f / 64.f);
        float q = 0.f;
#pragma unroll
        for (int i = 0; i < 8; ++i) { x[i] -= mean; q += x[i] * x[i]; }
        const float rstd = rsqrtf(sum8(q) * (1.f / 64.f) + EPS);
#pragma unroll
        for (int i = 0; i < 8; ++i) { const float yy = x[i] * rstd * gg[i] + bb[i]; x[i] = yy * sigm(yy); }
        *(v4u*)(ob + r * DP) = pack8(x); }
    LDS_WAIT();
}
__device__ __forceinline__ int sgu_swz(int c, int chunk) { return (chunk ^ ((c & 15) ^ (c >> 4))) << 3; }
__device__ __forceinline__ void sgu_unit(const bf16* __restrict__ Z, bf16* __restrict__ CAT, const bf16* __restrict__ Wb, const float* __restrict__ lg, const float* __restrict__ lb,
                                         const float* __restrict__ sb, int chunk, int h, LAS bf16* vT, int lane) {
    const size_t r0 = (size_t)chunk * 128;
    const int fr = lane & 15, fq = lane >> 4;
    bf16x8 wf[8][4];
#pragma unroll
    for (int mt = 0; mt < 8; ++mt)
#pragma unroll
        for (int ks = 0; ks < 4; ++ks) if (ks * 32 <= mt * 16 + 15) wf[mt][ks] = *(const bf16x8*)(Wb + ((size_t)(h * 128 + mt * 16 + fr) * 128 + ks * 32 + fq * 8));
    { const int rr = lane >> 3, cg = lane & 7, c0 = h * 64 + cg * 8;
      float gg[8], bb[8];
#pragma unroll
      for (int i = 0; i < 8; ++i) { gg[i] = lg[c0 + i]; bb[i] = lb[c0 + i]; }
#pragma unroll 1
      for (int jh = 0; jh < 16; jh += 8) {
          v4u raw[8];
#pragma unroll
          for (int j = 0; j < 8; ++j) raw[j] = ld16(Z + (r0 + 8 * (jh + j) + rr) * ZP + 1024 + c0);
#pragma unroll
          for (int j = 0; j < 8; ++j) { float x[8]; unpack8(raw[j], x);
              float sm = ((x[0] + x[1]) + (x[2] + x[3])) + ((x[4] + x[5]) + (x[6] + x[7])); const float mean = sum8(sm) * (1.f / 64.f);
              float q = 0.f;
#pragma unroll
              for (int i = 0; i < 8; ++i) { x[i] -= mean; q += x[i] * x[i]; }
              const float rstd = rsqrtf(sum8(q) * (1.f / 64.f) + EPS);
#pragma unroll
              for (int i = 0; i < 8; ++i) { const int cl = cg * 8 + i; vT[cl * 128 + sgu_swz(cl, jh + j) + rr] = (bf16)f2bf(x[i] * rstd * gg[i] + bb[i]); } }
      }
    }
    LDS_WAIT();
#pragma unroll
    for (int mt = 0; mt < 8; ++mt) {
        f32x4 acc[4];
#pragma unroll
        for (int nt = 0; nt < 4; ++nt) acc[nt] = (f32x4){0.f, 0.f, 0.f, 0.f};
        const int t = mt * 16 + fr;
        v2u uv[4];
#pragma unroll
        for (int nt = 0; nt < 4; ++nt) uv[nt] = *(const v2u*)(Z + (r0 + t) * ZP + 768 + h * 64 + nt * 16 + 4 * fq);
        const float bt = sb[h * 128 + t];
#pragma unroll
        for (int ks = 0; ks < 4; ++ks) if (ks * 32 <= mt * 16 + 15) {
#pragma unroll
            for (int nt = 0; nt < 4; ++nt) { const int cl = nt * 16 + fr; const bf16x8 vf = *(const LAS bf16x8*)(vT + cl * 128 + sgu_swz(cl, ks * 4 + fq));
                acc[nt] = __builtin_amdgcn_mfma_f32_16x16x32_bf16(vf, wf[mt][ks], acc[nt], 0, 0, 0); }
        }
#pragma unroll
        for (int nt = 0; nt < 4; ++nt) { const float u0 = __uint_as_float(uv[nt].x << 16), u1 = __uint_as_float(uv[nt].x & 0xffff0000u), u2 = __uint_as_float(uv[nt].y << 16), u3 = __uint_as_float(uv[nt].y & 0xffff0000u);
            v2u w; w.x = pg8::cvt_pk_bf16(u0 * (acc[nt][0] + bt), u1 * (acc[nt][1] + bt)); w.y = pg8::cvt_pk_bf16(u2 * (acc[nt][2] + bt), u3 * (acc[nt][3] + bt));
            *(v2u*)(CAT + (r0 + t) * DP + 512 + h * 64 + nt * 16 + 4 * fq) = w; }
    }
    LDS_WAIT();
}
__device__ __forceinline__ void sgu_sample_unit(const bf16* __restrict__ Z, bf16* __restrict__ CAT, const float* __restrict__ Wf, const float* __restrict__ lg, const float* __restrict__ lb,
                                                const float* __restrict__ sb, float* __restrict__ vout, int seq, int h, int lane) {
    const int c = h * 64 + lane; const size_t rowbase = (size_t)MP + (size_t)seq * ST;
    const float gg = lg[c], bb = lb[c];
    float vn[ST];
#pragma unroll
    for (int t = 0; t < ST; ++t) { const float v = bf2f(Z[(rowbase + t) * ZP + 1024 + c]); const float mean = wave_sum(v) * (1.f / 64.f); const float d = v - mean; const float var = wave_sum(d * d) * (1.f / 64.f);
        vn[t] = d * rsqrtf(var + EPS) * gg + bb; vout[((size_t)seq * ST + t) * GW + c] = vn[t]; }
#pragma unroll
    for (int t = 0; t < ST; ++t) { float sv = sb[h * 128 + t];
#pragma unroll
        for (int s = 0; s <= t; ++s) sv += Wf[((size_t)h * 128 + t) * 128 + s] * vn[s];
        const float u = bf2f(Z[(rowbase + t) * ZP + 768 + c]);
        CAT[(rowbase + t) * DP + 512 + c] = (bf16)f2bf(u * sv); }
}

#define XB_TMO      128
#define XB_XCNT(j)  (256  + 64 * (j))
#define XB_XSUB(j)  (1280 + 64 * (j))
#define XB_XGEN(j)  (2304 + 64 * (j))
#define XB_TOP      3328
#define XB_TOPGEN   3392
#define XCD_BAR_WORDS 3456
#define XB_SPIN_CAP (1u << 18)

__device__ __forceinline__ unsigned xb_ld(unsigned* p)              { return __hip_atomic_load(p, __ATOMIC_RELAXED, __HIP_MEMORY_SCOPE_AGENT); }
__device__ __forceinline__ unsigned xb_add(unsigned* p, unsigned v) { return __hip_atomic_fetch_add(p, v, __ATOMIC_RELAXED, __HIP_MEMORY_SCOPE_AGENT); }
__device__ __forceinline__ unsigned xb_xcc_id() { return (unsigned)__builtin_amdgcn_s_getreg((3 << 11) | 20) & 0xFu; }
#define XB_SPIN(cond, bar) do { unsigned _sp = 0; while (cond) { __builtin_amdgcn_s_sleep(1); \
    if ((++_sp & 255u) == 0u) { if (xb_ld(&(bar)[XB_TMO])) break; if (_sp > XB_SPIN_CAP) { atomicAdd(&(bar)[XB_TMO], 1u); break; } } } } while (0)

struct XcdBarrier {
    unsigned* bar; unsigned x;
    volatile LAS unsigned* st;
};

__device__ __forceinline__ XcdBarrier xcd_barrier_post(unsigned* bar, volatile LAS unsigned* st) {
    XcdBarrier b; b.bar = bar; b.x = xb_xcc_id(); b.st = st;
    if (threadIdx.x == 0) (void)xb_add(&bar[XB_XCNT(b.x)], 1u);
    return b;
}
__device__ __forceinline__ void xcd_barrier_complete(unsigned* bar, unsigned x, unsigned& nloc, unsigned& nx) {
    const unsigned G = gridDim.x * gridDim.y * gridDim.z;
    unsigned sum, cnt, mine, sp = 0u;
    for (;;) {
        sum = 0u; cnt = 0u; mine = 0u;
#pragma unroll
        for (unsigned j = 0; j < 16; ++j) { const unsigned c = xb_ld(&bar[XB_XCNT(j)]); sum += c; cnt += (c > 0u) ? 1u : 0u; mine = (j == x) ? c : mine; }
        if (sum == G) break;
        __builtin_amdgcn_s_sleep(1);
        if ((++sp & 255u) == 0u) { if (xb_ld(&bar[XB_TMO])) break; if (sp > XB_SPIN_CAP) { atomicAdd(&bar[XB_TMO], 1u); break; } }
    }
    nloc = mine > 0u ? mine : 1u; nx = cnt > 0u ? cnt : 1u;
}

__device__ __forceinline__ void xcd_barrier(const XcdBarrier& b) {
    asm volatile("s_waitcnt vmcnt(0)" ::: "memory");
    __syncthreads();
    if (threadIdx.x == 0) {
        unsigned* bar = b.bar;
        __builtin_amdgcn_s_waitcnt(0);
        unsigned nloc = b.st[0], nx = b.st[1];
        if (nloc == 0u) { xcd_barrier_complete(bar, b.x, nloc, nx); b.st[0] = nloc; b.st[1] = nx; }
        const unsigned old = xb_add(&bar[XB_XSUB(b.x)], 1u);
        const unsigned gen = old / nloc;
        if (old + 1u == (gen + 1u) * nloc) {
            __builtin_amdgcn_fence(__ATOMIC_RELEASE, "agent");
            asm volatile("s_waitcnt vmcnt(0)" ::: "memory");
            const unsigned og = xb_add(&bar[XB_TOP], 1u);
            const unsigned tg = og / nx;
            if (og + 1u == (tg + 1u) * nx) xb_add(&bar[XB_TOPGEN], 1u);
            else XB_SPIN(xb_ld(&bar[XB_TOPGEN]) == tg, bar);
            __builtin_amdgcn_fence(__ATOMIC_ACQUIRE, "agent");
            xb_add(&bar[XB_XGEN(b.x)], 1u);
            asm volatile("s_waitcnt vmcnt(0)" ::: "memory");
        } else {
            XB_SPIN(xb_ld(&bar[XB_XGEN(b.x)]) == gen, bar);
            __builtin_amdgcn_fence(__ATOMIC_ACQUIRE, "agent");
            asm volatile("s_waitcnt vmcnt(0)" ::: "memory");
        }
    }
    __syncthreads();
}

template <int NT, int ACT, int K>
__device__ __forceinline__ void small_gemm_tile(LAS unsigned char* lds, const bf16* __restrict__ A, const bf16* __restrict__ Bt, bf16* __restrict__ O, int ldc, int lda, int ldb, const float* __restrict__ rs, int m0, int n0, int tid) {
    constexpr int NC = 16 * NT, KW = K / 8, NCH = KW / 128;
    const int wave = __builtin_amdgcn_readfirstlane(tid >> 6), lane = tid & 63, fr = lane & 15, fq = lane >> 4;
    const bf16* ap = A + (size_t)(m0 + fr) * lda + wave * KW + fq * 8;
    const bf16* bp = Bt + (size_t)(n0 + fr) * ldb + wave * KW + fq * 8;
    f32x4 acc[4][NT];
#pragma unroll
    for (int m = 0; m < 4; ++m)
#pragma unroll
        for (int n = 0; n < NT; ++n) acc[m][n] = (f32x4){0.f, 0.f, 0.f, 0.f};
    if constexpr (NCH == 1) {
        bf16x8 fa[4][4], fb[4][NT];
#pragma unroll
        for (int s_ = 0; s_ < 4; ++s_) {
#pragma unroll
            for (int m = 0; m < 4; ++m) fa[s_][m] = *(const bf16x8*)(ap + (size_t)m * 16 * lda + s_ * 32);
#pragma unroll
            for (int n = 0; n < NT; ++n) fb[s_][n] = *(const bf16x8*)(bp + (size_t)n * 16 * ldb + s_ * 32); }
        __builtin_amdgcn_sched_barrier(0);
#pragma unroll
        for (int s_ = 0; s_ < 4; ++s_)
#pragma unroll
            for (int m = 0; m < 4; ++m)
#pragma unroll
                for (int n = 0; n < NT; ++n) acc[m][n] = __builtin_amdgcn_mfma_f32_16x16x32_bf16(fa[s_][m], fb[s_][n], acc[m][n], 0, 0, 0);
        __builtin_amdgcn_sched_barrier(0);
    } else {
        constexpr int NC2 = KW / 64;
        bf16x8 fa[3][2][4], fb[3][2][NT];
#define SG_LD(buf, c) do { _Pragma("unroll") for (int s_ = 0; s_ < 2; ++s_) { \
            _Pragma("unroll") for (int m = 0; m < 4; ++m) fa[buf][s_][m] = *(const bf16x8*)(ap + (size_t)m * 16 * lda + (c) * 64 + s_ * 32); \
            _Pragma("unroll") for (int n = 0; n < NT; ++n) fb[buf][s_][n] = *(const bf16x8*)(bp + (size_t)n * 16 * ldb + (c) * 64 + s_ * 32); } } while (0)
        SG_LD(0, 0); SG_LD(1, 1);
        __builtin_amdgcn_sched_barrier(0);
#pragma unroll
        for (int c = 0; c < NC2; ++c) {
            if (c + 2 < NC2) SG_LD((c + 2) % 3, c + 2);
            __builtin_amdgcn_sched_barrier(0);
#pragma unroll
            for (int s_ = 0; s_ < 2; ++s_)
#pragma unroll
                for (int m = 0; m < 4; ++m)
#pragma unroll
                    for (int n = 0; n < NT; ++n) acc[m][n] = __builtin_amdgcn_mfma_f32_16x16x32_bf16(fa[c % 3][s_][m], fb[c % 3][s_][n], acc[m][n], 0, 0, 0);
            __builtin_amdgcn_sched_barrier(0);
        }
#undef SG_LD
    }
    LAS float* P = (LAS float*)lds + wave * (64 * NC);
#pragma unroll
    for (int m = 0; m < 4; ++m)
#pragma unroll
        for (int n = 0; n < NT; ++n)
#pragma unroll
            for (int i = 0; i < 4; ++i) P[(m * 16 + fq * 4 + i) * NC + n * 16 + fr] = acc[m][n][i];
    __syncthreads();
    constexpr int EPT = 64 * NC / 512;
    const int e0 = tid * EPT, row = e0 / NC, col = e0 % NC;
    float r[EPT];
#pragma unroll
    for (int j = 0; j < EPT; ++j) r[j] = 0.f;
#pragma unroll
    for (int w = 0; w < 8; ++w) { const LAS f32x4* q = (const LAS f32x4*)((LAS float*)lds + w * (64 * NC) + e0);
#pragma unroll
        for (int j = 0; j < EPT / 4; ++j) { const f32x4 v = q[j]; r[4 * j] += v[0]; r[4 * j + 1] += v[1]; r[4 * j + 2] += v[2]; r[4 * j + 3] += v[3]; } }
    if (rs) { const float sc = rs[m0 + row];
#pragma unroll
        for (int j = 0; j < EPT; ++j) r[j] *= sc; }
    if (ACT == 1) {
#pragma unroll
        for (int j = 0; j < EPT; ++j) { const float t = fmaxf(r[j], 0.f); r[j] = t * t; } }
    bf16* op = O + (size_t)(m0 + row) * ldc + n0 + col;
    if (EPT == 8) { v4u w; w.x = pk2(r[0], r[1]); w.y = pk2(r[2], r[3]); w.z = pk2(r[4 % EPT], r[5 % EPT]); w.w = pk2(r[6 % EPT], r[7 % EPT]); *(v4u*)op = w; }
    else { v2u w; w.x = pk2(r[0], r[1]); w.y = pk2(r[2], r[3]); *(v2u*)op = w; }
    __syncthreads();
}

#define SMALL_TN(j, ntn) ((((j) >> 8) * 32 + ((j) & 7) * 4 + (((j) >> 3) & 3)))
constexpr int NPH = 15;
#ifndef REP_PRO
#define REP_PRO 1
#endif
#ifndef REP_GEMM
#define REP_GEMM 1
#endif
#ifndef REP_MIX
#define REP_MIX 1
#endif
#ifndef REP_SYNC
#define REP_SYNC 1
#endif
struct Args { const float* in[24]; float* out; unsigned char* ws; int ph_lo, ph_hi; };
__global__ void __launch_bounds__(NWAVES * 64, 2) hybrid_fwd(Args args) {
    extern __shared__ __attribute__((aligned(16))) unsigned char lds_raw[];
    LAS unsigned char* lds = (LAS unsigned char*)lds_raw;
    volatile LAS unsigned* MISC = (volatile LAS unsigned*)(lds + MISC_OFF);
    if (threadIdx.x < 64) MISC[threadIdx.x] = 0u;
    __syncthreads();
    (void)xcd_barrier_post((unsigned*)(args.ws + WS_CTL), MISC + 8);
    for (int ph = args.ph_lo; ph < args.ph_hi;) {
        int tid = threadIdx.x; asm volatile("" : "+v"(tid));
        const int lane = tid & 63, wave = __builtin_amdgcn_readfirstlane(tid >> 6);
        const int G = gridDim.x; const int bx = blockIdx.x;
        unsigned char* ws = args.ws;
        if (ph == 0) {
            const int vcu = (G % 8 == 0) ? (bx % 8) * (G / 8) + bx / 8 : bx; const int gw = vcu * NWAVES + wave, NGW = G * NWAVES;
            LAS float* scr = (LAS float*)(lds + wave * WAVE_SCR);
            bf16* XN = (bf16*)(ws + WS_XN); bf16* SGW = (bf16*)(ws + WS_SGUW);
            constexpr int I_FOLD = 4 * (DM / 32), I_OUT = (DM / 64) * (DM / 32) - I_FOLD, I_IN = (DM / 64) * (INW / 32), I_UP = (DM / 64) * (FF / 32), I_DN = (FF / 64) * (DM / 32);
            constexpr int I_LAYER = I_OUT + I_IN + I_UP + I_DN, I_ALL = DEPTH * I_LAYER;
            const int gwf = (NGW == 2048) ? (wave < 4 ? vcu * 4 + wave : 1024 + vcu * 4 + (wave - 4)) : gw;
            for (int it = gwf; it < DEPTH * I_FOLD * 4; it += NGW) { const int l = it / (I_FOLD * 4), r = it % (I_FOLD * 4);
                fold_item(args.in[10] + (size_t)l * DM * DM, (bf16*)(ws + WS_W + (size_t)l * W_LAYER + W_OUT), args.in[11] + (size_t)l * 4 * 64 * 64, args.in[12] + (size_t)l * GW, scr, r, lane); }
#define TR_DECODE(it_, d_) do { const int l_ = (it_) / I_LAYER; int r_ = (it_) % I_LAYER; unsigned char* wl_ = ws + WS_W + (size_t)l_ * W_LAYER; int nblk_; \
                if (r_ < I_OUT) { r_ += I_FOLD; d_.W = args.in[10] + (size_t)l_ * DM * DM; d_.WT = (bf16*)(wl_ + W_OUT); d_.gk = nullptr; d_.K = DM; d_.N = DM; } \
                else if ((r_ -= I_OUT) < I_IN) { d_.W = args.in[9] + (size_t)l_ * DM * INW; d_.WT = (bf16*)(wl_ + W_IN); d_.gk = args.in[5] + (size_t)l_ * DM; d_.K = DM; d_.N = INW; } \
                else if ((r_ -= I_IN) < I_UP) { d_.W = args.in[22] + (size_t)l_ * DM * FF; d_.WT = (bf16*)(wl_ + W_UP); d_.gk = args.in[7] + (size_t)l_ * DM; d_.K = DM; d_.N = FF; } \
                else { r_ -= I_UP; d_.W = args.in[23] + (size_t)l_ * FF * DM; d_.WT = (bf16*)(wl_ + W_DN); d_.gk = nullptr; d_.K = FF; d_.N = DM; } \
                nblk_ = d_.N / 32; d_.k0 = 64 * (r_ / nblk_); d_.n0 = 32 * (r_ % nblk_); } while (0)
            { const int TSTEP = NGW; int it = NGW - 1 - gwf;
              if (it >= 0 && it < I_ALL) {
                TrDesc d0, d1, d2; TR_DECODE(it, d0);
                float va[32], vb[32], vc[32];
                tr_load(va, d0, lane);
                { const int q = it + TSTEP < I_ALL ? it + TSTEP : it; TR_DECODE(q, d1); }
                tr_load(vb, d1, lane);
#pragma unroll 1
                for (; it < I_ALL; it += TSTEP) {
                    { const int q = it + 2 * TSTEP < I_ALL ? it + 2 * TSTEP : it; TR_DECODE(q, d2); }
                    tr_load(vc, d2, lane);
                    tr_store(va, d0, scr, lane);
#pragma unroll
                    for (int i = 0; i < 32; ++i) { va[i] = vb[i]; vb[i] = vc[i]; }
                    d0 = d1; d1 = d2;
                }
              }
            }
#undef TR_DECODE
#define X_SRC(m) ((m) < MP ? args.in[0] + (size_t)(m) * DM : args.in[1] + (size_t)((m) - MP) * DM)
            if (gw < MT) { XRow x0, x1, x2;
                xrow_load(x0, X_SRC(gw), lane);
                { const int mb = gw + NGW < MT ? gw + NGW : gw; xrow_load(x1, X_SRC(mb), lane); }
#pragma unroll 1
                for (int m = gw; m < MT; m += NGW) {
                    { const int mc = m + 2 * NGW < MT ? m + 2 * NGW : m; xrow_load(x2, X_SRC(mc), lane); }
                    xrow_finish(x0, (bf16*)args.out + (size_t)m * 2 * DM, (float*)(ws + WS_RS) + m, lane);
                    x0 = x1; x1 = x2;
                } }
#undef X_SRC

            for (int e = bx * (NWAVES * 64) + tid; e < DEPTH * 4 * 128 * 128; e += G * NWAVES * 64) { const int t = (e >> 7) & 127, s = e & 127; SGW[e] = (bf16)(s <= t ? f2bf(args.in[19][e]) : 0u); }
        } else {
            const int l = (ph - 1) / 7, k = (ph - 1) - 7 * l;
            unsigned char* wl = ws + WS_W + (size_t)l * W_LAYER;
            if (k == 0 || k == 2 || k == 5) {
                const bf16* A = k == 0 ? (const bf16*)args.out : (const bf16*)(ws + (k == 2 ? WS_CAT : WS_H));
                const bf16* Bt = (const bf16*)(wl + (k == 0 ? W_IN : k == 2 ? W_OUT : W_DN));
                bf16* O = (bf16*)(ws + (k == 0 ? WS_Z : WS_O));
                const int N = k == 0 ? INW : DM, K = k == 5 ? FF : DM;
                pg8::Gemm g{A, Bt, MP, N, K, k == 5 ? FP : k == 0 ? 2 * DM : DP, K + WPAD}; pg8::StaticOrder S; S.init(MP, N, G, bx);
                pg8::EpiBf16<0> E{O, k == 0 ? ZP : OP, k == 0 ? (const float*)(ws + WS_RS) : nullptr};
                pg8::gemm_phase<pg8::EpiBf16<0>, pg8::StaticOrder, true, true>(lds, g, S, E, tid);
                if (k == 0) { for (int j = bx; j < (MS / 64) * (INW / 64); j += G) small_gemm_tile<4, 0, DM>(lds, A, Bt, O, ZP, 2 * DM, DM + WPAD, (const float*)(ws + WS_RS), MP + ((j >> 5) & 7) * 64, SMALL_TN(j, INW / 64) * 64, tid); }
                else { for (int j = bx; j < (MS / 64) * (DM / 32); j += G) { if (k == 2) small_gemm_tile<2, 0, DM>(lds, A, Bt, O, OP, DP, DM + WPAD, nullptr, MP + ((j >> 5) & 7) * 64, SMALL_TN(j, DM / 32) * 32, tid); else small_gemm_tile<2, 0, FF>(lds, A, Bt, O, OP, FP, FF + WPAD, nullptr, MP + ((j >> 5) & 7) * 64, SMALL_TN(j, DM / 32) * 32, tid); } }
            } else if (k == 4) {
                pg8::Gemm g{(const bf16*)args.out, (const bf16*)(wl + W_UP), MP, FF, DM, 2 * DM, DM + WPAD}; pg8::StaticOrder S; S.init(MP, FF, G, bx);
                pg8::EpiBf16<1> E{(bf16*)(ws + WS_H), FP, (const float*)(ws + WS_RS)};
                pg8::gemm_phase<pg8::EpiBf16<1>, pg8::StaticOrder, true, true>(lds, g, S, E, tid);
                for (int j = bx; j < (MS / 64) * (FF / 64); j += G) small_gemm_tile<4, 1, DM>(lds, (const bf16*)args.out, (const bf16*)(wl + W_UP), (bf16*)(ws + WS_H), FP, 2 * DM, DM + WPAD, (const float*)(ws + WS_RS), MP + ((j >> 5) & 7) * 64, SMALL_TN(j, FF / 64) * 64, tid);
            } else if (k == 1) {
                const int vcu = (G % 8 == 0) ? (bx % 8) * (G / 8) + bx / 8 : bx; const int NGW = G * NWAVES;
                const int gw = (NGW == 2048) ? (wave < 2 ? vcu * 2 + wave : 512 + vcu * 6 + (wave - 2)) : vcu * NWAVES + wave;
                LAS float* scr = (LAS float*)(lds + wave * WAVE_SCR);
                const bf16* ZB = (const bf16*)(ws + WS_Z); bf16* CAT = (bf16*)(ws + WS_CAT); const bf16* SGW = (const bf16*)(ws + WS_SGUW) + (size_t)l * 4 * 128 * 128;
                float* out = args.out;
                constexpr int NU_SGU = 512, NU_CONV = 2048, NU_SEG = 1024, NU_SMP = 2048, NU = NU_SGU + NU_CONV + 2 * NU_SEG + NU_SMP;
#pragma unroll 1
                for (int ui = 0; ; ++ui) {
                    int u;
                    if (NGW != 2048) { u = ui * NGW + gw; if (u >= NU) break; }
                    else { if (ui >= 4) break;
                        if (gw < 512) { if (ui == 0) u = gw; else if (ui == 1) u = NU_SGU + 1536 + gw; else break; }
                        else { const int g5 = gw - 512; if (ui == 0) u = NU_SGU + g5; else { const int sidx = (ui - 1) * 1536 + g5; if (sidx >= 2 * NU_SEG + NU_SMP) break; u = NU_SGU + NU_CONV + sidx; } } }
                    int lane = tid & 63; asm volatile("" : "+v"(lane));
                    if (u < NU_SGU) { sgu_unit(ZB, CAT, SGW, args.in[17] + (size_t)l * GW, args.in[18] + (size_t)l * GW, args.in[20] + (size_t)l * 4 * 128, u >> 2, u & 3, (LAS bf16*)scr, lane); continue; }
                    int r = u - NU_SGU;
                    if (r < NU_CONV) { const int seg = r >> 2, h = r & 3, seq = seg >> 6, t0 = (seg & 63) * 32;
                        conv_unit_p(ZB, CAT, out + OUT_CONV_P + (size_t)l * NBP * 30 * GW, args.in[13] + (size_t)l * 31 * GW, args.in[14] + (size_t)l * GW, args.in[15] + (size_t)l * GW, args.in[16] + (size_t)l * GW, seq, t0, h, scr, lane);
                        continue; }
                    r -= NU_CONV;
                    if (r < 2 * NU_SEG) { const int ty = r / NU_SEG, q = r % NU_SEG, seg = q >> 2, h = q & 3, seq = seg >> 5, t0 = (seg & 31) * 64;
                        if (ty == 0) { float* np = out + OUT_POOL_P + (size_t)l * NBP * 15 * GW;
                            if (h == 0) pool_unit_p<2>(ZB, CAT, np, seq, t0, h, lane); else if (h == 1) pool_unit_p<4>(ZB, CAT, np, seq, t0, h, lane);
                            else if (h == 2) pool_unit_p<8>(ZB, CAT, np, seq, t0, h, lane); else pool_unit_p<16>(ZB, CAT, np, seq, t0, h, lane); }
                        else short_unit_p(ZB, CAT, out + OUT_SHORT_P + (size_t)l * NBP * 2 * GW, args.in[21] + (size_t)l * 3 * GW, seq, t0, h, lane);
                        continue; }
                    r -= 2 * NU_SEG;
                    { const int ty = r >> 9, q = r & 511, seq = q >> 2, h = q & 3;
                        if (ty == 0) conv_unit<true>(ZB, CAT, args.in[3] + (size_t)l * NSB * 30 * GW, out + OUT_CONV_S + (size_t)l * NSB * 30 * GW, args.in[13] + (size_t)l * 31 * GW, args.in[14] + (size_t)l * GW, args.in[15] + (size_t)l * GW, args.in[16] + (size_t)l * GW, seq, 0, ST, h, scr, lane);
                        else if (ty == 1) { const float* sp = args.in[2] + (size_t)l * NSB * 15 * GW; float* np = out + OUT_POOL_S + (size_t)l * NSB * 15 * GW;
                            if (h == 0) pool_sample_unit<2>(ZB, CAT, sp, np, seq, h, lane); else if (h == 1) pool_sample_unit<4>(ZB, CAT, sp, np, seq, h, lane); else if (h == 2) pool_sample_unit<8>(ZB, CAT, sp, np, seq, h, lane); else pool_sample_unit<16>(ZB, CAT, sp, np, seq, h, lane); }
                        else if (ty == 2) short_unit<true>(ZB, CAT, args.in[4] + (size_t)l * NSB * 2 * GW, out + OUT_SHORT_S + (size_t)l * NSB * 2 * GW, args.in[21] + (size_t)l * 3 * GW, seq, 0, ST, h, lane);
                        else sgu_sample_unit(ZB, CAT, args.in[19] + (size_t)l * 4 * 128 * 128, args.in[17] + (size_t)l * GW, args.in[18] + (size_t)l * GW, args.in[20] + (size_t)l * 4 * 128, out + OUT_V_S + (size_t)l * NSB * ST * GW, seq, h, lane); }
                }
            } else {
                const int vcu = (G % 8 == 0) ? (bx % 8) * (G / 8) + bx / 8 : bx; const int gw = vcu * NWAVES + wave, NGW = G * NWAVES;
                const float* g = args.in[k == 3 ? 6 : 8] + (size_t)l * DM;
                float* X = args.out; const bf16* OB = (const bf16*)(ws + WS_O); float* RS = (float*)(ws + WS_RS);
                const bool from_input = (l == 0 && k == 3), write_xn = !(l == DEPTH - 1 && k == 6);
                f32x4 gg[4];
#pragma unroll
                for (int j = 0; j < 4; ++j) gg[j] = ((const f32x4*)g + lane)[64 * j];
                const int m_lo = 0;
#define EW_X32(m) ((m) < MP ? args.in[0] + (size_t)(m) * DM : args.in[1] + (size_t)((m) - MP) * DM)
                bf16* X16 = (bf16*)args.out;
                const bool dst16 = write_xn;
                { EwRow r0, r1, r2;
                  const int ma = m_lo + gw;
                  if (ma < MT) {
                    ew_load(r0, X16 + (size_t)ma * 2 * DM, OB + (size_t)ma * OP, lane);
                    { const int mb = ma + NGW < MT ? ma + NGW : ma; ew_load(r1, X16 + (size_t)mb * 2 * DM, OB + (size_t)mb * OP, lane); }
#pragma unroll 1
                    for (int m = ma; m < MT; m += NGW) {
                        { const int mc = m + 2 * NGW < MT ? m + 2 * NGW : m; ew_load(r2, X16 + (size_t)mc * 2 * DM, OB + (size_t)mc * OP, lane); }
                        ew_finish(r0, gg, X + (size_t)m * DM, X16 + (size_t)m * 2 * DM, dst16, RS + m, write_xn, lane);
                        r0 = r1; r1 = r2;
                    }
                  }
                }
#undef EW_X32
            }
        }
        ++ph;
        if (ph < args.ph_hi) {
            if (args.ph_lo < 0) cg::this_grid().sync();
            else { XcdBarrier b; b.bar = (unsigned*)(args.ws + WS_CTL); b.x = xb_xcc_id(); b.st = (volatile LAS unsigned*)(lds + MISC_OFF) + 8; xcd_barrier(b); }
        }
    }
}

#ifndef MK_N_LAUNCHES
#define MK_N_LAUNCHES 1
#endif
extern "C" void kernel_launch(void* const* d_in, const int* in_sizes, int n_in, void* d_out, int out_size, void* d_ws, size_t ws_size, hipStream_t stream) {
    static int grid = 0;
    if (grid == 0) {
        if (n_in != 24 || (size_t)out_size != OUT_END || ws_size < WS_END) { fprintf(stderr, "kernel_launch: unexpected shapes (n_in %d out %d ws %zu)\n", n_in, out_size, ws_size); grid = -1; return; }
        int dev = 0, cus = 0, per_cu = 0;
        if (hipGetDevice(&dev) != hipSuccess || hipDeviceGetAttribute(&cus, hipDeviceAttributeMultiprocessorCount, dev) != hipSuccess) { grid = -1; return; }
        if (hipFuncSetAttribute((const void*)hybrid_fwd, hipFuncAttributeMaxDynamicSharedMemorySize, LDS_BYTES) != hipSuccess) { fprintf(stderr, "kernel_launch: hipFuncSetAttribute failed\n"); grid = -1; return; }
        if (hipOccupancyMaxActiveBlocksPerMultiprocessor(&per_cu, (const void*)hybrid_fwd, NWAVES * 64, LDS_BYTES) != hipSuccess || per_cu < 1) per_cu = 1;
        (void)hipGetLastError();
        grid = cus * per_cu;
    }
    if (grid < 0) return;
    if (hipMemsetAsync((char*)d_ws + WS_CTL, 0, CTL_ZERO_BYTES, stream) != hipSuccess) { fprintf(stderr, "kernel_launch: hipMemsetAsync failed\n"); return; }
    Args a{};
    for (int i = 0; i < 24; ++i) a.in[i] = (const float*)d_in[i];
    a.out = (float*)d_out; a.ws = (unsigned char*)d_ws;
#if MK_N_LAUNCHES == 1
    a.ph_lo = 0; a.ph_hi = NPH;
    void* kargs[] = {&a};
    hipError_t e = hipLaunchCooperativeKernel((const void*)hybrid_fwd, dim3(grid), dim3(NWAVES * 64), kargs, LDS_BYTES, stream);
    if (e != hipSuccess) fprintf(stderr, "cooperative launch failed: %s (grid %d)\n", hipGetErrorString(e), grid);
#else
    for (int p = 0; p < NPH; ++p) { a.ph_lo = p; a.ph_hi = p + 1; hipLaunchKernelGGL(hybrid_fwd, dim3(grid), dim3(NWAVES * 64), LDS_BYTES, stream, a); }
#endif
}
```

```cpp
#include <hip/hip_runtime.h>
#include <hip/hip_cooperative_groups.h>
#include <cstdio>
#include <cstdint>
namespace pg8 {
#define PG8_LAS __attribute__((address_space(3)))
typedef unsigned short bf16_t;
typedef short bf16x8 __attribute__((ext_vector_type(8)));
typedef float f32x4 __attribute__((ext_vector_type(4)));
typedef unsigned u32x4 __attribute__((ext_vector_type(4)));
constexpr int KPAD = 64;
constexpr int BM = 256, BK = 64, HALF = 128, HTB = HALF * BK * 2  , STAGE_BYTES = 8 * HTB, NXCD = 8, WGM = 1;

__host__ __device__ __forceinline__ int lds_byte(int r, int c) { const int st = (r >> 4) * 2 + (c >> 5), rr = r & 15, cc = c & 31, ob = rr * 64 + cc * 2; return st * 1024 + (ob ^ (((ob >> 9) & 1) << 5)); }
__host__ __device__ __forceinline__ void stage_rc(int b, int& R, int& C) { const int st = b / 1024, sb = b % 1024, swz = sb ^ (((sb >> 9) & 1) << 5); R = (st >> 1) * 16 + swz / 64; C = (st & 1) * 32 + (swz % 64) / 2; }
__host__ __device__ __forceinline__ int perm32(int rho) { const int n = rho >> 4, i = rho & 15; return 8 * (i >> 2) + 4 * n + (i & 3); }

struct Unit { int pm, pn; };
struct Gemm { const bf16_t* A; const bf16_t* Bt; int M, N, K, lda, ldb; };

struct StaticOrder {
    int nM, nN, nwg, G, c;
    __host__ __device__ void init(int M, int N, int G_, int c_) { nM = M / BM; nN = N / BM; nwg = nM * nN; G = G_; c = c_; }
    __host__ __device__ bool next(int i, Unit& u) const {
        const long L = (long)i * G + c; if (L >= nwg) return false;
        int wgid = (int)L; { const int q = nwg / NXCD, r = nwg % NXCD, xcd = wgid % NXCD, off = wgid / NXCD; wgid = (xcd < r ? xcd * (q + 1) : r * (q + 1) + (xcd - r) * q) + off; }
        const int nig = WGM * nN, gid = wgid / nig, fm = gid * WGM, gsz = (nM - fm) < WGM ? (nM - fm) : WGM;
        u.pm = fm + ((wgid % nig) % gsz); u.pn = (wgid % nig) / gsz; return true;
    }
    __device__ __forceinline__ void a_ready(const Unit&) const {}
    __device__ __forceinline__ void done(const Unit&) const {}
};

__device__ __forceinline__ unsigned cvt_pk_bf16(float lo, float hi) { unsigned r; asm volatile("v_cvt_pk_bf16_f32 %0, %1, %2" : "=v"(r) : "v"(lo), "v"(hi)); return r; }
__device__ __forceinline__ float relu_sq(float x) { float r; asm volatile("v_max_f32 %0, 0, %1" : "=v"(r) : "v"(x)); return r * r; }
__device__ __forceinline__ void st16_wt(void* p, u32x4 v) { asm volatile("global_store_dwordx4 %0, %1, off sc1" :: "v"(p), "v"(v) : "memory"); }
template <int ACT  > struct EpiBf16 {
    static constexpr bool PERM = true, AFTER_DRAIN = false;
    bf16_t* O; int ldc; const float* rs;
    __device__ __forceinline__ void operator()(const f32x4 (&acc)[2][2][4][2], const Unit& u, int wr, int wc, int fr, int fq) const {
        const int row0 = u.pm * BM + wr * 64 + fr; const int col0 = u.pn * BM + wc * 32 + 8 * fq;
#pragma unroll
        for (int ai = 0; ai < 2; ++ai)
#pragma unroll
            for (int m = 0; m < 4; ++m) { bf16_t* rowp = O + (size_t)(row0 + ai * HALF + m * 16) * ldc + col0; const float sc = rs ? rs[row0 + ai * HALF + m * 16] : 1.f;
#pragma unroll
                for (int bj = 0; bj < 2; ++bj) { f32x4 v0 = acc[ai][bj][m][0] * sc, v1 = acc[ai][bj][m][1] * sc;
                    if (ACT == 1) {
#pragma unroll
                        for (int e = 0; e < 4; ++e) { v0[e] = relu_sq(v0[e]); v1[e] = relu_sq(v1[e]); } }
                    u32x4 w; w.x = cvt_pk_bf16(v0[0], v0[1]); w.y = cvt_pk_bf16(v0[2], v0[3]); w.z = cvt_pk_bf16(v1[0], v1[1]); w.w = cvt_pk_bf16(v1[2], v1[3]);
                    *(u32x4*)(rowp + bj * HALF) = w; } }
    }
};

template <class Epi, class Sched, bool ALIGN_EPI = false, bool SP2 = false>
__device__ __forceinline__ void gemm_phase(PG8_LAS unsigned char* lds, const Gemm g, const Sched& S, const Epi& E, const int tid) {
    const int wid = __builtin_amdgcn_readfirstlane(tid >> 6), lane = tid & 63, wr = wid >> 2, wc = wid & 3, fr = lane & 15, fq = lane >> 4;
    const int K = g.K, nt = K / BK;
    unsigned voffA[2], voffB[2];
#pragma unroll
    for (int i = 0; i < 2; ++i) { int R, C; stage_rc(tid * 16 + i * 8192, R, C); const int Rb = Epi::PERM ? ((R & ~31) + perm32(R & 31)) : R;
        voffA[i] = (unsigned)(R * g.lda + C) * 2u; voffB[i] = (unsigned)(Rb * g.ldb + C) * 2u; }
    const size_t kstep = (size_t)(BK * 2);
    const size_t hstepA = (size_t)HALF * g.lda * 2, hstepB = (size_t)HALF * g.ldb * 2;
    const size_t tstepA = 2 * hstepA, tstepB = 2 * hstepB;
    const unsigned ldsw = (unsigned)wid * 1024u;
    const int aoff = lds_byte(wr * 64 + fr, fq * 8), boff = lds_byte(wc * 32 + fr, fq * 8);
#define PG8_SA(b, h) (((b) * 2 + (h)) * HTB)
#define PG8_SB(b, h) ((4 + (b) * 2 + (h)) * HTB)
#define PG8_STAGE(bufoff, gbase, voff) do { _Pragma("unroll") for (int _i = 0; _i < 2; ++_i) \
        __builtin_amdgcn_global_load_lds((const unsigned*)((const char*)(gbase) + (voff)[_i]), (PG8_LAS unsigned*)(lds + (bufoff) + ldsw + _i * 8192), 16, 0, 0); } while (0)
#define PG8_LDA(dst, b, h) do { _Pragma("unroll") for (int m = 0; m < 4; ++m) _Pragma("unroll") for (int k = 0; k < 2; ++k) dst[m][k] = *(const PG8_LAS bf16x8*)(lds + PG8_SA(b, h) + aoff + m * 2048 + k * 1024); } while (0)
#define PG8_LDB(dst, b, h) do { _Pragma("unroll") for (int n = 0; n < 2; ++n) _Pragma("unroll") for (int k = 0; k < 2; ++k) dst[n][k] = *(const PG8_LAS bf16x8*)(lds + PG8_SB(b, h) + boff + n * 2048 + k * 1024); } while (0)
#define PG8_MMA(ai, bj, At, Bt) do { __builtin_amdgcn_s_setprio(1); _Pragma("unroll") for (int m = 0; m < 4; ++m) _Pragma("unroll") for (int n = 0; n < 2; ++n) _Pragma("unroll") for (int k = 0; k < 2; ++k) \
        acc[ai][bj][m][n] = __builtin_amdgcn_mfma_f32_16x16x32_bf16(Bt[n][k], At[m][k], acc[ai][bj][m][n], 0, 0, 0); __builtin_amdgcn_s_setprio(0); } while (0)
#define PG8_WAIT_V(n) asm volatile("s_waitcnt vmcnt(" #n ")" ::: "memory")
#define PG8_WAIT_L(n) asm volatile("s_waitcnt lgkmcnt(" #n ")" ::: "memory")
#define PG8_BAR __builtin_amdgcn_s_barrier()
#define PG8_SCHED __builtin_amdgcn_sched_barrier(0)
    Unit cur, nxt; int ui = 0;
    if (!S.next(0, cur)) return;
    f32x4 acc[2][2][4][2];
#pragma unroll
    for (int a = 0; a < 2; ++a)
#pragma unroll
        for (int b = 0; b < 2; ++b)
#pragma unroll
            for (int m = 0; m < 4; ++m)
#pragma unroll
                for (int n = 0; n < 2; ++n) acc[a][b][m][n] = (f32x4){0.f, 0.f, 0.f, 0.f};
    bf16x8 At[4][2], B0[2][2], B1[2][2];
    const char* cA = (const char*)g.A + (size_t)cur.pm * tstepA; const char* cB = (const char*)g.Bt + (size_t)cur.pn * tstepB;
    S.a_ready(cur);
    if constexpr (SP2) {
        PG8_STAGE(PG8_SB(0, 0), cB, voffB); PG8_STAGE(PG8_SB(0, 1), cB + hstepB, voffB); PG8_STAGE(PG8_SA(0, 0), cA, voffA); PG8_STAGE(PG8_SA(0, 1), cA + hstepA, voffA);
        if (wr == 1) PG8_BAR;
        PG8_WAIT_V(2); PG8_BAR;
        PG8_STAGE(PG8_SB(1, 0), cB + kstep, voffB); PG8_STAGE(PG8_SA(1, 0), cA + kstep, voffA); PG8_STAGE(PG8_SB(1, 1), cB + hstepB + kstep, voffB);
        PG8_WAIT_V(6); PG8_BAR;
    } else {
        PG8_STAGE(PG8_SB(0, 0), cB, voffB); PG8_STAGE(PG8_SA(0, 0), cA, voffA); PG8_STAGE(PG8_SB(0, 1), cB + hstepB, voffB); PG8_STAGE(PG8_SA(0, 1), cA + hstepA, voffA);
        if (wr == 1) PG8_BAR;
        PG8_WAIT_V(4); PG8_BAR;
        PG8_STAGE(PG8_SB(1, 0), cB + kstep, voffB); PG8_STAGE(PG8_SA(1, 0), cA + kstep, voffA); PG8_STAGE(PG8_SB(1, 1), cB + hstepB + kstep, voffB);
        PG8_WAIT_V(6); PG8_BAR;
    }
    for (;;) {
        const bool has_next = S.next(ui + 1, nxt);
        const char* nA = has_next ? (const char*)g.A + (size_t)nxt.pm * tstepA : cA; const char* nB = has_next ? (const char*)g.Bt + (size_t)nxt.pn * tstepB : cB;
        for (int t = 0; t < nt; t += 2) {
            const bool last = (t == nt - 2);
            const char* a1 = cA + (size_t)(t + 1) * kstep;
            const char* a2 = last ? nA : cA + (size_t)(t + 2) * kstep; const char* b2 = last ? nB : cB + (size_t)(t + 2) * kstep;
            const char* a3 = a2 + kstep; const char* b3 = b2 + kstep;
            if (last && has_next) S.a_ready(nxt);
            if constexpr (SP2) {
            PG8_LDB(B0, 0, 0); PG8_LDB(B1, 0, 1); PG8_SCHED; PG8_LDA(At, 0, 0); PG8_STAGE(PG8_SA(1, 1), a1 + hstepA, voffA);
            PG8_WAIT_V(8); PG8_WAIT_L(0); PG8_BAR; PG8_MMA(0, 0, At, B0); PG8_MMA(0, 1, At, B1); PG8_BAR; PG8_SCHED;
            PG8_LDA(At, 0, 1); PG8_STAGE(PG8_SB(0, 0), b2, voffB); PG8_STAGE(PG8_SB(0, 1), b2 + hstepB, voffB); PG8_STAGE(PG8_SA(0, 0), a2, voffA);
            PG8_WAIT_V(8); PG8_WAIT_L(0); PG8_BAR; PG8_MMA(1, 0, At, B0); PG8_MMA(1, 1, At, B1); PG8_BAR; PG8_SCHED;
            PG8_LDB(B0, 1, 0); PG8_LDB(B1, 1, 1); PG8_SCHED; PG8_LDA(At, 1, 0); PG8_STAGE(PG8_SA(0, 1), a2 + hstepA, voffA);
            PG8_WAIT_V(8); PG8_WAIT_L(0); PG8_BAR; PG8_MMA(0, 0, At, B0); PG8_MMA(0, 1, At, B1); PG8_BAR; PG8_SCHED;
            PG8_LDA(At, 1, 1); PG8_STAGE(PG8_SB(1, 0), b3, voffB); PG8_STAGE(PG8_SB(1, 1), b3 + hstepB, voffB); PG8_STAGE(PG8_SA(1, 0), a3, voffA);
            PG8_WAIT_V(8); PG8_WAIT_L(0); PG8_BAR; PG8_MMA(1, 0, At, B0); PG8_MMA(1, 1, At, B1); PG8_BAR; PG8_SCHED;
            } else {
            PG8_LDB(B0, 0, 0); PG8_SCHED; PG8_LDA(At, 0, 0); PG8_STAGE(PG8_SA(1, 1), a1 + hstepA, voffA);
            PG8_WAIT_L(8); PG8_BAR; PG8_WAIT_L(0); PG8_MMA(0, 0, At, B0); PG8_BAR; PG8_SCHED;
            PG8_LDB(B1, 0, 1); PG8_STAGE(PG8_SB(0, 0), b2, voffB);
            PG8_BAR; PG8_WAIT_L(0); PG8_MMA(0, 1, At, B1); PG8_BAR;
            PG8_LDA(At, 0, 1); PG8_STAGE(PG8_SA(0, 0), a2, voffA);
            PG8_BAR; PG8_WAIT_L(0); PG8_MMA(1, 0, At, B0); PG8_BAR; PG8_SCHED;
            PG8_STAGE(PG8_SB(0, 1), b2 + hstepB, voffB);
            PG8_WAIT_V(6); PG8_BAR; PG8_MMA(1, 1, At, B1); PG8_BAR;
            PG8_LDB(B0, 1, 0); PG8_SCHED; PG8_LDA(At, 1, 0); PG8_STAGE(PG8_SA(0, 1), a2 + hstepA, voffA);
            PG8_WAIT_L(8); PG8_BAR; PG8_WAIT_L(0); PG8_MMA(0, 0, At, B0); PG8_BAR; PG8_SCHED;
            PG8_LDB(B1, 1, 1); PG8_STAGE(PG8_SB(1, 0), b3, voffB);
            PG8_BAR; PG8_WAIT_L(0); PG8_MMA(0, 1, At, B1); PG8_BAR;
            PG8_LDA(At, 1, 1); PG8_STAGE(PG8_SA(1, 0), a3, voffA);
            PG8_BAR; PG8_WAIT_L(0); PG8_MMA(1, 0, At, B0); PG8_BAR; PG8_SCHED;
            PG8_STAGE(PG8_SB(1, 1), b3 + hstepB, voffB);
            PG8_WAIT_V(6); PG8_BAR; PG8_MMA(1, 1, At, B1); PG8_BAR;
            }
        }
        if constexpr (ALIGN_EPI) { if (wr == 0) PG8_BAR; }
        if constexpr (!Epi::AFTER_DRAIN) { E(acc, cur, wr, wc, fr, fq); S.done(cur); }
        if (!has_next) break;
#pragma unroll
        for (int a = 0; a < 2; ++a)
#pragma unroll
            for (int b = 0; b < 2; ++b)
#pragma unroll
                for (int m = 0; m < 4; ++m)
#pragma unroll
                    for (int n = 0; n < 2; ++n) acc[a][b][m][n] = (f32x4){0.f, 0.f, 0.f, 0.f};
        cur = nxt; cA = nA; cB = nB; ++ui;
        if constexpr (ALIGN_EPI) { if (wr == 1) PG8_BAR; }
    }
    PG8_WAIT_V(0);
    if constexpr (!ALIGN_EPI) { if (wr == 0) PG8_BAR; }
    PG8_BAR;
    if constexpr (Epi::AFTER_DRAIN) { E.fused(acc, cur, wr, wc, fr, fq, lds, wid, lane); S.done(cur); }
#undef PG8_SA
#undef PG8_SB
#undef PG8_STAGE
#undef PG8_LDA
#undef PG8_LDB
#undef PG8_MMA
#undef PG8_WAIT_V
#undef PG8_WAIT_L
#undef PG8_BAR
#undef PG8_SCHED
}
}

namespace cg = cooperative_groups;
#define LAS __attribute__((address_space(3)))
typedef unsigned short bf16;
typedef unsigned v4u __attribute__((ext_vector_type(4)));
typedef unsigned v2u __attribute__((ext_vector_type(2)));
typedef float f32x4 __attribute__((ext_vector_type(4)));
typedef short bf16x8 __attribute__((ext_vector_type(8)));

constexpr int NWAVES = 8;
constexpr int DM = 1024, FF = 4096, INW = 2048, GW = 256;
constexpr int ZP = INW + 64;
#ifndef HPAD
#define HPAD 0
#endif
#ifndef WPAD
#define WPAD 0
#endif
#ifndef APAD
#define APAD 0
#endif
constexpr int DP = DM + APAD;
#ifndef OPAD
#define OPAD 0
#endif
constexpr int OP = DM + OPAD;
constexpr int FP = FF + HPAD;
constexpr int MP = 16384, MS = 512, MT = MP + MS;
constexpr int SEQ = 2048, NBP = 8, NSB = 128, ST = 4, DEPTH = 2;
constexpr float EPS = 1e-6f;
constexpr size_t MiB = 1u << 20;
constexpr size_t WS_SGUW = 1 * MiB;
constexpr size_t WS_W = 2 * MiB, W_LAYER = 24 * MiB, W_IN = 0, W_OUT = 9 * MiB / 2, W_UP = 7 * MiB, W_DN = 31 * MiB / 2;
constexpr size_t WS_XN = 50 * MiB, WS_O = 84 * MiB, WS_H = 120 * MiB, WS_Z = 120 * MiB, WS_CAT = 189 * MiB, WS_RS = 254 * MiB  , WS_END = 255 * MiB;
static_assert(WS_Z + (size_t)16896 * ZP * 2 <= WS_CAT && WS_XN + (size_t)16896 * DP * 2 <= WS_O && WS_CAT + (size_t)16896 * DP * 2 <= WS_H + (size_t)16896 * FP * 2 && WS_H + (size_t)16896 * FP * 2 <= WS_END, "d_ws map");
constexpr int LDS_BYTES = 147456;
constexpr int MISC_OFF = LDS_BYTES - 256;
constexpr size_t WS_CTL = 0, CTL_ZERO_BYTES = 64 * 1024;
constexpr int WAVE_SCR = 17408;
constexpr size_t OUT_Y = 0;
constexpr size_t OUT_POOL_P = (size_t)MT * DM;
constexpr size_t OUT_POOL_S = OUT_POOL_P + (size_t)DEPTH * NBP * 15 * GW;
constexpr size_t OUT_CONV_P = OUT_POOL_S + (size_t)DEPTH * NSB * 15 * GW;
constexpr size_t OUT_CONV_S = OUT_CONV_P + (size_t)DEPTH * NBP * 30 * GW;
constexpr size_t OUT_SHORT_P = OUT_CONV_S + (size_t)DEPTH * NSB * 30 * GW;
constexpr size_t OUT_SHORT_S = OUT_SHORT_P + (size_t)DEPTH * NBP * 2 * GW;
constexpr size_t OUT_V_S = OUT_SHORT_S + (size_t)DEPTH * NSB * 2 * GW;
constexpr size_t OUT_END = OUT_V_S + (size_t)DEPTH * NSB * ST * GW;

__device__ __forceinline__ float bf2f(bf16 b) { return __uint_as_float(((unsigned)b) << 16); }
__device__ __forceinline__ unsigned f2bf(float f) { unsigned u = __float_as_uint(f); return (u + 0x7fffu + ((u >> 16) & 1u)) >> 16; }
__device__ __forceinline__ unsigned pk2(float lo, float hi) { return f2bf(lo) | (f2bf(hi) << 16); }
template <int CTRL, int ROWMASK> __device__ __forceinline__ float dpp_get(float v) { return __int_as_float(__builtin_amdgcn_update_dpp(0, __float_as_int(v), CTRL, ROWMASK, 0xF, false)); }
__device__ __forceinline__ float sum8(float v) { v += dpp_get<0xB1, 0xF>(v); v += dpp_get<0x4E, 0xF>(v); v += dpp_get<0x141, 0xF>(v); return v; }
__device__ __forceinline__ float wave_sum(float v) {
    v = sum8(v); v += dpp_get<0x140, 0xF>(v); v += dpp_get<0x142, 0xA>(v); v += dpp_get<0x143, 0xC>(v);
    return __int_as_float(__builtin_amdgcn_readlane(__float_as_int(v), 63));
}
__device__ __forceinline__ void unpack8(const v4u w, float (&f)[8]) {
    f[0] = __uint_as_float(w.x << 16); f[1] = __uint_as_float(w.x & 0xffff0000u); f[2] = __uint_as_float(w.y << 16); f[3] = __uint_as_float(w.y & 0xffff0000u);
    f[4] = __uint_as_float(w.z << 16); f[5] = __uint_as_float(w.z & 0xffff0000u); f[6] = __uint_as_float(w.w << 16); f[7] = __uint_as_float(w.w & 0xffff0000u); }
__device__ __forceinline__ v4u pack8(const float (&f)[8]) { v4u w; w.x = pg8::cvt_pk_bf16(f[0], f[1]); w.y = pg8::cvt_pk_bf16(f[2], f[3]); w.z = pg8::cvt_pk_bf16(f[4], f[5]); w.w = pg8::cvt_pk_bf16(f[6], f[7]); return w; }
__device__ __forceinline__ v4u ld16(const bf16* p) { return *(const v4u*)p; }
__device__ __forceinline__ float sigm(float x) { return __builtin_amdgcn_rcpf(1.f + __builtin_amdgcn_exp2f(-1.44269504f * x)); }
#define LDS_WAIT() asm volatile("s_waitcnt lgkmcnt(0)" ::: "memory")

__device__ __forceinline__ void transpose_item(const float* __restrict__ W, int K, int N, bf16* __restrict__ WT, const float* __restrict__ gk, LAS float* scr, int item, int lane) {
    const int nblk = N / 32, kb = item / nblk, nb = item % nblk, k0 = 64 * kb, n0 = 32 * nb;
#pragma unroll 8
    for (int i = 0; i < 32; ++i) { const int kk = 2 * i + (lane >> 5); float v = W[(size_t)(k0 + kk) * N + n0 + (lane & 31)]; if (gk) v *= gk[k0 + kk]; scr[kk * 33 + (lane & 31)] = v; }
    LDS_WAIT();
    const int c = lane & 7;
#pragma unroll
    for (int j = 0; j < 4; ++j) { const int n = (lane >> 3) + 8 * j; const LAS float* s = scr + (8 * c) * 33 + n;
        v4u o; o.x = pk2(s[0 * 33], s[1 * 33]); o.y = pk2(s[2 * 33], s[3 * 33]); o.z = pk2(s[4 * 33], s[5 * 33]); o.w = pk2(s[6 * 33], s[7 * 33]);
        *(v4u*)(WT + (size_t)(n0 + n) * K + k0 + 8 * c) = o; }
    LDS_WAIT();
}
struct TrDesc { const float* W; bf16* WT; const float* gk; int K, N, k0, n0; };
__device__ __forceinline__ void tr_load(float (&v)[32], const TrDesc& d, int lane) {
    const float* p = d.W + (size_t)(d.k0 + (lane >> 5)) * d.N + d.n0 + (lane & 31);
#pragma unroll
    for (int i = 0; i < 32; ++i) v[i] = __builtin_nontemporal_load(p + (size_t)(2 * i) * d.N);
}
__device__ __forceinline__ void tr_store(const float (&v)[32], const TrDesc& d, LAS float* scr, int lane) {
#pragma unroll
    for (int i = 0; i < 32; ++i) { const int kk = 2 * i + (lane >> 5); float x = v[i]; if (d.gk) x *= d.gk[d.k0 + kk]; scr[kk * 33 + (lane & 31)] = x; }
    LDS_WAIT();
    const int c = lane & 7;
#pragma unroll
    for (int j = 0; j < 4; ++j) { const int n = (lane >> 3) + 8 * j; const LAS float* s = scr + (8 * c) * 33 + n;
        v4u o; o.x = pg8::cvt_pk_bf16(s[0 * 33], s[1 * 33]); o.y = pg8::cvt_pk_bf16(s[2 * 33], s[3 * 33]); o.z = pg8::cvt_pk_bf16(s[4 * 33], s[5 * 33]); o.w = pg8::cvt_pk_bf16(s[6 * 33], s[7 * 33]);
        *(v4u*)(d.WT + (size_t)(d.n0 + n) * (d.K + WPAD) + d.k0 + 8 * c) = o; }
    LDS_WAIT();
}
__device__ __forceinline__ void fold_item(const float* __restrict__ W, bf16* __restrict__ WT, const float* __restrict__ wp, const float* __restrict__ ps, LAS float* scr, int item4, int lane) {
    const int K = DM, N = DM; const int item = item4 >> 2, q = item4 & 3; const int nblk = N / 32, g = item / nblk, nb = item % nblk, k0 = 64 * g, n0 = 32 * nb;
    LAS float* scr2 = scr + 64 * 33;
#pragma unroll 8
    for (int i = 0; i < 32; ++i) { const int kk = 2 * i + (lane >> 5); scr[kk * 33 + (lane & 31)] = W[(size_t)(k0 + kk) * N + n0 + (lane & 31)] * ps[k0 + kk]; }
    LDS_WAIT();
    const int n = lane & 31;
    LAS float* wpL = scr2 + 16 * 33;
    { const f32x4* src = (const f32x4*)(wp + (size_t)(g * 64 + 16 * q) * 64) + lane;
#pragma unroll
      for (int j = 0; j < 4; ++j) *(LAS f32x4*)(wpL + 4 * lane + 256 * j) = src[64 * j]; }
    LDS_WAIT();
#pragma unroll 2
    for (int i = 0; i < 8; ++i) { const int kl = 2 * i + (lane >> 5); const LAS float* wr = wpL + kl * 64; float a = 0.f;
#pragma unroll 16
        for (int d = 0; d < 64; ++d) a += wr[d] * scr[d * 33 + n];
        scr2[kl * 33 + n] = a; }
    LDS_WAIT();
    { const int ch = lane >> 5; const LAS float* s = scr2 + (8 * ch) * 33 + n;
        v4u o; o.x = pk2(s[0 * 33], s[1 * 33]); o.y = pk2(s[2 * 33], s[3 * 33]); o.z = pk2(s[4 * 33], s[5 * 33]); o.w = pk2(s[6 * 33], s[7 * 33]);
        *(v4u*)(WT + (size_t)(n0 + n) * (K + WPAD) + k0 + 16 * q + 8 * ch) = o; }
    LDS_WAIT();
}
struct XRow { f32x4 v[4]; };
__device__ __forceinline__ void xrow_load(XRow& r, const float* __restrict__ xrow, int lane) {
    const f32x4* xr = (const f32x4*)xrow + lane;
#pragma unroll
    for (int j = 0; j < 4; ++j) r.v[j] = __builtin_nontemporal_load(xr + 64 * j);
}
__device__ __forceinline__ void xrow_finish(const XRow& r, bf16* __restrict__ orow, float* __restrict__ rsp, int lane) {
    float s = 0.f;
#pragma unroll
    for (int j = 0; j < 4; ++j) s += (r.v[j].x * r.v[j].x + r.v[j].y * r.v[j].y) + (r.v[j].z * r.v[j].z + r.v[j].w * r.v[j].w);
    const float rstd = rsqrtf(wave_sum(s) * (1.f / DM) + EPS);
    if (lane == 0) *rsp = rstd;
    v2u* o8 = (v2u*)orow + lane;
#pragma unroll
    for (int j = 0; j < 4; ++j) { v2u o; o.x = pg8::cvt_pk_bf16(r.v[j].x, r.v[j].y); o.y = pg8::cvt_pk_bf16(r.v[j].z, r.v[j].w); o8[64 * j] = o; }
}
struct EwRow { v2u x[4]; v2u o[4]; };
__device__ __forceinline__ f32x4 unpack4(const v2u w) { return (f32x4){__uint_as_float(w.x << 16), __uint_as_float(w.x & 0xffff0000u), __uint_as_float(w.y << 16), __uint_as_float(w.y & 0xffff0000u)}; }
__device__ __forceinline__ void ew_load(EwRow& r, const bf16* __restrict__ xrow16, const bf16* __restrict__ orow, int lane) {
    const v2u* xr = (const v2u*)xrow16 + lane; const v2u* orr = (const v2u*)orow + lane;
#pragma unroll
    for (int j = 0; j < 4; ++j) { r.x[j] = xr[64 * j]; r.o[j] = orr[64 * j]; }
}
__device__ __forceinline__ void ew_finish(const EwRow& r, const f32x4 (&gg)[4], float* __restrict__ Xrow32, bf16* __restrict__ Xrow16, bool dst16, float* __restrict__ rsp, bool write_xn, int lane) {
    f32x4 o[4], x[4]; float so = 0.f;
#pragma unroll
    for (int j = 0; j < 4; ++j) { o[j] = unpack4(r.o[j]); so += (o[j].x * o[j].x + o[j].y * o[j].y) + (o[j].z * o[j].z + o[j].w * o[j].w); }
    const float rs = rsqrtf(wave_sum(so) * (1.f / DM) + EPS); float s1 = 0.f;
#pragma unroll
    for (int j = 0; j < 4; ++j) { x[j] = unpack4(r.x[j]) + o[j] * rs * gg[j]; s1 += (x[j].x * x[j].x + x[j].y * x[j].y) + (x[j].z * x[j].z + x[j].w * x[j].w); }
    if (dst16) { v2u* Xr = (v2u*)Xrow16 + lane;
#pragma unroll
        for (int j = 0; j < 4; ++j) { v2u w; w.x = pg8::cvt_pk_bf16(x[j].x, x[j].y); w.y = pg8::cvt_pk_bf16(x[j].z, x[j].w); Xr[64 * j] = w; } }
    else { f32x4* Xr = (f32x4*)Xrow32 + lane;
#pragma unroll
        for (int j = 0; j < 4; ++j) Xr[64 * j] = x[j]; }
    if (write_xn) { const float r1 = rsqrtf(wave_sum(s1) * (1.f / DM) + EPS); if (lane == 0) *rsp = r1; }
}

template <bool SAMPLE>
__device__ __forceinline__ void pool_unit(const bf16* __restrict__ Z, bf16* __restrict__ CAT, const float* __restrict__ state, float* __restrict__ newp,
                                          int seq, int t0, int nrows, int g, int lane) {
    const int c = g * 64 + lane, w = 2 << g;
    const size_t rowbase = SAMPLE ? (size_t)MP + (size_t)seq * ST : (size_t)seq * SEQ;
    const bf16* zc = Z + rowbase * ZP + c;
    const float* st = state + (size_t)seq * 15 * GW + c;
#define POOL_A(e) ((e) >= 0 ? bf2f(zc[(size_t)(e) * ZP]) : (SAMPLE ? st[(15 + (e)) * GW] : 0.f))
    float S = 0.f;
    for (int j = 1; j < w; ++j) S += POOL_A(t0 - j);
#pragma unroll 4
    for (int t = t0; t < t0 + nrows; ++t) {
        const float a = POOL_A(t); S += a;
        const float cnt = SAMPLE ? (float)w : (float)(t + 1 < w ? t + 1 : w);
        CAT[(rowbase + t) * DP + c] = (bf16)f2bf(S / cnt - a);
        const int e = t - w + 1; S -= POOL_A(e);
    }
    const int T = SAMPLE ? ST : SEQ;
    if (t0 + nrows == T) {
        for (int j = 0; j < 15; ++j) { const int e = T - 15 + j; newp[((size_t)seq * 15 + j) * GW + c] = POOL_A(e); }
    }
#undef POOL_A
}
template <int W>
__device__ __forceinline__ void pool_sample_unit(const bf16* __restrict__ Z, bf16* __restrict__ CAT, const float* __restrict__ state, float* __restrict__ newp, int seq, int g, int lane) {
    const int c = g * 64 + lane;
    const size_t rowbase = (size_t)MP + (size_t)seq * ST;
    float ext[15 + ST];
#pragma unroll
    for (int j = 0; j < 15; ++j) ext[j] = state[((size_t)seq * 15 + j) * GW + c];
#pragma unroll
    for (int t = 0; t < ST; ++t) ext[15 + t] = bf2f(Z[(rowbase + t) * ZP + c]);
#pragma unroll
    for (int t = 0; t < ST; ++t) { float S = 0.f;
#pragma unroll
        for (int i = 0; i < W; ++i) S += ext[15 + t - i];
        CAT[(rowbase + t) * DP + c] = (bf16)f2bf(S * (1.f / W) - ext[15 + t]); }
#pragma unroll
    for (int j = 0; j < 15; ++j) newp[((size_t)seq * 15 + j) * GW + c] = ext[ST + j];
}
template <bool SAMPLE>
__device__ __forceinline__ void short_unit(const bf16* __restrict__ Z, bf16* __restrict__ CAT, const float* __restrict__ state, float* __restrict__ news,
                                           const float* __restrict__ sw, int seq, int t0, int nrows, int h, int lane) {
    const int c = h * 64 + lane;
    const size_t rowbase = SAMPLE ? (size_t)MP + (size_t)seq * ST : (size_t)seq * SEQ;
    const bf16* zc = Z + rowbase * ZP + c;
    const float* st = state + (size_t)seq * 2 * GW + c;
    const float w0 = sw[c], w1 = sw[GW + c], w2 = sw[2 * GW + c];
#define SH_E(e) ((e) >= 0 ? bf2f(zc[(size_t)(e) * ZP + 1536]) * bf2f(zc[(size_t)(e) * ZP + 1792]) : (SAMPLE ? st[(2 + (e)) * GW] : 0.f))
    float e2 = SH_E(t0 - 2), e1 = SH_E(t0 - 1);
#pragma unroll 4
    for (int t = t0; t < t0 + nrows; ++t) {
        const float e0 = SH_E(t); const float bg = bf2f(zc[(size_t)t * ZP + 1280]);
        CAT[(rowbase + t) * DP + 768 + c] = (bf16)f2bf(bg * (w0 * e2 + w1 * e1 + w2 * e0));
        e2 = e1; e1 = e0;
    }
    const int T = SAMPLE ? ST : SEQ;
    if (t0 + nrows == T) { news[((size_t)seq * 2 + 0) * GW + c] = e2; news[((size_t)seq * 2 + 1) * GW + c] = e1; }
#undef SH_E
}
template <bool SAMPLE>
__device__ __forceinline__ void conv_unit(const bf16* __restrict__ Z, bf16* __restrict__ CAT, const float* __restrict__ state, float* __restrict__ newc,
                                          const float* __restrict__ cw, const float* __restrict__ cb, const float* __restrict__ lg, const float* __restrict__ lb,
                                          int seq, int t0, int nrows, int h, LAS float* gL, int lane) {
    const int c = h * 64 + lane;
    const size_t rowbase = SAMPLE ? (size_t)MP + (size_t)seq * ST : (size_t)seq * SEQ;
    const bf16* zc = Z + rowbase * ZP + c;
    bf16* oc = CAT + rowbase * DP + 256 + c;
    const int T = SAMPLE ? ST : SEQ;
    const bool last = (t0 + nrows == T);
    const int nin = nrows + 30;
#pragma unroll
    for (int r = 0; r < nin; ++r) { const int s = t0 - 30 + r; float gs = 0.f;
        if (s >= 0) { const unsigned off = (unsigned)s * ZP; const float p = bf2f(zc[off + 256]), gt = bf2f(zc[off + 512]); gs = p * sigm(gt); }
        else if (SAMPLE) gs = state[((size_t)seq * 30 + 30 + s) * GW + c];
        if (last && s >= T - 30) newc[((size_t)seq * 30 + (s - (T - 30))) * GW + c] = gs;
        gL[r * 64 + lane] = gs; }
    LDS_WAIT();
    float wk[31];
#pragma unroll
    for (int k = 0; k < 31; ++k) wk[k] = cw[k * GW + c];
    const float bias = cb[c], gg = lg[c], bb = lb[c];
#pragma unroll 1
    for (int tq = 0; tq < nrows; tq += 4) {
        float acc[4] = {bias, bias, bias, bias};
#pragma unroll
        for (int r = 0; r < 34; ++r) { const float gv = gL[(tq + r) * 64 + lane];
#pragma unroll
            for (int q = 0; q < 4; ++q) { const int k = r - q; if (k >= 0 && k <= 30) acc[q] += wk[k] * gv; } }
#pragma unroll
        for (int q = 0; q < 4; ++q) { const float cv = acc[q];
            const float mean = wave_sum(cv) * (1.f / 64.f); const float d = cv - mean;
            const float var = wave_sum(d * d) * (1.f / 64.f);
            const float y = d * rsqrtf(var + EPS) * gg + bb;
            oc[(unsigned)(t0 + tq + q) * DP] = (bf16)f2bf(y * sigm(y)); }
    }
    LDS_WAIT();
}
template <int W>
__device__ __forceinline__ void pool_unit_p(const bf16* __restrict__ Z, bf16* __restrict__ CAT, float* __restrict__ newp, int seq, int t0, int g, int lane) {
    const int rr = lane >> 3, cg = lane & 7, c0 = g * 64 + cg * 8, tb = t0 + rr * 8;
    const size_t rowbase = (size_t)seq * SEQ;
    const bf16* zb = Z + (rowbase + tb) * ZP + c0;
    v4u raw[W + 7];
#pragma unroll
    for (int j = 0; j < W + 7; ++j) { const int dj = j - (W - 1); raw[j] = (tb + dj >= 0) ? ld16(zb + (long)dj * ZP) : (v4u){0u, 0u, 0u, 0u}; }
    float S[8];
#pragma unroll
    for (int i = 0; i < 8; ++i) S[i] = 0.f;
#pragma unroll
    for (int j = 0; j < W - 1; ++j) { float f[8]; unpack8(raw[j], f);
#pragma unroll
        for (int i = 0; i < 8; ++i) S[i] += f[i]; }
    bf16* ob = CAT + (rowbase + tb) * DP + c0;
    const bool lastseg = (t0 + 64 == SEQ);
#pragma unroll
    for (int j = 0; j < 8; ++j) { float a[8], o[8], od[8]; unpack8(raw[j + W - 1], a); unpack8(raw[j], od);
        const int t = tb + j; const float inv = 1.f / (float)(t + 1 < W ? t + 1 : W);
#pragma unroll
        for (int i = 0; i < 8; ++i) { S[i] += a[i]; o[i] = S[i] * inv - a[i]; S[i] -= od[i]; }
        *(v4u*)(ob + j * DP) = pack8(o);
        if (lastseg && t >= SEQ - 15) { float* np = newp + ((size_t)seq * 15 + (t - (SEQ - 15))) * GW + c0; *(f32x4*)np = (f32x4){a[0], a[1], a[2], a[3]}; *(f32x4*)(np + 4) = (f32x4){a[4], a[5], a[6], a[7]}; }
    }
}
__device__ __forceinline__ void short_unit_p(const bf16* __restrict__ Z, bf16* __restrict__ CAT, float* __restrict__ news, const float* __restrict__ sw, int seq, int t0, int h, int lane) {
    const int rr = lane >> 3, cg = lane & 7, c0 = h * 64 + cg * 8, tb = t0 + rr * 8;
    const size_t rowbase = (size_t)seq * SEQ;
    const bf16* zb = Z + (rowbase + tb) * ZP + c0;
    v4u Bv[8], Cv[10], Hv[10];
#pragma unroll
    for (int j = 0; j < 10; ++j) { const int dj = j - 2; const bool ok = (tb + dj >= 0);
        Cv[j] = ok ? ld16(zb + (long)dj * ZP + 1536) : (v4u){0u, 0u, 0u, 0u}; Hv[j] = ok ? ld16(zb + (long)dj * ZP + 1792) : (v4u){0u, 0u, 0u, 0u};
        if (j >= 2) Bv[j - 2] = ld16(zb + (long)dj * ZP + 1280); }
    float w0[8], w1[8], w2[8];
#pragma unroll
    for (int i = 0; i < 8; ++i) { w0[i] = sw[c0 + i]; w1[i] = sw[GW + c0 + i]; w2[i] = sw[2 * GW + c0 + i]; }
    float e2[8], e1[8];
    { float c[8], hh[8]; unpack8(Cv[0], c); unpack8(Hv[0], hh);
#pragma unroll
      for (int i = 0; i < 8; ++i) e2[i] = c[i] * hh[i];
      unpack8(Cv[1], c); unpack8(Hv[1], hh);
#pragma unroll
      for (int i = 0; i < 8; ++i) e1[i] = c[i] * hh[i]; }
    bf16* ob = CAT + (rowbase + tb) * DP + 768 + c0;
#pragma unroll
    for (int j = 0; j < 8; ++j) { float c[8], hh[8], b[8], o[8]; unpack8(Cv[j + 2], c); unpack8(Hv[j + 2], hh); unpack8(Bv[j], b);
#pragma unroll
        for (int i = 0; i < 8; ++i) { const float e0 = c[i] * hh[i]; o[i] = b[i] * (w0[i] * e2[i] + w1[i] * e1[i] + w2[i] * e0); e2[i] = e1[i]; e1[i] = e0; }
        *(v4u*)(ob + j * DP) = pack8(o); }
    if (t0 + 64 == SEQ && rr == 7) { float* np = news + (size_t)seq * 2 * GW + c0;
        *(f32x4*)np = (f32x4){e2[0], e2[1], e2[2], e2[3]}; *(f32x4*)(np + 4) = (f32x4){e2[4], e2[5], e2[6], e2[7]};
        *(f32x4*)(np + GW) = (f32x4){e1[0], e1[1], e1[2], e1[3]}; *(f32x4*)(np + GW + 4) = (f32x4){e1[4], e1[5], e1[6], e1[7]}; }
}
__device__ __forceinline__ void conv_unit_p(const bf16* __restrict__ Z, bf16* __restrict__ CAT, float* __restrict__ newc,
                                            const float* __restrict__ cw, const float* __restrict__ cb, const float* __restrict__ lg, const float* __restrict__ lb,
                                            int seq, int t0, int h, LAS float* gL, int lane) {
    const int rr = lane >> 3, cg = lane & 7, c0 = h * 64 + cg * 8;
    const size_t rowbase = (size_t)seq * SEQ;
    const bool last = (t0 + 32 == SEQ);
    const int c = h * 64 + lane;
    float wk[31];
#pragma unroll
    for (int k = 0; k < 31; ++k) wk[k] = cw[k * GW + c];
    const float bias = cb[c];
    { v4u pv[8], gv[8];
#pragma unroll
      for (int j = 0; j < 8; ++j) { const int r = 8 * j + rr, sx = t0 - 30 + r; const bool ok = (sx >= 0 && r < 62);
          const bf16* zp = Z + (rowbase + (ok ? sx : 0)) * ZP + c0;
          pv[j] = ok ? ld16(zp + 256) : (v4u){0u, 0u, 0u, 0u}; gv[j] = ok ? ld16(zp + 512) : (v4u){0u, 0u, 0u, 0u}; }
#pragma unroll
      for (int j = 0; j < 8; ++j) { const int r = 8 * j + rr, sx = t0 - 30 + r; float p[8], gt[8]; unpack8(pv[j], p); unpack8(gv[j], gt);
#pragma unroll
          for (int i = 0; i < 8; ++i) p[i] = p[i] * sigm(gt[i]);
          if (r < 62) { *(LAS f32x4*)(gL + r * 64 + cg * 8) = (f32x4){p[0], p[1], p[2], p[3]}; *(LAS f32x4*)(gL + r * 64 + cg * 8 + 4) = (f32x4){p[4], p[5], p[6], p[7]}; }
          if (last && sx >= SEQ - 30 && r < 62) { float* np = newc + ((size_t)seq * 30 + (sx - (SEQ - 30))) * GW + c0; *(f32x4*)np = (f32x4){p[0], p[1], p[2], p[3]}; *(f32x4*)(np + 4) = (f32x4){p[4], p[5], p[6], p[7]}; } }
    }
    LDS_WAIT();
#pragma unroll 1
    for (int tq = 0; tq < 32; tq += 4) {
        float acc[4] = {bias, bias, bias, bias};
#pragma unroll
        for (int r = 0; r < 34; ++r) { const float gvv = gL[(tq + r) * 64 + lane];
#pragma unroll
            for (int q = 0; q < 4; ++q) { const int k = r - q; if (k >= 0 && k <= 30) acc[q] += wk[k] * gvv; } }
        LDS_WAIT();
#pragma unroll
        for (int q = 0; q < 4; ++q) gL[(tq + q) * 64 + lane] = acc[q];
    }
    LDS_WAIT();
    float gg[8], bb[8];
#pragma unroll
    for (int i = 0; i < 8; ++i) { gg[i] = lg[c0 + i]; bb[i] = lb[c0 + i]; }
    bf16* ob = CAT + (rowbase + t0) * DP + 256 + c0;
#pragma unroll
    for (int j = 0; j < 4; ++j) { const int r = 8 * j + rr; const f32x4 a = *(const LAS f32x4*)(gL + r * 64 + cg * 8), b = *(const LAS f32x4*)(gL + r * 64 + cg * 8 + 4);
        float x[8] = {a[0], a[1], a[2], a[3], b[0], b[1], b[2], b[3]};
        const float mean = sum8(((x[0] + x[1]) + (x[2] + x[3])) + ((x[4] + x[5]) + (x[6] + x[7]))) * (1.f / 64.f);
        float q = 0.f;
#pragma unroll
        for (int i = 0; i < 8; ++i) { x[i] -= mean; q += x[i] * x[i]; }
        const float rstd = rsqrtf(sum8(q) * (1.f / 64.f) + EPS);
#pragma unroll
        for (int i = 0; i < 8; ++i) { const float yy = x[i] * rstd * gg[i] + bb[i]; x[i] = yy * sigm(yy); }
        *(v4u*)(ob + r * DP) = pack8(x); }
    LDS_WAIT();
}
__device__ __forceinline__ int sgu_swz(int c, int chunk) { return (chunk ^ ((c & 15) ^ (c >> 4))) << 3; }
__device__ __forceinline__ void sgu_unit(const bf16* __restrict__ Z, bf16* __restrict__ CAT, const bf16* __restrict__ Wb, const float* __restrict__ lg, const float* __restrict__ lb,
                                         const float* __restrict__ sb, int chunk, int h, LAS bf16* vT, int lane) {
    const size_t r0 = (size_t)chunk * 128;
    const int fr = lane & 15, fq = lane >> 4;
    bf16x8 wf[8][4];
#pragma unroll
    for (int mt = 0; mt < 8; ++mt)
#pragma unroll
        for (int ks = 0; ks < 4; ++ks) if (ks * 32 <= mt * 16 + 15) wf[mt][ks] = *(const bf16x8*)(Wb + ((size_t)(h * 128 + mt * 16 + fr) * 128 + ks * 32 + fq * 8));
    { const int rr = lane >> 3, cg = lane & 7, c0 = h * 64 + cg * 8;
      float gg[8], bb[8];
#pragma unroll
      for (int i = 0; i < 8; ++i) { gg[i] = lg[c0 + i]; bb[i] = lb[c0 + i]; }
#pragma unroll 1
      for (int jh = 0; jh < 16; jh += 8) {
          v4u raw[8];
#pragma unroll
          for (int j = 0; j < 8; ++j) raw[j] = ld16(Z + (r0 + 8 * (jh + j) + rr) * ZP + 1024 + c0);
#pragma unroll
          for (int j = 0; j < 8; ++j) { float x[8]; unpack8(raw[j], x);
              float sm = ((x[0] + x[1]) + (x[2] + x[3])) + ((x[4] + x[5]) + (x[6] + x[7])); const float mean = sum8(sm) * (1.f / 64.f);
              float q = 0.f;
#pragma unroll
              for (int i = 0; i < 8; ++i) { x[i] -= mean; q += x[i] * x[i]; }
              const float rstd = rsqrtf(sum8(q) * (1.f / 64.f) + EPS);
#pragma unroll
              for (int i = 0; i < 8; ++i) { const int cl = cg * 8 + i; vT[cl * 128 + sgu_swz(cl, jh + j) + rr] = (bf16)f2bf(x[i] * rstd * gg[i] + bb[i]); } }
      }
    }
    LDS_WAIT();
#pragma unroll
    for (int mt = 0; mt < 8; ++mt) {
        f32x4 acc[4];
#pragma unroll
        for (int nt = 0; nt < 4; ++nt) acc[nt] = (f32x4){0.f, 0.f, 0.f, 0.f};
        const int t = mt * 16 + fr;
        v2u uv[4];
#pragma unroll
        for (int nt = 0; nt < 4; ++nt) uv[nt] = *(const v2u*)(Z + (r0 + t) * ZP + 768 + h * 64 + nt * 16 + 4 * fq);
        const float bt = sb[h * 128 + t];
#pragma unroll
        for (int ks = 0; ks < 4; ++ks) if (ks * 32 <= mt * 16 + 15) {
#pragma unroll
            for (int nt = 0; nt < 4; ++nt) { const int cl = nt * 16 + fr; const bf16x8 vf = *(const LAS bf16x8*)(vT + cl * 128 + sgu_swz(cl, ks * 4 + fq));
                acc[nt] = __builtin_amdgcn_mfma_f32_16x16x32_bf16(vf, wf[mt][ks], acc[nt], 0, 0, 0); }
        }
#pragma unroll
        for (int nt = 0; nt < 4; ++nt) { const float u0 = __uint_as_float(uv[nt].x << 16), u1 = __uint_as_float(uv[nt].x & 0xffff0000u), u2 = __uint_as_float(uv[nt].y << 16), u3 = __uint_as_float(uv[nt].y & 0xffff0000u);
            v2u w; w.x = pg8::cvt_pk_bf16(u0 * (acc[nt][0] + bt), u1 * (acc[nt][1] + bt)); w.y = pg8::cvt_pk_bf16(u2 * (acc[nt][2] + bt), u3 * (acc[nt][3] + bt));
            *(v2u*)(CAT + (r0 + t) * DP + 512 + h * 64 + nt * 16 + 4 * fq) = w; }
    }
    LDS_WAIT();
}
__device__ __forceinline__ void sgu_sample_unit(const bf16* __restrict__ Z, bf16* __restrict__ CAT, const float* __restrict__ Wf, const float* __restrict__ lg, const float* __restrict__ lb,
                                                const float* __restrict__ sb, float* __restrict__ vout, int seq, int h, int lane) {
    const int c = h * 64 + lane; const size_t rowbase = (size_t)MP + (size_t)seq * ST;
    const float gg = lg[c], bb = lb[c];
    float vn[ST];
#pragma unroll
    for (int t = 0; t < ST; ++t) { const float v = bf2f(Z[(rowbase + t) * ZP + 1024 + c]); const float mean = wave_sum(v) * (1.f / 64.f); const float d = v - mean; const float var = wave_sum(d * d) * (1.f / 64.f);
        vn[t] = d * rsqrtf(var + EPS) * gg + bb; vout[((size_t)seq * ST + t) * GW + c] = vn[t]; }
#pragma unroll
    for (int t = 0; t < ST; ++t) { float sv = sb[h * 128 + t];
#pragma unroll
        for (int s = 0; s <= t; ++s) sv += Wf[((size_t)h * 128 + t) * 128 + s] * vn[s];
        const float u = bf2f(Z[(rowbase + t) * ZP + 768 + c]);
        CAT[(rowbase + t) * DP + 512 + c] = (bf16)f2bf(u * sv); }
}

#define XB_TMO      128
#define XB_XCNT(j)  (256  + 64 * (j))
#define XB_XSUB(j)  (1280 + 64 * (j))
#define XB_XGEN(j)  (2304 + 64 * (j))
#define XB_TOP      3328
#define XB_TOPGEN   3392
#define XCD_BAR_WORDS 3456
#define XB_SPIN_CAP (1u << 18)

__device__ __forceinline__ unsigned xb_ld(unsigned* p)              { return __hip_atomic_load(p, __ATOMIC_RELAXED, __HIP_MEMORY_SCOPE_AGENT); }
__device__ __forceinline__ unsigned xb_add(unsigned* p, unsigned v) { return __hip_atomic_fetch_add(p, v, __ATOMIC_RELAXED, __HIP_MEMORY_SCOPE_AGENT); }
__device__ __forceinline__ unsigned xb_xcc_id() { return (unsigned)__builtin_amdgcn_s_getreg((3 << 11) | 20) & 0xFu; }
#define XB_SPIN(cond, bar) do { unsigned _sp = 0; while (cond) { __builtin_amdgcn_s_sleep(1); \
    if ((++_sp & 255u) == 0u) { if (xb_ld(&(bar)[XB_TMO])) break; if (_sp > XB_SPIN_CAP) { atomicAdd(&(bar)[XB_TMO], 1u); break; } } } } while (0)

struct XcdBarrier {
    unsigned* bar; unsigned x;
    volatile LAS unsigned* st;
};

__device__ __forceinline__ XcdBarrier xcd_barrier_post(unsigned* bar, volatile LAS unsigned* st) {
    XcdBarrier b; b.bar = bar; b.x = xb_xcc_id(); b.st = st;
    if (threadIdx.x == 0) (void)xb_add(&bar[XB_XCNT(b.x)], 1u);
    return b;
}
__device__ __forceinline__ void xcd_barrier_complete(unsigned* bar, unsigned x, unsigned& nloc, unsigned& nx) {
    const unsigned G = gridDim.x * gridDim.y * gridDim.z;
    unsigned sum, cnt, mine, sp = 0u;
    for (;;) {
        sum = 0u; cnt = 0u; mine = 0u;
#pragma unroll
        for (unsigned j = 0; j < 16; ++j) { const unsigned c = xb_ld(&bar[XB_XCNT(j)]); sum += c; cnt += (c > 0u) ? 1u : 0u; mine = (j == x) ? c : mine; }
        if (sum == G) break;
        __builtin_amdgcn_s_sleep(1);
        if ((++sp & 255u) == 0u) { if (xb_ld(&bar[XB_TMO])) break; if (sp > XB_SPIN_CAP) { atomicAdd(&bar[XB_TMO], 1u); break; } }
    }
    nloc = mine > 0u ? mine : 1u; nx = cnt > 0u ? cnt : 1u;
}

__device__ __forceinline__ void xcd_barrier(const XcdBarrier& b) {
    asm volatile("s_waitcnt vmcnt(0)" ::: "memory");
    __syncthreads();
    if (threadIdx.x == 0) {
        unsigned* bar = b.bar;
        __builtin_amdgcn_s_waitcnt(0);
        unsigned nloc = b.st[0], nx = b.st[1];
        if (nloc == 0u) { xcd_barrier_complete(bar, b.x, nloc, nx); b.st[0] = nloc; b.st[1] = nx; }
        const unsigned old = xb_add(&bar[XB_XSUB(b.x)], 1u);
        const unsigned gen = old / nloc;
        if (old + 1u == (gen + 1u) * nloc) {
            __builtin_amdgcn_fence(__ATOMIC_RELEASE, "agent");
            asm volatile("s_waitcnt vmcnt(0)" ::: "memory");
            const unsigned og = xb_add(&bar[XB_TOP], 1u);
            const unsigned tg = og / nx;
            if (og + 1u == (tg + 1u) * nx) xb_add(&bar[XB_TOPGEN], 1u);
            else XB_SPIN(xb_ld(&bar[XB_TOPGEN]) == tg, bar);
            __builtin_amdgcn_fence(__ATOMIC_ACQUIRE, "agent");
            xb_add(&bar[XB_XGEN(b.x)], 1u);
            asm volatile("s_waitcnt vmcnt(0)" ::: "memory");
        } else {
            XB_SPIN(xb_ld(&bar[XB_XGEN(b.x)]) == gen, bar);
            __builtin_amdgcn_fence(__ATOMIC_ACQUIRE, "agent");
            asm volatile("s_waitcnt vmcnt(0)" ::: "memory");
        }
    }
    __syncthreads();
}

#define GB_CNT(x)  (8192 + 64 * (x))
#define GB_MASK(x) (9216 + 64 * (x))
__device__ __forceinline__ void group_barrier(unsigned* ctl, int x, unsigned target, bool coloc) {
    asm volatile("s_waitcnt vmcnt(0)" ::: "memory");
    __syncthreads();
    if (threadIdx.x == 0) {
        if (!coloc) { __builtin_amdgcn_fence(__ATOMIC_RELEASE, "agent"); asm volatile("s_waitcnt vmcnt(0)" ::: "memory"); }
        (void)xb_add(&ctl[GB_CNT(x)], 1u);
        XB_SPIN(xb_ld(&ctl[GB_CNT(x)]) < target, ctl);
        __builtin_amdgcn_fence(__ATOMIC_ACQUIRE, "agent");
        asm volatile("s_waitcnt vmcnt(0)" ::: "memory");
    }
    __syncthreads();
}

template <int NT, int ACT, int K>
__device__ __forceinline__ void small_gemm_tile(LAS unsigned char* lds, const bf16* __restrict__ A, const bf16* __restrict__ Bt, bf16* __restrict__ O, int ldc, int lda, int ldb, const float* __restrict__ rs, int m0, int n0, int tid) {
    constexpr int NC = 16 * NT, KW = K / 8, NCH = KW / 128;
    const int wave = __builtin_amdgcn_readfirstlane(tid >> 6), lane = tid & 63, fr = lane & 15, fq = lane >> 4;
    const bf16* ap = A + (size_t)(m0 + fr) * lda + wave * KW + fq * 8;
    const bf16* bp = Bt + (size_t)(n0 + fr) * ldb + wave * KW + fq * 8;
    f32x4 acc[4][NT];
#pragma unroll
    for (int m = 0; m < 4; ++m)
#pragma unroll
        for (int n = 0; n < NT; ++n) acc[m][n] = (f32x4){0.f, 0.f, 0.f, 0.f};
    if constexpr (NCH == 1) {
        bf16x8 fa[4][4], fb[4][NT];
#pragma unroll
        for (int s_ = 0; s_ < 4; ++s_) {
#pragma unroll
            for (int m = 0; m < 4; ++m) fa[s_][m] = *(const bf16x8*)(ap + (size_t)m * 16 * lda + s_ * 32);
#pragma unroll
            for (int n = 0; n < NT; ++n) fb[s_][n] = *(const bf16x8*)(bp + (size_t)n * 16 * ldb + s_ * 32); }
        __builtin_amdgcn_sched_barrier(0);
#pragma unroll
        for (int s_ = 0; s_ < 4; ++s_)
#pragma unroll
            for (int m = 0; m < 4; ++m)
#pragma unroll
                for (int n = 0; n < NT; ++n) acc[m][n] = __builtin_amdgcn_mfma_f32_16x16x32_bf16(fa[s_][m], fb[s_][n], acc[m][n], 0, 0, 0);
        __builtin_amdgcn_sched_barrier(0);
    } else {
        constexpr int NC2 = KW / 64;
        bf16x8 fa[3][2][4], fb[3][2][NT];
#define SG_LD(buf, c) do { _Pragma("unroll") for (int s_ = 0; s_ < 2; ++s_) { \
            _Pragma("unroll") for (int m = 0; m < 4; ++m) fa[buf][s_][m] = *(const bf16x8*)(ap + (size_t)m * 16 * lda + (c) * 64 + s_ * 32); \
            _Pragma("unroll") for (int n = 0; n < NT; ++n) fb[buf][s_][n] = *(const bf16x8*)(bp + (size_t)n * 16 * ldb + (c) * 64 + s_ * 32); } } while (0)
        SG_LD(0, 0); SG_LD(1, 1);
        __builtin_amdgcn_sched_barrier(0);
#pragma unroll
        for (int c = 0; c < NC2; ++c) {
            if (c + 2 < NC2) SG_LD((c + 2) % 3, c + 2);
            __builtin_amdgcn_sched_barrier(0);
#pragma unroll
            for (int s_ = 0; s_ < 2; ++s_)
#pragma unroll
                for (int m = 0; m < 4; ++m)
#pragma unroll
                    for (int n = 0; n < NT; ++n) acc[m][n] = __builtin_amdgcn_mfma_f32_16x16x32_bf16(fa[c % 3][s_][m], fb[c % 3][s_][n], acc[m][n], 0, 0, 0);
            __builtin_amdgcn_sched_barrier(0);
        }
#undef SG_LD
    }
    LAS float* P = (LAS float*)lds + wave * (64 * NC);
#pragma unroll
    for (int m = 0; m < 4; ++m)
#pragma unroll
        for (int n = 0; n < NT; ++n)
#pragma unroll
            for (int i = 0; i < 4; ++i) P[(m * 16 + fq * 4 + i) * NC + n * 16 + fr] = acc[m][n][i];
    __syncthreads();
    constexpr int EPT = 64 * NC / 512;
    const int e0 = tid * EPT, row = e0 / NC, col = e0 % NC;
    float r[EPT];
#pragma unroll
    for (int j = 0; j < EPT; ++j) r[j] = 0.f;
#pragma unroll
    for (int w = 0; w < 8; ++w) { const LAS f32x4* q = (const LAS f32x4*)((LAS float*)lds + w * (64 * NC) + e0);
#pragma unroll
        for (int j = 0; j < EPT / 4; ++j) { const f32x4 v = q[j]; r[4 * j] += v[0]; r[4 * j + 1] += v[1]; r[4 * j + 2] += v[2]; r[4 * j + 3] += v[3]; } }
    if (rs) { const float sc = rs[m0 + row];
#pragma unroll
        for (int j = 0; j < EPT; ++j) r[j] *= sc; }
    if (ACT == 1) {
#pragma unroll
        for (int j = 0; j < EPT; ++j) { const float t = fmaxf(r[j], 0.f); r[j] = t * t; } }
    bf16* op = O + (size_t)(m0 + row) * ldc + n0 + col;
    if (EPT == 8) { v4u w; w.x = pk2(r[0], r[1]); w.y = pk2(r[2], r[3]); w.z = pk2(r[4 % EPT], r[5 % EPT]); w.w = pk2(r[6 % EPT], r[7 % EPT]); *(v4u*)op = w; }
    else { v2u w; w.x = pk2(r[0], r[1]); w.y = pk2(r[2], r[3]); *(v2u*)op = w; }
    __syncthreads();
}

#define SMALL_TN(j, ntn) (((j) >> 8) * 32 + (((j) >> 3) & 31))
constexpr int NPH = 15;
#ifndef REP_PRO
#define REP_PRO 1
#endif
#ifndef REP_GEMM
#define REP_GEMM 1
#endif
#ifndef REP_MIX
#define REP_MIX 1
#endif
#ifndef REP_SYNC
#define REP_SYNC 1
#endif
struct Args { const float* in[24]; float* out; unsigned char* ws; int ph_lo, ph_hi; };
__global__ void __launch_bounds__(NWAVES * 64, 2) hybrid_fwd(Args args) {
    extern __shared__ __attribute__((aligned(16))) unsigned char lds_raw[];
    LAS unsigned char* lds = (LAS unsigned char*)lds_raw;
    volatile LAS unsigned* MISC = (volatile LAS unsigned*)(lds + MISC_OFF);
    if (threadIdx.x < 64) MISC[threadIdx.x] = 0u;
    __syncthreads();
    (void)xcd_barrier_post((unsigned*)(args.ws + WS_CTL), MISC + 8);
    if (threadIdx.x == 0) atomicOr((unsigned*)(args.ws + WS_CTL) + GB_MASK(blockIdx.x & 7), 1u << xb_xcc_id());
    unsigned gbn = 0;
    for (int ph = args.ph_lo; ph < args.ph_hi;) {
        int tid = threadIdx.x; asm volatile("" : "+v"(tid));
        const int lane = tid & 63, wave = __builtin_amdgcn_readfirstlane(tid >> 6);
        const int G = gridDim.x; const int bx = blockIdx.x;
        unsigned char* ws = args.ws;
        if (ph == 0) {
            const int vcu = (G % 8 == 0) ? (bx % 8) * (G / 8) + bx / 8 : bx; const int gw = vcu * NWAVES + wave, NGW = G * NWAVES;
            LAS float* scr = (LAS float*)(lds + wave * WAVE_SCR);
            bf16* XN = (bf16*)(ws + WS_XN); bf16* SGW = (bf16*)(ws + WS_SGUW);
            constexpr int I_FOLD = 4 * (DM / 32), I_OUT = (DM / 64) * (DM / 32) - I_FOLD, I_IN = (DM / 64) * (INW / 32), I_UP = (DM / 64) * (FF / 32), I_DN = (FF / 64) * (DM / 32);
            constexpr int I_LAYER = I_OUT + I_IN + I_UP + I_DN, I_ALL = DEPTH * I_LAYER;
            const int gwf = (NGW == 2048) ? (wave < 4 ? vcu * 4 + wave : 1024 + vcu * 4 + (wave - 4)) : gw;
            for (int it = gwf; it < DEPTH * I_FOLD * 4; it += NGW) { const int l = it / (I_FOLD * 4), r = it % (I_FOLD * 4);
                fold_item(args.in[10] + (size_t)l * DM * DM, (bf16*)(ws + WS_W + (size_t)l * W_LAYER + W_OUT), args.in[11] + (size_t)l * 4 * 64 * 64, args.in[12] + (size_t)l * GW, scr, r, lane); }
#define TR_DECODE(it_, d_) do { const int l_ = (it_) / I_LAYER; int r_ = (it_) % I_LAYER; unsigned char* wl_ = ws + WS_W + (size_t)l_ * W_LAYER; int nblk_; \
                if (r_ < I_OUT) { r_ += I_FOLD; d_.W = args.in[10] + (size_t)l_ * DM * DM; d_.WT = (bf16*)(wl_ + W_OUT); d_.gk = nullptr; d_.K = DM; d_.N = DM; } \
                else if ((r_ -= I_OUT) < I_IN) { d_.W = args.in[9] + (size_t)l_ * DM * INW; d_.WT = (bf16*)(wl_ + W_IN); d_.gk = args.in[5] + (size_t)l_ * DM; d_.K = DM; d_.N = INW; } \
                else if ((r_ -= I_IN) < I_UP) { d_.W = args.in[22] + (size_t)l_ * DM * FF; d_.WT = (bf16*)(wl_ + W_UP); d_.gk = args.in[7] + (size_t)l_ * DM; d_.K = DM; d_.N = FF; } \
                else { r_ -= I_UP; d_.W = args.in[23] + (size_t)l_ * FF * DM; d_.WT = (bf16*)(wl_ + W_DN); d_.gk = nullptr; d_.K = FF; d_.N = DM; } \
                nblk_ = d_.N / 32; d_.k0 = 64 * (r_ / nblk_); d_.n0 = 32 * (r_ % nblk_); } while (0)
            { const int TSTEP = NGW; int it = NGW - 1 - gwf;
              if (it >= 0 && it < I_ALL) {
                TrDesc d0, d1, d2; TR_DECODE(it, d0);
                float va[32], vb[32], vc[32];
                tr_load(va, d0, lane);
                { const int q = it + TSTEP < I_ALL ? it + TSTEP : it; TR_DECODE(q, d1); }
                tr_load(vb, d1, lane);
#pragma unroll 1
                for (; it < I_ALL; it += TSTEP) {
                    { const int q = it + 2 * TSTEP < I_ALL ? it + 2 * TSTEP : it; TR_DECODE(q, d2); }
                    tr_load(vc, d2, lane);
                    tr_store(va, d0, scr, lane);
#pragma unroll
                    for (int i = 0; i < 32; ++i) { va[i] = vb[i]; vb[i] = vc[i]; }
                    d0 = d1; d1 = d2;
                }
              }
            }
#undef TR_DECODE
#define X_SRC(m) ((m) < MP ? args.in[0] + (size_t)(m) * DM : args.in[1] + (size_t)((m) - MP) * DM)
            { const bool aff = false; const int x = vcu >> 5, wl = (vcu & 31) * NWAVES + wave;
              const int nk = aff ? 8 + (wl < 64 ? 1 : 0) : (gw < MT ? (MT - gw + NGW - 1) / NGW : 0);
#define PR_ROW(k) (aff ? ((k) < 8 ? 2048 * x + 256 * (k) + wl : MP + 64 * x + wl) : gw + (k) * NGW)
              if (nk > 0) { XRow x0, x1, x2;
                { const int ma = PR_ROW(0); xrow_load(x0, X_SRC(ma), lane); }
                { const int kb = 1 < nk ? 1 : 0; const int mb = PR_ROW(kb); xrow_load(x1, X_SRC(mb), lane); }
#pragma unroll 1
                for (int k = 0; k < nk; ++k) {
                    { const int kc = k + 2 < nk ? k + 2 : k; const int mc = PR_ROW(kc); xrow_load(x2, X_SRC(mc), lane); }
                    const int m = PR_ROW(k);
                    xrow_finish(x0, (bf16*)args.out + (size_t)m * 2 * DM, (float*)(ws + WS_RS) + m, lane);
                    x0 = x1; x1 = x2;
                } }
#undef PR_ROW
            }
#undef X_SRC

            for (int e = bx * (NWAVES * 64) + tid; e < DEPTH * 4 * 128 * 128; e += G * NWAVES * 64) { const int t = (e >> 7) & 127, s = e & 127; SGW[e] = (bf16)(s <= t ? f2bf(args.in[19][e]) : 0u); }
        } else {
            const int l = (ph - 1) / 7, k = (ph - 1) - 7 * l;
            unsigned char* wl = ws + WS_W + (size_t)l * W_LAYER;
            if (k == 0 || k == 2 || k == 5) {
                const bf16* A = k == 0 ? (const bf16*)args.out : (const bf16*)(ws + (k == 2 ? WS_CAT : WS_H));
                const bf16* Bt = (const bf16*)(wl + (k == 0 ? W_IN : k == 2 ? W_OUT : W_DN));
                bf16* O = (bf16*)(ws + (k == 0 ? WS_Z : WS_O));
                const int N = k == 0 ? INW : DM, K = k == 5 ? FF : DM;
                pg8::Gemm g{A, Bt, MP, N, K, k == 5 ? FP : k == 0 ? 2 * DM : DP, K + WPAD}; pg8::StaticOrder S; S.init(MP, N, G, bx);
                pg8::EpiBf16<0> E{O, k == 0 ? ZP : OP, k == 0 ? (const float*)(ws + WS_RS) : nullptr};
                pg8::gemm_phase<pg8::EpiBf16<0>, pg8::StaticOrder, true, true>(lds, g, S, E, tid);
                if (k == 0) { for (int j = bx; j < (MS / 64) * (INW / 64); j += G) small_gemm_tile<4, 0, DM>(lds, A, Bt, O, ZP, 2 * DM, DM + WPAD, (const float*)(ws + WS_RS), MP + (j & 7) * 64, SMALL_TN(j, INW / 64) * 64, tid); }
                else { for (int j = bx; j < (MS / 64) * (DM / 32); j += G) { if (k == 2) small_gemm_tile<2, 0, DM>(lds, A, Bt, O, OP, DP, DM + WPAD, nullptr, MP + (j & 7) * 64, SMALL_TN(j, DM / 32) * 32, tid); else small_gemm_tile<2, 0, FF>(lds, A, Bt, O, OP, FP, FF + WPAD, nullptr, MP + (j & 7) * 64, SMALL_TN(j, DM / 32) * 32, tid); } }
            } else if (k == 4) {
                pg8::Gemm g{(const bf16*)args.out, (const bf16*)(wl + W_UP), MP, FF, DM, 2 * DM, DM + WPAD}; pg8::StaticOrder S; S.init(MP, FF, G, bx);
                pg8::EpiBf16<1> E{(bf16*)(ws + WS_H), FP, (const float*)(ws + WS_RS)};
                pg8::gemm_phase<pg8::EpiBf16<1>, pg8::StaticOrder, true, true>(lds, g, S, E, tid);
                for (int j = bx; j < (MS / 64) * (FF / 64); j += G) small_gemm_tile<4, 1, DM>(lds, (const bf16*)args.out, (const bf16*)(wl + W_UP), (bf16*)(ws + WS_H), FP, 2 * DM, DM + WPAD, (const float*)(ws + WS_RS), MP + (j & 7) * 64, SMALL_TN(j, FF / 64) * 64, tid);
            } else if (k == 1) {
                const int vcu = (G % 8 == 0) ? (bx % 8) * (G / 8) + bx / 8 : bx; const int NGW = G * NWAVES;
                const int gw = (NGW == 2048) ? (wave < 2 ? vcu * 2 + wave : 512 + vcu * 6 + (wave - 2)) : vcu * NWAVES + wave;
                LAS float* scr = (LAS float*)(lds + wave * WAVE_SCR);
                const bf16* ZB = (const bf16*)(ws + WS_Z); bf16* CAT = (bf16*)(ws + WS_CAT); const bf16* SGW = (const bf16*)(ws + WS_SGUW) + (size_t)l * 4 * 128 * 128;
                float* out = args.out;
                constexpr int NU_SGU = 512, NU_CONV = 2048, NU_SEG = 1024, NU_SMP = 2048, NU = NU_SGU + NU_CONV + 2 * NU_SEG + NU_SMP;
#pragma unroll 1
                for (int ui = 0; ; ++ui) {
                    int u;
                    if (NGW != 2048) { u = ui * NGW + gw; if (u >= NU) break; }
                    else { if (ui >= 4) break;
                        const int x = vcu >> 5, cl_ = vcu & 31;
                        if (wave < 2) { const int a_l = cl_ * 2 + wave; if (ui == 0) u = 64 * x + a_l; else if (ui == 1) u = NU_SGU + 256 * x + 192 + a_l; else break; }
                        else { const int b_l = cl_ * 6 + (wave - 2);
                            if (ui == 0) u = NU_SGU + 256 * x + b_l;
                            else { const int ll = (ui - 1) * 192 + b_l; if (ll >= 512) break;
                                if (ll < 128) u = NU_SGU + NU_CONV + 128 * x + ll; else if (ll < 256) u = NU_SGU + NU_CONV + NU_SEG + 128 * x + (ll - 128); else { const int ls = ll - 256; u = NU_SGU + NU_CONV + 2 * NU_SEG + (ls >> 6) * 512 + (16 * x + ((ls >> 2) & 15)) * 4 + (ls & 3); } } } }
                    int lane = tid & 63; asm volatile("" : "+v"(lane));
                    if (u < NU_SGU) { sgu_unit(ZB, CAT, SGW, args.in[17] + (size_t)l * GW, args.in[18] + (size_t)l * GW, args.in[20] + (size_t)l * 4 * 128, u >> 2, u & 3, (LAS bf16*)scr, lane); continue; }
                    int r = u - NU_SGU;
                    if (r < NU_CONV) { const int seg = r >> 2, h = r & 3, seq = seg >> 6, t0 = (seg & 63) * 32;
                        conv_unit_p(ZB, CAT, out + OUT_CONV_P + (size_t)l * NBP * 30 * GW, args.in[13] + (size_t)l * 31 * GW, args.in[14] + (size_t)l * GW, args.in[15] + (size_t)l * GW, args.in[16] + (size_t)l * GW, seq, t0, h, scr, lane);
                        continue; }
                    r -= NU_CONV;
                    if (r < 2 * NU_SEG) { const int ty = r / NU_SEG, q = r % NU_SEG, seg = q >> 2, h = q & 3, seq = seg >> 5, t0 = (seg & 31) * 64;
                        if (ty == 0) { float* np = out + OUT_POOL_P + (size_t)l * NBP * 15 * GW;
                            if (h == 0) pool_unit_p<2>(ZB, CAT, np, seq, t0, h, lane); else if (h == 1) pool_unit_p<4>(ZB, CAT, np, seq, t0, h, lane);
                            else if (h == 2) pool_unit_p<8>(ZB, CAT, np, seq, t0, h, lane); else pool_unit_p<16>(ZB, CAT, np, seq, t0, h, lane); }
                        else short_unit_p(ZB, CAT, out + OUT_SHORT_P + (size_t)l * NBP * 2 * GW, args.in[21] + (size_t)l * 3 * GW, seq, t0, h, lane);
                        continue; }
                    r -= 2 * NU_SEG;
                    { const int ty = r >> 9, q = r & 511, seq = q >> 2, h = q & 3;
                        if (ty == 0) conv_unit<true>(ZB, CAT, args.in[3] + (size_t)l * NSB * 30 * GW, out + OUT_CONV_S + (size_t)l * NSB * 30 * GW, args.in[13] + (size_t)l * 31 * GW, args.in[14] + (size_t)l * GW, args.in[15] + (size_t)l * GW, args.in[16] + (size_t)l * GW, seq, 0, ST, h, scr, lane);
                        else if (ty == 1) { const float* sp = args.in[2] + (size_t)l * NSB * 15 * GW; float* np = out + OUT_POOL_S + (size_t)l * NSB * 15 * GW;
                            if (h == 0) pool_sample_unit<2>(ZB, CAT, sp, np, seq, h, lane); else if (h == 1) pool_sample_unit<4>(ZB, CAT, sp, np, seq, h, lane); else if (h == 2) pool_sample_unit<8>(ZB, CAT, sp, np, seq, h, lane); else pool_sample_unit<16>(ZB, CAT, sp, np, seq, h, lane); }
                        else if (ty == 2) short_unit<true>(ZB, CAT, args.in[4] + (size_t)l * NSB * 2 * GW, out + OUT_SHORT_S + (size_t)l * NSB * 2 * GW, args.in[21] + (size_t)l * 3 * GW, seq, 0, ST, h, lane);
                        else sgu_sample_unit(ZB, CAT, args.in[19] + (size_t)l * 4 * 128 * 128, args.in[17] + (size_t)l * GW, args.in[18] + (size_t)l * GW, args.in[20] + (size_t)l * 4 * 128, out + OUT_V_S + (size_t)l * NSB * ST * GW, seq, h, lane); }
                }
            } else {
                const int vcu = (G % 8 == 0) ? (bx % 8) * (G / 8) + bx / 8 : bx; const int gw = vcu * NWAVES + wave, NGW = G * NWAVES;
                const float* g = args.in[k == 3 ? 6 : 8] + (size_t)l * DM;
                float* X = args.out; const bf16* OB = (const bf16*)(ws + WS_O); float* RS = (float*)(ws + WS_RS);
                const bool from_input = (l == 0 && k == 3), write_xn = !(l == DEPTH - 1 && k == 6);
                f32x4 gg[4];
#pragma unroll
                for (int j = 0; j < 4; ++j) gg[j] = ((const f32x4*)g + lane)[64 * j];
                const int m_lo = 0;
#define EW_X32(m) ((m) < MP ? args.in[0] + (size_t)(m) * DM : args.in[1] + (size_t)((m) - MP) * DM)
                bf16* X16 = (bf16*)args.out;
                const bool dst16 = write_xn;
                { const bool aff = (NGW == 2048); const int x = vcu >> 5, wl = (vcu & 31) * NWAVES + wave;
                  const int nk = aff ? 8 + (wl < 64 ? 1 : 0) : (gw < MT ? (MT - gw + NGW - 1) / NGW : 0);
#define EW_ROW(k) (aff ? ((k) < 8 ? 2048 * x + 256 * (k) + wl : MP + 64 * x + wl) : gw + (k) * NGW)
                  if (nk > 0) { EwRow r0, r1, r2;
                    { const int ma = EW_ROW(0); ew_load(r0, X16 + (size_t)ma * 2 * DM, OB + (size_t)ma * OP, lane); }
                    { const int kb = 1 < nk ? 1 : 0; const int mb = EW_ROW(kb); ew_load(r1, X16 + (size_t)mb * 2 * DM, OB + (size_t)mb * OP, lane); }
#pragma unroll 1
                    for (int k = 0; k < nk; ++k) {
                        { const int kc = k + 2 < nk ? k + 2 : k; const int mc = EW_ROW(kc); ew_load(r2, X16 + (size_t)mc * 2 * DM, OB + (size_t)mc * OP, lane); }
                        const int m = EW_ROW(k);
                        ew_finish(r0, gg, X + (size_t)m * DM, X16 + (size_t)m * 2 * DM, dst16, RS + m, write_xn, lane);
                        r0 = r1; r1 = r2;
                    }
                  }
#undef EW_ROW
                }
#undef EW_X32
            }
        }
        ++ph;
        if (ph < args.ph_hi) {
            const int kd = (ph - 2) % 7;
            const bool local = (gridDim.x == 256) && ph >= 2 && kd != 3 && kd != 6;
            if (args.ph_lo < 0) cg::this_grid().sync();
            else if (local) { unsigned* ctl = (unsigned*)(args.ws + WS_CTL); const int x = blockIdx.x & 7; ++gbn;
                const unsigned mk = xb_ld(&ctl[GB_MASK(x)]); group_barrier(ctl, x, 32u * gbn, (mk & (mk - 1u)) == 0u && mk != 0u); }
            else { XcdBarrier b; b.bar = (unsigned*)(args.ws + WS_CTL); b.x = xb_xcc_id(); b.st = (volatile LAS unsigned*)(lds + MISC_OFF) + 8; xcd_barrier(b); }
        }
    }
}

#ifndef MK_N_LAUNCHES
#define MK_N_LAUNCHES 1
#endif
extern "C" void kernel_launch(void* const* d_in, const int* in_sizes, int n_in, void* d_out, int out_size, void* d_ws, size_t ws_size, hipStream_t stream) {
    static int grid = 0;
    if (grid == 0) {
        if (n_in != 24 || (size_t)out_size != OUT_END || ws_size < WS_END) { fprintf(stderr, "kernel_launch: unexpected shapes (n_in %d out %d ws %zu)\n", n_in, out_size, ws_size); grid = -1; return; }
        int dev = 0, cus = 0, per_cu = 0;
        if (hipGetDevice(&dev) != hipSuccess || hipDeviceGetAttribute(&cus, hipDeviceAttributeMultiprocessorCount, dev) != hipSuccess) { grid = -1; return; }
        if (hipFuncSetAttribute((const void*)hybrid_fwd, hipFuncAttributeMaxDynamicSharedMemorySize, LDS_BYTES) != hipSuccess) { fprintf(stderr, "kernel_launch: hipFuncSetAttribute failed\n"); grid = -1; return; }
        if (hipOccupancyMaxActiveBlocksPerMultiprocessor(&per_cu, (const void*)hybrid_fwd, NWAVES * 64, LDS_BYTES) != hipSuccess || per_cu < 1) per_cu = 1;
        (void)hipGetLastError();
        grid = cus * per_cu;
    }
    if (grid < 0) return;
    if (hipMemsetAsync((char*)d_ws + WS_CTL, 0, CTL_ZERO_BYTES, stream) != hipSuccess) { fprintf(stderr, "kernel_launch: hipMemsetAsync failed\n"); return; }
    Args a{};
    for (int i = 0; i < 24; ++i) a.in[i] = (const float*)d_in[i];
    a.out = (float*)d_out; a.ws = (unsigned char*)d_ws;
#if MK_N_LAUNCHES == 1
    a.ph_lo = 0; a.ph_hi = NPH;
    void* kargs[] = {&a};
    hipError_t e = hipLaunchCooperativeKernel((const void*)hybrid_fwd, dim3(grid), dim3(NWAVES * 64), kargs, LDS_BYTES, stream);
    if (e != hipSuccess) fprintf(stderr, "cooperative launch failed: %s (grid %d)\n", hipGetErrorString(e), grid);
#else
    for (int p = 0; p < NPH; ++p) { a.ph_lo = p; a.ph_hi = p + 1; hipLaunchKernelGGL(hybrid_fwd, dim3(grid), dim3(NWAVES * 64), LDS_BYTES, stream, a); }
#endif
}
```

```cpp
#include <hip/hip_runtime.h>
#include <hip/hip_cooperative_groups.h>
#include <cstdio>
#include <cstdint>
namespace pg8 {
#define PG8_LAS __attribute__((address_space(3)))
typedef unsigned short bf16_t;
typedef short bf16x8 __attribute__((ext_vector_type(8)));
typedef float f32x4 __attribute__((ext_vector_type(4)));
typedef unsigned u32x4 __attribute__((ext_vector_type(4)));
constexpr int KPAD = 64;
constexpr int BM = 256, BK = 64, HALF = 128, HTB = HALF * BK * 2  , STAGE_BYTES = 8 * HTB, NXCD = 8, WGM = 1;

__host__ __device__ __forceinline__ int lds_byte(int r, int c) { const int st = (r >> 4) * 2 + (c >> 5), rr = r & 15, cc = c & 31, ob = rr * 64 + cc * 2; return st * 1024 + (ob ^ (((ob >> 9) & 1) << 5)); }
__host__ __device__ __forceinline__ void stage_rc(int b, int& R, int& C) { const int st = b / 1024, sb = b % 1024, swz = sb ^ (((sb >> 9) & 1) << 5); R = (st >> 1) * 16 + swz / 64; C = (st & 1) * 32 + (swz % 64) / 2; }
__host__ __device__ __forceinline__ int perm32(int rho) { const int n = rho >> 4, i = rho & 15; return 8 * (i >> 2) + 4 * n + (i & 3); }

struct Unit { int pm, pn; };
struct Gemm { const bf16_t* A; const bf16_t* Bt; int M, N, K, lda, ldb; };

struct StaticOrder {
    int nM, nN, nwg, G, c;
    __host__ __device__ void init(int M, int N, int G_, int c_) { nM = M / BM; nN = N / BM; nwg = nM * nN; G = G_; c = c_; }
    __host__ __device__ bool next(int i, Unit& u) const {
        const long L = (long)i * G + c; if (L >= nwg) return false;
        int wgid = (int)L; { const int q = nwg / NXCD, r = nwg % NXCD, xcd = wgid % NXCD, off = wgid / NXCD; wgid = (xcd < r ? xcd * (q + 1) : r * (q + 1) + (xcd - r) * q) + off; }
        const int nig = WGM * nN, gid = wgid / nig, fm = gid * WGM, gsz = (nM - fm) < WGM ? (nM - fm) : WGM;
        u.pm = fm + ((wgid % nig) % gsz); u.pn = (wgid % nig) / gsz; return true;
    }
    __device__ __forceinline__ void a_ready(const Unit&) const {}
    __device__ __forceinline__ void done(const Unit&) const {}
};

__device__ __forceinline__ unsigned cvt_pk_bf16(float lo, float hi) { unsigned r; asm volatile("v_cvt_pk_bf16_f32 %0, %1, %2" : "=v"(r) : "v"(lo), "v"(hi)); return r; }
__device__ __forceinline__ float relu_sq(float x) { float r; asm volatile("v_max_f32 %0, 0, %1" : "=v"(r) : "v"(x)); return r * r; }
__device__ __forceinline__ void st16_wt(void* p, u32x4 v) { asm volatile("global_store_dwordx4 %0, %1, off sc1" :: "v"(p), "v"(v) : "memory"); }
template <int ACT  > struct EpiBf16 {
    static constexpr bool PERM = true, AFTER_DRAIN = false;
    bf16_t* O; int ldc; const float* rs;
    __device__ __forceinline__ void operator()(const f32x4 (&acc)[2][2][4][2], const Unit& u, int wr, int wc, int fr, int fq) const {
        const int row0 = u.pm * BM + wr * 64 + fr; const int col0 = u.pn * BM + wc * 32 + 8 * fq;
#pragma unroll
        for (int ai = 0; ai < 2; ++ai)
#pragma unroll
            for (int m = 0; m < 4; ++m) { bf16_t* rowp = O + (size_t)(row0 + ai * HALF + m * 16) * ldc + col0; const float sc = rs ? rs[row0 + ai * HALF + m * 16] : 1.f;
#pragma unroll
                for (int bj = 0; bj < 2; ++bj) { f32x4 v0 = acc[ai][bj][m][0] * sc, v1 = acc[ai][bj][m][1] * sc;
                    if (ACT == 1) {
#pragma unroll
                        for (int e = 0; e < 4; ++e) { v0[e] = relu_sq(v0[e]); v1[e] = relu_sq(v1[e]); } }
                    u32x4 w; w.x = cvt_pk_bf16(v0[0], v0[1]); w.y = cvt_pk_bf16(v0[2], v0[3]); w.z = cvt_pk_bf16(v1[0], v1[1]); w.w = cvt_pk_bf16(v1[2], v1[3]);
                    *(u32x4*)(rowp + bj * HALF) = w; } }
    }
};

template <class Epi, class Sched, bool ALIGN_EPI = false, bool SP2 = false>
__device__ __forceinline__ void gemm_phase(PG8_LAS unsigned char* lds, const Gemm g, const Sched& S, const Epi& E, const int tid) {
    const int wid = __builtin_amdgcn_readfirstlane(tid >> 6), lane = tid & 63, wr = wid >> 2, wc = wid & 3, fr = lane & 15, fq = lane >> 4;
    const int K = g.K, nt = K / BK;
    unsigned voffA[2], voffB[2];
#pragma unroll
    for (int i = 0; i < 2; ++i) { int R, C; stage_rc(tid * 16 + i * 8192, R, C); const int Rb = Epi::PERM ? ((R & ~31) + perm32(R & 31)) : R;
        voffA[i] = (unsigned)(R * g.lda + C) * 2u; voffB[i] = (unsigned)(Rb * g.ldb + C) * 2u; }
    const size_t kstep = (size_t)(BK * 2);
    const size_t hstepA = (size_t)HALF * g.lda * 2, hstepB = (size_t)HALF * g.ldb * 2;
    const size_t tstepA = 2 * hstepA, tstepB = 2 * hstepB;
    const unsigned ldsw = (unsigned)wid * 1024u;
    const int aoff = lds_byte(wr * 64 + fr, fq * 8), boff = lds_byte(wc * 32 + fr, fq * 8);
#define PG8_SA(b, h) (((b) * 2 + (h)) * HTB)
#define PG8_SB(b, h) ((4 + (b) * 2 + (h)) * HTB)
#define PG8_STAGE(bufoff, gbase, voff) do { _Pragma("unroll") for (int _i = 0; _i < 2; ++_i) \
        __builtin_amdgcn_global_load_lds((const unsigned*)((const char*)(gbase) + (voff)[_i]), (PG8_LAS unsigned*)(lds + (bufoff) + ldsw + _i * 8192), 16, 0, 0); } while (0)
#define PG8_LDA(dst, b, h) do { _Pragma("unroll") for (int m = 0; m < 4; ++m) _Pragma("unroll") for (int k = 0; k < 2; ++k) dst[m][k] = *(const PG8_LAS bf16x8*)(lds + PG8_SA(b, h) + aoff + m * 2048 + k * 1024); } while (0)
#define PG8_LDB(dst, b, h) do { _Pragma("unroll") for (int n = 0; n < 2; ++n) _Pragma("unroll") for (int k = 0; k < 2; ++k) dst[n][k] = *(const PG8_LAS bf16x8*)(lds + PG8_SB(b, h) + boff + n * 2048 + k * 1024); } while (0)
#define PG8_MMA(ai, bj, At, Bt) do { __builtin_amdgcn_s_setprio(1); _Pragma("unroll") for (int m = 0; m < 4; ++m) _Pragma("unroll") for (int n = 0; n < 2; ++n) _Pragma("unroll") for (int k = 0; k < 2; ++k) \
        acc[ai][bj][m][n] = __builtin_amdgcn_mfma_f32_16x16x32_bf16(Bt[n][k], At[m][k], acc[ai][bj][m][n], 0, 0, 0); __builtin_amdgcn_s_setprio(0); } while (0)
#define PG8_WAIT_V(n) asm volatile("s_waitcnt vmcnt(" #n ")" ::: "memory")
#define PG8_WAIT_L(n) asm volatile("s_waitcnt lgkmcnt(" #n ")" ::: "memory")
#define PG8_BAR __builtin_amdgcn_s_barrier()
#define PG8_SCHED __builtin_amdgcn_sched_barrier(0)
    Unit cur, nxt; int ui = 0;
    if (!S.next(0, cur)) return;
    f32x4 acc[2][2][4][2];
#pragma unroll
    for (int a = 0; a < 2; ++a)
#pragma unroll
        for (int b = 0; b < 2; ++b)
#pragma unroll
            for (int m = 0; m < 4; ++m)
#pragma unroll
                for (int n = 0; n < 2; ++n) acc[a][b][m][n] = (f32x4){0.f, 0.f, 0.f, 0.f};
    bf16x8 At[4][2], B0[2][2], B1[2][2];
    const char* cA = (const char*)g.A + (size_t)cur.pm * tstepA; const char* cB = (const char*)g.Bt + (size_t)cur.pn * tstepB;
    S.a_ready(cur);
    if constexpr (SP2) {
        PG8_STAGE(PG8_SB(0, 0), cB, voffB); PG8_STAGE(PG8_SB(0, 1), cB + hstepB, voffB); PG8_STAGE(PG8_SA(0, 0), cA, voffA); PG8_STAGE(PG8_SA(0, 1), cA + hstepA, voffA);
        if (wr == 1) PG8_BAR;
        PG8_WAIT_V(2); PG8_BAR;
        PG8_STAGE(PG8_SB(1, 0), cB + kstep, voffB); PG8_STAGE(PG8_SA(1, 0), cA + kstep, voffA); PG8_STAGE(PG8_SB(1, 1), cB + hstepB + kstep, voffB);
        PG8_WAIT_V(6); PG8_BAR;
    } else {
        PG8_STAGE(PG8_SB(0, 0), cB, voffB); PG8_STAGE(PG8_SA(0, 0), cA, voffA); PG8_STAGE(PG8_SB(0, 1), cB + hstepB, voffB); PG8_STAGE(PG8_SA(0, 1), cA + hstepA, voffA);
        if (wr == 1) PG8_BAR;
        PG8_WAIT_V(4); PG8_BAR;
        PG8_STAGE(PG8_SB(1, 0), cB + kstep, voffB); PG8_STAGE(PG8_SA(1, 0), cA + kstep, voffA); PG8_STAGE(PG8_SB(1, 1), cB + hstepB + kstep, voffB);
        PG8_WAIT_V(6); PG8_BAR;
    }
    for (;;) {
        const bool has_next = S.next(ui + 1, nxt);
        const char* nA = has_next ? (const char*)g.A + (size_t)nxt.pm * tstepA : cA; const char* nB = has_next ? (const char*)g.Bt + (size_t)nxt.pn * tstepB : cB;
        for (int t = 0; t < nt; t += 2) {
            const bool last = (t == nt - 2);
            const char* a1 = cA + (size_t)(t + 1) * kstep;
            const char* a2 = last ? nA : cA + (size_t)(t + 2) * kstep; const char* b2 = last ? nB : cB + (size_t)(t + 2) * kstep;
            const char* a3 = a2 + kstep; const char* b3 = b2 + kstep;
            if (last && has_next) S.a_ready(nxt);
            if constexpr (SP2) {
            PG8_LDB(B0, 0, 0); PG8_LDB(B1, 0, 1); PG8_SCHED; PG8_LDA(At, 0, 0); PG8_STAGE(PG8_SA(1, 1), a1 + hstepA, voffA);
            PG8_WAIT_V(8); PG8_WAIT_L(0); PG8_BAR; PG8_MMA(0, 0, At, B0); PG8_MMA(0, 1, At, B1); PG8_BAR; PG8_SCHED;
            PG8_LDA(At, 0, 1); PG8_STAGE(PG8_SB(0, 0), b2, voffB); PG8_STAGE(PG8_SB(0, 1), b2 + hstepB, voffB); PG8_STAGE(PG8_SA(0, 0), a2, voffA);
            PG8_WAIT_V(8); PG8_WAIT_L(0); PG8_BAR; PG8_MMA(1, 0, At, B0); PG8_MMA(1, 1, At, B1); PG8_BAR; PG8_SCHED;
            PG8_LDB(B0, 1, 0); PG8_LDB(B1, 1, 1); PG8_SCHED; PG8_LDA(At, 1, 0); PG8_STAGE(PG8_SA(0, 1), a2 + hstepA, voffA);
            PG8_WAIT_V(8); PG8_WAIT_L(0); PG8_BAR; PG8_MMA(0, 0, At, B0); PG8_MMA(0, 1, At, B1); PG8_BAR; PG8_SCHED;
            PG8_LDA(At, 1, 1); PG8_STAGE(PG8_SB(1, 0), b3, voffB); PG8_STAGE(PG8_SB(1, 1), b3 + hstepB, voffB); PG8_STAGE(PG8_SA(1, 0), a3, voffA);
            PG8_WAIT_V(8); PG8_WAIT_L(0); PG8_BAR; PG8_MMA(1, 0, At, B0); PG8_MMA(1, 1, At, B1); PG8_BAR; PG8_SCHED;
            } else {
            PG8_LDB(B0, 0, 0); PG8_SCHED; PG8_LDA(At, 0, 0); PG8_STAGE(PG8_SA(1, 1), a1 + hstepA, voffA);
            PG8_WAIT_L(8); PG8_BAR; PG8_WAIT_L(0); PG8_MMA(0, 0, At, B0); PG8_BAR; PG8_SCHED;
            PG8_LDB(B1, 0, 1); PG8_STAGE(PG8_SB(0, 0), b2, voffB);
            PG8_BAR; PG8_WAIT_L(0); PG8_MMA(0, 1, At, B1); PG8_BAR;
            PG8_LDA(At, 0, 1); PG8_STAGE(PG8_SA(0, 0), a2, voffA);
            PG8_BAR; PG8_WAIT_L(0); PG8_MMA(1, 0, At, B0); PG8_BAR; PG8_SCHED;
            PG8_STAGE(PG8_SB(0, 1), b2 + hstepB, voffB);
            PG8_WAIT_V(6); PG8_BAR; PG8_MMA(1, 1, At, B1); PG8_BAR;
            PG8_LDB(B0, 1, 0); PG8_SCHED; PG8_LDA(At, 1, 0); PG8_STAGE(PG8_SA(0, 1), a2 + hstepA, voffA);
            PG8_WAIT_L(8); PG8_BAR; PG8_WAIT_L(0); PG8_MMA(0, 0, At, B0); PG8_BAR; PG8_SCHED;
            PG8_LDB(B1, 1, 1); PG8_STAGE(PG8_SB(1, 0), b3, voffB);
            PG8_BAR; PG8_WAIT_L(0); PG8_MMA(0, 1, At, B1); PG8_BAR;
            PG8_LDA(At, 1, 1); PG8_STAGE(PG8_SA(1, 0), a3, voffA);
            PG8_BAR; PG8_WAIT_L(0); PG8_MMA(1, 0, At, B0); PG8_BAR; PG8_SCHED;
            PG8_STAGE(PG8_SB(1, 1), b3 + hstepB, voffB);
            PG8_WAIT_V(6); PG8_BAR; PG8_MMA(1, 1, At, B1); PG8_BAR;
            }
        }
        if constexpr (ALIGN_EPI) { if (wr == 0) PG8_BAR; }
        if constexpr (!Epi::AFTER_DRAIN) { E(acc, cur, wr, wc, fr, fq); S.done(cur); }
        if (!has_next) break;
#pragma unroll
        for (int a = 0; a < 2; ++a)
#pragma unroll
            for (int b = 0; b < 2; ++b)
#pragma unroll
                for (int m = 0; m < 4; ++m)
#pragma unroll
                    for (int n = 0; n < 2; ++n) acc[a][b][m][n] = (f32x4){0.f, 0.f, 0.f, 0.f};
        cur = nxt; cA = nA; cB = nB; ++ui;
        if constexpr (ALIGN_EPI) { if (wr == 1) PG8_BAR; }
    }
    PG8_WAIT_V(0);
    if constexpr (!ALIGN_EPI) { if (wr == 0) PG8_BAR; }
    PG8_BAR;
    if constexpr (Epi::AFTER_DRAIN) { E.fused(acc, cur, wr, wc, fr, fq, lds, wid, lane); S.done(cur); }
#undef PG8_SA
#undef PG8_SB
#undef PG8_STAGE
#undef PG8_LDA
#undef PG8_LDB
#undef PG8_MMA
#undef PG8_WAIT_V
#undef PG8_WAIT_L
#undef PG8_BAR
#undef PG8_SCHED
}
}

namespace cg = cooperative_groups;
#define LAS __attribute__((address_space(3)))
typedef unsigned short bf16;
typedef unsigned v4u __attribute__((ext_vector_type(4)));
typedef unsigned v2u __attribute__((ext_vector_type(2)));
typedef float f32x4 __attribute__((ext_vector_type(4)));
typedef short bf16x8 __attribute__((ext_vector_type(8)));

constexpr int NWAVES = 8;
constexpr int DM = 1024, FF = 4096, INW = 2048, GW = 256;
constexpr int ZP = INW + 64;
#ifndef HPAD
#define HPAD 0
#endif
#ifndef WPAD
#define WPAD 0
#endif
#ifndef APAD
#define APAD 0
#endif
constexpr int DP = DM + APAD;
#ifndef OPAD
#define OPAD 0
#endif
constexpr int OP = DM + OPAD;
constexpr int FP = FF + HPAD;
constexpr int MP = 16384, MS = 512, MT = MP + MS;
constexpr int SEQ = 2048, NBP = 8, NSB = 128, ST = 4, DEPTH = 2;
constexpr float EPS = 1e-6f;
constexpr size_t MiB = 1u << 20;
constexpr size_t WS_SGUW = 1 * MiB;
constexpr size_t WS_W = 2 * MiB, W_LAYER = 24 * MiB, W_IN = 0, W_OUT = 9 * MiB / 2, W_UP = 7 * MiB, W_DN = 31 * MiB / 2;
constexpr size_t WS_XN = 50 * MiB, WS_O = 84 * MiB, WS_H = 120 * MiB, WS_Z = 120 * MiB, WS_CAT = 189 * MiB, WS_RS = 254 * MiB  , WS_END = 255 * MiB;
static_assert(WS_Z + (size_t)16896 * ZP * 2 <= WS_CAT && WS_XN + (size_t)16896 * DP * 2 <= WS_O && WS_CAT + (size_t)16896 * DP * 2 <= WS_H + (size_t)16896 * FP * 2 && WS_H + (size_t)16896 * FP * 2 <= WS_END, "d_ws map");
constexpr int LDS_BYTES = 147456;
constexpr int MISC_OFF = LDS_BYTES - 256;
constexpr size_t WS_CTL = 0, CTL_ZERO_BYTES = 64 * 1024;
constexpr int WAVE_SCR = 17408;
constexpr size_t OUT_Y = 0;
constexpr size_t OUT_POOL_P = (size_t)MT * DM;
constexpr size_t OUT_POOL_S = OUT_POOL_P + (size_t)DEPTH * NBP * 15 * GW;
constexpr size_t OUT_CONV_P = OUT_POOL_S + (size_t)DEPTH * NSB * 15 * GW;
constexpr size_t OUT_CONV_S = OUT_CONV_P + (size_t)DEPTH * NBP * 30 * GW;
constexpr size_t OUT_SHORT_P = OUT_CONV_S + (size_t)DEPTH * NSB * 30 * GW;
constexpr size_t OUT_SHORT_S = OUT_SHORT_P + (size_t)DEPTH * NBP * 2 * GW;
constexpr size_t OUT_V_S = OUT_SHORT_S + (size_t)DEPTH * NSB * 2 * GW;
constexpr size_t OUT_END = OUT_V_S + (size_t)DEPTH * NSB * ST * GW;

__device__ __forceinline__ float bf2f(bf16 b) { return __uint_as_float(((unsigned)b) << 16); }
__device__ __forceinline__ unsigned f2bf(float f) { unsigned u = __float_as_uint(f); return (u + 0x7fffu + ((u >> 16) & 1u)) >> 16; }
__device__ __forceinline__ unsigned pk2(float lo, float hi) { return f2bf(lo) | (f2bf(hi) << 16); }
template <int CTRL, int ROWMASK> __device__ __forceinline__ float dpp_get(float v) { return __int_as_float(__builtin_amdgcn_update_dpp(0, __float_as_int(v), CTRL, ROWMASK, 0xF, false)); }
__device__ __forceinline__ float sum8(float v) { v += dpp_get<0xB1, 0xF>(v); v += dpp_get<0x4E, 0xF>(v); v += dpp_get<0x141, 0xF>(v); return v; }
__device__ __forceinline__ float wave_sum(float v) {
    v = sum8(v); v += dpp_get<0x140, 0xF>(v); v += dpp_get<0x142, 0xA>(v); v += dpp_get<0x143, 0xC>(v);
    return __int_as_float(__builtin_amdgcn_readlane(__float_as_int(v), 63));
}
__device__ __forceinline__ void unpack8(const v4u w, float (&f)[8]) {
    f[0] = __uint_as_float(w.x << 16); f[1] = __uint_as_float(w.x & 0xffff0000u); f[2] = __uint_as_float(w.y << 16); f[3] = __uint_as_float(w.y & 0xffff0000u);
    f[4] = __uint_as_float(w.z << 16); f[5] = __uint_as_float(w.z & 0xffff0000u); f[6] = __uint_as_float(w.w << 16); f[7] = __uint_as_float(w.w & 0xffff0000u); }
__device__ __forceinline__ v4u pack8(const float (&f)[8]) { v4u w; w.x = pg8::cvt_pk_bf16(f[0], f[1]); w.y = pg8::cvt_pk_bf16(f[2], f[3]); w.z = pg8::cvt_pk_bf16(f[4], f[5]); w.w = pg8::cvt_pk_bf16(f[6], f[7]); return w; }
__device__ __forceinline__ v4u ld16(const bf16* p) { return *(const v4u*)p; }
__device__ __forceinline__ float sigm(float x) { return __builtin_amdgcn_rcpf(1.f + __builtin_amdgcn_exp2f(-1.44269504f * x)); }
#define LDS_WAIT() asm volatile("s_waitcnt lgkmcnt(0)" ::: "memory")

__device__ __forceinline__ void transpose_item(const float* __restrict__ W, int K, int N, bf16* __restrict__ WT, const float* __restrict__ gk, LAS float* scr, int item, int lane) {
    const int nblk = N / 32, kb = item / nblk, nb = item % nblk, k0 = 64 * kb, n0 = 32 * nb;
#pragma unroll 8
    for (int i = 0; i < 32; ++i) { const int kk = 2 * i + (lane >> 5); float v = W[(size_t)(k0 + kk) * N + n0 + (lane & 31)]; if (gk) v *= gk[k0 + kk]; scr[kk * 33 + (lane & 31)] = v; }
    LDS_WAIT();
    const int c = lane & 7;
#pragma unroll
    for (int j = 0; j < 4; ++j) { const int n = (lane >> 3) + 8 * j; const LAS float* s = scr + (8 * c) * 33 + n;
        v4u o; o.x = pk2(s[0 * 33], s[1 * 33]); o.y = pk2(s[2 * 33], s[3 * 33]); o.z = pk2(s[4 * 33], s[5 * 33]); o.w = pk2(s[6 * 33], s[7 * 33]);
        *(v4u*)(WT + (size_t)(n0 + n) * K + k0 + 8 * c) = o; }
    LDS_WAIT();
}
struct TrDesc { const float* W; bf16* WT; const float* gk; int K, N, k0, n0; };
__device__ __forceinline__ void tr_load(float (&v)[32], const TrDesc& d, int lane) {
    const float* p = d.W + (size_t)(d.k0 + (lane >> 5)) * d.N + d.n0 + (lane & 31);
#pragma unroll
    for (int i = 0; i < 32; ++i) v[i] = __builtin_nontemporal_load(p + (size_t)(2 * i) * d.N);
}
__device__ __forceinline__ void tr_store(const float (&v)[32], const TrDesc& d, LAS float* scr, int lane) {
#pragma unroll
    for (int i = 0; i < 32; ++i) { const int kk = 2 * i + (lane >> 5); float x = v[i]; if (d.gk) x *= d.gk[d.k0 + kk]; scr[kk * 33 + (lane & 31)] = x; }
    LDS_WAIT();
    const int c = lane & 7;
#pragma unroll
    for (int j = 0; j < 4; ++j) { const int n = (lane >> 3) + 8 * j; const LAS float* s = scr + (8 * c) * 33 + n;
        v4u o; o.x = pg8::cvt_pk_bf16(s[0 * 33], s[1 * 33]); o.y = pg8::cvt_pk_bf16(s[2 * 33], s[3 * 33]); o.z = pg8::cvt_pk_bf16(s[4 * 33], s[5 * 33]); o.w = pg8::cvt_pk_bf16(s[6 * 33], s[7 * 33]);
        *(v4u*)(d.WT + (size_t)(d.n0 + n) * (d.K + WPAD) + d.k0 + 8 * c) = o; }
    LDS_WAIT();
}
__device__ __forceinline__ void fold_item(const float* __restrict__ W, bf16* __restrict__ WT, const float* __restrict__ wp, const float* __restrict__ ps, LAS float* scr, int item4, int lane) {
    const int K = DM, N = DM; const int item = item4 >> 2, q = item4 & 3; const int nblk = N / 32, g = item / nblk, nb = item % nblk, k0 = 64 * g, n0 = 32 * nb;
    LAS float* scr2 = scr + 64 * 33;
#pragma unroll 8
    for (int i = 0; i < 32; ++i) { const int kk = 2 * i + (lane >> 5); scr[kk * 33 + (lane & 31)] = W[(size_t)(k0 + kk) * N + n0 + (lane & 31)] * ps[k0 + kk]; }
    LDS_WAIT();
    const int n = lane & 31;
    LAS float* wpL = scr2 + 16 * 33;
    { const f32x4* src = (const f32x4*)(wp + (size_t)(g * 64 + 16 * q) * 64) + lane;
#pragma unroll
      for (int j = 0; j < 4; ++j) *(LAS f32x4*)(wpL + 4 * lane + 256 * j) = src[64 * j]; }
    LDS_WAIT();
#pragma unroll 2
    for (int i = 0; i < 8; ++i) { const int kl = 2 * i + (lane >> 5); const LAS float* wr = wpL + kl * 64; float a = 0.f;
#pragma unroll 16
        for (int d = 0; d < 64; ++d) a += wr[d] * scr[d * 33 + n];
        scr2[kl * 33 + n] = a; }
    LDS_WAIT();
    { const int ch = lane >> 5; const LAS float* s = scr2 + (8 * ch) * 33 + n;
        v4u o; o.x = pk2(s[0 * 33], s[1 * 33]); o.y = pk2(s[2 * 33], s[3 * 33]); o.z = pk2(s[4 * 33], s[5 * 33]); o.w = pk2(s[6 * 33], s[7 * 33]);
        *(v4u*)(WT + (size_t)(n0 + n) * (K + WPAD) + k0 + 16 * q + 8 * ch) = o; }
    LDS_WAIT();
}
struct XRow { f32x4 v[4]; };
__device__ __forceinline__ void xrow_load(XRow& r, const float* __restrict__ xrow, int lane) {
    const f32x4* xr = (const f32x4*)xrow + lane;
#pragma unroll
    for (int j = 0; j < 4; ++j) r.v[j] = __builtin_nontemporal_load(xr + 64 * j);
}
__device__ __forceinline__ void xrow_finish(const XRow& r, bf16* __restrict__ orow, float* __restrict__ rsp, int lane) {
    float s = 0.f;
#pragma unroll
    for (int j = 0; j < 4; ++j) s += (r.v[j].x * r.v[j].x + r.v[j].y * r.v[j].y) + (r.v[j].z * r.v[j].z + r.v[j].w * r.v[j].w);
    const float rstd = rsqrtf(wave_sum(s) * (1.f / DM) + EPS);
    if (lane == 0) *rsp = rstd;
    v2u* o8 = (v2u*)orow + lane;
#pragma unroll
    for (int j = 0; j < 4; ++j) { v2u o; o.x = pg8::cvt_pk_bf16(r.v[j].x, r.v[j].y); o.y = pg8::cvt_pk_bf16(r.v[j].z, r.v[j].w); o8[64 * j] = o; }
}
struct EwRow { v4u x[2]; v4u o[2]; };
__device__ __forceinline__ f32x4 unpack4(const v2u w) { return (f32x4){__uint_as_float(w.x << 16), __uint_as_float(w.x & 0xffff0000u), __uint_as_float(w.y << 16), __uint_as_float(w.y & 0xffff0000u)}; }
__device__ __forceinline__ void ew_load(EwRow& r, const bf16* __restrict__ xrow16, const bf16* __restrict__ orow, int lane) {
    const v4u* xr = (const v4u*)xrow16 + lane; const v4u* orr = (const v4u*)orow + lane;
#pragma unroll
    for (int j = 0; j < 2; ++j) { r.x[j] = xr[64 * j]; r.o[j] = orr[64 * j]; }
}
__device__ __forceinline__ void ew_finish(const EwRow& r, const float (&gg)[2][8], float* __restrict__ Xrow32, bf16* __restrict__ Xrow16, bool dst16, float* __restrict__ rsp, bool write_xn, int lane) {
    float o[2][8], x[2][8]; float so = 0.f;
#pragma unroll
    for (int j = 0; j < 2; ++j) { unpack8(r.o[j], o[j]); unpack8(r.x[j], x[j]);
#pragma unroll
        for (int i = 0; i < 8; i += 2) so += o[j][i] * o[j][i] + o[j][i + 1] * o[j][i + 1]; }
    const float rs = rsqrtf(wave_sum(so) * (1.f / DM) + EPS); float s1 = 0.f;
#pragma unroll
    for (int j = 0; j < 2; ++j)
#pragma unroll
        for (int i = 0; i < 8; ++i) { x[j][i] += o[j][i] * rs * gg[j][i]; s1 += x[j][i] * x[j][i]; }
    if (dst16) { v4u* Xr = (v4u*)Xrow16 + lane;
#pragma unroll
        for (int j = 0; j < 2; ++j) Xr[64 * j] = pack8(x[j]); }
    else { f32x4* Xr = (f32x4*)Xrow32 + 2 * lane;
#pragma unroll
        for (int j = 0; j < 2; ++j) { Xr[128 * j] = (f32x4){x[j][0], x[j][1], x[j][2], x[j][3]}; Xr[128 * j + 1] = (f32x4){x[j][4], x[j][5], x[j][6], x[j][7]}; } }
    if (write_xn) { const float r1 = rsqrtf(wave_sum(s1) * (1.f / DM) + EPS); if (lane == 0) *rsp = r1; }
}

template <bool SAMPLE>
__device__ __forceinline__ void pool_unit(const bf16* __restrict__ Z, bf16* __restrict__ CAT, const float* __restrict__ state, float* __restrict__ newp,
                                          int seq, int t0, int nrows, int g, int lane) {
    const int c = g * 64 + lane, w = 2 << g;
    const size_t rowbase = SAMPLE ? (size_t)MP + (size_t)seq * ST : (size_t)seq * SEQ;
    const bf16* zc = Z + rowbase * ZP + c;
    const float* st = state + (size_t)seq * 15 * GW + c;
#define POOL_A(e) ((e) >= 0 ? bf2f(zc[(size_t)(e) * ZP]) : (SAMPLE ? st[(15 + (e)) * GW] : 0.f))
    float S = 0.f;
    for (int j = 1; j < w; ++j) S += POOL_A(t0 - j);
#pragma unroll 4
    for (int t = t0; t < t0 + nrows; ++t) {
        const float a = POOL_A(t); S += a;
        const float cnt = SAMPLE ? (float)w : (float)(t + 1 < w ? t + 1 : w);
        CAT[(rowbase + t) * DP + c] = (bf16)f2bf(S / cnt - a);
        const int e = t - w + 1; S -= POOL_A(e);
    }
    const int T = SAMPLE ? ST : SEQ;
    if (t0 + nrows == T) {
        for (int j = 0; j < 15; ++j) { const int e = T - 15 + j; newp[((size_t)seq * 15 + j) * GW + c] = POOL_A(e); }
    }
#undef POOL_A
}
template <int W>
__device__ __forceinline__ void pool_sample_unit(const bf16* __restrict__ Z, bf16* __restrict__ CAT, const float* __restrict__ state, float* __restrict__ newp, int seq, int g, int lane) {
    const int c = g * 64 + lane;
    const size_t rowbase = (size_t)MP + (size_t)seq * ST;
    float ext[15 + ST];
#pragma unroll
    for (int j = 0; j < 15; ++j) ext[j] = state[((size_t)seq * 15 + j) * GW + c];
#pragma unroll
    for (int t = 0; t < ST; ++t) ext[15 + t] = bf2f(Z[(rowbase + t) * ZP + c]);
#pragma unroll
    for (int t = 0; t < ST; ++t) { float S = 0.f;
#pragma unroll
        for (int i = 0; i < W; ++i) S += ext[15 + t - i];
        CAT[(rowbase + t) * DP + c] = (bf16)f2bf(S * (1.f / W) - ext[15 + t]); }
#pragma unroll
    for (int j = 0; j < 15; ++j) newp[((size_t)seq * 15 + j) * GW + c] = ext[ST + j];
}
template <bool SAMPLE>
__device__ __forceinline__ void short_unit(const bf16* __restrict__ Z, bf16* __restrict__ CAT, const float* __restrict__ state, float* __restrict__ news,
                                           const float* __restrict__ sw, int seq, int t0, int nrows, int h, int lane) {
    const int c = h * 64 + lane;
    const size_t rowbase = SAMPLE ? (size_t)MP + (size_t)seq * ST : (size_t)seq * SEQ;
    const bf16* zc = Z + rowbase * ZP + c;
    const float* st = state + (size_t)seq * 2 * GW + c;
    const float w0 = sw[c], w1 = sw[GW + c], w2 = sw[2 * GW + c];
#define SH_E(e) ((e) >= 0 ? bf2f(zc[(size_t)(e) * ZP + 1536]) * bf2f(zc[(size_t)(e) * ZP + 1792]) : (SAMPLE ? st[(2 + (e)) * GW] : 0.f))
    float e2 = SH_E(t0 - 2), e1 = SH_E(t0 - 1);
#pragma unroll 4
    for (int t = t0; t < t0 + nrows; ++t) {
        const float e0 = SH_E(t); const float bg = bf2f(zc[(size_t)t * ZP + 1280]);
        CAT[(rowbase + t) * DP + 768 + c] = (bf16)f2bf(bg * (w0 * e2 + w1 * e1 + w2 * e0));
        e2 = e1; e1 = e0;
    }
    const int T = SAMPLE ? ST : SEQ;
    if (t0 + nrows == T) { news[((size_t)seq * 2 + 0) * GW + c] = e2; news[((size_t)seq * 2 + 1) * GW + c] = e1; }
#undef SH_E
}
template <bool SAMPLE>
__device__ __forceinline__ void conv_unit(const bf16* __restrict__ Z, bf16* __restrict__ CAT, const float* __restrict__ state, float* __restrict__ newc,
                                          const float* __restrict__ cw, const float* __restrict__ cb, const float* __restrict__ lg, const float* __restrict__ lb,
                                          int seq, int t0, int nrows, int h, LAS float* gL, int lane) {
    const int c = h * 64 + lane;
    const size_t rowbase = SAMPLE ? (size_t)MP + (size_t)seq * ST : (size_t)seq * SEQ;
    const bf16* zc = Z + rowbase * ZP + c;
    bf16* oc = CAT + rowbase * DP + 256 + c;
    const int T = SAMPLE ? ST : SEQ;
    const bool last = (t0 + nrows == T);
    const int nin = nrows + 30;
#pragma unroll
    for (int r = 0; r < nin; ++r) { const int s = t0 - 30 + r; float gs = 0.f;
        if (s >= 0) { const unsigned off = (unsigned)s * ZP; const float p = bf2f(zc[off + 256]), gt = bf2f(zc[off + 512]); gs = p * sigm(gt); }
        else if (SAMPLE) gs = state[((size_t)seq * 30 + 30 + s) * GW + c];
        if (last && s >= T - 30) newc[((size_t)seq * 30 + (s - (T - 30))) * GW + c] = gs;
        gL[r * 64 + lane] = gs; }
    LDS_WAIT();
    float wk[31];
#pragma unroll
    for (int k = 0; k < 31; ++k) wk[k] = cw[k * GW + c];
    const float bias = cb[c], gg = lg[c], bb = lb[c];
#pragma unroll 1
    for (int tq = 0; tq < nrows; tq += 4) {
        float acc[4] = {bias, bias, bias, bias};
#pragma unroll
        for (int r = 0; r < 34; ++r) { const float gv = gL[(tq + r) * 64 + lane];
#pragma unroll
            for (int q = 0; q < 4; ++q) { const int k = r - q; if (k >= 0 && k <= 30) acc[q] += wk[k] * gv; } }
#pragma unroll
        for (int q = 0; q < 4; ++q) { const float cv = acc[q];
            const float mean = wave_sum(cv) * (1.f / 64.f); const float d = cv - mean;
            const float var = wave_sum(d * d) * (1.f / 64.f);
            const float y = d * rsqrtf(var + EPS) * gg + bb;
            oc[(unsigned)(t0 + tq + q) * DP] = (bf16)f2bf(y * sigm(y)); }
    }
    LDS_WAIT();
}
template <int W>
__device__ __forceinline__ void pool_unit_p(const bf16* __restrict__ Z, bf16* __restrict__ CAT, float* __restrict__ newp, int seq, int t0, int g, int lane) {
    const int rr = lane >> 3, cg = lane & 7, c0 = g * 64 + cg * 8, tb = t0 + rr * 8;
    const size_t rowbase = (size_t)seq * SEQ;
    const bf16* zb = Z + (rowbase + tb) * ZP + c0;
    v4u raw[W + 7];
#pragma unroll
    for (int j = 0; j < W + 7; ++j) { const int dj = j - (W - 1); raw[j] = (tb + dj >= 0) ? ld16(zb + (long)dj * ZP) : (v4u){0u, 0u, 0u, 0u}; }
    float S[8];
#pragma unroll
    for (int i = 0; i < 8; ++i) S[i] = 0.f;
#pragma unroll
    for (int j = 0; j < W - 1; ++j) { float f[8]; unpack8(raw[j], f);
#pragma unroll
        for (int i = 0; i < 8; ++i) S[i] += f[i]; }
    bf16* ob = CAT + (rowbase + tb) * DP + c0;
    const bool lastseg = (t0 + 64 == SEQ);
#pragma unroll
    for (int j = 0; j < 8; ++j) { float a[8], o[8], od[8]; unpack8(raw[j + W - 1], a); unpack8(raw[j], od);
        const int t = tb + j; const float inv = 1.f / (float)(t + 1 < W ? t + 1 : W);
#pragma unroll
        for (int i = 0; i < 8; ++i) { S[i] += a[i]; o[i] = S[i] * inv - a[i]; S[i] -= od[i]; }
        *(v4u*)(ob + j * DP) = pack8(o);
        if (lastseg && t >= SEQ - 15) { float* np = newp + ((size_t)seq * 15 + (t - (SEQ - 15))) * GW + c0; *(f32x4*)np = (f32x4){a[0], a[1], a[2], a[3]}; *(f32x4*)(np + 4) = (f32x4){a[4], a[5], a[6], a[7]}; }
    }
}
__device__ __forceinline__ void short_unit_p(const bf16* __restrict__ Z, bf16* __restrict__ CAT, float* __restrict__ news, const float* __restrict__ sw, int seq, int t0, int h, int lane) {
    const int rr = lane >> 3, cg = lane & 7, c0 = h * 64 + cg * 8, tb = t0 + rr * 8;
    const size_t rowbase = (size_t)seq * SEQ;
    const bf16* zb = Z + (rowbase + tb) * ZP + c0;
    v4u Bv[8], Cv[10], Hv[10];
#pragma unroll
    for (int j = 0; j < 10; ++j) { const int dj = j - 2; const bool ok = (tb + dj >= 0);
        Cv[j] = ok ? ld16(zb + (long)dj * ZP + 1536) : (v4u){0u, 0u, 0u, 0u}; Hv[j] = ok ? ld16(zb + (long)dj * ZP + 1792) : (v4u){0u, 0u, 0u, 0u};
        if (j >= 2) Bv[j - 2] = ld16(zb + (long)dj * ZP + 1280); }
    float w0[8], w1[8], w2[8];
#pragma unroll
    for (int i = 0; i < 8; ++i) { w0[i] = sw[c0 + i]; w1[i] = sw[GW + c0 + i]; w2[i] = sw[2 * GW + c0 + i]; }
    float e2[8], e1[8];
    { float c[8], hh[8]; unpack8(Cv[0], c); unpack8(Hv[0], hh);
#pragma unroll
      for (int i = 0; i < 8; ++i) e2[i] = c[i] * hh[i];
      unpack8(Cv[1], c); unpack8(Hv[1], hh);
#pragma unroll
      for (int i = 0; i < 8; ++i) e1[i] = c[i] * hh[i]; }
    bf16* ob = CAT + (rowbase + tb) * DP + 768 + c0;
#pragma unroll
    for (int j = 0; j < 8; ++j) { float c[8], hh[8], b[8], o[8]; unpack8(Cv[j + 2], c); unpack8(Hv[j + 2], hh); unpack8(Bv[j], b);
#pragma unroll
        for (int i = 0; i < 8; ++i) { const float e0 = c[i] * hh[i]; o[i] = b[i] * (w0[i] * e2[i] + w1[i] * e1[i] + w2[i] * e0); e2[i] = e1[i]; e1[i] = e0; }
        *(v4u*)(ob + j * DP) = pack8(o); }
    if (t0 + 64 == SEQ && rr == 7) { float* np = news + (size_t)seq * 2 * GW + c0;
        *(f32x4*)np = (f32x4){e2[0], e2[1], e2[2], e2[3]}; *(f32x4*)(np + 4) = (f32x4){e2[4], e2[5], e2[6], e2[7]};
        *(f32x4*)(np + GW) = (f32x4){e1[0], e1[1], e1[2], e1[3]}; *(f32x4*)(np + GW + 4) = (f32x4){e1[4], e1[5], e1[6], e1[7]}; }
}
__device__ __forceinline__ void conv_unit_p(const bf16* __restrict__ Z, bf16* __restrict__ CAT, float* __restrict__ newc,
                                            const float* __restrict__ cw, const float* __restrict__ cb, const float* __restrict__ lg, const float* __restrict__ lb,
                                            int seq, int t0, int h, LAS float* gL, int lane) {
    const int rr = lane >> 3, cg = lane & 7, c0 = h * 64 + cg * 8;
    const size_t rowbase = (size_t)seq * SEQ;
    const bool last = (t0 + 32 == SEQ);
    const int c = h * 64 + lane;
    float wk[31];
#pragma unroll
    for (int k = 0; k < 31; ++k) wk[k] = cw[k * GW + c];
    const float bias = cb[c];
    { v4u pv[8], gv[8];
#pragma unroll
      for (int j = 0; j < 8; ++j) { const int r = 8 * j + rr, sx = t0 - 30 + r; const bool ok = (sx >= 0 && r < 62);
          const bf16* zp = Z + (rowbase + (ok ? sx : 0)) * ZP + c0;
          pv[j] = ok ? ld16(zp + 256) : (v4u){0u, 0u, 0u, 0u}; gv[j] = ok ? ld16(zp + 512) : (v4u){0u, 0u, 0u, 0u}; }
#pragma unroll
      for (int j = 0; j < 8; ++j) { const int r = 8 * j + rr, sx = t0 - 30 + r; float p[8], gt[8]; unpack8(pv[j], p); unpack8(gv[j], gt);
#pragma unroll
          for (int i = 0; i < 8; ++i) p[i] = p[i] * sigm(gt[i]);
          if (r < 62) { *(LAS f32x4*)(gL + r * 64 + cg * 8) = (f32x4){p[0], p[1], p[2], p[3]}; *(LAS f32x4*)(gL + r * 64 + cg * 8 + 4) = (f32x4){p[4], p[5], p[6], p[7]}; }
          if (last && sx >= SEQ - 30 && r < 62) { float* np = newc + ((size_t)seq * 30 + (sx - (SEQ - 30))) * GW + c0; *(f32x4*)np = (f32x4){p[0], p[1], p[2], p[3]}; *(f32x4*)(np + 4) = (f32x4){p[4], p[5], p[6], p[7]}; } }
    }
    LDS_WAIT();
#pragma unroll 1
    for (int tq = 0; tq < 32; tq += 4) {
        float acc[4] = {bias, bias, bias, bias};
#pragma unroll
        for (int r = 0; r < 34; ++r) { const float gvv = gL[(tq + r) * 64 + lane];
#pragma unroll
            for (int q = 0; q < 4; ++q) { const int k = r - q; if (k >= 0 && k <= 30) acc[q] += wk[k] * gvv; } }
        LDS_WAIT();
#pragma unroll
        for (int q = 0; q < 4; ++q) gL[(tq + q) * 64 + lane] = acc[q];
    }
    LDS_WAIT();
    float gg[8], bb[8];
#pragma unroll
    for (int i = 0; i < 8; ++i) { gg[i] = lg[c0 + i]; bb[i] = lb[c0 + i]; }
    bf16* ob = CAT + (rowbase + t0) * DP + 256 + c0;
#pragma unroll
    for (int j = 0; j < 4; ++j) { const int r = 8 * j + rr; const f32x4 a = *(const LAS f32x4*)(gL + r * 64 + cg * 8), b = *(const LAS f32x4*)(gL + r * 64 + cg * 8 + 4);
        float x[8] = {a[0], a[1], a[2], a[3], b[0], b[1], b[2], b[3]};
        const float mean = sum8(((x[0] + x[1]) + (x[2] + x[3])) + ((x[4] + x[5]) + (x[6] + x[7]))) * (1.f / 64.f);
        float q = 0.f;
#pragma unroll
        for (int i = 0; i < 8; ++i) { x[i] -= mean; q += x[i] * x[i]; }
        const float rstd = rsqrtf(sum8(q) * (1.f / 64.f) + EPS);
#pragma unroll
        for (int i = 0; i < 8; ++i) { const float yy = x[i] * rstd * gg[i] + bb[i]; x[i] = yy * sigm(yy); }
        *(v4u*)(ob + r * DP) = pack8(x); }
    LDS_WAIT();
}
__device__ __forceinline__ int sgu_swz(int c, int chunk) { return (chunk ^ ((c & 15) ^ (c >> 4))) << 3; }
__device__ __forceinline__ void sgu_unit(const bf16* __restrict__ Z, bf16* __restrict__ CAT, const bf16* __restrict__ Wb, const float* __restrict__ lg, const float* __restrict__ lb,
                                         const float* __restrict__ sb, int chunk, int h, LAS bf16* vT, int lane) {
    const size_t r0 = (size_t)chunk * 128;
    const int fr = lane & 15, fq = lane >> 4;
    bf16x8 wf[8][4];
#pragma unroll
    for (int mt = 0; mt < 8; ++mt)
#pragma unroll
        for (int ks = 0; ks < 4; ++ks) if (ks * 32 <= mt * 16 + 15) wf[mt][ks] = *(const bf16x8*)(Wb + ((size_t)(h * 128 + mt * 16 + fr) * 128 + ks * 32 + fq * 8));
    { const int rr = lane >> 3, cg = lane & 7, c0 = h * 64 + cg * 8;
      float gg[8], bb[8];
#pragma unroll
      for (int i = 0; i < 8; ++i) { gg[i] = lg[c0 + i]; bb[i] = lb[c0 + i]; }
#pragma unroll 1
      for (int jh = 0; jh < 16; jh += 8) {
          v4u raw[8];
#pragma unroll
          for (int j = 0; j < 8; ++j) raw[j] = ld16(Z + (r0 + 8 * (jh + j) + rr) * ZP + 1024 + c0);
#pragma unroll
          for (int j = 0; j < 8; ++j) { float x[8]; unpack8(raw[j], x);
              float sm = ((x[0] + x[1]) + (x[2] + x[3])) + ((x[4] + x[5]) + (x[6] + x[7])); const float mean = sum8(sm) * (1.f / 64.f);
              float q = 0.f;
#pragma unroll
              for (int i = 0; i < 8; ++i) { x[i] -= mean; q += x[i] * x[i]; }
              const float rstd = rsqrtf(sum8(q) * (1.f / 64.f) + EPS);
#pragma unroll
              for (int i = 0; i < 8; ++i) { const int cl = cg * 8 + i; vT[cl * 128 + sgu_swz(cl, jh + j) + rr] = (bf16)f2bf(x[i] * rstd * gg[i] + bb[i]); } }
      }
    }
    LDS_WAIT();
#pragma unroll
    for (int mt = 0; mt < 8; ++mt) {
        f32x4 acc[4];
#pragma unroll
        for (int nt = 0; nt < 4; ++nt) acc[nt] = (f32x4){0.f, 0.f, 0.f, 0.f};
        const int t = mt * 16 + fr;
        v2u uv[4];
#pragma unroll
        for (int nt = 0; nt < 4; ++nt) uv[nt] = *(const v2u*)(Z + (r0 + t) * ZP + 768 + h * 64 + nt * 16 + 4 * fq);
        const float bt = sb[h * 128 + t];
#pragma unroll
        for (int ks = 0; ks < 4; ++ks) if (ks * 32 <= mt * 16 + 15) {
#pragma unroll
            for (int nt = 0; nt < 4; ++nt) { const int cl = nt * 16 + fr; const bf16x8 vf = *(const LAS bf16x8*)(vT + cl * 128 + sgu_swz(cl, ks * 4 + fq));
                acc[nt] = __builtin_amdgcn_mfma_f32_16x16x32_bf16(vf, wf[mt][ks], acc[nt], 0, 0, 0); }
        }
#pragma unroll
        for (int nt = 0; nt < 4; ++nt) { const float u0 = __uint_as_float(uv[nt].x << 16), u1 = __uint_as_float(uv[nt].x & 0xffff0000u), u2 = __uint_as_float(uv[nt].y << 16), u3 = __uint_as_float(uv[nt].y & 0xffff0000u);
            v2u w; w.x = pg8::cvt_pk_bf16(u0 * (acc[nt][0] + bt), u1 * (acc[nt][1] + bt)); w.y = pg8::cvt_pk_bf16(u2 * (acc[nt][2] + bt), u3 * (acc[nt][3] + bt));
            *(v2u*)(CAT + (r0 + t) * DP + 512 + h * 64 + nt * 16 + 4 * fq) = w; }
    }
    LDS_WAIT();
}
__device__ __forceinline__ void sgu_sample_unit(const bf16* __restrict__ Z, bf16* __restrict__ CAT, const float* __restrict__ Wf, const float* __restrict__ lg, const float* __restrict__ lb,
                                                const float* __restrict__ sb, float* __restrict__ vout, int seq, int h, int lane) {
    const int c = h * 64 + lane; const size_t rowbase = (size_t)MP + (size_t)seq * ST;
    const float gg = lg[c], bb = lb[c];
    float vn[ST];
#pragma unroll
    for (int t = 0; t < ST; ++t) { const float v = bf2f(Z[(rowbase + t) * ZP + 1024 + c]); const float mean = wave_sum(v) * (1.f / 64.f); const float d = v - mean; const float var = wave_sum(d * d) * (1.f / 64.f);
        vn[t] = d * rsqrtf(var + EPS) * gg + bb; vout[((size_t)seq * ST + t) * GW + c] = vn[t]; }
#pragma unroll
    for (int t = 0; t < ST; ++t) { float sv = sb[h * 128 + t];
#pragma unroll
        for (int s = 0; s <= t; ++s) sv += Wf[((size_t)h * 128 + t) * 128 + s] * vn[s];
        const float u = bf2f(Z[(rowbase + t) * ZP + 768 + c]);
        CAT[(rowbase + t) * DP + 512 + c] = (bf16)f2bf(u * sv); }
}

#define XB_TMO      128
#define XB_XCNT(j)  (256  + 64 * (j))
#define XB_XSUB(j)  (1280 + 64 * (j))
#define XB_XGEN(j)  (2304 + 64 * (j))
#define XB_TOP      3328
#define XB_TOPGEN   3392
#define XCD_BAR_WORDS 3456
#define XB_SPIN_CAP (1u << 18)

__device__ __forceinline__ unsigned xb_ld(unsigned* p)              { return __hip_atomic_load(p, __ATOMIC_RELAXED, __HIP_MEMORY_SCOPE_AGENT); }
__device__ __forceinline__ unsigned xb_add(unsigned* p, unsigned v) { return __hip_atomic_fetch_add(p, v, __ATOMIC_RELAXED, __HIP_MEMORY_SCOPE_AGENT); }
__device__ __forceinline__ unsigned xb_xcc_id() { return (unsigned)__builtin_amdgcn_s_getreg((3 << 11) | 20) & 0xFu; }
#define XB_SPIN(cond, bar) do { unsigned _sp = 0; while (cond) { __builtin_amdgcn_s_sleep(1); \
    if ((++_sp & 255u) == 0u) { if (xb_ld(&(bar)[XB_TMO])) break; if (_sp > XB_SPIN_CAP) { atomicAdd(&(bar)[XB_TMO], 1u); break; } } } } while (0)

struct XcdBarrier {
    unsigned* bar; unsigned x;
    volatile LAS unsigned* st;
};

__device__ __forceinline__ XcdBarrier xcd_barrier_post(unsigned* bar, volatile LAS unsigned* st) {
    XcdBarrier b; b.bar = bar; b.x = xb_xcc_id(); b.st = st;
    if (threadIdx.x == 0) (void)xb_add(&bar[XB_XCNT(b.x)], 1u);
    return b;
}
__device__ __forceinline__ void xcd_barrier_complete(unsigned* bar, unsigned x, unsigned& nloc, unsigned& nx) {
    const unsigned G = gridDim.x * gridDim.y * gridDim.z;
    unsigned sum, cnt, mine, sp = 0u;
    for (;;) {
        sum = 0u; cnt = 0u; mine = 0u;
#pragma unroll
        for (unsigned j = 0; j < 16; ++j) { const unsigned c = xb_ld(&bar[XB_XCNT(j)]); sum += c; cnt += (c > 0u) ? 1u : 0u; mine = (j == x) ? c : mine; }
        if (sum == G) break;
        __builtin_amdgcn_s_sleep(1);
        if ((++sp & 255u) == 0u) { if (xb_ld(&bar[XB_TMO])) break; if (sp > XB_SPIN_CAP) { atomicAdd(&bar[XB_TMO], 1u); break; } }
    }
    nloc = mine > 0u ? mine : 1u; nx = cnt > 0u ? cnt : 1u;
}

__device__ __forceinline__ void xcd_barrier(const XcdBarrier& b) {
    asm volatile("s_waitcnt vmcnt(0)" ::: "memory");
    __syncthreads();
    if (threadIdx.x == 0) {
        unsigned* bar = b.bar;
        __builtin_amdgcn_s_waitcnt(0);
        unsigned nloc = b.st[0], nx = b.st[1];
        if (nloc == 0u) { xcd_barrier_complete(bar, b.x, nloc, nx); b.st[0] = nloc; b.st[1] = nx; }
        const unsigned old = xb_add(&bar[XB_XSUB(b.x)], 1u);
        const unsigned gen = old / nloc;
        if (old + 1u == (gen + 1u) * nloc) {
            __builtin_amdgcn_fence(__ATOMIC_RELEASE, "agent");
            asm volatile("s_waitcnt vmcnt(0)" ::: "memory");
            const unsigned og = xb_add(&bar[XB_TOP], 1u);
            const unsigned tg = og / nx;
            if (og + 1u == (tg + 1u) * nx) xb_add(&bar[XB_TOPGEN], 1u);
            else XB_SPIN(xb_ld(&bar[XB_TOPGEN]) == tg, bar);
            __builtin_amdgcn_fence(__ATOMIC_ACQUIRE, "agent");
            xb_add(&bar[XB_XGEN(b.x)], 1u);
            asm volatile("s_waitcnt vmcnt(0)" ::: "memory");
        } else {
            XB_SPIN(xb_ld(&bar[XB_XGEN(b.x)]) == gen, bar);
            __builtin_amdgcn_fence(__ATOMIC_ACQUIRE, "agent");
            asm volatile("s_waitcnt vmcnt(0)" ::: "memory");
        }
    }
    __syncthreads();
}

#define GB_CNT(x)  (8192 + 64 * (x))
#define GB_MASK(x) (9216 + 64 * (x))
__device__ __forceinline__ void group_barrier(unsigned* ctl, int x, unsigned target, bool coloc) {
    asm volatile("s_waitcnt vmcnt(0)" ::: "memory");
    __syncthreads();
    if (threadIdx.x == 0) {
        if (!coloc) { __builtin_amdgcn_fence(__ATOMIC_RELEASE, "agent"); asm volatile("s_waitcnt vmcnt(0)" ::: "memory"); }
        (void)xb_add(&ctl[GB_CNT(x)], 1u);
        XB_SPIN(xb_ld(&ctl[GB_CNT(x)]) < target, ctl);
        __builtin_amdgcn_fence(__ATOMIC_ACQUIRE, "agent");
        asm volatile("s_waitcnt vmcnt(0)" ::: "memory");
    }
    __syncthreads();
}

template <int NT, int ACT, int K>
__device__ __forceinline__ void small_gemm_tile(LAS unsigned char* lds, const bf16* __restrict__ A, const bf16* __restrict__ Bt, bf16* __restrict__ O, int ldc, int lda, int ldb, const float* __restrict__ rs, int m0, int n0, int tid) {
    constexpr int NC = 16 * NT, KW = K / 8, NCH = KW / 128;
    const int wave = __builtin_amdgcn_readfirstlane(tid >> 6), lane = tid & 63, fr = lane & 15, fq = lane >> 4;
    const bf16* ap = A + (size_t)(m0 + fr) * lda + wave * KW + fq * 8;
    const bf16* bp = Bt + (size_t)(n0 + fr) * ldb + wave * KW + fq * 8;
    f32x4 acc[4][NT];
#pragma unroll
    for (int m = 0; m < 4; ++m)
#pragma unroll
        for (int n = 0; n < NT; ++n) acc[m][n] = (f32x4){0.f, 0.f, 0.f, 0.f};
    if constexpr (NCH == 1) {
        bf16x8 fa[4][4], fb[4][NT];
#pragma unroll
        for (int s_ = 0; s_ < 4; ++s_) {
#pragma unroll
            for (int m = 0; m < 4; ++m) fa[s_][m] = *(const bf16x8*)(ap + (size_t)m * 16 * lda + s_ * 32);
#pragma unroll
            for (int n = 0; n < NT; ++n) fb[s_][n] = *(const bf16x8*)(bp + (size_t)n * 16 * ldb + s_ * 32); }
        __builtin_amdgcn_sched_barrier(0);
#pragma unroll
        for (int s_ = 0; s_ < 4; ++s_)
#pragma unroll
            for (int m = 0; m < 4; ++m)
#pragma unroll
                for (int n = 0; n < NT; ++n) acc[m][n] = __builtin_amdgcn_mfma_f32_16x16x32_bf16(fa[s_][m], fb[s_][n], acc[m][n], 0, 0, 0);
        __builtin_amdgcn_sched_barrier(0);
    } else {
        constexpr int NC2 = KW / 64;
        bf16x8 fa[3][2][4], fb[3][2][NT];
#define SG_LD(buf, c) do { _Pragma("unroll") for (int s_ = 0; s_ < 2; ++s_) { \
            _Pragma("unroll") for (int m = 0; m < 4; ++m) fa[buf][s_][m] = *(const bf16x8*)(ap + (size_t)m * 16 * lda + (c) * 64 + s_ * 32); \
            _Pragma("unroll") for (int n = 0; n < NT; ++n) fb[buf][s_][n] = *(const bf16x8*)(bp + (size_t)n * 16 * ldb + (c) * 64 + s_ * 32); } } while (0)
        SG_LD(0, 0); SG_LD(1, 1);
        __builtin_amdgcn_sched_barrier(0);
#pragma unroll
        for (int c = 0; c < NC2; ++c) {
            if (c + 2 < NC2) SG_LD((c + 2) % 3, c + 2);
            __builtin_amdgcn_sched_barrier(0);
#pragma unroll
            for (int s_ = 0; s_ < 2; ++s_)
#pragma unroll
                for (int m = 0; m < 4; ++m)
#pragma unroll
                    for (int n = 0; n < NT; ++n) acc[m][n] = __builtin_amdgcn_mfma_f32_16x16x32_bf16(fa[c % 3][s_][m], fb[c % 3][s_][n], acc[m][n], 0, 0, 0);
            __builtin_amdgcn_sched_barrier(0);
        }
#undef SG_LD
    }
    LAS float* P = (LAS float*)lds + wave * (64 * NC);
#pragma unroll
    for (int m = 0; m < 4; ++m)
#pragma unroll
        for (int n = 0; n < NT; ++n)
#pragma unroll
            for (int i = 0; i < 4; ++i) P[(m * 16 + fq * 4 + i) * NC + n * 16 + fr] = acc[m][n][i];
    __syncthreads();
    constexpr int EPT = 64 * NC / 512;
    const int e0 = tid * EPT, row = e0 / NC, col = e0 % NC;
    float r[EPT];
#pragma unroll
    for (int j = 0; j < EPT; ++j) r[j] = 0.f;
#pragma unroll
    for (int w = 0; w < 8; ++w) { const LAS f32x4* q = (const LAS f32x4*)((LAS float*)lds + w * (64 * NC) + e0);
#pragma unroll
        for (int j = 0; j < EPT / 4; ++j) { const f32x4 v = q[j]; r[4 * j] += v[0]; r[4 * j + 1] += v[1]; r[4 * j + 2] += v[2]; r[4 * j + 3] += v[3]; } }
    if (rs) { const float sc = rs[m0 + row];
#pragma unroll
        for (int j = 0; j < EPT; ++j) r[j] *= sc; }
    if (ACT == 1) {
#pragma unroll
        for (int j = 0; j < EPT; ++j) { const float t = fmaxf(r[j], 0.f); r[j] = t * t; } }
    bf16* op = O + (size_t)(m0 + row) * ldc + n0 + col;
    if (EPT == 8) { v4u w; w.x = pk2(r[0], r[1]); w.y = pk2(r[2], r[3]); w.z = pk2(r[4 % EPT], r[5 % EPT]); w.w = pk2(r[6 % EPT], r[7 % EPT]); *(v4u*)op = w; }
    else { v2u w; w.x = pk2(r[0], r[1]); w.y = pk2(r[2], r[3]); *(v2u*)op = w; }
    __syncthreads();
}

#define SMALL_TN(j, ntn) (((j) >> 8) * 32 + (((j) >> 3) & 31))
constexpr int NPH = 15;
#ifndef REP_PRO
#define REP_PRO 1
#endif
#ifndef REP_GEMM
#define REP_GEMM 1
#endif
#ifndef REP_MIX
#define REP_MIX 1
#endif
#ifndef REP_SYNC
#define REP_SYNC 1
#endif
struct Args { const float* in[24]; float* out; unsigned char* ws; int ph_lo, ph_hi; };
__global__ void __launch_bounds__(NWAVES * 64, 2) hybrid_fwd(Args args) {
    extern __shared__ __attribute__((aligned(16))) unsigned char lds_raw[];
    LAS unsigned char* lds = (LAS unsigned char*)lds_raw;
    volatile LAS unsigned* MISC = (volatile LAS unsigned*)(lds + MISC_OFF);
    if (threadIdx.x < 64) MISC[threadIdx.x] = 0u;
    __syncthreads();
    (void)xcd_barrier_post((unsigned*)(args.ws + WS_CTL), MISC + 8);
    if (threadIdx.x == 0) atomicOr((unsigned*)(args.ws + WS_CTL) + GB_MASK(blockIdx.x & 7), 1u << xb_xcc_id());
    unsigned gbn = 0;
    for (int ph = args.ph_lo; ph < args.ph_hi;) {
        int tid = threadIdx.x; asm volatile("" : "+v"(tid));
        const int lane = tid & 63, wave = __builtin_amdgcn_readfirstlane(tid >> 6);
        const int G = gridDim.x; const int bx = blockIdx.x;
        unsigned char* ws = args.ws;
        if (ph == 0) {
            const int vcu = (G % 8 == 0) ? (bx % 8) * (G / 8) + bx / 8 : bx; const int gw = vcu * NWAVES + wave, NGW = G * NWAVES;
            LAS float* scr = (LAS float*)(lds + wave * WAVE_SCR);
            bf16* XN = (bf16*)(ws + WS_XN); bf16* SGW = (bf16*)(ws + WS_SGUW);
            constexpr int I_FOLD = 4 * (DM / 32), I_OUT = (DM / 64) * (DM / 32) - I_FOLD, I_IN = (DM / 64) * (INW / 32), I_UP = (DM / 64) * (FF / 32), I_DN = (FF / 64) * (DM / 32);
            constexpr int I_LAYER = I_OUT + I_IN + I_UP + I_DN, I_ALL = DEPTH * I_LAYER;
            const int gwf = (NGW == 2048) ? (wave < 4 ? vcu * 4 + wave : 1024 + vcu * 4 + (wave - 4)) : gw;
            for (int it = gwf; it < DEPTH * I_FOLD * 4; it += NGW) { const int l = it / (I_FOLD * 4), r = it % (I_FOLD * 4);
                fold_item(args.in[10] + (size_t)l * DM * DM, (bf16*)(ws + WS_W + (size_t)l * W_LAYER + W_OUT), args.in[11] + (size_t)l * 4 * 64 * 64, args.in[12] + (size_t)l * GW, scr, r, lane); }
#define TR_DECODE(it_, d_) do { const int l_ = (it_) / I_LAYER; int r_ = (it_) % I_LAYER; unsigned char* wl_ = ws + WS_W + (size_t)l_ * W_LAYER; int nblk_; \
                if (r_ < I_OUT) { r_ += I_FOLD; d_.W = args.in[10] + (size_t)l_ * DM * DM; d_.WT = (bf16*)(wl_ + W_OUT); d_.gk = nullptr; d_.K = DM; d_.N = DM; } \
                else if ((r_ -= I_OUT) < I_IN) { d_.W = args.in[9] + (size_t)l_ * DM * INW; d_.WT = (bf16*)(wl_ + W_IN); d_.gk = args.in[5] + (size_t)l_ * DM; d_.K = DM; d_.N = INW; } \
                else if ((r_ -= I_IN) < I_UP) { d_.W = args.in[22] + (size_t)l_ * DM * FF; d_.WT = (bf16*)(wl_ + W_UP); d_.gk = args.in[7] + (size_t)l_ * DM; d_.K = DM; d_.N = FF; } \
                else { r_ -= I_UP; d_.W = args.in[23] + (size_t)l_ * FF * DM; d_.WT = (bf16*)(wl_ + W_DN); d_.gk = nullptr; d_.K = FF; d_.N = DM; } \
                nblk_ = d_.N / 32; d_.k0 = 64 * (r_ / nblk_); d_.n0 = 32 * (r_ % nblk_); } while (0)
            { const int TSTEP = NGW; int it = NGW - 1 - gwf;
              if (it >= 0 && it < I_ALL) {
                TrDesc d0, d1, d2; TR_DECODE(it, d0);
                float va[32], vb[32], vc[32];
                tr_load(va, d0, lane);
                { const int q = it + TSTEP < I_ALL ? it + TSTEP : it; TR_DECODE(q, d1); }
                tr_load(vb, d1, lane);
#pragma unroll 1
                for (; it < I_ALL; it += TSTEP) {
                    { const int q = it + 2 * TSTEP < I_ALL ? it + 2 * TSTEP : it; TR_DECODE(q, d2); }
                    tr_load(vc, d2, lane);
                    tr_store(va, d0, scr, lane);
#pragma unroll
                    for (int i = 0; i < 32; ++i) { va[i] = vb[i]; vb[i] = vc[i]; }
                    d0 = d1; d1 = d2;
                }
              }
            }
#undef TR_DECODE
#define X_SRC(m) ((m) < MP ? args.in[0] + (size_t)(m) * DM : args.in[1] + (size_t)((m) - MP) * DM)
            { const bool aff = false; const int x = vcu >> 5, wl = (vcu & 31) * NWAVES + wave;
              const int nk = aff ? 8 + (wl < 64 ? 1 : 0) : (gw < MT ? (MT - gw + NGW - 1) / NGW : 0);
#define PR_ROW(k) (aff ? ((k) < 8 ? 2048 * x + 256 * (k) + wl : MP + 64 * x + wl) : gw + (k) * NGW)
              if (nk > 0) { XRow x0, x1, x2;
                { const int ma = PR_ROW(0); xrow_load(x0, X_SRC(ma), lane); }
                { const int kb = 1 < nk ? 1 : 0; const int mb = PR_ROW(kb); xrow_load(x1, X_SRC(mb), lane); }
#pragma unroll 1
                for (int k = 0; k < nk; ++k) {
                    { const int kc = k + 2 < nk ? k + 2 : k; const int mc = PR_ROW(kc); xrow_load(x2, X_SRC(mc), lane); }
                    const int m = PR_ROW(k);
                    xrow_finish(x0, (bf16*)args.out + (size_t)m * 2 * DM, (float*)(ws + WS_RS) + m, lane);
                    x0 = x1; x1 = x2;
                } }
#undef PR_ROW
            }
#undef X_SRC

            for (int e = bx * (NWAVES * 64) + tid; e < DEPTH * 4 * 128 * 128; e += G * NWAVES * 64) { const int t = (e >> 7) & 127, s = e & 127; SGW[e] = (bf16)(s <= t ? f2bf(args.in[19][e]) : 0u); }
        } else {
            const int l = (ph - 1) / 7, k = (ph - 1) - 7 * l;
            unsigned char* wl = ws + WS_W + (size_t)l * W_LAYER;
            if (k == 0 || k == 2 || k == 5) {
                const bf16* A = k == 0 ? (const bf16*)args.out : (const bf16*)(ws + (k == 2 ? WS_CAT : WS_H));
                const bf16* Bt = (const bf16*)(wl + (k == 0 ? W_IN : k == 2 ? W_OUT : W_DN));
                bf16* O = (bf16*)(ws + (k == 0 ? WS_Z : WS_O));
                const int N = k == 0 ? INW : DM, K = k == 5 ? FF : DM;
                pg8::Gemm g{A, Bt, MP, N, K, k == 5 ? FP : k == 0 ? 2 * DM : DP, K + WPAD}; pg8::StaticOrder S; S.init(MP, N, G, bx);
                pg8::EpiBf16<0> E{O, k == 0 ? ZP : OP, k == 0 ? (const float*)(ws + WS_RS) : nullptr};
                pg8::gemm_phase<pg8::EpiBf16<0>, pg8::StaticOrder, true, true>(lds, g, S, E, tid);
                if (k == 0) { for (int j = bx; j < (MS / 64) * (INW / 64); j += G) small_gemm_tile<4, 0, DM>(lds, A, Bt, O, ZP, 2 * DM, DM + WPAD, (const float*)(ws + WS_RS), MP + (j & 7) * 64, SMALL_TN(j, INW / 64) * 64, tid); }
                else { for (int j = bx; j < (MS / 64) * (DM / 32); j += G) { if (k == 2) small_gemm_tile<2, 0, DM>(lds, A, Bt, O, OP, DP, DM + WPAD, nullptr, MP + (j & 7) * 64, SMALL_TN(j, DM / 32) * 32, tid); else small_gemm_tile<2, 0, FF>(lds, A, Bt, O, OP, FP, FF + WPAD, nullptr, MP + (j & 7) * 64, SMALL_TN(j, DM / 32) * 32, tid); } }
            } else if (k == 4) {
                pg8::Gemm g{(const bf16*)args.out, (const bf16*)(wl + W_UP), MP, FF, DM, 2 * DM, DM + WPAD}; pg8::StaticOrder S; S.init(MP, FF, G, bx);
                pg8::EpiBf16<1> E{(bf16*)(ws + WS_H), FP, (const float*)(ws + WS_RS)};
                pg8::gemm_phase<pg8::EpiBf16<1>, pg8::StaticOrder, true, true>(lds, g, S, E, tid);
                for (int j = bx; j < (MS / 64) * (FF / 64); j += G) small_gemm_tile<4, 1, DM>(lds, (const bf16*)args.out, (const bf16*)(wl + W_UP), (bf16*)(ws + WS_H), FP, 2 * DM, DM + WPAD, (const float*)(ws + WS_RS), MP + (j & 7) * 64, SMALL_TN(j, FF / 64) * 64, tid);
            } else if (k == 1) {
                const int vcu = (G % 8 == 0) ? (bx % 8) * (G / 8) + bx / 8 : bx; const int NGW = G * NWAVES;
                const int gw = (NGW == 2048) ? (wave < 2 ? vcu * 2 + wave : 512 + vcu * 6 + (wave - 2)) : vcu * NWAVES + wave;
                LAS float* scr = (LAS float*)(lds + wave * WAVE_SCR);
                const bf16* ZB = (const bf16*)(ws + WS_Z); bf16* CAT = (bf16*)(ws + WS_CAT); const bf16* SGW = (const bf16*)(ws + WS_SGUW) + (size_t)l * 4 * 128 * 128;
                float* out = args.out;
                constexpr int NU_SGU = 512, NU_CONV = 2048, NU_SEG = 1024, NU_SMP = 2048, NU = NU_SGU + NU_CONV + 2 * NU_SEG + NU_SMP;
#pragma unroll 1
                for (int ui = 0; ; ++ui) {
                    int u;
                    if (NGW != 2048) { u = ui * NGW + gw; if (u >= NU) break; }
                    else { if (ui >= 4) break;
                        const int x = vcu >> 5, cl_ = vcu & 31;
                        if (wave < 2) { const int a_l = cl_ * 2 + wave; if (ui == 0) u = 64 * x + a_l; else if (ui == 1) u = NU_SGU + 256 * x + 192 + a_l; else break; }
                        else { const int b_l = cl_ * 6 + (wave - 2);
                            if (ui == 0) u = NU_SGU + 256 * x + b_l;
                            else { const int ll = (ui - 1) * 192 + b_l; if (ll >= 512) break;
                                if (ll < 128) u = NU_SGU + NU_CONV + 128 * x + ll; else if (ll < 256) u = NU_SGU + NU_CONV + NU_SEG + 128 * x + (ll - 128); else { const int ls = ll - 256; u = NU_SGU + NU_CONV + 2 * NU_SEG + (ls >> 6) * 512 + (16 * x + ((ls >> 2) & 15)) * 4 + (ls & 3); } } } }
                    int lane = tid & 63; asm volatile("" : "+v"(lane));
                    if (u < NU_SGU) { sgu_unit(ZB, CAT, SGW, args.in[17] + (size_t)l * GW, args.in[18] + (size_t)l * GW, args.in[20] + (size_t)l * 4 * 128, u >> 2, u & 3, (LAS bf16*)scr, lane); continue; }
                    int r = u - NU_SGU;
                    if (r < NU_CONV) { const int seg = r >> 2, h = r & 3, seq = seg >> 6, t0 = (seg & 63) * 32;
                        conv_unit_p(ZB, CAT, out + OUT_CONV_P + (size_t)l * NBP * 30 * GW, args.in[13] + (size_t)l * 31 * GW, args.in[14] + (size_t)l * GW, args.in[15] + (size_t)l * GW, args.in[16] + (size_t)l * GW, seq, t0, h, scr, lane);
                        continue; }
                    r -= NU_CONV;
                    if (r < 2 * NU_SEG) { const int ty = r / NU_SEG, q = r % NU_SEG, seg = q >> 2, h = q & 3, seq = seg >> 5, t0 = (seg & 31) * 64;
                        if (ty == 0) { float* np = out + OUT_POOL_P + (size_t)l * NBP * 15 * GW;
                            if (h == 0) pool_unit_p<2>(ZB, CAT, np, seq, t0, h, lane); else if (h == 1) pool_unit_p<4>(ZB, CAT, np, seq, t0, h, lane);
                            else if (h == 2) pool_unit_p<8>(ZB, CAT, np, seq, t0, h, lane); else pool_unit_p<16>(ZB, CAT, np, seq, t0, h, lane); }
                        else short_unit_p(ZB, CAT, out + OUT_SHORT_P + (size_t)l * NBP * 2 * GW, args.in[21] + (size_t)l * 3 * GW, seq, t0, h, lane);
                        continue; }
                    r -= 2 * NU_SEG;
                    { const int ty = r >> 9, q = r & 511, seq = q >> 2, h = q & 3;
                        if (ty == 0) conv_unit<true>(ZB, CAT, args.in[3] + (size_t)l * NSB * 30 * GW, out + OUT_CONV_S + (size_t)l * NSB * 30 * GW, args.in[13] + (size_t)l * 31 * GW, args.in[14] + (size_t)l * GW, args.in[15] + (size_t)l * GW, args.in[16] + (size_t)l * GW, seq, 0, ST, h, scr, lane);
                        else if (ty == 1) { const float* sp = args.in[2] + (size_t)l * NSB * 15 * GW; float* np = out + OUT_POOL_S + (size_t)l * NSB * 15 * GW;
                            if (h == 0) pool_sample_unit<2>(ZB, CAT, sp, np, seq, h, lane); else if (h == 1) pool_sample_unit<4>(ZB, CAT, sp, np, seq, h, lane); else if (h == 2) pool_sample_unit<8>(ZB, CAT, sp, np, seq, h, lane); else pool_sample_unit<16>(ZB, CAT, sp, np, seq, h, lane); }
                        else if (ty == 2) short_unit<true>(ZB, CAT, args.in[4] + (size_t)l * NSB * 2 * GW, out + OUT_SHORT_S + (size_t)l * NSB * 2 * GW, args.in[21] + (size_t)l * 3 * GW, seq, 0, ST, h, lane);
                        else sgu_sample_unit(ZB, CAT, args.in[19] + (size_t)l * 4 * 128 * 128, args.in[17] + (size_t)l * GW, args.in[18] + (size_t)l * GW, args.in[20] + (size_t)l * 4 * 128, out + OUT_V_S + (size_t)l * NSB * ST * GW, seq, h, lane); }
                }
            } else {
                const int vcu = (G % 8 == 0) ? (bx % 8) * (G / 8) + bx / 8 : bx; const int gw = vcu * NWAVES + wave, NGW = G * NWAVES;
                const float* g = args.in[k == 3 ? 6 : 8] + (size_t)l * DM;
                float* X = args.out; const bf16* OB = (const bf16*)(ws + WS_O); float* RS = (float*)(ws + WS_RS);
                const bool from_input = (l == 0 && k == 3), write_xn = !(l == DEPTH - 1 && k == 6);
                float gg[2][8];
#pragma unroll
                for (int j = 0; j < 2; ++j) { const f32x4 g0 = ((const f32x4*)g)[2 * (lane + 64 * j)], g1 = ((const f32x4*)g)[2 * (lane + 64 * j) + 1];
                    gg[j][0] = g0[0]; gg[j][1] = g0[1]; gg[j][2] = g0[2]; gg[j][3] = g0[3]; gg[j][4] = g1[0]; gg[j][5] = g1[1]; gg[j][6] = g1[2]; gg[j][7] = g1[3]; }
                const int m_lo = 0;
#define EW_X32(m) ((m) < MP ? args.in[0] + (size_t)(m) * DM : args.in[1] + (size_t)((m) - MP) * DM)
                bf16* X16 = (bf16*)args.out;
                const bool dst16 = write_xn;
                { const bool aff = (NGW == 2048); const int x = vcu >> 5, wl = (vcu & 31) * NWAVES + wave;
                  const int nk = aff ? 8 + (wl < 64 ? 1 : 0) : (gw < MT ? (MT - gw + NGW - 1) / NGW : 0);
#define EW_ROW(k) (aff ? ((k) < 8 ? 2048 * x + 256 * (k) + wl : MP + 64 * x + wl) : gw + (k) * NGW)
                  if (nk > 0) { EwRow r0, r1, r2;
                    { const int ma = EW_ROW(0); ew_load(r0, X16 + (size_t)ma * 2 * DM, OB + (size_t)ma * OP, lane); }
                    { const int kb = 1 < nk ? 1 : 0; const int mb = EW_ROW(kb); ew_load(r1, X16 + (size_t)mb * 2 * DM, OB + (size_t)mb * OP, lane); }
#pragma unroll 1
                    for (int k = 0; k < nk; ++k) {
                        { const int kc = k + 2 < nk ? k + 2 : k; const int mc = EW_ROW(kc); ew_load(r2, X16 + (size_t)mc * 2 * DM, OB + (size_t)mc * OP, lane); }
                        const int m = EW_ROW(k);
                        ew_finish(r0, gg, X + (size_t)m * DM, X16 + (size_t)m * 2 * DM, dst16, RS + m, write_xn, lane);
                        r0 = r1; r1 = r2;
                    }
                  }
#undef EW_ROW
                }
#undef EW_X32
            }
        }
        ++ph;
        if (ph < args.ph_hi) {
            const int kd = (ph - 2) % 7;
            const bool local = (gridDim.x == 256) && ph >= 2 && kd != 3 && kd != 6;
            if (args.ph_lo < 0) cg::this_grid().sync();
            else if (local) { unsigned* ctl = (unsigned*)(args.ws + WS_CTL); const int x = blockIdx.x & 7; ++gbn;
                const unsigned mk = xb_ld(&ctl[GB_MASK(x)]); group_barrier(ctl, x, 32u * gbn, (mk & (mk - 1u)) == 0u && mk != 0u); }
            else { XcdBarrier b; b.bar = (unsigned*)(args.ws + WS_CTL); b.x = xb_xcc_id(); b.st = (volatile LAS unsigned*)(lds + MISC_OFF) + 8; xcd_barrier(b); }
        }
    }
}

#ifndef MK_N_LAUNCHES
#define MK_N_LAUNCHES 1
#endif
extern "C" void kernel_launch(void* const* d_in, const int* in_sizes, int n_in, void* d_out, int out_size, void* d_ws, size_t ws_size, hipStream_t stream) {
    static int grid = 0;
    if (grid == 0) {
        if (n_in != 24 || (size_t)out_size != OUT_END || ws_size < WS_END) { fprintf(stderr, "kernel_launch: unexpected shapes (n_in %d out %d ws %zu)\n", n_in, out_size, ws_size); grid = -1; return; }
        int dev = 0, cus = 0, per_cu = 0;
        if (hipGetDevice(&dev) != hipSuccess || hipDeviceGetAttribute(&cus, hipDeviceAttributeMultiprocessorCount, dev) != hipSuccess) { grid = -1; return; }
        if (hipFuncSetAttribute((const void*)hybrid_fwd, hipFuncAttributeMaxDynamicSharedMemorySize, LDS_BYTES) != hipSuccess) { fprintf(stderr, "kernel_launch: hipFuncSetAttribute failed\n"); grid = -1; return; }
        if (hipOccupancyMaxActiveBlocksPerMultiprocessor(&per_cu, (const void*)hybrid_fwd, NWAVES * 64, LDS_BYTES) != hipSuccess || per_cu < 1) per_cu = 1;
        (void)hipGetLastError();
        grid = cus * per_cu;
    }
    if (grid < 0) return;
    if (hipMemsetAsync((char*)d_ws + WS_CTL, 0, CTL_ZERO_BYTES, stream) != hipSuccess) { fprintf(stderr, "kernel_launch: hipMemsetAsync failed\n"); return; }
    Args a{};
    for (int i = 0; i < 24; ++i) a.in[i] = (const float*)d_in[i];
    a.out = (float*)d_out; a.ws = (unsigned char*)d_ws;
#if MK_N_LAUNCHES == 1
    a.ph_lo = 0; a.ph_hi = NPH;
    void* kargs[] = {&a};
    hipError_t e = hipLaunchCooperativeKernel((const void*)hybrid_fwd, dim3(grid), dim3(NWAVES * 64), kargs, LDS_BYTES, stream);
    if (e != hipSuccess) fprintf(stderr, "cooperative launch failed: %s (grid %d)\n", hipGetErrorString(e), grid);
#else
    for (int p = 0; p < NPH; ++p) { a.ph_lo = p; a.ph_hi = p + 1; hipLaunchKernelGGL(hybrid_fwd, dim3(grid), dim3(NWAVES * 64), LDS_BYTES, stream, a); }
#endif
}
```
